# Optimizing an MI355X kernel written in HIP

```python
import jax, jax.numpy as jnp
from jax import lax
import numpy as np

D_MODEL = 1024
BATCH = 16
SEQ = 4096
DEPTH = 4

GRID_W = 64
CTX_LEN = 256
N_MIXERS = 2
N_GLA_LAYERS = (DEPTH + 1) // 2
N_MLA_LAYERS = DEPTH // 2
EPS = 1e-6

GLA_HEADS = 4
GLA_DK = D_MODEL // 2 // GLA_HEADS
GLA_DV = D_MODEL // GLA_HEADS
GLA_GATE_RANK = 16
GLA_GATE_NORMALIZER = 16.0
GLA_CHUNK = 64
GLA_IN = 2 * GLA_HEADS * GLA_DK + 2 * GLA_HEADS * GLA_DV

MLA_HEADS = 8
MLA_NOPE = 128
MLA_ROPE = 64
MLA_QK = MLA_NOPE + MLA_ROPE
MLA_V = 128
MLA_Q_RANK = 384
MLA_KV_RANK = 256
MLA_DOWN = MLA_Q_RANK + MLA_KV_RANK + MLA_ROPE
ROPE_THETA = 10000.0
ROPE_FREQS = MLA_ROPE // 4
Q_BLOCK = 128

D_FF = 2816
CONV_W = 3

kernel_name = 'hybrid_gla_mla_convffn_prefix_dit'


def rmsnorm(x, g):
    xf = x.astype(jnp.float32)
    y = xf * lax.rsqrt(jnp.mean(xf * xf, axis=-1, keepdims=True) + EPS)
    return (y * g.astype(jnp.float32)).astype(x.dtype)


def ada_modulation(cond, w, b):
    m = jax.nn.silu(cond) @ w + b
    return jnp.split(m, 6, axis=-1)


def modulate(x, g, shift, scale):
    return rmsnorm(x, g) * (1 + scale[..., None, :]) + shift[..., None, :]


def axial_rope_tables(length):
    rows = length // GRID_W
    t = jnp.arange(rows * GRID_W)
    row = (t // GRID_W).astype(jnp.float32)
    col = (t % GRID_W).astype(jnp.float32)
    inv = ROPE_THETA ** (-jnp.arange(ROPE_FREQS, dtype=jnp.float32) / ROPE_FREQS)
    ang = jnp.stack([row[:, None] * inv, col[:, None] * inv], axis=1)
    return jnp.cos(ang)[:, None], jnp.sin(ang)[:, None]


def apply_axial_rope(x, cos, sin):
    xr = x.astype(jnp.float32).reshape(*x.shape[:-1], 2, 2, ROPE_FREQS)
    x1, x2 = xr[..., 0, :], xr[..., 1, :]
    out = jnp.stack([x1 * cos - x2 * sin, x1 * sin + x2 * cos], axis=-2)
    return out.reshape(x.shape).astype(x.dtype)


def gla_project(h, w_in):
    B, L, _ = h.shape
    q, k, v, r = jnp.split(h @ w_in, [GLA_HEADS * GLA_DK, 2 * GLA_HEADS * GLA_DK,
                                      2 * GLA_HEADS * GLA_DK + GLA_HEADS * GLA_DV], axis=-1)
    q = q.reshape(B, L, GLA_HEADS, GLA_DK) * (GLA_DK ** -0.5)
    k = k.reshape(B, L, GLA_HEADS, GLA_DK)
    v = v.reshape(B, L, GLA_HEADS, GLA_DV)
    return q, k, v, r


def gla_log_decay(h, w1, w2, b):
    z = ((h @ w1) @ w2 + b).astype(jnp.float32)
    return (jax.nn.log_sigmoid(z) / GLA_GATE_NORMALIZER).reshape(*h.shape[:-1], GLA_HEADS, GLA_DK)


def gla_chunked(q, k, v, g, s0):
    B, L, H, _ = q.shape
    n = L // GLA_CHUNK
    def chunks(a):
        return a.reshape(B, n, GLA_CHUNK, H, a.shape[-1]).astype(jnp.float32)
    qc, kc, vc, gc = chunks(q), chunks(k), chunks(v), chunks(g)
    b = jnp.cumsum(gc, axis=2)
    b_last = b[:, :, -1:]
    q_dec = qc * jnp.exp(b)
    k_intra = kc * jnp.exp(-b)
    k_state = kc * jnp.exp(b_last - b)
    mask = jnp.tril(jnp.ones((GLA_CHUNK, GLA_CHUNK), dtype=bool))
    scores = jnp.where(mask, jnp.einsum('bnthd,bnshd->bnhts', q_dec, k_intra), 0.0)
    o_intra = jnp.einsum('bnhts,bnshv->bnthv', scores, vc)

    def step(S, xs):
        qd, ks, vv, bl = xs
        o = jnp.einsum('bthd,bhdv->bthv', qd, S)
        S = S * jnp.exp(bl)[..., None] + jnp.einsum('bthd,bthv->bhdv', ks, vv)
        return S, o

    xs = (jnp.moveaxis(q_dec, 1, 0), jnp.moveaxis(k_state, 1, 0),
          jnp.moveaxis(vc, 1, 0), jnp.moveaxis(b_last[:, :, 0], 1, 0))
    s_final, o_inter = lax.scan(step, s0.astype(jnp.float32), xs)
    o = o_intra + jnp.moveaxis(o_inter, 0, 1)
    return o.reshape(B, L, H, v.shape[-1]).astype(v.dtype), s_final


def gla_bidirectional(q, k, v, g_fwd, g_bwd, s_fwd0, s_bwd0):
    o_f, s_f = gla_chunked(q, k, v, g_fwd, s_fwd0)
    flip = lambda a: jnp.flip(a, axis=1)
    o_b, s_b = gla_chunked(flip(q), flip(k), flip(v), flip(g_bwd), s_bwd0)
    return o_f + flip(o_b), s_f, s_b


def gla_output(o, r, out_norm, w_out):
    B, L = o.shape[:2]
    o = rmsnorm(o, out_norm).reshape(B, L, GLA_HEADS * GLA_DV)
    return (o * jax.nn.silu(r)) @ w_out


def gla_mixer(h, hc, w_in, gate_w1, gate_w2, gate_b, out_norm, w_out, need_ctx_out):
    B = h.shape[0]
    s0 = jnp.zeros((B, GLA_HEADS, GLA_DK, GLA_DV), jnp.float32)
    qc, kc, vc, rc = gla_project(hc, w_in)
    gfc = gla_log_decay(hc, gate_w1[0], gate_w2[0], gate_b[0])
    gbc = gla_log_decay(hc, gate_w1[1], gate_w2[1], gate_b[1])
    oc, s_fwd, s_bwd = gla_bidirectional(qc, kc, vc, gfc, gbc, s0, s0)
    q, k, v, r = gla_project(h, w_in)
    gf = gla_log_decay(h, gate_w1[0], gate_w2[0], gate_b[0])
    gb = gla_log_decay(h, gate_w1[1], gate_w2[1], gate_b[1])
    o, _, _ = gla_bidirectional(q, k, v, gf, gb, s_fwd, s_bwd)
    out = gla_output(o, r, out_norm, w_out)
    out_c = gla_output(oc, rc, out_norm, w_out) if need_ctx_out else None
    return out, out_c


def split_norm(t, g):
    return jnp.concatenate([rmsnorm(t[..., :MLA_NOPE], g[:MLA_NOPE]),
                            rmsnorm(t[..., MLA_NOPE:], g[MLA_NOPE:])], axis=-1)


def mla_qkv(h, w_down, q_lora_norm, kv_lora_norm, w_uq, w_ukv, q_norm, k_norm, rope, want_q):
    B, L, _ = h.shape
    c_q, c_kv, k_pe = jnp.split(h @ w_down, [MLA_Q_RANK, MLA_Q_RANK + MLA_KV_RANK], axis=-1)
    kv = (rmsnorm(c_kv, kv_lora_norm) @ w_ukv).reshape(B, L, MLA_HEADS, MLA_NOPE + MLA_V)
    k_nope, v = kv[..., :MLA_NOPE], kv[..., MLA_NOPE:]
    k_nope = rmsnorm(k_nope, k_norm[:MLA_NOPE])
    k_pe = rmsnorm(k_pe, k_norm[MLA_NOPE:])[:, :, None, :]
    if rope is not None:
        k_pe = apply_axial_rope(k_pe, *rope)
    k = jnp.concatenate([k_nope, jnp.broadcast_to(k_pe, (B, L, MLA_HEADS, MLA_ROPE))], axis=-1)
    q = None
    if want_q:
        q = split_norm((rmsnorm(c_q, q_lora_norm) @ w_uq).reshape(B, L, MLA_HEADS, MLA_QK), q_norm)
        if rope is not None:
            q = jnp.concatenate([q[..., :MLA_NOPE], apply_axial_rope(q[..., MLA_NOPE:], *rope)], axis=-1)
    return q, k, v


def block_softmax_attention(q, k, v):
    B, L, H, Dh = q.shape
    nb = L // Q_BLOCK
    scale = Dh ** -0.5
    qb = jnp.moveaxis(q.reshape(B, nb, Q_BLOCK, H, Dh), 1, 0)
    def one(qblk):
        s = jnp.einsum('bqhd,bkhd->bhqk', qblk, k).astype(jnp.float32) * scale
        p = jax.nn.softmax(s, axis=-1).astype(v.dtype)
        return jnp.einsum('bhqk,bkhv->bqhv', p, v)
    o = lax.map(one, qb)
    return jnp.moveaxis(o, 0, 1).reshape(B, L, H, v.shape[-1])


def mla_mixer(h, hc, w_down, q_lora_norm, kv_lora_norm, w_uq, w_ukv, q_norm, k_norm, w_out, rope, need_ctx_out):
    B, L, _ = h.shape
    qc, kc, vc = mla_qkv(hc, w_down, q_lora_norm, kv_lora_norm, w_uq, w_ukv, q_norm, k_norm, None, need_ctx_out)
    q, k, v = mla_qkv(h, w_down, q_lora_norm, kv_lora_norm, w_uq, w_ukv, q_norm, k_norm, rope, True)
    o = block_softmax_attention(q, jnp.concatenate([kc, k], axis=1), jnp.concatenate([vc, v], axis=1))
    out = o.reshape(B, L, MLA_HEADS * MLA_V) @ w_out
    out_c = None
    if need_ctx_out:
        oc = block_softmax_attention(qc, kc, vc)
        out_c = oc.reshape(B, hc.shape[1], MLA_HEADS * MLA_V) @ w_out
    return out, out_c


def depthwise_conv3(u, w, b):
    up = jnp.pad(u, ((0, 0), (1, 1), (0, 0)))
    return up[:, :-2] * w[0] + up[:, 1:-1] * w[1] + up[:, 2:] * w[2] + b


def conv_ffn(h, w_up, conv_w, conv_b, w_down):
    u = depthwise_conv3(h @ w_up, conv_w, conv_b)
    a, g = jnp.split(u, 2, axis=-1)
    return (jax.nn.silu(g) * a) @ w_down


def setup_inputs(seed: int = 0) -> dict:
    key = jax.random.key(seed)
    ks = jax.random.split(key, 32)
    nrm = lambda k, shape, s: jax.random.normal(k, shape, jnp.float32) * s
    gain = lambda k, shape: 1.0 + 0.05 * jax.random.normal(k, shape, jnp.float32)
    return {
        'x': nrm(ks[0], (BATCH, SEQ, D_MODEL), 1.0),
        'c': nrm(ks[1], (BATCH, D_MODEL), 1.0),
        'ctx': nrm(ks[2], (BATCH, CTX_LEN, D_MODEL), 1.0),
        'c_ctx': nrm(ks[3], (D_MODEL,), 1.0),
        'w_ada': nrm(ks[4], (DEPTH, D_MODEL, 6 * D_MODEL), 0.5 * D_MODEL ** -0.5),
        'b_ada': nrm(ks[5], (DEPTH, 6 * D_MODEL), 0.02),
        'norm_mix': gain(ks[6], (DEPTH, D_MODEL)),
        'norm_ffn': gain(ks[7], (DEPTH, D_MODEL)),
        'gla_w_in': nrm(ks[8], (N_GLA_LAYERS, D_MODEL, GLA_IN), D_MODEL ** -0.5),
        'gla_gate_w1': nrm(ks[9], (N_GLA_LAYERS, 2, D_MODEL, GLA_GATE_RANK), D_MODEL ** -0.5),
        'gla_gate_w2': nrm(ks[10], (N_GLA_LAYERS, 2, GLA_GATE_RANK, GLA_HEADS * GLA_DK), GLA_GATE_RANK ** -0.5),
        'gla_gate_b': nrm(ks[11], (N_GLA_LAYERS, 2, GLA_HEADS * GLA_DK), 0.1),
        'gla_out_norm': gain(ks[12], (N_GLA_LAYERS, GLA_DV)),
        'gla_w_out': nrm(ks[13], (N_GLA_LAYERS, GLA_HEADS * GLA_DV, D_MODEL), (GLA_HEADS * GLA_DV) ** -0.5),
        'mla_w_down': nrm(ks[14], (N_MLA_LAYERS, D_MODEL, MLA_DOWN), D_MODEL ** -0.5),
        'mla_q_lora_norm': gain(ks[15], (N_MLA_LAYERS, MLA_Q_RANK)),
        'mla_kv_lora_norm': gain(ks[16], (N_MLA_LAYERS, MLA_KV_RANK)),
        'mla_w_uq': nrm(ks[17], (N_MLA_LAYERS, MLA_Q_RANK, MLA_HEADS * MLA_QK), MLA_Q_RANK ** -0.5),
        'mla_w_ukv': nrm(ks[18], (N_MLA_LAYERS, MLA_KV_RANK, MLA_HEADS * (MLA_NOPE + MLA_V)), MLA_KV_RANK ** -0.5),
        'mla_q_norm': gain(ks[19], (N_MLA_LAYERS, MLA_QK)),
        'mla_k_norm': gain(ks[20], (N_MLA_LAYERS, MLA_QK)),
        'mla_w_out': nrm(ks[21], (N_MLA_LAYERS, MLA_HEADS * MLA_V, D_MODEL), (MLA_HEADS * MLA_V) ** -0.5),
        'ffn_w_up': nrm(ks[22], (DEPTH, D_MODEL, 2 * D_FF), D_MODEL ** -0.5),
        'ffn_conv_w': nrm(ks[23], (DEPTH, CONV_W, 2 * D_FF), CONV_W ** -0.5),
        'ffn_conv_b': nrm(ks[24], (DEPTH, 2 * D_FF), 0.02),
        'ffn_w_down': nrm(ks[25], (DEPTH, D_FF, D_MODEL), D_FF ** -0.5),
    }


def reference(x, c, ctx, c_ctx, w_ada, b_ada, norm_mix, norm_ffn,
              gla_w_in, gla_gate_w1, gla_gate_w2, gla_gate_b, gla_out_norm, gla_w_out,
              mla_w_down, mla_q_lora_norm, mla_kv_lora_norm, mla_w_uq, mla_w_ukv,
              mla_q_norm, mla_k_norm, mla_w_out,
              ffn_w_up, ffn_conv_w, ffn_conv_b, ffn_w_down):
    rope = axial_rope_tables(x.shape[1])
    xc = ctx
    for i in range(DEPTH):
        last = i == DEPTH - 1
        j = i // N_MIXERS
        sh1, sc1, g1, sh2, sc2, g2 = ada_modulation(c, w_ada[i], b_ada[i])
        csh1, csc1, cg1, csh2, csc2, cg2 = ada_modulation(c_ctx, w_ada[i], b_ada[i])
        h = modulate(x, norm_mix[i], sh1, sc1)
        hc = modulate(xc, norm_mix[i], csh1, csc1)
        if i % N_MIXERS == 0:
            o, oc = gla_mixer(h, hc, gla_w_in[j], gla_gate_w1[j], gla_gate_w2[j], gla_gate_b[j],
                              gla_out_norm[j], gla_w_out[j], not last)
        else:
            o, oc = mla_mixer(h, hc, mla_w_down[j], mla_q_lora_norm[j], mla_kv_lora_norm[j],
                              mla_w_uq[j], mla_w_ukv[j], mla_q_norm[j], mla_k_norm[j], mla_w_out[j],
                              rope, not last)
        x = x + g1[:, None, :] * o
        x = x + g2[:, None, :] * conv_ffn(modulate(x, norm_ffn[i], sh2, sc2),
                                          ffn_w_up[i], ffn_conv_w[i], ffn_conv_b[i], ffn_w_down[i])
        if not last:
            xc = xc + cg1 * oc
            xc = xc + cg2 * conv_ffn(modulate(xc, norm_ffn[i], csh2, csc2),
                                     ffn_w_up[i], ffn_conv_w[i], ffn_conv_b[i], ffn_w_down[i])
    return x
```

```cpp
#include <hip/hip_runtime.h>
#include <hip/hip_cooperative_groups.h>
#include <cstdio>
#include <cstdint>
namespace cg = cooperative_groups;

#ifndef MK_MULTI
#define MK_MULTI 0
#endif

#define LAS __attribute__((address_space(3)))
#define DI __device__ __forceinline__
typedef unsigned short bf16_t;
typedef short bf16x8 __attribute__((ext_vector_type(8)));
typedef short s16x4 __attribute__((ext_vector_type(4)));
typedef float f32x2 __attribute__((ext_vector_type(2)));
typedef float f32x4 __attribute__((ext_vector_type(4)));
typedef float f32x16 __attribute__((ext_vector_type(16)));
typedef unsigned u32x2 __attribute__((ext_vector_type(2)));
typedef unsigned u32x4 __attribute__((ext_vector_type(4)));

constexpr int DM = 1024, NB = 16, SEQ = 4096, CTXL = 256;
constexpr int TL = NB * SEQ, TC = NB * CTXL, MR = TL + TC;
constexpr int KEYS = CTXL + SEQ;
constexpr int DFF = 2816, DFFH = 1408;
constexpr int NTHREADS = 512;
constexpr int LDS_BYTES = 131072;
constexpr int NPH = 53;

constexpr size_t SZ_GIN = 3328ull * 1024 * 2, SZ_SQ = 1024ull * 1024 * 2, SZ_MDOWN = 768ull * 1024 * 2, SZ_MUQ = 1536ull * 384 * 2,
                 SZ_MUKV = 2048ull * 256 * 2, SZ_FUP = 2816ull * 1024 * 2, SZ_FDOWN = 1024ull * 1408 * 2;
constexpr size_t WS_GIN = 0;
constexpr size_t WS_GOUT = WS_GIN + 2 * SZ_GIN;
constexpr size_t WS_MDOWN = WS_GOUT + 2 * SZ_SQ;
constexpr size_t WS_MUQ = WS_MDOWN + 2 * SZ_MDOWN;
constexpr size_t WS_MUKV = WS_MUQ + 2 * SZ_MUQ;
constexpr size_t WS_MOUT = WS_MUKV + 2 * SZ_MUKV;
constexpr size_t WS_FUP = WS_MOUT + 2 * SZ_SQ;
constexpr size_t WS_FDOWN = WS_FUP + 8 * SZ_FUP;
constexpr size_t WS_MOD = WS_FDOWN + 8 * SZ_FDOWN;
constexpr size_t SZ_MOD = 4ull * 17 * 6144 * 4;
constexpr size_t WS_XC = WS_MOD + ((SZ_MOD + 255) / 256) * 256;
constexpr size_t WS_H = WS_XC + (size_t)TC * 1024 * 4;
constexpr size_t WS_R = WS_H + (size_t)MR * 1024 * 2;
constexpr size_t WS_QKVR = WS_R;
constexpr size_t WS_LR = WS_QKVR + (size_t)MR * 3072 * 2;
constexpr size_t WS_OF = WS_LR + (size_t)MR * 32 * 4;
constexpr size_t WS_OB = WS_OF + (size_t)MR * 1024 * 2;
constexpr size_t WS_GLA_END = WS_OB + (size_t)MR * 1024 * 2;
constexpr size_t WS_QRAW = WS_R;
constexpr size_t WS_DN = WS_R;
constexpr size_t WS_CQN = WS_QRAW + (size_t)MR * 1536 * 2;
constexpr size_t WS_CKVN = WS_CQN + (size_t)MR * 384 * 2;
constexpr size_t WS_KB = WS_CKVN + (size_t)MR * 256 * 2;
constexpr size_t WS_VB = WS_KB + (size_t)NB * KEYS * 1536 * 2;
constexpr size_t WS_MLA_END = WS_VB + (size_t)NB * KEYS * 1024 * 2;
constexpr size_t WS_U = WS_R;
constexpr size_t WS_ACT = WS_U + (size_t)MR * 2816 * 2;
constexpr size_t WS_FFN_END = WS_ACT + (size_t)MR * 1408 * 2;
constexpr size_t WS_END = WS_GLA_END > WS_MLA_END ? (WS_GLA_END > WS_FFN_END ? WS_GLA_END : WS_FFN_END) : (WS_MLA_END > WS_FFN_END ? WS_MLA_END : WS_FFN_END);
static_assert(WS_END <= (1ull << 30), "workspace over 1 GiB");

struct Params { const float* in[26]; float* out; unsigned char* ws; int ph_lo, ph_hi; };

DI unsigned cvt_pk_bf16(float lo, float hi) { unsigned r; asm("v_cvt_pk_bf16_f32 %0, %1, %2" : "=v"(r) : "v"(lo), "v"(hi)); return r; }
DI float bf_lo(unsigned u) { return __uint_as_float(u << 16); }
DI float bf_hi(unsigned u) { return __uint_as_float(u & 0xffff0000u); }
DI bf16_t f2bf(float f) { return (bf16_t)(cvt_pk_bf16(f, 0.f) & 0xffffu); }
DI float wave_sum(float v) {
#pragma unroll
    for (int o = 32; o >= 1; o >>= 1) v += __shfl_xor(v, o);
    return v;
}
DI float silu_f(float v) { return v * __builtin_amdgcn_rcpf(1.0f + __expf(-v)); }
DI int crow(int r, int hi) { return (r & 3) + 8 * (r >> 2) + 4 * hi; }
DI int tid_opq() { int t = threadIdx.x; asm volatile("" : "+v"(t)); return t; }
DI int opq(int i) { asm volatile("" : "+s"(i)); return i; }

namespace pg8 {
constexpr int BM = 256, BK = 64, HALF = 128, HTB = HALF * BK * 2, STAGE_BYTES = 8 * HTB, NXCD = 8, WGM = 8;
DI int lds_byte(int r, int c) { const int st = (r >> 4) * 2 + (c >> 5), rr = r & 15, cc = c & 31, ob = rr * 64 + cc * 2; return st * 1024 + (ob ^ (((ob >> 9) & 1) << 5)); }
DI void stage_rc(int b, int& R, int& C) { const int st = b / 1024, sb = b % 1024, swz = sb ^ (((sb >> 9) & 1) << 5); R = (st >> 1) * 16 + swz / 64; C = (st & 1) * 32 + (swz % 64) / 2; }
DI int perm32(int rho) { const int n = rho >> 4, i = rho & 15; return 8 * (i >> 2) + 4 * n + (i & 3); }
struct Unit { int pm, pn; };
struct Gemm { const bf16_t* A; const bf16_t* Bt; int M, N, K, lda, ldb; };
struct StaticOrder {
    int nM, nN, nwg, G, c;
    DI void init(int M, int N, int G_, int c_) { nM = M / BM; nN = N / BM; nwg = nM * nN; G = G_; c = c_; }
    DI bool next(int i, Unit& u) const {
        const long L = (long)i * G + c; if (L >= nwg) return false;
        int wgid = (int)L; { const int q = nwg / NXCD, r = nwg % NXCD, xcd = wgid % NXCD, off = wgid / NXCD; wgid = (xcd < r ? xcd * (q + 1) : r * (q + 1) + (xcd - r) * q) + off; }
        const int nig = WGM * nN, gid = wgid / nig, fm = gid * WGM, gsz = (nM - fm) < WGM ? (nM - fm) : WGM;
        u.pm = fm + ((wgid % nig) % gsz); u.pn = (wgid % nig) / gsz; return true;
    }
};

template <class Epi>
DI void gemm_phase(LAS unsigned char* lds, const Gemm g, const StaticOrder& S, const Epi& E, const bool perm) {
    const int tid = tid_opq(), wid = __builtin_amdgcn_readfirstlane(tid >> 6), lane = tid & 63, wr = wid >> 2, wc = wid & 3, fr = lane & 15, fq = lane >> 4;
    const int K = g.K, nt = K / BK;
    unsigned voffA[2], voffB[2];
#pragma unroll
    for (int i = 0; i < 2; ++i) { int R, C; stage_rc(tid * 16 + i * 8192, R, C); const int Rb = perm ? ((R & ~31) + perm32(R & 31)) : R;
        voffA[i] = (unsigned)(R * g.lda + C) * 2u; voffB[i] = (unsigned)(Rb * g.ldb + C) * 2u; }
    const size_t kstep = (size_t)(BK * 2);
    const size_t hstepA = (size_t)HALF * g.lda * 2, hstepB = (size_t)HALF * g.ldb * 2;
    const size_t tstepA = 2 * hstepA, tstepB = 2 * hstepB;
    const unsigned ldsw = (unsigned)wid * 1024u;
    const int aoff = lds_byte(wr * 64 + fr, fq * 8), boff = lds_byte(wc * 32 + fr, fq * 8);
#define PG8_SA(b, h) (((b) * 2 + (h)) * HTB)
#define PG8_SB(b, h) ((4 + (b) * 2 + (h)) * HTB)
#define PG8_STAGE(bufoff, gbase, voff) do { _Pragma("unroll") for (int _i = 0; _i < 2; ++_i) \
        __builtin_amdgcn_global_load_lds((const unsigned*)((const char*)(gbase) + (voff)[_i]), (LAS unsigned*)(lds + (bufoff) + ldsw + _i * 8192), 16, 0, 0); } while (0)
#define PG8_LDA(dst, b, h) do { _Pragma("unroll") for (int m = 0; m < 4; ++m) _Pragma("unroll") for (int k = 0; k < 2; ++k) dst[m][k] = *(const LAS bf16x8*)(lds + PG8_SA(b, h) + aoff + m * 2048 + k * 1024); } while (0)
#define PG8_LDB(dst, b, h) do { _Pragma("unroll") for (int n = 0; n < 2; ++n) _Pragma("unroll") for (int k = 0; k < 2; ++k) dst[n][k] = *(const LAS bf16x8*)(lds + PG8_SB(b, h) + boff + n * 2048 + k * 1024); } while (0)
#define PG8_MMA(ai, bj, At, Bt) do { __builtin_amdgcn_s_setprio(1); _Pragma("unroll") for (int m = 0; m < 4; ++m) _Pragma("unroll") for (int n = 0; n < 2; ++n) _Pragma("unroll") for (int k = 0; k < 2; ++k) \
        acc[ai][bj][m][n] = __builtin_amdgcn_mfma_f32_16x16x32_bf16(Bt[n][k], At[m][k], acc[ai][bj][m][n], 0, 0, 0); __builtin_amdgcn_s_setprio(0); } while (0)
#define PG8_WAIT_V(n) asm volatile("s_waitcnt vmcnt(" #n ")" ::: "memory")
#define PG8_WAIT_L(n) asm volatile("s_waitcnt lgkmcnt(" #n ")" ::: "memory")
#define PG8_BAR __builtin_amdgcn_s_barrier()
#define PG8_SCHED __builtin_amdgcn_sched_barrier(0)
    Unit cur, nxt; int ui = 0;
    if (!S.next(0, cur)) return;
    f32x4 acc[2][2][4][2];
#pragma unroll
    for (int a = 0; a < 2; ++a)
#pragma unroll
        for (int b = 0; b < 2; ++b)
#pragma unroll
            for (int m = 0; m < 4; ++m)
#pragma unroll
                for (int n = 0; n < 2; ++n) acc[a][b][m][n] = (f32x4){0.f, 0.f, 0.f, 0.f};
    bf16x8 At[4][2], B0[2][2], B1[2][2];
    const char* cA = (const char*)g.A + (size_t)cur.pm * tstepA; const char* cB = (const char*)g.Bt + (size_t)cur.pn * tstepB;
    PG8_STAGE(PG8_SB(0, 0), cB, voffB); PG8_STAGE(PG8_SA(0, 0), cA, voffA); PG8_STAGE(PG8_SB(0, 1), cB + hstepB, voffB); PG8_STAGE(PG8_SA(0, 1), cA + hstepA, voffA);
    if (wr == 1) PG8_BAR;
    PG8_WAIT_V(4); PG8_BAR;
    PG8_STAGE(PG8_SB(1, 0), cB + kstep, voffB); PG8_STAGE(PG8_SA(1, 0), cA + kstep, voffA); PG8_STAGE(PG8_SB(1, 1), cB + hstepB + kstep, voffB);
    PG8_WAIT_V(6); PG8_BAR;
    for (;;) {
        const bool has_next = S.next(ui + 1, nxt);
        const char* nA = has_next ? (const char*)g.A + (size_t)nxt.pm * tstepA : cA; const char* nB = has_next ? (const char*)g.Bt + (size_t)nxt.pn * tstepB : cB;
        for (int t = 0; t < nt; t += 2) {
            const bool last = (t == nt - 2);
            const char* a1 = cA + (size_t)(t + 1) * kstep;
            const char* a2 = last ? nA : cA + (size_t)(t + 2) * kstep; const char* b2 = last ? nB : cB + (size_t)(t + 2) * kstep;
            const char* a3 = a2 + kstep; const char* b3 = b2 + kstep;
            PG8_LDB(B0, 0, 0); PG8_SCHED; PG8_LDA(At, 0, 0); PG8_STAGE(PG8_SA(1, 1), a1 + hstepA, voffA);
            PG8_WAIT_L(8); PG8_BAR; PG8_WAIT_L(0); PG8_MMA(0, 0, At, B0); PG8_BAR; PG8_SCHED;
            PG8_LDB(B1, 0, 1); PG8_STAGE(PG8_SB(0, 0), b2, voffB);
            PG8_BAR; PG8_WAIT_L(0); PG8_MMA(0, 1, At, B1); PG8_BAR;
            PG8_LDA(At, 0, 1); PG8_STAGE(PG8_SA(0, 0), a2, voffA);
            PG8_BAR; PG8_WAIT_L(0); PG8_MMA(1, 0, At, B0); PG8_BAR; PG8_SCHED;
            PG8_STAGE(PG8_SB(0, 1), b2 + hstepB, voffB);
            PG8_WAIT_V(6); PG8_BAR; PG8_MMA(1, 1, At, B1); PG8_BAR;
            PG8_LDB(B0, 1, 0); PG8_SCHED; PG8_LDA(At, 1, 0); PG8_STAGE(PG8_SA(0, 1), a2 + hstepA, voffA);
            PG8_WAIT_L(8); PG8_BAR; PG8_WAIT_L(0); PG8_MMA(0, 0, At, B0); PG8_BAR; PG8_SCHED;
            PG8_LDB(B1, 1, 1); PG8_STAGE(PG8_SB(1, 0), b3, voffB);
            PG8_BAR; PG8_WAIT_L(0); PG8_MMA(0, 1, At, B1); PG8_BAR;
            PG8_LDA(At, 1, 1); PG8_STAGE(PG8_SA(1, 0), a3, voffA);
            PG8_BAR; PG8_WAIT_L(0); PG8_MMA(1, 0, At, B0); PG8_BAR; PG8_SCHED;
            PG8_STAGE(PG8_SB(1, 1), b3 + hstepB, voffB);
            PG8_WAIT_V(6); PG8_BAR; PG8_MMA(1, 1, At, B1); PG8_BAR;
        }
        E(acc, cur, wr, wc, fr, fq);
        if (!has_next) break;
#pragma unroll
        for (int a = 0; a < 2; ++a)
#pragma unroll
            for (int b = 0; b < 2; ++b)
#pragma unroll
                for (int m = 0; m < 4; ++m)
#pragma unroll
                    for (int n = 0; n < 2; ++n) acc[a][b][m][n] = (f32x4){0.f, 0.f, 0.f, 0.f};
        cur = nxt; cA = nA; cB = nB; ++ui;
    }
    PG8_WAIT_V(0);
    if (wr == 0) PG8_BAR;
    PG8_BAR;
#undef PG8_SA
#undef PG8_SB
#undef PG8_STAGE
#undef PG8_LDA
#undef PG8_LDB
#undef PG8_MMA
#undef PG8_WAIT_V
#undef PG8_WAIT_L
#undef PG8_BAR
#undef PG8_SCHED
}
}

enum { EPI_BF16 = 0, EPI_GLA_IN = 1, EPI_RESID = 2, EPI_UKV = 3 };
struct Epi {
    int kind;
    bf16_t* O; int ldc;
    float* lr;
    const float* base_l; const float* base_c; float* out_l; float* out_c; const float* gate;
    bf16_t* KB; bf16_t* VB;
    DI void operator()(const f32x4 (&acc)[2][2][4][2], const pg8::Unit& u, int wr, int wc, int fr, int fq) const {
        if (kind == EPI_RESID) {
            const int bidx = u.pm < 256 ? (u.pm >> 4) : 16;
            const float* gv = gate + (size_t)bidx * 6144;
            const float* bp = u.pm < 256 ? base_l + (size_t)u.pm * 256 * 1024 : base_c + (size_t)(u.pm - 256) * 256 * 1024;
            float* op = u.pm < 256 ? out_l + (size_t)u.pm * 256 * 1024 : out_c + (size_t)(u.pm - 256) * 256 * 1024;
            const int col0 = u.pn * 256 + wc * 32 + 4 * fq;
            f32x4 gt[2][2];
#pragma unroll
            for (int bj = 0; bj < 2; ++bj)
#pragma unroll
                for (int n = 0; n < 2; ++n) gt[bj][n] = *(const f32x4*)(gv + col0 + bj * 128 + n * 16);
#pragma unroll
            for (int ai = 0; ai < 2; ++ai)
#pragma unroll
                for (int m = 0; m < 4; ++m) {
                    const size_t off = (size_t)(ai * 128 + wr * 64 + m * 16 + fr) * 1024 + col0;
#pragma unroll
                    for (int bj = 0; bj < 2; ++bj)
#pragma unroll
                        for (int n = 0; n < 2; ++n) {
                            const f32x4 bs = *(const f32x4*)(bp + off + bj * 128 + n * 16);
                            *(f32x4*)(op + off + bj * 128 + n * 16) = bs + gt[bj][n] * acc[ai][bj][m][n];
                        }
                }
            return;
        }
        const int rowt = u.pm * 256 + wr * 64 + fr;
#pragma unroll
        for (int ai = 0; ai < 2; ++ai)
#pragma unroll
            for (int m = 0; m < 4; ++m) {
                const int row = rowt + ai * 128 + m * 16;
#pragma unroll
                for (int bj = 0; bj < 2; ++bj) {
                    f32x4 v0 = acc[ai][bj][m][0], v1 = acc[ai][bj][m][1];
                    const int cin = bj * 128 + wc * 32 + 8 * fq;
                    if (kind == EPI_GLA_IN) {
                        if (u.pn == 12) {
                            if (bj == 0 && wc == 0) { float* lp = lr + (size_t)row * 32 + 8 * fq; *(f32x4*)lp = v0; *(f32x4*)(lp + 4) = v1; }
                            continue;
                        }
                        if (u.pn < 2) { v0 *= 0.08838834764831845f; v1 *= 0.08838834764831845f; }
                    }
                    u32x4 w; w.x = cvt_pk_bf16(v0[0], v0[1]); w.y = cvt_pk_bf16(v0[2], v0[3]); w.z = cvt_pk_bf16(v1[0], v1[1]); w.w = cvt_pk_bf16(v1[2], v1[3]);
                    if (kind == EPI_UKV) {
                        int key;
                        if (u.pm < 256) { const int b = u.pm >> 4; key = b * KEYS + CTXL + (row - b * SEQ); }
                        else { const int b = u.pm - 256; key = b * KEYS + (row - TL - b * CTXL); }
                        const int cc = wc * 32 + 8 * fq;
                        if (bj == 0) *(u32x4*)(KB + (size_t)key * 1536 + u.pn * 192 + cc) = w;
                        else *(u32x4*)(VB + (size_t)key * 1024 + u.pn * 128 + cc) = w;
                    } else {
                        *(u32x4*)(O + (size_t)row * ldc + u.pn * 256 + cin) = w;
                    }
                }
            }
    }
};

DI void prep_phase(const Params& p, LAS unsigned char* lds) {
    const int tid = tid_opq();
    unsigned char* ws = p.ws;
    LAS float* tl = (LAS float*)lds;
    const float* in_c = p.in[opq(1)]; const float* in_cctx = p.in[opq(3)]; const float* in_wada = p.in[opq(4)]; const float* in_bada = p.in[opq(5)];
    const float* in_gin = p.in[opq(8)]; const float* in_w1 = p.in[opq(9)]; const float* in_gout = p.in[opq(13)]; const float* in_mdown = p.in[opq(14)];
    const float* in_uq = p.in[opq(17)]; const float* in_ukv = p.in[opq(18)]; const float* in_mout = p.in[opq(21)]; const float* in_fup = p.in[opq(22)]; const float* in_fdown = p.in[opq(25)];
    constexpr int T0 = 1536, T2 = 512, T3 = 352, T4 = 288, T5 = 256, T6 = 512, T7 = 5632, T8 = 2816;
    constexpr int NTILE = T0 + T2 + T3 + T4 + T5 + T6 + T7 + T8;
    for (int t = blockIdx.x; t < NTILE; t += gridDim.x) {
        const float* src; int N, k0, n0, ld; bf16_t* dst;
        int q = t;
        if (q < T0) { const int j = q / 768, r = q % 768, kt = r / 48, nt = r % 48; src = in_gin + (size_t)j * 1024 * 3072; N = 3072; k0 = kt * 64; n0 = nt * 64;
            dst = (bf16_t*)(ws + WS_GIN + j * SZ_GIN) + (size_t)n0 * 1024 + k0; ld = 1024; }
        else if ((q -= T0) < T2) { const int j = q / 256, r = q % 256, kt = r / 16, nt = r % 16; src = in_gout + (size_t)j * 1024 * 1024; N = 1024; k0 = kt * 64; n0 = nt * 64;
            dst = (bf16_t*)(ws + WS_GOUT + j * SZ_SQ) + (size_t)n0 * 1024 + k0; ld = 1024; }
        else if ((q -= T2) < T3) { const int j = q / 176, r = q % 176, kt = r / 11, nt = r % 11; src = in_mdown + (size_t)j * 1024 * 704; N = 704; k0 = kt * 64; n0 = nt * 64;
            dst = (bf16_t*)(ws + WS_MDOWN + j * SZ_MDOWN) + (size_t)n0 * 1024 + k0; ld = 1024; }
        else if ((q -= T3) < T4) { const int j = q / 144, r = q % 144, kt = r / 24, nt = r % 24; src = in_uq + (size_t)j * 384 * 1536; N = 1536; k0 = kt * 64; n0 = nt * 64;
            dst = (bf16_t*)(ws + WS_MUQ + j * SZ_MUQ) + (size_t)n0 * 384 + k0; ld = 384; }
        else if ((q -= T4) < T5) { const int j = q / 128, r = q % 128, kt = r / 32, nt = r % 32; src = in_ukv + (size_t)j * 256 * 2048; N = 2048; k0 = kt * 64; n0 = nt * 64;
            dst = (bf16_t*)(ws + WS_MUKV + j * SZ_MUKV) + (size_t)n0 * 256 + k0; ld = 256; }
        else if ((q -= T5) < T6) { const int j = q / 256, r = q % 256, kt = r / 16, nt = r % 16; src = in_mout + (size_t)j * 1024 * 1024; N = 1024; k0 = kt * 64; n0 = nt * 64;
            dst = (bf16_t*)(ws + WS_MOUT + j * SZ_SQ) + (size_t)n0 * 1024 + k0; ld = 1024; }
        else if ((q -= T6) < T7) { const int i = q / 1408, r = q % 1408, kt = r / 88, nt = r % 88; src = in_fup + (size_t)i * 1024 * 5632; N = 5632; k0 = kt * 64; n0 = nt * 64;
            const int isg = n0 >= DFF ? 1 : 0, cc = n0 - isg * DFF, hf = cc / DFFH, rem = cc % DFFH, drow = (rem >> 7) * 256 + isg * 128 + (rem & 127);
            dst = (bf16_t*)(ws + WS_FUP + (size_t)(i * 2 + hf) * SZ_FUP) + (size_t)drow * 1024 + k0; ld = 1024; }
        else { q -= T7; const int i = q / 704, r = q % 704, kt = r / 16, nt = r % 16; src = in_fdown + (size_t)i * 2816 * 1024; N = 1024; k0 = kt * 64; n0 = nt * 64;
            const int hf = k0 / DFFH, kk = k0 % DFFH;
            dst = (bf16_t*)(ws + WS_FDOWN + (size_t)(i * 2 + hf) * SZ_FDOWN) + (size_t)n0 * 1408 + kk; ld = 1408; }
#pragma unroll
        for (int i = 0; i < 8; ++i) { const int r = (tid >> 6) + 8 * i, c = tid & 63; tl[c * 65 + r] = src[(size_t)(k0 + r) * N + n0 + c]; }
        __syncthreads();
#pragma unroll
        for (int i = 0; i < 4; ++i) { const int rr = (tid >> 5) + 16 * i, c2 = (tid & 31) * 2; const float a = tl[rr * 65 + c2], b = tl[rr * 65 + c2 + 1];
            *(unsigned*)(dst + (size_t)rr * ld + c2) = cvt_pk_bf16(a, b); }
        __syncthreads();
    }
    const int gtid = blockIdx.x * NTHREADS + tid, gstride = gridDim.x * NTHREADS;
    for (int idx = gtid; idx < 65536; idx += gstride) {
        const int k = idx & 1023, r = (idx >> 10) & 15, dir = (idx >> 14) & 1, j = idx >> 15;
        const float v = in_w1[((size_t)(j * 2 + dir) * 1024 + k) * 16 + r];
        ((bf16_t*)(ws + WS_GIN + j * SZ_GIN))[(size_t)(3072 + dir * 16 + r) * 1024 + k] = f2bf(v);
    }
    for (int idx = gtid; idx < 2 * 114688; idx += gstride) { const int j = idx / 114688, o = idx % 114688; ((unsigned*)(ws + WS_GIN + j * SZ_GIN + 3104ull * 1024 * 2))[o] = 0u; }
    for (int idx = gtid; idx < 2 * 32768; idx += gstride) { const int j = idx / 32768, o = idx % 32768; ((unsigned*)(ws + WS_MDOWN + j * SZ_MDOWN + 704ull * 1024 * 2))[o] = 0u; }
    LAS float* sl = (LAS float*)lds;
    LAS float* red = (LAS float*)(lds + 81920);
    __syncthreads();
    for (int idx = tid; idx < 17 * 1024; idx += NTHREADS) { const int r = idx >> 10, k = idx & 1023; const float v = r < 16 ? in_c[r * 1024 + k] : in_cctx[k]; sl[k * 20 + r] = v / (1.0f + __expf(-v)); }
    __syncthreads();
    float* mod = (float*)(ws + WS_MOD);
    for (int it = blockIdx.x; it < 384; it += gridDim.x) {
        const int layer = it / 96, n0 = (it % 96) * 64, nn = tid & 63, ks = tid >> 6;
        const float* W = in_wada + (size_t)layer * 1024 * 6144 + n0 + nn;
        float acc[17];
#pragma unroll
        for (int r = 0; r < 17; ++r) acc[r] = 0.f;
        for (int kk = 0; kk < 128; ++kk) {
            const int k = ks * 128 + kk; const float w = W[(size_t)k * 6144];
            const f32x4 s0 = *(const LAS f32x4*)(sl + k * 20), s1 = *(const LAS f32x4*)(sl + k * 20 + 4), s2 = *(const LAS f32x4*)(sl + k * 20 + 8), s3 = *(const LAS f32x4*)(sl + k * 20 + 12);
            const float s16 = sl[k * 20 + 16];
#pragma unroll
            for (int j = 0; j < 4; ++j) { acc[j] += s0[j] * w; acc[4 + j] += s1[j] * w; acc[8 + j] += s2[j] * w; acc[12 + j] += s3[j] * w; }
            acc[16] += s16 * w;
        }
#pragma unroll
        for (int r = 0; r < 17; ++r) red[(ks * 17 + r) * 64 + nn] = acc[r];
        __syncthreads();
        for (int o = tid; o < 17 * 64; o += NTHREADS) { const int r = o >> 6, c = o & 63; float s = in_bada[layer * 6144 + n0 + c];
#pragma unroll
            for (int k8 = 0; k8 < 8; ++k8) s += red[(k8 * 17 + r) * 64 + c];
            mod[(size_t)(layer * 17 + r) * 6144 + n0 + c] = s; }
        __syncthreads();
    }
}

DI void norm_phase(const float* xl, const float* xc, const float* gain, const float* modl, int sh_off, int sc_off, bf16_t* h) {
    const int tid = tid_opq(), wave = tid >> 6, lane = tid & 63;
    for (int row = blockIdx.x * 8 + wave; row < MR; row += gridDim.x * 8) {
        const float* src = row < TL ? xl + (size_t)row * 1024 : xc + (size_t)(row - TL) * 1024;
        const float* mb = modl + (size_t)(row < TL ? (row >> 12) : 16) * 6144;
        f32x4 v[4]; float ss = 0.f;
#pragma unroll
        for (int i = 0; i < 4; ++i) { v[i] = *(const f32x4*)(src + i * 256 + lane * 4); ss += v[i][0] * v[i][0] + v[i][1] * v[i][1] + v[i][2] * v[i][2] + v[i][3] * v[i][3]; }
        ss = wave_sum(ss);
        const float rstd = rsqrtf(ss * (1.0f / 1024.0f) + 1e-6f);
#pragma unroll
        for (int i = 0; i < 4; ++i) {
            const int c = i * 256 + lane * 4;
            const f32x4 g = *(const f32x4*)(gain + c), sc = *(const f32x4*)(mb + sc_off + c), sh = *(const f32x4*)(mb + sh_off + c);
            const f32x4 y = (v[i] * rstd * g) * (sc + 1.0f) + sh;
            u32x2 w; w.x = cvt_pk_bf16(y[0], y[1]); w.y = cvt_pk_bf16(y[2], y[3]);
            *(u32x2*)(h + (size_t)row * 1024 + c) = w;
        }
    }
}

DI void scan_phase(const bf16_t* qkvr, const float* lr, const float* w2, const float* gb, bf16_t* of, bf16_t* ob, LAS unsigned char* lds) {
    constexpr int QD = 0, KI = 17408, KST = 34816, VT = 53248, ST = 71680, PP = 106496, LRS = 115712, SEG = 123904, BL = 128000;
    const int tid = tid_opq(), wave = __builtin_amdgcn_readfirstlane(tid >> 6), lane = tid & 63;
    const int l31 = lane & 31, lh = lane >> 5, l15 = lane & 15, lq = lane >> 4;
    for (int item = blockIdx.x; item < 256; item += gridDim.x) {
        const int b = item >> 4, dir = (item >> 3) & 1, h = (item >> 1) & 3, dvh = item & 1;
        bf16_t* obuf = dir ? ob : of;
        const int d0 = 2 * lane;
        float w2r[16][2];
#pragma unroll
        for (int r = 0; r < 16; ++r) { const f32x2 t = *(const f32x2*)(w2 + (size_t)(dir * 16 + r) * 512 + h * 128 + d0); w2r[r][0] = t.x; w2r[r][1] = t.y; }
        const f32x2 gbias = *(const f32x2*)(gb + dir * 512 + h * 128 + d0);
        f32x16 Sacc[2];
#pragma unroll
        for (int i = 0; i < 16; ++i) { Sacc[0][i] = 0.f; Sacc[1][i] = 0.f; }
        __syncthreads();
        for (int o = tid; o < 34816 / 16; o += NTHREADS) *(LAS u32x4*)(lds + ST + o * 16) = (u32x4){0u, 0u, 0u, 0u};
        unsigned qv[8], kv[8], vv[8]; f32x4 lrv = (f32x4){0.f, 0.f, 0.f, 0.f};
        const int qcol = h * 128 + d0, kcol = 512 + h * 128 + d0, vcol = 1024 + h * 256 + dvh * 128 + d0;
#define SCAN_ROWBASE(c, rb, sg) do { if (dir == 0) { sg = 1; rb = (c) < 4 ? TL + b * CTXL + (c) * 64 : b * SEQ + ((c) - 4) * 64; } \
                                     else { sg = -1; rb = (c) < 4 ? TL + b * CTXL + 255 - (c) * 64 : b * SEQ + 4095 - ((c) - 4) * 64; } } while (0)
#define SCAN_LOAD(c) do { int rb_, sg_; SCAN_ROWBASE(c, rb_, sg_); \
        _Pragma("unroll") for (int i = 0; i < 8; ++i) { const size_t ro = (size_t)(rb_ + sg_ * (wave * 8 + i)) * 3072; \
            qv[i] = *(const unsigned*)(qkvr + ro + qcol); kv[i] = *(const unsigned*)(qkvr + ro + kcol); vv[i] = *(const unsigned*)(qkvr + ro + vcol); } \
        if (tid < 256) lrv = *(const f32x4*)(lr + (size_t)(rb_ + sg_ * (tid >> 2)) * 32 + dir * 16 + (tid & 3) * 4); } while (0)
        SCAN_LOAD(0);
        if (tid < 256) *(LAS f32x4*)(lds + LRS + (tid >> 2) * 64 + (tid & 3) * 16) = lrv;
        __syncthreads();
        for (int c = 0; c < 68; ++c) {
            int rowbase, sgn; SCAN_ROWBASE(c, rowbase, sgn);
            const LAS float* lrs = (const LAS float*)(lds + LRS + (c & 1) * 4096);
            float bl0[8], bl1[8]; float cum0 = 0.f, cum1 = 0.f;
#pragma unroll
            for (int i = 0; i < 8; ++i) {
                const int s = wave * 8 + i;
                float z0 = gbias.x, z1 = gbias.y;
#pragma unroll
                for (int r4 = 0; r4 < 4; ++r4) { const f32x4 lv = *(const LAS f32x4*)(lrs + s * 16 + r4 * 4);
#pragma unroll
                    for (int j = 0; j < 4; ++j) { z0 += lv[j] * w2r[r4 * 4 + j][0]; z1 += lv[j] * w2r[r4 * 4 + j][1]; } }
                const float g0 = (fminf(z0, 0.f) - __logf(1.0f + __expf(-fabsf(z0)))) * 0.0625f;
                const float g1 = (fminf(z1, 0.f) - __logf(1.0f + __expf(-fabsf(z1)))) * 0.0625f;
                cum0 += g0; cum1 += g1; bl0[i] = cum0; bl1[i] = cum1;
            }
            *(LAS f32x2*)(lds + SEG + (wave * 128 + d0) * 4) = (f32x2){cum0, cum1};
            __syncthreads();
            float off0 = 0.f, off1 = 0.f, tot0 = 0.f, tot1 = 0.f;
#pragma unroll
            for (int w = 0; w < 8; ++w) { const f32x2 t = *(const LAS f32x2*)(lds + SEG + (w * 128 + d0) * 4); tot0 += t.x; tot1 += t.y; if (w < wave) { off0 += t.x; off1 += t.y; } }
            if (wave == 0) *(LAS f32x2*)(lds + BL + d0 * 4) = (f32x2){tot0, tot1};
            {
                unsigned ks0[4], ks1[4], vt0[4], vt1[4];
#pragma unroll
                for (int i = 0; i < 8; ++i) {
                    const int s = wave * 8 + i;
                    const float b0 = off0 + bl0[i], b1 = off1 + bl1[i];
                    const float q0 = bf_lo(qv[i]), q1 = bf_hi(qv[i]), k0 = bf_lo(kv[i]), k1 = bf_hi(kv[i]);
                    *(LAS unsigned*)(lds + QD + s * 272 + d0 * 2) = cvt_pk_bf16(q0 * __expf(b0), q1 * __expf(b1));
                    *(LAS unsigned*)(lds + KI + s * 272 + d0 * 2) = cvt_pk_bf16(k0 * __expf(-b0), k1 * __expf(-b1));
                    const float e0 = k0 * __expf(tot0 - b0), e1 = k1 * __expf(tot1 - b1);
                    if (i & 1) { ks0[i >> 1] = (ks0[i >> 1] & 0xffffu) | (cvt_pk_bf16(0.f, e0) & 0xffff0000u); ks1[i >> 1] = (ks1[i >> 1] & 0xffffu) | (cvt_pk_bf16(0.f, e1) & 0xffff0000u);
                                 vt0[i >> 1] = (vt0[i >> 1] & 0xffffu) | (vv[i] << 16); vt1[i >> 1] = (vt1[i >> 1] & 0xffffu) | (vv[i] & 0xffff0000u); }
                    else { ks0[i >> 1] = cvt_pk_bf16(e0, 0.f) & 0xffffu; ks1[i >> 1] = cvt_pk_bf16(e1, 0.f) & 0xffffu; vt0[i >> 1] = vv[i] & 0xffffu; vt1[i >> 1] = vv[i] >> 16; }
                }
                *(LAS u32x4*)(lds + KST + d0 * 144 + wave * 16) = (u32x4){ks0[0], ks0[1], ks0[2], ks0[3]};
                *(LAS u32x4*)(lds + KST + (d0 + 1) * 144 + wave * 16) = (u32x4){ks1[0], ks1[1], ks1[2], ks1[3]};
                *(LAS u32x4*)(lds + VT + d0 * 144 + wave * 16) = (u32x4){vt0[0], vt0[1], vt0[2], vt0[3]};
                *(LAS u32x4*)(lds + VT + (d0 + 1) * 144 + wave * 16) = (u32x4){vt1[0], vt1[1], vt1[2], vt1[3]};
            }
            __syncthreads();
            if (c + 1 < 68) SCAN_LOAD(c + 1);
            {
                const int t0 = 16 * (wave >> 1);
#pragma unroll
                for (int j = 0; j < 2; ++j) {
                    const int s0 = 16 * ((wave & 1) * 2 + j);
                    f32x4 a4 = (f32x4){0.f, 0.f, 0.f, 0.f};
#pragma unroll
                    for (int kk = 0; kk < 4; ++kk) {
                        const bf16x8 af = *(const LAS bf16x8*)(lds + QD + (t0 + l15) * 272 + (kk * 32 + 8 * lq) * 2);
                        const bf16x8 bf = *(const LAS bf16x8*)(lds + KI + (s0 + l15) * 272 + (kk * 32 + 8 * lq) * 2);
                        a4 = __builtin_amdgcn_mfma_f32_16x16x32_bf16(af, bf, a4, 0, 0, 0);
                    }
                    const int s = s0 + l15;
#pragma unroll
                    for (int r = 0; r < 4; ++r) { const int t = t0 + 4 * lq + r; *(LAS bf16_t*)(lds + PP + t * 144 + s * 2) = f2bf(s <= t ? a4[r] : 0.f); }
                }
            }
            __syncthreads();
            {
                const int tq = wave >> 2, vq = wave & 3;
                f32x16 oacc;
#pragma unroll
                for (int i = 0; i < 16; ++i) oacc[i] = 0.f;
#pragma unroll
                for (int kk = 0; kk < 8; ++kk) {
                    const bf16x8 af = *(const LAS bf16x8*)(lds + QD + (32 * tq + l31) * 272 + (kk * 16 + 8 * lh) * 2);
                    const bf16x8 bf = *(const LAS bf16x8*)(lds + ST + (32 * vq + l31) * 272 + (kk * 16 + 8 * lh) * 2);
                    oacc = __builtin_amdgcn_mfma_f32_32x32x16_bf16(af, bf, oacc, 0, 0, 0);
                }
#pragma unroll
                for (int kk = 0; kk < 4; ++kk) {
                    const bf16x8 af = *(const LAS bf16x8*)(lds + PP + (32 * tq + l31) * 144 + (kk * 16 + 8 * lh) * 2);
                    const bf16x8 bf = *(const LAS bf16x8*)(lds + VT + (32 * vq + l31) * 144 + (kk * 16 + 8 * lh) * 2);
                    oacc = __builtin_amdgcn_mfma_f32_32x32x16_bf16(af, bf, oacc, 0, 0, 0);
                }
                const int ocol = h * 256 + dvh * 128 + 32 * vq + l31;
#pragma unroll
                for (int r = 0; r < 16; ++r) { const int t = 32 * tq + crow(r, lh); obuf[(size_t)(rowbase + sgn * t) * 1024 + ocol] = f2bf(oacc[r]); }
            }
            {
                const int vq = wave & 3;
#pragma unroll
                for (int j = 0; j < 2; ++j) {
                    const int dq = 2 * (wave >> 2) + j;
#pragma unroll
                    for (int r = 0; r < 16; ++r) Sacc[j][r] *= __expf(*(const LAS float*)(lds + BL + (32 * dq + crow(r, lh)) * 4));
#pragma unroll
                    for (int kk = 0; kk < 4; ++kk) {
                        const bf16x8 af = *(const LAS bf16x8*)(lds + KST + (32 * dq + l31) * 144 + (kk * 16 + 8 * lh) * 2);
                        const bf16x8 bf = *(const LAS bf16x8*)(lds + VT + (32 * vq + l31) * 144 + (kk * 16 + 8 * lh) * 2);
                        Sacc[j] = __builtin_amdgcn_mfma_f32_32x32x16_bf16(af, bf, Sacc[j], 0, 0, 0);
                    }
                }
            }
            if (tid < 256) *(LAS f32x4*)(lds + LRS + ((c + 1) & 1) * 4096 + (tid >> 2) * 64 + (tid & 3) * 16) = lrv;
            __syncthreads();
            {
                const int vq = wave & 3;
#pragma unroll
                for (int j = 0; j < 2; ++j) {
                    const int dq = 2 * (wave >> 2) + j;
#pragma unroll
                    for (int g = 0; g < 4; ++g) {
                        u32x2 w; w.x = cvt_pk_bf16(Sacc[j][4 * g], Sacc[j][4 * g + 1]); w.y = cvt_pk_bf16(Sacc[j][4 * g + 2], Sacc[j][4 * g + 3]);
                        *(LAS u32x2*)(lds + ST + (32 * vq + l31) * 272 + (32 * dq + 8 * g + 4 * lh) * 2) = w;
                    }
                }
            }
        }
#undef SCAN_LOAD
#undef SCAN_ROWBASE
    }
    __syncthreads();
}

DI void glapost_phase(const bf16_t* of, const bf16_t* ob, const bf16_t* qkvr, const float* onorm, bf16_t* a) {
    const int tid = tid_opq(), wave = tid >> 6, lane = tid & 63;
    const int c0 = lane * 16;
    for (int row = blockIdx.x * 8 + wave; row < MR; row += gridDim.x * 8) {
        const u32x4 f0 = *(const u32x4*)(of + (size_t)row * 1024 + c0), f1 = *(const u32x4*)(of + (size_t)row * 1024 + c0 + 8);
        const u32x4 b0 = *(const u32x4*)(ob + (size_t)row * 1024 + c0), b1 = *(const u32x4*)(ob + (size_t)row * 1024 + c0 + 8);
        const u32x4 r0 = *(const u32x4*)(qkvr + (size_t)row * 3072 + 2048 + c0), r1 = *(const u32x4*)(qkvr + (size_t)row * 3072 + 2048 + c0 + 8);
        float o[16], rr[16];
#pragma unroll
        for (int j = 0; j < 4; ++j) {
            o[2 * j] = bf_lo(f0[j]) + bf_lo(b0[j]); o[2 * j + 1] = bf_hi(f0[j]) + bf_hi(b0[j]);
            o[8 + 2 * j] = bf_lo(f1[j]) + bf_lo(b1[j]); o[8 + 2 * j + 1] = bf_hi(f1[j]) + bf_hi(b1[j]);
            rr[2 * j] = bf_lo(r0[j]); rr[2 * j + 1] = bf_hi(r0[j]); rr[8 + 2 * j] = bf_lo(r1[j]); rr[8 + 2 * j + 1] = bf_hi(r1[j]);
        }
        float ss = 0.f;
#pragma unroll
        for (int j = 0; j < 16; ++j) ss += o[j] * o[j];
        ss += __shfl_xor(ss, 1); ss += __shfl_xor(ss, 2); ss += __shfl_xor(ss, 4); ss += __shfl_xor(ss, 8);
        const float rstd = rsqrtf(ss * (1.0f / 256.0f) + 1e-6f);
        const float* gn = onorm + (c0 & 255);
        unsigned w[8];
#pragma unroll
        for (int j = 0; j < 8; ++j) {
            const float y0 = o[2 * j] * rstd * gn[2 * j] * silu_f(rr[2 * j]), y1 = o[2 * j + 1] * rstd * gn[2 * j + 1] * silu_f(rr[2 * j + 1]);
            w[j] = cvt_pk_bf16(y0, y1);
        }
        *(u32x4*)(a + (size_t)row * 1024 + c0) = (u32x4){w[0], w[1], w[2], w[3]};
        *(u32x4*)(a + (size_t)row * 1024 + c0 + 8) = (u32x4){w[4], w[5], w[6], w[7]};
    }
}

DI void rope_cs(int tpos, int lane, float& cs, float& sn) {
    const int f = lane & 15; const int pos = (lane >> 5) ? (tpos & 63) : (tpos >> 6);
    const float inv = exp2f(-(float)f * (13.287712379549449f / 16.0f));
    const float ang = (float)pos * inv;
    const float kf = rintf(ang * 0.15915494309189535f);
    float r = fmaf(-kf, 6.2831854820251465f, ang); r = fmaf(-kf, -1.7484556000744883e-7f, r);
    cs = __cosf(r); sn = __sinf(r);
}
DI float rope_apply(float y, int lane, float cs, float sn) {
    const float pr = __shfl_xor(y, 16);
    return (lane & 16) ? (pr * sn + y * cs) : (y * cs - pr * sn);
}
DI int key_of_row(int row) {
    if (row < TL) { const int b = row >> 12; return b * KEYS + CTXL + (row & 4095); }
    const int rc = row - TL; const int b = rc >> 8; return b * KEYS + (rc & 255);
}

DI void mlamid_phase(const bf16_t* dn, const float* qln, const float* kvln, const float* knorm, bf16_t* cqn, bf16_t* ckvn, bf16_t* KB) {
    const int tid = tid_opq(), wave = tid >> 6, lane = tid & 63;
    for (int row = blockIdx.x * 8 + wave; row < MR; row += gridDim.x * 8) {
        const bf16_t* src = dn + (size_t)row * 768;
        unsigned q[3]; float ss = 0.f;
#pragma unroll
        for (int i = 0; i < 3; ++i) { q[i] = *(const unsigned*)(src + i * 128 + 2 * lane); const float a = bf_lo(q[i]), b = bf_hi(q[i]); ss += a * a + b * b; }
        ss = wave_sum(ss);
        float rstd = rsqrtf(ss * (1.0f / 384.0f) + 1e-6f);
#pragma unroll
        for (int i = 0; i < 3; ++i) { const int c = i * 128 + 2 * lane; *(unsigned*)(cqn + (size_t)row * 384 + c) = cvt_pk_bf16(bf_lo(q[i]) * rstd * qln[c], bf_hi(q[i]) * rstd * qln[c + 1]); }
        const u32x2 kvv = *(const u32x2*)(src + 384 + 4 * lane);
        const float k0 = bf_lo(kvv.x), k1 = bf_hi(kvv.x), k2 = bf_lo(kvv.y), k3 = bf_hi(kvv.y);
        ss = wave_sum(k0 * k0 + k1 * k1 + k2 * k2 + k3 * k3);
        rstd = rsqrtf(ss * (1.0f / 256.0f) + 1e-6f);
        { const f32x4 g = *(const f32x4*)(kvln + 4 * lane); u32x2 w; w.x = cvt_pk_bf16(k0 * rstd * g[0], k1 * rstd * g[1]); w.y = cvt_pk_bf16(k2 * rstd * g[2], k3 * rstd * g[3]);
          *(u32x2*)(ckvn + (size_t)row * 256 + 4 * lane) = w; }
        const float x = __uint_as_float(((unsigned)src[640 + lane]) << 16);
        ss = wave_sum(x * x);
        rstd = rsqrtf(ss * (1.0f / 64.0f) + 1e-6f);
        float y = x * rstd * knorm[128 + lane];
        if (row < TL) { float cs, sn; rope_cs(row & 4095, lane, cs, sn); y = rope_apply(y, lane, cs, sn); }
        const bf16_t yb = f2bf(y);
        bf16_t* kd = KB + (size_t)key_of_row(row) * 1536 + 128 + lane;
#pragma unroll
        for (int hh = 0; hh < 8; ++hh) kd[hh * 192] = yb;
    }
}

DI void qkprep_phase(bf16_t* Q, bf16_t* KB, const float* qnorm, const float* knorm) {
    const int tid = tid_opq(), wave = tid >> 6, lane = tid & 63;
    const float qn0 = qnorm[2 * lane], qn1 = qnorm[2 * lane + 1], qnr = qnorm[128 + lane];
    const float kn0 = knorm[2 * lane], kn1 = knorm[2 * lane + 1];
    for (int row = blockIdx.x * 8 + wave; row < MR; row += gridDim.x * 8) {
        float cs = 1.f, sn = 0.f;
        const bool lat = row < TL;
        if (lat) rope_cs(row & 4095, lane, cs, sn);
        bf16_t* qr = Q + (size_t)row * 1536;
        bf16_t* kr = KB + (size_t)key_of_row(row) * 1536;
#pragma unroll
        for (int hh = 0; hh < 8; ++hh) {
            const unsigned qa = *(const unsigned*)(qr + hh * 192 + 2 * lane);
            const float xr = __uint_as_float(((unsigned)qr[hh * 192 + 128 + lane]) << 16);
            const unsigned ka = *(const unsigned*)(kr + hh * 192 + 2 * lane);
            const float a0 = bf_lo(qa), a1 = bf_hi(qa), c0 = bf_lo(ka), c1 = bf_hi(ka);
            const float s1 = wave_sum(a0 * a0 + a1 * a1), s2 = wave_sum(xr * xr), s3 = wave_sum(c0 * c0 + c1 * c1);
            const float r1 = rsqrtf(s1 * (1.0f / 128.0f) + 1e-6f), r2 = rsqrtf(s2 * (1.0f / 64.0f) + 1e-6f), r3 = rsqrtf(s3 * (1.0f / 128.0f) + 1e-6f);
            *(unsigned*)(qr + hh * 192 + 2 * lane) = cvt_pk_bf16(a0 * r1 * qn0, a1 * r1 * qn1);
            float y = xr * r2 * qnr;
            if (lat) y = rope_apply(y, lane, cs, sn);
            qr[hh * 192 + 128 + lane] = f2bf(y);
            *(unsigned*)(kr + hh * 192 + 2 * lane) = cvt_pk_bf16(c0 * r3 * kn0, c1 * r3 * kn1);
        }
    }
}

namespace att {
constexpr int DQK = 192, DV = 128, NW = 8, QBLK = 32, KVBLK = 64;
constexpr int LDQ = 1536, LDK = 1536, LDV = 1024, LDO = 1024;
constexpr float SCALE = 0.07216878364870322f;
constexpr float THR = 8.f;
constexpr size_t SHM_V = KVBLK * DV * 2, SHM_K = KVBLK * DQK * 2;
#define KSWZ(row, colB) ((row) * 384 + ((colB) ^ ((((row) >> 1) & 7) << 4)))
#define SBAR() __builtin_amdgcn_sched_barrier(0)
DI unsigned cvtpk(float lo, float hi) { unsigned r; asm volatile("v_cvt_pk_bf16_f32 %0, %1, %2" : "=v"(r) : "v"(lo), "v"(hi)); return r; }
DI void partialSM(f32x16& p0, f32x16& p1, float& m_reg, float& mn, float& alpha) {
    constexpr float C = SCALE * 1.4426950408889634f;
    float pmax = p0[0];
#pragma unroll
    for (int r = 1; r < 16; ++r) pmax = fmaxf(pmax, p0[r]);
#pragma unroll
    for (int r = 0; r < 16; ++r) pmax = fmaxf(pmax, p1[r]);
    { auto rr = __builtin_amdgcn_permlane32_swap(__float_as_uint(pmax), __float_as_uint(pmax), false, false);
      pmax = fmaxf(__uint_as_float(rr[0]), __uint_as_float(rr[1])); }
    if (__builtin_expect(__all(pmax - m_reg <= THR / SCALE), 1)) { mn = m_reg; alpha = 1.f; }
    else { mn = fmaxf(m_reg, pmax); alpha = __builtin_amdgcn_exp2f((m_reg - mn) * C); m_reg = mn; }
    const float mnC = -mn * C;
#pragma unroll
    for (int r = 0; r < 16; ++r) p0[r] = fmaf(p0[r], C, mnC);
#pragma unroll
    for (int r = 0; r < 16; ++r) p1[r] = fmaf(p1[r], C, mnC);
#pragma unroll
    for (int r = 0; r < 16; ++r) p0[r] = __builtin_amdgcn_exp2f(p0[r]);
}
DI void finishSM(f32x16& p0, f32x16& p1, float alpha, float& l_reg, bf16x8& pa0, bf16x8& pa1, bf16x8& pa2, bf16x8& pa3) {
#pragma unroll
    for (int r = 0; r < 16; ++r) p1[r] = __builtin_amdgcn_exp2f(p1[r]);
    float ps = 0;
#pragma unroll
    for (int r = 0; r < 16; ++r) ps += p0[r];
#pragma unroll
    for (int r = 0; r < 16; ++r) ps += p1[r];
    { auto rr = __builtin_amdgcn_permlane32_swap(__float_as_uint(ps), __float_as_uint(ps), false, false);
      ps = __uint_as_float(rr[0]) + __uint_as_float(rr[1]); }
    l_reg = l_reg * alpha + ps;
#define PK4(P, BASE, OUT) do { unsigned a0 = cvtpk(P[BASE + 0], P[BASE + 1]), a1 = cvtpk(P[BASE + 2], P[BASE + 3]);   \
    unsigned b0 = cvtpk(P[BASE + 4], P[BASE + 5]), b1 = cvtpk(P[BASE + 6], P[BASE + 7]);                              \
    auto r0 = __builtin_amdgcn_permlane32_swap(a0, b0, false, false); auto r1 = __builtin_amdgcn_permlane32_swap(a1, b1, false, false); \
    u32x4 w = {r0[0], r1[0], r0[1], r1[1]}; OUT = *reinterpret_cast<bf16x8*>(&w); } while (0)
    PK4(p0, 0, pa0); PK4(p0, 8, pa1); PK4(p1, 0, pa2); PK4(p1, 8, pa3);
#undef PK4
}
DI void qkt(f32x16& p0, f32x16& p1, const char* Ks, const bf16x8* qr, int r32, int hi) {
#pragma unroll
    for (int r = 0; r < 16; ++r) { p0[r] = 0.f; p1[r] = 0.f; }
#pragma unroll
    for (int d0 = 0; d0 < 12; ++d0) { const int cb = (d0 * 16 + hi * 8) * 2;
        const bf16x8 b0 = *reinterpret_cast<const bf16x8*>(Ks + KSWZ(r32, cb));
        const bf16x8 b1 = *reinterpret_cast<const bf16x8*>(Ks + KSWZ(32 + r32, cb));
        p0 = __builtin_amdgcn_mfma_f32_32x32x16_bf16(b0, qr[d0], p0, 0, 0, 0);
        p1 = __builtin_amdgcn_mfma_f32_32x32x16_bf16(b1, qr[d0], p1, 0, 0, 0); }
}
DI int v_st(int k, int c) { const int kk = (k & ~0xC) | ((k & 4) << 1) | ((k & 8) >> 1); return ((kk >> 3) * 4 + (c >> 5)) * 512 + ((kk & 7) * 32 + (c & 31)) * 2; }
DI int v_rd_base(int lane) { return ((lane & 3) << 3) | (((lane >> 2) & 3) << 6) | (((lane >> 4) & 1) << 5) | (((lane >> 5) & 1) << 8); }
constexpr int v_rd_off(int d0, int ks, int half) { return d0 * 512 + ks * 4096 + half * 2048; }
template <int OFF> DI s16x4 tr_read(int vb) { s16x4 r; asm volatile("ds_read_b64_tr_b16 %0, %1 offset:%2" : "=&v"(r) : "v"(vb), "i"(OFF) : "memory"); return r; }
template <int D0> DI void pv_one(f32x16& od, int vb, bf16x8 pa0, bf16x8 pa1, bf16x8 pa2, bf16x8 pa3) {
    const s16x4 l0 = tr_read<v_rd_off(D0, 0, 0)>(vb), h0 = tr_read<v_rd_off(D0, 0, 1)>(vb), l1 = tr_read<v_rd_off(D0, 1, 0)>(vb), h1 = tr_read<v_rd_off(D0, 1, 1)>(vb);
    const s16x4 l2 = tr_read<v_rd_off(D0, 2, 0)>(vb), h2 = tr_read<v_rd_off(D0, 2, 1)>(vb), l3 = tr_read<v_rd_off(D0, 3, 0)>(vb), h3 = tr_read<v_rd_off(D0, 3, 1)>(vb);
    asm volatile("s_waitcnt lgkmcnt(0)" ::: "memory"); SBAR();
#define PK(L, H) (bf16x8){L[0], L[1], L[2], L[3], H[0], H[1], H[2], H[3]}
    od = __builtin_amdgcn_mfma_f32_32x32x16_bf16(pa0, PK(l0, h0), od, 0, 0, 0);
    od = __builtin_amdgcn_mfma_f32_32x32x16_bf16(pa1, PK(l1, h1), od, 0, 0, 0);
    od = __builtin_amdgcn_mfma_f32_32x32x16_bf16(pa2, PK(l2, h2), od, 0, 0, 0);
    od = __builtin_amdgcn_mfma_f32_32x32x16_bf16(pa3, PK(l3, h3), od, 0, 0, 0);
#undef PK
}
DI void pv_d0(f32x16* o, int vb, bf16x8 pa0, bf16x8 pa1, bf16x8 pa2, bf16x8 pa3) {
    pv_one<0>(o[0], vb, pa0, pa1, pa2, pa3); pv_one<1>(o[1], vb, pa0, pa1, pa2, pa3); pv_one<2>(o[2], vb, pa0, pa1, pa2, pa3); pv_one<3>(o[3], vb, pa0, pa1, pa2, pa3);
}
DI void attn_body(const bf16_t* __restrict__ Qb, const bf16_t* __restrict__ Kh, const bf16_t* __restrict__ Vh, bf16_t* __restrict__ Ob, int seq, char* lds) {
    const int tid = tid_opq(), wid = tid >> 6, lane = tid & 63, r32 = lane & 31, hi = lane >> 5;
    char* V_lds = lds; char* K_lds = lds + 2 * SHM_V;
    float* wsf = (float*)(lds + 2 * SHM_V + 2 * SHM_K) + wid * 64; float* li_l = wsf; float* al_l = wsf + 32;
    float m_reg = -1e30f, l_reg = 0; f32x16 o[4]; bf16x8 qr[12];
#pragma unroll
    for (int d = 0; d < 4; ++d)
#pragma unroll
        for (int r = 0; r < 16; ++r) o[d][r] = 0.f;
    const bf16_t* Qw = Qb + (long)(wid * QBLK + r32) * LDQ + hi * 8;
#pragma unroll
    for (int d0 = 0; d0 < 12; ++d0) qr[d0] = *reinterpret_cast<const bf16x8*>(Qw + d0 * 16);
    const int sr = tid >> 4, sc = (tid & 15) * 8, vst0 = v_st(sr, sc), vst1 = v_st(32 + sr, sc);
    const int pr = tid >> 3, pc = 128 + (tid & 7) * 8;
    const int vb0 = (int)(uintptr_t)V_lds + v_rd_base(lane);
    bf16x8 vs0, vs1, ks0, ks1, kp;
#define SLOAD(k0) do { vs0 = *reinterpret_cast<const bf16x8*>(&Vh[(long)((k0) + sr) * LDV + sc]); vs1 = *reinterpret_cast<const bf16x8*>(&Vh[(long)((k0) + 32 + sr) * LDV + sc]); \
    ks0 = *reinterpret_cast<const bf16x8*>(&Kh[(long)((k0) + sr) * LDK + sc]); ks1 = *reinterpret_cast<const bf16x8*>(&Kh[(long)((k0) + 32 + sr) * LDK + sc]); \
    kp = *reinterpret_cast<const bf16x8*>(&Kh[(long)((k0) + pr) * LDK + pc]); } while (0)
#define SWRITE(b) do { *(bf16x8*)(V_lds + (b) * SHM_V + vst0) = vs0; *(bf16x8*)(V_lds + (b) * SHM_V + vst1) = vs1; \
    *(bf16x8*)(K_lds + (b) * SHM_K + KSWZ(sr, sc * 2)) = ks0; *(bf16x8*)(K_lds + (b) * SHM_K + KSWZ(32 + sr, sc * 2)) = ks1; \
    *(bf16x8*)(K_lds + (b) * SHM_K + KSWZ(pr, pc * 2)) = kp; } while (0)
#define RESC(a) do { if (__any((a) < 1.f)) { if (hi == 0) al_l[r32] = (a); asm volatile("s_waitcnt lgkmcnt(0)" ::: "memory"); \
    _Pragma("unroll") for (int d = 0; d < 4; ++d) _Pragma("unroll") for (int r = 0; r < 16; ++r) o[d][r] *= al_l[crow(r, hi)]; } } while (0)
    f32x16 p0, p1; float mn, al; bf16x8 pa0, pa1, pa2, pa3; const int NT = seq / KVBLK;
    SLOAD(0); asm volatile("s_waitcnt vmcnt(0)" ::: "memory"); SWRITE(0); __syncthreads();
    for (int j = 0; j < NT; ++j) {
        const int cb = j & 1;
        if (j + 1 < NT) SLOAD((j + 1) * KVBLK);
        SBAR(); qkt(p0, p1, K_lds + cb * SHM_K, qr, r32, hi);
        partialSM(p0, p1, m_reg, mn, al);
        finishSM(p0, p1, al, l_reg, pa0, pa1, pa2, pa3);
        RESC(al); SBAR();
        pv_d0(o, vb0 + cb * (int)SHM_V, pa0, pa1, pa2, pa3);
        if (j + 1 < NT) { asm volatile("s_waitcnt vmcnt(0)" ::: "memory"); SWRITE(cb ^ 1); }
        __syncthreads();
    }
    if (hi == 0) li_l[r32] = l_reg; asm volatile("s_waitcnt lgkmcnt(0)" ::: "memory");
    float rli[16];
#pragma unroll
    for (int r = 0; r < 16; ++r) rli[r] = __builtin_amdgcn_rcpf(li_l[crow(r, hi)]);
    bf16_t* Ow = Ob + (long)(wid * QBLK) * LDO;
#pragma unroll
    for (int r = 0; r < 16; ++r) { const int orow = crow(r, hi);
#pragma unroll
        for (int d0 = 0; d0 < 4; ++d0) Ow[(long)orow * LDO + d0 * 32 + r32] = f2bf(o[d0][r] * rli[r]); }
#undef SLOAD
#undef SWRITE
#undef RESC
}
#undef KSWZ
#undef SBAR
}

DI void attn_phase(const bf16_t* Q, const bf16_t* KB, const bf16_t* VB, bf16_t* O, char* lds) {
    for (int it = blockIdx.x; it < 2048 + 128; it += gridDim.x) {
        int b, h, qrow0, seq;
        if (it < 2048) { b = it >> 7; h = (it >> 4) & 7; qrow0 = b * SEQ + (it & 15) * 256; seq = KEYS; }
        else { const int j = it - 2048; b = j >> 3; h = j & 7; qrow0 = TL + b * CTXL; seq = CTXL; }
        att::attn_body(Q + (size_t)qrow0 * 1536 + h * 192, KB + (size_t)b * KEYS * 1536 + h * 192, VB + (size_t)b * KEYS * 1024 + h * 128,
                       O + (size_t)qrow0 * 1024 + h * 128, seq, lds);
        __syncthreads();
    }
}

DI void conv_phase(const bf16_t* u, const float* cw, const float* cb, int hf, bf16_t* act) {
    const int gtid = blockIdx.x * NTHREADS + tid_opq(), gstride = gridDim.x * NTHREADS;
    constexpr int NCG = DFFH / 8, NRG = MR / 16;
    for (int unit = gtid; unit < NCG * NRG; unit += gstride) {
        const int cgi = unit % NCG, rg = unit / NCG;
        const int j0 = cgi * 8, acol = (j0 >> 7) * 256 + (j0 & 127), gcol = acol + 128;
        const int ca = hf * DFFH + j0, cg_ = DFF + ca;
        const int r0 = rg * 16;
        int s0, L;
        if (r0 < TL) { s0 = r0 & ~4095; L = SEQ; } else { s0 = TL + ((r0 - TL) & ~255); L = CTXL; }
        float wa[3][8], wg[3][8], ba[8], bg[8];
#pragma unroll
        for (int t = 0; t < 3; ++t) {
            const f32x4 a0 = *(const f32x4*)(cw + (size_t)t * 2 * DFF + ca), a1 = *(const f32x4*)(cw + (size_t)t * 2 * DFF + ca + 4);
            const f32x4 g0 = *(const f32x4*)(cw + (size_t)t * 2 * DFF + cg_), g1 = *(const f32x4*)(cw + (size_t)t * 2 * DFF + cg_ + 4);
#pragma unroll
            for (int j = 0; j < 4; ++j) { wa[t][j] = a0[j]; wa[t][4 + j] = a1[j]; wg[t][j] = g0[j]; wg[t][4 + j] = g1[j]; }
        }
        { const f32x4 a0 = *(const f32x4*)(cb + ca), a1 = *(const f32x4*)(cb + ca + 4), g0 = *(const f32x4*)(cb + cg_), g1 = *(const f32x4*)(cb + cg_ + 4);
#pragma unroll
          for (int j = 0; j < 4; ++j) { ba[j] = a0[j]; ba[4 + j] = a1[j]; bg[j] = g0[j]; bg[4 + j] = g1[j]; } }
        const u32x4 zero4 = (u32x4){0u, 0u, 0u, 0u};
        u32x4 pa = zero4, pg = zero4, ca4, cg4, na, ng;
        if (r0 > s0) { pa = *(const u32x4*)(u + (size_t)(r0 - 1) * 2816 + acol); pg = *(const u32x4*)(u + (size_t)(r0 - 1) * 2816 + gcol); }
        ca4 = *(const u32x4*)(u + (size_t)r0 * 2816 + acol); cg4 = *(const u32x4*)(u + (size_t)r0 * 2816 + gcol);
#pragma unroll 4
        for (int i = 0; i < 16; ++i) {
            const int row = r0 + i;
            if (row + 1 < s0 + L) { na = *(const u32x4*)(u + (size_t)(row + 1) * 2816 + acol); ng = *(const u32x4*)(u + (size_t)(row + 1) * 2816 + gcol); }
            else { na = zero4; ng = zero4; }
            unsigned w[4];
#pragma unroll
            for (int j = 0; j < 4; ++j) {
                const float av0 = bf_lo(pa[j]) * wa[0][2 * j] + bf_lo(ca4[j]) * wa[1][2 * j] + bf_lo(na[j]) * wa[2][2 * j] + ba[2 * j];
                const float av1 = bf_hi(pa[j]) * wa[0][2 * j + 1] + bf_hi(ca4[j]) * wa[1][2 * j + 1] + bf_hi(na[j]) * wa[2][2 * j + 1] + ba[2 * j + 1];
                const float gv0 = bf_lo(pg[j]) * wg[0][2 * j] + bf_lo(cg4[j]) * wg[1][2 * j] + bf_lo(ng[j]) * wg[2][2 * j] + bg[2 * j];
                const float gv1 = bf_hi(pg[j]) * wg[0][2 * j + 1] + bf_hi(cg4[j]) * wg[1][2 * j + 1] + bf_hi(ng[j]) * wg[2][2 * j + 1] + bg[2 * j + 1];
                w[j] = cvt_pk_bf16(silu_f(gv0) * av0, silu_f(gv1) * av1);
            }
            *(u32x4*)(act + (size_t)row * 1408 + j0) = (u32x4){w[0], w[1], w[2], w[3]};
            pa = ca4; pg = cg4; ca4 = na; cg4 = ng;
        }
    }
}

__global__ void __launch_bounds__(NTHREADS) mega(Params p) {
    extern __shared__ __attribute__((aligned(16))) unsigned char smem[];
    LAS unsigned char* lds = (LAS unsigned char*)smem;
    cg::grid_group grid = cg::this_grid();
    unsigned char* ws = p.ws;
    float* mod = (float*)(ws + WS_MOD);
    float* xc = (float*)(ws + WS_XC);
    bf16_t* hbuf = (bf16_t*)(ws + WS_H);

    for (int ph = p.ph_lo; ph < p.ph_hi; ++ph) {
        if (ph == 0) {
            prep_phase(p, lds);
        } else {
            const int q = ph - 1, lp = q / 26; int r = q % 26; int layer, nmix;
            if (r < 12) { layer = 2 * lp; nmix = 5; } else { layer = 2 * lp + 1; r -= 12; nmix = 7; }
            const bool is_mla = layer & 1; const int j = layer >> 1;
            const float* modl = mod + (size_t)layer * 17 * 6144;
            const bool first = (layer == 0);
            int op = -1, gsel = 0, hf = 0;
            if (r < nmix) {
                if (!is_mla) { const int ops[5] = {0, 2, 3, 4, 2}; op = r == 0 ? 0 : r == 1 ? 2 : r == 2 ? 3 : r == 3 ? 4 : 2; (void)ops; gsel = r == 1 ? 0 : 1; }
                else { op = r == 0 ? 0 : r == 1 ? 2 : r == 2 ? 5 : r == 3 ? 2 : r == 4 ? 6 : r == 5 ? 7 : 2; gsel = r == 1 ? 2 : r == 3 ? 3 : 5; }
            } else {
                const int f = r - nmix;
                if (f == 0) op = 1; else { hf = (f - 1) / 3; const int s = (f - 1) % 3; op = s == 1 ? 8 : 2; gsel = s == 0 ? 6 : 7; }
            }
            if (op == 0) {
                norm_phase(first ? p.in[opq(0)] : p.out, first ? p.in[opq(2)] : xc, p.in[opq(6)] + layer * 1024, modl, 0, 1024, hbuf);
            } else if (op == 1) {
                norm_phase(p.out, xc, p.in[opq(7)] + layer * 1024, modl, 3 * 1024, 4 * 1024, hbuf);
            } else if (op == 2) {
                const int ng = (gsel == 3) ? 2 : 1;
                for (int gi = 0; gi < ng; ++gi) {
                    pg8::Gemm g; Epi E; bool perm = true;
                    E.kind = EPI_BF16; E.O = nullptr; E.ldc = 0; E.lr = nullptr; E.base_l = nullptr; E.base_c = nullptr; E.out_l = nullptr; E.out_c = nullptr; E.gate = nullptr; E.KB = nullptr; E.VB = nullptr;
                    g.M = MR;
                    const int gs = gsel + gi;
                    if (gs == 0) { g.A = hbuf; g.Bt = (const bf16_t*)(ws + WS_GIN + j * SZ_GIN); g.N = 3328; g.K = 1024; g.lda = 1024; g.ldb = 1024;
                        E.kind = EPI_GLA_IN; E.O = (bf16_t*)(ws + WS_QKVR); E.ldc = 3072; E.lr = (float*)(ws + WS_LR); }
                    else if (gs == 1 || gs == 5) { g.A = hbuf; g.Bt = (const bf16_t*)(ws + (gs == 1 ? WS_GOUT : WS_MOUT) + j * SZ_SQ); g.N = 1024; g.K = 1024; g.lda = 1024; g.ldb = 1024; perm = false;
                        E.kind = EPI_RESID; E.base_l = first ? p.in[opq(0)] : p.out; E.base_c = first ? p.in[opq(2)] : xc; E.out_l = p.out; E.out_c = xc; E.gate = modl + 2 * 1024; }
                    else if (gs == 2) { g.A = hbuf; g.Bt = (const bf16_t*)(ws + WS_MDOWN + j * SZ_MDOWN); g.N = 768; g.K = 1024; g.lda = 1024; g.ldb = 1024;
                        E.O = (bf16_t*)(ws + WS_DN); E.ldc = 768; }
                    else if (gs == 3) { g.A = (const bf16_t*)(ws + WS_CQN); g.Bt = (const bf16_t*)(ws + WS_MUQ + j * SZ_MUQ); g.N = 1536; g.K = 384; g.lda = 384; g.ldb = 384;
                        E.O = (bf16_t*)(ws + WS_QRAW); E.ldc = 1536; }
                    else if (gs == 4) { g.A = (const bf16_t*)(ws + WS_CKVN); g.Bt = (const bf16_t*)(ws + WS_MUKV + j * SZ_MUKV); g.N = 2048; g.K = 256; g.lda = 256; g.ldb = 256;
                        E.kind = EPI_UKV; E.KB = (bf16_t*)(ws + WS_KB); E.VB = (bf16_t*)(ws + WS_VB); }
                    else if (gs == 6) { g.A = hbuf; g.Bt = (const bf16_t*)(ws + WS_FUP + (size_t)(layer * 2 + hf) * SZ_FUP); g.N = 2816; g.K = 1024; g.lda = 1024; g.ldb = 1024;
                        E.O = (bf16_t*)(ws + WS_U); E.ldc = 2816; }
                    else { g.A = (const bf16_t*)(ws + WS_ACT); g.Bt = (const bf16_t*)(ws + WS_FDOWN + (size_t)(layer * 2 + hf) * SZ_FDOWN); g.N = 1024; g.K = 1408; g.lda = 1408; g.ldb = 1408; perm = false;
                        E.kind = EPI_RESID; E.base_l = p.out; E.base_c = xc; E.out_l = p.out; E.out_c = xc; E.gate = modl + 5 * 1024; }
                    pg8::StaticOrder S; S.init(g.M, g.N, (int)gridDim.x, (int)blockIdx.x);
                    pg8::gemm_phase<Epi>(lds, g, S, E, perm);
                    __syncthreads();
                }
            } else if (op == 3) {
                scan_phase((const bf16_t*)(ws + WS_QKVR), (const float*)(ws + WS_LR), p.in[opq(10)] + (size_t)j * 2 * 16 * 512, p.in[opq(11)] + (size_t)j * 2 * 512,
                           (bf16_t*)(ws + WS_OF), (bf16_t*)(ws + WS_OB), lds);
            } else if (op == 4) {
                glapost_phase((const bf16_t*)(ws + WS_OF), (const bf16_t*)(ws + WS_OB), (const bf16_t*)(ws + WS_QKVR), p.in[opq(12)] + j * 256, hbuf);
            } else if (op == 5) {
                mlamid_phase((const bf16_t*)(ws + WS_DN), p.in[opq(15)] + j * 384, p.in[opq(16)] + j * 256, p.in[opq(20)] + j * 192, (bf16_t*)(ws + WS_CQN), (bf16_t*)(ws + WS_CKVN), (bf16_t*)(ws + WS_KB));
            } else if (op == 6) {
                qkprep_phase((bf16_t*)(ws + WS_QRAW), (bf16_t*)(ws + WS_KB), p.in[opq(19)] + j * 192, p.in[opq(20)] + j * 192);
            } else if (op == 7) {
                attn_phase((const bf16_t*)(ws + WS_QRAW), (const bf16_t*)(ws + WS_KB), (const bf16_t*)(ws + WS_VB), hbuf, (char*)smem);
            } else if (op == 8) {
                conv_phase((const bf16_t*)(ws + WS_U), p.in[opq(23)] + (size_t)layer * 3 * 2 * DFF, p.in[opq(24)] + (size_t)layer * 2 * DFF, hf, (bf16_t*)(ws + WS_ACT));
            }
        }
        if (ph + 1 < p.ph_hi) grid.sync();
    }
}

extern "C" void kernel_launch(void* const* d_in, const int* in_sizes, int n_in, void* d_out, int out_size, void* d_ws, size_t ws_size, hipStream_t stream) {
    static int grid = 0;
    if (grid == 0) {
        if (n_in != 26 || ws_size < WS_END) { fprintf(stderr, "kernel_launch: n_in %d ws %zu (need %zu)\n", n_in, ws_size, (size_t)WS_END); grid = -1; return; }
        int dev = 0, cus = 0, per_cu = 0;
        hipGetDevice(&dev);
        hipDeviceGetAttribute(&cus, hipDeviceAttributeMultiprocessorCount, dev);
        if (hipFuncSetAttribute((const void*)mega, hipFuncAttributeMaxDynamicSharedMemorySize, LDS_BYTES) != hipSuccess) { fprintf(stderr, "kernel_launch: hipFuncSetAttribute failed\n"); grid = -1; return; }
        if (hipOccupancyMaxActiveBlocksPerMultiprocessor(&per_cu, (const void*)mega, NTHREADS, LDS_BYTES) != hipSuccess || per_cu < 1) { fprintf(stderr, "kernel_launch: occupancy query %d\n", per_cu); per_cu = 1; }
        (void)hipGetLastError();
        grid = cus * per_cu;
        fprintf(stderr, "kernel_launch: grid %d (cus %d x %d)\n", grid, cus, per_cu);
    }
    if (grid < 0) return;
    Params p{};
    for (int i = 0; i < 26; ++i) p.in[i] = (const float*)d_in[i];
    p.out = (float*)d_out; p.ws = (unsigned char*)d_ws;
#if MK_MULTI
    for (int ph = 0; ph < NPH; ++ph) {
        p.ph_lo = ph; p.ph_hi = ph + 1;
        hipLaunchKernelGGL(mega, dim3(grid), dim3(NTHREADS), LDS_BYTES, stream, p);
    }
#else
    p.ph_lo = 0; p.ph_hi = NPH;
    void* args[] = {&p};
    hipError_t e = hipLaunchCooperativeKernel((const void*)mega, dim3(grid), dim3(NTHREADS), args, LDS_BYTES, stream);
    if (e != hipSuccess) fprintf(stderr, "cooperative launch failed: %s (grid %d)\n", hipGetErrorString(e), grid);
#endif
}
```

```cpp
#include <hip/hip_runtime.h>
#include <hip/hip_cooperative_groups.h>
#include <cstdio>
#include <cstdint>
namespace cg = cooperative_groups;

#ifndef MK_MULTI
#define MK_MULTI 0
#endif

#define LAS __attribute__((address_space(3)))
#define DI __device__ __forceinline__
typedef unsigned short bf16_t;
typedef short bf16x8 __attribute__((ext_vector_type(8)));
typedef short s16x4 __attribute__((ext_vector_type(4)));
typedef float f32x2 __attribute__((ext_vector_type(2)));
typedef float f32x4 __attribute__((ext_vector_type(4)));
typedef float f32x16 __attribute__((ext_vector_type(16)));
typedef unsigned u32x2 __attribute__((ext_vector_type(2)));
typedef unsigned u32x4 __attribute__((ext_vector_type(4)));

constexpr int DM = 1024, NB = 16, SEQ = 4096, CTXL = 256;
constexpr int TL = NB * SEQ, TC = NB * CTXL, MR = TL + TC;
constexpr int KEYS = CTXL + SEQ;
constexpr int DFF = 2816, DFFH = 1408;
constexpr int NTHREADS = 512;
constexpr int LDS_BYTES = 131072 + 12288;
constexpr int XCH_OFF = 131072;
constexpr int NPH = 41;

constexpr size_t SZ_GIN = 3328ull * 1024 * 2, SZ_SQ = 1024ull * 1024 * 2, SZ_MDOWN = 768ull * 1024 * 2, SZ_MUQ = 1536ull * 384 * 2,
                 SZ_MUKV = 2048ull * 256 * 2, SZ_FUP = 5632ull * 1024 * 2, SZ_FDOWN = 1024ull * 2816 * 2;
constexpr size_t WS_GIN = 0;
constexpr size_t WS_GOUT = WS_GIN + 2 * SZ_GIN;
constexpr size_t WS_MDOWN = WS_GOUT + 2 * SZ_SQ;
constexpr size_t WS_MUQ = WS_MDOWN + 2 * SZ_MDOWN;
constexpr size_t WS_MUKV = WS_MUQ + 2 * SZ_MUQ;
constexpr size_t WS_MOUT = WS_MUKV + 2 * SZ_MUKV;
constexpr size_t WS_FUP = WS_MOUT + 2 * SZ_SQ;
constexpr size_t WS_FDOWN = WS_FUP + 4 * SZ_FUP;
constexpr size_t WS_MOD = WS_FDOWN + 4 * SZ_FDOWN;
constexpr size_t SZ_MOD = 4ull * 17 * 6144 * 4;
constexpr size_t WS_XC = WS_MOD + ((SZ_MOD + 255) / 256) * 256;
constexpr size_t WS_H = WS_XC + (size_t)TC * 1024 * 4;
constexpr size_t WS_R = WS_H + (size_t)MR * 1024 * 2;
constexpr size_t WS_QKVR = WS_R;
constexpr size_t WS_LR = WS_QKVR + (size_t)MR * 3072 * 2;
constexpr size_t WS_OF = WS_LR + (size_t)MR * 32 * 4;
constexpr size_t WS_OB = WS_OF + (size_t)MR * 1024 * 2;
constexpr size_t WS_GLA_END = WS_OB + (size_t)MR * 1024 * 2;
constexpr size_t WS_QRAW = WS_R;
constexpr size_t WS_DN = WS_R;
constexpr size_t WS_CQN = WS_QRAW + (size_t)MR * 1536 * 2;
constexpr size_t WS_CKVN = WS_CQN + (size_t)MR * 384 * 2;
constexpr size_t WS_KB = WS_CKVN + (size_t)MR * 256 * 2;
constexpr size_t WS_VB = WS_KB + (size_t)NB * KEYS * 1536 * 2;
constexpr size_t WS_MLA_END = WS_VB + (size_t)NB * KEYS * 1024 * 2;
constexpr size_t WS_ACT = WS_R;
constexpr size_t WS_HALO = WS_ACT + (size_t)MR * 2816 * 2;
constexpr size_t WS_FFN_END = WS_HALO + 272ull * 22 * 4 * 256 * 4;
constexpr size_t WS_END = WS_GLA_END > WS_MLA_END ? (WS_GLA_END > WS_FFN_END ? WS_GLA_END : WS_FFN_END) : (WS_MLA_END > WS_FFN_END ? WS_MLA_END : WS_FFN_END);
static_assert(WS_END <= (1ull << 30), "workspace over 1 GiB");

struct Params { const float* in[28]; int ph_lo, ph_hi; };

DI unsigned cvt_pk_bf16(float lo, float hi) { unsigned r; asm("v_cvt_pk_bf16_f32 %0, %1, %2" : "=v"(r) : "v"(lo), "v"(hi)); return r; }
DI float bf_lo(unsigned u) { return __uint_as_float(u << 16); }
DI float bf_hi(unsigned u) { return __uint_as_float(u & 0xffff0000u); }
DI bf16_t f2bf(float f) { return (bf16_t)(cvt_pk_bf16(f, 0.f) & 0xffffu); }
DI float wave_sum(float v) {
#pragma unroll
    for (int o = 32; o >= 1; o >>= 1) v += __shfl_xor(v, o);
    return v;
}
DI float silu_f(float v) { return v * __builtin_amdgcn_rcpf(1.0f + __expf(-v)); }
DI int crow(int r, int hi) { return (r & 3) + 8 * (r >> 2) + 4 * hi; }
DI int tid_opq() { int t = threadIdx.x; asm volatile("" : "+v"(t)); return t; }
DI int opq(int i) { asm volatile("" : "+s"(i)); return i; }

namespace pg8 {
constexpr int BM = 256, BK = 64, HALF = 128, HTB = HALF * BK * 2, STAGE_BYTES = 8 * HTB, NXCD = 8, WGM = 8;
DI int lds_byte(int r, int c) { const int st = (r >> 4) * 2 + (c >> 5), rr = r & 15, cc = c & 31, ob = rr * 64 + cc * 2; return st * 1024 + (ob ^ (((ob >> 9) & 1) << 5)); }
DI void stage_rc(int b, int& R, int& C) { const int st = b / 1024, sb = b % 1024, swz = sb ^ (((sb >> 9) & 1) << 5); R = (st >> 1) * 16 + swz / 64; C = (st & 1) * 32 + (swz % 64) / 2; }
DI int perm32(int rho) { const int n = rho >> 4, i = rho & 15; return 8 * (i >> 2) + 4 * n + (i & 3); }
struct Unit { int pm, pn; };
struct Gemm { const bf16_t* A; const bf16_t* Bt; int M, N, K, lda, ldb; };
struct StaticOrder {
    int nM, nN, nwg, G, c;
    DI void init(int M, int N, int G_, int c_) { nM = M / BM; nN = N / BM; nwg = nM * nN; G = G_; c = c_; }
    DI bool next(int i, Unit& u) const {
        const long L = (long)i * G + c; if (L >= nwg) return false;
        int wgid = (int)L; { const int q = nwg / NXCD, r = nwg % NXCD, xcd = wgid % NXCD, off = wgid / NXCD; wgid = (xcd < r ? xcd * (q + 1) : r * (q + 1) + (xcd - r) * q) + off; }
        const int nig = WGM * nN, gid = wgid / nig, fm = gid * WGM, gsz = (nM - fm) < WGM ? (nM - fm) : WGM;
        u.pm = fm + ((wgid % nig) % gsz); u.pn = (wgid % nig) / gsz; return true;
    }
};

template <class Epi, int KIND>
DI void gemm_phase(LAS unsigned char* lds, const Gemm g, const StaticOrder& S, const Epi& E) {
    constexpr bool perm = Epi::template perm_of<KIND>();
    const int tid = tid_opq(), wid = __builtin_amdgcn_readfirstlane(tid >> 6), lane = tid & 63, wr = wid >> 2, wc = wid & 3, fr = lane & 15, fq = lane >> 4;
    const int K = g.K, nt = K / BK;
    unsigned voffA[2], voffB[2];
#pragma unroll
    for (int i = 0; i < 2; ++i) { int R, C; stage_rc(tid * 16 + i * 8192, R, C); const int Rb = perm ? ((R & ~31) + perm32(R & 31)) : R;
        voffA[i] = (unsigned)(R * g.lda + C) * 2u; voffB[i] = (unsigned)(Rb * g.ldb + C) * 2u; }
    const size_t kstep = (size_t)(BK * 2);
    const size_t hstepA = (size_t)HALF * g.lda * 2, hstepB = (size_t)HALF * g.ldb * 2;
    const size_t tstepA = 2 * hstepA, tstepB = 2 * hstepB;
    const unsigned ldsw = (unsigned)wid * 1024u;
    const int aoff = lds_byte(wr * 64 + fr, fq * 8), boff = lds_byte(wc * 32 + fr, fq * 8);
#define PG8_SA(b, h) (((b) * 2 + (h)) * HTB)
#define PG8_SB(b, h) ((4 + (b) * 2 + (h)) * HTB)
#define PG8_STAGE(bufoff, gbase, voff) do { _Pragma("unroll") for (int _i = 0; _i < 2; ++_i) \
        __builtin_amdgcn_global_load_lds((const unsigned*)((const char*)(gbase) + (voff)[_i]), (LAS unsigned*)(lds + (bufoff) + ldsw + _i * 8192), 16, 0, 0); } while (0)
#define PG8_LDA(dst, b, h) do { _Pragma("unroll") for (int m = 0; m < 4; ++m) _Pragma("unroll") for (int k = 0; k < 2; ++k) dst[m][k] = *(const LAS bf16x8*)(lds + PG8_SA(b, h) + aoff + m * 2048 + k * 1024); } while (0)
#define PG8_LDB(dst, b, h) do { _Pragma("unroll") for (int n = 0; n < 2; ++n) _Pragma("unroll") for (int k = 0; k < 2; ++k) dst[n][k] = *(const LAS bf16x8*)(lds + PG8_SB(b, h) + boff + n * 2048 + k * 1024); } while (0)
#define PG8_MMA(ai, bj, At, Bt) do { __builtin_amdgcn_s_setprio(1); _Pragma("unroll") for (int m = 0; m < 4; ++m) _Pragma("unroll") for (int n = 0; n < 2; ++n) _Pragma("unroll") for (int k = 0; k < 2; ++k) \
        acc[ai][bj][m][n] = __builtin_amdgcn_mfma_f32_16x16x32_bf16(Bt[n][k], At[m][k], acc[ai][bj][m][n], 0, 0, 0); __builtin_amdgcn_s_setprio(0); } while (0)
#define PG8_WAIT_V(n) asm volatile("s_waitcnt vmcnt(" #n ")" ::: "memory")
#define PG8_WAIT_L(n) asm volatile("s_waitcnt lgkmcnt(" #n ")" ::: "memory")
#define PG8_BAR __builtin_amdgcn_s_barrier()
#define PG8_SCHED __builtin_amdgcn_sched_barrier(0)
    Unit cur, nxt; int ui = 0;
    if (!S.next(0, cur)) return;
    f32x4 acc[2][2][4][2];
#pragma unroll
    for (int a = 0; a < 2; ++a)
#pragma unroll
        for (int b = 0; b < 2; ++b)
#pragma unroll
            for (int m = 0; m < 4; ++m)
#pragma unroll
                for (int n = 0; n < 2; ++n) acc[a][b][m][n] = (f32x4){0.f, 0.f, 0.f, 0.f};
    bf16x8 At[4][2], B0[2][2], B1[2][2];
    const char* cA = (const char*)g.A + (size_t)cur.pm * tstepA; const char* cB = (const char*)g.Bt + (size_t)cur.pn * tstepB;
    PG8_STAGE(PG8_SB(0, 0), cB, voffB); PG8_STAGE(PG8_SA(0, 0), cA, voffA); PG8_STAGE(PG8_SB(0, 1), cB + hstepB, voffB); PG8_STAGE(PG8_SA(0, 1), cA + hstepA, voffA);
    if (wr == 1) PG8_BAR;
    PG8_WAIT_V(4); PG8_BAR;
    PG8_STAGE(PG8_SB(1, 0), cB + kstep, voffB); PG8_STAGE(PG8_SA(1, 0), cA + kstep, voffA); PG8_STAGE(PG8_SB(1, 1), cB + hstepB + kstep, voffB);
    PG8_WAIT_V(6); PG8_BAR;
    for (;;) {
        const bool has_next = S.next(ui + 1, nxt);
        const char* nA = has_next ? (const char*)g.A + (size_t)nxt.pm * tstepA : cA; const char* nB = has_next ? (const char*)g.Bt + (size_t)nxt.pn * tstepB : cB;
        for (int t = 0; t < nt; t += 2) {
            const bool last = (t == nt - 2);
            const char* a1 = cA + (size_t)(t + 1) * kstep;
            const char* a2 = last ? nA : cA + (size_t)(t + 2) * kstep; const char* b2 = last ? nB : cB + (size_t)(t + 2) * kstep;
            const char* a3 = a2 + kstep; const char* b3 = b2 + kstep;
            PG8_LDB(B0, 0, 0); PG8_SCHED; PG8_LDA(At, 0, 0); PG8_STAGE(PG8_SA(1, 1), a1 + hstepA, voffA);
            PG8_WAIT_L(8); PG8_BAR; PG8_WAIT_L(0); PG8_MMA(0, 0, At, B0); PG8_BAR; PG8_SCHED;
            PG8_LDB(B1, 0, 1); PG8_STAGE(PG8_SB(0, 0), b2, voffB);
            PG8_BAR; PG8_WAIT_L(0); PG8_MMA(0, 1, At, B1); PG8_BAR;
            PG8_LDA(At, 0, 1); PG8_STAGE(PG8_SA(0, 0), a2, voffA);
            PG8_BAR; PG8_WAIT_L(0); PG8_MMA(1, 0, At, B0); PG8_BAR; PG8_SCHED;
            PG8_STAGE(PG8_SB(0, 1), b2 + hstepB, voffB);
            PG8_WAIT_V(6); PG8_BAR; PG8_MMA(1, 1, At, B1); PG8_BAR;
            PG8_LDB(B0, 1, 0); PG8_SCHED; PG8_LDA(At, 1, 0); PG8_STAGE(PG8_SA(0, 1), a2 + hstepA, voffA);
            PG8_WAIT_L(8); PG8_BAR; PG8_WAIT_L(0); PG8_MMA(0, 0, At, B0); PG8_BAR; PG8_SCHED;
            PG8_LDB(B1, 1, 1); PG8_STAGE(PG8_SB(1, 0), b3, voffB);
            PG8_BAR; PG8_WAIT_L(0); PG8_MMA(0, 1, At, B1); PG8_BAR;
            PG8_LDA(At, 1, 1); PG8_STAGE(PG8_SA(1, 0), a3, voffA);
            PG8_BAR; PG8_WAIT_L(0); PG8_MMA(1, 0, At, B0); PG8_BAR; PG8_SCHED;
            PG8_STAGE(PG8_SB(1, 1), b3 + hstepB, voffB);
            PG8_WAIT_V(6); PG8_BAR; PG8_MMA(1, 1, At, B1); PG8_BAR;
        }
        E.template run<KIND>(acc, cur, wr, wc, fr, fq);
        if (!has_next) break;
#pragma unroll
        for (int a = 0; a < 2; ++a)
#pragma unroll
            for (int b = 0; b < 2; ++b)
#pragma unroll
                for (int m = 0; m < 4; ++m)
#pragma unroll
                    for (int n = 0; n < 2; ++n) acc[a][b][m][n] = (f32x4){0.f, 0.f, 0.f, 0.f};
        cur = nxt; cA = nA; cB = nB; ++ui;
    }
    PG8_WAIT_V(0);
    if (wr == 0) PG8_BAR;
    PG8_BAR;
#undef PG8_SA
#undef PG8_SB
#undef PG8_STAGE
#undef PG8_LDA
#undef PG8_LDB
#undef PG8_MMA
#undef PG8_WAIT_V
#undef PG8_WAIT_L
#undef PG8_BAR
#undef PG8_SCHED
}
}

enum { EPI_BF16 = 0, EPI_GLA_IN = 1, EPI_RESID = 2, EPI_UKV = 3, EPI_FFN_UP = 4 };
DI float dpp_ror1(float v) { return __int_as_float(__builtin_amdgcn_update_dpp(0, __float_as_int(v), 0x121, 0xf, 0xf, false)); }
DI float dpp_ror15(float v) { return __int_as_float(__builtin_amdgcn_update_dpp(0, __float_as_int(v), 0x12F, 0xf, 0xf, false)); }
struct Epi {
    int ldc; LAS float* xch;
    void* q0; void* q1; void* q2; void* q3; void* q4;
    static DI f32x4 ror1_4(f32x4 v) { float a, b, c, d;
        asm volatile("s_nop 1\n\tv_mov_b32_dpp %0, %4 row_ror:1 row_mask:0xf bank_mask:0xf\n\tv_mov_b32_dpp %1, %5 row_ror:1 row_mask:0xf bank_mask:0xf\n\tv_mov_b32_dpp %2, %6 row_ror:1 row_mask:0xf bank_mask:0xf\n\tv_mov_b32_dpp %3, %7 row_ror:1 row_mask:0xf bank_mask:0xf"
                     : "=&v"(a), "=&v"(b), "=&v"(c), "=&v"(d) : "v"(v[0]), "v"(v[1]), "v"(v[2]), "v"(v[3]));
        return (f32x4){a, b, c, d}; }
    static DI f32x2 ror1_2(f32x2 v) { float a, b;
        asm volatile("s_nop 1\n\tv_mov_b32_dpp %0, %2 row_ror:1 row_mask:0xf bank_mask:0xf\n\tv_mov_b32_dpp %1, %3 row_ror:1 row_mask:0xf bank_mask:0xf" : "=&v"(a), "=&v"(b) : "v"(v[0]), "v"(v[1]));
        return (f32x2){a, b}; }
    static DI f32x2 ror15_2(f32x2 v) { float a, b;
        asm volatile("s_nop 1\n\tv_mov_b32_dpp %0, %2 row_ror:15 row_mask:0xf bank_mask:0xf\n\tv_mov_b32_dpp %1, %3 row_ror:15 row_mask:0xf bank_mask:0xf" : "=&v"(a), "=&v"(b) : "v"(v[0]), "v"(v[1]));
        return (f32x2){a, b}; }
    static DI f32x4 ror15_4(f32x4 v) { float a, b, c, d;
        asm volatile("s_nop 1\n\tv_mov_b32_dpp %0, %4 row_ror:15 row_mask:0xf bank_mask:0xf\n\tv_mov_b32_dpp %1, %5 row_ror:15 row_mask:0xf bank_mask:0xf\n\tv_mov_b32_dpp %2, %6 row_ror:15 row_mask:0xf bank_mask:0xf\n\tv_mov_b32_dpp %3, %7 row_ror:15 row_mask:0xf bank_mask:0xf"
                     : "=&v"(a), "=&v"(b), "=&v"(c), "=&v"(d) : "v"(v[0]), "v"(v[1]), "v"(v[2]), "v"(v[3]));
        return (f32x4){a, b, c, d}; }
    DI void ffn_up(const f32x4 (&acc)[2][2][4][2], const pg8::Unit& u, int wr, int wc, int fr, int fq) const {
        bf16_t* O = (bf16_t*)q0; const float* cw = (const float*)q1; const float* cb = (const float*)q2; float* halo = (float*)q3;
        const int cl = wc * 32 + 8 * fq;
#define XW(ST, TB, BJ, V0, V1) do { LAS float* xp_ = xch + ((((ST) + 1) * 2 + (TB)) * 2 + (BJ)) * 128 + cl; *(LAS f32x4*)xp_ = (V0); *(LAS f32x4*)(xp_ + 4) = (V1); } while (0)
        if (fr == 0) { XW(wr, 0, 0, acc[0][0][0][0], acc[0][0][0][1]); XW(wr, 0, 1, acc[0][1][0][0], acc[0][1][0][1]); XW(2 + wr, 0, 0, acc[1][0][0][0], acc[1][0][0][1]); XW(2 + wr, 0, 1, acc[1][1][0][0], acc[1][1][0][1]); }
        if (fr == 15) { XW(wr, 1, 0, acc[0][0][3][0], acc[0][0][3][1]); XW(wr, 1, 1, acc[0][1][3][0], acc[0][1][3][1]); XW(2 + wr, 1, 0, acc[1][0][3][0], acc[1][0][3][1]); XW(2 + wr, 1, 1, acc[1][1][3][0], acc[1][1][3][1]); }
        { const f32x4 zz = (f32x4){0.f, 0.f, 0.f, 0.f}; if (fr == 0 && wr == 0) { XW(-1, 1, 0, zz, zz); XW(-1, 1, 1, zz, zz); } if (fr == 15 && wr == 1) { XW(4, 0, 0, zz, zz); XW(4, 0, 1, zz, zz); } }
#undef XW
        {
            float* hp = halo + (size_t)(u.pm * 22 + u.pn) * 4 * 256 + cl;
            if (wr == 0 && fr < 2) { float* h2 = hp + fr * 256; *(f32x4*)h2 = acc[0][0][0][0]; *(f32x4*)(h2 + 4) = acc[0][0][0][1]; *(f32x4*)(h2 + 128) = acc[0][1][0][0]; *(f32x4*)(h2 + 132) = acc[0][1][0][1]; }
            if (wr == 1 && fr >= 14) { float* h2 = hp + (fr - 12) * 256; *(f32x4*)h2 = acc[1][0][3][0]; *(f32x4*)(h2 + 4) = acc[1][0][3][1]; *(f32x4*)(h2 + 128) = acc[1][1][3][0]; *(f32x4*)(h2 + 132) = acc[1][1][3][1]; }
        }
        asm volatile("s_waitcnt lgkmcnt(0)" ::: "memory"); __builtin_amdgcn_s_barrier(); asm volatile("" ::: "memory"); __builtin_amdgcn_s_barrier(); asm volatile("" ::: "memory");
        const int rowt = u.pm * 256 + wr * 64 + fr;
        const bool f0 = fr == 0, f15 = fr == 15;
        f32x2 sg[2][4][4];
#define SILU2(v) (f32x2){silu_f(v[0]), silu_f(v[1])}
#define H2(V, HH) __builtin_shufflevector(V, V, 2 * (HH), 2 * (HH) + 1)
#define CONV_GROUP(BJ, Q, AI, OP) do { \
            const int st = 2 * (AI) + wr; \
            const f32x2 pb = *(const LAS f32x2*)(xch + (((st) * 2 + 1) * 2 + (BJ)) * 128 + cl + 2 * (Q)); \
            const f32x2 nb = *(const LAS f32x2*)(xch + (((st + 2) * 2 + 0) * 2 + (BJ)) * 128 + cl + 2 * (Q)); \
            const f32x2 c0 = H2(acc[AI][BJ][0][(Q) >> 1], (Q) & 1), c1 = H2(acc[AI][BJ][1][(Q) >> 1], (Q) & 1), c2 = H2(acc[AI][BJ][2][(Q) >> 1], (Q) & 1), c3 = H2(acc[AI][BJ][3][(Q) >> 1], (Q) & 1); \
            const f32x2 R0 = ror1_2(c0), L0 = ror15_2(c0), L1 = ror15_2(c1); \
            { const f32x2 v = w0 * (f0 ? pb : R0) + w1 * c0 + w2 * (f15 ? L1 : L0) + bb; OP(sg[AI][0][Q], v); } \
            __builtin_amdgcn_sched_barrier(0); \
            const f32x2 R1 = ror1_2(c1), L2 = ror15_2(c2); \
            { const f32x2 v = w0 * (f0 ? R0 : R1) + w1 * c1 + w2 * (f15 ? L2 : L1) + bb; OP(sg[AI][1][Q], v); } \
            __builtin_amdgcn_sched_barrier(0); \
            const f32x2 R2 = ror1_2(c2), L3 = ror15_2(c3); \
            { const f32x2 v = w0 * (f0 ? R1 : R2) + w1 * c2 + w2 * (f15 ? L3 : L2) + bb; OP(sg[AI][2][Q], v); } \
            __builtin_amdgcn_sched_barrier(0); \
            const f32x2 R3 = ror1_2(c3); \
            { const f32x2 v = w0 * (f0 ? R2 : R3) + w1 * c3 + w2 * (f15 ? nb : L3) + bb; OP(sg[AI][3][Q], v); } \
            __builtin_amdgcn_sched_barrier(0); } while (0)
#define OP_G(dst, v) dst = SILU2(v)
#define OP_A(dst, v) dst *= v
#define CONV_W(BJ, Q) const int ch = (BJ) * 2816 + u.pn * 128 + cl + 2 * (Q); \
            const f32x2 w0 = *(const f32x2*)(cw + ch), w1 = *(const f32x2*)(cw + 5632 + ch), w2 = *(const f32x2*)(cw + 2 * 5632 + ch), bb = *(const f32x2*)(cb + ch);
        { CONV_W(1, 0) CONV_GROUP(1, 0, 0, OP_G); CONV_GROUP(1, 0, 1, OP_G); }
        { CONV_W(1, 1) CONV_GROUP(1, 1, 0, OP_G); CONV_GROUP(1, 1, 1, OP_G); }
        { CONV_W(1, 2) CONV_GROUP(1, 2, 0, OP_G); CONV_GROUP(1, 2, 1, OP_G); }
        { CONV_W(1, 3) CONV_GROUP(1, 3, 0, OP_G); CONV_GROUP(1, 3, 1, OP_G); }
        { CONV_W(0, 0) CONV_GROUP(0, 0, 0, OP_A); CONV_GROUP(0, 0, 1, OP_A); }
        { CONV_W(0, 1) CONV_GROUP(0, 1, 0, OP_A); CONV_GROUP(0, 1, 1, OP_A); }
        { CONV_W(0, 2) CONV_GROUP(0, 2, 0, OP_A); CONV_GROUP(0, 2, 1, OP_A); }
        { CONV_W(0, 3) CONV_GROUP(0, 3, 0, OP_A); CONV_GROUP(0, 3, 1, OP_A); }
#undef CONV_W
#undef CONV_GROUP
#undef OP_G
#undef OP_A
#undef SILU2
#undef H2
#define ST16(AI, MM) do { u32x4 w_; w_.x = cvt_pk_bf16(sg[AI][MM][0][0], sg[AI][MM][0][1]); w_.y = cvt_pk_bf16(sg[AI][MM][1][0], sg[AI][MM][1][1]); w_.z = cvt_pk_bf16(sg[AI][MM][2][0], sg[AI][MM][2][1]); w_.w = cvt_pk_bf16(sg[AI][MM][3][0], sg[AI][MM][3][1]); \
            *(u32x4*)(O + (size_t)(rowt + (AI) * 128 + (MM) * 16) * 2816 + u.pn * 128 + cl) = w_; } while (0)
        ST16(0, 0); ST16(0, 1); ST16(0, 2); ST16(0, 3); ST16(1, 0); ST16(1, 1); ST16(1, 2); ST16(1, 3);
#undef ST16
    }
    template <int K> static constexpr bool perm_of() { return K != EPI_RESID; }
    template <int kind> DI void run(const f32x4 (&acc)[2][2][4][2], const pg8::Unit& u, int wr, int wc, int fr, int fq) const {
        asm volatile("" : "+v"(fr), "+v"(fq));
        if constexpr (kind == EPI_FFN_UP) { ffn_up(acc, u, wr, wc, fr, fq); return; }
        if constexpr (kind == EPI_RESID) {
            const float* base_l = (const float*)q0; const float* base_c = (const float*)q1; float* out_l = (float*)q2; float* out_c = (float*)q3; const float* gate = (const float*)q4;
            const int bidx = u.pm < 256 ? (u.pm >> 4) : 16;
            const float* gv = gate + (size_t)bidx * 6144;
            const float* bp = u.pm < 256 ? base_l + (size_t)u.pm * 256 * 1024 : base_c + (size_t)(u.pm - 256) * 256 * 1024;
            float* op = u.pm < 256 ? out_l + (size_t)u.pm * 256 * 1024 : out_c + (size_t)(u.pm - 256) * 256 * 1024;
            const int col0 = u.pn * 256 + wc * 32 + 4 * fq;
            f32x4 gt[2][2];
#pragma unroll
            for (int bj = 0; bj < 2; ++bj)
#pragma unroll
                for (int n = 0; n < 2; ++n) gt[bj][n] = *(const f32x4*)(gv + col0 + bj * 128 + n * 16);
#pragma unroll
            for (int ai = 0; ai < 2; ++ai)
#pragma unroll
                for (int m = 0; m < 4; ++m) {
                    const size_t off = (size_t)(ai * 128 + wr * 64 + m * 16 + fr) * 1024 + col0;
#pragma unroll
                    for (int bj = 0; bj < 2; ++bj)
#pragma unroll
                        for (int n = 0; n < 2; ++n) {
                            const f32x4 bs = *(const f32x4*)(bp + off + bj * 128 + n * 16);
                            *(f32x4*)(op + off + bj * 128 + n * 16) = bs + gt[bj][n] * acc[ai][bj][m][n];
                        }
                }
            return;
        } else {
        bf16_t* O = (bf16_t*)q0; float* lr = (float*)q1; bf16_t* KB = (bf16_t*)q0; bf16_t* VB = (bf16_t*)q1;
        const int rowt = u.pm * 256 + wr * 64 + fr;
#pragma unroll
        for (int ai = 0; ai < 2; ++ai)
#pragma unroll
            for (int m = 0; m < 4; ++m) {
                const int row = rowt + ai * 128 + m * 16;
#pragma unroll
                for (int bj = 0; bj < 2; ++bj) {
                    f32x4 v0 = acc[ai][bj][m][0], v1 = acc[ai][bj][m][1];
                    const int cin = bj * 128 + wc * 32 + 8 * fq;
                    if constexpr (kind == EPI_GLA_IN) {
                        if (u.pn == 12) {
                            if (bj == 0 && wc == 0) { float* lp = lr + (size_t)row * 32 + 8 * fq; *(f32x4*)lp = v0; *(f32x4*)(lp + 4) = v1; }
                            continue;
                        }
                        if (u.pn < 2) { v0 *= 0.08838834764831845f; v1 *= 0.08838834764831845f; }
                    }
                    u32x4 w; w.x = cvt_pk_bf16(v0[0], v0[1]); w.y = cvt_pk_bf16(v0[2], v0[3]); w.z = cvt_pk_bf16(v1[0], v1[1]); w.w = cvt_pk_bf16(v1[2], v1[3]);
                    if constexpr (kind == EPI_UKV) {
                        int key;
                        if (u.pm < 256) { const int b = u.pm >> 4; key = b * KEYS + CTXL + (row - b * SEQ); }
                        else { const int b = u.pm - 256; key = b * KEYS + (row - TL - b * CTXL); }
                        const int cc = wc * 32 + 8 * fq;
                        if (bj == 0) *(u32x4*)(KB + (size_t)key * 1536 + u.pn * 192 + cc) = w;
                        else *(u32x4*)(VB + (size_t)key * 1024 + u.pn * 128 + cc) = w;
                    } else {
                        *(u32x4*)(O + (size_t)row * ldc + u.pn * 256 + cin) = w;
                    }
                }
            }
        }
    }
};

DI void prep_phase(const Params& p, LAS unsigned char* lds) {
    const int tid = tid_opq();
    unsigned char* ws = (unsigned char*)p.in[opq(27)];
    LAS float* tl = (LAS float*)lds;
    const float* in_c = p.in[opq(1)]; const float* in_cctx = p.in[opq(3)]; const float* in_wada = p.in[opq(4)]; const float* in_bada = p.in[opq(5)];
    const float* in_gin = p.in[opq(8)]; const float* in_w1 = p.in[opq(9)]; const float* in_gout = p.in[opq(13)]; const float* in_mdown = p.in[opq(14)];
    const float* in_uq = p.in[opq(17)]; const float* in_ukv = p.in[opq(18)]; const float* in_mout = p.in[opq(21)]; const float* in_fup = p.in[opq(22)]; const float* in_fdown = p.in[opq(25)];
    constexpr int T0 = 1536, T2 = 512, T3 = 352, T4 = 288, T5 = 256, T6 = 512, T7 = 5632, T8 = 2816;
    constexpr int NTILE = T0 + T2 + T3 + T4 + T5 + T6 + T7 + T8;
    for (int t = blockIdx.x; t < NTILE; t += gridDim.x) {
        const float* src; int N, k0, n0, ld; bf16_t* dst;
        int q = t;
        if (q < T0) { const int j = q / 768, r = q % 768, kt = r / 48, nt = r % 48; src = in_gin + (size_t)j * 1024 * 3072; N = 3072; k0 = kt * 64; n0 = nt * 64;
            dst = (bf16_t*)(ws + WS_GIN + j * SZ_GIN) + (size_t)n0 * 1024 + k0; ld = 1024; }
        else if ((q -= T0) < T2) { const int j = q / 256, r = q % 256, kt = r / 16, nt = r % 16; src = in_gout + (size_t)j * 1024 * 1024; N = 1024; k0 = kt * 64; n0 = nt * 64;
            dst = (bf16_t*)(ws + WS_GOUT + j * SZ_SQ) + (size_t)n0 * 1024 + k0; ld = 1024; }
        else if ((q -= T2) < T3) { const int j = q / 176, r = q % 176, kt = r / 11, nt = r % 11; src = in_mdown + (size_t)j * 1024 * 704; N = 704; k0 = kt * 64; n0 = nt * 64;
            dst = (bf16_t*)(ws + WS_MDOWN + j * SZ_MDOWN) + (size_t)n0 * 1024 + k0; ld = 1024; }
        else if ((q -= T3) < T4) { const int j = q / 144, r = q % 144, kt = r / 24, nt = r % 24; src = in_uq + (size_t)j * 384 * 1536; N = 1536; k0 = kt * 64; n0 = nt * 64;
            dst = (bf16_t*)(ws + WS_MUQ + j * SZ_MUQ) + (size_t)n0 * 384 + k0; ld = 384; }
        else if ((q -= T4) < T5) { const int j = q / 128, r = q % 128, kt = r / 32, nt = r % 32; src = in_ukv + (size_t)j * 256 * 2048; N = 2048; k0 = kt * 64; n0 = nt * 64;
            dst = (bf16_t*)(ws + WS_MUKV + j * SZ_MUKV) + (size_t)n0 * 256 + k0; ld = 256; }
        else if ((q -= T5) < T6) { const int j = q / 256, r = q % 256, kt = r / 16, nt = r % 16; src = in_mout + (size_t)j * 1024 * 1024; N = 1024; k0 = kt * 64; n0 = nt * 64;
            dst = (bf16_t*)(ws + WS_MOUT + j * SZ_SQ) + (size_t)n0 * 1024 + k0; ld = 1024; }
        else if ((q -= T6) < T7) { const int i = q / 1408, r = q % 1408, kt = r / 88, nt = r % 88; src = in_fup + (size_t)i * 1024 * 5632; N = 5632; k0 = kt * 64; n0 = nt * 64;
            const int isg = n0 >= DFF ? 1 : 0, cc = n0 - isg * DFF, drow = (cc >> 7) * 256 + isg * 128 + (cc & 127);
            dst = (bf16_t*)(ws + WS_FUP + (size_t)i * SZ_FUP) + (size_t)drow * 1024 + k0; ld = 1024; }
        else { q -= T7; const int i = q / 704, r = q % 704, kt = r / 16, nt = r % 16; src = in_fdown + (size_t)i * 2816 * 1024; N = 1024; k0 = kt * 64; n0 = nt * 64;
            dst = (bf16_t*)(ws + WS_FDOWN + (size_t)i * SZ_FDOWN) + (size_t)n0 * 2816 + k0; ld = 2816; }
#pragma unroll
        for (int i = 0; i < 8; ++i) { const int r = (tid >> 6) + 8 * i, c = tid & 63; tl[c * 65 + r] = src[(size_t)(k0 + r) * N + n0 + c]; }
        __syncthreads();
#pragma unroll
        for (int i = 0; i < 4; ++i) { const int rr = (tid >> 5) + 16 * i, c2 = (tid & 31) * 2; const float a = tl[rr * 65 + c2], b = tl[rr * 65 + c2 + 1];
            *(unsigned*)(dst + (size_t)rr * ld + c2) = cvt_pk_bf16(a, b); }
        __syncthreads();
    }
    const int gtid = blockIdx.x * NTHREADS + tid, gstride = gridDim.x * NTHREADS;
    for (int idx = gtid; idx < 65536; idx += gstride) {
        const int k = idx & 1023, r = (idx >> 10) & 15, dir = (idx >> 14) & 1, j = idx >> 15;
        const float v = in_w1[((size_t)(j * 2 + dir) * 1024 + k) * 16 + r];
        ((bf16_t*)(ws + WS_GIN + j * SZ_GIN))[(size_t)(3072 + dir * 16 + r) * 1024 + k] = f2bf(v);
    }
    for (int idx = gtid; idx < 2 * 114688; idx += gstride) { const int j = idx / 114688, o = idx % 114688; ((unsigned*)(ws + WS_GIN + j * SZ_GIN + 3104ull * 1024 * 2))[o] = 0u; }
    for (int idx = gtid; idx < 2 * 32768; idx += gstride) { const int j = idx / 32768, o = idx % 32768; ((unsigned*)(ws + WS_MDOWN + j * SZ_MDOWN + 704ull * 1024 * 2))[o] = 0u; }
    LAS float* sl = (LAS float*)lds;
    LAS float* red = (LAS float*)(lds + 81920);
    __syncthreads();
    for (int idx = tid; idx < 17 * 1024; idx += NTHREADS) { const int r = idx >> 10, k = idx & 1023; const float v = r < 16 ? in_c[r * 1024 + k] : in_cctx[k]; sl[k * 20 + r] = v / (1.0f + __expf(-v)); }
    __syncthreads();
    float* mod = (float*)(ws + WS_MOD);
    for (int it = blockIdx.x; it < 384; it += gridDim.x) {
        const int layer = it / 96, n0 = (it % 96) * 64, nn = tid & 63, ks = tid >> 6;
        const float* W = in_wada + (size_t)layer * 1024 * 6144 + n0 + nn;
        float acc[17];
#pragma unroll
        for (int r = 0; r < 17; ++r) acc[r] = 0.f;
        for (int kk = 0; kk < 128; ++kk) {
            const int k = ks * 128 + kk; const float w = W[(size_t)k * 6144];
            const f32x4 s0 = *(const LAS f32x4*)(sl + k * 20), s1 = *(const LAS f32x4*)(sl + k * 20 + 4), s2 = *(const LAS f32x4*)(sl + k * 20 + 8), s3 = *(const LAS f32x4*)(sl + k * 20 + 12);
            const float s16 = sl[k * 20 + 16];
#pragma unroll
            for (int j = 0; j < 4; ++j) { acc[j] += s0[j] * w; acc[4 + j] += s1[j] * w; acc[8 + j] += s2[j] * w; acc[12 + j] += s3[j] * w; }
            acc[16] += s16 * w;
        }
#pragma unroll
        for (int r = 0; r < 17; ++r) red[(ks * 17 + r) * 64 + nn] = acc[r];
        __syncthreads();
        for (int o = tid; o < 17 * 64; o += NTHREADS) { const int r = o >> 6, c = o & 63; float s = in_bada[layer * 6144 + n0 + c];
#pragma unroll
            for (int k8 = 0; k8 < 8; ++k8) s += red[(k8 * 17 + r) * 64 + c];
            mod[(size_t)(layer * 17 + r) * 6144 + n0 + c] = s; }
        __syncthreads();
    }
}

DI void norm_phase(const float* xl, const float* xc, const float* gain, const float* modl, int sh_off, int sc_off, bf16_t* h) {
    const int tid = tid_opq(), wave = tid >> 6, lane = tid & 63;
    for (int row = blockIdx.x * 8 + wave; row < MR; row += gridDim.x * 8) {
        const float* src = row < TL ? xl + (size_t)row * 1024 : xc + (size_t)(row - TL) * 1024;
        const float* mb = modl + (size_t)(row < TL ? (row >> 12) : 16) * 6144;
        f32x4 v[4]; float ss = 0.f;
#pragma unroll
        for (int i = 0; i < 4; ++i) { v[i] = *(const f32x4*)(src + i * 256 + lane * 4); ss += v[i][0] * v[i][0] + v[i][1] * v[i][1] + v[i][2] * v[i][2] + v[i][3] * v[i][3]; }
        ss = wave_sum(ss);
        const float rstd = rsqrtf(ss * (1.0f / 1024.0f) + 1e-6f);
#pragma unroll
        for (int i = 0; i < 4; ++i) {
            const int c = i * 256 + lane * 4;
            const f32x4 g = *(const f32x4*)(gain + c), sc = *(const f32x4*)(mb + sc_off + c), sh = *(const f32x4*)(mb + sh_off + c);
            const f32x4 y = (v[i] * rstd * g) * (sc + 1.0f) + sh;
            u32x2 w; w.x = cvt_pk_bf16(y[0], y[1]); w.y = cvt_pk_bf16(y[2], y[3]);
            *(u32x2*)(h + (size_t)row * 1024 + c) = w;
        }
    }
}

DI void scan_phase(const bf16_t* qkvr, const float* lr, const float* w2, const float* gb, bf16_t* of, bf16_t* ob, LAS unsigned char* lds) {
    constexpr int QD = 0, KI = 17408, KST = 34816, VT = 53248, ST = 71680, PP = 106496, LRS = 115712, SEG = 123904, BL = 128000;
    const int tid = tid_opq(), wave = __builtin_amdgcn_readfirstlane(tid >> 6), lane = tid & 63;
    const int l31 = lane & 31, lh = lane >> 5, l15 = lane & 15, lq = lane >> 4;
    for (int item = blockIdx.x; item < 256; item += gridDim.x) {
        const int b = item >> 4, dir = (item >> 3) & 1, h = (item >> 1) & 3, dvh = item & 1;
        bf16_t* obuf = dir ? ob : of;
        const int d0 = 2 * lane;
        float w2r[16][2];
#pragma unroll
        for (int r = 0; r < 16; ++r) { const f32x2 t = *(const f32x2*)(w2 + (size_t)(dir * 16 + r) * 512 + h * 128 + d0); w2r[r][0] = t.x; w2r[r][1] = t.y; }
        const f32x2 gbias = *(const f32x2*)(gb + dir * 512 + h * 128 + d0);
        f32x16 Sacc[2];
#pragma unroll
        for (int i = 0; i < 16; ++i) { Sacc[0][i] = 0.f; Sacc[1][i] = 0.f; }
        __syncthreads();
        for (int o = tid; o < 34816 / 16; o += NTHREADS) *(LAS u32x4*)(lds + ST + o * 16) = (u32x4){0u, 0u, 0u, 0u};
        unsigned qv[8], kv[8], vv[8]; f32x4 lrv = (f32x4){0.f, 0.f, 0.f, 0.f};
        const int qcol = h * 128 + d0, kcol = 512 + h * 128 + d0, vcol = 1024 + h * 256 + dvh * 128 + d0;
#define SCAN_ROWBASE(c, rb, sg) do { if (dir == 0) { sg = 1; rb = (c) < 4 ? TL + b * CTXL + (c) * 64 : b * SEQ + ((c) - 4) * 64; } \
                                     else { sg = -1; rb = (c) < 4 ? TL + b * CTXL + 255 - (c) * 64 : b * SEQ + 4095 - ((c) - 4) * 64; } } while (0)
#define SCAN_LOAD(c) do { int rb_, sg_; SCAN_ROWBASE(c, rb_, sg_); \
        _Pragma("unroll") for (int i = 0; i < 8; ++i) { const size_t ro = (size_t)(rb_ + sg_ * (wave * 8 + i)) * 3072; \
            qv[i] = *(const unsigned*)(qkvr + ro + qcol); kv[i] = *(const unsigned*)(qkvr + ro + kcol); vv[i] = *(const unsigned*)(qkvr + ro + vcol); } \
        if (tid < 256) lrv = *(const f32x4*)(lr + (size_t)(rb_ + sg_ * (tid >> 2)) * 32 + dir * 16 + (tid & 3) * 4); } while (0)
        SCAN_LOAD(0);
        if (tid < 256) *(LAS f32x4*)(lds + LRS + (tid >> 2) * 64 + (tid & 3) * 16) = lrv;
        __syncthreads();
        for (int c = 0; c < 68; ++c) {
            int rowbase, sgn; SCAN_ROWBASE(c, rowbase, sgn);
            const LAS float* lrs = (const LAS float*)(lds + LRS + (c & 1) * 4096);
            float bl0[8], bl1[8]; float cum0 = 0.f, cum1 = 0.f;
#pragma unroll
            for (int i = 0; i < 8; ++i) {
                const int s = wave * 8 + i;
                float z0 = gbias.x, z1 = gbias.y;
#pragma unroll
                for (int r4 = 0; r4 < 4; ++r4) { const f32x4 lv = *(const LAS f32x4*)(lrs + s * 16 + r4 * 4);
#pragma unroll
                    for (int j = 0; j < 4; ++j) { z0 += lv[j] * w2r[r4 * 4 + j][0]; z1 += lv[j] * w2r[r4 * 4 + j][1]; } }
                const float g0 = (fminf(z0, 0.f) - __logf(1.0f + __expf(-fabsf(z0)))) * 0.0625f;
                const float g1 = (fminf(z1, 0.f) - __logf(1.0f + __expf(-fabsf(z1)))) * 0.0625f;
                cum0 += g0; cum1 += g1; bl0[i] = cum0; bl1[i] = cum1;
            }
            *(LAS f32x2*)(lds + SEG + (wave * 128 + d0) * 4) = (f32x2){cum0, cum1};
            __syncthreads();
            float off0 = 0.f, off1 = 0.f, tot0 = 0.f, tot1 = 0.f;
#pragma unroll
            for (int w = 0; w < 8; ++w) { const f32x2 t = *(const LAS f32x2*)(lds + SEG + (w * 128 + d0) * 4); tot0 += t.x; tot1 += t.y; if (w < wave) { off0 += t.x; off1 += t.y; } }
            if (wave == 0) *(LAS f32x2*)(lds + BL + d0 * 4) = (f32x2){tot0, tot1};
            {
                unsigned ks0[4], ks1[4], vt0[4], vt1[4];
#pragma unroll
                for (int i = 0; i < 8; ++i) {
                    const int s = wave * 8 + i;
                    const float b0 = off0 + bl0[i], b1 = off1 + bl1[i];
                    const float q0 = bf_lo(qv[i]), q1 = bf_hi(qv[i]), k0 = bf_lo(kv[i]), k1 = bf_hi(kv[i]);
                    *(LAS unsigned*)(lds + QD + s * 272 + d0 * 2) = cvt_pk_bf16(q0 * __expf(b0), q1 * __expf(b1));
                    *(LAS unsigned*)(lds + KI + s * 272 + d0 * 2) = cvt_pk_bf16(k0 * __expf(-b0), k1 * __expf(-b1));
                    const float e0 = k0 * __expf(tot0 - b0), e1 = k1 * __expf(tot1 - b1);
                    if (i & 1) { ks0[i >> 1] = (ks0[i >> 1] & 0xffffu) | (cvt_pk_bf16(0.f, e0) & 0xffff0000u); ks1[i >> 1] = (ks1[i >> 1] & 0xffffu) | (cvt_pk_bf16(0.f, e1) & 0xffff0000u);
                                 vt0[i >> 1] = (vt0[i >> 1] & 0xffffu) | (vv[i] << 16); vt1[i >> 1] = (vt1[i >> 1] & 0xffffu) | (vv[i] & 0xffff0000u); }
                    else { ks0[i >> 1] = cvt_pk_bf16(e0, 0.f) & 0xffffu; ks1[i >> 1] = cvt_pk_bf16(e1, 0.f) & 0xffffu; vt0[i >> 1] = vv[i] & 0xffffu; vt1[i >> 1] = vv[i] >> 16; }
                }
                *(LAS u32x4*)(lds + KST + d0 * 144 + wave * 16) = (u32x4){ks0[0], ks0[1], ks0[2], ks0[3]};
                *(LAS u32x4*)(lds + KST + (d0 + 1) * 144 + wave * 16) = (u32x4){ks1[0], ks1[1], ks1[2], ks1[3]};
                *(LAS u32x4*)(lds + VT + d0 * 144 + wave * 16) = (u32x4){vt0[0], vt0[1], vt0[2], vt0[3]};
                *(LAS u32x4*)(lds + VT + (d0 + 1) * 144 + wave * 16) = (u32x4){vt1[0], vt1[1], vt1[2], vt1[3]};
            }
            __syncthreads();
            if (c + 1 < 68) SCAN_LOAD(c + 1);
            {
                const int t0 = 16 * (wave >> 1);
#pragma unroll
                for (int j = 0; j < 2; ++j) {
                    const int s0 = 16 * ((wave & 1) * 2 + j);
                    f32x4 a4 = (f32x4){0.f, 0.f, 0.f, 0.f};
#pragma unroll
                    for (int kk = 0; kk < 4; ++kk) {
                        const bf16x8 af = *(const LAS bf16x8*)(lds + QD + (t0 + l15) * 272 + (kk * 32 + 8 * lq) * 2);
                        const bf16x8 bf = *(const LAS bf16x8*)(lds + KI + (s0 + l15) * 272 + (kk * 32 + 8 * lq) * 2);
                        a4 = __builtin_amdgcn_mfma_f32_16x16x32_bf16(af, bf, a4, 0, 0, 0);
                    }
                    const int s = s0 + l15;
#pragma unroll
                    for (int r = 0; r < 4; ++r) { const int t = t0 + 4 * lq + r; *(LAS bf16_t*)(lds + PP + t * 144 + s * 2) = f2bf(s <= t ? a4[r] : 0.f); }
                }
            }
            __syncthreads();
            {
                const int tq = wave >> 2, vq = wave & 3;
                f32x16 oacc;
#pragma unroll
                for (int i = 0; i < 16; ++i) oacc[i] = 0.f;
#pragma unroll
                for (int kk = 0; kk < 8; ++kk) {
                    const bf16x8 af = *(const LAS bf16x8*)(lds + QD + (32 * tq + l31) * 272 + (kk * 16 + 8 * lh) * 2);
                    const bf16x8 bf = *(const LAS bf16x8*)(lds + ST + (32 * vq + l31) * 272 + (kk * 16 + 8 * lh) * 2);
                    oacc = __builtin_amdgcn_mfma_f32_32x32x16_bf16(af, bf, oacc, 0, 0, 0);
                }
#pragma unroll
                for (int kk = 0; kk < 4; ++kk) {
                    const bf16x8 af = *(const LAS bf16x8*)(lds + PP + (32 * tq + l31) * 144 + (kk * 16 + 8 * lh) * 2);
                    const bf16x8 bf = *(const LAS bf16x8*)(lds + VT + (32 * vq + l31) * 144 + (kk * 16 + 8 * lh) * 2);
                    oacc = __builtin_amdgcn_mfma_f32_32x32x16_bf16(af, bf, oacc, 0, 0, 0);
                }
                const int ocol = h * 256 + dvh * 128 + 32 * vq + l31;
#pragma unroll
                for (int r = 0; r < 16; ++r) { const int t = 32 * tq + crow(r, lh); obuf[(size_t)(rowbase + sgn * t) * 1024 + ocol] = f2bf(oacc[r]); }
            }
            {
                const int vq = wave & 3;
#pragma unroll
                for (int j = 0; j < 2; ++j) {
                    const int dq = 2 * (wave >> 2) + j;
#pragma unroll
                    for (int r = 0; r < 16; ++r) Sacc[j][r] *= __expf(*(const LAS float*)(lds + BL + (32 * dq + crow(r, lh)) * 4));
#pragma unroll
                    for (int kk = 0; kk < 4; ++kk) {
                        const bf16x8 af = *(const LAS bf16x8*)(lds + KST + (32 * dq + l31) * 144 + (kk * 16 + 8 * lh) * 2);
                        const bf16x8 bf = *(const LAS bf16x8*)(lds + VT + (32 * vq + l31) * 144 + (kk * 16 + 8 * lh) * 2);
                        Sacc[j] = __builtin_amdgcn_mfma_f32_32x32x16_bf16(af, bf, Sacc[j], 0, 0, 0);
                    }
                }
            }
            if (tid < 256) *(LAS f32x4*)(lds + LRS + ((c + 1) & 1) * 4096 + (tid >> 2) * 64 + (tid & 3) * 16) = lrv;
            __syncthreads();
            {
                const int vq = wave & 3;
#pragma unroll
                for (int j = 0; j < 2; ++j) {
                    const int dq = 2 * (wave >> 2) + j;
#pragma unroll
                    for (int g = 0; g < 4; ++g) {
                        u32x2 w; w.x = cvt_pk_bf16(Sacc[j][4 * g], Sacc[j][4 * g + 1]); w.y = cvt_pk_bf16(Sacc[j][4 * g + 2], Sacc[j][4 * g + 3]);
                        *(LAS u32x2*)(lds + ST + (32 * vq + l31) * 272 + (32 * dq + 8 * g + 4 * lh) * 2) = w;
                    }
                }
            }
        }
#undef SCAN_LOAD
#undef SCAN_ROWBASE
    }
    __syncthreads();
}

DI void glapost_phase(const bf16_t* of, const bf16_t* ob, const bf16_t* qkvr, const float* onorm, bf16_t* a) {
    const int tid = tid_opq(), wave = tid >> 6, lane = tid & 63;
    const int c0 = lane * 16;
    for (int row = blockIdx.x * 8 + wave; row < MR; row += gridDim.x * 8) {
        const u32x4 f0 = *(const u32x4*)(of + (size_t)row * 1024 + c0), f1 = *(const u32x4*)(of + (size_t)row * 1024 + c0 + 8);
        const u32x4 b0 = *(const u32x4*)(ob + (size_t)row * 1024 + c0), b1 = *(const u32x4*)(ob + (size_t)row * 1024 + c0 + 8);
        const u32x4 r0 = *(const u32x4*)(qkvr + (size_t)row * 3072 + 2048 + c0), r1 = *(const u32x4*)(qkvr + (size_t)row * 3072 + 2048 + c0 + 8);
        float o[16], rr[16];
#pragma unroll
        for (int j = 0; j < 4; ++j) {
            o[2 * j] = bf_lo(f0[j]) + bf_lo(b0[j]); o[2 * j + 1] = bf_hi(f0[j]) + bf_hi(b0[j]);
            o[8 + 2 * j] = bf_lo(f1[j]) + bf_lo(b1[j]); o[8 + 2 * j + 1] = bf_hi(f1[j]) + bf_hi(b1[j]);
            rr[2 * j] = bf_lo(r0[j]); rr[2 * j + 1] = bf_hi(r0[j]); rr[8 + 2 * j] = bf_lo(r1[j]); rr[8 + 2 * j + 1] = bf_hi(r1[j]);
        }
        float ss = 0.f;
#pragma unroll
        for (int j = 0; j < 16; ++j) ss += o[j] * o[j];
        ss += __shfl_xor(ss, 1); ss += __shfl_xor(ss, 2); ss += __shfl_xor(ss, 4); ss += __shfl_xor(ss, 8);
        const float rstd = rsqrtf(ss * (1.0f / 256.0f) + 1e-6f);
        const float* gn = onorm + (c0 & 255);
        unsigned w[8];
#pragma unroll
        for (int j = 0; j < 8; ++j) {
            const float y0 = o[2 * j] * rstd * gn[2 * j] * silu_f(rr[2 * j]), y1 = o[2 * j + 1] * rstd * gn[2 * j + 1] * silu_f(rr[2 * j + 1]);
            w[j] = cvt_pk_bf16(y0, y1);
        }
        *(u32x4*)(a + (size_t)row * 1024 + c0) = (u32x4){w[0], w[1], w[2], w[3]};
        *(u32x4*)(a + (size_t)row * 1024 + c0 + 8) = (u32x4){w[4], w[5], w[6], w[7]};
    }
}

DI void rope_cs(int tpos, int lane, float& cs, float& sn) {
    const int f = lane & 15; const int pos = (lane >> 5) ? (tpos & 63) : (tpos >> 6);
    const float inv = exp2f(-(float)f * (13.287712379549449f / 16.0f));
    const float ang = (float)pos * inv;
    const float kf = rintf(ang * 0.15915494309189535f);
    float r = fmaf(-kf, 6.2831854820251465f, ang); r = fmaf(-kf, -1.7484556000744883e-7f, r);
    cs = __cosf(r); sn = __sinf(r);
}
DI float rope_apply(float y, int lane, float cs, float sn) {
    const float pr = __shfl_xor(y, 16);
    return (lane & 16) ? (pr * sn + y * cs) : (y * cs - pr * sn);
}
DI int key_of_row(int row) {
    if (row < TL) { const int b = row >> 12; return b * KEYS + CTXL + (row & 4095); }
    const int rc = row - TL; const int b = rc >> 8; return b * KEYS + (rc & 255);
}

DI void mlamid_phase(const bf16_t* dn, const float* qln, const float* kvln, const float* knorm, bf16_t* cqn, bf16_t* ckvn, bf16_t* KB) {
    const int tid = tid_opq(), wave = tid >> 6, lane = tid & 63;
    for (int row = blockIdx.x * 8 + wave; row < MR; row += gridDim.x * 8) {
        const bf16_t* src = dn + (size_t)row * 768;
        unsigned q[3]; float ss = 0.f;
#pragma unroll
        for (int i = 0; i < 3; ++i) { q[i] = *(const unsigned*)(src + i * 128 + 2 * lane); const float a = bf_lo(q[i]), b = bf_hi(q[i]); ss += a * a + b * b; }
        ss = wave_sum(ss);
        float rstd = rsqrtf(ss * (1.0f / 384.0f) + 1e-6f);
#pragma unroll
        for (int i = 0; i < 3; ++i) { const int c = i * 128 + 2 * lane; *(unsigned*)(cqn + (size_t)row * 384 + c) = cvt_pk_bf16(bf_lo(q[i]) * rstd * qln[c], bf_hi(q[i]) * rstd * qln[c + 1]); }
        const u32x2 kvv = *(const u32x2*)(src + 384 + 4 * lane);
        const float k0 = bf_lo(kvv.x), k1 = bf_hi(kvv.x), k2 = bf_lo(kvv.y), k3 = bf_hi(kvv.y);
        ss = wave_sum(k0 * k0 + k1 * k1 + k2 * k2 + k3 * k3);
        rstd = rsqrtf(ss * (1.0f / 256.0f) + 1e-6f);
        { const f32x4 g = *(const f32x4*)(kvln + 4 * lane); u32x2 w; w.x = cvt_pk_bf16(k0 * rstd * g[0], k1 * rstd * g[1]); w.y = cvt_pk_bf16(k2 * rstd * g[2], k3 * rstd * g[3]);
          *(u32x2*)(ckvn + (size_t)row * 256 + 4 * lane) = w; }
        const float x = __uint_as_float(((unsigned)src[640 + lane]) << 16);
        ss = wave_sum(x * x);
        rstd = rsqrtf(ss * (1.0f / 64.0f) + 1e-6f);
        float y = x * rstd * knorm[128 + lane];
        if (row < TL) { float cs, sn; rope_cs(row & 4095, lane, cs, sn); y = rope_apply(y, lane, cs, sn); }
        const bf16_t yb = f2bf(y);
        bf16_t* kd = KB + (size_t)key_of_row(row) * 1536 + 128 + lane;
#pragma unroll
        for (int hh = 0; hh < 8; ++hh) kd[hh * 192] = yb;
    }
}

DI void qkprep_phase(bf16_t* Q, bf16_t* KB, const float* qnorm, const float* knorm) {
    const int tid = tid_opq(), wave = tid >> 6, lane = tid & 63;
    const float qn0 = qnorm[2 * lane], qn1 = qnorm[2 * lane + 1], qnr = qnorm[128 + lane];
    const float kn0 = knorm[2 * lane], kn1 = knorm[2 * lane + 1];
    for (int row = blockIdx.x * 8 + wave; row < MR; row += gridDim.x * 8) {
        float cs = 1.f, sn = 0.f;
        const bool lat = row < TL;
        if (lat) rope_cs(row & 4095, lane, cs, sn);
        bf16_t* qr = Q + (size_t)row * 1536;
        bf16_t* kr = KB + (size_t)key_of_row(row) * 1536;
#pragma unroll
        for (int hh = 0; hh < 8; ++hh) {
            const unsigned qa = *(const unsigned*)(qr + hh * 192 + 2 * lane);
            const float xr = __uint_as_float(((unsigned)qr[hh * 192 + 128 + lane]) << 16);
            const unsigned ka = *(const unsigned*)(kr + hh * 192 + 2 * lane);
            const float a0 = bf_lo(qa), a1 = bf_hi(qa), c0 = bf_lo(ka), c1 = bf_hi(ka);
            const float s1 = wave_sum(a0 * a0 + a1 * a1), s2 = wave_sum(xr * xr), s3 = wave_sum(c0 * c0 + c1 * c1);
            const float r1 = rsqrtf(s1 * (1.0f / 128.0f) + 1e-6f), r2 = rsqrtf(s2 * (1.0f / 64.0f) + 1e-6f), r3 = rsqrtf(s3 * (1.0f / 128.0f) + 1e-6f);
            *(unsigned*)(qr + hh * 192 + 2 * lane) = cvt_pk_bf16(a0 * r1 * qn0, a1 * r1 * qn1);
            float y = xr * r2 * qnr;
            if (lat) y = rope_apply(y, lane, cs, sn);
            qr[hh * 192 + 128 + lane] = f2bf(y);
            *(unsigned*)(kr + hh * 192 + 2 * lane) = cvt_pk_bf16(c0 * r3 * kn0, c1 * r3 * kn1);
        }
    }
}

namespace att {
constexpr int DQK = 192, DV = 128, NW = 8, QBLK = 32, KVBLK = 64;
constexpr int LDQ = 1536, LDK = 1536, LDV = 1024, LDO = 1024;
constexpr float SCALE = 0.07216878364870322f;
constexpr float THR = 8.f;
constexpr size_t SHM_V = KVBLK * DV * 2, SHM_K = KVBLK * DQK * 2;
#define KSWZ(row, colB) ((row) * 384 + ((colB) ^ ((((row) >> 1) & 7) << 4)))
#define SBAR() __builtin_amdgcn_sched_barrier(0)
DI unsigned cvtpk(float lo, float hi) { unsigned r; asm volatile("v_cvt_pk_bf16_f32 %0, %1, %2" : "=v"(r) : "v"(lo), "v"(hi)); return r; }
DI void partialSM(f32x16& p0, f32x16& p1, float& m_reg, float& mn, float& alpha) {
    constexpr float C = SCALE * 1.4426950408889634f;
    float pmax = p0[0];
#pragma unroll
    for (int r = 1; r < 16; ++r) pmax = fmaxf(pmax, p0[r]);
#pragma unroll
    for (int r = 0; r < 16; ++r) pmax = fmaxf(pmax, p1[r]);
    { auto rr = __builtin_amdgcn_permlane32_swap(__float_as_uint(pmax), __float_as_uint(pmax), false, false);
      pmax = fmaxf(__uint_as_float(rr[0]), __uint_as_float(rr[1])); }
    if (__builtin_expect(__all(pmax - m_reg <= THR / SCALE), 1)) { mn = m_reg; alpha = 1.f; }
    else { mn = fmaxf(m_reg, pmax); alpha = __builtin_amdgcn_exp2f((m_reg - mn) * C); m_reg = mn; }
    const float mnC = -mn * C;
#pragma unroll
    for (int r = 0; r < 16; ++r) p0[r] = fmaf(p0[r], C, mnC);
#pragma unroll
    for (int r = 0; r < 16; ++r) p1[r] = fmaf(p1[r], C, mnC);
#pragma unroll
    for (int r = 0; r < 16; ++r) p0[r] = __builtin_amdgcn_exp2f(p0[r]);
}
DI void finishSM(f32x16& p0, f32x16& p1, float alpha, float& l_reg, bf16x8& pa0, bf16x8& pa1, bf16x8& pa2, bf16x8& pa3) {
#pragma unroll
    for (int r = 0; r < 16; ++r) p1[r] = __builtin_amdgcn_exp2f(p1[r]);
    float ps = 0;
#pragma unroll
    for (int r = 0; r < 16; ++r) ps += p0[r];
#pragma unroll
    for (int r = 0; r < 16; ++r) ps += p1[r];
    { auto rr = __builtin_amdgcn_permlane32_swap(__float_as_uint(ps), __float_as_uint(ps), false, false);
      ps = __uint_as_float(rr[0]) + __uint_as_float(rr[1]); }
    l_reg = l_reg * alpha + ps;
#define PK4(P, BASE, OUT) do { unsigned a0 = cvtpk(P[BASE + 0], P[BASE + 1]), a1 = cvtpk(P[BASE + 2], P[BASE + 3]);   \
    unsigned b0 = cvtpk(P[BASE + 4], P[BASE + 5]), b1 = cvtpk(P[BASE + 6], P[BASE + 7]);                              \
    auto r0 = __builtin_amdgcn_permlane32_swap(a0, b0, false, false); auto r1 = __builtin_amdgcn_permlane32_swap(a1, b1, false, false); \
    u32x4 w = {r0[0], r1[0], r0[1], r1[1]}; OUT = *reinterpret_cast<bf16x8*>(&w); } while (0)
    PK4(p0, 0, pa0); PK4(p0, 8, pa1); PK4(p1, 0, pa2); PK4(p1, 8, pa3);
#undef PK4
}
DI void qkt(f32x16& p0, f32x16& p1, const char* Ks, const bf16x8* qr, int r32, int hi) {
#pragma unroll
    for (int r = 0; r < 16; ++r) { p0[r] = 0.f; p1[r] = 0.f; }
#pragma unroll
    for (int d0 = 0; d0 < 12; ++d0) { const int cb = (d0 * 16 + hi * 8) * 2;
        const bf16x8 b0 = *reinterpret_cast<const bf16x8*>(Ks + KSWZ(r32, cb));
        const bf16x8 b1 = *reinterpret_cast<const bf16x8*>(Ks + KSWZ(32 + r32, cb));
        p0 = __builtin_amdgcn_mfma_f32_32x32x16_bf16(b0, qr[d0], p0, 0, 0, 0);
        p1 = __builtin_amdgcn_mfma_f32_32x32x16_bf16(b1, qr[d0], p1, 0, 0, 0); }
}
DI int v_st(int k, int c) { const int kk = (k & ~0xC) | ((k & 4) << 1) | ((k & 8) >> 1); return ((kk >> 3) * 4 + (c >> 5)) * 512 + ((kk & 7) * 32 + (c & 31)) * 2; }
DI int v_rd_base(int lane) { return ((lane & 3) << 3) | (((lane >> 2) & 3) << 6) | (((lane >> 4) & 1) << 5) | (((lane >> 5) & 1) << 8); }
constexpr int v_rd_off(int d0, int ks, int half) { return d0 * 512 + ks * 4096 + half * 2048; }
template <int OFF> DI s16x4 tr_read(int vb) { s16x4 r; asm volatile("ds_read_b64_tr_b16 %0, %1 offset:%2" : "=&v"(r) : "v"(vb), "i"(OFF) : "memory"); return r; }
template <int D0> DI void pv_one(f32x16& od, int vb, bf16x8 pa0, bf16x8 pa1, bf16x8 pa2, bf16x8 pa3) {
    const s16x4 l0 = tr_read<v_rd_off(D0, 0, 0)>(vb), h0 = tr_read<v_rd_off(D0, 0, 1)>(vb), l1 = tr_read<v_rd_off(D0, 1, 0)>(vb), h1 = tr_read<v_rd_off(D0, 1, 1)>(vb);
    const s16x4 l2 = tr_read<v_rd_off(D0, 2, 0)>(vb), h2 = tr_read<v_rd_off(D0, 2, 1)>(vb), l3 = tr_read<v_rd_off(D0, 3, 0)>(vb), h3 = tr_read<v_rd_off(D0, 3, 1)>(vb);
    asm volatile("s_waitcnt lgkmcnt(0)" ::: "memory"); SBAR();
#define PK(L, H) (bf16x8){L[0], L[1], L[2], L[3], H[0], H[1], H[2], H[3]}
    od = __builtin_amdgcn_mfma_f32_32x32x16_bf16(pa0, PK(l0, h0), od, 0, 0, 0);
    od = __builtin_amdgcn_mfma_f32_32x32x16_bf16(pa1, PK(l1, h1), od, 0, 0, 0);
    od = __builtin_amdgcn_mfma_f32_32x32x16_bf16(pa2, PK(l2, h2), od, 0, 0, 0);
    od = __builtin_amdgcn_mfma_f32_32x32x16_bf16(pa3, PK(l3, h3), od, 0, 0, 0);
#undef PK
}
DI void pv_d0(f32x16* o, int vb, bf16x8 pa0, bf16x8 pa1, bf16x8 pa2, bf16x8 pa3) {
    pv_one<0>(o[0], vb, pa0, pa1, pa2, pa3); pv_one<1>(o[1], vb, pa0, pa1, pa2, pa3); pv_one<2>(o[2], vb, pa0, pa1, pa2, pa3); pv_one<3>(o[3], vb, pa0, pa1, pa2, pa3);
}
DI void attn_body(const bf16_t* __restrict__ Qb, const bf16_t* __restrict__ Kh, const bf16_t* __restrict__ Vh, bf16_t* __restrict__ Ob, int seq, char* lds) {
    const int tid = tid_opq(), wid = tid >> 6, lane = tid & 63, r32 = lane & 31, hi = lane >> 5;
    char* V_lds = lds; char* K_lds = lds + 2 * SHM_V;
    float* wsf = (float*)(lds + 2 * SHM_V + 2 * SHM_K) + wid * 64; float* li_l = wsf; float* al_l = wsf + 32;
    float m_reg = -1e30f, l_reg = 0; f32x16 o[4]; bf16x8 qr[12];
#pragma unroll
    for (int d = 0; d < 4; ++d)
#pragma unroll
        for (int r = 0; r < 16; ++r) o[d][r] = 0.f;
    const bf16_t* Qw = Qb + (long)(wid * QBLK + r32) * LDQ + hi * 8;
#pragma unroll
    for (int d0 = 0; d0 < 12; ++d0) qr[d0] = *reinterpret_cast<const bf16x8*>(Qw + d0 * 16);
    const int sr = tid >> 4, sc = (tid & 15) * 8, vst0 = v_st(sr, sc), vst1 = v_st(32 + sr, sc);
    const int pr = tid >> 3, pc = 128 + (tid & 7) * 8;
    const int vb0 = (int)(uintptr_t)V_lds + v_rd_base(lane);
    bf16x8 vs0, vs1, ks0, ks1, kp;
#define SLOAD(k0) do { vs0 = *reinterpret_cast<const bf16x8*>(&Vh[(long)((k0) + sr) * LDV + sc]); vs1 = *reinterpret_cast<const bf16x8*>(&Vh[(long)((k0) + 32 + sr) * LDV + sc]); \
    ks0 = *reinterpret_cast<const bf16x8*>(&Kh[(long)((k0) + sr) * LDK + sc]); ks1 = *reinterpret_cast<const bf16x8*>(&Kh[(long)((k0) + 32 + sr) * LDK + sc]); \
    kp = *reinterpret_cast<const bf16x8*>(&Kh[(long)((k0) + pr) * LDK + pc]); } while (0)
#define SWRITE(b) do { *(bf16x8*)(V_lds + (b) * SHM_V + vst0) = vs0; *(bf16x8*)(V_lds + (b) * SHM_V + vst1) = vs1; \
    *(bf16x8*)(K_lds + (b) * SHM_K + KSWZ(sr, sc * 2)) = ks0; *(bf16x8*)(K_lds + (b) * SHM_K + KSWZ(32 + sr, sc * 2)) = ks1; \
    *(bf16x8*)(K_lds + (b) * SHM_K + KSWZ(pr, pc * 2)) = kp; } while (0)
#define RESC(a) do { if (__any((a) < 1.f)) { if (hi == 0) al_l[r32] = (a); asm volatile("s_waitcnt lgkmcnt(0)" ::: "memory"); \
    _Pragma("unroll") for (int d = 0; d < 4; ++d) _Pragma("unroll") for (int r = 0; r < 16; ++r) o[d][r] *= al_l[crow(r, hi)]; } } while (0)
    f32x16 p0, p1; float mn, al; bf16x8 pa0, pa1, pa2, pa3; const int NT = seq / KVBLK;
    SLOAD(0); asm volatile("s_waitcnt vmcnt(0)" ::: "memory"); SWRITE(0); __syncthreads();
    for (int j = 0; j < NT; ++j) {
        const int cb = j & 1;
        if (j + 1 < NT) SLOAD((j + 1) * KVBLK);
        SBAR(); qkt(p0, p1, K_lds + cb * SHM_K, qr, r32, hi);
        partialSM(p0, p1, m_reg, mn, al);
        finishSM(p0, p1, al, l_reg, pa0, pa1, pa2, pa3);
        RESC(al); SBAR();
        pv_d0(o, vb0 + cb * (int)SHM_V, pa0, pa1, pa2, pa3);
        if (j + 1 < NT) { asm volatile("s_waitcnt vmcnt(0)" ::: "memory"); SWRITE(cb ^ 1); }
        __syncthreads();
    }
    if (hi == 0) li_l[r32] = l_reg; asm volatile("s_waitcnt lgkmcnt(0)" ::: "memory");
    float rli[16];
#pragma unroll
    for (int r = 0; r < 16; ++r) rli[r] = __builtin_amdgcn_rcpf(li_l[crow(r, hi)]);
    bf16_t* Ow = Ob + (long)(wid * QBLK) * LDO;
#pragma unroll
    for (int r = 0; r < 16; ++r) { const int orow = crow(r, hi);
#pragma unroll
        for (int d0 = 0; d0 < 4; ++d0) Ow[(long)orow * LDO + d0 * 32 + r32] = f2bf(o[d0][r] * rli[r]); }
#undef SLOAD
#undef SWRITE
#undef RESC
}
#undef KSWZ
#undef SBAR
}

DI void attn_phase(const bf16_t* Q, const bf16_t* KB, const bf16_t* VB, bf16_t* O, char* lds) {
    for (int it = blockIdx.x; it < 2048 + 128; it += gridDim.x) {
        int b, h, qrow0, seq;
        if (it < 2048) { b = it >> 7; h = (it >> 4) & 7; qrow0 = b * SEQ + (it & 15) * 256; seq = KEYS; }
        else { const int j = it - 2048; b = j >> 3; h = j & 7; qrow0 = TL + b * CTXL; seq = CTXL; }
        att::attn_body(Q + (size_t)qrow0 * 1536 + h * 192, KB + (size_t)b * KEYS * 1536 + h * 192, VB + (size_t)b * KEYS * 1024 + h * 128,
                       O + (size_t)qrow0 * 1024 + h * 128, seq, lds);
        __syncthreads();
    }
}

DI void fixup_phase(const float* halo, const float* cw, const float* cb, bf16_t* act) {
    const int gtid = blockIdx.x * NTHREADS + tid_opq(), gstride = gridDim.x * NTHREADS;
    for (int idx = gtid; idx < 272 * 22 * 64; idx += gstride) {
        const int c4 = (idx & 31) * 4, which = (idx >> 5) & 1, t = idx >> 6, pn = t % 22, pm = t / 22;
        const float* hp = halo + (size_t)(pm * 22 + pn) * 4 * 256;
        const bool sfirst = pm >= 256 || (pm & 15) == 0, slast = pm >= 256 || (pm & 15) == 15;
        const f32x4 z4 = (f32x4){0.f, 0.f, 0.f, 0.f};
        f32x4 pa, pg, ca, cg_, na, ng; int row;
        if (which == 0) { row = pm * 256;
            if (sfirst) { pa = z4; pg = z4; } else { const float* q = halo + (size_t)((pm - 1) * 22 + pn) * 4 * 256 + 3 * 256; pa = *(const f32x4*)(q + c4); pg = *(const f32x4*)(q + 128 + c4); }
            ca = *(const f32x4*)(hp + c4); cg_ = *(const f32x4*)(hp + 128 + c4); na = *(const f32x4*)(hp + 256 + c4); ng = *(const f32x4*)(hp + 256 + 128 + c4);
        } else { row = pm * 256 + 255;
            pa = *(const f32x4*)(hp + 2 * 256 + c4); pg = *(const f32x4*)(hp + 2 * 256 + 128 + c4); ca = *(const f32x4*)(hp + 3 * 256 + c4); cg_ = *(const f32x4*)(hp + 3 * 256 + 128 + c4);
            if (slast) { na = z4; ng = z4; } else { const float* q = halo + (size_t)((pm + 1) * 22 + pn) * 4 * 256; na = *(const f32x4*)(q + c4); ng = *(const f32x4*)(q + 128 + c4); }
        }
        const int ch = pn * 128 + c4;
        const f32x4 w0a = *(const f32x4*)(cw + ch), w1a = *(const f32x4*)(cw + 5632 + ch), w2a = *(const f32x4*)(cw + 2 * 5632 + ch), ba = *(const f32x4*)(cb + ch);
        const f32x4 w0g = *(const f32x4*)(cw + 2816 + ch), w1g = *(const f32x4*)(cw + 5632 + 2816 + ch), w2g = *(const f32x4*)(cw + 2 * 5632 + 2816 + ch), bg = *(const f32x4*)(cb + 2816 + ch);
        const f32x4 av = w0a * pa + w1a * ca + w2a * na + ba, gv = w0g * pg + w1g * cg_ + w2g * ng + bg;
        u32x2 w; w.x = cvt_pk_bf16(silu_f(gv[0]) * av[0], silu_f(gv[1]) * av[1]); w.y = cvt_pk_bf16(silu_f(gv[2]) * av[2], silu_f(gv[3]) * av[3]);
        *(u32x2*)(act + (size_t)row * 2816 + ch) = w;
    }
}

__global__ void __launch_bounds__(NTHREADS) mega(Params p) {
    extern __shared__ __attribute__((aligned(16))) unsigned char smem[];
    LAS unsigned char* lds = (LAS unsigned char*)smem;
    cg::grid_group grid = cg::this_grid();

    for (int ph = p.ph_lo; ph < p.ph_hi; ++ph) {
        unsigned char* ws = (unsigned char*)p.in[opq(27)];
        float* const xout = (float*)p.in[opq(26)];
        float* mod = (float*)(ws + WS_MOD);
        float* xc = (float*)(ws + WS_XC);
        bf16_t* hbuf = (bf16_t*)(ws + WS_H);
        if (ph == 0) {
            prep_phase(p, lds);
#if defined(MK_DUP_OP) && MK_DUP_OP == 99
            grid.sync(); prep_phase(p, lds);
#endif
        } else {
            const int q = ph - 1, lp = q / 20; int r = q % 20; int layer, nmix;
            if (r < 9) { layer = 2 * lp; nmix = 5; } else { layer = 2 * lp + 1; r -= 9; nmix = 7; }
            const bool is_mla = layer & 1; const int j = layer >> 1;
            const float* modl = mod + (size_t)layer * 17 * 6144;
            const bool first = (layer == 0);
            int op = -1, gsel = 0, hf = 0;
            if (r < nmix) {
                if (!is_mla) { const int ops[5] = {0, 2, 3, 4, 2}; op = r == 0 ? 0 : r == 1 ? 2 : r == 2 ? 3 : r == 3 ? 4 : 2; (void)ops; gsel = r == 1 ? 0 : 1; }
                else { op = r == 0 ? 0 : r == 1 ? 2 : r == 2 ? 5 : r == 3 ? 2 : r == 4 ? 6 : r == 5 ? 7 : 2; gsel = r == 1 ? 2 : r == 3 ? 3 : 5; }
            } else {
                const int f = r - nmix;
                op = f == 0 ? 1 : f == 2 ? 8 : 2; gsel = f == 1 ? 6 : 7;
            }
#ifdef MK_DUP_OP
            for (int rep_ = 0; rep_ < ((op == MK_DUP_OP || (op == 2 && gsel == MK_DUP_OP - 100)) ? 2 : 1); ++rep_) {
            if (rep_) grid.sync();
#else
            {
#endif
            if (op == 0) {
                norm_phase(first ? p.in[opq(0)] : xout, first ? p.in[opq(2)] : xc, p.in[opq(6)] + layer * 1024, modl, 0, 1024, hbuf);
            } else if (op == 1) {
                norm_phase(xout, xc, p.in[opq(7)] + layer * 1024, modl, 3 * 1024, 4 * 1024, hbuf);
            } else if (op == 2) {
                const int ng = (gsel == 3) ? 2 : 1;
                for (int gi = 0; gi < ng; ++gi) {
                    pg8::Gemm g; Epi E; int kind = EPI_BF16;
                    E.ldc = 0; E.xch = (LAS float*)(lds + XCH_OFF); E.q0 = nullptr; E.q1 = nullptr; E.q2 = nullptr; E.q3 = nullptr; E.q4 = nullptr;
                    g.M = MR;
                    const int gs = gsel + gi;
                    if (gs == 0) { g.A = hbuf; g.Bt = (const bf16_t*)(ws + WS_GIN + j * SZ_GIN); g.N = 3328; g.K = 1024; g.lda = 1024; g.ldb = 1024;
                        kind = EPI_GLA_IN; E.q0 = ws + WS_QKVR; E.ldc = 3072; E.q1 = ws + WS_LR; }
                    else if (gs == 1 || gs == 5) { g.A = hbuf; g.Bt = (const bf16_t*)(ws + (gs == 1 ? WS_GOUT : WS_MOUT) + j * SZ_SQ); g.N = 1024; g.K = 1024; g.lda = 1024; g.ldb = 1024;
                        kind = EPI_RESID; E.q0 = (void*)(first ? p.in[opq(0)] : xout); E.q1 = (void*)(first ? p.in[opq(2)] : xc); E.q2 = xout; E.q3 = xc; E.q4 = (void*)(modl + 2 * 1024); }
                    else if (gs == 2) { g.A = hbuf; g.Bt = (const bf16_t*)(ws + WS_MDOWN + j * SZ_MDOWN); g.N = 768; g.K = 1024; g.lda = 1024; g.ldb = 1024;
                        E.q0 = ws + WS_DN; E.ldc = 768; }
                    else if (gs == 3) { g.A = (const bf16_t*)(ws + WS_CQN); g.Bt = (const bf16_t*)(ws + WS_MUQ + j * SZ_MUQ); g.N = 1536; g.K = 384; g.lda = 384; g.ldb = 384;
                        E.q0 = ws + WS_QRAW; E.ldc = 1536; }
                    else if (gs == 4) { g.A = (const bf16_t*)(ws + WS_CKVN); g.Bt = (const bf16_t*)(ws + WS_MUKV + j * SZ_MUKV); g.N = 2048; g.K = 256; g.lda = 256; g.ldb = 256;
                        kind = EPI_UKV; E.q0 = ws + WS_KB; E.q1 = ws + WS_VB; }
                    else if (gs == 6) { g.A = hbuf; g.Bt = (const bf16_t*)(ws + WS_FUP + (size_t)layer * SZ_FUP); g.N = 5632; g.K = 1024; g.lda = 1024; g.ldb = 1024;
                        kind = EPI_FFN_UP; E.q0 = ws + WS_ACT; E.ldc = 2816; E.q1 = (void*)(p.in[opq(23)] + (size_t)layer * 3 * 2 * DFF); E.q2 = (void*)(p.in[opq(24)] + (size_t)layer * 2 * DFF);
                        E.q3 = ws + WS_HALO; }
                    else { g.A = (const bf16_t*)(ws + WS_ACT); g.Bt = (const bf16_t*)(ws + WS_FDOWN + (size_t)layer * SZ_FDOWN); g.N = 1024; g.K = 2816; g.lda = 2816; g.ldb = 2816;
                        kind = EPI_RESID; E.q0 = xout; E.q1 = xc; E.q2 = xout; E.q3 = xc; E.q4 = (void*)(modl + 5 * 1024); }
                    pg8::StaticOrder S; S.init(g.M, g.N, (int)gridDim.x, (int)blockIdx.x);
                    if (kind == EPI_BF16) pg8::gemm_phase<Epi, EPI_BF16>(lds, g, S, E);
                    else if (kind == EPI_GLA_IN) pg8::gemm_phase<Epi, EPI_GLA_IN>(lds, g, S, E);
                    else if (kind == EPI_RESID) pg8::gemm_phase<Epi, EPI_RESID>(lds, g, S, E);
                    else if (kind == EPI_UKV) pg8::gemm_phase<Epi, EPI_UKV>(lds, g, S, E);
                    else pg8::gemm_phase<Epi, EPI_FFN_UP>(lds, g, S, E);
                    __syncthreads();
                }
            } else if (op == 3) {
                scan_phase((const bf16_t*)(ws + WS_QKVR), (const float*)(ws + WS_LR), p.in[opq(10)] + (size_t)j * 2 * 16 * 512, p.in[opq(11)] + (size_t)j * 2 * 512,
                           (bf16_t*)(ws + WS_OF), (bf16_t*)(ws + WS_OB), lds);
            } else if (op == 4) {
                glapost_phase((const bf16_t*)(ws + WS_OF), (const bf16_t*)(ws + WS_OB), (const bf16_t*)(ws + WS_QKVR), p.in[opq(12)] + j * 256, hbuf);
            } else if (op == 5) {
                mlamid_phase((const bf16_t*)(ws + WS_DN), p.in[opq(15)] + j * 384, p.in[opq(16)] + j * 256, p.in[opq(20)] + j * 192, (bf16_t*)(ws + WS_CQN), (bf16_t*)(ws + WS_CKVN), (bf16_t*)(ws + WS_KB));
            } else if (op == 6) {
                qkprep_phase((bf16_t*)(ws + WS_QRAW), (bf16_t*)(ws + WS_KB), p.in[opq(19)] + j * 192, p.in[opq(20)] + j * 192);
            } else if (op == 7) {
                attn_phase((const bf16_t*)(ws + WS_QRAW), (const bf16_t*)(ws + WS_KB), (const bf16_t*)(ws + WS_VB), hbuf, (char*)smem);
            } else if (op == 8) {
                fixup_phase((const float*)(ws + WS_HALO), p.in[opq(23)] + (size_t)layer * 3 * 2 * DFF, p.in[opq(24)] + (size_t)layer * 2 * DFF, (bf16_t*)(ws + WS_ACT));
            }
            }
        }
        if (ph + 1 < p.ph_hi) grid.sync();
    }
}

extern "C" void kernel_launch(void* const* d_in, const int* in_sizes, int n_in, void* d_out, int out_size, void* d_ws, size_t ws_size, hipStream_t stream) {
    static int grid = 0;
    if (grid == 0) {
        if (n_in != 26 || ws_size < WS_END) { fprintf(stderr, "kernel_launch: n_in %d ws %zu (need %zu)\n", n_in, ws_size, (size_t)WS_END); grid = -1; return; }
        int dev = 0, cus = 0, per_cu = 0;
        hipGetDevice(&dev);
        hipDeviceGetAttribute(&cus, hipDeviceAttributeMultiprocessorCount, dev);
        if (hipFuncSetAttribute((const void*)mega, hipFuncAttributeMaxDynamicSharedMemorySize, LDS_BYTES) != hipSuccess) { fprintf(stderr, "kernel_launch: hipFuncSetAttribute failed\n"); grid = -1; return; }
        if (hipOccupancyMaxActiveBlocksPerMultiprocessor(&per_cu, (const void*)mega, NTHREADS, LDS_BYTES) != hipSuccess || per_cu < 1) { fprintf(stderr, "kernel_launch: occupancy query %d\n", per_cu); per_cu = 1; }
        (void)hipGetLastError();
        grid = cus * per_cu;
        fprintf(stderr, "kernel_launch: grid %d (cus %d x %d)\n", grid, cus, per_cu);
    }
    if (grid < 0) return;
    Params p{};
    for (int i = 0; i < 26; ++i) p.in[i] = (const float*)d_in[i];
    p.in[26] = (const float*)d_out; p.in[27] = (const float*)d_ws;
#if MK_MULTI
    for (int ph = 0; ph < NPH; ++ph) {
        p.ph_lo = ph; p.ph_hi = ph + 1;
        hipLaunchKernelGGL(mega, dim3(grid), dim3(NTHREADS), LDS_BYTES, stream, p);
    }
#else
    p.ph_lo = 0; p.ph_hi = NPH;
    void* args[] = {&p};
    hipError_t e = hipLaunchCooperativeKernel((const void*)mega, dim3(grid), dim3(NTHREADS), args, LDS_BYTES, stream);
    if (e != hipSuccess) fprintf(stderr, "cooperative launch failed: %s (grid %d)\n", hipGetErrorString(e), grid);
#endif
}
```

```cpp
#include <hip/hip_runtime.h>
#include <hip/hip_cooperative_groups.h>
#include <cstdio>
#include <cstdint>
namespace cg = cooperative_groups;

#ifndef MK_MULTI
#define MK_MULTI 0
#endif

#define LAS __attribute__((address_space(3)))
#define DI __device__ __forceinline__
typedef unsigned short bf16_t;
typedef short bf16x8 __attribute__((ext_vector_type(8)));
typedef short s16x4 __attribute__((ext_vector_type(4)));
typedef float f32x2 __attribute__((ext_vector_type(2)));
typedef float f32x4 __attribute__((ext_vector_type(4)));
typedef float f32x16 __attribute__((ext_vector_type(16)));
typedef unsigned u32x2 __attribute__((ext_vector_type(2)));
typedef unsigned u32x4 __attribute__((ext_vector_type(4)));

constexpr int DM = 1024, NB = 16, SEQ = 4096, CTXL = 256;
constexpr int TL = NB * SEQ, TC = NB * CTXL, MR = TL + TC;
constexpr int KEYS = CTXL + SEQ;
constexpr int DFF = 2816, DFFH = 1408;
constexpr int NTHREADS = 512;
constexpr int LDS_BYTES = 131072 + 12288 + 2 * 5120 + 6144;
constexpr int WIMG_F = 3072, PREW_F = 3072 + 2 * 1280;
constexpr int XCH_OFF = 131072;
constexpr int NPH = 43;

constexpr size_t SZ_GIN = 3328ull * 1024 * 2, SZ_SQ = 1024ull * 1024 * 2, SZ_MDOWN = 768ull * 1024 * 2, SZ_MUQ = 1536ull * 384 * 2,
                 SZ_MUKV = 2048ull * 256 * 2, SZ_FUP = 5632ull * 1024 * 2, SZ_FDOWN = 1024ull * 2816 * 2;
constexpr size_t WS_GIN = 0;
constexpr size_t WS_GOUT = WS_GIN + 2 * SZ_GIN;
constexpr size_t WS_MDOWN = WS_GOUT + 2 * SZ_SQ;
constexpr size_t WS_MUQ = WS_MDOWN + 2 * SZ_MDOWN;
constexpr size_t WS_MUKV = WS_MUQ + 2 * SZ_MUQ;
constexpr size_t WS_MOUT = WS_MUKV + 2 * SZ_MUKV;
constexpr size_t WS_FUP = WS_MOUT + 2 * SZ_SQ;
constexpr size_t WS_FDOWN = WS_FUP + 4 * SZ_FUP;
constexpr size_t WS_MOD = WS_FDOWN + 4 * SZ_FDOWN;
constexpr size_t SZ_MOD = 4ull * 17 * 6144 * 4;
constexpr size_t WS_RS = WS_MOD + ((SZ_MOD + 255) / 256) * 256;
constexpr size_t WS_SHW = WS_RS + 2ull * MR * 4;
constexpr size_t WS_XC = WS_SHW + 4ull * 2 * 17 * 5632 * 4;
constexpr size_t WS_H = WS_XC + (size_t)TC * 1024 * 4;
constexpr size_t WS_R = WS_H + (size_t)MR * 1024 * 2;
constexpr size_t WS_QK = WS_R;
constexpr size_t WS_VR = WS_QK + (size_t)MR * 1024 * 2;
constexpr size_t WS_LR = WS_VR + (size_t)MR * 2048 * 2;
constexpr int NCHI = NB * 2 * 4 * 68;
constexpr size_t WS_GQ = WS_LR + (size_t)MR * 32 * 4;
constexpr size_t WS_GK = WS_GQ + (size_t)NCHI * 64 * 128 * 2;
constexpr size_t WS_GP = WS_GK + (size_t)NCHI * 64 * 128 * 2;
constexpr size_t WS_GE = WS_GP + (size_t)NCHI * 64 * 64 * 2;
constexpr size_t WS_GLA_END = WS_GE + (size_t)NCHI * 128 * 4;
constexpr size_t WS_QRAW = WS_R;
constexpr size_t WS_DN = WS_R;
constexpr size_t WS_CQN = WS_QRAW + (size_t)MR * 1536 * 2;
constexpr size_t WS_CKVN = WS_CQN + (size_t)MR * 384 * 2;
constexpr size_t WS_KB = WS_CKVN + (size_t)MR * 256 * 2;
constexpr size_t WS_VB = WS_KB + (size_t)NB * KEYS * 1536 * 2;
constexpr size_t WS_MLA_END = WS_VB + (size_t)NB * KEYS * 1024 * 2;
constexpr size_t WS_ACT = WS_R;
constexpr size_t WS_HALO = WS_ACT + (size_t)MR * 2816 * 2;
constexpr size_t WS_XSA = WS_HALO + 272ull * 22 * 4 * 256 * 4;
constexpr size_t WS_FFN_END = WS_XSA + (size_t)MR * 1024 * 2;
constexpr size_t WS_END = WS_GLA_END > WS_MLA_END ? (WS_GLA_END > WS_FFN_END ? WS_GLA_END : WS_FFN_END) : (WS_MLA_END > WS_FFN_END ? WS_MLA_END : WS_FFN_END);
static_assert(WS_END <= (1ull << 30), "workspace over 1 GiB");

struct Params { const float* in[28]; int ph_lo, ph_hi; };

DI unsigned cvt_pk_bf16(float lo, float hi) { unsigned r; asm("v_cvt_pk_bf16_f32 %0, %1, %2" : "=v"(r) : "v"(lo), "v"(hi)); return r; }
DI float bf_lo(unsigned u) { return __uint_as_float(u << 16); }
DI float bf_hi(unsigned u) { return __uint_as_float(u & 0xffff0000u); }
DI bf16_t f2bf(float f) { return (bf16_t)(cvt_pk_bf16(f, 0.f) & 0xffffu); }
DI float wave_sum(float v) {
#pragma unroll
    for (int o = 32; o >= 1; o >>= 1) v += __shfl_xor(v, o);
    return v;
}
DI float silu_f(float v) { return v * __builtin_amdgcn_rcpf(1.0f + __expf(-v)); }
DI int crow(int r, int hi) { return (r & 3) + 8 * (r >> 2) + 4 * hi; }
DI int tid_opq() { int t = threadIdx.x; asm volatile("" : "+v"(t)); return t; }
DI int opq(int i) { asm volatile("" : "+s"(i)); return i; }

namespace pg8 {
constexpr int BM = 256, BK = 64, HALF = 128, HTB = HALF * BK * 2, STAGE_BYTES = 8 * HTB, NXCD = 8, WGM = 8;
DI int lds_byte(int r, int c) { const int st = (r >> 4) * 2 + (c >> 5), rr = r & 15, cc = c & 31, ob = rr * 64 + cc * 2; return st * 1024 + (ob ^ (((ob >> 9) & 1) << 5)); }
DI void stage_rc(int b, int& R, int& C) { const int st = b / 1024, sb = b % 1024, swz = sb ^ (((sb >> 9) & 1) << 5); R = (st >> 1) * 16 + swz / 64; C = (st & 1) * 32 + (swz % 64) / 2; }
DI int perm32(int rho) { const int n = rho >> 4, i = rho & 15; return 8 * (i >> 2) + 4 * n + (i & 3); }
struct Unit { int pm, pn; };
struct Gemm { const bf16_t* A; const bf16_t* Bt; int M, N, K, lda, ldb; };
struct StaticOrder {
    int nM, nN, nwg, G, c;
    DI void init(int M, int N, int G_, int c_) { nM = M / BM; nN = N / BM; nwg = nM * nN; G = G_; c = c_; }
    DI bool next(int i, Unit& u) const {
        const long L = (long)i * G + c; if (L >= nwg) return false;
        int wgid = (int)L; { const int q = nwg / NXCD, r = nwg % NXCD, xcd = wgid % NXCD, off = wgid / NXCD; wgid = (xcd < r ? xcd * (q + 1) : r * (q + 1) + (xcd - r) * q) + off; }
        const int nig = WGM * nN, gid = wgid / nig, fm = gid * WGM, gsz = (nM - fm) < WGM ? (nM - fm) : WGM;
        u.pm = fm + ((wgid % nig) % gsz); u.pn = (wgid % nig) / gsz; return true;
    }
};

template <class Epi, int KIND>
DI void gemm_phase(LAS unsigned char* lds, const Gemm g, const StaticOrder& S, const Epi& E) {
    constexpr bool perm = Epi::template perm_of<KIND>();
    const int tid = tid_opq(), wid = __builtin_amdgcn_readfirstlane(tid >> 6), lane = tid & 63, wr = wid >> 2, wc = wid & 3, fr = lane & 15, fq = lane >> 4;
    const int K = g.K, nt = K / BK;
    unsigned voffA[2], voffB[2];
#pragma unroll
    for (int i = 0; i < 2; ++i) { int R, C; stage_rc(tid * 16 + i * 8192, R, C); const int Rb = perm ? ((R & ~31) + perm32(R & 31)) : R;
        voffA[i] = (unsigned)(R * g.lda + C) * 2u; voffB[i] = (unsigned)(Rb * g.ldb + C) * 2u; }
    const size_t kstep = (size_t)(BK * 2);
    const size_t hstepA = (size_t)HALF * g.lda * 2, hstepB = (size_t)HALF * g.ldb * 2;
    const size_t tstepA = 2 * hstepA, tstepB = 2 * hstepB;
    const unsigned ldsw = (unsigned)wid * 1024u;
    const int aoff = lds_byte(wr * 64 + fr, fq * 8), boff = lds_byte(wc * 32 + fr, fq * 8);
#define PG8_SA(b, h) (((b) * 2 + (h)) * HTB)
#define PG8_SB(b, h) ((4 + (b) * 2 + (h)) * HTB)
#define PG8_STAGE(bufoff, gbase, voff) do { _Pragma("unroll") for (int _i = 0; _i < 2; ++_i) \
        __builtin_amdgcn_global_load_lds((const unsigned*)((const char*)(gbase) + (voff)[_i]), (LAS unsigned*)(lds + (bufoff) + ldsw + _i * 8192), 16, 0, 0); } while (0)
#define PG8_LDA(dst, b, h) do { _Pragma("unroll") for (int m = 0; m < 4; ++m) _Pragma("unroll") for (int k = 0; k < 2; ++k) dst[m][k] = *(const LAS bf16x8*)(lds + PG8_SA(b, h) + aoff + m * 2048 + k * 1024); } while (0)
#define PG8_LDB(dst, b, h) do { _Pragma("unroll") for (int n = 0; n < 2; ++n) _Pragma("unroll") for (int k = 0; k < 2; ++k) dst[n][k] = *(const LAS bf16x8*)(lds + PG8_SB(b, h) + boff + n * 2048 + k * 1024); } while (0)
#define PG8_MMA(ai, bj, At, Bt) do { __builtin_amdgcn_s_setprio(1); _Pragma("unroll") for (int m = 0; m < 4; ++m) _Pragma("unroll") for (int n = 0; n < 2; ++n) _Pragma("unroll") for (int k = 0; k < 2; ++k) \
        acc[ai][bj][m][n] = __builtin_amdgcn_mfma_f32_16x16x32_bf16(Bt[n][k], At[m][k], acc[ai][bj][m][n], 0, 0, 0); __builtin_amdgcn_s_setprio(0); } while (0)
#define PG8_WAIT_V(n) asm volatile("s_waitcnt vmcnt(" #n ")" ::: "memory")
#define PG8_WAIT_L(n) asm volatile("s_waitcnt lgkmcnt(" #n ")" ::: "memory")
#define PG8_BAR __builtin_amdgcn_s_barrier()
#define PG8_SCHED __builtin_amdgcn_sched_barrier(0)
    Unit cur, nxt; int ui = 0;
    if (!S.next(0, cur)) return;
    f32x4 acc[2][2][4][2];
#pragma unroll
    for (int a = 0; a < 2; ++a)
#pragma unroll
        for (int b = 0; b < 2; ++b)
#pragma unroll
            for (int m = 0; m < 4; ++m)
#pragma unroll
                for (int n = 0; n < 2; ++n) acc[a][b][m][n] = (f32x4){0.f, 0.f, 0.f, 0.f};
    bf16x8 At[4][2], B0[2][2], B1[2][2];
    typename Epi::Pre pre;
    const char* cA = (const char*)g.A + (size_t)cur.pm * tstepA; const char* cB = (const char*)g.Bt + (size_t)cur.pn * tstepB;
    PG8_STAGE(PG8_SB(0, 0), cB, voffB); PG8_STAGE(PG8_SA(0, 0), cA, voffA); PG8_STAGE(PG8_SB(0, 1), cB + hstepB, voffB); PG8_STAGE(PG8_SA(0, 1), cA + hstepA, voffA);
    if (wr == 1) PG8_BAR;
    PG8_WAIT_V(4); PG8_BAR;
    PG8_STAGE(PG8_SB(1, 0), cB + kstep, voffB); PG8_STAGE(PG8_SA(1, 0), cA + kstep, voffA); PG8_STAGE(PG8_SB(1, 1), cB + hstepB + kstep, voffB);
    PG8_WAIT_V(6); PG8_BAR;
    for (;;) {
        const bool has_next = S.next(ui + 1, nxt);
        const char* nA = has_next ? (const char*)g.A + (size_t)nxt.pm * tstepA : cA; const char* nB = has_next ? (const char*)g.Bt + (size_t)nxt.pn * tstepB : cB;
        E.template prefetch<KIND>(pre, cur, wr, wc, fr, fq, ui & 1);
        for (int t = 0; t < nt; t += 2) {
            const bool last = (t == nt - 2);
            const char* a1 = cA + (size_t)(t + 1) * kstep;
            const char* a2 = last ? nA : cA + (size_t)(t + 2) * kstep; const char* b2 = last ? nB : cB + (size_t)(t + 2) * kstep;
            const char* a3 = a2 + kstep; const char* b3 = b2 + kstep;
            PG8_LDB(B0, 0, 0); PG8_SCHED; PG8_LDA(At, 0, 0); PG8_STAGE(PG8_SA(1, 1), a1 + hstepA, voffA);
            PG8_WAIT_L(8); PG8_BAR; PG8_WAIT_L(0); PG8_MMA(0, 0, At, B0); PG8_BAR; PG8_SCHED;
            PG8_LDB(B1, 0, 1); PG8_STAGE(PG8_SB(0, 0), b2, voffB);
            PG8_BAR; PG8_WAIT_L(0); PG8_MMA(0, 1, At, B1); PG8_BAR;
            PG8_LDA(At, 0, 1); PG8_STAGE(PG8_SA(0, 0), a2, voffA);
            PG8_BAR; PG8_WAIT_L(0); PG8_MMA(1, 0, At, B0); PG8_BAR; PG8_SCHED;
            PG8_STAGE(PG8_SB(0, 1), b2 + hstepB, voffB);
            PG8_WAIT_V(6); PG8_BAR; PG8_MMA(1, 1, At, B1); PG8_BAR;
            PG8_LDB(B0, 1, 0); PG8_SCHED; PG8_LDA(At, 1, 0); PG8_STAGE(PG8_SA(0, 1), a2 + hstepA, voffA);
            PG8_WAIT_L(8); PG8_BAR; PG8_WAIT_L(0); PG8_MMA(0, 0, At, B0); PG8_BAR; PG8_SCHED;
            PG8_LDB(B1, 1, 1); PG8_STAGE(PG8_SB(1, 0), b3, voffB);
            PG8_BAR; PG8_WAIT_L(0); PG8_MMA(0, 1, At, B1); PG8_BAR;
            PG8_LDA(At, 1, 1); PG8_STAGE(PG8_SA(1, 0), a3, voffA);
            PG8_BAR; PG8_WAIT_L(0); PG8_MMA(1, 0, At, B0); PG8_BAR; PG8_SCHED;
            PG8_STAGE(PG8_SB(1, 1), b3 + hstepB, voffB);
            PG8_WAIT_V(6); PG8_BAR; PG8_MMA(1, 1, At, B1); PG8_BAR;
        }
        E.template run<KIND>(acc, pre, cur, wr, wc, fr, fq, ui & 1);
        if (!has_next) break;
#pragma unroll
        for (int a = 0; a < 2; ++a)
#pragma unroll
            for (int b = 0; b < 2; ++b)
#pragma unroll
                for (int m = 0; m < 4; ++m)
#pragma unroll
                    for (int n = 0; n < 2; ++n) acc[a][b][m][n] = (f32x4){0.f, 0.f, 0.f, 0.f};
        cur = nxt; cA = nA; cB = nB; ++ui;
    }
    PG8_WAIT_V(0);
    if (wr == 0) PG8_BAR;
    PG8_BAR;
#undef PG8_SA
#undef PG8_SB
#undef PG8_STAGE
#undef PG8_LDA
#undef PG8_LDB
#undef PG8_MMA
#undef PG8_WAIT_V
#undef PG8_WAIT_L
#undef PG8_BAR
#undef PG8_SCHED
}
}

enum { EPI_BF16 = 0, EPI_GLA_IN = 1, EPI_RESID = 2, EPI_UKV = 3, EPI_FFN_UP = 4 };
DI float dpp_ror1(float v) { return __int_as_float(__builtin_amdgcn_update_dpp(0, __float_as_int(v), 0x121, 0xf, 0xf, false)); }
DI float dpp_ror15(float v) { return __int_as_float(__builtin_amdgcn_update_dpp(0, __float_as_int(v), 0x12F, 0xf, 0xf, false)); }
struct Epi {
    struct Pre { float rsv[2][4]; f32x4 sw[2][2]; f32x2 wl0, wl1; };
    int ldc; LAS float* xch;
    void* q0; void* q1; void* q2; void* q3; void* q4; void* q5;
    static DI f32x4 ror1_4(f32x4 v) { float a, b, c, d;
        asm volatile("s_nop 1\n\tv_mov_b32_dpp %0, %4 row_ror:1 row_mask:0xf bank_mask:0xf\n\tv_mov_b32_dpp %1, %5 row_ror:1 row_mask:0xf bank_mask:0xf\n\tv_mov_b32_dpp %2, %6 row_ror:1 row_mask:0xf bank_mask:0xf\n\tv_mov_b32_dpp %3, %7 row_ror:1 row_mask:0xf bank_mask:0xf"
                     : "=&v"(a), "=&v"(b), "=&v"(c), "=&v"(d) : "v"(v[0]), "v"(v[1]), "v"(v[2]), "v"(v[3]));
        return (f32x4){a, b, c, d}; }
    static DI f32x2 ror1_2(f32x2 v) { float a, b;
        asm volatile("s_nop 1\n\tv_mov_b32_dpp %0, %2 row_ror:1 row_mask:0xf bank_mask:0xf\n\tv_mov_b32_dpp %1, %3 row_ror:1 row_mask:0xf bank_mask:0xf" : "=&v"(a), "=&v"(b) : "v"(v[0]), "v"(v[1]));
        return (f32x2){a, b}; }
    static DI f32x2 ror15_2(f32x2 v) { float a, b;
        asm volatile("s_nop 1\n\tv_mov_b32_dpp %0, %2 row_ror:15 row_mask:0xf bank_mask:0xf\n\tv_mov_b32_dpp %1, %3 row_ror:15 row_mask:0xf bank_mask:0xf" : "=&v"(a), "=&v"(b) : "v"(v[0]), "v"(v[1]));
        return (f32x2){a, b}; }
    static DI f32x4 ror15_4(f32x4 v) { float a, b, c, d;
        asm volatile("s_nop 1\n\tv_mov_b32_dpp %0, %4 row_ror:15 row_mask:0xf bank_mask:0xf\n\tv_mov_b32_dpp %1, %5 row_ror:15 row_mask:0xf bank_mask:0xf\n\tv_mov_b32_dpp %2, %6 row_ror:15 row_mask:0xf bank_mask:0xf\n\tv_mov_b32_dpp %3, %7 row_ror:15 row_mask:0xf bank_mask:0xf"
                     : "=&v"(a), "=&v"(b), "=&v"(c), "=&v"(d) : "v"(v[0]), "v"(v[1]), "v"(v[2]), "v"(v[3]));
        return (f32x4){a, b, c, d}; }
    DI void ffn_up(const f32x4 (&acc)[2][2][4][2], const pg8::Unit& u, int wr, int wc, int fr, int fq, int par) const {
        bf16_t* O = (bf16_t*)q0; float* halo = (float*)q3;
        const int cl = wc * 32 + 8 * fq;
        float rstd[2][4];
        { const LAS float* pw = xch + PREW_F + (wr * 4 + wc) * 192;
#pragma unroll
          for (int g = 0; g < 8; ++g) rstd[g >> 2][g & 3] = rsqrtf(pw[g * 16 + fr] * (1.0f / 1024.0f) + 1e-6f); }
        const LAS float* wbuf = xch + WIMG_F + par * 1280;
#define XW(ST, TB, BJ, V0, V1) do { LAS float* xp_ = xch + ((((ST) + 1) * 2 + (TB)) * 2 + (BJ)) * 128 + cl; *(LAS f32x4*)xp_ = (V0); *(LAS f32x4*)(xp_ + 4) = (V1); } while (0)
#define TR(AI, BJ, M, N) (acc[AI][BJ][M][N] * rstd[AI][M])
        if (fr == 0) { XW(wr, 0, 0, TR(0, 0, 0, 0), TR(0, 0, 0, 1)); XW(wr, 0, 1, TR(0, 1, 0, 0), TR(0, 1, 0, 1)); XW(2 + wr, 0, 0, TR(1, 0, 0, 0), TR(1, 0, 0, 1)); XW(2 + wr, 0, 1, TR(1, 1, 0, 0), TR(1, 1, 0, 1)); }
        if (fr == 15) { XW(wr, 1, 0, TR(0, 0, 3, 0), TR(0, 0, 3, 1)); XW(wr, 1, 1, TR(0, 1, 3, 0), TR(0, 1, 3, 1)); XW(2 + wr, 1, 0, TR(1, 0, 3, 0), TR(1, 0, 3, 1)); XW(2 + wr, 1, 1, TR(1, 1, 3, 0), TR(1, 1, 3, 1)); }
        { const f32x4 zz = (f32x4){0.f, 0.f, 0.f, 0.f}; if (fr == 0 && wr == 0) { XW(-1, 1, 0, zz, zz); XW(-1, 1, 1, zz, zz); } if (fr == 15 && wr == 1) { XW(4, 0, 0, zz, zz); XW(4, 0, 1, zz, zz); } }
#undef XW
        asm volatile("s_waitcnt lgkmcnt(0)" ::: "memory"); __builtin_amdgcn_s_barrier(); asm volatile("" ::: "memory"); __builtin_amdgcn_s_barrier(); asm volatile("" ::: "memory");
        {
            float* hp = halo + (size_t)(u.pm * 22 + u.pn) * 4 * 256 + cl;
            const f32x4 sa0 = *(const LAS f32x4*)(wbuf + 512 + cl), sa1 = *(const LAS f32x4*)(wbuf + 512 + cl + 4), sg0 = *(const LAS f32x4*)(wbuf + 640 + 512 + cl), sg1 = *(const LAS f32x4*)(wbuf + 640 + 512 + cl + 4);
            if (wr == 0 && fr < 2) { float* h2 = hp + fr * 256; *(f32x4*)h2 = TR(0, 0, 0, 0) + sa0; *(f32x4*)(h2 + 4) = TR(0, 0, 0, 1) + sa1; *(f32x4*)(h2 + 128) = TR(0, 1, 0, 0) + sg0; *(f32x4*)(h2 + 132) = TR(0, 1, 0, 1) + sg1; }
            if (wr == 1 && fr >= 14) { float* h2 = hp + (fr - 12) * 256; *(f32x4*)h2 = TR(1, 0, 3, 0) + sa0; *(f32x4*)(h2 + 4) = TR(1, 0, 3, 1) + sa1; *(f32x4*)(h2 + 128) = TR(1, 1, 3, 0) + sg0; *(f32x4*)(h2 + 132) = TR(1, 1, 3, 1) + sg1; }
        }
#undef TR
        asm volatile("" ::: "memory");
        const int rowt = u.pm * 256 + wr * 64 + fr;
        const bool f0 = fr == 0, f15 = fr == 15;
        f32x2 sg[2][4][4];
#define SILU2(v) (f32x2){silu_f(v[0]), silu_f(v[1])}
#define H2(V, HH) __builtin_shufflevector(V, V, 2 * (HH), 2 * (HH) + 1)
#define CONV_GROUP(BJ, Q, AI, OP) do { \
            const int st = 2 * (AI) + wr; \
            const f32x2 pb = *(const LAS f32x2*)(xch + (((st) * 2 + 1) * 2 + (BJ)) * 128 + cl + 2 * (Q)) + sw; \
            const f32x2 nb = *(const LAS f32x2*)(xch + (((st + 2) * 2 + 0) * 2 + (BJ)) * 128 + cl + 2 * (Q)) + sw; \
            const f32x2 c0 = H2(acc[AI][BJ][0][(Q) >> 1], (Q) & 1) * rstd[AI][0] + sw, c1 = H2(acc[AI][BJ][1][(Q) >> 1], (Q) & 1) * rstd[AI][1] + sw, \
                        c2 = H2(acc[AI][BJ][2][(Q) >> 1], (Q) & 1) * rstd[AI][2] + sw, c3 = H2(acc[AI][BJ][3][(Q) >> 1], (Q) & 1) * rstd[AI][3] + sw; \
            const f32x2 R0 = ror1_2(c0), L0 = ror15_2(c0), L1 = ror15_2(c1); \
            { const f32x2 v = w0 * (f0 ? pb : R0) + w1 * c0 + w2 * (f15 ? L1 : L0) + bb; OP(sg[AI][0][Q], v); } \
            __builtin_amdgcn_sched_barrier(0); \
            const f32x2 R1 = ror1_2(c1), L2 = ror15_2(c2); \
            { const f32x2 v = w0 * (f0 ? R0 : R1) + w1 * c1 + w2 * (f15 ? L2 : L1) + bb; OP(sg[AI][1][Q], v); } \
            __builtin_amdgcn_sched_barrier(0); \
            const f32x2 R2 = ror1_2(c2), L3 = ror15_2(c3); \
            { const f32x2 v = w0 * (f0 ? R1 : R2) + w1 * c2 + w2 * (f15 ? L3 : L2) + bb; OP(sg[AI][2][Q], v); } \
            __builtin_amdgcn_sched_barrier(0); \
            const f32x2 R3 = ror1_2(c3); \
            { const f32x2 v = w0 * (f0 ? R2 : R3) + w1 * c3 + w2 * (f15 ? nb : L3) + bb; OP(sg[AI][3][Q], v); } \
            __builtin_amdgcn_sched_barrier(0); } while (0)
#define OP_G(dst, v) dst = SILU2(v)
#define OP_A(dst, v) dst *= v
#define CONV_W(BJ, Q) const LAS float* wp_ = wbuf + (BJ) * 640 + cl + 2 * (Q); \
            const f32x2 w0 = *(const LAS f32x2*)wp_, w1 = *(const LAS f32x2*)(wp_ + 128), w2 = *(const LAS f32x2*)(wp_ + 256), bb = *(const LAS f32x2*)(wp_ + 384), sw = *(const LAS f32x2*)(wp_ + 512);
        { CONV_W(1, 0) CONV_GROUP(1, 0, 0, OP_G); CONV_GROUP(1, 0, 1, OP_G); }
        { CONV_W(1, 1) CONV_GROUP(1, 1, 0, OP_G); CONV_GROUP(1, 1, 1, OP_G); }
        { CONV_W(1, 2) CONV_GROUP(1, 2, 0, OP_G); CONV_GROUP(1, 2, 1, OP_G); }
        { CONV_W(1, 3) CONV_GROUP(1, 3, 0, OP_G); CONV_GROUP(1, 3, 1, OP_G); }
        { CONV_W(0, 0) CONV_GROUP(0, 0, 0, OP_A); CONV_GROUP(0, 0, 1, OP_A); }
        { CONV_W(0, 1) CONV_GROUP(0, 1, 0, OP_A); CONV_GROUP(0, 1, 1, OP_A); }
        { CONV_W(0, 2) CONV_GROUP(0, 2, 0, OP_A); CONV_GROUP(0, 2, 1, OP_A); }
        { CONV_W(0, 3) CONV_GROUP(0, 3, 0, OP_A); CONV_GROUP(0, 3, 1, OP_A); }
#undef CONV_W
#undef CONV_GROUP
#undef OP_G
#undef OP_A
#undef SILU2
#undef H2
#define ST16(AI, MM) do { u32x4 w_; w_.x = cvt_pk_bf16(sg[AI][MM][0][0], sg[AI][MM][0][1]); w_.y = cvt_pk_bf16(sg[AI][MM][1][0], sg[AI][MM][1][1]); w_.z = cvt_pk_bf16(sg[AI][MM][2][0], sg[AI][MM][2][1]); w_.w = cvt_pk_bf16(sg[AI][MM][3][0], sg[AI][MM][3][1]); \
            *(u32x4*)(O + (size_t)(rowt + (AI) * 128 + (MM) * 16) * 2816 + u.pn * 128 + cl) = w_; } while (0)
        ST16(0, 0); ST16(0, 1); ST16(0, 2); ST16(0, 3); ST16(1, 0); ST16(1, 1); ST16(1, 2); ST16(1, 3);
#undef ST16
    }
    template <int K> static constexpr bool perm_of() { return K != EPI_RESID; }
    template <int kind> DI void prefetch(Pre& P, const pg8::Unit& u, int wr, int wc, int fr, int fq, int par) const {
        (void)P;
        if constexpr (kind == EPI_GLA_IN || kind == EPI_BF16 || kind == EPI_FFN_UP) {
            const float* rsb = (const float*)(kind == EPI_FFN_UP ? q4 : q3);
            if (rsb) {
                LAS float* pw = xch + PREW_F + (wr * 4 + wc) * 192;
                const int bidx = u.pm < 256 ? (u.pm >> 4) : 16;
                if (fq == 0) {
                    const float* rsp = rsb + u.pm * 256 + wr * 64 + fr;
#pragma unroll
                    for (int g = 0; g < 8; ++g) __builtin_amdgcn_global_load_lds((const unsigned*)(rsp + (g >> 2) * 128 + (g & 3) * 16), (LAS unsigned*)(pw + g * 16), 4, 0, 0);
                    if constexpr (kind != EPI_FFN_UP) {
                        const float* sw = (const float*)q4 + (size_t)bidx * 5632 + u.pn * 256 + (fr >> 3) * 128 + wc * 32 + (fr & 7) * 4;
                        __builtin_amdgcn_global_load_lds((const unsigned*)sw, (LAS unsigned*)(pw + 128), 16, 0, 0);
                    }
                }
                if constexpr (kind == EPI_FFN_UP) {
                    const int wid = wr * 4 + wc;
                    if (wid < 5) {
                        const float* cw = (const float*)q1; const float* cb = (const float*)q2; const float* shw = (const float*)q5 + (size_t)bidx * 5632 + u.pn * 256;
                        const int i4 = (wid * 64 + fq * 16 + fr) * 4, bjw = i4 / 640, rem = i4 % 640, kw = rem >> 7, c_ = rem & 127;
                        const float* srcw = kw < 3 ? cw + kw * 5632 + bjw * 2816 + u.pn * 128 + c_ : kw == 3 ? cb + bjw * 2816 + u.pn * 128 + c_ : shw + bjw * 128 + c_;
                        __builtin_amdgcn_global_load_lds((const unsigned*)srcw, (LAS unsigned*)(xch + WIMG_F + par * 1280 + wid * 256), 16, 0, 0);
                    }
                }
            }
        }
    }
    template <int kind> DI void run(const f32x4 (&acc)[2][2][4][2], const Pre& P, const pg8::Unit& u, int wr, int wc, int fr, int fq, int par) const {
        asm volatile("" : "+v"(fr), "+v"(fq));
        if constexpr (kind == EPI_FFN_UP) { ffn_up(acc, u, wr, wc, fr, fq, par); return; }
        if constexpr (kind == EPI_RESID) {
            const float* base_l = (const float*)q0; const float* base_c = (const float*)q1; float* out_l = (float*)q2; unsigned char* wsb = (unsigned char*)q3; float* out_c = (float*)(wsb + WS_XC);
            const float* modl = (const float*)q4; const float* gnext = (const float*)q5;
            const int bidx = u.pm < 256 ? (u.pm >> 4) : 16;
            const float* gv = modl + (size_t)bidx * 6144 + (ldc ? 5 * 1024 : 2 * 1024);
            const float* bp = u.pm < 256 ? base_l + (size_t)u.pm * 256 * 1024 : base_c + (size_t)(u.pm - 256) * 256 * 1024;
            float* op = u.pm < 256 ? out_l + (size_t)u.pm * 256 * 1024 : out_c + (size_t)(u.pm - 256) * 256 * 1024;
            const int col0 = u.pn * 256 + wc * 32 + 4 * fq;
            f32x4 gt[2][2], gn[2][2];
#pragma unroll
            for (int bj = 0; bj < 2; ++bj)
#pragma unroll
                for (int n = 0; n < 2; ++n) gt[bj][n] = *(const f32x4*)(gv + col0 + bj * 128 + n * 16);
            if (gnext) {
                const float* scn = ldc ? modl + (size_t)(17 + bidx) * 6144 + 1024 : modl + (size_t)bidx * 6144 + 4 * 1024;
#pragma unroll
                for (int bj = 0; bj < 2; ++bj)
#pragma unroll
                    for (int n = 0; n < 2; ++n) gn[bj][n] = *(const f32x4*)(gnext + col0 + bj * 128 + n * 16) * (*(const f32x4*)(scn + col0 + bj * 128 + n * 16) + 1.0f);
            }
            bf16_t* xs = (bf16_t*)(wsb + (ldc ? WS_H : WS_XSA)) + (size_t)u.pm * 256 * 1024;
            float* rs = (float*)(wsb + WS_RS) + (ldc ? MR : 0) + u.pm * 256;
#pragma unroll
            for (int ai = 0; ai < 2; ++ai)
#pragma unroll
                for (int m = 0; m < 4; ++m) {
                    const int rl = ai * 128 + wr * 64 + m * 16 + fr;
                    const size_t off = (size_t)rl * 1024 + col0;
                    float ssq = 0.f;
#pragma unroll
                    for (int bj = 0; bj < 2; ++bj)
#pragma unroll
                        for (int n = 0; n < 2; ++n) {
                            const f32x4 bs = *(const f32x4*)(bp + off + bj * 128 + n * 16);
                            const f32x4 xn = bs + gt[bj][n] * acc[ai][bj][m][n];
                            *(f32x4*)(op + off + bj * 128 + n * 16) = xn;
                            if (gnext) {
                                ssq += xn[0] * xn[0] + xn[1] * xn[1] + xn[2] * xn[2] + xn[3] * xn[3];
                                const f32x4 y = xn * gn[bj][n];
                                u32x2 w; w.x = cvt_pk_bf16(y[0], y[1]); w.y = cvt_pk_bf16(y[2], y[3]);
                                *(u32x2*)(xs + off + bj * 128 + n * 16) = w;
                            }
                        }
                    if (gnext) {
                        ssq += __shfl_xor(ssq, 16); ssq += __shfl_xor(ssq, 32);
                        if (fq == 0) unsafeAtomicAdd(rs + rl, ssq);
                    }
                }
            return;
        } else {
        bf16_t* O = (bf16_t*)q0; float* lr = (float*)q1; bf16_t* KB = (bf16_t*)q0; bf16_t* VB = (bf16_t*)q1;
        const int rowt = u.pm * 256 + wr * 64 + fr;
        f32x4 swv[2][2]; float rsv[2][4];
        if constexpr (kind == EPI_GLA_IN || kind == EPI_BF16) {
            if (q3) { const LAS float* pw = xch + PREW_F + (wr * 4 + wc) * 192;
#pragma unroll
                for (int g = 0; g < 8; ++g) rsv[g >> 2][g & 3] = pw[g * 16 + fr];
#pragma unroll
                for (int bj = 0; bj < 2; ++bj) { swv[bj][0] = *(const LAS f32x4*)(pw + 128 + bj * 32 + 8 * fq); swv[bj][1] = *(const LAS f32x4*)(pw + 128 + bj * 32 + 8 * fq + 4); } }
        }
#pragma unroll
        for (int ai = 0; ai < 2; ++ai)
#pragma unroll
            for (int m = 0; m < 4; ++m) {
                const int row = rowt + ai * 128 + m * 16;
#pragma unroll
                for (int bj = 0; bj < 2; ++bj) {
                    f32x4 v0 = acc[ai][bj][m][0], v1 = acc[ai][bj][m][1];
                    const int cin = bj * 128 + wc * 32 + 8 * fq;
                    if constexpr (kind == EPI_GLA_IN || kind == EPI_BF16) {
                        if (q3) {
                            const float rstd = rsqrtf(rsv[ai][m] * (1.0f / 1024.0f) + 1e-6f);
                            v0 = v0 * rstd + swv[bj][0]; v1 = v1 * rstd + swv[bj][1];
                        }
                    }
                    if constexpr (kind == EPI_GLA_IN) {
                        if (u.pn == 12) {
                            if (bj == 0 && wc == 0) { float* lp = lr + (size_t)row * 32 + 8 * fq; *(f32x4*)lp = v0; *(f32x4*)(lp + 4) = v1; }
                            continue;
                        }
                        if (u.pn < 2) { v0 *= 0.08838834764831845f; v1 *= 0.08838834764831845f; }
                    }
                    u32x4 w; w.x = cvt_pk_bf16(v0[0], v0[1]); w.y = cvt_pk_bf16(v0[2], v0[3]); w.z = cvt_pk_bf16(v1[0], v1[1]); w.w = cvt_pk_bf16(v1[2], v1[3]);
                    if constexpr (kind == EPI_GLA_IN) {
                        if (u.pn < 4) *(u32x4*)(O + (size_t)row * 1024 + u.pn * 256 + cin) = w;
                        else *(u32x4*)((bf16_t*)q2 + (size_t)row * 2048 + (u.pn - 4) * 256 + cin) = w;
                    } else if constexpr (kind == EPI_UKV) {
                        int key;
                        if (u.pm < 256) { const int b = u.pm >> 4; key = b * KEYS + CTXL + (row - b * SEQ); }
                        else { const int b = u.pm - 256; key = b * KEYS + (row - TL - b * CTXL); }
                        const int cc = wc * 32 + 8 * fq;
                        if (bj == 0) *(u32x4*)(KB + (size_t)key * 1536 + u.pn * 192 + cc) = w;
                        else *(u32x4*)(VB + (size_t)key * 1024 + u.pn * 128 + cc) = w;
                    } else {
                        *(u32x4*)(O + (size_t)row * ldc + u.pn * 256 + cin) = w;
                    }
                }
            }
        }
    }
};

DI void prep_phase(const Params& p, LAS unsigned char* lds) {
    const int tid = tid_opq();
    unsigned char* ws = (unsigned char*)p.in[opq(27)];
    LAS float* tl = (LAS float*)lds;
    const float* in_c = p.in[opq(1)]; const float* in_cctx = p.in[opq(3)]; const float* in_wada = p.in[opq(4)]; const float* in_bada = p.in[opq(5)];
    const float* in_gin = p.in[opq(8)]; const float* in_w1 = p.in[opq(9)]; const float* in_gout = p.in[opq(13)]; const float* in_mdown = p.in[opq(14)];
    const float* in_uq = p.in[opq(17)]; const float* in_ukv = p.in[opq(18)]; const float* in_mout = p.in[opq(21)]; const float* in_fup = p.in[opq(22)]; const float* in_fdown = p.in[opq(25)];
    constexpr int T0 = 1536, T2 = 512, T3 = 352, T4 = 288, T5 = 256, T6 = 512, T7 = 5632, T8 = 2816;
    constexpr int NTILE = T0 + T2 + T3 + T4 + T5 + T6 + T7 + T8;
    for (int t = blockIdx.x; t < NTILE; t += gridDim.x) {
        const float* src; int N, k0, n0, ld; bf16_t* dst;
        int q = t;
        if (q < T0) { const int j = q / 768, r = q % 768, kt = r / 48, nt = r % 48; src = in_gin + (size_t)j * 1024 * 3072; N = 3072; k0 = kt * 64; n0 = nt * 64;
            dst = (bf16_t*)(ws + WS_GIN + j * SZ_GIN) + (size_t)n0 * 1024 + k0; ld = 1024; }
        else if ((q -= T0) < T2) { const int j = q / 256, r = q % 256, kt = r / 16, nt = r % 16; src = in_gout + (size_t)j * 1024 * 1024; N = 1024; k0 = kt * 64; n0 = nt * 64;
            dst = (bf16_t*)(ws + WS_GOUT + j * SZ_SQ) + (size_t)n0 * 1024 + k0; ld = 1024; }
        else if ((q -= T2) < T3) { const int j = q / 176, r = q % 176, kt = r / 11, nt = r % 11; src = in_mdown + (size_t)j * 1024 * 704; N = 704; k0 = kt * 64; n0 = nt * 64;
            dst = (bf16_t*)(ws + WS_MDOWN + j * SZ_MDOWN) + (size_t)n0 * 1024 + k0; ld = 1024; }
        else if ((q -= T3) < T4) { const int j = q / 144, r = q % 144, kt = r / 24, nt = r % 24; src = in_uq + (size_t)j * 384 * 1536; N = 1536; k0 = kt * 64; n0 = nt * 64;
            dst = (bf16_t*)(ws + WS_MUQ + j * SZ_MUQ) + (size_t)n0 * 384 + k0; ld = 384; }
        else if ((q -= T4) < T5) { const int j = q / 128, r = q % 128, kt = r / 32, nt = r % 32; src = in_ukv + (size_t)j * 256 * 2048; N = 2048; k0 = kt * 64; n0 = nt * 64;
            dst = (bf16_t*)(ws + WS_MUKV + j * SZ_MUKV) + (size_t)n0 * 256 + k0; ld = 256; }
        else if ((q -= T5) < T6) { const int j = q / 256, r = q % 256, kt = r / 16, nt = r % 16; src = in_mout + (size_t)j * 1024 * 1024; N = 1024; k0 = kt * 64; n0 = nt * 64;
            dst = (bf16_t*)(ws + WS_MOUT + j * SZ_SQ) + (size_t)n0 * 1024 + k0; ld = 1024; }
        else if ((q -= T6) < T7) { const int i = q / 1408, r = q % 1408, kt = r / 88, nt = r % 88; src = in_fup + (size_t)i * 1024 * 5632; N = 5632; k0 = kt * 64; n0 = nt * 64;
            const int isg = n0 >= DFF ? 1 : 0, cc = n0 - isg * DFF, drow = (cc >> 7) * 256 + isg * 128 + (cc & 127);
            dst = (bf16_t*)(ws + WS_FUP + (size_t)i * SZ_FUP) + (size_t)drow * 1024 + k0; ld = 1024; }
        else { q -= T7; const int i = q / 704, r = q % 704, kt = r / 16, nt = r % 16; src = in_fdown + (size_t)i * 2816 * 1024; N = 1024; k0 = kt * 64; n0 = nt * 64;
            dst = (bf16_t*)(ws + WS_FDOWN + (size_t)i * SZ_FDOWN) + (size_t)n0 * 2816 + k0; ld = 2816; }
#pragma unroll
        for (int i = 0; i < 8; ++i) { const int r = (tid >> 6) + 8 * i, c = tid & 63; tl[c * 65 + r] = src[(size_t)(k0 + r) * N + n0 + c]; }
        __syncthreads();
#pragma unroll
        for (int i = 0; i < 4; ++i) { const int rr = (tid >> 5) + 16 * i, c2 = (tid & 31) * 2; const float a = tl[rr * 65 + c2], b = tl[rr * 65 + c2 + 1];
            *(unsigned*)(dst + (size_t)rr * ld + c2) = cvt_pk_bf16(a, b); }
        __syncthreads();
    }
    const int gtid = blockIdx.x * NTHREADS + tid, gstride = gridDim.x * NTHREADS;
    for (int idx = gtid; idx < 65536; idx += gstride) {
        const int k = idx & 1023, r = (idx >> 10) & 15, dir = (idx >> 14) & 1, j = idx >> 15;
        const float v = in_w1[((size_t)(j * 2 + dir) * 1024 + k) * 16 + r];
        ((bf16_t*)(ws + WS_GIN + j * SZ_GIN))[(size_t)(3072 + dir * 16 + r) * 1024 + k] = f2bf(v);
    }
    for (int idx = gtid; idx < 2 * 114688; idx += gstride) { const int j = idx / 114688, o = idx % 114688; ((unsigned*)(ws + WS_GIN + j * SZ_GIN + 3104ull * 1024 * 2))[o] = 0u; }
    for (int idx = gtid; idx < 2 * 32768; idx += gstride) { const int j = idx / 32768, o = idx % 32768; ((unsigned*)(ws + WS_MDOWN + j * SZ_MDOWN + 704ull * 1024 * 2))[o] = 0u; }
    for (int idx = gtid; idx < MR; idx += gstride) ((float*)(ws + WS_RS))[idx] = 0.f;
    LAS float* sl = (LAS float*)lds;
    LAS float* red = (LAS float*)(lds + 81920);
    __syncthreads();
    for (int idx = tid; idx < 17 * 1024; idx += NTHREADS) { const int r = idx >> 10, k = idx & 1023; const float v = r < 16 ? in_c[r * 1024 + k] : in_cctx[k]; sl[k * 20 + r] = v / (1.0f + __expf(-v)); }
    __syncthreads();
    float* mod = (float*)(ws + WS_MOD);
    for (int it = blockIdx.x; it < 384; it += gridDim.x) {
        const int layer = it / 96, n0 = (it % 96) * 64, nn = tid & 63, ks = tid >> 6;
        const float* W = in_wada + (size_t)layer * 1024 * 6144 + n0 + nn;
        float acc[17];
#pragma unroll
        for (int r = 0; r < 17; ++r) acc[r] = 0.f;
        for (int kk = 0; kk < 128; ++kk) {
            const int k = ks * 128 + kk; const float w = W[(size_t)k * 6144];
            const f32x4 s0 = *(const LAS f32x4*)(sl + k * 20), s1 = *(const LAS f32x4*)(sl + k * 20 + 4), s2 = *(const LAS f32x4*)(sl + k * 20 + 8), s3 = *(const LAS f32x4*)(sl + k * 20 + 12);
            const float s16 = sl[k * 20 + 16];
#pragma unroll
            for (int j = 0; j < 4; ++j) { acc[j] += s0[j] * w; acc[4 + j] += s1[j] * w; acc[8 + j] += s2[j] * w; acc[12 + j] += s3[j] * w; }
            acc[16] += s16 * w;
        }
#pragma unroll
        for (int r = 0; r < 17; ++r) red[(ks * 17 + r) * 64 + nn] = acc[r];
        __syncthreads();
        for (int o = tid; o < 17 * 64; o += NTHREADS) { const int r = o >> 6, c = o & 63; float s = in_bada[layer * 6144 + n0 + c];
#pragma unroll
            for (int k8 = 0; k8 < 8; ++k8) s += red[(k8 * 17 + r) * 64 + c];
            mod[(size_t)(layer * 17 + r) * 6144 + n0 + c] = s; }
        __syncthreads();
    }
}

DI void shw_phase(unsigned char* ws, LAS unsigned char* lds) {
    const int tid = tid_opq(), wave = tid >> 6, lane = tid & 63;
    LAS float* sl = (LAS float*)lds;
    const float* mod = (const float*)(ws + WS_MOD);
    constexpr int NCH = 4 * 44 + 6 + 26 + 6;
    for (int ch = blockIdx.x; ch < NCH; ch += gridDim.x) {
        int layer, kind, n0; const bf16_t* Bt;
        if (ch < 176) { layer = ch / 44; kind = 1; n0 = (ch % 44) * 128; Bt = (const bf16_t*)(ws + WS_FUP + (size_t)layer * SZ_FUP); }
        else if (ch < 182) { layer = 1; kind = 0; n0 = (ch - 176) * 128; Bt = (const bf16_t*)(ws + WS_MDOWN); }
        else if (ch < 208) { layer = 2; kind = 0; n0 = (ch - 182) * 128; Bt = (const bf16_t*)(ws + WS_GIN + SZ_GIN); }
        else { layer = 3; kind = 0; n0 = (ch - 208) * 128; Bt = (const bf16_t*)(ws + WS_MDOWN + SZ_MDOWN); }
        __syncthreads();
        for (int idx = tid; idx < 17 * 256; idx += NTHREADS) { const int b = idx >> 8, k4 = (idx & 255) * 4;
            *(LAS f32x4*)(sl + b * 1024 + k4) = *(const f32x4*)(mod + (size_t)(layer * 17 + b) * 6144 + (kind ? 3 * 1024 : 0) + k4); }
        __syncthreads();
        float* out = (float*)(ws + WS_SHW) + (size_t)((layer * 2 + kind) * 17) * 5632;
#pragma unroll 1
        for (int i = 0; i < 16; ++i) {
            const int n = n0 + wave * 16 + i;
            float w[16];
#pragma unroll
            for (int j = 0; j < 4; ++j) { const u32x2 t = *(const u32x2*)(Bt + (size_t)n * 1024 + j * 256 + lane * 4); w[4 * j] = bf_lo(t.x); w[4 * j + 1] = bf_hi(t.x); w[4 * j + 2] = bf_lo(t.y); w[4 * j + 3] = bf_hi(t.y); }
            float mine = 0.f;
#pragma unroll 1
            for (int b = 0; b < 17; ++b) {
                float a = 0.f;
#pragma unroll
                for (int j = 0; j < 4; ++j) { const f32x4 sv = *(const LAS f32x4*)(sl + b * 1024 + j * 256 + lane * 4); a += sv[0] * w[4 * j] + sv[1] * w[4 * j + 1] + sv[2] * w[4 * j + 2] + sv[3] * w[4 * j + 3]; }
                a = wave_sum(a);
                if (lane == b) mine = a;
            }
            if (lane < 17) out[(size_t)lane * 5632 + n] = mine;
        }
    }
    __syncthreads();
}

DI void norm_phase(const float* xl, const float* xc, const float* gain, const float* modl, int sh_off, int sc_off, bf16_t* h) {
    const int tid = tid_opq(), wave = tid >> 6, lane = tid & 63;
    for (int row0 = (blockIdx.x * 8 + wave) * 4; row0 < MR; row0 += gridDim.x * 32) {
        const float* src = row0 < TL ? xl + (size_t)row0 * 1024 : xc + (size_t)(row0 - TL) * 1024;
        const float* mb = modl + (size_t)(row0 < TL ? (row0 >> 12) : 16) * 6144;
        f32x4 v[4][4]; float ss[4];
#pragma unroll
        for (int r = 0; r < 4; ++r)
#pragma unroll
            for (int i = 0; i < 4; ++i) v[r][i] = *(const f32x4*)(src + (size_t)r * 1024 + i * 256 + lane * 4);
#pragma unroll
        for (int r = 0; r < 4; ++r) { float t = 0.f;
#pragma unroll
            for (int i = 0; i < 4; ++i) t += v[r][i][0] * v[r][i][0] + v[r][i][1] * v[r][i][1] + v[r][i][2] * v[r][i][2] + v[r][i][3] * v[r][i][3];
            ss[r] = t; }
#pragma unroll
        for (int o = 32; o >= 1; o >>= 1) {
#pragma unroll
            for (int r = 0; r < 4; ++r) ss[r] += __shfl_xor(ss[r], o);
        }
#pragma unroll
        for (int i = 0; i < 4; ++i) {
            const int c = i * 256 + lane * 4;
            const f32x4 g = *(const f32x4*)(gain + c), sc = *(const f32x4*)(mb + sc_off + c), sh = *(const f32x4*)(mb + sh_off + c);
            const f32x4 gs = g * (sc + 1.0f);
#pragma unroll
            for (int r = 0; r < 4; ++r) {
                const float rstd = rsqrtf(ss[r] * (1.0f / 1024.0f) + 1e-6f);
                const f32x4 y = (v[r][i] * rstd) * gs + sh;
                u32x2 w; w.x = cvt_pk_bf16(y[0], y[1]); w.y = cvt_pk_bf16(y[2], y[3]);
                *(u32x2*)(h + (size_t)(row0 + r) * 1024 + c) = w;
            }
        }
    }
}

DI void scan_rowbase(int dir, int b, int c, int& rb, int& sg) {
    if (dir == 0) { sg = 1; rb = c < 4 ? TL + b * CTXL + c * 64 : b * SEQ + (c - 4) * 64; }
    else { sg = -1; rb = c < 4 ? TL + b * CTXL + 255 - c * 64 : b * SEQ + 4095 - (c - 4) * 64; }
}
struct GPStage { unsigned qv[8], kv[8]; f32x4 lrv; float w2r[16][2]; f32x2 gbias; };
DI void gp_load(GPStage& S, int item, const bf16_t* qk, const float* lr, const float* w2, const float* gb, int tid, int wave, int d0) {
    const int c = item % 68, rest = item / 68, h = rest & 3, dir = (rest >> 2) & 1, b = rest >> 3;
    int rowbase, sgn; scan_rowbase(dir, b, c, rowbase, sgn);
#pragma unroll
    for (int i = 0; i < 8; ++i) { const size_t ro = (size_t)(rowbase + sgn * (wave * 8 + i)) * 1024; S.qv[i] = *(const unsigned*)(qk + ro + h * 128 + d0); S.kv[i] = *(const unsigned*)(qk + ro + 512 + h * 128 + d0); }
    S.lrv = (f32x4){0.f, 0.f, 0.f, 0.f};
    if (tid < 256) S.lrv = *(const f32x4*)(lr + (size_t)(rowbase + sgn * (tid >> 2)) * 32 + dir * 16 + (tid & 3) * 4);
#pragma unroll
    for (int r = 0; r < 16; ++r) { const f32x2 t = *(const f32x2*)(w2 + (size_t)(dir * 16 + r) * 512 + h * 128 + d0); S.w2r[r][0] = t.x; S.w2r[r][1] = t.y; }
    S.gbias = *(const f32x2*)(gb + dir * 512 + h * 128 + d0);
}
DI void gp_item(const GPStage& S, int item, bf16_t* GQ, bf16_t* GK, bf16_t* GP, float* GE, LAS unsigned char* lds, int tid, int wave, int lane) {
    constexpr int QD = 0, KI = 17408, LRS = 34816, SEG = 38912;
    const int l15 = lane & 15, lq = lane >> 4, d0 = 2 * lane;
    if (tid < 256) *(LAS f32x4*)(lds + LRS + (tid >> 2) * 64 + (tid & 3) * 16) = S.lrv;
    __syncthreads();
    const LAS float* lrs = (const LAS float*)(lds + LRS);
    float bl0[8], bl1[8]; float cum0 = 0.f, cum1 = 0.f;
#pragma unroll
    for (int i = 0; i < 8; ++i) {
        const int s = wave * 8 + i;
        float z0 = S.gbias.x, z1 = S.gbias.y;
#pragma unroll
        for (int r4 = 0; r4 < 4; ++r4) { const f32x4 lv = *(const LAS f32x4*)(lrs + s * 16 + r4 * 4);
#pragma unroll
            for (int j = 0; j < 4; ++j) { z0 += lv[j] * S.w2r[r4 * 4 + j][0]; z1 += lv[j] * S.w2r[r4 * 4 + j][1]; } }
        const float g0 = (fminf(z0, 0.f) - __logf(1.0f + __expf(-fabsf(z0)))) * 0.0625f;
        const float g1 = (fminf(z1, 0.f) - __logf(1.0f + __expf(-fabsf(z1)))) * 0.0625f;
        cum0 += g0; cum1 += g1; bl0[i] = cum0; bl1[i] = cum1;
    }
    *(LAS f32x2*)(lds + SEG + (wave * 128 + d0) * 4) = (f32x2){cum0, cum1};
    __syncthreads();
    float off0 = 0.f, off1 = 0.f, tot0 = 0.f, tot1 = 0.f;
#pragma unroll
    for (int w = 0; w < 8; ++w) { const f32x2 t = *(const LAS f32x2*)(lds + SEG + (w * 128 + d0) * 4); tot0 += t.x; tot1 += t.y; if (w < wave) { off0 += t.x; off1 += t.y; } }
    if (wave == 0) *(f32x2*)(GE + (size_t)item * 128 + d0) = (f32x2){__expf(tot0), __expf(tot1)};
    {
        unsigned ks0[4], ks1[4];
        bf16_t* gq = GQ + (size_t)item * 8192;
#pragma unroll
        for (int i = 0; i < 8; ++i) {
            const int s = wave * 8 + i;
            const float b0 = off0 + bl0[i], b1 = off1 + bl1[i];
            const float q0 = bf_lo(S.qv[i]), q1 = bf_hi(S.qv[i]), k0 = bf_lo(S.kv[i]), k1 = bf_hi(S.kv[i]);
            const unsigned qd = cvt_pk_bf16(q0 * __expf(b0), q1 * __expf(b1));
            *(LAS unsigned*)(lds + QD + s * 272 + d0 * 2) = qd;
            *(unsigned*)(gq + s * 128 + d0) = qd;
            *(LAS unsigned*)(lds + KI + s * 272 + d0 * 2) = cvt_pk_bf16(k0 * __expf(-b0), k1 * __expf(-b1));
            const float e0 = k0 * __expf(tot0 - b0), e1 = k1 * __expf(tot1 - b1);
            if (i & 1) { ks0[i >> 1] = (ks0[i >> 1] & 0xffffu) | (cvt_pk_bf16(0.f, e0) & 0xffff0000u); ks1[i >> 1] = (ks1[i >> 1] & 0xffffu) | (cvt_pk_bf16(0.f, e1) & 0xffff0000u); }
            else { ks0[i >> 1] = cvt_pk_bf16(e0, 0.f) & 0xffffu; ks1[i >> 1] = cvt_pk_bf16(e1, 0.f) & 0xffffu; }
        }
        bf16_t* gk = GK + (size_t)item * 8192;
        *(u32x4*)(gk + d0 * 64 + wave * 8) = (u32x4){ks0[0], ks0[1], ks0[2], ks0[3]};
        *(u32x4*)(gk + (d0 + 1) * 64 + wave * 8) = (u32x4){ks1[0], ks1[1], ks1[2], ks1[3]};
    }
    __syncthreads();
    {
        bf16_t* gp = GP + (size_t)item * 4096;
        const int t0 = 16 * (wave >> 1);
#pragma unroll
        for (int j = 0; j < 2; ++j) {
            const int s0 = 16 * ((wave & 1) * 2 + j);
            f32x4 a4 = (f32x4){0.f, 0.f, 0.f, 0.f};
#pragma unroll
            for (int kk = 0; kk < 4; ++kk) {
                const bf16x8 af = *(const LAS bf16x8*)(lds + QD + (t0 + l15) * 272 + (kk * 32 + 8 * lq) * 2);
                const bf16x8 bf = *(const LAS bf16x8*)(lds + KI + (s0 + l15) * 272 + (kk * 32 + 8 * lq) * 2);
                a4 = __builtin_amdgcn_mfma_f32_16x16x32_bf16(af, bf, a4, 0, 0, 0);
            }
            const int sc = s0 + l15;
#pragma unroll
            for (int r = 0; r < 4; ++r) { const int t = t0 + 4 * lq + r; gp[t * 64 + sc] = f2bf(sc <= t ? a4[r] : 0.f); }
        }
    }
}
DI void gateprep_phase(const bf16_t* qk, const float* lr, const float* w2, const float* gb, bf16_t* GQ, bf16_t* GK, bf16_t* GP, float* GE, LAS unsigned char* lds) {
    const int tid = tid_opq(), wave = __builtin_amdgcn_readfirstlane(tid >> 6), lane = tid & 63, d0 = 2 * lane;
    const int G = gridDim.x;
    GPStage A, B;
    int item = opq((int)blockIdx.x);
    if (item < NCHI) gp_load(A, item, qk, lr, w2, gb, tid, wave, d0);
    for (; item < NCHI; item += 2 * G) {
        if (item + G < NCHI) gp_load(B, item + G, qk, lr, w2, gb, tid, wave, d0);
        gp_item(A, item, GQ, GK, GP, GE, lds, tid, wave, lane);
        if (item + G < NCHI) {
            if (item + 2 * G < NCHI) gp_load(A, item + 2 * G, qk, lr, w2, gb, tid, wave, d0);
            gp_item(B, item + G, GQ, GK, GP, GE, lds, tid, wave, lane);
        }
    }
    __syncthreads();
}

DI void scan_phase(const bf16_t* vr, const bf16_t* GQ, const bf16_t* GK, const bf16_t* GP, const float* GE, bf16_t* of, bf16_t* ob, LAS unsigned char* lds) {
    constexpr int QD = 0, KST = 17408, VT = 35840, ST = 54272, PP = 89088, BL = 98304;
    const int tid = tid_opq(), wave = __builtin_amdgcn_readfirstlane(tid >> 6), lane = tid & 63;
    const int l31 = lane & 31, lh = lane >> 5;
    for (int item = blockIdx.x; item < 256; item += gridDim.x) {
        const int b = item >> 4, dir = (item >> 3) & 1, h = (item >> 1) & 3, dvh = item & 1;
        bf16_t* obuf = dir ? ob : of;
        const int d0 = 2 * lane;
        const int gi0 = ((b * 2 + dir) * 4 + h) * 68;
        f32x16 Sacc[2];
#pragma unroll
        for (int i = 0; i < 16; ++i) { Sacc[0][i] = 0.f; Sacc[1][i] = 0.f; }
        __syncthreads();
        for (int o = tid; o < 34816 / 16; o += NTHREADS) *(LAS u32x4*)(lds + ST + o * 16) = (u32x4){0u, 0u, 0u, 0u};
        const int vcol = h * 256 + dvh * 128 + d0;
        struct ScStage { u32x4 gq0, gq1, gk0, gk1, gp0; unsigned vv[8]; float ebv; } A, B;
        A.ebv = 0.f; B.ebv = 0.f;
#define SCAN_LOAD(S, c) do { int rb_, sg_; scan_rowbase(dir, b, (c), rb_, sg_); const size_t gi_ = (size_t)(gi0 + (c)); \
        S.gq0 = *(const u32x4*)(GQ + gi_ * 8192 + tid * 8); S.gq1 = *(const u32x4*)(GQ + gi_ * 8192 + 4096 + tid * 8); \
        S.gk0 = *(const u32x4*)(GK + gi_ * 8192 + tid * 8); S.gk1 = *(const u32x4*)(GK + gi_ * 8192 + 4096 + tid * 8); \
        S.gp0 = *(const u32x4*)(GP + gi_ * 4096 + tid * 8); if (tid < 128) S.ebv = GE[gi_ * 128 + tid]; \
        _Pragma("unroll") for (int i = 0; i < 8; ++i) S.vv[i] = *(const unsigned*)(vr + (size_t)(rb_ + sg_ * (wave * 8 + i)) * 2048 + vcol); } while (0)
#define SCAN_CHUNK(S, c) do { \
            int rowbase, sgn; scan_rowbase(dir, b, (c), rowbase, sgn); \
            { const int e0 = tid * 8, e1 = 4096 + tid * 8; \
              *(LAS u32x4*)(lds + QD + (e0 >> 7) * 272 + (e0 & 127) * 2) = S.gq0; *(LAS u32x4*)(lds + QD + (e1 >> 7) * 272 + (e1 & 127) * 2) = S.gq1; \
              *(LAS u32x4*)(lds + KST + (e0 >> 6) * 144 + (e0 & 63) * 2) = S.gk0; *(LAS u32x4*)(lds + KST + (e1 >> 6) * 144 + (e1 & 63) * 2) = S.gk1; \
              *(LAS u32x4*)(lds + PP + (e0 >> 6) * 144 + (e0 & 63) * 2) = S.gp0; \
              if (tid < 128) *(LAS float*)(lds + BL + tid * 4) = S.ebv; \
              unsigned vt0[4], vt1[4]; \
              _Pragma("unroll") for (int i = 0; i < 8; ++i) { \
                  if (i & 1) { vt0[i >> 1] = (vt0[i >> 1] & 0xffffu) | (S.vv[i] << 16); vt1[i >> 1] = (vt1[i >> 1] & 0xffffu) | (S.vv[i] & 0xffff0000u); } \
                  else { vt0[i >> 1] = S.vv[i] & 0xffffu; vt1[i >> 1] = S.vv[i] >> 16; } } \
              *(LAS u32x4*)(lds + VT + d0 * 144 + wave * 16) = (u32x4){vt0[0], vt0[1], vt0[2], vt0[3]}; \
              *(LAS u32x4*)(lds + VT + (d0 + 1) * 144 + wave * 16) = (u32x4){vt1[0], vt1[1], vt1[2], vt1[3]}; \
            } \
            __syncthreads();     \
            if ((c) + 2 < 68) SCAN_LOAD(S, (c) + 2); \
            { \
                const int tq = wave >> 2, vq = wave & 3; \
                f32x16 oacc; \
                _Pragma("unroll") for (int i = 0; i < 16; ++i) oacc[i] = 0.f; \
                _Pragma("unroll") for (int kk = 0; kk < 8; ++kk) { \
                    const bf16x8 af = *(const LAS bf16x8*)(lds + QD + (32 * tq + l31) * 272 + (kk * 16 + 8 * lh) * 2); \
                    const bf16x8 bf = *(const LAS bf16x8*)(lds + ST + (32 * vq + l31) * 272 + (kk * 16 + 8 * lh) * 2); \
                    oacc = __builtin_amdgcn_mfma_f32_32x32x16_bf16(af, bf, oacc, 0, 0, 0); } \
                _Pragma("unroll") for (int kk = 0; kk < 4; ++kk) { \
                    const bf16x8 af = *(const LAS bf16x8*)(lds + PP + (32 * tq + l31) * 144 + (kk * 16 + 8 * lh) * 2); \
                    const bf16x8 bf = *(const LAS bf16x8*)(lds + VT + (32 * vq + l31) * 144 + (kk * 16 + 8 * lh) * 2); \
                    oacc = __builtin_amdgcn_mfma_f32_32x32x16_bf16(af, bf, oacc, 0, 0, 0); } \
                const int ocol = h * 256 + dvh * 128 + 32 * vq + l31; \
                _Pragma("unroll") for (int r = 0; r < 16; ++r) { const int t = 32 * tq + crow(r, lh); obuf[(size_t)(rowbase + sgn * t) * 1024 + ocol] = f2bf(oacc[r]); } \
            } \
            { \
                const int vq = wave & 3; \
                _Pragma("unroll") for (int j = 0; j < 2; ++j) { \
                    const int dq = 2 * (wave >> 2) + j; \
                    _Pragma("unroll") for (int r = 0; r < 16; ++r) Sacc[j][r] *= *(const LAS float*)(lds + BL + (32 * dq + crow(r, lh)) * 4); \
                    _Pragma("unroll") for (int kk = 0; kk < 4; ++kk) { \
                        const bf16x8 af = *(const LAS bf16x8*)(lds + KST + (32 * dq + l31) * 144 + (kk * 16 + 8 * lh) * 2); \
                        const bf16x8 bf = *(const LAS bf16x8*)(lds + VT + (32 * vq + l31) * 144 + (kk * 16 + 8 * lh) * 2); \
                        Sacc[j] = __builtin_amdgcn_mfma_f32_32x32x16_bf16(af, bf, Sacc[j], 0, 0, 0); } } \
            } \
            __syncthreads();     \
            { \
                const int vq = wave & 3; \
                _Pragma("unroll") for (int j = 0; j < 2; ++j) { \
                    const int dq = 2 * (wave >> 2) + j; \
                    _Pragma("unroll") for (int g = 0; g < 4; ++g) { \
                        u32x2 w; w.x = cvt_pk_bf16(Sacc[j][4 * g], Sacc[j][4 * g + 1]); w.y = cvt_pk_bf16(Sacc[j][4 * g + 2], Sacc[j][4 * g + 3]); \
                        *(LAS u32x2*)(lds + ST + (32 * vq + l31) * 272 + (32 * dq + 8 * g + 4 * lh) * 2) = w; } } \
            } } while (0)
        SCAN_LOAD(A, 0); SCAN_LOAD(B, 1);
        for (int c = 0; c < 68; c += 2) { SCAN_CHUNK(A, c); SCAN_CHUNK(B, c + 1); }
#undef SCAN_CHUNK
#undef SCAN_LOAD
    }
    __syncthreads();
}

DI void glapost_phase(const bf16_t* of, const bf16_t* ob, const bf16_t* vr, const float* onorm, bf16_t* a) {
    const int tid = tid_opq(), wave = tid >> 6, lane = tid & 63;
    const int c0 = lane * 16;
    for (int row = blockIdx.x * 8 + wave; row < MR; row += gridDim.x * 8) {
        const u32x4 f0 = *(const u32x4*)(of + (size_t)row * 1024 + c0), f1 = *(const u32x4*)(of + (size_t)row * 1024 + c0 + 8);
        const u32x4 b0 = *(const u32x4*)(ob + (size_t)row * 1024 + c0), b1 = *(const u32x4*)(ob + (size_t)row * 1024 + c0 + 8);
        const u32x4 r0 = *(const u32x4*)(vr + (size_t)row * 2048 + 1024 + c0), r1 = *(const u32x4*)(vr + (size_t)row * 2048 + 1024 + c0 + 8);
        float o[16], rr[16];
#pragma unroll
        for (int j = 0; j < 4; ++j) {
            o[2 * j] = bf_lo(f0[j]) + bf_lo(b0[j]); o[2 * j + 1] = bf_hi(f0[j]) + bf_hi(b0[j]);
            o[8 + 2 * j] = bf_lo(f1[j]) + bf_lo(b1[j]); o[8 + 2 * j + 1] = bf_hi(f1[j]) + bf_hi(b1[j]);
            rr[2 * j] = bf_lo(r0[j]); rr[2 * j + 1] = bf_hi(r0[j]); rr[8 + 2 * j] = bf_lo(r1[j]); rr[8 + 2 * j + 1] = bf_hi(r1[j]);
        }
        float ss = 0.f;
#pragma unroll
        for (int j = 0; j < 16; ++j) ss += o[j] * o[j];
        ss += __shfl_xor(ss, 1); ss += __shfl_xor(ss, 2); ss += __shfl_xor(ss, 4); ss += __shfl_xor(ss, 8);
        const float rstd = rsqrtf(ss * (1.0f / 256.0f) + 1e-6f);
        const float* gn = onorm + (c0 & 255);
        unsigned w[8];
#pragma unroll
        for (int j = 0; j < 8; ++j) {
            const float y0 = o[2 * j] * rstd * gn[2 * j] * silu_f(rr[2 * j]), y1 = o[2 * j + 1] * rstd * gn[2 * j + 1] * silu_f(rr[2 * j + 1]);
            w[j] = cvt_pk_bf16(y0, y1);
        }
        *(u32x4*)(a + (size_t)row * 1024 + c0) = (u32x4){w[0], w[1], w[2], w[3]};
        *(u32x4*)(a + (size_t)row * 1024 + c0 + 8) = (u32x4){w[4], w[5], w[6], w[7]};
    }
}

DI void rope_cs(int tpos, int lane, float& cs, float& sn) {
    const int f = lane & 15; const int pos = (lane >> 5) ? (tpos & 63) : (tpos >> 6);
    const float inv = exp2f(-(float)f * (13.287712379549449f / 16.0f));
    const float ang = (float)pos * inv;
    const float kf = rintf(ang * 0.15915494309189535f);
    float r = fmaf(-kf, 6.2831854820251465f, ang); r = fmaf(-kf, -1.7484556000744883e-7f, r);
    cs = __cosf(r); sn = __sinf(r);
}
DI float rope_apply(float y, int lane, float cs, float sn) {
    const float pr = __shfl_xor(y, 16);
    return (lane & 16) ? (pr * sn + y * cs) : (y * cs - pr * sn);
}
DI int key_of_row(int row) {
    if (row < TL) { const int b = row >> 12; return b * KEYS + CTXL + (row & 4095); }
    const int rc = row - TL; const int b = rc >> 8; return b * KEYS + (rc & 255);
}

DI void mlamid_phase(const bf16_t* dn, const float* qln, const float* kvln, const float* knorm, bf16_t* cqn, bf16_t* ckvn, bf16_t* KB) {
    const int tid = tid_opq(), wave = tid >> 6, lane = tid & 63;
    for (int row = blockIdx.x * 8 + wave; row < MR; row += gridDim.x * 8) {
        const bf16_t* src = dn + (size_t)row * 768;
        unsigned q[3]; float ss = 0.f;
#pragma unroll
        for (int i = 0; i < 3; ++i) { q[i] = *(const unsigned*)(src + i * 128 + 2 * lane); const float a = bf_lo(q[i]), b = bf_hi(q[i]); ss += a * a + b * b; }
        ss = wave_sum(ss);
        float rstd = rsqrtf(ss * (1.0f / 384.0f) + 1e-6f);
#pragma unroll
        for (int i = 0; i < 3; ++i) { const int c = i * 128 + 2 * lane; *(unsigned*)(cqn + (size_t)row * 384 + c) = cvt_pk_bf16(bf_lo(q[i]) * rstd * qln[c], bf_hi(q[i]) * rstd * qln[c + 1]); }
        const u32x2 kvv = *(const u32x2*)(src + 384 + 4 * lane);
        const float k0 = bf_lo(kvv.x), k1 = bf_hi(kvv.x), k2 = bf_lo(kvv.y), k3 = bf_hi(kvv.y);
        ss = wave_sum(k0 * k0 + k1 * k1 + k2 * k2 + k3 * k3);
        rstd = rsqrtf(ss * (1.0f / 256.0f) + 1e-6f);
        { const f32x4 g = *(const f32x4*)(kvln + 4 * lane); u32x2 w; w.x = cvt_pk_bf16(k0 * rstd * g[0], k1 * rstd * g[1]); w.y = cvt_pk_bf16(k2 * rstd * g[2], k3 * rstd * g[3]);
          *(u32x2*)(ckvn + (size_t)row * 256 + 4 * lane) = w; }
        const float x = __uint_as_float(((unsigned)src[640 + lane]) << 16);
        ss = wave_sum(x * x);
        rstd = rsqrtf(ss * (1.0f / 64.0f) + 1e-6f);
        float y = x * rstd * knorm[128 + lane];
        if (row < TL) { float cs, sn; rope_cs(row & 4095, lane, cs, sn); y = rope_apply(y, lane, cs, sn); }
        const bf16_t yb = f2bf(y);
        bf16_t* kd = KB + (size_t)key_of_row(row) * 1536 + 128 + lane;
#pragma unroll
        for (int hh = 0; hh < 8; ++hh) kd[hh * 192] = yb;
    }
}

DI void qkprep_phase(bf16_t* Q, bf16_t* KB, const float* qnorm, const float* knorm) {
    const int tid = tid_opq(), wave = tid >> 6, lane = tid & 63;
    const float qn0 = qnorm[2 * lane], qn1 = qnorm[2 * lane + 1], qnr = qnorm[128 + lane];
    const float kn0 = knorm[2 * lane], kn1 = knorm[2 * lane + 1];
    for (int row = blockIdx.x * 8 + wave; row < MR; row += gridDim.x * 8) {
        float cs = 1.f, sn = 0.f;
        const bool lat = row < TL;
        if (lat) rope_cs(row & 4095, lane, cs, sn);
        bf16_t* qr = Q + (size_t)row * 1536;
        bf16_t* kr = KB + (size_t)key_of_row(row) * 1536;
#pragma unroll
        for (int hh = 0; hh < 8; ++hh) {
            const unsigned qa = *(const unsigned*)(qr + hh * 192 + 2 * lane);
            const float xr = __uint_as_float(((unsigned)qr[hh * 192 + 128 + lane]) << 16);
            const unsigned ka = *(const unsigned*)(kr + hh * 192 + 2 * lane);
            const float a0 = bf_lo(qa), a1 = bf_hi(qa), c0 = bf_lo(ka), c1 = bf_hi(ka);
            const float s1 = wave_sum(a0 * a0 + a1 * a1), s2 = wave_sum(xr * xr), s3 = wave_sum(c0 * c0 + c1 * c1);
            const float r1 = rsqrtf(s1 * (1.0f / 128.0f) + 1e-6f), r2 = rsqrtf(s2 * (1.0f / 64.0f) + 1e-6f), r3 = rsqrtf(s3 * (1.0f / 128.0f) + 1e-6f);
            *(unsigned*)(qr + hh * 192 + 2 * lane) = cvt_pk_bf16(a0 * r1 * qn0, a1 * r1 * qn1);
            float y = xr * r2 * qnr;
            if (lat) y = rope_apply(y, lane, cs, sn);
            qr[hh * 192 + 128 + lane] = f2bf(y);
            *(unsigned*)(kr + hh * 192 + 2 * lane) = cvt_pk_bf16(c0 * r3 * kn0, c1 * r3 * kn1);
        }
    }
}

namespace att {
constexpr int DQK = 192, DV = 128, NW = 8, QBLK = 32, KVBLK = 64;
constexpr int LDQ = 1536, LDK = 1536, LDV = 1024, LDO = 1024;
constexpr float SCALE = 0.07216878364870322f;
constexpr float THR = 8.f;
constexpr size_t SHM_V = KVBLK * DV * 2, SHM_K = KVBLK * DQK * 2;
#define KSWZ(row, colB) ((row) * 384 + ((colB) ^ ((((row) >> 1) & 7) << 4)))
#define SBAR() __builtin_amdgcn_sched_barrier(0)
DI unsigned cvtpk(float lo, float hi) { unsigned r; asm volatile("v_cvt_pk_bf16_f32 %0, %1, %2" : "=v"(r) : "v"(lo), "v"(hi)); return r; }
DI void partialSM(f32x16& p0, f32x16& p1, float& m_reg, float& mn, float& alpha) {
    constexpr float C = SCALE * 1.4426950408889634f;
    float pmax = p0[0];
#pragma unroll
    for (int r = 1; r < 16; ++r) pmax = fmaxf(pmax, p0[r]);
#pragma unroll
    for (int r = 0; r < 16; ++r) pmax = fmaxf(pmax, p1[r]);
    { auto rr = __builtin_amdgcn_permlane32_swap(__float_as_uint(pmax), __float_as_uint(pmax), false, false);
      pmax = fmaxf(__uint_as_float(rr[0]), __uint_as_float(rr[1])); }
    if (__builtin_expect(__all(pmax - m_reg <= THR / SCALE), 1)) { mn = m_reg; alpha = 1.f; }
    else { mn = fmaxf(m_reg, pmax); alpha = __builtin_amdgcn_exp2f((m_reg - mn) * C); m_reg = mn; }
    const float mnC = -mn * C;
#pragma unroll
    for (int r = 0; r < 16; ++r) p0[r] = fmaf(p0[r], C, mnC);
#pragma unroll
    for (int r = 0; r < 16; ++r) p1[r] = fmaf(p1[r], C, mnC);
#pragma unroll
    for (int r = 0; r < 16; ++r) p0[r] = __builtin_amdgcn_exp2f(p0[r]);
}
DI void finishSM(f32x16& p0, f32x16& p1, float alpha, float& l_reg, bf16x8& pa0, bf16x8& pa1, bf16x8& pa2, bf16x8& pa3) {
#pragma unroll
    for (int r = 0; r < 16; ++r) p1[r] = __builtin_amdgcn_exp2f(p1[r]);
    float ps = 0;
#pragma unroll
    for (int r = 0; r < 16; ++r) ps += p0[r];
#pragma unroll
    for (int r = 0; r < 16; ++r) ps += p1[r];
    { auto rr = __builtin_amdgcn_permlane32_swap(__float_as_uint(ps), __float_as_uint(ps), false, false);
      ps = __uint_as_float(rr[0]) + __uint_as_float(rr[1]); }
    l_reg = l_reg * alpha + ps;
#define PK4(P, BASE, OUT) do { unsigned a0 = cvtpk(P[BASE + 0], P[BASE + 1]), a1 = cvtpk(P[BASE + 2], P[BASE + 3]);   \
    unsigned b0 = cvtpk(P[BASE + 4], P[BASE + 5]), b1 = cvtpk(P[BASE + 6], P[BASE + 7]);                              \
    auto r0 = __builtin_amdgcn_permlane32_swap(a0, b0, false, false); auto r1 = __builtin_amdgcn_permlane32_swap(a1, b1, false, false); \
    u32x4 w = {r0[0], r1[0], r0[1], r1[1]}; OUT = *reinterpret_cast<bf16x8*>(&w); } while (0)
    PK4(p0, 0, pa0); PK4(p0, 8, pa1); PK4(p1, 0, pa2); PK4(p1, 8, pa3);
#undef PK4
}
DI void qkt(f32x16& p0, f32x16& p1, const char* Ks, const bf16x8* qr, int r32, int hi) {
#pragma unroll
    for (int r = 0; r < 16; ++r) { p0[r] = 0.f; p1[r] = 0.f; }
#pragma unroll
    for (int d0 = 0; d0 < 12; ++d0) { const int cb = (d0 * 16 + hi * 8) * 2;
        const bf16x8 b0 = *reinterpret_cast<const bf16x8*>(Ks + KSWZ(r32, cb));
        const bf16x8 b1 = *reinterpret_cast<const bf16x8*>(Ks + KSWZ(32 + r32, cb));
        p0 = __builtin_amdgcn_mfma_f32_32x32x16_bf16(b0, qr[d0], p0, 0, 0, 0);
        p1 = __builtin_amdgcn_mfma_f32_32x32x16_bf16(b1, qr[d0], p1, 0, 0, 0); }
}
DI int v_st(int k, int c) { const int kk = (k & ~0xC) | ((k & 4) << 1) | ((k & 8) >> 1); return ((kk >> 3) * 4 + (c >> 5)) * 512 + ((kk & 7) * 32 + (c & 31)) * 2; }
DI int v_rd_base(int lane) { return ((lane & 3) << 3) | (((lane >> 2) & 3) << 6) | (((lane >> 4) & 1) << 5) | (((lane >> 5) & 1) << 8); }
constexpr int v_rd_off(int d0, int ks, int half) { return d0 * 512 + ks * 4096 + half * 2048; }
template <int OFF> DI s16x4 tr_read(int vb) { s16x4 r; asm volatile("ds_read_b64_tr_b16 %0, %1 offset:%2" : "=&v"(r) : "v"(vb), "i"(OFF) : "memory"); return r; }
template <int D0> DI void pv_one(f32x16& od, int vb, bf16x8 pa0, bf16x8 pa1, bf16x8 pa2, bf16x8 pa3) {
    const s16x4 l0 = tr_read<v_rd_off(D0, 0, 0)>(vb), h0 = tr_read<v_rd_off(D0, 0, 1)>(vb), l1 = tr_read<v_rd_off(D0, 1, 0)>(vb), h1 = tr_read<v_rd_off(D0, 1, 1)>(vb);
    const s16x4 l2 = tr_read<v_rd_off(D0, 2, 0)>(vb), h2 = tr_read<v_rd_off(D0, 2, 1)>(vb), l3 = tr_read<v_rd_off(D0, 3, 0)>(vb), h3 = tr_read<v_rd_off(D0, 3, 1)>(vb);
    asm volatile("s_waitcnt lgkmcnt(0)" ::: "memory"); SBAR();
#define PK(L, H) (bf16x8){L[0], L[1], L[2], L[3], H[0], H[1], H[2], H[3]}
    od = __builtin_amdgcn_mfma_f32_32x32x16_bf16(pa0, PK(l0, h0), od, 0, 0, 0);
    od = __builtin_amdgcn_mfma_f32_32x32x16_bf16(pa1, PK(l1, h1), od, 0, 0, 0);
    od = __builtin_amdgcn_mfma_f32_32x32x16_bf16(pa2, PK(l2, h2), od, 0, 0, 0);
    od = __builtin_amdgcn_mfma_f32_32x32x16_bf16(pa3, PK(l3, h3), od, 0, 0, 0);
#undef PK
}
DI void pv_d0(f32x16* o, int vb, bf16x8 pa0, bf16x8 pa1, bf16x8 pa2, bf16x8 pa3) {
    pv_one<0>(o[0], vb, pa0, pa1, pa2, pa3); pv_one<1>(o[1], vb, pa0, pa1, pa2, pa3); pv_one<2>(o[2], vb, pa0, pa1, pa2, pa3); pv_one<3>(o[3], vb, pa0, pa1, pa2, pa3);
}
DI void attn_body(const bf16_t* __restrict__ Qb, const bf16_t* __restrict__ Kh, const bf16_t* __restrict__ Vh, bf16_t* __restrict__ Ob, int seq, char* lds) {
    const int tid = tid_opq(), wid = tid >> 6, lane = tid & 63, r32 = lane & 31, hi = lane >> 5;
    char* V_lds = lds; char* K_lds = lds + 2 * SHM_V;
    float* wsf = (float*)(lds + 2 * SHM_V + 2 * SHM_K) + wid * 64; float* li_l = wsf; float* al_l = wsf + 32;
    float m_reg = -1e30f, l_reg = 0; f32x16 o[4]; bf16x8 qr[12];
#pragma unroll
    for (int d = 0; d < 4; ++d)
#pragma unroll
        for (int r = 0; r < 16; ++r) o[d][r] = 0.f;
    const bf16_t* Qw = Qb + (long)(wid * QBLK + r32) * LDQ + hi * 8;
#pragma unroll
    for (int d0 = 0; d0 < 12; ++d0) qr[d0] = *reinterpret_cast<const bf16x8*>(Qw + d0 * 16);
    const int sr = tid >> 4, sc = (tid & 15) * 8, vst0 = v_st(sr, sc), vst1 = v_st(32 + sr, sc);
    const int pr = tid >> 3, pc = 128 + (tid & 7) * 8;
    const int vb0 = (int)(uintptr_t)V_lds + v_rd_base(lane);
    bf16x8 vs0, vs1, ks0, ks1, kp;
#define SLOAD(k0) do { vs0 = *reinterpret_cast<const bf16x8*>(&Vh[(long)((k0) + sr) * LDV + sc]); vs1 = *reinterpret_cast<const bf16x8*>(&Vh[(long)((k0) + 32 + sr) * LDV + sc]); \
    ks0 = *reinterpret_cast<const bf16x8*>(&Kh[(long)((k0) + sr) * LDK + sc]); ks1 = *reinterpret_cast<const bf16x8*>(&Kh[(long)((k0) + 32 + sr) * LDK + sc]); \
    kp = *reinterpret_cast<const bf16x8*>(&Kh[(long)((k0) + pr) * LDK + pc]); } while (0)
#define SWRITE(b) do { *(bf16x8*)(V_lds + (b) * SHM_V + vst0) = vs0; *(bf16x8*)(V_lds + (b) * SHM_V + vst1) = vs1; \
    *(bf16x8*)(K_lds + (b) * SHM_K + KSWZ(sr, sc * 2)) = ks0; *(bf16x8*)(K_lds + (b) * SHM_K + KSWZ(32 + sr, sc * 2)) = ks1; \
    *(bf16x8*)(K_lds + (b) * SHM_K + KSWZ(pr, pc * 2)) = kp; } while (0)
#define RESC(a) do { if (__any((a) < 1.f)) { if (hi == 0) al_l[r32] = (a); asm volatile("s_waitcnt lgkmcnt(0)" ::: "memory"); \
    _Pragma("unroll") for (int d = 0; d < 4; ++d) _Pragma("unroll") for (int r = 0; r < 16; ++r) o[d][r] *= al_l[crow(r, hi)]; } } while (0)
    f32x16 p0, p1; float mn, al; bf16x8 pa0, pa1, pa2, pa3; const int NT = seq / KVBLK;
    SLOAD(0); asm volatile("s_waitcnt vmcnt(0)" ::: "memory"); SWRITE(0); __syncthreads();
    for (int j = 0; j < NT; ++j) {
        const int cb = j & 1;
        if (j + 1 < NT) SLOAD((j + 1) * KVBLK);
        SBAR(); qkt(p0, p1, K_lds + cb * SHM_K, qr, r32, hi);
        partialSM(p0, p1, m_reg, mn, al);
        finishSM(p0, p1, al, l_reg, pa0, pa1, pa2, pa3);
        RESC(al); SBAR();
        pv_d0(o, vb0 + cb * (int)SHM_V, pa0, pa1, pa2, pa3);
        if (j + 1 < NT) { asm volatile("s_waitcnt vmcnt(0)" ::: "memory"); SWRITE(cb ^ 1); }
        __syncthreads();
    }
    if (hi == 0) li_l[r32] = l_reg; asm volatile("s_waitcnt lgkmcnt(0)" ::: "memory");
    float rli[16];
#pragma unroll
    for (int r = 0; r < 16; ++r) rli[r] = __builtin_amdgcn_rcpf(li_l[crow(r, hi)]);
    bf16_t* Ow = Ob + (long)(wid * QBLK) * LDO;
#pragma unroll
    for (int r = 0; r < 16; ++r) { const int orow = crow(r, hi);
#pragma unroll
        for (int d0 = 0; d0 < 4; ++d0) Ow[(long)orow * LDO + d0 * 32 + r32] = f2bf(o[d0][r] * rli[r]); }
#undef SLOAD
#undef SWRITE
#undef RESC
}
#undef KSWZ
#undef SBAR
}

DI void attn_phase(const bf16_t* Q, const bf16_t* KB, const bf16_t* VB, bf16_t* O, char* lds) {
    for (int it = blockIdx.x; it < 2048 + 128; it += gridDim.x) {
        int b, h, qrow0, seq;
        if (it < 2048) { b = it >> 7; h = (it >> 4) & 7; qrow0 = b * SEQ + (it & 15) * 256; seq = KEYS; }
        else { const int j = it - 2048; b = j >> 3; h = j & 7; qrow0 = TL + b * CTXL; seq = CTXL; }
        att::attn_body(Q + (size_t)qrow0 * 1536 + h * 192, KB + (size_t)b * KEYS * 1536 + h * 192, VB + (size_t)b * KEYS * 1024 + h * 128,
                       O + (size_t)qrow0 * 1024 + h * 128, seq, lds);
        __syncthreads();
    }
}

DI void fixup_phase(const float* halo, const float* cw, const float* cb, bf16_t* act) {
    const int gtid = blockIdx.x * NTHREADS + tid_opq(), gstride = gridDim.x * NTHREADS;
    for (int idx = gtid; idx < 272 * 22 * 64; idx += gstride) {
        const int c4 = (idx & 31) * 4, which = (idx >> 5) & 1, t = idx >> 6, pn = t % 22, pm = t / 22;
        const float* hp = halo + (size_t)(pm * 22 + pn) * 4 * 256;
        const bool sfirst = pm >= 256 || (pm & 15) == 0, slast = pm >= 256 || (pm & 15) == 15;
        const f32x4 z4 = (f32x4){0.f, 0.f, 0.f, 0.f};
        f32x4 pa, pg, ca, cg_, na, ng; int row;
        if (which == 0) { row = pm * 256;
            if (sfirst) { pa = z4; pg = z4; } else { const float* q = halo + (size_t)((pm - 1) * 22 + pn) * 4 * 256 + 3 * 256; pa = *(const f32x4*)(q + c4); pg = *(const f32x4*)(q + 128 + c4); }
            ca = *(const f32x4*)(hp + c4); cg_ = *(const f32x4*)(hp + 128 + c4); na = *(const f32x4*)(hp + 256 + c4); ng = *(const f32x4*)(hp + 256 + 128 + c4);
        } else { row = pm * 256 + 255;
            pa = *(const f32x4*)(hp + 2 * 256 + c4); pg = *(const f32x4*)(hp + 2 * 256 + 128 + c4); ca = *(const f32x4*)(hp + 3 * 256 + c4); cg_ = *(const f32x4*)(hp + 3 * 256 + 128 + c4);
            if (slast) { na = z4; ng = z4; } else { const float* q = halo + (size_t)((pm + 1) * 22 + pn) * 4 * 256; na = *(const f32x4*)(q + c4); ng = *(const f32x4*)(q + 128 + c4); }
        }
        const int ch = pn * 128 + c4;
        const f32x4 w0a = *(const f32x4*)(cw + ch), w1a = *(const f32x4*)(cw + 5632 + ch), w2a = *(const f32x4*)(cw + 2 * 5632 + ch), ba = *(const f32x4*)(cb + ch);
        const f32x4 w0g = *(const f32x4*)(cw + 2816 + ch), w1g = *(const f32x4*)(cw + 5632 + 2816 + ch), w2g = *(const f32x4*)(cw + 2 * 5632 + 2816 + ch), bg = *(const f32x4*)(cb + 2816 + ch);
        const f32x4 av = w0a * pa + w1a * ca + w2a * na + ba, gv = w0g * pg + w1g * cg_ + w2g * ng + bg;
        u32x2 w; w.x = cvt_pk_bf16(silu_f(gv[0]) * av[0], silu_f(gv[1]) * av[1]); w.y = cvt_pk_bf16(silu_f(gv[2]) * av[2], silu_f(gv[3]) * av[3]);
        *(u32x2*)(act + (size_t)row * 2816 + ch) = w;
    }
}

__global__ void __launch_bounds__(NTHREADS) mega(Params p) {
    extern __shared__ __attribute__((aligned(16))) unsigned char smem[];
    LAS unsigned char* lds = (LAS unsigned char*)smem;
    cg::grid_group grid = cg::this_grid();

    for (int ph = p.ph_lo; ph < p.ph_hi; ++ph) {
        unsigned char* ws = (unsigned char*)p.in[opq(27)];
        float* const xout = (float*)p.in[opq(26)];
        float* mod = (float*)(ws + WS_MOD);
        float* xc = (float*)(ws + WS_XC);
        bf16_t* hbuf = (bf16_t*)(ws + WS_H);
        if (ph == 0) {
            prep_phase(p, lds);
#if defined(MK_DUP_OP) && MK_DUP_OP == 99
            grid.sync(); prep_phase(p, lds);
#endif
        } else {
            const int q = ph - 1, lp = q / 21; int r = q % 21; int layer, nmix;
            if (r < 10) { layer = 2 * lp; nmix = 6; } else { layer = 2 * lp + 1; r -= 10; nmix = 7; }
            const bool is_mla = layer & 1; const int j = layer >> 1;
            const float* modl = mod + (size_t)layer * 17 * 6144;
            const bool first = (layer == 0);
            int op = -1, gsel = 0, hf = 0;
            if (r < nmix) {
                if (!is_mla) { op = r == 0 ? 0 : r == 1 ? 2 : r == 2 ? 9 : r == 3 ? 3 : r == 4 ? 4 : 2; gsel = r == 1 ? 0 : 1; }
                else { op = r == 0 ? 0 : r == 1 ? 2 : r == 2 ? 5 : r == 3 ? 2 : r == 4 ? 6 : r == 5 ? 7 : 2; gsel = r == 1 ? 2 : r == 3 ? 3 : 5; }
            } else {
                const int f = r - nmix;
                op = f == 0 ? 1 : f == 2 ? 8 : 2; gsel = f == 1 ? 6 : 7;
            }
            if (op == 1 || (op == 0 && layer > 0)) continue;
#ifdef MK_DUP_OP
            for (int rep_ = 0; rep_ < ((op == MK_DUP_OP || (op == 2 && gsel == MK_DUP_OP - 100)) ? 2 : 1); ++rep_) {
            if (rep_) grid.sync();
#else
            {
#endif
            if (op == 0) {
                norm_phase(p.in[opq(0)], p.in[opq(2)], p.in[opq(6)], modl, 0, 1024, hbuf);
                shw_phase(ws, lds);
            } else if (op == 2) {
                const int ng = (gsel == 3) ? 2 : 1;
                for (int gi = 0; gi < ng; ++gi) {
                    pg8::Gemm g; Epi E; int kind = EPI_BF16;
                    E.ldc = 0; E.xch = (LAS float*)(lds + XCH_OFF); E.q0 = nullptr; E.q1 = nullptr; E.q2 = nullptr; E.q3 = nullptr; E.q4 = nullptr; E.q5 = nullptr;
                    float* const shw_mix = (float*)(ws + WS_SHW) + (size_t)(layer * 2) * 17 * 5632; float* const shw_ffn = shw_mix + 17 * 5632;
                    float* const rs0 = (float*)(ws + WS_RS); float* const rs1 = rs0 + MR;
                    g.M = MR;
                    const int gs = gsel + gi;
                    if (gs == 0) { g.A = hbuf; g.Bt = (const bf16_t*)(ws + WS_GIN + j * SZ_GIN); g.N = 3328; g.K = 1024; g.lda = 1024; g.ldb = 1024;
                        kind = EPI_GLA_IN; E.q0 = ws + WS_QK; E.ldc = 1024; E.q1 = ws + WS_LR; E.q2 = ws + WS_VR; if (!first) { E.q3 = rs1; E.q4 = shw_mix; } }
                    else if (gs == 1 || gs == 5) { g.A = hbuf; g.Bt = (const bf16_t*)(ws + (gs == 1 ? WS_GOUT : WS_MOUT) + j * SZ_SQ); g.N = 1024; g.K = 1024; g.lda = 1024; g.ldb = 1024;
                        kind = EPI_RESID; E.ldc = 0; E.q0 = (void*)(first ? p.in[opq(0)] : xout); E.q1 = (void*)(first ? p.in[opq(2)] : xc); E.q2 = xout; E.q3 = ws; E.q4 = (void*)modl; E.q5 = (void*)(p.in[opq(7)] + layer * 1024);
                        for (int i = blockIdx.x * NTHREADS + tid_opq(); i < MR; i += gridDim.x * NTHREADS) rs1[i] = 0.f; }
                    else if (gs == 2) { g.A = hbuf; g.Bt = (const bf16_t*)(ws + WS_MDOWN + j * SZ_MDOWN); g.N = 768; g.K = 1024; g.lda = 1024; g.ldb = 1024;
                        E.q0 = ws + WS_DN; E.ldc = 768; E.q3 = rs1; E.q4 = shw_mix; }
                    else if (gs == 3) { g.A = (const bf16_t*)(ws + WS_CQN); g.Bt = (const bf16_t*)(ws + WS_MUQ + j * SZ_MUQ); g.N = 1536; g.K = 384; g.lda = 384; g.ldb = 384;
                        E.q0 = ws + WS_QRAW; E.ldc = 1536; }
                    else if (gs == 4) { g.A = (const bf16_t*)(ws + WS_CKVN); g.Bt = (const bf16_t*)(ws + WS_MUKV + j * SZ_MUKV); g.N = 2048; g.K = 256; g.lda = 256; g.ldb = 256;
                        kind = EPI_UKV; E.q0 = ws + WS_KB; E.q1 = ws + WS_VB; }
                    else if (gs == 6) { g.A = (const bf16_t*)(ws + WS_XSA); g.Bt = (const bf16_t*)(ws + WS_FUP + (size_t)layer * SZ_FUP); g.N = 5632; g.K = 1024; g.lda = 1024; g.ldb = 1024;
                        kind = EPI_FFN_UP; E.q0 = ws + WS_ACT; E.ldc = 2816; E.q1 = (void*)(p.in[opq(23)] + (size_t)layer * 3 * 2 * DFF); E.q2 = (void*)(p.in[opq(24)] + (size_t)layer * 2 * DFF);
                        E.q3 = ws + WS_HALO; E.q4 = rs0; E.q5 = shw_ffn; }
                    else { g.A = (const bf16_t*)(ws + WS_ACT); g.Bt = (const bf16_t*)(ws + WS_FDOWN + (size_t)layer * SZ_FDOWN); g.N = 1024; g.K = 2816; g.lda = 2816; g.ldb = 2816;
                        kind = EPI_RESID; E.ldc = 1; E.q0 = xout; E.q1 = xc; E.q2 = xout; E.q3 = ws; E.q4 = (void*)modl; E.q5 = layer < 3 ? (void*)(p.in[opq(6)] + (layer + 1) * 1024) : nullptr;
                        for (int i = blockIdx.x * NTHREADS + tid_opq(); i < MR; i += gridDim.x * NTHREADS) rs0[i] = 0.f; }
                    pg8::StaticOrder S; S.init(g.M, g.N, (int)gridDim.x, (int)blockIdx.x);
                    if (kind == EPI_BF16) pg8::gemm_phase<Epi, EPI_BF16>(lds, g, S, E);
                    else if (kind == EPI_GLA_IN) pg8::gemm_phase<Epi, EPI_GLA_IN>(lds, g, S, E);
                    else if (kind == EPI_RESID) pg8::gemm_phase<Epi, EPI_RESID>(lds, g, S, E);
                    else if (kind == EPI_UKV) pg8::gemm_phase<Epi, EPI_UKV>(lds, g, S, E);
                    else pg8::gemm_phase<Epi, EPI_FFN_UP>(lds, g, S, E);
                    __syncthreads();
                }
            } else if (op == 3) {
                scan_phase((const bf16_t*)(ws + WS_VR), (const bf16_t*)(ws + WS_GQ), (const bf16_t*)(ws + WS_GK), (const bf16_t*)(ws + WS_GP), (const float*)(ws + WS_GE),
                           hbuf, (bf16_t*)(ws + WS_QK), lds);
            } else if (op == 9) {
                gateprep_phase((const bf16_t*)(ws + WS_QK), (const float*)(ws + WS_LR), p.in[opq(10)] + (size_t)j * 2 * 16 * 512, p.in[opq(11)] + (size_t)j * 2 * 512,
                               (bf16_t*)(ws + WS_GQ), (bf16_t*)(ws + WS_GK), (bf16_t*)(ws + WS_GP), (float*)(ws + WS_GE), lds);
            } else if (op == 4) {
                glapost_phase(hbuf, (const bf16_t*)(ws + WS_QK), (const bf16_t*)(ws + WS_VR), p.in[opq(12)] + j * 256, hbuf);
            } else if (op == 5) {
                mlamid_phase((const bf16_t*)(ws + WS_DN), p.in[opq(15)] + j * 384, p.in[opq(16)] + j * 256, p.in[opq(20)] + j * 192, (bf16_t*)(ws + WS_CQN), (bf16_t*)(ws + WS_CKVN), (bf16_t*)(ws + WS_KB));
            } else if (op == 6) {
                qkprep_phase((bf16_t*)(ws + WS_QRAW), (bf16_t*)(ws + WS_KB), p.in[opq(19)] + j * 192, p.in[opq(20)] + j * 192);
            } else if (op == 7) {
                attn_phase((const bf16_t*)(ws + WS_QRAW), (const bf16_t*)(ws + WS_KB), (const bf16_t*)(ws + WS_VB), hbuf, (char*)smem);
            } else if (op == 8) {
                fixup_phase((const float*)(ws + WS_HALO), p.in[opq(23)] + (size_t)layer * 3 * 2 * DFF, p.in[opq(24)] + (size_t)layer * 2 * DFF, (bf16_t*)(ws + WS_ACT));
            }
            }
        }
        if (ph + 1 < p.ph_hi) grid.sync();
    }
}

extern "C" void kernel_launch(void* const* d_in, const int* in_sizes, int n_in, void* d_out, int out_size, void* d_ws, size_t ws_size, hipStream_t stream) {
    static int grid = 0;
    if (grid == 0) {
        if (n_in != 26 || ws_size < WS_END) { fprintf(stderr, "kernel_launch: n_in %d ws %zu (need %zu)\n", n_in, ws_size, (size_t)WS_END); grid = -1; return; }
        int dev = 0, cus = 0, per_cu = 0;
        hipGetDevice(&dev);
        hipDeviceGetAttribute(&cus, hipDeviceAttributeMultiprocessorCount, dev);
        if (hipFuncSetAttribute((const void*)mega, hipFuncAttributeMaxDynamicSharedMemorySize, LDS_BYTES) != hipSuccess) { fprintf(stderr, "kernel_launch: hipFuncSetAttribute failed\n"); grid = -1; return; }
        if (hipOccupancyMaxActiveBlocksPerMultiprocessor(&per_cu, (const void*)mega, NTHREADS, LDS_BYTES) != hipSuccess || per_cu < 1) { fprintf(stderr, "kernel_launch: occupancy query %d\n", per_cu); per_cu = 1; }
        (void)hipGetLastError();
        grid = cus * per_cu;
        fprintf(stderr, "kernel_launch: grid %d (cus %d x %d)\n", grid, cus, per_cu);
    }
    if (grid < 0) return;
    Params p{};
    for (int i = 0; i < 26; ++i) p.in[i] = (const float*)d_in[i];
    p.in[26] = (const float*)d_out; p.in[27] = (const float*)d_ws;
#if MK_MULTI
    for (int ph = 0; ph < NPH; ++ph) {
        p.ph_lo = ph; p.ph_hi = ph + 1;
        hipLaunchKernelGGL(mega, dim3(grid), dim3(NTHREADS), LDS_BYTES, stream, p);
    }
#else
    p.ph_lo = 0; p.ph_hi = NPH;
    void* args[] = {&p};
    hipError_t e = hipLaunchCooperativeKernel((const void*)mega, dim3(grid), dim3(NTHREADS), args, LDS_BYTES, stream);
    if (e != hipSuccess) fprintf(stderr, "cooperative launch failed: %s (grid %d)\n", hipGetErrorString(e), grid);
#endif
}
```

```cpp
#include <hip/hip_runtime.h>
#include <hip/hip_cooperative_groups.h>
#include <cstdio>
#include <cstdint>
namespace cg = cooperative_groups;

#ifndef MK_MULTI
#define MK_MULTI 0
#endif

#define LAS __attribute__((address_space(3)))
#define DI __device__ __forceinline__
typedef unsigned short bf16_t;
typedef short bf16x8 __attribute__((ext_vector_type(8)));
typedef short s16x4 __attribute__((ext_vector_type(4)));
typedef float f32x2 __attribute__((ext_vector_type(2)));
typedef float f32x4 __attribute__((ext_vector_type(4)));
typedef float f32x16 __attribute__((ext_vector_type(16)));
typedef unsigned u32x2 __attribute__((ext_vector_type(2)));
typedef unsigned u32x4 __attribute__((ext_vector_type(4)));

constexpr int DM = 1024, NB = 16, SEQ = 4096, CTXL = 256;
constexpr int TL = NB * SEQ, TC = NB * CTXL, MR = TL + TC;
constexpr int KEYS = CTXL + SEQ;
constexpr int DFF = 2816, DFFH = 1408;
constexpr int NTHREADS = 512;
constexpr int XB_ST_OFF = 131072 + 12288 + 2 * 5120 + 6144;
constexpr int LDS_BYTES = XB_ST_OFF + 16;
constexpr int WIMG_F = 3072, PREW_F = 3072 + 2 * 1280;
constexpr int XCH_OFF = 131072;
constexpr int NPH = 43;

constexpr size_t SZ_GIN = 3328ull * 1024 * 2, SZ_SQ = 1024ull * 1024 * 2, SZ_MDOWN = 768ull * 1024 * 2, SZ_MUQ = 1536ull * 384 * 2,
                 SZ_MUKV = 2048ull * 256 * 2, SZ_FUP = 5632ull * 1024 * 2, SZ_FDOWN = 1024ull * 2816 * 2;
constexpr size_t WS_GIN = 0;
constexpr size_t WS_GOUT = WS_GIN + 2 * SZ_GIN;
constexpr size_t WS_MDOWN = WS_GOUT + 2 * SZ_SQ;
constexpr size_t WS_MUQ = WS_MDOWN + 2 * SZ_MDOWN;
constexpr size_t WS_MUKV = WS_MUQ + 2 * SZ_MUQ;
constexpr size_t WS_MOUT = WS_MUKV + 2 * SZ_MUKV;
constexpr size_t WS_FUP = WS_MOUT + 2 * SZ_SQ;
constexpr size_t WS_FDOWN = WS_FUP + 4 * SZ_FUP;
constexpr size_t WS_MOD = WS_FDOWN + 4 * SZ_FDOWN;
constexpr size_t SZ_MOD = 4ull * 17 * 6144 * 4;
constexpr size_t WS_RS = WS_MOD + ((SZ_MOD + 255) / 256) * 256;
constexpr size_t WS_SHW = WS_RS + 2ull * MR * 4;
constexpr size_t WS_BAR = WS_SHW + 4ull * 2 * 17 * 5632 * 4;
constexpr size_t WS_XC = WS_BAR + 16384;
constexpr size_t WS_H = WS_XC + (size_t)TC * 1024 * 4;
constexpr size_t WS_R = WS_H + (size_t)MR * 1024 * 2;
constexpr size_t WS_QK = WS_R;
constexpr size_t WS_VR = WS_QK + (size_t)MR * 1024 * 2;
constexpr size_t WS_LR = WS_VR + (size_t)MR * 2048 * 2;
constexpr int NCHI = NB * 2 * 4 * 68;
constexpr size_t WS_GQ = WS_LR + (size_t)MR * 32 * 4;
constexpr size_t WS_GK = WS_GQ + (size_t)NCHI * 64 * 128 * 2;
constexpr size_t WS_GP = WS_GK + (size_t)NCHI * 64 * 128 * 2;
constexpr size_t WS_GE = WS_GP + (size_t)NCHI * 64 * 64 * 2;
constexpr size_t WS_GLA_END = WS_GE + (size_t)NCHI * 128 * 4;
constexpr size_t WS_QRAW = WS_R;
constexpr size_t WS_DN = WS_R;
constexpr size_t WS_CQN = WS_QRAW + (size_t)MR * 1536 * 2;
constexpr size_t WS_CKVN = WS_CQN + (size_t)MR * 384 * 2;
constexpr size_t WS_KB = WS_CKVN + (size_t)MR * 256 * 2;
constexpr size_t WS_VB = WS_KB + (size_t)NB * KEYS * 1536 * 2;
constexpr size_t WS_MLA_END = WS_VB + (size_t)NB * KEYS * 1024 * 2;
constexpr size_t WS_ACT = WS_R;
constexpr size_t WS_HALO = WS_ACT + (size_t)MR * 2816 * 2;
constexpr size_t WS_XSA = WS_HALO + 272ull * 22 * 4 * 256 * 4;
constexpr size_t WS_FFN_END = WS_XSA + (size_t)MR * 1024 * 2;
constexpr size_t WS_END = WS_GLA_END > WS_MLA_END ? (WS_GLA_END > WS_FFN_END ? WS_GLA_END : WS_FFN_END) : (WS_MLA_END > WS_FFN_END ? WS_MLA_END : WS_FFN_END);
static_assert(WS_END <= (1ull << 30), "workspace over 1 GiB");

struct Params { const float* in[28]; int ph_lo, ph_hi; };

DI unsigned cvt_pk_bf16(float lo, float hi) { unsigned r; asm("v_cvt_pk_bf16_f32 %0, %1, %2" : "=v"(r) : "v"(lo), "v"(hi)); return r; }
DI float bf_lo(unsigned u) { return __uint_as_float(u << 16); }
DI float bf_hi(unsigned u) { return __uint_as_float(u & 0xffff0000u); }
DI bf16_t f2bf(float f) { return (bf16_t)(cvt_pk_bf16(f, 0.f) & 0xffffu); }
DI float wave_sum(float v) {
#pragma unroll
    for (int o = 32; o >= 1; o >>= 1) v += __shfl_xor(v, o);
    return v;
}
DI float silu_f(float v) { return v * __builtin_amdgcn_rcpf(1.0f + __expf(-v)); }
DI int crow(int r, int hi) { return (r & 3) + 8 * (r >> 2) + 4 * hi; }
DI int tid_opq() { int t = threadIdx.x; asm volatile("" : "+v"(t)); return t; }
DI int opq(int i) { asm volatile("" : "+s"(i)); return i; }

namespace pg8 {
constexpr int BM = 256, BK = 64, HALF = 128, HTB = HALF * BK * 2, STAGE_BYTES = 8 * HTB, NXCD = 8, WGM = 8;
DI int lds_byte(int r, int c) { const int st = (r >> 4) * 2 + (c >> 5), rr = r & 15, cc = c & 31, ob = rr * 64 + cc * 2; return st * 1024 + (ob ^ (((ob >> 9) & 1) << 5)); }
DI void stage_rc(int b, int& R, int& C) { const int st = b / 1024, sb = b % 1024, swz = sb ^ (((sb >> 9) & 1) << 5); R = (st >> 1) * 16 + swz / 64; C = (st & 1) * 32 + (swz % 64) / 2; }
DI int perm32(int rho) { const int n = rho >> 4, i = rho & 15; return 8 * (i >> 2) + 4 * n + (i & 3); }
struct Unit { int pm, pn; };
struct Gemm { const bf16_t* A; const bf16_t* Bt; int M, N, K, lda, ldb; };
struct StaticOrder {
    int nM, nN, nwg, G, c;
    DI void init(int M, int N, int G_, int c_) { nM = M / BM; nN = N / BM; nwg = nM * nN; G = G_; c = c_; }
    DI bool next(int i, Unit& u) const {
        const long L = (long)i * G + c; if (L >= nwg) return false;
        int wgid = (int)L; { const int q = nwg / NXCD, r = nwg % NXCD, xcd = wgid % NXCD, off = wgid / NXCD; wgid = (xcd < r ? xcd * (q + 1) : r * (q + 1) + (xcd - r) * q) + off; }
        const int nig = WGM * nN, gid = wgid / nig, fm = gid * WGM, gsz = (nM - fm) < WGM ? (nM - fm) : WGM;
        u.pm = fm + ((wgid % nig) % gsz); u.pn = (wgid % nig) / gsz; return true;
    }
};

template <class Epi, int KIND>
DI void gemm_phase(LAS unsigned char* lds, const Gemm g, const StaticOrder& S, const Epi& E) {
    constexpr bool perm = Epi::template perm_of<KIND>();
    const int tid = tid_opq(), wid = __builtin_amdgcn_readfirstlane(tid >> 6), lane = tid & 63, wr = wid >> 2, wc = wid & 3, fr = lane & 15, fq = lane >> 4;
    const int K = g.K, nt = K / BK;
    unsigned voffA[2], voffB[2];
#pragma unroll
    for (int i = 0; i < 2; ++i) { int R, C; stage_rc(tid * 16 + i * 8192, R, C); const int Rb = perm ? ((R & ~31) + perm32(R & 31)) : R;
        voffA[i] = (unsigned)(R * g.lda + C) * 2u; voffB[i] = (unsigned)(Rb * g.ldb + C) * 2u; }
    const size_t kstep = (size_t)(BK * 2);
    const size_t hstepA = (size_t)HALF * g.lda * 2, hstepB = (size_t)HALF * g.ldb * 2;
    const size_t tstepA = 2 * hstepA, tstepB = 2 * hstepB;
    const unsigned ldsw = (unsigned)wid * 1024u;
    const int aoff = lds_byte(wr * 64 + fr, fq * 8), boff = lds_byte(wc * 32 + fr, fq * 8);
#define PG8_SA(b, h) (((b) * 2 + (h)) * HTB)
#define PG8_SB(b, h) ((4 + (b) * 2 + (h)) * HTB)
#define PG8_STAGE(bufoff, gbase, voff) do { _Pragma("unroll") for (int _i = 0; _i < 2; ++_i) \
        __builtin_amdgcn_global_load_lds((const unsigned*)((const char*)(gbase) + (voff)[_i]), (LAS unsigned*)(lds + (bufoff) + ldsw + _i * 8192), 16, 0, 0); } while (0)
#define PG8_LDA(dst, b, h) do { _Pragma("unroll") for (int m = 0; m < 4; ++m) _Pragma("unroll") for (int k = 0; k < 2; ++k) dst[m][k] = *(const LAS bf16x8*)(lds + PG8_SA(b, h) + aoff + m * 2048 + k * 1024); } while (0)
#define PG8_LDB(dst, b, h) do { _Pragma("unroll") for (int n = 0; n < 2; ++n) _Pragma("unroll") for (int k = 0; k < 2; ++k) dst[n][k] = *(const LAS bf16x8*)(lds + PG8_SB(b, h) + boff + n * 2048 + k * 1024); } while (0)
#define PG8_MMA(ai, bj, At, Bt) do { __builtin_amdgcn_s_setprio(1); _Pragma("unroll") for (int m = 0; m < 4; ++m) _Pragma("unroll") for (int n = 0; n < 2; ++n) _Pragma("unroll") for (int k = 0; k < 2; ++k) \
        acc[ai][bj][m][n] = __builtin_amdgcn_mfma_f32_16x16x32_bf16(Bt[n][k], At[m][k], acc[ai][bj][m][n], 0, 0, 0); __builtin_amdgcn_s_setprio(0); } while (0)
#define PG8_WAIT_V(n) asm volatile("s_waitcnt vmcnt(" #n ")" ::: "memory")
#define PG8_WAIT_L(n) asm volatile("s_waitcnt lgkmcnt(" #n ")" ::: "memory")
#define PG8_BAR __builtin_amdgcn_s_barrier()
#define PG8_SCHED __builtin_amdgcn_sched_barrier(0)
    Unit cur, nxt; int ui = 0;
    if (!S.next(0, cur)) return;
    f32x4 acc[2][2][4][2];
#pragma unroll
    for (int a = 0; a < 2; ++a)
#pragma unroll
        for (int b = 0; b < 2; ++b)
#pragma unroll
            for (int m = 0; m < 4; ++m)
#pragma unroll
                for (int n = 0; n < 2; ++n) acc[a][b][m][n] = (f32x4){0.f, 0.f, 0.f, 0.f};
    bf16x8 At[4][2], B0[2][2], B1[2][2];
    typename Epi::Pre pre;
    const char* cA = (const char*)g.A + (size_t)cur.pm * tstepA; const char* cB = (const char*)g.Bt + (size_t)cur.pn * tstepB;
    PG8_STAGE(PG8_SB(0, 0), cB, voffB); PG8_STAGE(PG8_SA(0, 0), cA, voffA); PG8_STAGE(PG8_SB(0, 1), cB + hstepB, voffB); PG8_STAGE(PG8_SA(0, 1), cA + hstepA, voffA);
    if (wr == 1) PG8_BAR;
    PG8_WAIT_V(4); PG8_BAR;
    PG8_STAGE(PG8_SB(1, 0), cB + kstep, voffB); PG8_STAGE(PG8_SA(1, 0), cA + kstep, voffA); PG8_STAGE(PG8_SB(1, 1), cB + hstepB + kstep, voffB);
    PG8_WAIT_V(6); PG8_BAR;
    for (;;) {
        const bool has_next = S.next(ui + 1, nxt);
        const char* nA = has_next ? (const char*)g.A + (size_t)nxt.pm * tstepA : cA; const char* nB = has_next ? (const char*)g.Bt + (size_t)nxt.pn * tstepB : cB;
        E.template prefetch<KIND>(pre, cur, wr, wc, fr, fq, ui & 1);
        for (int t = 0; t < nt; t += 2) {
            const bool last = (t == nt - 2);
            const char* a1 = cA + (size_t)(t + 1) * kstep;
            const char* a2 = last ? nA : cA + (size_t)(t + 2) * kstep; const char* b2 = last ? nB : cB + (size_t)(t + 2) * kstep;
            const char* a3 = a2 + kstep; const char* b3 = b2 + kstep;
            PG8_LDB(B0, 0, 0); PG8_SCHED; PG8_LDA(At, 0, 0); PG8_STAGE(PG8_SA(1, 1), a1 + hstepA, voffA);
            PG8_WAIT_L(8); PG8_BAR; PG8_WAIT_L(0); PG8_MMA(0, 0, At, B0); PG8_BAR; PG8_SCHED;
            PG8_LDB(B1, 0, 1); PG8_STAGE(PG8_SB(0, 0), b2, voffB);
            PG8_BAR; PG8_WAIT_L(0); PG8_MMA(0, 1, At, B1); PG8_BAR;
            PG8_LDA(At, 0, 1); PG8_STAGE(PG8_SA(0, 0), a2, voffA);
            PG8_BAR; PG8_WAIT_L(0); PG8_MMA(1, 0, At, B0); PG8_BAR; PG8_SCHED;
            PG8_STAGE(PG8_SB(0, 1), b2 + hstepB, voffB);
            PG8_WAIT_V(6); PG8_BAR; PG8_MMA(1, 1, At, B1); PG8_BAR;
            PG8_LDB(B0, 1, 0); PG8_SCHED; PG8_LDA(At, 1, 0); PG8_STAGE(PG8_SA(0, 1), a2 + hstepA, voffA);
            PG8_WAIT_L(8); PG8_BAR; PG8_WAIT_L(0); PG8_MMA(0, 0, At, B0); PG8_BAR; PG8_SCHED;
            PG8_LDB(B1, 1, 1); PG8_STAGE(PG8_SB(1, 0), b3, voffB);
            PG8_BAR; PG8_WAIT_L(0); PG8_MMA(0, 1, At, B1); PG8_BAR;
            PG8_LDA(At, 1, 1); PG8_STAGE(PG8_SA(1, 0), a3, voffA);
            PG8_BAR; PG8_WAIT_L(0); PG8_MMA(1, 0, At, B0); PG8_BAR; PG8_SCHED;
            PG8_STAGE(PG8_SB(1, 1), b3 + hstepB, voffB);
            PG8_WAIT_V(6); PG8_BAR; PG8_MMA(1, 1, At, B1); PG8_BAR;
        }
        E.template run<KIND>(acc, pre, cur, wr, wc, fr, fq, ui & 1);
        if (!has_next) break;
#pragma unroll
        for (int a = 0; a < 2; ++a)
#pragma unroll
            for (int b = 0; b < 2; ++b)
#pragma unroll
                for (int m = 0; m < 4; ++m)
#pragma unroll
                    for (int n = 0; n < 2; ++n) acc[a][b][m][n] = (f32x4){0.f, 0.f, 0.f, 0.f};
        cur = nxt; cA = nA; cB = nB; ++ui;
    }
    PG8_WAIT_V(0);
    if (wr == 0) PG8_BAR;
    PG8_BAR;
#undef PG8_SA
#undef PG8_SB
#undef PG8_STAGE
#undef PG8_LDA
#undef PG8_LDB
#undef PG8_MMA
#undef PG8_WAIT_V
#undef PG8_WAIT_L
#undef PG8_BAR
#undef PG8_SCHED
}
}

enum { EPI_BF16 = 0, EPI_GLA_IN = 1, EPI_RESID = 2, EPI_UKV = 3, EPI_FFN_UP = 4 };
DI float dpp_ror1(float v) { return __int_as_float(__builtin_amdgcn_update_dpp(0, __float_as_int(v), 0x121, 0xf, 0xf, false)); }
DI float dpp_ror15(float v) { return __int_as_float(__builtin_amdgcn_update_dpp(0, __float_as_int(v), 0x12F, 0xf, 0xf, false)); }
struct Epi {
    struct Pre { float rsv[2][4]; f32x4 sw[2][2]; f32x2 wl0, wl1; };
    int ldc; LAS float* xch;
    void* q0; void* q1; void* q2; void* q3; void* q4; void* q5;
    static DI f32x4 ror1_4(f32x4 v) { float a, b, c, d;
        asm volatile("s_nop 1\n\tv_mov_b32_dpp %0, %4 row_ror:1 row_mask:0xf bank_mask:0xf\n\tv_mov_b32_dpp %1, %5 row_ror:1 row_mask:0xf bank_mask:0xf\n\tv_mov_b32_dpp %2, %6 row_ror:1 row_mask:0xf bank_mask:0xf\n\tv_mov_b32_dpp %3, %7 row_ror:1 row_mask:0xf bank_mask:0xf"
                     : "=&v"(a), "=&v"(b), "=&v"(c), "=&v"(d) : "v"(v[0]), "v"(v[1]), "v"(v[2]), "v"(v[3]));
        return (f32x4){a, b, c, d}; }
    static DI f32x2 ror1_2(f32x2 v) { float a, b;
        asm volatile("s_nop 1\n\tv_mov_b32_dpp %0, %2 row_ror:1 row_mask:0xf bank_mask:0xf\n\tv_mov_b32_dpp %1, %3 row_ror:1 row_mask:0xf bank_mask:0xf" : "=&v"(a), "=&v"(b) : "v"(v[0]), "v"(v[1]));
        return (f32x2){a, b}; }
    static DI f32x2 ror15_2(f32x2 v) { float a, b;
        asm volatile("s_nop 1\n\tv_mov_b32_dpp %0, %2 row_ror:15 row_mask:0xf bank_mask:0xf\n\tv_mov_b32_dpp %1, %3 row_ror:15 row_mask:0xf bank_mask:0xf" : "=&v"(a), "=&v"(b) : "v"(v[0]), "v"(v[1]));
        return (f32x2){a, b}; }
    static DI f32x4 ror15_4(f32x4 v) { float a, b, c, d;
        asm volatile("s_nop 1\n\tv_mov_b32_dpp %0, %4 row_ror:15 row_mask:0xf bank_mask:0xf\n\tv_mov_b32_dpp %1, %5 row_ror:15 row_mask:0xf bank_mask:0xf\n\tv_mov_b32_dpp %2, %6 row_ror:15 row_mask:0xf bank_mask:0xf\n\tv_mov_b32_dpp %3, %7 row_ror:15 row_mask:0xf bank_mask:0xf"
                     : "=&v"(a), "=&v"(b), "=&v"(c), "=&v"(d) : "v"(v[0]), "v"(v[1]), "v"(v[2]), "v"(v[3]));
        return (f32x4){a, b, c, d}; }
    DI void ffn_up(const f32x4 (&acc)[2][2][4][2], const pg8::Unit& u, int wr, int wc, int fr, int fq, int par) const {
        bf16_t* O = (bf16_t*)q0; float* halo = (float*)q3;
        const int cl = wc * 32 + 8 * fq;
        float rstd[2][4];
        { const LAS float* pw = xch + PREW_F + (wr * 4 + wc) * 192;
#pragma unroll
          for (int g = 0; g < 8; ++g) rstd[g >> 2][g & 3] = rsqrtf(pw[g * 16 + fr] * (1.0f / 1024.0f) + 1e-6f); }
        const LAS float* wbuf = xch + WIMG_F + par * 1280;
#define XW(ST, TB, BJ, V0, V1) do { LAS float* xp_ = xch + ((((ST) + 1) * 2 + (TB)) * 2 + (BJ)) * 128 + cl; *(LAS f32x4*)xp_ = (V0); *(LAS f32x4*)(xp_ + 4) = (V1); } while (0)
#define TR(AI, BJ, M, N) (acc[AI][BJ][M][N] * rstd[AI][M])
        if (fr == 0) { XW(wr, 0, 0, TR(0, 0, 0, 0), TR(0, 0, 0, 1)); XW(wr, 0, 1, TR(0, 1, 0, 0), TR(0, 1, 0, 1)); XW(2 + wr, 0, 0, TR(1, 0, 0, 0), TR(1, 0, 0, 1)); XW(2 + wr, 0, 1, TR(1, 1, 0, 0), TR(1, 1, 0, 1)); }
        if (fr == 15) { XW(wr, 1, 0, TR(0, 0, 3, 0), TR(0, 0, 3, 1)); XW(wr, 1, 1, TR(0, 1, 3, 0), TR(0, 1, 3, 1)); XW(2 + wr, 1, 0, TR(1, 0, 3, 0), TR(1, 0, 3, 1)); XW(2 + wr, 1, 1, TR(1, 1, 3, 0), TR(1, 1, 3, 1)); }
        { const f32x4 zz = (f32x4){0.f, 0.f, 0.f, 0.f}; if (fr == 0 && wr == 0) { XW(-1, 1, 0, zz, zz); XW(-1, 1, 1, zz, zz); } if (fr == 15 && wr == 1) { XW(4, 0, 0, zz, zz); XW(4, 0, 1, zz, zz); } }
#undef XW
        asm volatile("s_waitcnt lgkmcnt(0)" ::: "memory"); __builtin_amdgcn_s_barrier(); asm volatile("" ::: "memory"); __builtin_amdgcn_s_barrier(); asm volatile("" ::: "memory");
        {
            float* hp = halo + (size_t)(u.pm * 22 + u.pn) * 4 * 256 + cl;
            const f32x4 sa0 = *(const LAS f32x4*)(wbuf + 512 + cl), sa1 = *(const LAS f32x4*)(wbuf + 512 + cl + 4), sg0 = *(const LAS f32x4*)(wbuf + 640 + 512 + cl), sg1 = *(const LAS f32x4*)(wbuf + 640 + 512 + cl + 4);
            if (wr == 0 && fr < 2) { float* h2 = hp + fr * 256; *(f32x4*)h2 = TR(0, 0, 0, 0) + sa0; *(f32x4*)(h2 + 4) = TR(0, 0, 0, 1) + sa1; *(f32x4*)(h2 + 128) = TR(0, 1, 0, 0) + sg0; *(f32x4*)(h2 + 132) = TR(0, 1, 0, 1) + sg1; }
            if (wr == 1 && fr >= 14) { float* h2 = hp + (fr - 12) * 256; *(f32x4*)h2 = TR(1, 0, 3, 0) + sa0; *(f32x4*)(h2 + 4) = TR(1, 0, 3, 1) + sa1; *(f32x4*)(h2 + 128) = TR(1, 1, 3, 0) + sg0; *(f32x4*)(h2 + 132) = TR(1, 1, 3, 1) + sg1; }
        }
#undef TR
        asm volatile("" ::: "memory");
        const int rowt = u.pm * 256 + wr * 64 + fr;
        const bool f0 = fr == 0, f15 = fr == 15;
        f32x2 sg[2][4][4];
#define SILU2(v) (f32x2){silu_f(v[0]), silu_f(v[1])}
#define H2(V, HH) __builtin_shufflevector(V, V, 2 * (HH), 2 * (HH) + 1)
#define CONV_GROUP(BJ, Q, AI, OP) do { \
            const int st = 2 * (AI) + wr; \
            const f32x2 pb = *(const LAS f32x2*)(xch + (((st) * 2 + 1) * 2 + (BJ)) * 128 + cl + 2 * (Q)) + sw; \
            const f32x2 nb = *(const LAS f32x2*)(xch + (((st + 2) * 2 + 0) * 2 + (BJ)) * 128 + cl + 2 * (Q)) + sw; \
            const f32x2 c0 = H2(acc[AI][BJ][0][(Q) >> 1], (Q) & 1) * rstd[AI][0] + sw, c1 = H2(acc[AI][BJ][1][(Q) >> 1], (Q) & 1) * rstd[AI][1] + sw, \
                        c2 = H2(acc[AI][BJ][2][(Q) >> 1], (Q) & 1) * rstd[AI][2] + sw, c3 = H2(acc[AI][BJ][3][(Q) >> 1], (Q) & 1) * rstd[AI][3] + sw; \
            const f32x2 R0 = ror1_2(c0), L0 = ror15_2(c0), L1 = ror15_2(c1); \
            { const f32x2 v = w0 * (f0 ? pb : R0) + w1 * c0 + w2 * (f15 ? L1 : L0) + bb; OP(sg[AI][0][Q], v); } \
            __builtin_amdgcn_sched_barrier(0); \
            const f32x2 R1 = ror1_2(c1), L2 = ror15_2(c2); \
            { const f32x2 v = w0 * (f0 ? R0 : R1) + w1 * c1 + w2 * (f15 ? L2 : L1) + bb; OP(sg[AI][1][Q], v); } \
            __builtin_amdgcn_sched_barrier(0); \
            const f32x2 R2 = ror1_2(c2), L3 = ror15_2(c3); \
            { const f32x2 v = w0 * (f0 ? R1 : R2) + w1 * c2 + w2 * (f15 ? L3 : L2) + bb; OP(sg[AI][2][Q], v); } \
            __builtin_amdgcn_sched_barrier(0); \
            const f32x2 R3 = ror1_2(c3); \
            { const f32x2 v = w0 * (f0 ? R2 : R3) + w1 * c3 + w2 * (f15 ? nb : L3) + bb; OP(sg[AI][3][Q], v); } \
            __builtin_amdgcn_sched_barrier(0); } while (0)
#define OP_G(dst, v) dst = SILU2(v)
#define OP_A(dst, v) dst *= v
#define CONV_W(BJ, Q) const LAS float* wp_ = wbuf + (BJ) * 640 + cl + 2 * (Q); \
            const f32x2 w0 = *(const LAS f32x2*)wp_, w1 = *(const LAS f32x2*)(wp_ + 128), w2 = *(const LAS f32x2*)(wp_ + 256), bb = *(const LAS f32x2*)(wp_ + 384), sw = *(const LAS f32x2*)(wp_ + 512);
        { CONV_W(1, 0) CONV_GROUP(1, 0, 0, OP_G); CONV_GROUP(1, 0, 1, OP_G); }
        { CONV_W(1, 1) CONV_GROUP(1, 1, 0, OP_G); CONV_GROUP(1, 1, 1, OP_G); }
        { CONV_W(1, 2) CONV_GROUP(1, 2, 0, OP_G); CONV_GROUP(1, 2, 1, OP_G); }
        { CONV_W(1, 3) CONV_GROUP(1, 3, 0, OP_G); CONV_GROUP(1, 3, 1, OP_G); }
        { CONV_W(0, 0) CONV_GROUP(0, 0, 0, OP_A); CONV_GROUP(0, 0, 1, OP_A); }
        { CONV_W(0, 1) CONV_GROUP(0, 1, 0, OP_A); CONV_GROUP(0, 1, 1, OP_A); }
        { CONV_W(0, 2) CONV_GROUP(0, 2, 0, OP_A); CONV_GROUP(0, 2, 1, OP_A); }
        { CONV_W(0, 3) CONV_GROUP(0, 3, 0, OP_A); CONV_GROUP(0, 3, 1, OP_A); }
#undef CONV_W
#undef CONV_GROUP
#undef OP_G
#undef OP_A
#undef SILU2
#undef H2
#define ST16(AI, MM) do { u32x4 w_; w_.x = cvt_pk_bf16(sg[AI][MM][0][0], sg[AI][MM][0][1]); w_.y = cvt_pk_bf16(sg[AI][MM][1][0], sg[AI][MM][1][1]); w_.z = cvt_pk_bf16(sg[AI][MM][2][0], sg[AI][MM][2][1]); w_.w = cvt_pk_bf16(sg[AI][MM][3][0], sg[AI][MM][3][1]); \
            *(u32x4*)(O + (size_t)(rowt + (AI) * 128 + (MM) * 16) * 2816 + u.pn * 128 + cl) = w_; } while (0)
        ST16(0, 0); ST16(0, 1); ST16(0, 2); ST16(0, 3); ST16(1, 0); ST16(1, 1); ST16(1, 2); ST16(1, 3);
#undef ST16
    }
    template <int K> static constexpr bool perm_of() { return K != EPI_RESID; }
    template <int kind> DI void prefetch(Pre& P, const pg8::Unit& u, int wr, int wc, int fr, int fq, int par) const {
        (void)P;
        if constexpr (kind == EPI_GLA_IN || kind == EPI_BF16 || kind == EPI_FFN_UP) {
            const float* rsb = (const float*)(kind == EPI_FFN_UP ? q4 : q3);
            if (rsb) {
                LAS float* pw = xch + PREW_F + (wr * 4 + wc) * 192;
                const int bidx = u.pm < 256 ? (u.pm >> 4) : 16;
                if (fq == 0) {
                    const float* rsp = rsb + u.pm * 256 + wr * 64 + fr;
#pragma unroll
                    for (int g = 0; g < 8; ++g) __builtin_amdgcn_global_load_lds((const unsigned*)(rsp + (g >> 2) * 128 + (g & 3) * 16), (LAS unsigned*)(pw + g * 16), 4, 0, 0);
                    if constexpr (kind != EPI_FFN_UP) {
                        const float* sw = (const float*)q4 + (size_t)bidx * 5632 + u.pn * 256 + (fr >> 3) * 128 + wc * 32 + (fr & 7) * 4;
                        __builtin_amdgcn_global_load_lds((const unsigned*)sw, (LAS unsigned*)(pw + 128), 16, 0, 0);
                    }
                }
                if constexpr (kind == EPI_FFN_UP) {
                    const int wid = wr * 4 + wc;
                    if (wid < 5) {
                        const float* cw = (const float*)q1; const float* cb = (const float*)q2; const float* shw = (const float*)q5 + (size_t)bidx * 5632 + u.pn * 256;
                        const int i4 = (wid * 64 + fq * 16 + fr) * 4, bjw = i4 / 640, rem = i4 % 640, kw = rem >> 7, c_ = rem & 127;
                        const float* srcw = kw < 3 ? cw + kw * 5632 + bjw * 2816 + u.pn * 128 + c_ : kw == 3 ? cb + bjw * 2816 + u.pn * 128 + c_ : shw + bjw * 128 + c_;
                        __builtin_amdgcn_global_load_lds((const unsigned*)srcw, (LAS unsigned*)(xch + WIMG_F + par * 1280 + wid * 256), 16, 0, 0);
                    }
                }
            }
        }
    }
    template <int kind> DI void run(const f32x4 (&acc)[2][2][4][2], const Pre& P, const pg8::Unit& u, int wr, int wc, int fr, int fq, int par) const {
        asm volatile("" : "+v"(fr), "+v"(fq));
        if constexpr (kind == EPI_FFN_UP) { ffn_up(acc, u, wr, wc, fr, fq, par); return; }
        if constexpr (kind == EPI_RESID) {
            const float* base_l = (const float*)q0; const float* base_c = (const float*)q1; float* out_l = (float*)q2; unsigned char* wsb = (unsigned char*)q3; float* out_c = (float*)(wsb + WS_XC);
            const float* modl = (const float*)q4; const float* gnext = (const float*)q5;
            const int bidx = u.pm < 256 ? (u.pm >> 4) : 16;
            const float* gv = modl + (size_t)bidx * 6144 + (ldc ? 5 * 1024 : 2 * 1024);
            const float* bp = u.pm < 256 ? base_l + (size_t)u.pm * 256 * 1024 : base_c + (size_t)(u.pm - 256) * 256 * 1024;
            float* op = u.pm < 256 ? out_l + (size_t)u.pm * 256 * 1024 : out_c + (size_t)(u.pm - 256) * 256 * 1024;
            const int col0 = u.pn * 256 + wc * 32 + 4 * fq;
            f32x4 gt[2][2], gn[2][2];
#pragma unroll
            for (int bj = 0; bj < 2; ++bj)
#pragma unroll
                for (int n = 0; n < 2; ++n) gt[bj][n] = *(const f32x4*)(gv + col0 + bj * 128 + n * 16);
            if (gnext) {
                const float* scn = ldc ? modl + (size_t)(17 + bidx) * 6144 + 1024 : modl + (size_t)bidx * 6144 + 4 * 1024;
#pragma unroll
                for (int bj = 0; bj < 2; ++bj)
#pragma unroll
                    for (int n = 0; n < 2; ++n) gn[bj][n] = *(const f32x4*)(gnext + col0 + bj * 128 + n * 16) * (*(const f32x4*)(scn + col0 + bj * 128 + n * 16) + 1.0f);
            }
            bf16_t* xs = (bf16_t*)(wsb + (ldc ? WS_H : WS_XSA)) + (size_t)u.pm * 256 * 1024;
            float* rs = (float*)(wsb + WS_RS) + (ldc ? MR : 0) + u.pm * 256;
#pragma unroll
            for (int ai = 0; ai < 2; ++ai)
#pragma unroll
                for (int m = 0; m < 4; ++m) {
                    const int rl = ai * 128 + wr * 64 + m * 16 + fr;
                    const size_t off = (size_t)rl * 1024 + col0;
                    float ssq = 0.f;
#pragma unroll
                    for (int bj = 0; bj < 2; ++bj)
#pragma unroll
                        for (int n = 0; n < 2; ++n) {
                            const f32x4 bs = *(const f32x4*)(bp + off + bj * 128 + n * 16);
                            const f32x4 xn = bs + gt[bj][n] * acc[ai][bj][m][n];
                            *(f32x4*)(op + off + bj * 128 + n * 16) = xn;
                            if (gnext) {
                                ssq += xn[0] * xn[0] + xn[1] * xn[1] + xn[2] * xn[2] + xn[3] * xn[3];
                                const f32x4 y = xn * gn[bj][n];
                                u32x2 w; w.x = cvt_pk_bf16(y[0], y[1]); w.y = cvt_pk_bf16(y[2], y[3]);
                                *(u32x2*)(xs + off + bj * 128 + n * 16) = w;
                            }
                        }
                    if (gnext) {
                        ssq += __shfl_xor(ssq, 16); ssq += __shfl_xor(ssq, 32);
                        if (fq == 0) unsafeAtomicAdd(rs + rl, ssq);
                    }
                }
            return;
        } else {
        bf16_t* O = (bf16_t*)q0; float* lr = (float*)q1; bf16_t* KB = (bf16_t*)q0; bf16_t* VB = (bf16_t*)q1;
        const int rowt = u.pm * 256 + wr * 64 + fr;
        f32x4 swv[2][2]; float rsv[2][4];
        if constexpr (kind == EPI_GLA_IN || kind == EPI_BF16) {
            if (q3) { const LAS float* pw = xch + PREW_F + (wr * 4 + wc) * 192;
#pragma unroll
                for (int g = 0; g < 8; ++g) rsv[g >> 2][g & 3] = pw[g * 16 + fr];
#pragma unroll
                for (int bj = 0; bj < 2; ++bj) { swv[bj][0] = *(const LAS f32x4*)(pw + 128 + bj * 32 + 8 * fq); swv[bj][1] = *(const LAS f32x4*)(pw + 128 + bj * 32 + 8 * fq + 4); } }
        }
#pragma unroll
        for (int ai = 0; ai < 2; ++ai)
#pragma unroll
            for (int m = 0; m < 4; ++m) {
                const int row = rowt + ai * 128 + m * 16;
#pragma unroll
                for (int bj = 0; bj < 2; ++bj) {
                    f32x4 v0 = acc[ai][bj][m][0], v1 = acc[ai][bj][m][1];
                    const int cin = bj * 128 + wc * 32 + 8 * fq;
                    if constexpr (kind == EPI_GLA_IN || kind == EPI_BF16) {
                        if (q3) {
                            const float rstd = rsqrtf(rsv[ai][m] * (1.0f / 1024.0f) + 1e-6f);
                            v0 = v0 * rstd + swv[bj][0]; v1 = v1 * rstd + swv[bj][1];
                        }
                    }
                    if constexpr (kind == EPI_GLA_IN) {
                        if (u.pn == 12) {
                            if (bj == 0 && wc == 0) { float* lp = lr + (size_t)row * 32 + 8 * fq; *(f32x4*)lp = v0; *(f32x4*)(lp + 4) = v1; }
                            continue;
                        }
                        if (u.pn < 2) { v0 *= 0.08838834764831845f; v1 *= 0.08838834764831845f; }
                    }
                    u32x4 w; w.x = cvt_pk_bf16(v0[0], v0[1]); w.y = cvt_pk_bf16(v0[2], v0[3]); w.z = cvt_pk_bf16(v1[0], v1[1]); w.w = cvt_pk_bf16(v1[2], v1[3]);
                    if constexpr (kind == EPI_GLA_IN) {
                        if (u.pn < 4) *(u32x4*)(O + (size_t)row * 1024 + u.pn * 256 + cin) = w;
                        else *(u32x4*)((bf16_t*)q2 + (size_t)row * 2048 + (u.pn - 4) * 256 + cin) = w;
                    } else if constexpr (kind == EPI_UKV) {
                        int key;
                        if (u.pm < 256) { const int b = u.pm >> 4; key = b * KEYS + CTXL + (row - b * SEQ); }
                        else { const int b = u.pm - 256; key = b * KEYS + (row - TL - b * CTXL); }
                        const int cc = wc * 32 + 8 * fq;
                        if (bj == 0) *(u32x4*)(KB + (size_t)key * 1536 + u.pn * 192 + cc) = w;
                        else *(u32x4*)(VB + (size_t)key * 1024 + u.pn * 128 + cc) = w;
                    } else {
                        *(u32x4*)(O + (size_t)row * ldc + u.pn * 256 + cin) = w;
                    }
                }
            }
        }
    }
};

DI void prep_phase(const Params& p, LAS unsigned char* lds) {
    const int tid = tid_opq();
    unsigned char* ws = (unsigned char*)p.in[opq(27)];
    LAS float* tl = (LAS float*)lds;
    const float* in_c = p.in[opq(1)]; const float* in_cctx = p.in[opq(3)]; const float* in_wada = p.in[opq(4)]; const float* in_bada = p.in[opq(5)];
    const float* in_gin = p.in[opq(8)]; const float* in_w1 = p.in[opq(9)]; const float* in_gout = p.in[opq(13)]; const float* in_mdown = p.in[opq(14)];
    const float* in_uq = p.in[opq(17)]; const float* in_ukv = p.in[opq(18)]; const float* in_mout = p.in[opq(21)]; const float* in_fup = p.in[opq(22)]; const float* in_fdown = p.in[opq(25)];
    constexpr int T0 = 1536, T2 = 512, T3 = 352, T4 = 288, T5 = 256, T6 = 512, T7 = 5632, T8 = 2816;
    constexpr int NTILE = T0 + T2 + T3 + T4 + T5 + T6 + T7 + T8;
    for (int t = blockIdx.x; t < NTILE; t += gridDim.x) {
        const float* src; int N, k0, n0, ld; bf16_t* dst;
        int q = t;
        if (q < T0) { const int j = q / 768, r = q % 768, kt = r / 48, nt = r % 48; src = in_gin + (size_t)j * 1024 * 3072; N = 3072; k0 = kt * 64; n0 = nt * 64;
            dst = (bf16_t*)(ws + WS_GIN + j * SZ_GIN) + (size_t)n0 * 1024 + k0; ld = 1024; }
        else if ((q -= T0) < T2) { const int j = q / 256, r = q % 256, kt = r / 16, nt = r % 16; src = in_gout + (size_t)j * 1024 * 1024; N = 1024; k0 = kt * 64; n0 = nt * 64;
            dst = (bf16_t*)(ws + WS_GOUT + j * SZ_SQ) + (size_t)n0 * 1024 + k0; ld = 1024; }
        else if ((q -= T2) < T3) { const int j = q / 176, r = q % 176, kt = r / 11, nt = r % 11; src = in_mdown + (size_t)j * 1024 * 704; N = 704; k0 = kt * 64; n0 = nt * 64;
            dst = (bf16_t*)(ws + WS_MDOWN + j * SZ_MDOWN) + (size_t)n0 * 1024 + k0; ld = 1024; }
        else if ((q -= T3) < T4) { const int j = q / 144, r = q % 144, kt = r / 24, nt = r % 24; src = in_uq + (size_t)j * 384 * 1536; N = 1536; k0 = kt * 64; n0 = nt * 64;
            dst = (bf16_t*)(ws + WS_MUQ + j * SZ_MUQ) + (size_t)n0 * 384 + k0; ld = 384; }
        else if ((q -= T4) < T5) { const int j = q / 128, r = q % 128, kt = r / 32, nt = r % 32; src = in_ukv + (size_t)j * 256 * 2048; N = 2048; k0 = kt * 64; n0 = nt * 64;
            dst = (bf16_t*)(ws + WS_MUKV + j * SZ_MUKV) + (size_t)n0 * 256 + k0; ld = 256; }
        else if ((q -= T5) < T6) { const int j = q / 256, r = q % 256, kt = r / 16, nt = r % 16; src = in_mout + (size_t)j * 1024 * 1024; N = 1024; k0 = kt * 64; n0 = nt * 64;
            dst = (bf16_t*)(ws + WS_MOUT + j * SZ_SQ) + (size_t)n0 * 1024 + k0; ld = 1024; }
        else if ((q -= T6) < T7) { const int i = q / 1408, r = q % 1408, kt = r / 88, nt = r % 88; src = in_fup + (size_t)i * 1024 * 5632; N = 5632; k0 = kt * 64; n0 = nt * 64;
            const int isg = n0 >= DFF ? 1 : 0, cc = n0 - isg * DFF, drow = (cc >> 7) * 256 + isg * 128 + (cc & 127);
            dst = (bf16_t*)(ws + WS_FUP + (size_t)i * SZ_FUP) + (size_t)drow * 1024 + k0; ld = 1024; }
        else { q -= T7; const int i = q / 704, r = q % 704, kt = r / 16, nt = r % 16; src = in_fdown + (size_t)i * 2816 * 1024; N = 1024; k0 = kt * 64; n0 = nt * 64;
            dst = (bf16_t*)(ws + WS_FDOWN + (size_t)i * SZ_FDOWN) + (size_t)n0 * 2816 + k0; ld = 2816; }
#pragma unroll
        for (int i = 0; i < 8; ++i) { const int r = (tid >> 6) + 8 * i, c = tid & 63; tl[c * 65 + r] = src[(size_t)(k0 + r) * N + n0 + c]; }
        __syncthreads();
#pragma unroll
        for (int i = 0; i < 4; ++i) { const int rr = (tid >> 5) + 16 * i, c2 = (tid & 31) * 2; const float a = tl[rr * 65 + c2], b = tl[rr * 65 + c2 + 1];
            *(unsigned*)(dst + (size_t)rr * ld + c2) = cvt_pk_bf16(a, b); }
        __syncthreads();
    }
    const int gtid = blockIdx.x * NTHREADS + tid, gstride = gridDim.x * NTHREADS;
    for (int idx = gtid; idx < 65536; idx += gstride) {
        const int k = idx & 1023, r = (idx >> 10) & 15, dir = (idx >> 14) & 1, j = idx >> 15;
        const float v = in_w1[((size_t)(j * 2 + dir) * 1024 + k) * 16 + r];
        ((bf16_t*)(ws + WS_GIN + j * SZ_GIN))[(size_t)(3072 + dir * 16 + r) * 1024 + k] = f2bf(v);
    }
    for (int idx = gtid; idx < 2 * 114688; idx += gstride) { const int j = idx / 114688, o = idx % 114688; ((unsigned*)(ws + WS_GIN + j * SZ_GIN + 3104ull * 1024 * 2))[o] = 0u; }
    for (int idx = gtid; idx < 2 * 32768; idx += gstride) { const int j = idx / 32768, o = idx % 32768; ((unsigned*)(ws + WS_MDOWN + j * SZ_MDOWN + 704ull * 1024 * 2))[o] = 0u; }
    for (int idx = gtid; idx < MR; idx += gstride) ((float*)(ws + WS_RS))[idx] = 0.f;
    LAS float* sl = (LAS float*)lds;
    LAS float* red = (LAS float*)(lds + 81920);
    __syncthreads();
    for (int idx = tid; idx < 17 * 1024; idx += NTHREADS) { const int r = idx >> 10, k = idx & 1023; const float v = r < 16 ? in_c[r * 1024 + k] : in_cctx[k]; sl[k * 20 + r] = v / (1.0f + __expf(-v)); }
    __syncthreads();
    float* mod = (float*)(ws + WS_MOD);
    for (int it = blockIdx.x; it < 384; it += gridDim.x) {
        const int layer = it / 96, n0 = (it % 96) * 64, nn = tid & 63, ks = tid >> 6;
        const float* W = in_wada + (size_t)layer * 1024 * 6144 + n0 + nn;
        float acc[17];
#pragma unroll
        for (int r = 0; r < 17; ++r) acc[r] = 0.f;
        for (int kk = 0; kk < 128; ++kk) {
            const int k = ks * 128 + kk; const float w = W[(size_t)k * 6144];
            const f32x4 s0 = *(const LAS f32x4*)(sl + k * 20), s1 = *(const LAS f32x4*)(sl + k * 20 + 4), s2 = *(const LAS f32x4*)(sl + k * 20 + 8), s3 = *(const LAS f32x4*)(sl + k * 20 + 12);
            const float s16 = sl[k * 20 + 16];
#pragma unroll
            for (int j = 0; j < 4; ++j) { acc[j] += s0[j] * w; acc[4 + j] += s1[j] * w; acc[8 + j] += s2[j] * w; acc[12 + j] += s3[j] * w; }
            acc[16] += s16 * w;
        }
#pragma unroll
        for (int r = 0; r < 17; ++r) red[(ks * 17 + r) * 64 + nn] = acc[r];
        __syncthreads();
        for (int o = tid; o < 17 * 64; o += NTHREADS) { const int r = o >> 6, c = o & 63; float s = in_bada[layer * 6144 + n0 + c];
#pragma unroll
            for (int k8 = 0; k8 < 8; ++k8) s += red[(k8 * 17 + r) * 64 + c];
            mod[(size_t)(layer * 17 + r) * 6144 + n0 + c] = s; }
        __syncthreads();
    }
}

DI void shw_phase(unsigned char* ws, LAS unsigned char* lds) {
    const int tid = tid_opq(), wave = tid >> 6, lane = tid & 63;
    LAS float* sl = (LAS float*)lds;
    const float* mod = (const float*)(ws + WS_MOD);
    constexpr int NCH = 4 * 44 + 6 + 26 + 6;
    for (int ch = blockIdx.x; ch < NCH; ch += gridDim.x) {
        int layer, kind, n0; const bf16_t* Bt;
        if (ch < 176) { layer = ch / 44; kind = 1; n0 = (ch % 44) * 128; Bt = (const bf16_t*)(ws + WS_FUP + (size_t)layer * SZ_FUP); }
        else if (ch < 182) { layer = 1; kind = 0; n0 = (ch - 176) * 128; Bt = (const bf16_t*)(ws + WS_MDOWN); }
        else if (ch < 208) { layer = 2; kind = 0; n0 = (ch - 182) * 128; Bt = (const bf16_t*)(ws + WS_GIN + SZ_GIN); }
        else { layer = 3; kind = 0; n0 = (ch - 208) * 128; Bt = (const bf16_t*)(ws + WS_MDOWN + SZ_MDOWN); }
        __syncthreads();
        for (int idx = tid; idx < 17 * 256; idx += NTHREADS) { const int b = idx >> 8, k4 = (idx & 255) * 4;
            *(LAS f32x4*)(sl + b * 1024 + k4) = *(const f32x4*)(mod + (size_t)(layer * 17 + b) * 6144 + (kind ? 3 * 1024 : 0) + k4); }
        __syncthreads();
        float* out = (float*)(ws + WS_SHW) + (size_t)((layer * 2 + kind) * 17) * 5632;
#pragma unroll 1
        for (int i = 0; i < 16; ++i) {
            const int n = n0 + wave * 16 + i;
            float w[16];
#pragma unroll
            for (int j = 0; j < 4; ++j) { const u32x2 t = *(const u32x2*)(Bt + (size_t)n * 1024 + j * 256 + lane * 4); w[4 * j] = bf_lo(t.x); w[4 * j + 1] = bf_hi(t.x); w[4 * j + 2] = bf_lo(t.y); w[4 * j + 3] = bf_hi(t.y); }
            float mine = 0.f;
#pragma unroll 1
            for (int b = 0; b < 17; ++b) {
                float a = 0.f;
#pragma unroll
                for (int j = 0; j < 4; ++j) { const f32x4 sv = *(const LAS f32x4*)(sl + b * 1024 + j * 256 + lane * 4); a += sv[0] * w[4 * j] + sv[1] * w[4 * j + 1] + sv[2] * w[4 * j + 2] + sv[3] * w[4 * j + 3]; }
                a = wave_sum(a);
                if (lane == b) mine = a;
            }
            if (lane < 17) out[(size_t)lane * 5632 + n] = mine;
        }
    }
    __syncthreads();
}

DI void norm_phase(const float* xl, const float* xc, const float* gain, const float* modl, int sh_off, int sc_off, bf16_t* h) {
    const int tid = tid_opq(), wave = tid >> 6, lane = tid & 63;
    for (int row0 = (blockIdx.x * 8 + wave) * 4; row0 < MR; row0 += gridDim.x * 32) {
        const float* src = row0 < TL ? xl + (size_t)row0 * 1024 : xc + (size_t)(row0 - TL) * 1024;
        const float* mb = modl + (size_t)(row0 < TL ? (row0 >> 12) : 16) * 6144;
        f32x4 v[4][4]; float ss[4];
#pragma unroll
        for (int r = 0; r < 4; ++r)
#pragma unroll
            for (int i = 0; i < 4; ++i) v[r][i] = *(const f32x4*)(src + (size_t)r * 1024 + i * 256 + lane * 4);
#pragma unroll
        for (int r = 0; r < 4; ++r) { float t = 0.f;
#pragma unroll
            for (int i = 0; i < 4; ++i) t += v[r][i][0] * v[r][i][0] + v[r][i][1] * v[r][i][1] + v[r][i][2] * v[r][i][2] + v[r][i][3] * v[r][i][3];
            ss[r] = t; }
#pragma unroll
        for (int o = 32; o >= 1; o >>= 1) {
#pragma unroll
            for (int r = 0; r < 4; ++r) ss[r] += __shfl_xor(ss[r], o);
        }
#pragma unroll
        for (int i = 0; i < 4; ++i) {
            const int c = i * 256 + lane * 4;
            const f32x4 g = *(const f32x4*)(gain + c), sc = *(const f32x4*)(mb + sc_off + c), sh = *(const f32x4*)(mb + sh_off + c);
            const f32x4 gs = g * (sc + 1.0f);
#pragma unroll
            for (int r = 0; r < 4; ++r) {
                const float rstd = rsqrtf(ss[r] * (1.0f / 1024.0f) + 1e-6f);
                const f32x4 y = (v[r][i] * rstd) * gs + sh;
                u32x2 w; w.x = cvt_pk_bf16(y[0], y[1]); w.y = cvt_pk_bf16(y[2], y[3]);
                *(u32x2*)(h + (size_t)(row0 + r) * 1024 + c) = w;
            }
        }
    }
}

DI void scan_rowbase(int dir, int b, int c, int& rb, int& sg) {
    if (dir == 0) { sg = 1; rb = c < 4 ? TL + b * CTXL + c * 64 : b * SEQ + (c - 4) * 64; }
    else { sg = -1; rb = c < 4 ? TL + b * CTXL + 255 - c * 64 : b * SEQ + 4095 - (c - 4) * 64; }
}
struct GPStage { unsigned qv[8], kv[8]; f32x4 lrv; float w2r[16][2]; f32x2 gbias; };
DI void gp_load(GPStage& S, int item, const bf16_t* qk, const float* lr, const float* w2, const float* gb, int tid, int wave, int d0) {
    const int c = item % 68, rest = item / 68, h = rest & 3, dir = (rest >> 2) & 1, b = rest >> 3;
    int rowbase, sgn; scan_rowbase(dir, b, c, rowbase, sgn);
#pragma unroll
    for (int i = 0; i < 8; ++i) { const size_t ro = (size_t)(rowbase + sgn * (wave * 8 + i)) * 1024; S.qv[i] = *(const unsigned*)(qk + ro + h * 128 + d0); S.kv[i] = *(const unsigned*)(qk + ro + 512 + h * 128 + d0); }
    S.lrv = (f32x4){0.f, 0.f, 0.f, 0.f};
    if (tid < 256) S.lrv = *(const f32x4*)(lr + (size_t)(rowbase + sgn * (tid >> 2)) * 32 + dir * 16 + (tid & 3) * 4);
#pragma unroll
    for (int r = 0; r < 16; ++r) { const f32x2 t = *(const f32x2*)(w2 + (size_t)(dir * 16 + r) * 512 + h * 128 + d0); S.w2r[r][0] = t.x; S.w2r[r][1] = t.y; }
    S.gbias = *(const f32x2*)(gb + dir * 512 + h * 128 + d0);
}
DI void gp_item(const GPStage& S, int item, bf16_t* GQ, bf16_t* GK, bf16_t* GP, float* GE, LAS unsigned char* lds, int tid, int wave, int lane) {
    constexpr int QD = 0, KI = 17408, LRS = 34816, SEG = 38912;
    const int l15 = lane & 15, lq = lane >> 4, d0 = 2 * lane;
    if (tid < 256) *(LAS f32x4*)(lds + LRS + (tid >> 2) * 64 + (tid & 3) * 16) = S.lrv;
    __syncthreads();
    const LAS float* lrs = (const LAS float*)(lds + LRS);
    float bl0[8], bl1[8]; float cum0 = 0.f, cum1 = 0.f;
#pragma unroll
    for (int i = 0; i < 8; ++i) {
        const int s = wave * 8 + i;
        float z0 = S.gbias.x, z1 = S.gbias.y;
#pragma unroll
        for (int r4 = 0; r4 < 4; ++r4) { const f32x4 lv = *(const LAS f32x4*)(lrs + s * 16 + r4 * 4);
#pragma unroll
            for (int j = 0; j < 4; ++j) { z0 += lv[j] * S.w2r[r4 * 4 + j][0]; z1 += lv[j] * S.w2r[r4 * 4 + j][1]; } }
        const float g0 = (fminf(z0, 0.f) - __logf(1.0f + __expf(-fabsf(z0)))) * 0.0625f;
        const float g1 = (fminf(z1, 0.f) - __logf(1.0f + __expf(-fabsf(z1)))) * 0.0625f;
        cum0 += g0; cum1 += g1; bl0[i] = cum0; bl1[i] = cum1;
    }
    *(LAS f32x2*)(lds + SEG + (wave * 128 + d0) * 4) = (f32x2){cum0, cum1};
    __syncthreads();
    float off0 = 0.f, off1 = 0.f, tot0 = 0.f, tot1 = 0.f;
#pragma unroll
    for (int w = 0; w < 8; ++w) { const f32x2 t = *(const LAS f32x2*)(lds + SEG + (w * 128 + d0) * 4); tot0 += t.x; tot1 += t.y; if (w < wave) { off0 += t.x; off1 += t.y; } }
    if (wave == 0) *(f32x2*)(GE + (size_t)item * 128 + d0) = (f32x2){__expf(tot0), __expf(tot1)};
    {
        unsigned ks0[4], ks1[4];
        bf16_t* gq = GQ + (size_t)item * 8192;
#pragma unroll
        for (int i = 0; i < 8; ++i) {
            const int s = wave * 8 + i;
            const float b0 = off0 + bl0[i], b1 = off1 + bl1[i];
            const float q0 = bf_lo(S.qv[i]), q1 = bf_hi(S.qv[i]), k0 = bf_lo(S.kv[i]), k1 = bf_hi(S.kv[i]);
            const unsigned qd = cvt_pk_bf16(q0 * __expf(b0), q1 * __expf(b1));
            *(LAS unsigned*)(lds + QD + s * 272 + d0 * 2) = qd;
            *(unsigned*)(gq + s * 128 + d0) = qd;
            *(LAS unsigned*)(lds + KI + s * 272 + d0 * 2) = cvt_pk_bf16(k0 * __expf(-b0), k1 * __expf(-b1));
            const float e0 = k0 * __expf(tot0 - b0), e1 = k1 * __expf(tot1 - b1);
            if (i & 1) { ks0[i >> 1] = (ks0[i >> 1] & 0xffffu) | (cvt_pk_bf16(0.f, e0) & 0xffff0000u); ks1[i >> 1] = (ks1[i >> 1] & 0xffffu) | (cvt_pk_bf16(0.f, e1) & 0xffff0000u); }
            else { ks0[i >> 1] = cvt_pk_bf16(e0, 0.f) & 0xffffu; ks1[i >> 1] = cvt_pk_bf16(e1, 0.f) & 0xffffu; }
        }
        bf16_t* gk = GK + (size_t)item * 8192;
        *(u32x4*)(gk + d0 * 64 + wave * 8) = (u32x4){ks0[0], ks0[1], ks0[2], ks0[3]};
        *(u32x4*)(gk + (d0 + 1) * 64 + wave * 8) = (u32x4){ks1[0], ks1[1], ks1[2], ks1[3]};
    }
    __syncthreads();
    {
        bf16_t* gp = GP + (size_t)item * 4096;
        const int t0 = 16 * (wave >> 1);
#pragma unroll
        for (int j = 0; j < 2; ++j) {
            const int s0 = 16 * ((wave & 1) * 2 + j);
            f32x4 a4 = (f32x4){0.f, 0.f, 0.f, 0.f};
#pragma unroll
            for (int kk = 0; kk < 4; ++kk) {
                const bf16x8 af = *(const LAS bf16x8*)(lds + QD + (t0 + l15) * 272 + (kk * 32 + 8 * lq) * 2);
                const bf16x8 bf = *(const LAS bf16x8*)(lds + KI + (s0 + l15) * 272 + (kk * 32 + 8 * lq) * 2);
                a4 = __builtin_amdgcn_mfma_f32_16x16x32_bf16(af, bf, a4, 0, 0, 0);
            }
            const int sc = s0 + l15;
#pragma unroll
            for (int r = 0; r < 4; ++r) { const int t = t0 + 4 * lq + r; gp[t * 64 + sc] = f2bf(sc <= t ? a4[r] : 0.f); }
        }
    }
}
DI void gateprep_phase(const bf16_t* qk, const float* lr, const float* w2, const float* gb, bf16_t* GQ, bf16_t* GK, bf16_t* GP, float* GE, LAS unsigned char* lds) {
    const int tid = tid_opq(), wave = __builtin_amdgcn_readfirstlane(tid >> 6), lane = tid & 63, d0 = 2 * lane;
    const int G = gridDim.x;
    GPStage A, B;
    int item = opq((int)blockIdx.x);
    if (item < NCHI) gp_load(A, item, qk, lr, w2, gb, tid, wave, d0);
    for (; item < NCHI; item += 2 * G) {
        if (item + G < NCHI) gp_load(B, item + G, qk, lr, w2, gb, tid, wave, d0);
        gp_item(A, item, GQ, GK, GP, GE, lds, tid, wave, lane);
        if (item + G < NCHI) {
            if (item + 2 * G < NCHI) gp_load(A, item + 2 * G, qk, lr, w2, gb, tid, wave, d0);
            gp_item(B, item + G, GQ, GK, GP, GE, lds, tid, wave, lane);
        }
    }
    __syncthreads();
}

DI void scan_phase(const bf16_t* vr, const bf16_t* GQ, const bf16_t* GK, const bf16_t* GP, const float* GE, bf16_t* of, bf16_t* ob, LAS unsigned char* lds) {
    constexpr int QD = 0, KST = 17408, VT = 35840, ST = 54272, PP = 89088, BL = 98304;
    const int tid = tid_opq(), wave = __builtin_amdgcn_readfirstlane(tid >> 6), lane = tid & 63;
    const int l31 = lane & 31, lh = lane >> 5;
    for (int item = blockIdx.x; item < 256; item += gridDim.x) {
        const int b = item >> 4, dir = (item >> 3) & 1, h = (item >> 1) & 3, dvh = item & 1;
        bf16_t* obuf = dir ? ob : of;
        const int d0 = 2 * lane;
        const int gi0 = ((b * 2 + dir) * 4 + h) * 68;
        f32x16 Sacc[2];
#pragma unroll
        for (int i = 0; i < 16; ++i) { Sacc[0][i] = 0.f; Sacc[1][i] = 0.f; }
        __syncthreads();
        for (int o = tid; o < 34816 / 16; o += NTHREADS) *(LAS u32x4*)(lds + ST + o * 16) = (u32x4){0u, 0u, 0u, 0u};
        const int vcol = h * 256 + dvh * 128 + d0;
        struct ScStage { u32x4 gq0, gq1, gk0, gk1, gp0; unsigned vv[8]; float ebv; } A, B;
        A.ebv = 0.f; B.ebv = 0.f;
#define SCAN_LOAD(S, c) do { int rb_, sg_; scan_rowbase(dir, b, (c), rb_, sg_); const size_t gi_ = (size_t)(gi0 + (c)); \
        S.gq0 = *(const u32x4*)(GQ + gi_ * 8192 + tid * 8); S.gq1 = *(const u32x4*)(GQ + gi_ * 8192 + 4096 + tid * 8); \
        S.gk0 = *(const u32x4*)(GK + gi_ * 8192 + tid * 8); S.gk1 = *(const u32x4*)(GK + gi_ * 8192 + 4096 + tid * 8); \
        S.gp0 = *(const u32x4*)(GP + gi_ * 4096 + tid * 8); if (tid < 128) S.ebv = GE[gi_ * 128 + tid]; \
        _Pragma("unroll") for (int i = 0; i < 8; ++i) S.vv[i] = *(const unsigned*)(vr + (size_t)(rb_ + sg_ * (wave * 8 + i)) * 2048 + vcol); } while (0)
#define SCAN_CHUNK(S, c) do { \
            int rowbase, sgn; scan_rowbase(dir, b, (c), rowbase, sgn); \
            { const int e0 = tid * 8, e1 = 4096 + tid * 8; \
              *(LAS u32x4*)(lds + QD + (e0 >> 7) * 272 + (e0 & 127) * 2) = S.gq0; *(LAS u32x4*)(lds + QD + (e1 >> 7) * 272 + (e1 & 127) * 2) = S.gq1; \
              *(LAS u32x4*)(lds + KST + (e0 >> 6) * 144 + (e0 & 63) * 2) = S.gk0; *(LAS u32x4*)(lds + KST + (e1 >> 6) * 144 + (e1 & 63) * 2) = S.gk1; \
              *(LAS u32x4*)(lds + PP + (e0 >> 6) * 144 + (e0 & 63) * 2) = S.gp0; \
              if (tid < 128) *(LAS float*)(lds + BL + tid * 4) = S.ebv; \
              unsigned vt0[4], vt1[4]; \
              _Pragma("unroll") for (int i = 0; i < 8; ++i) { \
                  if (i & 1) { vt0[i >> 1] = (vt0[i >> 1] & 0xffffu) | (S.vv[i] << 16); vt1[i >> 1] = (vt1[i >> 1] & 0xffffu) | (S.vv[i] & 0xffff0000u); } \
                  else { vt0[i >> 1] = S.vv[i] & 0xffffu; vt1[i >> 1] = S.vv[i] >> 16; } } \
              *(LAS u32x4*)(lds + VT + d0 * 144 + wave * 16) = (u32x4){vt0[0], vt0[1], vt0[2], vt0[3]}; \
              *(LAS u32x4*)(lds + VT + (d0 + 1) * 144 + wave * 16) = (u32x4){vt1[0], vt1[1], vt1[2], vt1[3]}; \
            } \
            __syncthreads();     \
            if ((c) + 2 < 68) SCAN_LOAD(S, (c) + 2); \
            { \
                const int tq = wave >> 2, vq = wave & 3; \
                f32x16 oacc; \
                _Pragma("unroll") for (int i = 0; i < 16; ++i) oacc[i] = 0.f; \
                _Pragma("unroll") for (int kk = 0; kk < 8; ++kk) { \
                    const bf16x8 af = *(const LAS bf16x8*)(lds + QD + (32 * tq + l31) * 272 + (kk * 16 + 8 * lh) * 2); \
                    const bf16x8 bf = *(const LAS bf16x8*)(lds + ST + (32 * vq + l31) * 272 + (kk * 16 + 8 * lh) * 2); \
                    oacc = __builtin_amdgcn_mfma_f32_32x32x16_bf16(af, bf, oacc, 0, 0, 0); } \
                _Pragma("unroll") for (int kk = 0; kk < 4; ++kk) { \
                    const bf16x8 af = *(const LAS bf16x8*)(lds + PP + (32 * tq + l31) * 144 + (kk * 16 + 8 * lh) * 2); \
                    const bf16x8 bf = *(const LAS bf16x8*)(lds + VT + (32 * vq + l31) * 144 + (kk * 16 + 8 * lh) * 2); \
                    oacc = __builtin_amdgcn_mfma_f32_32x32x16_bf16(af, bf, oacc, 0, 0, 0); } \
                const int ocol = h * 256 + dvh * 128 + 32 * vq + l31; \
                _Pragma("unroll") for (int r = 0; r < 16; ++r) { const int t = 32 * tq + crow(r, lh); obuf[(size_t)(rowbase + sgn * t) * 1024 + ocol] = f2bf(oacc[r]); } \
            } \
            { \
                const int vq = wave & 3; \
                _Pragma("unroll") for (int j = 0; j < 2; ++j) { \
                    const int dq = 2 * (wave >> 2) + j; \
                    _Pragma("unroll") for (int r = 0; r < 16; ++r) Sacc[j][r] *= *(const LAS float*)(lds + BL + (32 * dq + crow(r, lh)) * 4); \
                    _Pragma("unroll") for (int kk = 0; kk < 4; ++kk) { \
                        const bf16x8 af = *(const LAS bf16x8*)(lds + KST + (32 * dq + l31) * 144 + (kk * 16 + 8 * lh) * 2); \
                        const bf16x8 bf = *(const LAS bf16x8*)(lds + VT + (32 * vq + l31) * 144 + (kk * 16 + 8 * lh) * 2); \
                        Sacc[j] = __builtin_amdgcn_mfma_f32_32x32x16_bf16(af, bf, Sacc[j], 0, 0, 0); } } \
            } \
            __syncthreads();     \
            { \
                const int vq = wave & 3; \
                _Pragma("unroll") for (int j = 0; j < 2; ++j) { \
                    const int dq = 2 * (wave >> 2) + j; \
                    _Pragma("unroll") for (int g = 0; g < 4; ++g) { \
                        u32x2 w; w.x = cvt_pk_bf16(Sacc[j][4 * g], Sacc[j][4 * g + 1]); w.y = cvt_pk_bf16(Sacc[j][4 * g + 2], Sacc[j][4 * g + 3]); \
                        *(LAS u32x2*)(lds + ST + (32 * vq + l31) * 272 + (32 * dq + 8 * g + 4 * lh) * 2) = w; } } \
            } } while (0)
        SCAN_LOAD(A, 0); SCAN_LOAD(B, 1);
        for (int c = 0; c < 68; c += 2) { SCAN_CHUNK(A, c); SCAN_CHUNK(B, c + 1); }
#undef SCAN_CHUNK
#undef SCAN_LOAD
    }
    __syncthreads();
}

DI void glapost_phase(const bf16_t* of, const bf16_t* ob, const bf16_t* vr, const float* onorm, bf16_t* a) {
    const int tid = tid_opq(), wave = tid >> 6, lane = tid & 63;
    const int c0 = lane * 16;
    for (int row = blockIdx.x * 8 + wave; row < MR; row += gridDim.x * 8) {
        const u32x4 f0 = *(const u32x4*)(of + (size_t)row * 1024 + c0), f1 = *(const u32x4*)(of + (size_t)row * 1024 + c0 + 8);
        const u32x4 b0 = *(const u32x4*)(ob + (size_t)row * 1024 + c0), b1 = *(const u32x4*)(ob + (size_t)row * 1024 + c0 + 8);
        const u32x4 r0 = *(const u32x4*)(vr + (size_t)row * 2048 + 1024 + c0), r1 = *(const u32x4*)(vr + (size_t)row * 2048 + 1024 + c0 + 8);
        float o[16], rr[16];
#pragma unroll
        for (int j = 0; j < 4; ++j) {
            o[2 * j] = bf_lo(f0[j]) + bf_lo(b0[j]); o[2 * j + 1] = bf_hi(f0[j]) + bf_hi(b0[j]);
            o[8 + 2 * j] = bf_lo(f1[j]) + bf_lo(b1[j]); o[8 + 2 * j + 1] = bf_hi(f1[j]) + bf_hi(b1[j]);
            rr[2 * j] = bf_lo(r0[j]); rr[2 * j + 1] = bf_hi(r0[j]); rr[8 + 2 * j] = bf_lo(r1[j]); rr[8 + 2 * j + 1] = bf_hi(r1[j]);
        }
        float ss = 0.f;
#pragma unroll
        for (int j = 0; j < 16; ++j) ss += o[j] * o[j];
        ss += __shfl_xor(ss, 1); ss += __shfl_xor(ss, 2); ss += __shfl_xor(ss, 4); ss += __shfl_xor(ss, 8);
        const float rstd = rsqrtf(ss * (1.0f / 256.0f) + 1e-6f);
        const float* gn = onorm + (c0 & 255);
        unsigned w[8];
#pragma unroll
        for (int j = 0; j < 8; ++j) {
            const float y0 = o[2 * j] * rstd * gn[2 * j] * silu_f(rr[2 * j]), y1 = o[2 * j + 1] * rstd * gn[2 * j + 1] * silu_f(rr[2 * j + 1]);
            w[j] = cvt_pk_bf16(y0, y1);
        }
        *(u32x4*)(a + (size_t)row * 1024 + c0) = (u32x4){w[0], w[1], w[2], w[3]};
        *(u32x4*)(a + (size_t)row * 1024 + c0 + 8) = (u32x4){w[4], w[5], w[6], w[7]};
    }
}

DI void rope_cs(int tpos, int lane, float& cs, float& sn) {
    const int f = lane & 15; const int pos = (lane >> 5) ? (tpos & 63) : (tpos >> 6);
    const float inv = exp2f(-(float)f * (13.287712379549449f / 16.0f));
    const float ang = (float)pos * inv;
    const float kf = rintf(ang * 0.15915494309189535f);
    float r = fmaf(-kf, 6.2831854820251465f, ang); r = fmaf(-kf, -1.7484556000744883e-7f, r);
    cs = __cosf(r); sn = __sinf(r);
}
DI float rope_apply(float y, int lane, float cs, float sn) {
    const float pr = __shfl_xor(y, 16);
    return (lane & 16) ? (pr * sn + y * cs) : (y * cs - pr * sn);
}
DI int key_of_row(int row) {
    if (row < TL) { const int b = row >> 12; return b * KEYS + CTXL + (row & 4095); }
    const int rc = row - TL; const int b = rc >> 8; return b * KEYS + (rc & 255);
}

DI void mlamid_phase(const bf16_t* dn, const float* qln, const float* kvln, const float* knorm, bf16_t* cqn, bf16_t* ckvn, bf16_t* KB) {
    const int tid = tid_opq(), wave = tid >> 6, lane = tid & 63;
    for (int row = blockIdx.x * 8 + wave; row < MR; row += gridDim.x * 8) {
        const bf16_t* src = dn + (size_t)row * 768;
        unsigned q[3]; float ss = 0.f;
#pragma unroll
        for (int i = 0; i < 3; ++i) { q[i] = *(const unsigned*)(src + i * 128 + 2 * lane); const float a = bf_lo(q[i]), b = bf_hi(q[i]); ss += a * a + b * b; }
        ss = wave_sum(ss);
        float rstd = rsqrtf(ss * (1.0f / 384.0f) + 1e-6f);
#pragma unroll
        for (int i = 0; i < 3; ++i) { const int c = i * 128 + 2 * lane; *(unsigned*)(cqn + (size_t)row * 384 + c) = cvt_pk_bf16(bf_lo(q[i]) * rstd * qln[c], bf_hi(q[i]) * rstd * qln[c + 1]); }
        const u32x2 kvv = *(const u32x2*)(src + 384 + 4 * lane);
        const float k0 = bf_lo(kvv.x), k1 = bf_hi(kvv.x), k2 = bf_lo(kvv.y), k3 = bf_hi(kvv.y);
        ss = wave_sum(k0 * k0 + k1 * k1 + k2 * k2 + k3 * k3);
        rstd = rsqrtf(ss * (1.0f / 256.0f) + 1e-6f);
        { const f32x4 g = *(const f32x4*)(kvln + 4 * lane); u32x2 w; w.x = cvt_pk_bf16(k0 * rstd * g[0], k1 * rstd * g[1]); w.y = cvt_pk_bf16(k2 * rstd * g[2], k3 * rstd * g[3]);
          *(u32x2*)(ckvn + (size_t)row * 256 + 4 * lane) = w; }
        const float x = __uint_as_float(((unsigned)src[640 + lane]) << 16);
        ss = wave_sum(x * x);
        rstd = rsqrtf(ss * (1.0f / 64.0f) + 1e-6f);
        float y = x * rstd * knorm[128 + lane];
        if (row < TL) { float cs, sn; rope_cs(row & 4095, lane, cs, sn); y = rope_apply(y, lane, cs, sn); }
        const bf16_t yb = f2bf(y);
        bf16_t* kd = KB + (size_t)key_of_row(row) * 1536 + 128 + lane;
#pragma unroll
        for (int hh = 0; hh < 8; ++hh) kd[hh * 192] = yb;
    }
}

DI void qkprep_phase(bf16_t* Q, bf16_t* KB, const float* qnorm, const float* knorm) {
    const int tid = tid_opq(), wave = tid >> 6, lane = tid & 63;
    const float qn0 = qnorm[2 * lane], qn1 = qnorm[2 * lane + 1], qnr = qnorm[128 + lane];
    const float kn0 = knorm[2 * lane], kn1 = knorm[2 * lane + 1];
    for (int row = blockIdx.x * 8 + wave; row < MR; row += gridDim.x * 8) {
        float cs = 1.f, sn = 0.f;
        const bool lat = row < TL;
        if (lat) rope_cs(row & 4095, lane, cs, sn);
        bf16_t* qr = Q + (size_t)row * 1536;
        bf16_t* kr = KB + (size_t)key_of_row(row) * 1536;
#pragma unroll
        for (int hh = 0; hh < 8; ++hh) {
            const unsigned qa = *(const unsigned*)(qr + hh * 192 + 2 * lane);
            const float xr = __uint_as_float(((unsigned)qr[hh * 192 + 128 + lane]) << 16);
            const unsigned ka = *(const unsigned*)(kr + hh * 192 + 2 * lane);
            const float a0 = bf_lo(qa), a1 = bf_hi(qa), c0 = bf_lo(ka), c1 = bf_hi(ka);
            const float s1 = wave_sum(a0 * a0 + a1 * a1), s2 = wave_sum(xr * xr), s3 = wave_sum(c0 * c0 + c1 * c1);
            const float r1 = rsqrtf(s1 * (1.0f / 128.0f) + 1e-6f), r2 = rsqrtf(s2 * (1.0f / 64.0f) + 1e-6f), r3 = rsqrtf(s3 * (1.0f / 128.0f) + 1e-6f);
            *(unsigned*)(qr + hh * 192 + 2 * lane) = cvt_pk_bf16(a0 * r1 * qn0, a1 * r1 * qn1);
            float y = xr * r2 * qnr;
            if (lat) y = rope_apply(y, lane, cs, sn);
            qr[hh * 192 + 128 + lane] = f2bf(y);
            *(unsigned*)(kr + hh * 192 + 2 * lane) = cvt_pk_bf16(c0 * r3 * kn0, c1 * r3 * kn1);
        }
    }
}

namespace att {
constexpr int DQK = 192, DV = 128, NW = 8, QBLK = 32, KVBLK = 64;
constexpr int LDQ = 1536, LDK = 1536, LDV = 1024, LDO = 1024;
constexpr float SCALE = 0.07216878364870322f;
constexpr float THR = 8.f;
constexpr size_t SHM_V = KVBLK * DV * 2, SHM_K = KVBLK * DQK * 2;
#define KSWZ(row, colB) ((row) * 384 + ((colB) ^ ((((row) >> 1) & 7) << 4)))
#define SBAR() __builtin_amdgcn_sched_barrier(0)
DI unsigned cvtpk(float lo, float hi) { unsigned r; asm volatile("v_cvt_pk_bf16_f32 %0, %1, %2" : "=v"(r) : "v"(lo), "v"(hi)); return r; }
DI void partialSM(f32x16& p0, f32x16& p1, float& m_reg, float& mn, float& alpha) {
    constexpr float C = SCALE * 1.4426950408889634f;
    float pmax = p0[0];
#pragma unroll
    for (int r = 1; r < 16; ++r) pmax = fmaxf(pmax, p0[r]);
#pragma unroll
    for (int r = 0; r < 16; ++r) pmax = fmaxf(pmax, p1[r]);
    { auto rr = __builtin_amdgcn_permlane32_swap(__float_as_uint(pmax), __float_as_uint(pmax), false, false);
      pmax = fmaxf(__uint_as_float(rr[0]), __uint_as_float(rr[1])); }
    if (__builtin_expect(__all(pmax - m_reg <= THR / SCALE), 1)) { mn = m_reg; alpha = 1.f; }
    else { mn = fmaxf(m_reg, pmax); alpha = __builtin_amdgcn_exp2f((m_reg - mn) * C); m_reg = mn; }
    const float mnC = -mn * C;
#pragma unroll
    for (int r = 0; r < 16; ++r) p0[r] = fmaf(p0[r], C, mnC);
#pragma unroll
    for (int r = 0; r < 16; ++r) p1[r] = fmaf(p1[r], C, mnC);
#pragma unroll
    for (int r = 0; r < 16; ++r) p0[r] = __builtin_amdgcn_exp2f(p0[r]);
}
DI void finishSM(f32x16& p0, f32x16& p1, float alpha, float& l_reg, bf16x8& pa0, bf16x8& pa1, bf16x8& pa2, bf16x8& pa3) {
#pragma unroll
    for (int r = 0; r < 16; ++r) p1[r] = __builtin_amdgcn_exp2f(p1[r]);
    float ps = 0;
#pragma unroll
    for (int r = 0; r < 16; ++r) ps += p0[r];
#pragma unroll
    for (int r = 0; r < 16; ++r) ps += p1[r];
    { auto rr = __builtin_amdgcn_permlane32_swap(__float_as_uint(ps), __float_as_uint(ps), false, false);
      ps = __uint_as_float(rr[0]) + __uint_as_float(rr[1]); }
    l_reg = l_reg * alpha + ps;
#define PK4(P, BASE, OUT) do { unsigned a0 = cvtpk(P[BASE + 0], P[BASE + 1]), a1 = cvtpk(P[BASE + 2], P[BASE + 3]);   \
    unsigned b0 = cvtpk(P[BASE + 4], P[BASE + 5]), b1 = cvtpk(P[BASE + 6], P[BASE + 7]);                              \
    auto r0 = __builtin_amdgcn_permlane32_swap(a0, b0, false, false); auto r1 = __builtin_amdgcn_permlane32_swap(a1, b1, false, false); \
    u32x4 w = {r0[0], r1[0], r0[1], r1[1]}; OUT = *reinterpret_cast<bf16x8*>(&w); } while (0)
    PK4(p0, 0, pa0); PK4(p0, 8, pa1); PK4(p1, 0, pa2); PK4(p1, 8, pa3);
#undef PK4
}
DI void qkt(f32x16& p0, f32x16& p1, const char* Ks, const bf16x8* qr, int r32, int hi) {
#pragma unroll
    for (int r = 0; r < 16; ++r) { p0[r] = 0.f; p1[r] = 0.f; }
#pragma unroll
    for (int d0 = 0; d0 < 12; ++d0) { const int cb = (d0 * 16 + hi * 8) * 2;
        const bf16x8 b0 = *reinterpret_cast<const bf16x8*>(Ks + KSWZ(r32, cb));
        const bf16x8 b1 = *reinterpret_cast<const bf16x8*>(Ks + KSWZ(32 + r32, cb));
        p0 = __builtin_amdgcn_mfma_f32_32x32x16_bf16(b0, qr[d0], p0, 0, 0, 0);
        p1 = __builtin_amdgcn_mfma_f32_32x32x16_bf16(b1, qr[d0], p1, 0, 0, 0); }
}
DI int v_st(int k, int c) { const int kk = (k & ~0xC) | ((k & 4) << 1) | ((k & 8) >> 1); return ((kk >> 3) * 4 + (c >> 5)) * 512 + ((kk & 7) * 32 + (c & 31)) * 2; }
DI int v_rd_base(int lane) { return ((lane & 3) << 3) | (((lane >> 2) & 3) << 6) | (((lane >> 4) & 1) << 5) | (((lane >> 5) & 1) << 8); }
constexpr int v_rd_off(int d0, int ks, int half) { return d0 * 512 + ks * 4096 + half * 2048; }
template <int OFF> DI s16x4 tr_read(int vb) { s16x4 r; asm volatile("ds_read_b64_tr_b16 %0, %1 offset:%2" : "=&v"(r) : "v"(vb), "i"(OFF) : "memory"); return r; }
template <int D0> DI void pv_one(f32x16& od, int vb, bf16x8 pa0, bf16x8 pa1, bf16x8 pa2, bf16x8 pa3) {
    const s16x4 l0 = tr_read<v_rd_off(D0, 0, 0)>(vb), h0 = tr_read<v_rd_off(D0, 0, 1)>(vb), l1 = tr_read<v_rd_off(D0, 1, 0)>(vb), h1 = tr_read<v_rd_off(D0, 1, 1)>(vb);
    const s16x4 l2 = tr_read<v_rd_off(D0, 2, 0)>(vb), h2 = tr_read<v_rd_off(D0, 2, 1)>(vb), l3 = tr_read<v_rd_off(D0, 3, 0)>(vb), h3 = tr_read<v_rd_off(D0, 3, 1)>(vb);
    asm volatile("s_waitcnt lgkmcnt(0)" ::: "memory"); SBAR();
#define PK(L, H) (bf16x8){L[0], L[1], L[2], L[3], H[0], H[1], H[2], H[3]}
    od = __builtin_amdgcn_mfma_f32_32x32x16_bf16(pa0, PK(l0, h0), od, 0, 0, 0);
    od = __builtin_amdgcn_mfma_f32_32x32x16_bf16(pa1, PK(l1, h1), od, 0, 0, 0);
    od = __builtin_amdgcn_mfma_f32_32x32x16_bf16(pa2, PK(l2, h2), od, 0, 0, 0);
    od = __builtin_amdgcn_mfma_f32_32x32x16_bf16(pa3, PK(l3, h3), od, 0, 0, 0);
#undef PK
}
DI void pv_d0(f32x16* o, int vb, bf16x8 pa0, bf16x8 pa1, bf16x8 pa2, bf16x8 pa3) {
    pv_one<0>(o[0], vb, pa0, pa1, pa2, pa3); pv_one<1>(o[1], vb, pa0, pa1, pa2, pa3); pv_one<2>(o[2], vb, pa0, pa1, pa2, pa3); pv_one<3>(o[3], vb, pa0, pa1, pa2, pa3);
}
DI void attn_body(const bf16_t* __restrict__ Qb, const bf16_t* __restrict__ Kh, const bf16_t* __restrict__ Vh, bf16_t* __restrict__ Ob, int seq, char* lds) {
    const int tid = tid_opq(), wid = tid >> 6, lane = tid & 63, r32 = lane & 31, hi = lane >> 5;
    char* V_lds = lds; char* K_lds = lds + 2 * SHM_V;
    float* wsf = (float*)(lds + 2 * SHM_V + 2 * SHM_K) + wid * 64; float* li_l = wsf; float* al_l = wsf + 32;
    float m_reg = -1e30f, l_reg = 0; f32x16 o[4]; bf16x8 qr[12];
#pragma unroll
    for (int d = 0; d < 4; ++d)
#pragma unroll
        for (int r = 0; r < 16; ++r) o[d][r] = 0.f;
    const bf16_t* Qw = Qb + (long)(wid * QBLK + r32) * LDQ + hi * 8;
#pragma unroll
    for (int d0 = 0; d0 < 12; ++d0) qr[d0] = *reinterpret_cast<const bf16x8*>(Qw + d0 * 16);
    const int sr = tid >> 4, sc = (tid & 15) * 8, vst0 = v_st(sr, sc), vst1 = v_st(32 + sr, sc);
    const int pr = tid >> 3, pc = 128 + (tid & 7) * 8;
    const int vb0 = (int)(uintptr_t)V_lds + v_rd_base(lane);
    bf16x8 vs0, vs1, ks0, ks1, kp;
#define SLOAD(k0) do { vs0 = *reinterpret_cast<const bf16x8*>(&Vh[(long)((k0) + sr) * LDV + sc]); vs1 = *reinterpret_cast<const bf16x8*>(&Vh[(long)((k0) + 32 + sr) * LDV + sc]); \
    ks0 = *reinterpret_cast<const bf16x8*>(&Kh[(long)((k0) + sr) * LDK + sc]); ks1 = *reinterpret_cast<const bf16x8*>(&Kh[(long)((k0) + 32 + sr) * LDK + sc]); \
    kp = *reinterpret_cast<const bf16x8*>(&Kh[(long)((k0) + pr) * LDK + pc]); } while (0)
#define SWRITE(b) do { *(bf16x8*)(V_lds + (b) * SHM_V + vst0) = vs0; *(bf16x8*)(V_lds + (b) * SHM_V + vst1) = vs1; \
    *(bf16x8*)(K_lds + (b) * SHM_K + KSWZ(sr, sc * 2)) = ks0; *(bf16x8*)(K_lds + (b) * SHM_K + KSWZ(32 + sr, sc * 2)) = ks1; \
    *(bf16x8*)(K_lds + (b) * SHM_K + KSWZ(pr, pc * 2)) = kp; } while (0)
#define RESC(a) do { if (__any((a) < 1.f)) { if (hi == 0) al_l[r32] = (a); asm volatile("s_waitcnt lgkmcnt(0)" ::: "memory"); \
    _Pragma("unroll") for (int d = 0; d < 4; ++d) _Pragma("unroll") for (int r = 0; r < 16; ++r) o[d][r] *= al_l[crow(r, hi)]; } } while (0)
    f32x16 p0, p1; float mn, al; bf16x8 pa0, pa1, pa2, pa3; const int NT = seq / KVBLK;
    SLOAD(0); asm volatile("s_waitcnt vmcnt(0)" ::: "memory"); SWRITE(0); __syncthreads();
    for (int j = 0; j < NT; ++j) {
        const int cb = j & 1;
        if (j + 1 < NT) SLOAD((j + 1) * KVBLK);
        SBAR(); qkt(p0, p1, K_lds + cb * SHM_K, qr, r32, hi);
        partialSM(p0, p1, m_reg, mn, al);
        finishSM(p0, p1, al, l_reg, pa0, pa1, pa2, pa3);
        RESC(al); SBAR();
        pv_d0(o, vb0 + cb * (int)SHM_V, pa0, pa1, pa2, pa3);
        if (j + 1 < NT) { asm volatile("s_waitcnt vmcnt(0)" ::: "memory"); SWRITE(cb ^ 1); }
        __syncthreads();
    }
    if (hi == 0) li_l[r32] = l_reg; asm volatile("s_waitcnt lgkmcnt(0)" ::: "memory");
    float rli[16];
#pragma unroll
    for (int r = 0; r < 16; ++r) rli[r] = __builtin_amdgcn_rcpf(li_l[crow(r, hi)]);
    bf16_t* Ow = Ob + (long)(wid * QBLK) * LDO;
#pragma unroll
    for (int r = 0; r < 16; ++r) { const int orow = crow(r, hi);
#pragma unroll
        for (int d0 = 0; d0 < 4; ++d0) Ow[(long)orow * LDO + d0 * 32 + r32] = f2bf(o[d0][r] * rli[r]); }
#undef SLOAD
#undef SWRITE
#undef RESC
}
#undef KSWZ
#undef SBAR
}

DI void attn_phase(const bf16_t* Q, const bf16_t* KB, const bf16_t* VB, bf16_t* O, char* lds) {
    for (int it = blockIdx.x; it < 2048 + 128; it += gridDim.x) {
        int b, h, qrow0, seq;
        if (it < 2048) { b = it >> 7; h = (it >> 4) & 7; qrow0 = b * SEQ + (it & 15) * 256; seq = KEYS; }
        else { const int j = it - 2048; b = j >> 3; h = j & 7; qrow0 = TL + b * CTXL; seq = CTXL; }
        att::attn_body(Q + (size_t)qrow0 * 1536 + h * 192, KB + (size_t)b * KEYS * 1536 + h * 192, VB + (size_t)b * KEYS * 1024 + h * 128,
                       O + (size_t)qrow0 * 1024 + h * 128, seq, lds);
        __syncthreads();
    }
}

DI void fixup_phase(const float* halo, const float* cw, const float* cb, bf16_t* act) {
    const int gtid = blockIdx.x * NTHREADS + tid_opq(), gstride = gridDim.x * NTHREADS;
    for (int idx = gtid; idx < 272 * 22 * 64; idx += gstride) {
        const int c4 = (idx & 31) * 4, which = (idx >> 5) & 1, t = idx >> 6, pn = t % 22, pm = t / 22;
        const float* hp = halo + (size_t)(pm * 22 + pn) * 4 * 256;
        const bool sfirst = pm >= 256 || (pm & 15) == 0, slast = pm >= 256 || (pm & 15) == 15;
        const f32x4 z4 = (f32x4){0.f, 0.f, 0.f, 0.f};
        f32x4 pa, pg, ca, cg_, na, ng; int row;
        if (which == 0) { row = pm * 256;
            if (sfirst) { pa = z4; pg = z4; } else { const float* q = halo + (size_t)((pm - 1) * 22 + pn) * 4 * 256 + 3 * 256; pa = *(const f32x4*)(q + c4); pg = *(const f32x4*)(q + 128 + c4); }
            ca = *(const f32x4*)(hp + c4); cg_ = *(const f32x4*)(hp + 128 + c4); na = *(const f32x4*)(hp + 256 + c4); ng = *(const f32x4*)(hp + 256 + 128 + c4);
        } else { row = pm * 256 + 255;
            pa = *(const f32x4*)(hp + 2 * 256 + c4); pg = *(const f32x4*)(hp + 2 * 256 + 128 + c4); ca = *(const f32x4*)(hp + 3 * 256 + c4); cg_ = *(const f32x4*)(hp + 3 * 256 + 128 + c4);
            if (slast) { na = z4; ng = z4; } else { const float* q = halo + (size_t)((pm + 1) * 22 + pn) * 4 * 256; na = *(const f32x4*)(q + c4); ng = *(const f32x4*)(q + 128 + c4); }
        }
        const int ch = pn * 128 + c4;
        const f32x4 w0a = *(const f32x4*)(cw + ch), w1a = *(const f32x4*)(cw + 5632 + ch), w2a = *(const f32x4*)(cw + 2 * 5632 + ch), ba = *(const f32x4*)(cb + ch);
        const f32x4 w0g = *(const f32x4*)(cw + 2816 + ch), w1g = *(const f32x4*)(cw + 5632 + 2816 + ch), w2g = *(const f32x4*)(cw + 2 * 5632 + 2816 + ch), bg = *(const f32x4*)(cb + 2816 + ch);
        const f32x4 av = w0a * pa + w1a * ca + w2a * na + ba, gv = w0g * pg + w1g * cg_ + w2g * ng + bg;
        u32x2 w; w.x = cvt_pk_bf16(silu_f(gv[0]) * av[0], silu_f(gv[1]) * av[1]); w.y = cvt_pk_bf16(silu_f(gv[2]) * av[2], silu_f(gv[3]) * av[3]);
        *(u32x2*)(act + (size_t)row * 2816 + ch) = w;
    }
}


#define XB_TMO      128
#define XB_XCNT(j)  (256  + 64 * (j))
#define XB_XSUB(j)  (1280 + 64 * (j))
#define XB_XGEN(j)  (2304 + 64 * (j))
#define XB_TOP      3328
#define XB_TOPGEN   3392
#define XCD_BAR_WORDS 3456
#define XB_SPIN_CAP (1u << 18)
DI unsigned xb_ld(unsigned* p)              { return __hip_atomic_load(p, __ATOMIC_RELAXED, __HIP_MEMORY_SCOPE_AGENT); }
DI unsigned xb_add(unsigned* p, unsigned v) { return __hip_atomic_fetch_add(p, v, __ATOMIC_RELAXED, __HIP_MEMORY_SCOPE_AGENT); }
DI unsigned xb_xcc_id() { return (unsigned)__builtin_amdgcn_s_getreg((3 << 11) | 20) & 0xFu; }
#define XB_SPIN(cond, bar) do { unsigned _sp = 0; while (cond) { __builtin_amdgcn_s_sleep(1); \
    if ((++_sp & 255u) == 0u) { if (xb_ld(&(bar)[XB_TMO])) break; if (_sp > XB_SPIN_CAP) { atomicAdd(&(bar)[XB_TMO], 1u); break; } } } } while (0)
struct XcdBarrier { unsigned* bar; unsigned x; volatile LAS unsigned* st; };
DI XcdBarrier xcd_barrier_post(unsigned* bar, volatile LAS unsigned* st) {
    XcdBarrier b; b.bar = bar; b.x = xb_xcc_id(); b.st = st;
    if (threadIdx.x == 0) (void)xb_add(&bar[XB_XCNT(b.x)], 1u);
    return b;
}
DI void xcd_barrier_complete(unsigned* bar, unsigned x, unsigned& nloc, unsigned& nx) {
    const unsigned G = gridDim.x * gridDim.y * gridDim.z;
    unsigned sum, cnt, mine, sp = 0u;
    for (;;) {
        sum = 0u; cnt = 0u; mine = 0u;
#pragma unroll
        for (unsigned j = 0; j < 16; ++j) { const unsigned c = xb_ld(&bar[XB_XCNT(j)]); sum += c; cnt += (c > 0u) ? 1u : 0u; mine = (j == x) ? c : mine; }
        if (sum == G) break;
        __builtin_amdgcn_s_sleep(1);
        if ((++sp & 255u) == 0u) { if (xb_ld(&bar[XB_TMO])) break; if (sp > XB_SPIN_CAP) { atomicAdd(&bar[XB_TMO], 1u); break; } }
    }
    nloc = mine > 0u ? mine : 1u; nx = cnt > 0u ? cnt : 1u;
}
DI void xcd_barrier(const XcdBarrier& b) {
    asm volatile("s_waitcnt vmcnt(0)" ::: "memory");
    __syncthreads();
    if (threadIdx.x == 0) {
        unsigned* bar = b.bar;
        __builtin_amdgcn_s_waitcnt(0);
        unsigned nloc = b.st[0], nx = b.st[1];
        if (nloc == 0u) { xcd_barrier_complete(bar, b.x, nloc, nx); b.st[0] = nloc; b.st[1] = nx; }
        const unsigned old = xb_add(&bar[XB_XSUB(b.x)], 1u);
        const unsigned gen = old / nloc;
        if (old + 1u == (gen + 1u) * nloc) {
            __builtin_amdgcn_fence(__ATOMIC_RELEASE, "agent");
            asm volatile("s_waitcnt vmcnt(0)" ::: "memory");
            const unsigned og = xb_add(&bar[XB_TOP], 1u);
            const unsigned tg = og / nx;
            if (og + 1u == (tg + 1u) * nx) xb_add(&bar[XB_TOPGEN], 1u);
            else XB_SPIN(xb_ld(&bar[XB_TOPGEN]) == tg, bar);
            __builtin_amdgcn_fence(__ATOMIC_ACQUIRE, "agent");
            xb_add(&bar[XB_XGEN(b.x)], 1u);
            asm volatile("s_waitcnt vmcnt(0)" ::: "memory");
        } else {
            XB_SPIN(xb_ld(&bar[XB_XGEN(b.x)]) == gen, bar);
            __builtin_amdgcn_fence(__ATOMIC_ACQUIRE, "agent");
            asm volatile("s_waitcnt vmcnt(0)" ::: "memory");
        }
    }
    __syncthreads();
}

__global__ void __launch_bounds__(NTHREADS) mega(Params p) {
    extern __shared__ __attribute__((aligned(16))) unsigned char smem[];
    LAS unsigned char* lds = (LAS unsigned char*)smem;
    cg::grid_group grid = cg::this_grid();
    volatile LAS unsigned* xb_st = (volatile LAS unsigned*)(lds + XB_ST_OFF);
    if (threadIdx.x < 4) xb_st[threadIdx.x] = 0u;
    __syncthreads();
    XcdBarrier xbar = xcd_barrier_post((unsigned*)((unsigned char*)p.in[27] + WS_BAR), xb_st);

    for (int ph = p.ph_lo; ph < p.ph_hi; ++ph) {
        unsigned char* ws = (unsigned char*)p.in[opq(27)];
        float* const xout = (float*)p.in[opq(26)];
        float* mod = (float*)(ws + WS_MOD);
        float* xc = (float*)(ws + WS_XC);
        bf16_t* hbuf = (bf16_t*)(ws + WS_H);
        if (ph == 0) {
            prep_phase(p, lds);
#if defined(MK_DUP_OP) && MK_DUP_OP == 99
            grid.sync(); prep_phase(p, lds);
#endif
        } else {
            const int q = ph - 1, lp = q / 21; int r = q % 21; int layer, nmix;
            if (r < 10) { layer = 2 * lp; nmix = 6; } else { layer = 2 * lp + 1; r -= 10; nmix = 7; }
            const bool is_mla = layer & 1; const int j = layer >> 1;
            const float* modl = mod + (size_t)layer * 17 * 6144;
            const bool first = (layer == 0);
            int op = -1, gsel = 0, hf = 0;
            if (r < nmix) {
                if (!is_mla) { op = r == 0 ? 0 : r == 1 ? 2 : r == 2 ? 9 : r == 3 ? 3 : r == 4 ? 4 : 2; gsel = r == 1 ? 0 : 1; }
                else { op = r == 0 ? 0 : r == 1 ? 2 : r == 2 ? 5 : r == 3 ? 2 : r == 4 ? 6 : r == 5 ? 7 : 2; gsel = r == 1 ? 2 : r == 3 ? 3 : 5; }
            } else {
                const int f = r - nmix;
                op = f == 0 ? 1 : f == 2 ? 8 : 2; gsel = f == 1 ? 6 : 7;
            }
            if (op == 1 || (op == 0 && layer > 0)) continue;
#ifdef MK_DUP_OP
            for (int rep_ = 0; rep_ < ((op == MK_DUP_OP || (op == 2 && gsel == MK_DUP_OP - 100)) ? 2 : 1); ++rep_) {
            if (rep_) grid.sync();
#else
            {
#endif
            if (op == 0) {
                norm_phase(p.in[opq(0)], p.in[opq(2)], p.in[opq(6)], modl, 0, 1024, hbuf);
                shw_phase(ws, lds);
            } else if (op == 2) {
                const int ng = (gsel == 3) ? 2 : 1;
                for (int gi = 0; gi < ng; ++gi) {
                    pg8::Gemm g; Epi E; int kind = EPI_BF16;
                    E.ldc = 0; E.xch = (LAS float*)(lds + XCH_OFF); E.q0 = nullptr; E.q1 = nullptr; E.q2 = nullptr; E.q3 = nullptr; E.q4 = nullptr; E.q5 = nullptr;
                    float* const shw_mix = (float*)(ws + WS_SHW) + (size_t)(layer * 2) * 17 * 5632; float* const shw_ffn = shw_mix + 17 * 5632;
                    float* const rs0 = (float*)(ws + WS_RS); float* const rs1 = rs0 + MR;
                    g.M = MR;
                    const int gs = gsel + gi;
                    if (gs == 0) { g.A = hbuf; g.Bt = (const bf16_t*)(ws + WS_GIN + j * SZ_GIN); g.N = 3328; g.K = 1024; g.lda = 1024; g.ldb = 1024;
                        kind = EPI_GLA_IN; E.q0 = ws + WS_QK; E.ldc = 1024; E.q1 = ws + WS_LR; E.q2 = ws + WS_VR; if (!first) { E.q3 = rs1; E.q4 = shw_mix; } }
                    else if (gs == 1 || gs == 5) { g.A = hbuf; g.Bt = (const bf16_t*)(ws + (gs == 1 ? WS_GOUT : WS_MOUT) + j * SZ_SQ); g.N = 1024; g.K = 1024; g.lda = 1024; g.ldb = 1024;
                        kind = EPI_RESID; E.ldc = 0; E.q0 = (void*)(first ? p.in[opq(0)] : xout); E.q1 = (void*)(first ? p.in[opq(2)] : xc); E.q2 = xout; E.q3 = ws; E.q4 = (void*)modl; E.q5 = (void*)(p.in[opq(7)] + layer * 1024);
                        for (int i = blockIdx.x * NTHREADS + tid_opq(); i < MR; i += gridDim.x * NTHREADS) rs1[i] = 0.f; }
                    else if (gs == 2) { g.A = hbuf; g.Bt = (const bf16_t*)(ws + WS_MDOWN + j * SZ_MDOWN); g.N = 768; g.K = 1024; g.lda = 1024; g.ldb = 1024;
                        E.q0 = ws + WS_DN; E.ldc = 768; E.q3 = rs1; E.q4 = shw_mix; }
                    else if (gs == 3) { g.A = (const bf16_t*)(ws + WS_CQN); g.Bt = (const bf16_t*)(ws + WS_MUQ + j * SZ_MUQ); g.N = 1536; g.K = 384; g.lda = 384; g.ldb = 384;
                        E.q0 = ws + WS_QRAW; E.ldc = 1536; }
                    else if (gs == 4) { g.A = (const bf16_t*)(ws + WS_CKVN); g.Bt = (const bf16_t*)(ws + WS_MUKV + j * SZ_MUKV); g.N = 2048; g.K = 256; g.lda = 256; g.ldb = 256;
                        kind = EPI_UKV; E.q0 = ws + WS_KB; E.q1 = ws + WS_VB; }
                    else if (gs == 6) { g.A = (const bf16_t*)(ws + WS_XSA); g.Bt = (const bf16_t*)(ws + WS_FUP + (size_t)layer * SZ_FUP); g.N = 5632; g.K = 1024; g.lda = 1024; g.ldb = 1024;
                        kind = EPI_FFN_UP; E.q0 = ws + WS_ACT; E.ldc = 2816; E.q1 = (void*)(p.in[opq(23)] + (size_t)layer * 3 * 2 * DFF); E.q2 = (void*)(p.in[opq(24)] + (size_t)layer * 2 * DFF);
                        E.q3 = ws + WS_HALO; E.q4 = rs0; E.q5 = shw_ffn; }
                    else { g.A = (const bf16_t*)(ws + WS_ACT); g.Bt = (const bf16_t*)(ws + WS_FDOWN + (size_t)layer * SZ_FDOWN); g.N = 1024; g.K = 2816; g.lda = 2816; g.ldb = 2816;
                        kind = EPI_RESID; E.ldc = 1; E.q0 = xout; E.q1 = xc; E.q2 = xout; E.q3 = ws; E.q4 = (void*)modl; E.q5 = layer < 3 ? (void*)(p.in[opq(6)] + (layer + 1) * 1024) : nullptr;
                        for (int i = blockIdx.x * NTHREADS + tid_opq(); i < MR; i += gridDim.x * NTHREADS) rs0[i] = 0.f; }
                    pg8::StaticOrder S; S.init(g.M, g.N, (int)gridDim.x, (int)blockIdx.x);
                    if (kind == EPI_BF16) pg8::gemm_phase<Epi, EPI_BF16>(lds, g, S, E);
                    else if (kind == EPI_GLA_IN) pg8::gemm_phase<Epi, EPI_GLA_IN>(lds, g, S, E);
                    else if (kind == EPI_RESID) pg8::gemm_phase<Epi, EPI_RESID>(lds, g, S, E);
                    else if (kind == EPI_UKV) pg8::gemm_phase<Epi, EPI_UKV>(lds, g, S, E);
                    else pg8::gemm_phase<Epi, EPI_FFN_UP>(lds, g, S, E);
                    __syncthreads();
                }
            } else if (op == 3) {
                scan_phase((const bf16_t*)(ws + WS_VR), (const bf16_t*)(ws + WS_GQ), (const bf16_t*)(ws + WS_GK), (const bf16_t*)(ws + WS_GP), (const float*)(ws + WS_GE),
                           hbuf, (bf16_t*)(ws + WS_QK), lds);
            } else if (op == 9) {
                gateprep_phase((const bf16_t*)(ws + WS_QK), (const float*)(ws + WS_LR), p.in[opq(10)] + (size_t)j * 2 * 16 * 512, p.in[opq(11)] + (size_t)j * 2 * 512,
                               (bf16_t*)(ws + WS_GQ), (bf16_t*)(ws + WS_GK), (bf16_t*)(ws + WS_GP), (float*)(ws + WS_GE), lds);
            } else if (op == 4) {
                glapost_phase(hbuf, (const bf16_t*)(ws + WS_QK), (const bf16_t*)(ws + WS_VR), p.in[opq(12)] + j * 256, hbuf);
            } else if (op == 5) {
                mlamid_phase((const bf16_t*)(ws + WS_DN), p.in[opq(15)] + j * 384, p.in[opq(16)] + j * 256, p.in[opq(20)] + j * 192, (bf16_t*)(ws + WS_CQN), (bf16_t*)(ws + WS_CKVN), (bf16_t*)(ws + WS_KB));
            } else if (op == 6) {
                qkprep_phase((bf16_t*)(ws + WS_QRAW), (bf16_t*)(ws + WS_KB), p.in[opq(19)] + j * 192, p.in[opq(20)] + j * 192);
            } else if (op == 7) {
                attn_phase((const bf16_t*)(ws + WS_QRAW), (const bf16_t*)(ws + WS_KB), (const bf16_t*)(ws + WS_VB), hbuf, (char*)smem);
            } else if (op == 8) {
                fixup_phase((const float*)(ws + WS_HALO), p.in[opq(23)] + (size_t)layer * 3 * 2 * DFF, p.in[opq(24)] + (size_t)layer * 2 * DFF, (bf16_t*)(ws + WS_ACT));
            }
            }
        }
        if (ph + 1 < p.ph_hi) { if (ph == 0) grid.sync(); else xcd_barrier(xbar); }
    }
}

extern "C" void kernel_launch(void* const* d_in, const int* in_sizes, int n_in, void* d_out, int out_size, void* d_ws, size_t ws_size, hipStream_t stream) {
    static int grid = 0;
    if (grid == 0) {
        if (n_in != 26 || ws_size < WS_END) { fprintf(stderr, "kernel_launch: n_in %d ws %zu (need %zu)\n", n_in, ws_size, (size_t)WS_END); grid = -1; return; }
        int dev = 0, cus = 0, per_cu = 0;
        hipGetDevice(&dev);
        hipDeviceGetAttribute(&cus, hipDeviceAttributeMultiprocessorCount, dev);
        if (hipFuncSetAttribute((const void*)mega, hipFuncAttributeMaxDynamicSharedMemorySize, LDS_BYTES) != hipSuccess) { fprintf(stderr, "kernel_launch: hipFuncSetAttribute failed\n"); grid = -1; return; }
        if (hipOccupancyMaxActiveBlocksPerMultiprocessor(&per_cu, (const void*)mega, NTHREADS, LDS_BYTES) != hipSuccess || per_cu < 1) { fprintf(stderr, "kernel_launch: occupancy query %d\n", per_cu); per_cu = 1; }
        (void)hipGetLastError();
        grid = cus * per_cu;
        fprintf(stderr, "kernel_launch: grid %d (cus %d x %d)\n", grid, cus, per_cu);
    }
    if (grid < 0) return;
    Params p{};
    for (int i = 0; i < 26; ++i) p.in[i] = (const float*)d_in[i];
    p.in[26] = (const float*)d_out; p.in[27] = (const float*)d_ws;
    (void)hipMemsetAsync((unsigned char*)d_ws + WS_BAR, 0, 16384, stream);
#if MK_MULTI
    for (int ph = 0; ph < NPH; ++ph) {
        p.ph_lo = ph; p.ph_hi = ph + 1;
        hipLaunchKernelGGL(mega, dim3(grid), dim3(NTHREADS), LDS_BYTES, stream, p);
    }
#else
    p.ph_lo = 0; p.ph_hi = NPH;
    void* args[] = {&p};
    hipError_t e = hipLaunchCooperativeKernel((const void*)mega, dim3(grid), dim3(NTHREADS), args, LDS_BYTES, stream);
    if (e != hipSuccess) fprintf(stderr, "cooperative launch failed: %s (grid %d)\n", hipGetErrorString(e), grid);
#endif
}
```

```cpp
#include <hip/hip_runtime.h>
#include <hip/hip_cooperative_groups.h>
#include <cstdio>
#include <cstdint>
namespace cg = cooperative_groups;

#ifndef MK_MULTI
#define MK_MULTI 0
#endif

#define LAS __attribute__((address_space(3)))
#define DI __device__ __forceinline__
typedef unsigned short bf16_t;
typedef short bf16x8 __attribute__((ext_vector_type(8)));
typedef short s16x4 __attribute__((ext_vector_type(4)));
typedef float f32x2 __attribute__((ext_vector_type(2)));
typedef float f32x4 __attribute__((ext_vector_type(4)));
typedef float f32x16 __attribute__((ext_vector_type(16)));
typedef unsigned u32x2 __attribute__((ext_vector_type(2)));
typedef unsigned u32x4 __attribute__((ext_vector_type(4)));

constexpr int DM = 1024, NB = 16, SEQ = 4096, CTXL = 256;
constexpr int TL = NB * SEQ, TC = NB * CTXL, MR = TL + TC;
constexpr int KEYS = CTXL + SEQ;
constexpr int DFF = 2816, DFFH = 1408;
constexpr int NTHREADS = 512;
constexpr int XB_ST_OFF = 131072 + 12288 + 2 * 5120 + 6144;
constexpr int LDS_BYTES = XB_ST_OFF + 16;
constexpr int WIMG_F = 3072, PREW_F = 3072 + 2 * 1280;
constexpr int XCH_OFF = 131072;
constexpr int NPH = 43;

constexpr size_t SZ_GIN = 3328ull * 1024 * 2, SZ_SQ = 1024ull * 1024 * 2, SZ_MDOWN = 768ull * 1024 * 2, SZ_MUQ = 1536ull * 384 * 2,
                 SZ_MUKV = 2048ull * 256 * 2, SZ_FUP = 5632ull * 1024 * 2, SZ_FDOWN = 1024ull * 2816 * 2;
constexpr size_t WS_GIN = 0;
constexpr size_t WS_GOUT = WS_GIN + 2 * SZ_GIN;
constexpr size_t WS_MDOWN = WS_GOUT + 2 * SZ_SQ;
constexpr size_t WS_MUQ = WS_MDOWN + 2 * SZ_MDOWN;
constexpr size_t WS_MUKV = WS_MUQ + 2 * SZ_MUQ;
constexpr size_t WS_MOUT = WS_MUKV + 2 * SZ_MUKV;
constexpr size_t WS_FUP = WS_MOUT + 2 * SZ_SQ;
constexpr size_t WS_FDOWN = WS_FUP + 4 * SZ_FUP;
constexpr size_t WS_MOD = WS_FDOWN + 4 * SZ_FDOWN;
constexpr size_t SZ_MOD = 4ull * 17 * 6144 * 4;
constexpr size_t WS_RS = WS_MOD + ((SZ_MOD + 255) / 256) * 256;
constexpr size_t WS_SHW = WS_RS + 2ull * MR * 4;
constexpr size_t WS_BAR = WS_SHW + 4ull * 2 * 17 * 5632 * 4;
constexpr size_t WS_XC = WS_BAR + 16384;
constexpr size_t WS_H = WS_XC + (size_t)TC * 1024 * 4;
constexpr size_t WS_R = WS_H + (size_t)MR * 1024 * 2;
constexpr size_t WS_QK = WS_R;
constexpr size_t WS_VR = WS_QK + (size_t)MR * 1024 * 2;
constexpr size_t WS_LR = WS_VR + (size_t)MR * 2048 * 2;
constexpr int NCHI = NB * 2 * 4 * 68;
constexpr size_t WS_GQ = WS_LR + (size_t)MR * 32 * 4;
constexpr size_t WS_GK = WS_GQ + (size_t)NCHI * 64 * 128 * 2;
constexpr size_t WS_GP = WS_GK + (size_t)NCHI * 64 * 128 * 2;
constexpr size_t WS_GE = WS_GP + (size_t)NCHI * 64 * 64 * 2;
constexpr size_t WS_GLA_END = WS_GE + (size_t)NCHI * 128 * 4;
constexpr size_t WS_QRAW = WS_R;
constexpr size_t WS_DN = WS_R;
constexpr size_t WS_CQN = WS_QRAW + (size_t)MR * 1536 * 2;
constexpr size_t WS_CKVN = WS_CQN + (size_t)MR * 384 * 2;
constexpr size_t WS_KB = WS_CKVN + (size_t)MR * 256 * 2;
constexpr size_t WS_VB = WS_KB + (size_t)NB * KEYS * 1536 * 2;
constexpr size_t WS_MLA_END = WS_VB + (size_t)NB * KEYS * 1024 * 2;
constexpr size_t WS_ACT = WS_R;
constexpr size_t WS_HALO = WS_ACT + (size_t)MR * 2816 * 2;
constexpr size_t WS_XSA = WS_HALO + 272ull * 22 * 4 * 256 * 4;
constexpr size_t WS_FFN_END = WS_XSA + (size_t)MR * 1024 * 2;
constexpr size_t WS_END = WS_GLA_END > WS_MLA_END ? (WS_GLA_END > WS_FFN_END ? WS_GLA_END : WS_FFN_END) : (WS_MLA_END > WS_FFN_END ? WS_MLA_END : WS_FFN_END);
static_assert(WS_END <= (1ull << 30), "workspace over 1 GiB");

struct Params { const float* in[28]; int ph_lo, ph_hi; };

DI unsigned cvt_pk_bf16(float lo, float hi) { unsigned r; asm("v_cvt_pk_bf16_f32 %0, %1, %2" : "=v"(r) : "v"(lo), "v"(hi)); return r; }
DI float bf_lo(unsigned u) { return __uint_as_float(u << 16); }
DI float bf_hi(unsigned u) { return __uint_as_float(u & 0xffff0000u); }
DI bf16_t f2bf(float f) { return (bf16_t)(cvt_pk_bf16(f, 0.f) & 0xffffu); }
DI float wave_sum(float v) {
    v += __int_as_float(__builtin_amdgcn_update_dpp(0, __float_as_int(v), 0xB1, 0xF, 0xF, false));
    v += __int_as_float(__builtin_amdgcn_update_dpp(0, __float_as_int(v), 0x4E, 0xF, 0xF, false));
    v += __int_as_float(__builtin_amdgcn_update_dpp(0, __float_as_int(v), 0x141, 0xF, 0xF, false));
    v += __int_as_float(__builtin_amdgcn_update_dpp(0, __float_as_int(v), 0x140, 0xF, 0xF, false));
    v += __int_as_float(__builtin_amdgcn_update_dpp(0, __float_as_int(v), 0x142, 0xA, 0xF, false));
    v += __int_as_float(__builtin_amdgcn_update_dpp(0, __float_as_int(v), 0x143, 0xC, 0xF, false));
    return __int_as_float(__builtin_amdgcn_readlane(__float_as_int(v), 63));
}
DI float silu_f(float v) { return v * __builtin_amdgcn_rcpf(1.0f + __expf(-v)); }
DI int crow(int r, int hi) { return (r & 3) + 8 * (r >> 2) + 4 * hi; }
DI int tid_opq() { int t = threadIdx.x; asm volatile("" : "+v"(t)); return t; }
DI int opq(int i) { asm volatile("" : "+s"(i)); return i; }

namespace pg8 {
constexpr int BM = 256, BK = 64, HALF = 128, HTB = HALF * BK * 2, STAGE_BYTES = 8 * HTB, NXCD = 8, WGM = 8;
DI int lds_byte(int r, int c) { const int st = (r >> 4) * 2 + (c >> 5), rr = r & 15, cc = c & 31, ob = rr * 64 + cc * 2; return st * 1024 + (ob ^ (((ob >> 9) & 1) << 5)); }
DI void stage_rc(int b, int& R, int& C) { const int st = b / 1024, sb = b % 1024, swz = sb ^ (((sb >> 9) & 1) << 5); R = (st >> 1) * 16 + swz / 64; C = (st & 1) * 32 + (swz % 64) / 2; }
DI int perm32(int rho) { const int n = rho >> 4, i = rho & 15; return 8 * (i >> 2) + 4 * n + (i & 3); }
struct Unit { int pm, pn; };
struct Gemm { const bf16_t* A; const bf16_t* Bt; int M, N, K, lda, ldb; };
struct StaticOrder {
    int nM, nN, nwg, G, c;
    DI void init(int M, int N, int G_, int c_) { nM = M / BM; nN = N / BM; nwg = nM * nN; G = G_; c = c_; }
    DI bool next(int i, Unit& u) const {
        const long L = (long)i * G + c; if (L >= nwg) return false;
        int wgid = (int)L; { const int q = nwg / NXCD, r = nwg % NXCD, xcd = wgid % NXCD, off = wgid / NXCD; wgid = (xcd < r ? xcd * (q + 1) : r * (q + 1) + (xcd - r) * q) + off; }
        const int nig = WGM * nN, gid = wgid / nig, fm = gid * WGM, gsz = (nM - fm) < WGM ? (nM - fm) : WGM;
        u.pm = fm + ((wgid % nig) % gsz); u.pn = (wgid % nig) / gsz; return true;
    }
};

template <class Epi, int KIND>
DI void gemm_phase(LAS unsigned char* lds, const Gemm g, const StaticOrder& S, const Epi& E) {
    constexpr bool perm = Epi::template perm_of<KIND>();
    const int tid = tid_opq(), wid = __builtin_amdgcn_readfirstlane(tid >> 6), lane = tid & 63, wr = wid >> 2, wc = wid & 3, fr = lane & 15, fq = lane >> 4;
    const int K = g.K, nt = K / BK;
    unsigned voffA[2], voffB[2];
#pragma unroll
    for (int i = 0; i < 2; ++i) { int R, C; stage_rc(tid * 16 + i * 8192, R, C); const int Rb = perm ? ((R & ~31) + perm32(R & 31)) : R;
        voffA[i] = (unsigned)(R * g.lda + C) * 2u; voffB[i] = (unsigned)(Rb * g.ldb + C) * 2u; }
    const size_t kstep = (size_t)(BK * 2);
    const size_t hstepA = (size_t)HALF * g.lda * 2, hstepB = (size_t)HALF * g.ldb * 2;
    const size_t tstepA = 2 * hstepA, tstepB = 2 * hstepB;
    const unsigned ldsw = (unsigned)wid * 1024u;
    const int aoff = lds_byte(wr * 64 + fr, fq * 8), boff = lds_byte(wc * 32 + fr, fq * 8);
#define PG8_SA(b, h) (((b) * 2 + (h)) * HTB)
#define PG8_SB(b, h) ((4 + (b) * 2 + (h)) * HTB)
#define PG8_STAGE(bufoff, gbase, voff) do { _Pragma("unroll") for (int _i = 0; _i < 2; ++_i) \
        __builtin_amdgcn_global_load_lds((const unsigned*)((const char*)(gbase) + (voff)[_i]), (LAS unsigned*)(lds + (bufoff) + ldsw + _i * 8192), 16, 0, 0); } while (0)
#define PG8_LDA(dst, b, h) do { _Pragma("unroll") for (int m = 0; m < 4; ++m) _Pragma("unroll") for (int k = 0; k < 2; ++k) dst[m][k] = *(const LAS bf16x8*)(lds + PG8_SA(b, h) + aoff + m * 2048 + k * 1024); } while (0)
#define PG8_LDB(dst, b, h) do { _Pragma("unroll") for (int n = 0; n < 2; ++n) _Pragma("unroll") for (int k = 0; k < 2; ++k) dst[n][k] = *(const LAS bf16x8*)(lds + PG8_SB(b, h) + boff + n * 2048 + k * 1024); } while (0)
#define PG8_MMA(ai, bj, At, Bt) do { __builtin_amdgcn_s_setprio(1); _Pragma("unroll") for (int m = 0; m < 4; ++m) _Pragma("unroll") for (int n = 0; n < 2; ++n) _Pragma("unroll") for (int k = 0; k < 2; ++k) \
        acc[ai][bj][m][n] = __builtin_amdgcn_mfma_f32_16x16x32_bf16(Bt[n][k], At[m][k], acc[ai][bj][m][n], 0, 0, 0); __builtin_amdgcn_s_setprio(0); } while (0)
#define PG8_WAIT_V(n) asm volatile("s_waitcnt vmcnt(" #n ")" ::: "memory")
#define PG8_WAIT_L(n) asm volatile("s_waitcnt lgkmcnt(" #n ")" ::: "memory")
#define PG8_BAR __builtin_amdgcn_s_barrier()
#define PG8_SCHED __builtin_amdgcn_sched_barrier(0)
    Unit cur, nxt; int ui = 0;
    if (!S.next(0, cur)) return;
    f32x4 acc[2][2][4][2];
#pragma unroll
    for (int a = 0; a < 2; ++a)
#pragma unroll
        for (int b = 0; b < 2; ++b)
#pragma unroll
            for (int m = 0; m < 4; ++m)
#pragma unroll
                for (int n = 0; n < 2; ++n) acc[a][b][m][n] = (f32x4){0.f, 0.f, 0.f, 0.f};
    bf16x8 At[4][2], B0[2][2], B1[2][2];
    typename Epi::Pre pre;
    const char* cA = (const char*)g.A + (size_t)cur.pm * tstepA; const char* cB = (const char*)g.Bt + (size_t)cur.pn * tstepB;
    PG8_STAGE(PG8_SB(0, 0), cB, voffB); PG8_STAGE(PG8_SA(0, 0), cA, voffA); PG8_STAGE(PG8_SB(0, 1), cB + hstepB, voffB); PG8_STAGE(PG8_SA(0, 1), cA + hstepA, voffA);
    if (wr == 1) PG8_BAR;
    PG8_WAIT_V(4); PG8_BAR;
    PG8_STAGE(PG8_SB(1, 0), cB + kstep, voffB); PG8_STAGE(PG8_SA(1, 0), cA + kstep, voffA); PG8_STAGE(PG8_SB(1, 1), cB + hstepB + kstep, voffB);
    PG8_WAIT_V(6); PG8_BAR;
    for (;;) {
        const bool has_next = S.next(ui + 1, nxt);
        const char* nA = has_next ? (const char*)g.A + (size_t)nxt.pm * tstepA : cA; const char* nB = has_next ? (const char*)g.Bt + (size_t)nxt.pn * tstepB : cB;
        E.template prefetch<KIND>(pre, cur, wr, wc, fr, fq, ui & 1);
        for (int t = 0; t < nt; t += 2) {
            const bool last = (t == nt - 2);
            const char* a1 = cA + (size_t)(t + 1) * kstep;
            const char* a2 = last ? nA : cA + (size_t)(t + 2) * kstep; const char* b2 = last ? nB : cB + (size_t)(t + 2) * kstep;
            const char* a3 = a2 + kstep; const char* b3 = b2 + kstep;
            PG8_LDB(B0, 0, 0); PG8_SCHED; PG8_LDA(At, 0, 0); PG8_STAGE(PG8_SA(1, 1), a1 + hstepA, voffA);
            PG8_WAIT_L(8); PG8_BAR; PG8_WAIT_L(0); PG8_MMA(0, 0, At, B0); PG8_BAR; PG8_SCHED;
            PG8_LDB(B1, 0, 1); PG8_STAGE(PG8_SB(0, 0), b2, voffB);
            PG8_BAR; PG8_WAIT_L(0); PG8_MMA(0, 1, At, B1); PG8_BAR;
            PG8_LDA(At, 0, 1); PG8_STAGE(PG8_SA(0, 0), a2, voffA);
            PG8_BAR; PG8_WAIT_L(0); PG8_MMA(1, 0, At, B0); PG8_BAR; PG8_SCHED;
            PG8_STAGE(PG8_SB(0, 1), b2 + hstepB, voffB);
            PG8_WAIT_V(6); PG8_BAR; PG8_MMA(1, 1, At, B1); PG8_BAR;
            PG8_LDB(B0, 1, 0); PG8_SCHED; PG8_LDA(At, 1, 0); PG8_STAGE(PG8_SA(0, 1), a2 + hstepA, voffA);
            PG8_WAIT_L(8); PG8_BAR; PG8_WAIT_L(0); PG8_MMA(0, 0, At, B0); PG8_BAR; PG8_SCHED;
            PG8_LDB(B1, 1, 1); PG8_STAGE(PG8_SB(1, 0), b3, voffB);
            PG8_BAR; PG8_WAIT_L(0); PG8_MMA(0, 1, At, B1); PG8_BAR;
            PG8_LDA(At, 1, 1); PG8_STAGE(PG8_SA(1, 0), a3, voffA);
            PG8_BAR; PG8_WAIT_L(0); PG8_MMA(1, 0, At, B0); PG8_BAR; PG8_SCHED;
            PG8_STAGE(PG8_SB(1, 1), b3 + hstepB, voffB);
            PG8_WAIT_V(6); PG8_BAR; PG8_MMA(1, 1, At, B1); PG8_BAR;
        }
        E.template run<KIND>(acc, pre, cur, wr, wc, fr, fq, ui & 1);
        if (!has_next) break;
#pragma unroll
        for (int a = 0; a < 2; ++a)
#pragma unroll
            for (int b = 0; b < 2; ++b)
#pragma unroll
                for (int m = 0; m < 4; ++m)
#pragma unroll
                    for (int n = 0; n < 2; ++n) acc[a][b][m][n] = (f32x4){0.f, 0.f, 0.f, 0.f};
        cur = nxt; cA = nA; cB = nB; ++ui;
    }
    PG8_WAIT_V(0);
    if (wr == 0) PG8_BAR;
    PG8_BAR;
#undef PG8_SA
#undef PG8_SB
#undef PG8_STAGE
#undef PG8_LDA
#undef PG8_LDB
#undef PG8_MMA
#undef PG8_WAIT_V
#undef PG8_WAIT_L
#undef PG8_BAR
#undef PG8_SCHED
}
}

enum { EPI_BF16 = 0, EPI_GLA_IN = 1, EPI_RESID = 2, EPI_UKV = 3, EPI_FFN_UP = 4 };
DI float dpp_ror1(float v) { return __int_as_float(__builtin_amdgcn_update_dpp(0, __float_as_int(v), 0x121, 0xf, 0xf, false)); }
DI float dpp_ror15(float v) { return __int_as_float(__builtin_amdgcn_update_dpp(0, __float_as_int(v), 0x12F, 0xf, 0xf, false)); }
struct Epi {
    struct Pre { float rsv[2][4]; f32x4 sw[2][2]; f32x2 wl0, wl1; };
    int ldc; LAS float* xch;
    void* q0; void* q1; void* q2; void* q3; void* q4; void* q5;
    static DI f32x4 ror1_4(f32x4 v) { float a, b, c, d;
        asm volatile("s_nop 1\n\tv_mov_b32_dpp %0, %4 row_ror:1 row_mask:0xf bank_mask:0xf\n\tv_mov_b32_dpp %1, %5 row_ror:1 row_mask:0xf bank_mask:0xf\n\tv_mov_b32_dpp %2, %6 row_ror:1 row_mask:0xf bank_mask:0xf\n\tv_mov_b32_dpp %3, %7 row_ror:1 row_mask:0xf bank_mask:0xf"
                     : "=&v"(a), "=&v"(b), "=&v"(c), "=&v"(d) : "v"(v[0]), "v"(v[1]), "v"(v[2]), "v"(v[3]));
        return (f32x4){a, b, c, d}; }
    static DI f32x2 ror1_2(f32x2 v) { float a, b;
        asm volatile("s_nop 1\n\tv_mov_b32_dpp %0, %2 row_ror:1 row_mask:0xf bank_mask:0xf\n\tv_mov_b32_dpp %1, %3 row_ror:1 row_mask:0xf bank_mask:0xf" : "=&v"(a), "=&v"(b) : "v"(v[0]), "v"(v[1]));
        return (f32x2){a, b}; }
    static DI f32x2 ror15_2(f32x2 v) { float a, b;
        asm volatile("s_nop 1\n\tv_mov_b32_dpp %0, %2 row_ror:15 row_mask:0xf bank_mask:0xf\n\tv_mov_b32_dpp %1, %3 row_ror:15 row_mask:0xf bank_mask:0xf" : "=&v"(a), "=&v"(b) : "v"(v[0]), "v"(v[1]));
        return (f32x2){a, b}; }
    static DI f32x4 ror15_4(f32x4 v) { float a, b, c, d;
        asm volatile("s_nop 1\n\tv_mov_b32_dpp %0, %4 row_ror:15 row_mask:0xf bank_mask:0xf\n\tv_mov_b32_dpp %1, %5 row_ror:15 row_mask:0xf bank_mask:0xf\n\tv_mov_b32_dpp %2, %6 row_ror:15 row_mask:0xf bank_mask:0xf\n\tv_mov_b32_dpp %3, %7 row_ror:15 row_mask:0xf bank_mask:0xf"
                     : "=&v"(a), "=&v"(b), "=&v"(c), "=&v"(d) : "v"(v[0]), "v"(v[1]), "v"(v[2]), "v"(v[3]));
        return (f32x4){a, b, c, d}; }
    DI void ffn_up(const f32x4 (&acc)[2][2][4][2], const pg8::Unit& u, int wr, int wc, int fr, int fq, int par) const {
        bf16_t* O = (bf16_t*)q0; float* halo = (float*)q3;
        const int cl = wc * 32 + 8 * fq;
        float rstd[2][4];
        { const LAS float* pw = xch + PREW_F + (wr * 4 + wc) * 192;
#pragma unroll
          for (int g = 0; g < 8; ++g) rstd[g >> 2][g & 3] = rsqrtf(pw[g * 16 + fr] * (1.0f / 1024.0f) + 1e-6f); }
        const LAS float* wbuf = xch + WIMG_F + par * 1280;
#define XW(ST, TB, BJ, V0, V1) do { LAS float* xp_ = xch + ((((ST) + 1) * 2 + (TB)) * 2 + (BJ)) * 128 + cl; *(LAS f32x4*)xp_ = (V0); *(LAS f32x4*)(xp_ + 4) = (V1); } while (0)
#define TR(AI, BJ, M, N) (acc[AI][BJ][M][N] * rstd[AI][M])
        if (fr == 0) { XW(wr, 0, 0, TR(0, 0, 0, 0), TR(0, 0, 0, 1)); XW(wr, 0, 1, TR(0, 1, 0, 0), TR(0, 1, 0, 1)); XW(2 + wr, 0, 0, TR(1, 0, 0, 0), TR(1, 0, 0, 1)); XW(2 + wr, 0, 1, TR(1, 1, 0, 0), TR(1, 1, 0, 1)); }
        if (fr == 15) { XW(wr, 1, 0, TR(0, 0, 3, 0), TR(0, 0, 3, 1)); XW(wr, 1, 1, TR(0, 1, 3, 0), TR(0, 1, 3, 1)); XW(2 + wr, 1, 0, TR(1, 0, 3, 0), TR(1, 0, 3, 1)); XW(2 + wr, 1, 1, TR(1, 1, 3, 0), TR(1, 1, 3, 1)); }
        { const f32x4 zz = (f32x4){0.f, 0.f, 0.f, 0.f}; if (fr == 0 && wr == 0) { XW(-1, 1, 0, zz, zz); XW(-1, 1, 1, zz, zz); } if (fr == 15 && wr == 1) { XW(4, 0, 0, zz, zz); XW(4, 0, 1, zz, zz); } }
#undef XW
        asm volatile("s_waitcnt lgkmcnt(0)" ::: "memory"); __builtin_amdgcn_s_barrier(); asm volatile("" ::: "memory"); __builtin_amdgcn_s_barrier(); asm volatile("" ::: "memory");
        {
            float* hp = halo + (size_t)(u.pm * 22 + u.pn) * 4 * 256 + cl;
            const f32x4 sa0 = *(const LAS f32x4*)(wbuf + 512 + cl), sa1 = *(const LAS f32x4*)(wbuf + 512 + cl + 4), sg0 = *(const LAS f32x4*)(wbuf + 640 + 512 + cl), sg1 = *(const LAS f32x4*)(wbuf + 640 + 512 + cl + 4);
            if (wr == 0 && fr < 2) { float* h2 = hp + fr * 256; *(f32x4*)h2 = TR(0, 0, 0, 0) + sa0; *(f32x4*)(h2 + 4) = TR(0, 0, 0, 1) + sa1; *(f32x4*)(h2 + 128) = TR(0, 1, 0, 0) + sg0; *(f32x4*)(h2 + 132) = TR(0, 1, 0, 1) + sg1; }
            if (wr == 1 && fr >= 14) { float* h2 = hp + (fr - 12) * 256; *(f32x4*)h2 = TR(1, 0, 3, 0) + sa0; *(f32x4*)(h2 + 4) = TR(1, 0, 3, 1) + sa1; *(f32x4*)(h2 + 128) = TR(1, 1, 3, 0) + sg0; *(f32x4*)(h2 + 132) = TR(1, 1, 3, 1) + sg1; }
        }
#undef TR
        asm volatile("" ::: "memory");
        const int rowt = u.pm * 256 + wr * 64 + fr;
        const bool f0 = fr == 0, f15 = fr == 15;
        f32x2 sg[2][4][4];
#define SILU2(v) (f32x2){silu_f(v[0]), silu_f(v[1])}
#define H2(V, HH) __builtin_shufflevector(V, V, 2 * (HH), 2 * (HH) + 1)
#define CONV_GROUP(BJ, Q, AI, OP) do { \
            const int st = 2 * (AI) + wr; \
            const f32x2 pb = *(const LAS f32x2*)(xch + (((st) * 2 + 1) * 2 + (BJ)) * 128 + cl + 2 * (Q)) + sw; \
            const f32x2 nb = *(const LAS f32x2*)(xch + (((st + 2) * 2 + 0) * 2 + (BJ)) * 128 + cl + 2 * (Q)) + sw; \
            const f32x2 c0 = H2(acc[AI][BJ][0][(Q) >> 1], (Q) & 1) * rstd[AI][0] + sw, c1 = H2(acc[AI][BJ][1][(Q) >> 1], (Q) & 1) * rstd[AI][1] + sw, \
                        c2 = H2(acc[AI][BJ][2][(Q) >> 1], (Q) & 1) * rstd[AI][2] + sw, c3 = H2(acc[AI][BJ][3][(Q) >> 1], (Q) & 1) * rstd[AI][3] + sw; \
            const f32x2 R0 = ror1_2(c0), L0 = ror15_2(c0), L1 = ror15_2(c1); \
            { const f32x2 v = w0 * (f0 ? pb : R0) + w1 * c0 + w2 * (f15 ? L1 : L0) + bb; OP(sg[AI][0][Q], v); } \
            __builtin_amdgcn_sched_barrier(0); \
            const f32x2 R1 = ror1_2(c1), L2 = ror15_2(c2); \
            { const f32x2 v = w0 * (f0 ? R0 : R1) + w1 * c1 + w2 * (f15 ? L2 : L1) + bb; OP(sg[AI][1][Q], v); } \
            __builtin_amdgcn_sched_barrier(0); \
            const f32x2 R2 = ror1_2(c2), L3 = ror15_2(c3); \
            { const f32x2 v = w0 * (f0 ? R1 : R2) + w1 * c2 + w2 * (f15 ? L3 : L2) + bb; OP(sg[AI][2][Q], v); } \
            __builtin_amdgcn_sched_barrier(0); \
            const f32x2 R3 = ror1_2(c3); \
            { const f32x2 v = w0 * (f0 ? R2 : R3) + w1 * c3 + w2 * (f15 ? nb : L3) + bb; OP(sg[AI][3][Q], v); } \
            __builtin_amdgcn_sched_barrier(0); } while (0)
#define OP_G(dst, v) dst = SILU2(v)
#define OP_A(dst, v) dst *= v
#define CONV_W(BJ, Q) const LAS float* wp_ = wbuf + (BJ) * 640 + cl + 2 * (Q); \
            const f32x2 w0 = *(const LAS f32x2*)wp_, w1 = *(const LAS f32x2*)(wp_ + 128), w2 = *(const LAS f32x2*)(wp_ + 256), bb = *(const LAS f32x2*)(wp_ + 384), sw = *(const LAS f32x2*)(wp_ + 512);
        { CONV_W(1, 0) CONV_GROUP(1, 0, 0, OP_G); CONV_GROUP(1, 0, 1, OP_G); }
        { CONV_W(1, 1) CONV_GROUP(1, 1, 0, OP_G); CONV_GROUP(1, 1, 1, OP_G); }
        { CONV_W(1, 2) CONV_GROUP(1, 2, 0, OP_G); CONV_GROUP(1, 2, 1, OP_G); }
        { CONV_W(1, 3) CONV_GROUP(1, 3, 0, OP_G); CONV_GROUP(1, 3, 1, OP_G); }
        { CONV_W(0, 0) CONV_GROUP(0, 0, 0, OP_A); CONV_GROUP(0, 0, 1, OP_A); }
        { CONV_W(0, 1) CONV_GROUP(0, 1, 0, OP_A); CONV_GROUP(0, 1, 1, OP_A); }
        { CONV_W(0, 2) CONV_GROUP(0, 2, 0, OP_A); CONV_GROUP(0, 2, 1, OP_A); }
        { CONV_W(0, 3) CONV_GROUP(0, 3, 0, OP_A); CONV_GROUP(0, 3, 1, OP_A); }
#undef CONV_W
#undef CONV_GROUP
#undef OP_G
#undef OP_A
#undef SILU2
#undef H2
#define ST16(AI, MM) do { u32x4 w_; w_.x = cvt_pk_bf16(sg[AI][MM][0][0], sg[AI][MM][0][1]); w_.y = cvt_pk_bf16(sg[AI][MM][1][0], sg[AI][MM][1][1]); w_.z = cvt_pk_bf16(sg[AI][MM][2][0], sg[AI][MM][2][1]); w_.w = cvt_pk_bf16(sg[AI][MM][3][0], sg[AI][MM][3][1]); \
            *(u32x4*)(O + (size_t)(rowt + (AI) * 128 + (MM) * 16) * 2816 + u.pn * 128 + cl) = w_; } while (0)
        ST16(0, 0); ST16(0, 1); ST16(0, 2); ST16(0, 3); ST16(1, 0); ST16(1, 1); ST16(1, 2); ST16(1, 3);
#undef ST16
    }
    template <int K> static constexpr bool perm_of() { return K != EPI_RESID; }
    template <int kind> DI void prefetch(Pre& P, const pg8::Unit& u, int wr, int wc, int fr, int fq, int par) const {
        (void)P;
        if constexpr (kind == EPI_GLA_IN || kind == EPI_BF16 || kind == EPI_FFN_UP) {
            const float* rsb = (const float*)(kind == EPI_FFN_UP ? q4 : q3);
            if (rsb) {
                LAS float* pw = xch + PREW_F + (wr * 4 + wc) * 192;
                const int bidx = u.pm < 256 ? (u.pm >> 4) : 16;
                if (fq == 0) {
                    const float* rsp = rsb + u.pm * 256 + wr * 64 + fr;
#pragma unroll
                    for (int g = 0; g < 8; ++g) __builtin_amdgcn_global_load_lds((const unsigned*)(rsp + (g >> 2) * 128 + (g & 3) * 16), (LAS unsigned*)(pw + g * 16), 4, 0, 0);
                    if constexpr (kind != EPI_FFN_UP) {
                        const float* sw = (const float*)q4 + (size_t)bidx * 5632 + u.pn * 256 + (fr >> 3) * 128 + wc * 32 + (fr & 7) * 4;
                        __builtin_amdgcn_global_load_lds((const unsigned*)sw, (LAS unsigned*)(pw + 128), 16, 0, 0);
                    }
                }
                if constexpr (kind == EPI_FFN_UP) {
                    const int wid = wr * 4 + wc;
                    if (wid < 5) {
                        const float* cw = (const float*)q1; const float* cb = (const float*)q2; const float* shw = (const float*)q5 + (size_t)bidx * 5632 + u.pn * 256;
                        const int i4 = (wid * 64 + fq * 16 + fr) * 4, bjw = i4 / 640, rem = i4 % 640, kw = rem >> 7, c_ = rem & 127;
                        const float* srcw = kw < 3 ? cw + kw * 5632 + bjw * 2816 + u.pn * 128 + c_ : kw == 3 ? cb + bjw * 2816 + u.pn * 128 + c_ : shw + bjw * 128 + c_;
                        __builtin_amdgcn_global_load_lds((const unsigned*)srcw, (LAS unsigned*)(xch + WIMG_F + par * 1280 + wid * 256), 16, 0, 0);
                    }
                }
            }
        }
    }
    template <int kind> DI void run(const f32x4 (&acc)[2][2][4][2], const Pre& P, const pg8::Unit& u, int wr, int wc, int fr, int fq, int par) const {
        asm volatile("" : "+v"(fr), "+v"(fq));
        if constexpr (kind == EPI_FFN_UP) { ffn_up(acc, u, wr, wc, fr, fq, par); return; }
        if constexpr (kind == EPI_RESID) {
            const float* base_l = (const float*)q0; const float* base_c = (const float*)q1; float* out_l = (float*)q2; unsigned char* wsb = (unsigned char*)q3; float* out_c = (float*)(wsb + WS_XC);
            const float* modl = (const float*)q4; const float* gnext = (const float*)q5;
            const int bidx = u.pm < 256 ? (u.pm >> 4) : 16;
            const float* gv = modl + (size_t)bidx * 6144 + (ldc ? 5 * 1024 : 2 * 1024);
            const float* bp = u.pm < 256 ? base_l + (size_t)u.pm * 256 * 1024 : base_c + (size_t)(u.pm - 256) * 256 * 1024;
            float* op = u.pm < 256 ? out_l + (size_t)u.pm * 256 * 1024 : out_c + (size_t)(u.pm - 256) * 256 * 1024;
            const int col0 = u.pn * 256 + wc * 32 + 4 * fq;
            f32x4 gt[2][2], gn[2][2];
#pragma unroll
            for (int bj = 0; bj < 2; ++bj)
#pragma unroll
                for (int n = 0; n < 2; ++n) gt[bj][n] = *(const f32x4*)(gv + col0 + bj * 128 + n * 16);
            if (gnext) {
                const float* scn = ldc ? modl + (size_t)(17 + bidx) * 6144 + 1024 : modl + (size_t)bidx * 6144 + 4 * 1024;
#pragma unroll
                for (int bj = 0; bj < 2; ++bj)
#pragma unroll
                    for (int n = 0; n < 2; ++n) gn[bj][n] = *(const f32x4*)(gnext + col0 + bj * 128 + n * 16) * (*(const f32x4*)(scn + col0 + bj * 128 + n * 16) + 1.0f);
            }
            bf16_t* xs = (bf16_t*)(wsb + (ldc ? WS_H : WS_XSA)) + (size_t)u.pm * 256 * 1024;
            float* rs = (float*)(wsb + WS_RS) + (ldc ? MR : 0) + u.pm * 256;
#pragma unroll
            for (int ai = 0; ai < 2; ++ai)
#pragma unroll
                for (int m = 0; m < 4; ++m) {
                    const int rl = ai * 128 + wr * 64 + m * 16 + fr;
                    const size_t off = (size_t)rl * 1024 + col0;
                    float ssq = 0.f;
#pragma unroll
                    for (int bj = 0; bj < 2; ++bj)
#pragma unroll
                        for (int n = 0; n < 2; ++n) {
                            const f32x4 bs = *(const f32x4*)(bp + off + bj * 128 + n * 16);
                            const f32x4 xn = bs + gt[bj][n] * acc[ai][bj][m][n];
                            *(f32x4*)(op + off + bj * 128 + n * 16) = xn;
                            if (gnext) {
                                ssq += xn[0] * xn[0] + xn[1] * xn[1] + xn[2] * xn[2] + xn[3] * xn[3];
                                const f32x4 y = xn * gn[bj][n];
                                u32x2 w; w.x = cvt_pk_bf16(y[0], y[1]); w.y = cvt_pk_bf16(y[2], y[3]);
                                *(u32x2*)(xs + off + bj * 128 + n * 16) = w;
                            }
                        }
                    if (gnext) {
                        ssq += __shfl_xor(ssq, 16); ssq += __shfl_xor(ssq, 32);
                        if (fq == 0) unsafeAtomicAdd(rs + rl, ssq);
                    }
                }
            return;
        } else {
        bf16_t* O = (bf16_t*)q0; float* lr = (float*)q1; bf16_t* KB = (bf16_t*)q0; bf16_t* VB = (bf16_t*)q1;
        const int rowt = u.pm * 256 + wr * 64 + fr;
        f32x4 swv[2][2]; float rsv[2][4];
        if constexpr (kind == EPI_GLA_IN || kind == EPI_BF16) {
            if (q3) { const LAS float* pw = xch + PREW_F + (wr * 4 + wc) * 192;
#pragma unroll
                for (int g = 0; g < 8; ++g) rsv[g >> 2][g & 3] = pw[g * 16 + fr];
#pragma unroll
                for (int bj = 0; bj < 2; ++bj) { swv[bj][0] = *(const LAS f32x4*)(pw + 128 + bj * 32 + 8 * fq); swv[bj][1] = *(const LAS f32x4*)(pw + 128 + bj * 32 + 8 * fq + 4); } }
        }
#pragma unroll
        for (int ai = 0; ai < 2; ++ai)
#pragma unroll
            for (int m = 0; m < 4; ++m) {
                const int row = rowt + ai * 128 + m * 16;
#pragma unroll
                for (int bj = 0; bj < 2; ++bj) {
                    f32x4 v0 = acc[ai][bj][m][0], v1 = acc[ai][bj][m][1];
                    const int cin = bj * 128 + wc * 32 + 8 * fq;
                    if constexpr (kind == EPI_GLA_IN || kind == EPI_BF16) {
                        if (q3) {
                            const float rstd = rsqrtf(rsv[ai][m] * (1.0f / 1024.0f) + 1e-6f);
                            v0 = v0 * rstd + swv[bj][0]; v1 = v1 * rstd + swv[bj][1];
                        }
                    }
                    if constexpr (kind == EPI_GLA_IN) {
                        if (u.pn == 12) {
                            if (bj == 0 && wc == 0) { float* lp = lr + (size_t)row * 32 + 8 * fq; *(f32x4*)lp = v0; *(f32x4*)(lp + 4) = v1; }
                            continue;
                        }
                        if (u.pn < 2) { v0 *= 0.08838834764831845f; v1 *= 0.08838834764831845f; }
                    }
                    u32x4 w; w.x = cvt_pk_bf16(v0[0], v0[1]); w.y = cvt_pk_bf16(v0[2], v0[3]); w.z = cvt_pk_bf16(v1[0], v1[1]); w.w = cvt_pk_bf16(v1[2], v1[3]);
                    if constexpr (kind == EPI_GLA_IN) {
                        if (u.pn < 4) *(u32x4*)(O + (size_t)row * 1024 + u.pn * 256 + cin) = w;
                        else *(u32x4*)((bf16_t*)q2 + (size_t)row * 2048 + (u.pn - 4) * 256 + cin) = w;
                    } else if constexpr (kind == EPI_UKV) {
                        int key;
                        if (u.pm < 256) { const int b = u.pm >> 4; key = b * KEYS + CTXL + (row - b * SEQ); }
                        else { const int b = u.pm - 256; key = b * KEYS + (row - TL - b * CTXL); }
                        const int cc = wc * 32 + 8 * fq;
                        if (bj == 0) *(u32x4*)(KB + (size_t)key * 1536 + u.pn * 192 + cc) = w;
                        else *(u32x4*)(VB + (size_t)key * 1024 + u.pn * 128 + cc) = w;
                    } else {
                        *(u32x4*)(O + (size_t)row * ldc + u.pn * 256 + cin) = w;
                    }
                }
            }
        }
    }
};

DI void prep_phase(const Params& p, LAS unsigned char* lds) {
    const int tid = tid_opq();
    unsigned char* ws = (unsigned char*)p.in[opq(27)];
    LAS float* tl = (LAS float*)lds;
    const float* in_c = p.in[opq(1)]; const float* in_cctx = p.in[opq(3)]; const float* in_wada = p.in[opq(4)]; const float* in_bada = p.in[opq(5)];
    const float* in_gin = p.in[opq(8)]; const float* in_w1 = p.in[opq(9)]; const float* in_gout = p.in[opq(13)]; const float* in_mdown = p.in[opq(14)];
    const float* in_uq = p.in[opq(17)]; const float* in_ukv = p.in[opq(18)]; const float* in_mout = p.in[opq(21)]; const float* in_fup = p.in[opq(22)]; const float* in_fdown = p.in[opq(25)];
    constexpr int T0 = 1536, T2 = 512, T3 = 352, T4 = 288, T5 = 256, T6 = 512, T7 = 5632, T8 = 2816;
    constexpr int NTILE = T0 + T2 + T3 + T4 + T5 + T6 + T7 + T8;
    for (int t = blockIdx.x; t < NTILE; t += gridDim.x) {
        const float* src; int N, k0, n0, ld; bf16_t* dst;
        int q = t;
        if (q < T0) { const int j = q / 768, r = q % 768, kt = r / 48, nt = r % 48; src = in_gin + (size_t)j * 1024 * 3072; N = 3072; k0 = kt * 64; n0 = nt * 64;
            dst = (bf16_t*)(ws + WS_GIN + j * SZ_GIN) + (size_t)n0 * 1024 + k0; ld = 1024; }
        else if ((q -= T0) < T2) { const int j = q / 256, r = q % 256, kt = r / 16, nt = r % 16; src = in_gout + (size_t)j * 1024 * 1024; N = 1024; k0 = kt * 64; n0 = nt * 64;
            dst = (bf16_t*)(ws + WS_GOUT + j * SZ_SQ) + (size_t)n0 * 1024 + k0; ld = 1024; }
        else if ((q -= T2) < T3) { const int j = q / 176, r = q % 176, kt = r / 11, nt = r % 11; src = in_mdown + (size_t)j * 1024 * 704; N = 704; k0 = kt * 64; n0 = nt * 64;
            dst = (bf16_t*)(ws + WS_MDOWN + j * SZ_MDOWN) + (size_t)n0 * 1024 + k0; ld = 1024; }
        else if ((q -= T3) < T4) { const int j = q / 144, r = q % 144, kt = r / 24, nt = r % 24; src = in_uq + (size_t)j * 384 * 1536; N = 1536; k0 = kt * 64; n0 = nt * 64;
            dst = (bf16_t*)(ws + WS_MUQ + j * SZ_MUQ) + (size_t)n0 * 384 + k0; ld = 384; }
        else if ((q -= T4) < T5) { const int j = q / 128, r = q % 128, kt = r / 32, nt = r % 32; src = in_ukv + (size_t)j * 256 * 2048; N = 2048; k0 = kt * 64; n0 = nt * 64;
            dst = (bf16_t*)(ws + WS_MUKV + j * SZ_MUKV) + (size_t)n0 * 256 + k0; ld = 256; }
        else if ((q -= T5) < T6) { const int j = q / 256, r = q % 256, kt = r / 16, nt = r % 16; src = in_mout + (size_t)j * 1024 * 1024; N = 1024; k0 = kt * 64; n0 = nt * 64;
            dst = (bf16_t*)(ws + WS_MOUT + j * SZ_SQ) + (size_t)n0 * 1024 + k0; ld = 1024; }
        else if ((q -= T6) < T7) { const int i = q / 1408, r = q % 1408, kt = r / 88, nt = r % 88; src = in_fup + (size_t)i * 1024 * 5632; N = 5632; k0 = kt * 64; n0 = nt * 64;
            const int isg = n0 >= DFF ? 1 : 0, cc = n0 - isg * DFF, drow = (cc >> 7) * 256 + isg * 128 + (cc & 127);
            dst = (bf16_t*)(ws + WS_FUP + (size_t)i * SZ_FUP) + (size_t)drow * 1024 + k0; ld = 1024; }
        else { q -= T7; const int i = q / 704, r = q % 704, kt = r / 16, nt = r % 16; src = in_fdown + (size_t)i * 2816 * 1024; N = 1024; k0 = kt * 64; n0 = nt * 64;
            dst = (bf16_t*)(ws + WS_FDOWN + (size_t)i * SZ_FDOWN) + (size_t)n0 * 2816 + k0; ld = 2816; }
#pragma unroll
        for (int i = 0; i < 8; ++i) { const int r = (tid >> 6) + 8 * i, c = tid & 63; tl[c * 65 + r] = src[(size_t)(k0 + r) * N + n0 + c]; }
        __syncthreads();
#pragma unroll
        for (int i = 0; i < 4; ++i) { const int rr = (tid >> 5) + 16 * i, c2 = (tid & 31) * 2; const float a = tl[rr * 65 + c2], b = tl[rr * 65 + c2 + 1];
            *(unsigned*)(dst + (size_t)rr * ld + c2) = cvt_pk_bf16(a, b); }
        __syncthreads();
    }
    const int gtid = blockIdx.x * NTHREADS + tid, gstride = gridDim.x * NTHREADS;
    for (int idx = gtid; idx < 65536; idx += gstride) {
        const int k = idx & 1023, r = (idx >> 10) & 15, dir = (idx >> 14) & 1, j = idx >> 15;
        const float v = in_w1[((size_t)(j * 2 + dir) * 1024 + k) * 16 + r];
        ((bf16_t*)(ws + WS_GIN + j * SZ_GIN))[(size_t)(3072 + dir * 16 + r) * 1024 + k] = f2bf(v);
    }
    for (int idx = gtid; idx < 2 * 114688; idx += gstride) { const int j = idx / 114688, o = idx % 114688; ((unsigned*)(ws + WS_GIN + j * SZ_GIN + 3104ull * 1024 * 2))[o] = 0u; }
    for (int idx = gtid; idx < 2 * 32768; idx += gstride) { const int j = idx / 32768, o = idx % 32768; ((unsigned*)(ws + WS_MDOWN + j * SZ_MDOWN + 704ull * 1024 * 2))[o] = 0u; }
    for (int idx = gtid; idx < MR; idx += gstride) ((float*)(ws + WS_RS))[idx] = 0.f;
    LAS float* sl = (LAS float*)lds;
    LAS float* red = (LAS float*)(lds + 81920);
    __syncthreads();
    for (int idx = tid; idx < 17 * 1024; idx += NTHREADS) { const int r = idx >> 10, k = idx & 1023; const float v = r < 16 ? in_c[r * 1024 + k] : in_cctx[k]; sl[k * 20 + r] = v / (1.0f + __expf(-v)); }
    __syncthreads();
    float* mod = (float*)(ws + WS_MOD);
    for (int it = blockIdx.x; it < 384; it += gridDim.x) {
        const int layer = it / 96, n0 = (it % 96) * 64, nn = tid & 63, ks = tid >> 6;
        const float* W = in_wada + (size_t)layer * 1024 * 6144 + n0 + nn;
        float acc[17];
#pragma unroll
        for (int r = 0; r < 17; ++r) acc[r] = 0.f;
        for (int kk = 0; kk < 128; ++kk) {
            const int k = ks * 128 + kk; const float w = W[(size_t)k * 6144];
            const f32x4 s0 = *(const LAS f32x4*)(sl + k * 20), s1 = *(const LAS f32x4*)(sl + k * 20 + 4), s2 = *(const LAS f32x4*)(sl + k * 20 + 8), s3 = *(const LAS f32x4*)(sl + k * 20 + 12);
            const float s16 = sl[k * 20 + 16];
#pragma unroll
            for (int j = 0; j < 4; ++j) { acc[j] += s0[j] * w; acc[4 + j] += s1[j] * w; acc[8 + j] += s2[j] * w; acc[12 + j] += s3[j] * w; }
            acc[16] += s16 * w;
        }
#pragma unroll
        for (int r = 0; r < 17; ++r) red[(ks * 17 + r) * 64 + nn] = acc[r];
        __syncthreads();
        for (int o = tid; o < 17 * 64; o += NTHREADS) { const int r = o >> 6, c = o & 63; float s = in_bada[layer * 6144 + n0 + c];
#pragma unroll
            for (int k8 = 0; k8 < 8; ++k8) s += red[(k8 * 17 + r) * 64 + c];
            mod[(size_t)(layer * 17 + r) * 6144 + n0 + c] = s; }
        __syncthreads();
    }
}

DI void shw_phase(unsigned char* ws, LAS unsigned char* lds) {
    const int tid = tid_opq(), wave = tid >> 6, lane = tid & 63;
    LAS float* sl = (LAS float*)lds;
    const float* mod = (const float*)(ws + WS_MOD);
    constexpr int NCH = 4 * 44 + 6 + 26 + 6;
    for (int ch = blockIdx.x; ch < NCH; ch += gridDim.x) {
        int layer, kind, n0; const bf16_t* Bt;
        if (ch < 176) { layer = ch / 44; kind = 1; n0 = (ch % 44) * 128; Bt = (const bf16_t*)(ws + WS_FUP + (size_t)layer * SZ_FUP); }
        else if (ch < 182) { layer = 1; kind = 0; n0 = (ch - 176) * 128; Bt = (const bf16_t*)(ws + WS_MDOWN); }
        else if (ch < 208) { layer = 2; kind = 0; n0 = (ch - 182) * 128; Bt = (const bf16_t*)(ws + WS_GIN + SZ_GIN); }
        else { layer = 3; kind = 0; n0 = (ch - 208) * 128; Bt = (const bf16_t*)(ws + WS_MDOWN + SZ_MDOWN); }
        __syncthreads();
        for (int idx = tid; idx < 17 * 256; idx += NTHREADS) { const int b = idx >> 8, k4 = (idx & 255) * 4;
            *(LAS f32x4*)(sl + b * 1024 + k4) = *(const f32x4*)(mod + (size_t)(layer * 17 + b) * 6144 + (kind ? 3 * 1024 : 0) + k4); }
        __syncthreads();
        float* out = (float*)(ws + WS_SHW) + (size_t)((layer * 2 + kind) * 17) * 5632;
#pragma unroll 1
        for (int i = 0; i < 16; ++i) {
            const int n = n0 + wave * 16 + i;
            float w[16];
#pragma unroll
            for (int j = 0; j < 4; ++j) { const u32x2 t = *(const u32x2*)(Bt + (size_t)n * 1024 + j * 256 + lane * 4); w[4 * j] = bf_lo(t.x); w[4 * j + 1] = bf_hi(t.x); w[4 * j + 2] = bf_lo(t.y); w[4 * j + 3] = bf_hi(t.y); }
            float mine = 0.f;
#pragma unroll 1
            for (int b = 0; b < 17; ++b) {
                float a = 0.f;
#pragma unroll
                for (int j = 0; j < 4; ++j) { const f32x4 sv = *(const LAS f32x4*)(sl + b * 1024 + j * 256 + lane * 4); a += sv[0] * w[4 * j] + sv[1] * w[4 * j + 1] + sv[2] * w[4 * j + 2] + sv[3] * w[4 * j + 3]; }
                a = wave_sum(a);
                if (lane == b) mine = a;
            }
            if (lane < 17) out[(size_t)lane * 5632 + n] = mine;
        }
    }
    __syncthreads();
}

DI void norm_phase(const float* xl, const float* xc, const float* gain, const float* modl, int sh_off, int sc_off, bf16_t* h) {
    const int tid = tid_opq(), wave = tid >> 6, lane = tid & 63;
    for (int row0 = (blockIdx.x * 8 + wave) * 4; row0 < MR; row0 += gridDim.x * 32) {
        const float* src = row0 < TL ? xl + (size_t)row0 * 1024 : xc + (size_t)(row0 - TL) * 1024;
        const float* mb = modl + (size_t)(row0 < TL ? (row0 >> 12) : 16) * 6144;
        f32x4 v[4][4]; float ss[4];
#pragma unroll
        for (int r = 0; r < 4; ++r)
#pragma unroll
            for (int i = 0; i < 4; ++i) v[r][i] = *(const f32x4*)(src + (size_t)r * 1024 + i * 256 + lane * 4);
#pragma unroll
        for (int r = 0; r < 4; ++r) { float t = 0.f;
#pragma unroll
            for (int i = 0; i < 4; ++i) t += v[r][i][0] * v[r][i][0] + v[r][i][1] * v[r][i][1] + v[r][i][2] * v[r][i][2] + v[r][i][3] * v[r][i][3];
            ss[r] = t; }
#pragma unroll
        for (int o = 32; o >= 1; o >>= 1) {
#pragma unroll
            for (int r = 0; r < 4; ++r) ss[r] += __shfl_xor(ss[r], o);
        }
#pragma unroll
        for (int i = 0; i < 4; ++i) {
            const int c = i * 256 + lane * 4;
            const f32x4 g = *(const f32x4*)(gain + c), sc = *(const f32x4*)(mb + sc_off + c), sh = *(const f32x4*)(mb + sh_off + c);
            const f32x4 gs = g * (sc + 1.0f);
#pragma unroll
            for (int r = 0; r < 4; ++r) {
                const float rstd = rsqrtf(ss[r] * (1.0f / 1024.0f) + 1e-6f);
                const f32x4 y = (v[r][i] * rstd) * gs + sh;
                u32x2 w; w.x = cvt_pk_bf16(y[0], y[1]); w.y = cvt_pk_bf16(y[2], y[3]);
                *(u32x2*)(h + (size_t)(row0 + r) * 1024 + c) = w;
            }
        }
    }
}

DI void scan_rowbase(int dir, int b, int c, int& rb, int& sg) {
    if (dir == 0) { sg = 1; rb = c < 4 ? TL + b * CTXL + c * 64 : b * SEQ + (c - 4) * 64; }
    else { sg = -1; rb = c < 4 ? TL + b * CTXL + 255 - c * 64 : b * SEQ + 4095 - (c - 4) * 64; }
}
struct GPStage { unsigned qv[8], kv[8]; f32x4 lrv; float w2r[16][2]; f32x2 gbias; };
DI void gp_load(GPStage& S, int item, const bf16_t* qk, const float* lr, const float* w2, const float* gb, int tid, int wave, int d0) {
    const int c = item % 68, rest = item / 68, h = rest & 3, dir = (rest >> 2) & 1, b = rest >> 3;
    int rowbase, sgn; scan_rowbase(dir, b, c, rowbase, sgn);
#pragma unroll
    for (int i = 0; i < 8; ++i) { const size_t ro = (size_t)(rowbase + sgn * (wave * 8 + i)) * 1024; S.qv[i] = *(const unsigned*)(qk + ro + h * 128 + d0); S.kv[i] = *(const unsigned*)(qk + ro + 512 + h * 128 + d0); }
    S.lrv = (f32x4){0.f, 0.f, 0.f, 0.f};
    if (tid < 256) S.lrv = *(const f32x4*)(lr + (size_t)(rowbase + sgn * (tid >> 2)) * 32 + dir * 16 + (tid & 3) * 4);
#pragma unroll
    for (int r = 0; r < 16; ++r) { const f32x2 t = *(const f32x2*)(w2 + (size_t)(dir * 16 + r) * 512 + h * 128 + d0); S.w2r[r][0] = t.x; S.w2r[r][1] = t.y; }
    S.gbias = *(const f32x2*)(gb + dir * 512 + h * 128 + d0);
}
DI void gp_item(const GPStage& S, int item, bf16_t* GQ, bf16_t* GK, bf16_t* GP, float* GE, LAS unsigned char* lds, int tid, int wave, int lane) {
    constexpr int QD = 0, KI = 17408, LRS = 34816, SEG = 38912;
    const int l15 = lane & 15, lq = lane >> 4, d0 = 2 * lane;
    if (tid < 256) *(LAS f32x4*)(lds + LRS + (tid >> 2) * 64 + (tid & 3) * 16) = S.lrv;
    __syncthreads();
    const LAS float* lrs = (const LAS float*)(lds + LRS);
    float bl0[8], bl1[8]; float cum0 = 0.f, cum1 = 0.f;
#pragma unroll
    for (int i = 0; i < 8; ++i) {
        const int s = wave * 8 + i;
        float z0 = S.gbias.x, z1 = S.gbias.y;
#pragma unroll
        for (int r4 = 0; r4 < 4; ++r4) { const f32x4 lv = *(const LAS f32x4*)(lrs + s * 16 + r4 * 4);
#pragma unroll
            for (int j = 0; j < 4; ++j) { z0 += lv[j] * S.w2r[r4 * 4 + j][0]; z1 += lv[j] * S.w2r[r4 * 4 + j][1]; } }
        const float g0 = (fminf(z0, 0.f) - __logf(1.0f + __expf(-fabsf(z0)))) * 0.0625f;
        const float g1 = (fminf(z1, 0.f) - __logf(1.0f + __expf(-fabsf(z1)))) * 0.0625f;
        cum0 += g0; cum1 += g1; bl0[i] = cum0; bl1[i] = cum1;
    }
    *(LAS f32x2*)(lds + SEG + (wave * 128 + d0) * 4) = (f32x2){cum0, cum1};
    __syncthreads();
    float off0 = 0.f, off1 = 0.f, tot0 = 0.f, tot1 = 0.f;
#pragma unroll
    for (int w = 0; w < 8; ++w) { const f32x2 t = *(const LAS f32x2*)(lds + SEG + (w * 128 + d0) * 4); tot0 += t.x; tot1 += t.y; if (w < wave) { off0 += t.x; off1 += t.y; } }
    if (wave == 0) *(f32x2*)(GE + (size_t)item * 128 + d0) = (f32x2){__expf(tot0), __expf(tot1)};
    {
        unsigned ks0[4], ks1[4];
        bf16_t* gq = GQ + (size_t)item * 8192;
#pragma unroll
        for (int i = 0; i < 8; ++i) {
            const int s = wave * 8 + i;
            const float b0 = off0 + bl0[i], b1 = off1 + bl1[i];
            const float q0 = bf_lo(S.qv[i]), q1 = bf_hi(S.qv[i]), k0 = bf_lo(S.kv[i]), k1 = bf_hi(S.kv[i]);
            const unsigned qd = cvt_pk_bf16(q0 * __expf(b0), q1 * __expf(b1));
            *(LAS unsigned*)(lds + QD + s * 272 + d0 * 2) = qd;
            *(unsigned*)(gq + s * 128 + d0) = qd;
            *(LAS unsigned*)(lds + KI + s * 272 + d0 * 2) = cvt_pk_bf16(k0 * __expf(-b0), k1 * __expf(-b1));
            const float e0 = k0 * __expf(tot0 - b0), e1 = k1 * __expf(tot1 - b1);
            if (i & 1) { ks0[i >> 1] = (ks0[i >> 1] & 0xffffu) | (cvt_pk_bf16(0.f, e0) & 0xffff0000u); ks1[i >> 1] = (ks1[i >> 1] & 0xffffu) | (cvt_pk_bf16(0.f, e1) & 0xffff0000u); }
            else { ks0[i >> 1] = cvt_pk_bf16(e0, 0.f) & 0xffffu; ks1[i >> 1] = cvt_pk_bf16(e1, 0.f) & 0xffffu; }
        }
        bf16_t* gk = GK + (size_t)item * 8192;
        *(u32x4*)(gk + d0 * 64 + wave * 8) = (u32x4){ks0[0], ks0[1], ks0[2], ks0[3]};
        *(u32x4*)(gk + (d0 + 1) * 64 + wave * 8) = (u32x4){ks1[0], ks1[1], ks1[2], ks1[3]};
    }
    __syncthreads();
    {
        bf16_t* gp = GP + (size_t)item * 4096;
        const int t0 = 16 * (wave >> 1);
#pragma unroll
        for (int j = 0; j < 2; ++j) {
            const int s0 = 16 * ((wave & 1) * 2 + j);
            f32x4 a4 = (f32x4){0.f, 0.f, 0.f, 0.f};
#pragma unroll
            for (int kk = 0; kk < 4; ++kk) {
                const bf16x8 af = *(const LAS bf16x8*)(lds + QD + (t0 + l15) * 272 + (kk * 32 + 8 * lq) * 2);
                const bf16x8 bf = *(const LAS bf16x8*)(lds + KI + (s0 + l15) * 272 + (kk * 32 + 8 * lq) * 2);
                a4 = __builtin_amdgcn_mfma_f32_16x16x32_bf16(af, bf, a4, 0, 0, 0);
            }
            const int sc = s0 + l15;
#pragma unroll
            for (int r = 0; r < 4; ++r) { const int t = t0 + 4 * lq + r; gp[t * 64 + sc] = f2bf(sc <= t ? a4[r] : 0.f); }
        }
    }
}
DI void gateprep_phase(const bf16_t* qk, const float* lr, const float* w2, const float* gb, bf16_t* GQ, bf16_t* GK, bf16_t* GP, float* GE, LAS unsigned char* lds) {
    const int tid = tid_opq(), wave = __builtin_amdgcn_readfirstlane(tid >> 6), lane = tid & 63, d0 = 2 * lane;
    const int G = gridDim.x;
    GPStage A, B;
    int item = opq((int)blockIdx.x);
    if (item < NCHI) gp_load(A, item, qk, lr, w2, gb, tid, wave, d0);
    for (; item < NCHI; item += 2 * G) {
        if (item + G < NCHI) gp_load(B, item + G, qk, lr, w2, gb, tid, wave, d0);
        gp_item(A, item, GQ, GK, GP, GE, lds, tid, wave, lane);
        if (item + G < NCHI) {
            if (item + 2 * G < NCHI) gp_load(A, item + 2 * G, qk, lr, w2, gb, tid, wave, d0);
            gp_item(B, item + G, GQ, GK, GP, GE, lds, tid, wave, lane);
        }
    }
    __syncthreads();
}

DI void scan_phase(const bf16_t* vr, const bf16_t* GQ, const bf16_t* GK, const bf16_t* GP, const float* GE, bf16_t* of, bf16_t* ob, LAS unsigned char* lds) {
    constexpr int QD = 0, KST = 17408, VT = 35840, ST = 54272, PP = 89088, BL = 98304;
    const int tid = tid_opq(), wave = __builtin_amdgcn_readfirstlane(tid >> 6), lane = tid & 63;
    const int l31 = lane & 31, lh = lane >> 5;
    for (int item = blockIdx.x; item < 256; item += gridDim.x) {
        const int b = item >> 4, dir = (item >> 3) & 1, h = (item >> 1) & 3, dvh = item & 1;
        bf16_t* obuf = dir ? ob : of;
        const int d0 = 2 * lane;
        const int gi0 = ((b * 2 + dir) * 4 + h) * 68;
        f32x16 Sacc[2];
#pragma unroll
        for (int i = 0; i < 16; ++i) { Sacc[0][i] = 0.f; Sacc[1][i] = 0.f; }
        __syncthreads();
        for (int o = tid; o < 34816 / 16; o += NTHREADS) *(LAS u32x4*)(lds + ST + o * 16) = (u32x4){0u, 0u, 0u, 0u};
        const int vcol = h * 256 + dvh * 128 + d0;
        struct ScStage { u32x4 gq0, gq1, gk0, gk1, gp0; unsigned vv[8]; float ebv; } A, B;
        A.ebv = 0.f; B.ebv = 0.f;
#define SCAN_LOAD(S, c) do { int rb_, sg_; scan_rowbase(dir, b, (c), rb_, sg_); const size_t gi_ = (size_t)(gi0 + (c)); \
        S.gq0 = *(const u32x4*)(GQ + gi_ * 8192 + tid * 8); S.gq1 = *(const u32x4*)(GQ + gi_ * 8192 + 4096 + tid * 8); \
        S.gk0 = *(const u32x4*)(GK + gi_ * 8192 + tid * 8); S.gk1 = *(const u32x4*)(GK + gi_ * 8192 + 4096 + tid * 8); \
        S.gp0 = *(const u32x4*)(GP + gi_ * 4096 + tid * 8); if (tid < 128) S.ebv = GE[gi_ * 128 + tid]; \
        _Pragma("unroll") for (int i = 0; i < 8; ++i) S.vv[i] = *(const unsigned*)(vr + (size_t)(rb_ + sg_ * (wave * 8 + i)) * 2048 + vcol); } while (0)
#define SCAN_CHUNK(S, c) do { \
            int rowbase, sgn; scan_rowbase(dir, b, (c), rowbase, sgn); \
            { const int e0 = tid * 8, e1 = 4096 + tid * 8; \
              *(LAS u32x4*)(lds + QD + (e0 >> 7) * 272 + (e0 & 127) * 2) = S.gq0; *(LAS u32x4*)(lds + QD + (e1 >> 7) * 272 + (e1 & 127) * 2) = S.gq1; \
              *(LAS u32x4*)(lds + KST + (e0 >> 6) * 144 + (e0 & 63) * 2) = S.gk0; *(LAS u32x4*)(lds + KST + (e1 >> 6) * 144 + (e1 & 63) * 2) = S.gk1; \
              *(LAS u32x4*)(lds + PP + (e0 >> 6) * 144 + (e0 & 63) * 2) = S.gp0; \
              if (tid < 128) *(LAS float*)(lds + BL + tid * 4) = S.ebv; \
              unsigned vt0[4], vt1[4]; \
              _Pragma("unroll") for (int i = 0; i < 8; ++i) { \
                  if (i & 1) { vt0[i >> 1] = (vt0[i >> 1] & 0xffffu) | (S.vv[i] << 16); vt1[i >> 1] = (vt1[i >> 1] & 0xffffu) | (S.vv[i] & 0xffff0000u); } \
                  else { vt0[i >> 1] = S.vv[i] & 0xffffu; vt1[i >> 1] = S.vv[i] >> 16; } } \
              *(LAS u32x4*)(lds + VT + d0 * 144 + wave * 16) = (u32x4){vt0[0], vt0[1], vt0[2], vt0[3]}; \
              *(LAS u32x4*)(lds + VT + (d0 + 1) * 144 + wave * 16) = (u32x4){vt1[0], vt1[1], vt1[2], vt1[3]}; \
            } \
            __syncthreads();     \
            if ((c) + 2 < 68) SCAN_LOAD(S, (c) + 2); \
            { \
                const int tq = wave >> 2, vq = wave & 3; \
                f32x16 oacc; \
                _Pragma("unroll") for (int i = 0; i < 16; ++i) oacc[i] = 0.f; \
                _Pragma("unroll") for (int kk = 0; kk < 8; ++kk) { \
                    const bf16x8 af = *(const LAS bf16x8*)(lds + QD + (32 * tq + l31) * 272 + (kk * 16 + 8 * lh) * 2); \
                    const bf16x8 bf = *(const LAS bf16x8*)(lds + ST + (32 * vq + l31) * 272 + (kk * 16 + 8 * lh) * 2); \
                    oacc = __builtin_amdgcn_mfma_f32_32x32x16_bf16(af, bf, oacc, 0, 0, 0); } \
                _Pragma("unroll") for (int kk = 0; kk < 4; ++kk) { \
                    const bf16x8 af = *(const LAS bf16x8*)(lds + PP + (32 * tq + l31) * 144 + (kk * 16 + 8 * lh) * 2); \
                    const bf16x8 bf = *(const LAS bf16x8*)(lds + VT + (32 * vq + l31) * 144 + (kk * 16 + 8 * lh) * 2); \
                    oacc = __builtin_amdgcn_mfma_f32_32x32x16_bf16(af, bf, oacc, 0, 0, 0); } \
                const int ocol = h * 256 + dvh * 128 + 32 * vq + l31; \
                _Pragma("unroll") for (int r = 0; r < 16; ++r) { const int t = 32 * tq + crow(r, lh); obuf[(size_t)(rowbase + sgn * t) * 1024 + ocol] = f2bf(oacc[r]); } \
            } \
            { \
                const int vq = wave & 3; \
                _Pragma("unroll") for (int j = 0; j < 2; ++j) { \
                    const int dq = 2 * (wave >> 2) + j; \
                    _Pragma("unroll") for (int r = 0; r < 16; ++r) Sacc[j][r] *= *(const LAS float*)(lds + BL + (32 * dq + crow(r, lh)) * 4); \
                    _Pragma("unroll") for (int kk = 0; kk < 4; ++kk) { \
                        const bf16x8 af = *(const LAS bf16x8*)(lds + KST + (32 * dq + l31) * 144 + (kk * 16 + 8 * lh) * 2); \
                        const bf16x8 bf = *(const LAS bf16x8*)(lds + VT + (32 * vq + l31) * 144 + (kk * 16 + 8 * lh) * 2); \
                        Sacc[j] = __builtin_amdgcn_mfma_f32_32x32x16_bf16(af, bf, Sacc[j], 0, 0, 0); } } \
            } \
            __syncthreads();     \
            { \
                const int vq = wave & 3; \
                _Pragma("unroll") for (int j = 0; j < 2; ++j) { \
                    const int dq = 2 * (wave >> 2) + j; \
                    _Pragma("unroll") for (int g = 0; g < 4; ++g) { \
                        u32x2 w; w.x = cvt_pk_bf16(Sacc[j][4 * g], Sacc[j][4 * g + 1]); w.y = cvt_pk_bf16(Sacc[j][4 * g + 2], Sacc[j][4 * g + 3]); \
                        *(LAS u32x2*)(lds + ST + (32 * vq + l31) * 272 + (32 * dq + 8 * g + 4 * lh) * 2) = w; } } \
            } } while (0)
        SCAN_LOAD(A, 0); SCAN_LOAD(B, 1);
        for (int c = 0; c < 68; c += 2) { SCAN_CHUNK(A, c); SCAN_CHUNK(B, c + 1); }
#undef SCAN_CHUNK
#undef SCAN_LOAD
    }
    __syncthreads();
}

DI void glapost_phase(const bf16_t* of, const bf16_t* ob, const bf16_t* vr, const float* onorm, bf16_t* a) {
    const int tid = tid_opq(), wave = tid >> 6, lane = tid & 63;
    const int c0 = lane * 16;
    float gn[16];
#pragma unroll
    for (int j = 0; j < 4; ++j) { const f32x4 t = *(const f32x4*)(onorm + (c0 & 255) + 4 * j); gn[4 * j] = t[0]; gn[4 * j + 1] = t[1]; gn[4 * j + 2] = t[2]; gn[4 * j + 3] = t[3]; }
    for (int row0 = (blockIdx.x * 8 + wave) * 4; row0 < MR; row0 += gridDim.x * 32) {
        u32x4 f0[4], f1[4], b0[4], b1[4], r0[4], r1[4];
#pragma unroll
        for (int q = 0; q < 4; ++q) { const size_t ro = (size_t)(row0 + q);
            f0[q] = *(const u32x4*)(of + ro * 1024 + c0); f1[q] = *(const u32x4*)(of + ro * 1024 + c0 + 8);
            b0[q] = *(const u32x4*)(ob + ro * 1024 + c0); b1[q] = *(const u32x4*)(ob + ro * 1024 + c0 + 8);
            r0[q] = *(const u32x4*)(vr + ro * 2048 + 1024 + c0); r1[q] = *(const u32x4*)(vr + ro * 2048 + 1024 + c0 + 8); }
        asm volatile("" ::: "memory");
#pragma unroll
        for (int q = 0; q < 4; ++q) {
            float o[16], rr[16];
#pragma unroll
            for (int j = 0; j < 4; ++j) {
                o[2 * j] = bf_lo(f0[q][j]) + bf_lo(b0[q][j]); o[2 * j + 1] = bf_hi(f0[q][j]) + bf_hi(b0[q][j]);
                o[8 + 2 * j] = bf_lo(f1[q][j]) + bf_lo(b1[q][j]); o[8 + 2 * j + 1] = bf_hi(f1[q][j]) + bf_hi(b1[q][j]);
                rr[2 * j] = bf_lo(r0[q][j]); rr[2 * j + 1] = bf_hi(r0[q][j]); rr[8 + 2 * j] = bf_lo(r1[q][j]); rr[8 + 2 * j + 1] = bf_hi(r1[q][j]);
            }
            float ss = 0.f;
#pragma unroll
            for (int j = 0; j < 16; ++j) ss += o[j] * o[j];
            ss += __shfl_xor(ss, 1); ss += __shfl_xor(ss, 2); ss += __shfl_xor(ss, 4); ss += __shfl_xor(ss, 8);
            const float rstd = rsqrtf(ss * (1.0f / 256.0f) + 1e-6f);
            unsigned w[8];
#pragma unroll
            for (int j = 0; j < 8; ++j) {
                const float y0 = o[2 * j] * rstd * gn[2 * j] * silu_f(rr[2 * j]), y1 = o[2 * j + 1] * rstd * gn[2 * j + 1] * silu_f(rr[2 * j + 1]);
                w[j] = cvt_pk_bf16(y0, y1);
            }
            *(u32x4*)(a + (size_t)(row0 + q) * 1024 + c0) = (u32x4){w[0], w[1], w[2], w[3]};
            *(u32x4*)(a + (size_t)(row0 + q) * 1024 + c0 + 8) = (u32x4){w[4], w[5], w[6], w[7]};
        }
    }
}

DI void rope_cs(int tpos, int lane, float& cs, float& sn) {
    const int f = lane & 15; const int pos = (lane >> 5) ? (tpos & 63) : (tpos >> 6);
    const float inv = exp2f(-(float)f * (13.287712379549449f / 16.0f));
    const float ang = (float)pos * inv;
    const float kf = rintf(ang * 0.15915494309189535f);
    float r = fmaf(-kf, 6.2831854820251465f, ang); r = fmaf(-kf, -1.7484556000744883e-7f, r);
    cs = __cosf(r); sn = __sinf(r);
}
DI float rope_apply(float y, int lane, float cs, float sn) {
    const float pr = __shfl_xor(y, 16);
    return (lane & 16) ? (pr * sn + y * cs) : (y * cs - pr * sn);
}
DI int key_of_row(int row) {
    if (row < TL) { const int b = row >> 12; return b * KEYS + CTXL + (row & 4095); }
    const int rc = row - TL; const int b = rc >> 8; return b * KEYS + (rc & 255);
}

DI void mlamid_phase(const bf16_t* dn, const float* qln, const float* kvln, const float* knorm, bf16_t* cqn, bf16_t* ckvn, bf16_t* KB) {
    const int tid = tid_opq(), wave = tid >> 6, lane = tid & 63;
    for (int row = blockIdx.x * 8 + wave; row < MR; row += gridDim.x * 8) {
        const bf16_t* src = dn + (size_t)row * 768;
        unsigned q[3]; float ss = 0.f;
#pragma unroll
        for (int i = 0; i < 3; ++i) { q[i] = *(const unsigned*)(src + i * 128 + 2 * lane); const float a = bf_lo(q[i]), b = bf_hi(q[i]); ss += a * a + b * b; }
        ss = wave_sum(ss);
        float rstd = rsqrtf(ss * (1.0f / 384.0f) + 1e-6f);
#pragma unroll
        for (int i = 0; i < 3; ++i) { const int c = i * 128 + 2 * lane; *(unsigned*)(cqn + (size_t)row * 384 + c) = cvt_pk_bf16(bf_lo(q[i]) * rstd * qln[c], bf_hi(q[i]) * rstd * qln[c + 1]); }
        const u32x2 kvv = *(const u32x2*)(src + 384 + 4 * lane);
        const float k0 = bf_lo(kvv.x), k1 = bf_hi(kvv.x), k2 = bf_lo(kvv.y), k3 = bf_hi(kvv.y);
        ss = wave_sum(k0 * k0 + k1 * k1 + k2 * k2 + k3 * k3);
        rstd = rsqrtf(ss * (1.0f / 256.0f) + 1e-6f);
        { const f32x4 g = *(const f32x4*)(kvln + 4 * lane); u32x2 w; w.x = cvt_pk_bf16(k0 * rstd * g[0], k1 * rstd * g[1]); w.y = cvt_pk_bf16(k2 * rstd * g[2], k3 * rstd * g[3]);
          *(u32x2*)(ckvn + (size_t)row * 256 + 4 * lane) = w; }
        const float x = __uint_as_float(((unsigned)src[640 + lane]) << 16);
        ss = wave_sum(x * x);
        rstd = rsqrtf(ss * (1.0f / 64.0f) + 1e-6f);
        float y = x * rstd * knorm[128 + lane];
        if (row < TL) { float cs, sn; rope_cs(row & 4095, lane, cs, sn); y = rope_apply(y, lane, cs, sn); }
        const bf16_t yb = f2bf(y);
        bf16_t* kd = KB + (size_t)key_of_row(row) * 1536 + 128 + lane;
#pragma unroll
        for (int hh = 0; hh < 8; ++hh) kd[hh * 192] = yb;
    }
}

DI void qkprep_phase(bf16_t* Q, bf16_t* KB, const float* qnorm, const float* knorm) {
    const int tid = tid_opq(), wave = tid >> 6, lane = tid & 63;
    const float qn0 = qnorm[2 * lane], qn1 = qnorm[2 * lane + 1], qnr = qnorm[128 + lane];
    const float kn0 = knorm[2 * lane], kn1 = knorm[2 * lane + 1];
    for (int row = blockIdx.x * 8 + wave; row < MR; row += gridDim.x * 8) {
        float cs = 1.f, sn = 0.f;
        const bool lat = row < TL;
        if (lat) rope_cs(row & 4095, lane, cs, sn);
        bf16_t* qr = Q + (size_t)row * 1536;
        bf16_t* kr = KB + (size_t)key_of_row(row) * 1536;
        unsigned qa[8], ka[8]; bf16_t xq[8];
#pragma unroll
        for (int hh = 0; hh < 8; ++hh) { qa[hh] = *(const unsigned*)(qr + hh * 192 + 2 * lane); xq[hh] = qr[hh * 192 + 128 + lane]; ka[hh] = *(const unsigned*)(kr + hh * 192 + 2 * lane); }
        asm volatile("" ::: "memory");
#pragma unroll
        for (int hh = 0; hh < 8; ++hh) {
            const float xr = __uint_as_float(((unsigned)xq[hh]) << 16);
            const float a0 = bf_lo(qa[hh]), a1 = bf_hi(qa[hh]), c0 = bf_lo(ka[hh]), c1 = bf_hi(ka[hh]);
            const float s1 = wave_sum(a0 * a0 + a1 * a1), s2 = wave_sum(xr * xr), s3 = wave_sum(c0 * c0 + c1 * c1);
            const float r1 = rsqrtf(s1 * (1.0f / 128.0f) + 1e-6f), r2 = rsqrtf(s2 * (1.0f / 64.0f) + 1e-6f), r3 = rsqrtf(s3 * (1.0f / 128.0f) + 1e-6f);
            *(unsigned*)(qr + hh * 192 + 2 * lane) = cvt_pk_bf16(a0 * r1 * qn0, a1 * r1 * qn1);
            float y = xr * r2 * qnr;
            if (lat) y = rope_apply(y, lane, cs, sn);
            qr[hh * 192 + 128 + lane] = f2bf(y);
            *(unsigned*)(kr + hh * 192 + 2 * lane) = cvt_pk_bf16(c0 * r3 * kn0, c1 * r3 * kn1);
        }
    }
}

namespace att {
constexpr int DQK = 192, DV = 128, NW = 8, QBLK = 32, KVBLK = 64;
constexpr int LDQ = 1536, LDK = 1536, LDV = 1024, LDO = 1024;
constexpr float SCALE = 0.07216878364870322f;
constexpr float THR = 8.f;
constexpr size_t SHM_V = KVBLK * DV * 2, SHM_K = KVBLK * DQK * 2;
#define KSWZ(row, colB) ((row) * 384 + ((colB) ^ ((((row) >> 1) & 7) << 4)))
#define SBAR() __builtin_amdgcn_sched_barrier(0)
DI unsigned cvtpk(float lo, float hi) { unsigned r; asm volatile("v_cvt_pk_bf16_f32 %0, %1, %2" : "=v"(r) : "v"(lo), "v"(hi)); return r; }
DI void partialSM(f32x16& p0, f32x16& p1, float& m_reg, float& mn, float& alpha) {
    constexpr float C = SCALE * 1.4426950408889634f;
    float pmax = p0[0];
#pragma unroll
    for (int r = 1; r < 16; ++r) pmax = fmaxf(pmax, p0[r]);
#pragma unroll
    for (int r = 0; r < 16; ++r) pmax = fmaxf(pmax, p1[r]);
    { auto rr = __builtin_amdgcn_permlane32_swap(__float_as_uint(pmax), __float_as_uint(pmax), false, false);
      pmax = fmaxf(__uint_as_float(rr[0]), __uint_as_float(rr[1])); }
    if (__builtin_expect(__all(pmax - m_reg <= THR / SCALE), 1)) { mn = m_reg; alpha = 1.f; }
    else { mn = fmaxf(m_reg, pmax); alpha = __builtin_amdgcn_exp2f((m_reg - mn) * C); m_reg = mn; }
    const float mnC = -mn * C;
#pragma unroll
    for (int r = 0; r < 16; ++r) p0[r] = fmaf(p0[r], C, mnC);
#pragma unroll
    for (int r = 0; r < 16; ++r) p1[r] = fmaf(p1[r], C, mnC);
#pragma unroll
    for (int r = 0; r < 16; ++r) p0[r] = __builtin_amdgcn_exp2f(p0[r]);
}
DI void finishSM(f32x16& p0, f32x16& p1, float alpha, float& l_reg, bf16x8& pa0, bf16x8& pa1, bf16x8& pa2, bf16x8& pa3) {
#pragma unroll
    for (int r = 0; r < 16; ++r) p1[r] = __builtin_amdgcn_exp2f(p1[r]);
    float ps = 0;
#pragma unroll
    for (int r = 0; r < 16; ++r) ps += p0[r];
#pragma unroll
    for (int r = 0; r < 16; ++r) ps += p1[r];
    { auto rr = __builtin_amdgcn_permlane32_swap(__float_as_uint(ps), __float_as_uint(ps), false, false);
      ps = __uint_as_float(rr[0]) + __uint_as_float(rr[1]); }
    l_reg = l_reg * alpha + ps;
#define PK4(P, BASE, OUT) do { unsigned a0 = cvtpk(P[BASE + 0], P[BASE + 1]), a1 = cvtpk(P[BASE + 2], P[BASE + 3]);   \
    unsigned b0 = cvtpk(P[BASE + 4], P[BASE + 5]), b1 = cvtpk(P[BASE + 6], P[BASE + 7]);                              \
    auto r0 = __builtin_amdgcn_permlane32_swap(a0, b0, false, false); auto r1 = __builtin_amdgcn_permlane32_swap(a1, b1, false, false); \
    u32x4 w = {r0[0], r1[0], r0[1], r1[1]}; OUT = *reinterpret_cast<bf16x8*>(&w); } while (0)
    PK4(p0, 0, pa0); PK4(p0, 8, pa1); PK4(p1, 0, pa2); PK4(p1, 8, pa3);
#undef PK4
}
DI void qkt(f32x16& p0, f32x16& p1, const char* Ks, const bf16x8* qr, int r32, int hi) {
#pragma unroll
    for (int r = 0; r < 16; ++r) { p0[r] = 0.f; p1[r] = 0.f; }
#pragma unroll
    for (int d0 = 0; d0 < 12; ++d0) { const int cb = (d0 * 16 + hi * 8) * 2;
        const bf16x8 b0 = *reinterpret_cast<const bf16x8*>(Ks + KSWZ(r32, cb));
        const bf16x8 b1 = *reinterpret_cast<const bf16x8*>(Ks + KSWZ(32 + r32, cb));
        p0 = __builtin_amdgcn_mfma_f32_32x32x16_bf16(b0, qr[d0], p0, 0, 0, 0);
        p1 = __builtin_amdgcn_mfma_f32_32x32x16_bf16(b1, qr[d0], p1, 0, 0, 0); }
}
DI int v_st(int k, int c) { const int kk = (k & ~0xC) | ((k & 4) << 1) | ((k & 8) >> 1); return ((kk >> 3) * 4 + (c >> 5)) * 512 + ((kk & 7) * 32 + (c & 31)) * 2; }
DI int v_rd_base(int lane) { return ((lane & 3) << 3) | (((lane >> 2) & 3) << 6) | (((lane >> 4) & 1) << 5) | (((lane >> 5) & 1) << 8); }
constexpr int v_rd_off(int d0, int ks, int half) { return d0 * 512 + ks * 4096 + half * 2048; }
template <int OFF> DI s16x4 tr_read(int vb) { s16x4 r; asm volatile("ds_read_b64_tr_b16 %0, %1 offset:%2" : "=&v"(r) : "v"(vb), "i"(OFF) : "memory"); return r; }
template <int D0> DI void pv_one(f32x16& od, int vb, bf16x8 pa0, bf16x8 pa1, bf16x8 pa2, bf16x8 pa3) {
    const s16x4 l0 = tr_read<v_rd_off(D0, 0, 0)>(vb), h0 = tr_read<v_rd_off(D0, 0, 1)>(vb), l1 = tr_read<v_rd_off(D0, 1, 0)>(vb), h1 = tr_read<v_rd_off(D0, 1, 1)>(vb);
    const s16x4 l2 = tr_read<v_rd_off(D0, 2, 0)>(vb), h2 = tr_read<v_rd_off(D0, 2, 1)>(vb), l3 = tr_read<v_rd_off(D0, 3, 0)>(vb), h3 = tr_read<v_rd_off(D0, 3, 1)>(vb);
    asm volatile("s_waitcnt lgkmcnt(0)" ::: "memory"); SBAR();
#define PK(L, H) (bf16x8){L[0], L[1], L[2], L[3], H[0], H[1], H[2], H[3]}
    od = __builtin_amdgcn_mfma_f32_32x32x16_bf16(pa0, PK(l0, h0), od, 0, 0, 0);
    od = __builtin_amdgcn_mfma_f32_32x32x16_bf16(pa1, PK(l1, h1), od, 0, 0, 0);
    od = __builtin_amdgcn_mfma_f32_32x32x16_bf16(pa2, PK(l2, h2), od, 0, 0, 0);
    od = __builtin_amdgcn_mfma_f32_32x32x16_bf16(pa3, PK(l3, h3), od, 0, 0, 0);
#undef PK
}
DI void pv_d0(f32x16* o, int vb, bf16x8 pa0, bf16x8 pa1, bf16x8 pa2, bf16x8 pa3) {
    pv_one<0>(o[0], vb, pa0, pa1, pa2, pa3); pv_one<1>(o[1], vb, pa0, pa1, pa2, pa3); pv_one<2>(o[2], vb, pa0, pa1, pa2, pa3); pv_one<3>(o[3], vb, pa0, pa1, pa2, pa3);
}
DI void attn_body(const bf16_t* __restrict__ Qb, const bf16_t* __restrict__ Kh, const bf16_t* __restrict__ Vh, bf16_t* __restrict__ Ob, int seq, char* lds) {
    const int tid = tid_opq(), wid = tid >> 6, lane = tid & 63, r32 = lane & 31, hi = lane >> 5;
    char* V_lds = lds; char* K_lds = lds + 2 * SHM_V;
    float* wsf = (float*)(lds + 2 * SHM_V + 2 * SHM_K) + wid * 64; float* li_l = wsf; float* al_l = wsf + 32;
    float m_reg = -1e30f, l_reg = 0; f32x16 o[4]; bf16x8 qr[12];
#pragma unroll
    for (int d = 0; d < 4; ++d)
#pragma unroll
        for (int r = 0; r < 16; ++r) o[d][r] = 0.f;
    const bf16_t* Qw = Qb + (long)(wid * QBLK + r32) * LDQ + hi * 8;
#pragma unroll
    for (int d0 = 0; d0 < 12; ++d0) qr[d0] = *reinterpret_cast<const bf16x8*>(Qw + d0 * 16);
    const int sr = tid >> 4, sc = (tid & 15) * 8, vst0 = v_st(sr, sc), vst1 = v_st(32 + sr, sc);
    const int pr = tid >> 3, pc = 128 + (tid & 7) * 8;
    const int vb0 = (int)(uintptr_t)V_lds + v_rd_base(lane);
    bf16x8 vs0, vs1, ks0, ks1, kp;
#define SLOAD(k0) do { vs0 = *reinterpret_cast<const bf16x8*>(&Vh[(long)((k0) + sr) * LDV + sc]); vs1 = *reinterpret_cast<const bf16x8*>(&Vh[(long)((k0) + 32 + sr) * LDV + sc]); \
    ks0 = *reinterpret_cast<const bf16x8*>(&Kh[(long)((k0) + sr) * LDK + sc]); ks1 = *reinterpret_cast<const bf16x8*>(&Kh[(long)((k0) + 32 + sr) * LDK + sc]); \
    kp = *reinterpret_cast<const bf16x8*>(&Kh[(long)((k0) + pr) * LDK + pc]); } while (0)
#define SWRITE(b) do { *(bf16x8*)(V_lds + (b) * SHM_V + vst0) = vs0; *(bf16x8*)(V_lds + (b) * SHM_V + vst1) = vs1; \
    *(bf16x8*)(K_lds + (b) * SHM_K + KSWZ(sr, sc * 2)) = ks0; *(bf16x8*)(K_lds + (b) * SHM_K + KSWZ(32 + sr, sc * 2)) = ks1; \
    *(bf16x8*)(K_lds + (b) * SHM_K + KSWZ(pr, pc * 2)) = kp; } while (0)
#define RESC(a) do { if (__any((a) < 1.f)) { if (hi == 0) al_l[r32] = (a); asm volatile("s_waitcnt lgkmcnt(0)" ::: "memory"); \
    _Pragma("unroll") for (int d = 0; d < 4; ++d) _Pragma("unroll") for (int r = 0; r < 16; ++r) o[d][r] *= al_l[crow(r, hi)]; } } while (0)
    f32x16 p0, p1; float mn, al; bf16x8 pa0, pa1, pa2, pa3; const int NT = seq / KVBLK;
    SLOAD(0); asm volatile("s_waitcnt vmcnt(0)" ::: "memory"); SWRITE(0); __syncthreads();
    for (int j = 0; j < NT; ++j) {
        const int cb = j & 1;
        if (j + 1 < NT) SLOAD((j + 1) * KVBLK);
        SBAR(); qkt(p0, p1, K_lds + cb * SHM_K, qr, r32, hi);
        partialSM(p0, p1, m_reg, mn, al);
        finishSM(p0, p1, al, l_reg, pa0, pa1, pa2, pa3);
        RESC(al); SBAR();
        pv_d0(o, vb0 + cb * (int)SHM_V, pa0, pa1, pa2, pa3);
        if (j + 1 < NT) { asm volatile("s_waitcnt vmcnt(0)" ::: "memory"); SWRITE(cb ^ 1); }
        __syncthreads();
    }
    if (hi == 0) li_l[r32] = l_reg; asm volatile("s_waitcnt lgkmcnt(0)" ::: "memory");
    float rli[16];
#pragma unroll
    for (int r = 0; r < 16; ++r) rli[r] = __builtin_amdgcn_rcpf(li_l[crow(r, hi)]);
    bf16_t* Ow = Ob + (long)(wid * QBLK) * LDO;
#pragma unroll
    for (int r = 0; r < 16; ++r) { const int orow = crow(r, hi);
#pragma unroll
        for (int d0 = 0; d0 < 4; ++d0) Ow[(long)orow * LDO + d0 * 32 + r32] = f2bf(o[d0][r] * rli[r]); }
#undef SLOAD
#undef SWRITE
#undef RESC
}
#undef KSWZ
#undef SBAR
}

DI void attn_phase(const bf16_t* Q, const bf16_t* KB, const bf16_t* VB, bf16_t* O, char* lds, int nitems) {
    for (int it = blockIdx.x; it < nitems; it += gridDim.x) {
        int b, h, qrow0, seq;
        if (it < 2048) { b = it >> 7; h = (it >> 4) & 7; qrow0 = b * SEQ + (it & 15) * 256; seq = KEYS; }
        else { const int j = it - 2048; b = j >> 3; h = j & 7; qrow0 = TL + b * CTXL; seq = CTXL; }
        att::attn_body(Q + (size_t)qrow0 * 1536 + h * 192, KB + (size_t)b * KEYS * 1536 + h * 192, VB + (size_t)b * KEYS * 1024 + h * 128,
                       O + (size_t)qrow0 * 1024 + h * 128, seq, lds);
        __syncthreads();
    }
}

DI void fixup_phase(const float* halo, const float* cw, const float* cb, bf16_t* act) {
    const int gtid = blockIdx.x * NTHREADS + tid_opq(), gstride = gridDim.x * NTHREADS;
    for (int idx = gtid; idx < 272 * 22 * 64; idx += gstride) {
        const int c4 = (idx & 31) * 4, which = (idx >> 5) & 1, t = idx >> 6, pn = t % 22, pm = t / 22;
        const float* hp = halo + (size_t)(pm * 22 + pn) * 4 * 256;
        const bool sfirst = pm >= 256 || (pm & 15) == 0, slast = pm >= 256 || (pm & 15) == 15;
        const f32x4 z4 = (f32x4){0.f, 0.f, 0.f, 0.f};
        f32x4 pa, pg, ca, cg_, na, ng; int row;
        if (which == 0) { row = pm * 256;
            if (sfirst) { pa = z4; pg = z4; } else { const float* q = halo + (size_t)((pm - 1) * 22 + pn) * 4 * 256 + 3 * 256; pa = *(const f32x4*)(q + c4); pg = *(const f32x4*)(q + 128 + c4); }
            ca = *(const f32x4*)(hp + c4); cg_ = *(const f32x4*)(hp + 128 + c4); na = *(const f32x4*)(hp + 256 + c4); ng = *(const f32x4*)(hp + 256 + 128 + c4);
        } else { row = pm * 256 + 255;
            pa = *(const f32x4*)(hp + 2 * 256 + c4); pg = *(const f32x4*)(hp + 2 * 256 + 128 + c4); ca = *(const f32x4*)(hp + 3 * 256 + c4); cg_ = *(const f32x4*)(hp + 3 * 256 + 128 + c4);
            if (slast) { na = z4; ng = z4; } else { const float* q = halo + (size_t)((pm + 1) * 22 + pn) * 4 * 256; na = *(const f32x4*)(q + c4); ng = *(const f32x4*)(q + 128 + c4); }
        }
        const int ch = pn * 128 + c4;
        const f32x4 w0a = *(const f32x4*)(cw + ch), w1a = *(const f32x4*)(cw + 5632 + ch), w2a = *(const f32x4*)(cw + 2 * 5632 + ch), ba = *(const f32x4*)(cb + ch);
        const f32x4 w0g = *(const f32x4*)(cw + 2816 + ch), w1g = *(const f32x4*)(cw + 5632 + 2816 + ch), w2g = *(const f32x4*)(cw + 2 * 5632 + 2816 + ch), bg = *(const f32x4*)(cb + 2816 + ch);
        const f32x4 av = w0a * pa + w1a * ca + w2a * na + ba, gv = w0g * pg + w1g * cg_ + w2g * ng + bg;
        u32x2 w; w.x = cvt_pk_bf16(silu_f(gv[0]) * av[0], silu_f(gv[1]) * av[1]); w.y = cvt_pk_bf16(silu_f(gv[2]) * av[2], silu_f(gv[3]) * av[3]);
        *(u32x2*)(act + (size_t)row * 2816 + ch) = w;
    }
}


#define XB_TMO      128
#define XB_XCNT(j)  (256  + 64 * (j))
#define XB_XSUB(j)  (1280 + 64 * (j))
#define XB_XGEN(j)  (2304 + 64 * (j))
#define XB_TOP      3328
#define XB_TOPGEN   3392
#define XCD_BAR_WORDS 3456
#define XB_SPIN_CAP (1u << 18)
DI unsigned xb_ld(unsigned* p)              { return __hip_atomic_load(p, __ATOMIC_RELAXED, __HIP_MEMORY_SCOPE_AGENT); }
DI unsigned xb_add(unsigned* p, unsigned v) { return __hip_atomic_fetch_add(p, v, __ATOMIC_RELAXED, __HIP_MEMORY_SCOPE_AGENT); }
DI unsigned xb_xcc_id() { return (unsigned)__builtin_amdgcn_s_getreg((3 << 11) | 20) & 0xFu; }
#define XB_SPIN(cond, bar) do { unsigned _sp = 0; while (cond) { __builtin_amdgcn_s_sleep(1); \
    if ((++_sp & 255u) == 0u) { if (xb_ld(&(bar)[XB_TMO])) break; if (_sp > XB_SPIN_CAP) { atomicAdd(&(bar)[XB_TMO], 1u); break; } } } } while (0)
struct XcdBarrier { unsigned* bar; unsigned x; volatile LAS unsigned* st; };
DI XcdBarrier xcd_barrier_post(unsigned* bar, volatile LAS unsigned* st) {
    XcdBarrier b; b.bar = bar; b.x = xb_xcc_id(); b.st = st;
    if (threadIdx.x == 0) (void)xb_add(&bar[XB_XCNT(b.x)], 1u);
    return b;
}
DI void xcd_barrier_complete(unsigned* bar, unsigned x, unsigned& nloc, unsigned& nx) {
    const unsigned G = gridDim.x * gridDim.y * gridDim.z;
    unsigned sum, cnt, mine, sp = 0u;
    for (;;) {
        sum = 0u; cnt = 0u; mine = 0u;
#pragma unroll
        for (unsigned j = 0; j < 16; ++j) { const unsigned c = xb_ld(&bar[XB_XCNT(j)]); sum += c; cnt += (c > 0u) ? 1u : 0u; mine = (j == x) ? c : mine; }
        if (sum == G) break;
        __builtin_amdgcn_s_sleep(1);
        if ((++sp & 255u) == 0u) { if (xb_ld(&bar[XB_TMO])) break; if (sp > XB_SPIN_CAP) { atomicAdd(&bar[XB_TMO], 1u); break; } }
    }
    nloc = mine > 0u ? mine : 1u; nx = cnt > 0u ? cnt : 1u;
}
DI void xcd_barrier(const XcdBarrier& b) {
    asm volatile("s_waitcnt vmcnt(0)" ::: "memory");
    __syncthreads();
    if (threadIdx.x == 0) {
        unsigned* bar = b.bar;
        __builtin_amdgcn_s_waitcnt(0);
        unsigned nloc = b.st[0], nx = b.st[1];
        if (nloc == 0u) { xcd_barrier_complete(bar, b.x, nloc, nx); b.st[0] = nloc; b.st[1] = nx; }
        const unsigned old = xb_add(&bar[XB_XSUB(b.x)], 1u);
        const unsigned gen = old / nloc;
        if (old + 1u == (gen + 1u) * nloc) {
            __builtin_amdgcn_fence(__ATOMIC_RELEASE, "agent");
            asm volatile("s_waitcnt vmcnt(0)" ::: "memory");
            const unsigned og = xb_add(&bar[XB_TOP], 1u);
            const unsigned tg = og / nx;
            if (og + 1u == (tg + 1u) * nx) xb_add(&bar[XB_TOPGEN], 1u);
            else XB_SPIN(xb_ld(&bar[XB_TOPGEN]) == tg, bar);
            __builtin_amdgcn_fence(__ATOMIC_ACQUIRE, "agent");
            xb_add(&bar[XB_XGEN(b.x)], 1u);
            asm volatile("s_waitcnt vmcnt(0)" ::: "memory");
        } else {
            XB_SPIN(xb_ld(&bar[XB_XGEN(b.x)]) == gen, bar);
            __builtin_amdgcn_fence(__ATOMIC_ACQUIRE, "agent");
            asm volatile("s_waitcnt vmcnt(0)" ::: "memory");
        }
    }
    __syncthreads();
}

__global__ void __launch_bounds__(NTHREADS) mega(Params p) {
    extern __shared__ __attribute__((aligned(16))) unsigned char smem[];
    LAS unsigned char* lds = (LAS unsigned char*)smem;
    cg::grid_group grid = cg::this_grid();
    volatile LAS unsigned* xb_st = (volatile LAS unsigned*)(lds + XB_ST_OFF);
    if (threadIdx.x < 4) xb_st[threadIdx.x] = 0u;
    __syncthreads();
    XcdBarrier xbar = xcd_barrier_post((unsigned*)((unsigned char*)p.in[27] + WS_BAR), xb_st);

    for (int ph = p.ph_lo; ph < p.ph_hi; ++ph) {
        unsigned char* ws = (unsigned char*)p.in[opq(27)];
        float* const xout = (float*)p.in[opq(26)];
        float* mod = (float*)(ws + WS_MOD);
        float* xc = (float*)(ws + WS_XC);
        bf16_t* hbuf = (bf16_t*)(ws + WS_H);
        if (ph == 0) {
            prep_phase(p, lds);
#if defined(MK_DUP_OP) && MK_DUP_OP == 99
            grid.sync(); prep_phase(p, lds);
#endif
        } else {
            const int q = ph - 1, lp = q / 21; int r = q % 21; int layer, nmix;
            if (r < 10) { layer = 2 * lp; nmix = 6; } else { layer = 2 * lp + 1; r -= 10; nmix = 7; }
            const bool is_mla = layer & 1; const int j = layer >> 1;
            const float* modl = mod + (size_t)layer * 17 * 6144;
            const bool first = (layer == 0);
            int op = -1, gsel = 0, hf = 0;
            if (r < nmix) {
                if (!is_mla) { op = r == 0 ? 0 : r == 1 ? 2 : r == 2 ? 9 : r == 3 ? 3 : r == 4 ? 4 : 2; gsel = r == 1 ? 0 : 1; }
                else { op = r == 0 ? 0 : r == 1 ? 2 : r == 2 ? 5 : r == 3 ? 2 : r == 4 ? 6 : r == 5 ? 7 : 2; gsel = r == 1 ? 2 : r == 3 ? 3 : 5; }
            } else {
                const int f = r - nmix;
                op = f == 0 ? 1 : f == 2 ? 8 : 2; gsel = f == 1 ? 6 : 7;
            }
            if (op == 1 || (op == 0 && layer > 0)) continue;
#ifdef MK_DUP_OP
            for (int rep_ = 0; rep_ < ((op == MK_DUP_OP || (op == 2 && gsel == MK_DUP_OP - 100)) ? 2 : 1); ++rep_) {
            if (rep_) grid.sync();
#else
            {
#endif
            if (op == 0) {
                norm_phase(p.in[opq(0)], p.in[opq(2)], p.in[opq(6)], modl, 0, 1024, hbuf);
                shw_phase(ws, lds);
            } else if (op == 2) {
                const int ng = (gsel == 3) ? 2 : 1;
                for (int gi = 0; gi < ng; ++gi) {
                    pg8::Gemm g; Epi E; int kind = EPI_BF16;
                    E.ldc = 0; E.xch = (LAS float*)(lds + XCH_OFF); E.q0 = nullptr; E.q1 = nullptr; E.q2 = nullptr; E.q3 = nullptr; E.q4 = nullptr; E.q5 = nullptr;
                    float* const shw_mix = (float*)(ws + WS_SHW) + (size_t)(layer * 2) * 17 * 5632; float* const shw_ffn = shw_mix + 17 * 5632;
                    float* const rs0 = (float*)(ws + WS_RS); float* const rs1 = rs0 + MR;
                    g.M = MR;
                    const int gs = gsel + gi;
                    if (gs == 0) { g.A = hbuf; g.Bt = (const bf16_t*)(ws + WS_GIN + j * SZ_GIN); g.N = 3328; g.K = 1024; g.lda = 1024; g.ldb = 1024;
                        kind = EPI_GLA_IN; E.q0 = ws + WS_QK; E.ldc = 1024; E.q1 = ws + WS_LR; E.q2 = ws + WS_VR; if (!first) { E.q3 = rs1; E.q4 = shw_mix; } }
                    else if (gs == 1 || gs == 5) { g.A = hbuf; g.Bt = (const bf16_t*)(ws + (gs == 1 ? WS_GOUT : WS_MOUT) + j * SZ_SQ); g.N = 1024; g.K = 1024; g.lda = 1024; g.ldb = 1024;
                        kind = EPI_RESID; E.ldc = 0; E.q0 = (void*)(first ? p.in[opq(0)] : xout); E.q1 = (void*)(first ? p.in[opq(2)] : xc); E.q2 = xout; E.q3 = ws; E.q4 = (void*)modl; E.q5 = (void*)(p.in[opq(7)] + layer * 1024);
                        for (int i = blockIdx.x * NTHREADS + tid_opq(); i < MR; i += gridDim.x * NTHREADS) rs1[i] = 0.f; }
                    else if (gs == 2) { g.A = hbuf; g.Bt = (const bf16_t*)(ws + WS_MDOWN + j * SZ_MDOWN); g.N = 768; g.K = 1024; g.lda = 1024; g.ldb = 1024;
                        E.q0 = ws + WS_DN; E.ldc = 768; E.q3 = rs1; E.q4 = shw_mix; }
                    else if (gs == 3) { g.A = (const bf16_t*)(ws + WS_CQN); g.Bt = (const bf16_t*)(ws + WS_MUQ + j * SZ_MUQ); g.N = 1536; g.K = 384; g.lda = 384; g.ldb = 384;
                        E.q0 = ws + WS_QRAW; E.ldc = 1536; }
                    else if (gs == 4) { g.A = (const bf16_t*)(ws + WS_CKVN); g.Bt = (const bf16_t*)(ws + WS_MUKV + j * SZ_MUKV); g.N = 2048; g.K = 256; g.lda = 256; g.ldb = 256;
                        kind = EPI_UKV; E.q0 = ws + WS_KB; E.q1 = ws + WS_VB; }
                    else if (gs == 6) { g.A = (const bf16_t*)(ws + WS_XSA); g.Bt = (const bf16_t*)(ws + WS_FUP + (size_t)layer * SZ_FUP); g.N = 5632; g.K = 1024; g.lda = 1024; g.ldb = 1024;
                        kind = EPI_FFN_UP; E.q0 = ws + WS_ACT; E.ldc = 2816; E.q1 = (void*)(p.in[opq(23)] + (size_t)layer * 3 * 2 * DFF); E.q2 = (void*)(p.in[opq(24)] + (size_t)layer * 2 * DFF);
                        E.q3 = ws + WS_HALO; E.q4 = rs0; E.q5 = shw_ffn; }
                    else { g.A = (const bf16_t*)(ws + WS_ACT); g.Bt = (const bf16_t*)(ws + WS_FDOWN + (size_t)layer * SZ_FDOWN); g.N = 1024; g.K = 2816; g.lda = 2816; g.ldb = 2816;
                        kind = EPI_RESID; E.ldc = 1; E.q0 = xout; E.q1 = xc; E.q2 = xout; E.q3 = ws; E.q4 = (void*)modl; E.q5 = layer < 3 ? (void*)(p.in[opq(6)] + (layer + 1) * 1024) : nullptr;
                        for (int i = blockIdx.x * NTHREADS + tid_opq(); i < MR; i += gridDim.x * NTHREADS) rs0[i] = 0.f; }
                    if (layer == 3 && (gs == 3 || gs == 5 || gs == 6 || gs == 7)) g.M = TL;
                    pg8::StaticOrder S; S.init(g.M, g.N, (int)gridDim.x, (int)blockIdx.x);
                    if (kind == EPI_BF16) pg8::gemm_phase<Epi, EPI_BF16>(lds, g, S, E);
                    else if (kind == EPI_GLA_IN) pg8::gemm_phase<Epi, EPI_GLA_IN>(lds, g, S, E);
                    else if (kind == EPI_RESID) pg8::gemm_phase<Epi, EPI_RESID>(lds, g, S, E);
                    else if (kind == EPI_UKV) pg8::gemm_phase<Epi, EPI_UKV>(lds, g, S, E);
                    else pg8::gemm_phase<Epi, EPI_FFN_UP>(lds, g, S, E);
                    __syncthreads();
                }
            } else if (op == 3) {
                scan_phase((const bf16_t*)(ws + WS_VR), (const bf16_t*)(ws + WS_GQ), (const bf16_t*)(ws + WS_GK), (const bf16_t*)(ws + WS_GP), (const float*)(ws + WS_GE),
                           hbuf, (bf16_t*)(ws + WS_QK), lds);
            } else if (op == 9) {
                gateprep_phase((const bf16_t*)(ws + WS_QK), (const float*)(ws + WS_LR), p.in[opq(10)] + (size_t)j * 2 * 16 * 512, p.in[opq(11)] + (size_t)j * 2 * 512,
                               (bf16_t*)(ws + WS_GQ), (bf16_t*)(ws + WS_GK), (bf16_t*)(ws + WS_GP), (float*)(ws + WS_GE), lds);
            } else if (op == 4) {
                glapost_phase(hbuf, (const bf16_t*)(ws + WS_QK), (const bf16_t*)(ws + WS_VR), p.in[opq(12)] + j * 256, hbuf);
            } else if (op == 5) {
                mlamid_phase((const bf16_t*)(ws + WS_DN), p.in[opq(15)] + j * 384, p.in[opq(16)] + j * 256, p.in[opq(20)] + j * 192, (bf16_t*)(ws + WS_CQN), (bf16_t*)(ws + WS_CKVN), (bf16_t*)(ws + WS_KB));
            } else if (op == 6) {
                qkprep_phase((bf16_t*)(ws + WS_QRAW), (bf16_t*)(ws + WS_KB), p.in[opq(19)] + j * 192, p.in[opq(20)] + j * 192);
            } else if (op == 7) {
                attn_phase((const bf16_t*)(ws + WS_QRAW), (const bf16_t*)(ws + WS_KB), (const bf16_t*)(ws + WS_VB), hbuf, (char*)smem, layer == 3 ? 2048 : 2048 + 128);
            } else if (op == 8) {
                fixup_phase((const float*)(ws + WS_HALO), p.in[opq(23)] + (size_t)layer * 3 * 2 * DFF, p.in[opq(24)] + (size_t)layer * 2 * DFF, (bf16_t*)(ws + WS_ACT));
            }
            }
        }
        if (ph + 1 < p.ph_hi) { if (ph == 0) grid.sync(); else xcd_barrier(xbar); }
    }
}

extern "C" void kernel_launch(void* const* d_in, const int* in_sizes, int n_in, void* d_out, int out_size, void* d_ws, size_t ws_size, hipStream_t stream) {
    static int grid = 0;
    if (grid == 0) {
        if (n_in != 26 || ws_size < WS_END) { fprintf(stderr, "kernel_launch: n_in %d ws %zu (need %zu)\n", n_in, ws_size, (size_t)WS_END); grid = -1; return; }
        int dev = 0, cus = 0, per_cu = 0;
        hipGetDevice(&dev);
        hipDeviceGetAttribute(&cus, hipDeviceAttributeMultiprocessorCount, dev);
        if (hipFuncSetAttribute((const void*)mega, hipFuncAttributeMaxDynamicSharedMemorySize, LDS_BYTES) != hipSuccess) { fprintf(stderr, "kernel_launch: hipFuncSetAttribute failed\n"); grid = -1; return; }
        if (hipOccupancyMaxActiveBlocksPerMultiprocessor(&per_cu, (const void*)mega, NTHREADS, LDS_BYTES) != hipSuccess || per_cu < 1) { fprintf(stderr, "kernel_launch: occupancy query %d\n", per_cu); per_cu = 1; }
        (void)hipGetLastError();
        grid = cus * per_cu;
        fprintf(stderr, "kernel_launch: grid %d (cus %d x %d)\n", grid, cus, per_cu);
    }
    if (grid < 0) return;
    Params p{};
    for (int i = 0; i < 26; ++i) p.in[i] = (const float*)d_in[i];
    p.in[26] = (const float*)d_out; p.in[27] = (const float*)d_ws;
    (void)hipMemsetAsync((unsigned char*)d_ws + WS_BAR, 0, 16384, stream);
#if MK_MULTI
    for (int ph = 0; ph < NPH; ++ph) {
        p.ph_lo = ph; p.ph_hi = ph + 1;
        hipLaunchKernelGGL(mega, dim3(grid), dim3(NTHREADS), LDS_BYTES, stream, p);
    }
#else
    p.ph_lo = 0; p.ph_hi = NPH;
    void* args[] = {&p};
    hipError_t e = hipLaunchCooperativeKernel((const void*)mega, dim3(grid), dim3(NTHREADS), args, LDS_BYTES, stream);
    if (e != hipSuccess) fprintf(stderr, "cooperative launch failed: %s (grid %d)\n", hipGetErrorString(e), grid);
#endif
}
```

```cpp
#include <hip/hip_runtime.h>
#include <hip/hip_cooperative_groups.h>
#include <cstdio>
#include <cstdint>
namespace cg = cooperative_groups;

#ifndef MK_MULTI
#define MK_MULTI 0
#endif

#define LAS __attribute__((address_space(3)))
#define DI __device__ __forceinline__
typedef unsigned short bf16_t;
typedef short bf16x8 __attribute__((ext_vector_type(8)));
typedef short s16x4 __attribute__((ext_vector_type(4)));
typedef float f32x2 __attribute__((ext_vector_type(2)));
typedef float f32x4 __attribute__((ext_vector_type(4)));
typedef float f32x16 __attribute__((ext_vector_type(16)));
typedef unsigned u32x2 __attribute__((ext_vector_type(2)));
typedef unsigned u32x4 __attribute__((ext_vector_type(4)));

constexpr int DM = 1024, NB = 16, SEQ = 4096, CTXL = 256;
constexpr int TL = NB * SEQ, TC = NB * CTXL, MR = TL + TC;
constexpr int KEYS = CTXL + SEQ;
constexpr int DFF = 2816, DFFH = 1408;
constexpr int NTHREADS = 512;
constexpr int XB_ST_OFF = 131072 + 12288 + 2 * 5120 + 6144;
constexpr int LDS_BYTES = XB_ST_OFF + 16;
constexpr int WIMG_F = 3072, PREW_F = 3072 + 2 * 1280;
constexpr int XCH_OFF = 131072;
constexpr int NPH = 43;

constexpr size_t SZ_GIN = 3328ull * 1024 * 2, SZ_SQ = 1024ull * 1024 * 2, SZ_MDOWN = 768ull * 1024 * 2, SZ_MUQ = 1536ull * 384 * 2,
                 SZ_MUKV = 2048ull * 256 * 2, SZ_FUP = 5632ull * 1024 * 2, SZ_FDOWN = 1024ull * 2816 * 2;
constexpr size_t WS_GIN = 0;
constexpr size_t WS_GOUT = WS_GIN + 2 * SZ_GIN;
constexpr size_t WS_MDOWN = WS_GOUT + 2 * SZ_SQ;
constexpr size_t WS_MUQ = WS_MDOWN + 2 * SZ_MDOWN;
constexpr size_t WS_MUKV = WS_MUQ + 2 * SZ_MUQ;
constexpr size_t WS_MOUT = WS_MUKV + 2 * SZ_MUKV;
constexpr size_t WS_FUP = WS_MOUT + 2 * SZ_SQ;
constexpr size_t WS_FDOWN = WS_FUP + 4 * SZ_FUP;
constexpr size_t WS_MOD = WS_FDOWN + 4 * SZ_FDOWN;
constexpr size_t SZ_MOD = 4ull * 17 * 6144 * 4;
constexpr size_t WS_RS = WS_MOD + ((SZ_MOD + 255) / 256) * 256;
constexpr size_t WS_SHW = WS_RS + 2ull * MR * 4;
constexpr size_t WS_BAR = WS_SHW + 4ull * 2 * 17 * 5632 * 4;
constexpr size_t WS_XC = WS_BAR + 16384;
constexpr size_t WS_H = WS_XC + (size_t)TC * 1024 * 4;
constexpr size_t WS_R = WS_H + (size_t)MR * 1024 * 2;
constexpr size_t WS_QK = WS_R;
constexpr size_t WS_VR = WS_QK + (size_t)MR * 1024 * 2;
constexpr size_t WS_LR = WS_VR + (size_t)MR * 2048 * 2;
constexpr int NCHI = NB * 2 * 4 * 68;
constexpr size_t WS_GQ = WS_LR + (size_t)MR * 32 * 4;
constexpr size_t WS_GK = WS_GQ + (size_t)NCHI * 64 * 128 * 2;
constexpr size_t WS_GP = WS_GK + (size_t)NCHI * 64 * 128 * 2;
constexpr size_t WS_GE = WS_GP + (size_t)NCHI * 64 * 64 * 2;
constexpr size_t WS_GLA_END = WS_GE + (size_t)NCHI * 128 * 4;
constexpr size_t WS_QRAW = WS_R;
constexpr size_t WS_DN = WS_R;
constexpr size_t WS_CQN = WS_QRAW + (size_t)MR * 1536 * 2;
constexpr size_t WS_CKVN = WS_CQN + (size_t)MR * 384 * 2;
constexpr size_t WS_KB = WS_CKVN + (size_t)MR * 256 * 2;
constexpr size_t WS_VB = WS_KB + (size_t)NB * KEYS * 1536 * 2;
constexpr size_t WS_MLA_END = WS_VB + (size_t)NB * KEYS * 1024 * 2;
constexpr size_t WS_ACT = WS_R;
constexpr size_t WS_HALO = WS_ACT + (size_t)MR * 2816 * 2;
constexpr size_t WS_XSA = WS_HALO + 272ull * 22 * 4 * 256 * 4;
constexpr size_t WS_FFN_END = WS_XSA + (size_t)MR * 1024 * 2;
constexpr size_t WS_END = WS_GLA_END > WS_MLA_END ? (WS_GLA_END > WS_FFN_END ? WS_GLA_END : WS_FFN_END) : (WS_MLA_END > WS_FFN_END ? WS_MLA_END : WS_FFN_END);
static_assert(WS_END <= (1ull << 30), "workspace over 1 GiB");

struct Params { const float* in[28]; int ph_lo, ph_hi; };

DI unsigned cvt_pk_bf16(float lo, float hi) { unsigned r; asm("v_cvt_pk_bf16_f32 %0, %1, %2" : "=v"(r) : "v"(lo), "v"(hi)); return r; }
DI float bf_lo(unsigned u) { return __uint_as_float(u << 16); }
DI float bf_hi(unsigned u) { return __uint_as_float(u & 0xffff0000u); }
DI bf16_t f2bf(float f) { return (bf16_t)(cvt_pk_bf16(f, 0.f) & 0xffffu); }
DI float wave_sum(float v) {
    v += __int_as_float(__builtin_amdgcn_update_dpp(0, __float_as_int(v), 0xB1, 0xF, 0xF, false));
    v += __int_as_float(__builtin_amdgcn_update_dpp(0, __float_as_int(v), 0x4E, 0xF, 0xF, false));
    v += __int_as_float(__builtin_amdgcn_update_dpp(0, __float_as_int(v), 0x141, 0xF, 0xF, false));
    v += __int_as_float(__builtin_amdgcn_update_dpp(0, __float_as_int(v), 0x140, 0xF, 0xF, false));
    v += __int_as_float(__builtin_amdgcn_update_dpp(0, __float_as_int(v), 0x142, 0xA, 0xF, false));
    v += __int_as_float(__builtin_amdgcn_update_dpp(0, __float_as_int(v), 0x143, 0xC, 0xF, false));
    return __int_as_float(__builtin_amdgcn_readlane(__float_as_int(v), 63));
}
DI float silu_f(float v) { return v * __builtin_amdgcn_rcpf(1.0f + __expf(-v)); }
DI int crow(int r, int hi) { return (r & 3) + 8 * (r >> 2) + 4 * hi; }
DI int tid_opq() { int t = threadIdx.x; asm volatile("" : "+v"(t)); return t; }
DI int opq(int i) { asm volatile("" : "+s"(i)); return i; }

namespace pg8 {
constexpr int BM = 256, BK = 64, HALF = 128, HTB = HALF * BK * 2, STAGE_BYTES = 8 * HTB, NXCD = 8, WGM = 8;
DI int lds_byte(int r, int c) { const int st = (r >> 4) * 2 + (c >> 5), rr = r & 15, cc = c & 31, ob = rr * 64 + cc * 2; return st * 1024 + (ob ^ (((ob >> 9) & 1) << 5)); }
DI void stage_rc(int b, int& R, int& C) { const int st = b / 1024, sb = b % 1024, swz = sb ^ (((sb >> 9) & 1) << 5); R = (st >> 1) * 16 + swz / 64; C = (st & 1) * 32 + (swz % 64) / 2; }
DI int perm32(int rho) { const int n = rho >> 4, i = rho & 15; return 8 * (i >> 2) + 4 * n + (i & 3); }
struct Unit { int pm, pn; };
struct Gemm { const bf16_t* A; const bf16_t* Bt; int M, N, K, lda, ldb; };
struct StaticOrder {
    int nM, nN, nwg, G, c;
    DI void init(int M, int N, int G_, int c_) { nM = M / BM; nN = N / BM; nwg = nM * nN; G = G_; c = c_; }
    DI bool next(int i, Unit& u) const {
        const long L = (long)i * G + c; if (L >= nwg) return false;
        int wgid = (int)L; { const int q = nwg / NXCD, r = nwg % NXCD, xcd = wgid % NXCD, off = wgid / NXCD; wgid = (xcd < r ? xcd * (q + 1) : r * (q + 1) + (xcd - r) * q) + off; }
        const int nig = WGM * nN, gid = wgid / nig, fm = gid * WGM, gsz = (nM - fm) < WGM ? (nM - fm) : WGM;
        u.pm = fm + ((wgid % nig) % gsz); u.pn = (wgid % nig) / gsz; return true;
    }
};

template <class Epi, int KIND>
DI void gemm_phase(LAS unsigned char* lds, const Gemm g, const StaticOrder& S, const Epi& E) {
    constexpr bool perm = Epi::template perm_of<KIND>();
    const int tid = tid_opq(), wid = __builtin_amdgcn_readfirstlane(tid >> 6), lane = tid & 63, wr = wid >> 2, wc = wid & 3, fr = lane & 15, fq = lane >> 4;
    const int K = g.K, nt = K / BK;
    unsigned voffA[2], voffB[2];
#pragma unroll
    for (int i = 0; i < 2; ++i) { int R, C; stage_rc(tid * 16 + i * 8192, R, C); const int Rb = perm ? ((R & ~31) + perm32(R & 31)) : R;
        voffA[i] = (unsigned)(R * g.lda + C) * 2u; voffB[i] = (unsigned)(Rb * g.ldb + C) * 2u; }
    const size_t kstep = (size_t)(BK * 2);
    const size_t hstepA = (size_t)HALF * g.lda * 2, hstepB = (size_t)HALF * g.ldb * 2;
    const size_t tstepA = 2 * hstepA, tstepB = 2 * hstepB;
    const unsigned ldsw = (unsigned)wid * 1024u;
    const int aoff = lds_byte(wr * 64 + fr, fq * 8), boff = lds_byte(wc * 32 + fr, fq * 8);
#define PG8_SA(b, h) (((b) * 2 + (h)) * HTB)
#define PG8_SB(b, h) ((4 + (b) * 2 + (h)) * HTB)
#define PG8_STAGE(bufoff, gbase, voff) do { _Pragma("unroll") for (int _i = 0; _i < 2; ++_i) \
        __builtin_amdgcn_global_load_lds((const unsigned*)((const char*)(gbase) + (voff)[_i]), (LAS unsigned*)(lds + (bufoff) + ldsw + _i * 8192), 16, 0, 0); } while (0)
#define PG8_LDA(dst, b, h) do { _Pragma("unroll") for (int m = 0; m < 4; ++m) _Pragma("unroll") for (int k = 0; k < 2; ++k) dst[m][k] = *(const LAS bf16x8*)(lds + PG8_SA(b, h) + aoff + m * 2048 + k * 1024); } while (0)
#define PG8_LDB(dst, b, h) do { _Pragma("unroll") for (int n = 0; n < 2; ++n) _Pragma("unroll") for (int k = 0; k < 2; ++k) dst[n][k] = *(const LAS bf16x8*)(lds + PG8_SB(b, h) + boff + n * 2048 + k * 1024); } while (0)
#define PG8_MMA(ai, bj, At, Bt) do { __builtin_amdgcn_s_setprio(1); _Pragma("unroll") for (int m = 0; m < 4; ++m) _Pragma("unroll") for (int n = 0; n < 2; ++n) _Pragma("unroll") for (int k = 0; k < 2; ++k) \
        acc[ai][bj][m][n] = __builtin_amdgcn_mfma_f32_16x16x32_bf16(Bt[n][k], At[m][k], acc[ai][bj][m][n], 0, 0, 0); __builtin_amdgcn_s_setprio(0); } while (0)
#define PG8_WAIT_V(n) asm volatile("s_waitcnt vmcnt(" #n ")" ::: "memory")
#define PG8_WAIT_L(n) asm volatile("s_waitcnt lgkmcnt(" #n ")" ::: "memory")
#define PG8_BAR __builtin_amdgcn_s_barrier()
#define PG8_SCHED __builtin_amdgcn_sched_barrier(0)
    Unit cur, nxt; int ui = 0;
    if (!S.next(0, cur)) return;
    f32x4 acc[2][2][4][2];
#pragma unroll
    for (int a = 0; a < 2; ++a)
#pragma unroll
        for (int b = 0; b < 2; ++b)
#pragma unroll
            for (int m = 0; m < 4; ++m)
#pragma unroll
                for (int n = 0; n < 2; ++n) acc[a][b][m][n] = (f32x4){0.f, 0.f, 0.f, 0.f};
    bf16x8 At[4][2], B0[2][2], B1[2][2];
    typename Epi::Pre pre;
    const char* cA = (const char*)g.A + (size_t)cur.pm * tstepA; const char* cB = (const char*)g.Bt + (size_t)cur.pn * tstepB;
    PG8_STAGE(PG8_SB(0, 0), cB, voffB); PG8_STAGE(PG8_SA(0, 0), cA, voffA); PG8_STAGE(PG8_SB(0, 1), cB + hstepB, voffB); PG8_STAGE(PG8_SA(0, 1), cA + hstepA, voffA);
    if (wr == 1) PG8_BAR;
    PG8_WAIT_V(4); PG8_BAR;
    PG8_STAGE(PG8_SB(1, 0), cB + kstep, voffB); PG8_STAGE(PG8_SA(1, 0), cA + kstep, voffA); PG8_STAGE(PG8_SB(1, 1), cB + hstepB + kstep, voffB);
    PG8_WAIT_V(6); PG8_BAR;
    for (;;) {
        const bool has_next = S.next(ui + 1, nxt);
        const char* nA = has_next ? (const char*)g.A + (size_t)nxt.pm * tstepA : cA; const char* nB = has_next ? (const char*)g.Bt + (size_t)nxt.pn * tstepB : cB;
        E.template prefetch<KIND>(pre, cur, wr, wc, fr, fq, ui & 1);
        for (int t = 0; t < nt; t += 2) {
            const bool last = (t == nt - 2);
            const char* a1 = cA + (size_t)(t + 1) * kstep;
            const char* a2 = last ? nA : cA + (size_t)(t + 2) * kstep; const char* b2 = last ? nB : cB + (size_t)(t + 2) * kstep;
            const char* a3 = a2 + kstep; const char* b3 = b2 + kstep;
            PG8_LDB(B0, 0, 0); PG8_SCHED; PG8_LDA(At, 0, 0); PG8_STAGE(PG8_SA(1, 1), a1 + hstepA, voffA);
            PG8_WAIT_L(8); PG8_BAR; PG8_WAIT_L(0); PG8_MMA(0, 0, At, B0); PG8_BAR; PG8_SCHED;
            PG8_LDB(B1, 0, 1); PG8_STAGE(PG8_SB(0, 0), b2, voffB);
            PG8_BAR; PG8_WAIT_L(0); PG8_MMA(0, 1, At, B1); PG8_BAR;
            PG8_LDA(At, 0, 1); PG8_STAGE(PG8_SA(0, 0), a2, voffA);
            PG8_BAR; PG8_WAIT_L(0); PG8_MMA(1, 0, At, B0); PG8_BAR; PG8_SCHED;
            PG8_STAGE(PG8_SB(0, 1), b2 + hstepB, voffB);
            PG8_WAIT_V(6); PG8_BAR; PG8_MMA(1, 1, At, B1); PG8_BAR;
            PG8_LDB(B0, 1, 0); PG8_SCHED; PG8_LDA(At, 1, 0); PG8_STAGE(PG8_SA(0, 1), a2 + hstepA, voffA);
            PG8_WAIT_L(8); PG8_BAR; PG8_WAIT_L(0); PG8_MMA(0, 0, At, B0); PG8_BAR; PG8_SCHED;
            PG8_LDB(B1, 1, 1); PG8_STAGE(PG8_SB(1, 0), b3, voffB);
            PG8_BAR; PG8_WAIT_L(0); PG8_MMA(0, 1, At, B1); PG8_BAR;
            PG8_LDA(At, 1, 1); PG8_STAGE(PG8_SA(1, 0), a3, voffA);
            PG8_BAR; PG8_WAIT_L(0); PG8_MMA(1, 0, At, B0); PG8_BAR; PG8_SCHED;
            PG8_STAGE(PG8_SB(1, 1), b3 + hstepB, voffB);
            PG8_WAIT_V(6); PG8_BAR; PG8_MMA(1, 1, At, B1); PG8_BAR;
        }
        if (wr == 0) { PG8_BAR; asm volatile("" ::: "memory"); }
        E.template run<KIND>(acc, pre, cur, wr, wc, fr, fq, ui & 1);
        if (wr == 1) { asm volatile("" ::: "memory"); PG8_BAR; }
        if (!has_next) break;
#pragma unroll
        for (int a = 0; a < 2; ++a)
#pragma unroll
            for (int b = 0; b < 2; ++b)
#pragma unroll
                for (int m = 0; m < 4; ++m)
#pragma unroll
                    for (int n = 0; n < 2; ++n) acc[a][b][m][n] = (f32x4){0.f, 0.f, 0.f, 0.f};
        cur = nxt; cA = nA; cB = nB; ++ui;
    }
    PG8_WAIT_V(0);
    if (wr == 0) PG8_BAR;
    PG8_BAR;
#undef PG8_SA
#undef PG8_SB
#undef PG8_STAGE
#undef PG8_LDA
#undef PG8_LDB
#undef PG8_MMA
#undef PG8_WAIT_V
#undef PG8_WAIT_L
#undef PG8_BAR
#undef PG8_SCHED
}
}

enum { EPI_BF16 = 0, EPI_GLA_IN = 1, EPI_RESID = 2, EPI_UKV = 3, EPI_FFN_UP = 4 };
DI float dpp_ror1(float v) { return __int_as_float(__builtin_amdgcn_update_dpp(0, __float_as_int(v), 0x121, 0xf, 0xf, false)); }
DI float dpp_ror15(float v) { return __int_as_float(__builtin_amdgcn_update_dpp(0, __float_as_int(v), 0x12F, 0xf, 0xf, false)); }
struct Epi {
    struct Pre { float rsv[2][4]; f32x4 sw[2][2]; f32x2 wl0, wl1; };
    int ldc; LAS float* xch;
    void* q0; void* q1; void* q2; void* q3; void* q4; void* q5;
    static DI f32x4 ror1_4(f32x4 v) { float a, b, c, d;
        asm volatile("s_nop 1\n\tv_mov_b32_dpp %0, %4 row_ror:1 row_mask:0xf bank_mask:0xf\n\tv_mov_b32_dpp %1, %5 row_ror:1 row_mask:0xf bank_mask:0xf\n\tv_mov_b32_dpp %2, %6 row_ror:1 row_mask:0xf bank_mask:0xf\n\tv_mov_b32_dpp %3, %7 row_ror:1 row_mask:0xf bank_mask:0xf"
                     : "=&v"(a), "=&v"(b), "=&v"(c), "=&v"(d) : "v"(v[0]), "v"(v[1]), "v"(v[2]), "v"(v[3]));
        return (f32x4){a, b, c, d}; }
    static DI f32x2 ror1_2(f32x2 v) { float a, b;
        asm volatile("s_nop 1\n\tv_mov_b32_dpp %0, %2 row_ror:1 row_mask:0xf bank_mask:0xf\n\tv_mov_b32_dpp %1, %3 row_ror:1 row_mask:0xf bank_mask:0xf" : "=&v"(a), "=&v"(b) : "v"(v[0]), "v"(v[1]));
        return (f32x2){a, b}; }
    static DI f32x2 ror15_2(f32x2 v) { float a, b;
        asm volatile("s_nop 1\n\tv_mov_b32_dpp %0, %2 row_ror:15 row_mask:0xf bank_mask:0xf\n\tv_mov_b32_dpp %1, %3 row_ror:15 row_mask:0xf bank_mask:0xf" : "=&v"(a), "=&v"(b) : "v"(v[0]), "v"(v[1]));
        return (f32x2){a, b}; }
    static DI f32x4 ror15_4(f32x4 v) { float a, b, c, d;
        asm volatile("s_nop 1\n\tv_mov_b32_dpp %0, %4 row_ror:15 row_mask:0xf bank_mask:0xf\n\tv_mov_b32_dpp %1, %5 row_ror:15 row_mask:0xf bank_mask:0xf\n\tv_mov_b32_dpp %2, %6 row_ror:15 row_mask:0xf bank_mask:0xf\n\tv_mov_b32_dpp %3, %7 row_ror:15 row_mask:0xf bank_mask:0xf"
                     : "=&v"(a), "=&v"(b), "=&v"(c), "=&v"(d) : "v"(v[0]), "v"(v[1]), "v"(v[2]), "v"(v[3]));
        return (f32x4){a, b, c, d}; }
    DI void ffn_up(const f32x4 (&acc)[2][2][4][2], const pg8::Unit& u, int wr, int wc, int fr, int fq, int par) const {
        bf16_t* O = (bf16_t*)q0; float* halo = (float*)q3;
        const int cl = wc * 32 + 8 * fq;
        float rstd[2][4];
        { const LAS float* pw = xch + PREW_F + (wr * 4 + wc) * 192;
#pragma unroll
          for (int g = 0; g < 8; ++g) rstd[g >> 2][g & 3] = rsqrtf(pw[g * 16 + fr] * (1.0f / 1024.0f) + 1e-6f); }
        const LAS float* wbuf = xch + WIMG_F + par * 1280;
#define XW(ST, TB, BJ, V0, V1) do { LAS float* xp_ = xch + ((((ST) + 1) * 2 + (TB)) * 2 + (BJ)) * 128 + cl; *(LAS f32x4*)xp_ = (V0); *(LAS f32x4*)(xp_ + 4) = (V1); } while (0)
#define TR(AI, BJ, M, N) (acc[AI][BJ][M][N] * rstd[AI][M])
        if (fr == 0) { XW(wr, 0, 0, TR(0, 0, 0, 0), TR(0, 0, 0, 1)); XW(wr, 0, 1, TR(0, 1, 0, 0), TR(0, 1, 0, 1)); XW(2 + wr, 0, 0, TR(1, 0, 0, 0), TR(1, 0, 0, 1)); XW(2 + wr, 0, 1, TR(1, 1, 0, 0), TR(1, 1, 0, 1)); }
        if (fr == 15) { XW(wr, 1, 0, TR(0, 0, 3, 0), TR(0, 0, 3, 1)); XW(wr, 1, 1, TR(0, 1, 3, 0), TR(0, 1, 3, 1)); XW(2 + wr, 1, 0, TR(1, 0, 3, 0), TR(1, 0, 3, 1)); XW(2 + wr, 1, 1, TR(1, 1, 3, 0), TR(1, 1, 3, 1)); }
        { const f32x4 zz = (f32x4){0.f, 0.f, 0.f, 0.f}; if (fr == 0 && wr == 0) { XW(-1, 1, 0, zz, zz); XW(-1, 1, 1, zz, zz); } if (fr == 15 && wr == 1) { XW(4, 0, 0, zz, zz); XW(4, 0, 1, zz, zz); } }
#undef XW
        asm volatile("s_waitcnt lgkmcnt(0)" ::: "memory"); __builtin_amdgcn_s_barrier(); asm volatile("" ::: "memory"); __builtin_amdgcn_s_barrier(); asm volatile("" ::: "memory");
        {
            float* hp = halo + (size_t)(u.pm * 22 + u.pn) * 4 * 256 + cl;
            const f32x4 sa0 = *(const LAS f32x4*)(wbuf + 512 + cl), sa1 = *(const LAS f32x4*)(wbuf + 512 + cl + 4), sg0 = *(const LAS f32x4*)(wbuf + 640 + 512 + cl), sg1 = *(const LAS f32x4*)(wbuf + 640 + 512 + cl + 4);
            if (wr == 0 && fr < 2) { float* h2 = hp + fr * 256; *(f32x4*)h2 = TR(0, 0, 0, 0) + sa0; *(f32x4*)(h2 + 4) = TR(0, 0, 0, 1) + sa1; *(f32x4*)(h2 + 128) = TR(0, 1, 0, 0) + sg0; *(f32x4*)(h2 + 132) = TR(0, 1, 0, 1) + sg1; }
            if (wr == 1 && fr >= 14) { float* h2 = hp + (fr - 12) * 256; *(f32x4*)h2 = TR(1, 0, 3, 0) + sa0; *(f32x4*)(h2 + 4) = TR(1, 0, 3, 1) + sa1; *(f32x4*)(h2 + 128) = TR(1, 1, 3, 0) + sg0; *(f32x4*)(h2 + 132) = TR(1, 1, 3, 1) + sg1; }
        }
#undef TR
        asm volatile("" ::: "memory");
        const int rowt = u.pm * 256 + wr * 64 + fr;
        const bool f0 = fr == 0, f15 = fr == 15;
        f32x2 sg[2][4][4];
#define SILU2(v) (f32x2){silu_f(v[0]), silu_f(v[1])}
#define H2(V, HH) __builtin_shufflevector(V, V, 2 * (HH), 2 * (HH) + 1)
#define CONV_GROUP(BJ, Q, AI, OP) do { \
            const int st = 2 * (AI) + wr; \
            const f32x2 pb = *(const LAS f32x2*)(xch + (((st) * 2 + 1) * 2 + (BJ)) * 128 + cl + 2 * (Q)) + sw; \
            const f32x2 nb = *(const LAS f32x2*)(xch + (((st + 2) * 2 + 0) * 2 + (BJ)) * 128 + cl + 2 * (Q)) + sw; \
            const f32x2 c0 = H2(acc[AI][BJ][0][(Q) >> 1], (Q) & 1) * rstd[AI][0] + sw, c1 = H2(acc[AI][BJ][1][(Q) >> 1], (Q) & 1) * rstd[AI][1] + sw, \
                        c2 = H2(acc[AI][BJ][2][(Q) >> 1], (Q) & 1) * rstd[AI][2] + sw, c3 = H2(acc[AI][BJ][3][(Q) >> 1], (Q) & 1) * rstd[AI][3] + sw; \
            const f32x2 R0 = ror1_2(c0), L0 = ror15_2(c0), L1 = ror15_2(c1); \
            { const f32x2 v = w0 * (f0 ? pb : R0) + w1 * c0 + w2 * (f15 ? L1 : L0) + bb; OP(sg[AI][0][Q], v); } \
            __builtin_amdgcn_sched_barrier(0); \
            const f32x2 R1 = ror1_2(c1), L2 = ror15_2(c2); \
            { const f32x2 v = w0 * (f0 ? R0 : R1) + w1 * c1 + w2 * (f15 ? L2 : L1) + bb; OP(sg[AI][1][Q], v); } \
            __builtin_amdgcn_sched_barrier(0); \
            const f32x2 R2 = ror1_2(c2), L3 = ror15_2(c3); \
            { const f32x2 v = w0 * (f0 ? R1 : R2) + w1 * c2 + w2 * (f15 ? L3 : L2) + bb; OP(sg[AI][2][Q], v); } \
            __builtin_amdgcn_sched_barrier(0); \
            const f32x2 R3 = ror1_2(c3); \
            { const f32x2 v = w0 * (f0 ? R2 : R3) + w1 * c3 + w2 * (f15 ? nb : L3) + bb; OP(sg[AI][3][Q], v); } \
            __builtin_amdgcn_sched_barrier(0); } while (0)
#define OP_G(dst, v) dst = SILU2(v)
#define OP_A(dst, v) dst *= v
#define CONV_W(BJ, Q) const LAS float* wp_ = wbuf + (BJ) * 640 + cl + 2 * (Q); \
            const f32x2 w0 = *(const LAS f32x2*)wp_, w1 = *(const LAS f32x2*)(wp_ + 128), w2 = *(const LAS f32x2*)(wp_ + 256), bb = *(const LAS f32x2*)(wp_ + 384), sw = *(const LAS f32x2*)(wp_ + 512);
        { CONV_W(1, 0) CONV_GROUP(1, 0, 0, OP_G); CONV_GROUP(1, 0, 1, OP_G); }
        { CONV_W(1, 1) CONV_GROUP(1, 1, 0, OP_G); CONV_GROUP(1, 1, 1, OP_G); }
        { CONV_W(1, 2) CONV_GROUP(1, 2, 0, OP_G); CONV_GROUP(1, 2, 1, OP_G); }
        { CONV_W(1, 3) CONV_GROUP(1, 3, 0, OP_G); CONV_GROUP(1, 3, 1, OP_G); }
        { CONV_W(0, 0) CONV_GROUP(0, 0, 0, OP_A); CONV_GROUP(0, 0, 1, OP_A); }
        { CONV_W(0, 1) CONV_GROUP(0, 1, 0, OP_A); CONV_GROUP(0, 1, 1, OP_A); }
        { CONV_W(0, 2) CONV_GROUP(0, 2, 0, OP_A); CONV_GROUP(0, 2, 1, OP_A); }
        { CONV_W(0, 3) CONV_GROUP(0, 3, 0, OP_A); CONV_GROUP(0, 3, 1, OP_A); }
#undef CONV_W
#undef CONV_GROUP
#undef OP_G
#undef OP_A
#undef SILU2
#undef H2
#define ST16(AI, MM) do { u32x4 w_; w_.x = cvt_pk_bf16(sg[AI][MM][0][0], sg[AI][MM][0][1]); w_.y = cvt_pk_bf16(sg[AI][MM][1][0], sg[AI][MM][1][1]); w_.z = cvt_pk_bf16(sg[AI][MM][2][0], sg[AI][MM][2][1]); w_.w = cvt_pk_bf16(sg[AI][MM][3][0], sg[AI][MM][3][1]); \
            *(u32x4*)(O + (size_t)(rowt + (AI) * 128 + (MM) * 16) * 2816 + u.pn * 128 + cl) = w_; } while (0)
        ST16(0, 0); ST16(0, 1); ST16(0, 2); ST16(0, 3); ST16(1, 0); ST16(1, 1); ST16(1, 2); ST16(1, 3);
#undef ST16
    }
    template <int K> static constexpr bool perm_of() { return true; }
    template <int kind> DI void prefetch(Pre& P, const pg8::Unit& u, int wr, int wc, int fr, int fq, int par) const {
        (void)P;
        if constexpr (kind == EPI_GLA_IN || kind == EPI_BF16 || kind == EPI_FFN_UP) {
            const float* rsb = (const float*)(kind == EPI_FFN_UP ? q4 : q3);
            if (rsb) {
                LAS float* pw = xch + PREW_F + (wr * 4 + wc) * 192;
                const int bidx = u.pm < 256 ? (u.pm >> 4) : 16;
                if (fq == 0) {
                    const float* rsp = rsb + u.pm * 256 + wr * 64 + fr;
#pragma unroll
                    for (int g = 0; g < 8; ++g) __builtin_amdgcn_global_load_lds((const unsigned*)(rsp + (g >> 2) * 128 + (g & 3) * 16), (LAS unsigned*)(pw + g * 16), 4, 0, 0);
                    if constexpr (kind != EPI_FFN_UP) {
                        const float* sw = (const float*)q4 + (size_t)bidx * 5632 + u.pn * 256 + (fr >> 3) * 128 + wc * 32 + (fr & 7) * 4;
                        __builtin_amdgcn_global_load_lds((const unsigned*)sw, (LAS unsigned*)(pw + 128), 16, 0, 0);
                    }
                }
                if constexpr (kind == EPI_FFN_UP) {
                    const int wid = wr * 4 + wc;
                    if (wid < 5) {
                        const float* cw = (const float*)q1; const float* cb = (const float*)q2; const float* shw = (const float*)q5 + (size_t)bidx * 5632 + u.pn * 256;
                        const int i4 = (wid * 64 + fq * 16 + fr) * 4, bjw = i4 / 640, rem = i4 % 640, kw = rem >> 7, c_ = rem & 127;
                        const float* srcw = kw < 3 ? cw + kw * 5632 + bjw * 2816 + u.pn * 128 + c_ : kw == 3 ? cb + bjw * 2816 + u.pn * 128 + c_ : shw + bjw * 128 + c_;
                        __builtin_amdgcn_global_load_lds((const unsigned*)srcw, (LAS unsigned*)(xch + WIMG_F + par * 1280 + wid * 256), 16, 0, 0);
                    }
                }
            }
        }
    }
    template <int kind> DI void run(const f32x4 (&acc)[2][2][4][2], const Pre& P, const pg8::Unit& u, int wr, int wc, int fr, int fq, int par) const {
        asm volatile("" : "+v"(fr), "+v"(fq));
        if constexpr (kind == EPI_FFN_UP) { ffn_up(acc, u, wr, wc, fr, fq, par); return; }
        if constexpr (kind == EPI_RESID) {
            const float* base_l = (const float*)q0; const float* base_c = (const float*)q1; float* out_l = (float*)q2; unsigned char* wsb = (unsigned char*)q3; float* out_c = (float*)(wsb + WS_XC);
            const float* modl = (const float*)q4; const float* gnext = (const float*)q5;
            const int bidx = u.pm < 256 ? (u.pm >> 4) : 16;
            const float* gv = modl + (size_t)bidx * 6144 + (ldc ? 5 * 1024 : 2 * 1024);
            const float* bp = u.pm < 256 ? base_l + (size_t)u.pm * 256 * 1024 : base_c + (size_t)(u.pm - 256) * 256 * 1024;
            float* op = u.pm < 256 ? out_l + (size_t)u.pm * 256 * 1024 : out_c + (size_t)(u.pm - 256) * 256 * 1024;
            const int col0 = u.pn * 256 + wc * 32 + 8 * fq;
            f32x4 gt[2][2], gn[2][2];
#pragma unroll
            for (int bj = 0; bj < 2; ++bj)
#pragma unroll
                for (int n = 0; n < 2; ++n) gt[bj][n] = *(const f32x4*)(gv + col0 + bj * 128 + n * 4);
            if (gnext) {
                const float* scn = ldc ? modl + (size_t)(17 + bidx) * 6144 + 1024 : modl + (size_t)bidx * 6144 + 4 * 1024;
#pragma unroll
                for (int bj = 0; bj < 2; ++bj)
#pragma unroll
                    for (int n = 0; n < 2; ++n) gn[bj][n] = *(const f32x4*)(gnext + col0 + bj * 128 + n * 4) * (*(const f32x4*)(scn + col0 + bj * 128 + n * 4) + 1.0f);
            }
            bf16_t* xs = (bf16_t*)(wsb + (ldc ? WS_H : WS_XSA)) + (size_t)u.pm * 256 * 1024;
            float* rs = (float*)(wsb + WS_RS) + (ldc ? MR : 0) + u.pm * 256;
            f32x4 bsA[4], bsB[4];
#define RS_LOAD(K, DST) do { const size_t off_ = (size_t)(((K) >> 2) * 128 + wr * 64 + ((K) & 3) * 16 + fr) * 1024 + col0; \
                _Pragma("unroll") for (int q_ = 0; q_ < 4; ++q_) DST[q_] = *(const f32x4*)(bp + off_ + (q_ >> 1) * 128 + (q_ & 1) * 4); } while (0)
#define RS_DO(K, SRC) do { const int ai_ = (K) >> 2, m_ = (K) & 3; const int rl = ai_ * 128 + wr * 64 + m_ * 16 + fr; const size_t off = (size_t)rl * 1024 + col0; float ssq = 0.f; \
                _Pragma("unroll") for (int q_ = 0; q_ < 4; ++q_) { const int bj = q_ >> 1, n = q_ & 1; \
                    const f32x4 xn = SRC[q_] + gt[bj][n] * acc[ai_][bj][m_][n]; \
                    *(f32x4*)(op + off + bj * 128 + n * 4) = xn; \
                    if (gnext) { ssq += xn[0] * xn[0] + xn[1] * xn[1] + xn[2] * xn[2] + xn[3] * xn[3]; const f32x4 y = xn * gn[bj][n]; \
                        u32x2 w; w.x = cvt_pk_bf16(y[0], y[1]); w.y = cvt_pk_bf16(y[2], y[3]); *(u32x2*)(xs + off + bj * 128 + n * 4) = w; } } \
                if (gnext) { ssq += __shfl_xor(ssq, 16); ssq += __shfl_xor(ssq, 32); if (fq == 0) unsafeAtomicAdd(rs + rl, ssq); } } while (0)
            RS_LOAD(0, bsA);
            RS_LOAD(1, bsB); RS_DO(0, bsA);
            RS_LOAD(2, bsA); RS_DO(1, bsB);
            RS_LOAD(3, bsB); RS_DO(2, bsA);
            RS_LOAD(4, bsA); RS_DO(3, bsB);
            RS_LOAD(5, bsB); RS_DO(4, bsA);
            RS_LOAD(6, bsA); RS_DO(5, bsB);
            RS_LOAD(7, bsB); RS_DO(6, bsA);
            RS_DO(7, bsB);
#undef RS_LOAD
#undef RS_DO
            return;
        } else {
        bf16_t* O = (bf16_t*)q0; float* lr = (float*)q1; bf16_t* KB = (bf16_t*)q0; bf16_t* VB = (bf16_t*)q1;
        const int rowt = u.pm * 256 + wr * 64 + fr;
        f32x4 swv[2][2]; float rsv[2][4];
        if constexpr (kind == EPI_GLA_IN || kind == EPI_BF16) {
            if (q3) { const LAS float* pw = xch + PREW_F + (wr * 4 + wc) * 192;
#pragma unroll
                for (int g = 0; g < 8; ++g) rsv[g >> 2][g & 3] = pw[g * 16 + fr];
#pragma unroll
                for (int bj = 0; bj < 2; ++bj) { swv[bj][0] = *(const LAS f32x4*)(pw + 128 + bj * 32 + 8 * fq); swv[bj][1] = *(const LAS f32x4*)(pw + 128 + bj * 32 + 8 * fq + 4); } }
        }
#pragma unroll
        for (int ai = 0; ai < 2; ++ai)
#pragma unroll
            for (int m = 0; m < 4; ++m) {
                const int row = rowt + ai * 128 + m * 16;
#pragma unroll
                for (int bj = 0; bj < 2; ++bj) {
                    f32x4 v0 = acc[ai][bj][m][0], v1 = acc[ai][bj][m][1];
                    const int cin = bj * 128 + wc * 32 + 8 * fq;
                    if constexpr (kind == EPI_GLA_IN || kind == EPI_BF16) {
                        if (q3) {
                            const float rstd = rsqrtf(rsv[ai][m] * (1.0f / 1024.0f) + 1e-6f);
                            v0 = v0 * rstd + swv[bj][0]; v1 = v1 * rstd + swv[bj][1];
                        }
                    }
                    if constexpr (kind == EPI_GLA_IN) {
                        if (u.pn == 12) {
                            if (bj == 0 && wc == 0) { float* lp = lr + (size_t)row * 32 + 8 * fq; *(f32x4*)lp = v0; *(f32x4*)(lp + 4) = v1; }
                            continue;
                        }
                        if (u.pn < 2) { v0 *= 0.08838834764831845f; v1 *= 0.08838834764831845f; }
                    }
                    u32x4 w; w.x = cvt_pk_bf16(v0[0], v0[1]); w.y = cvt_pk_bf16(v0[2], v0[3]); w.z = cvt_pk_bf16(v1[0], v1[1]); w.w = cvt_pk_bf16(v1[2], v1[3]);
                    if constexpr (kind == EPI_GLA_IN) {
                        if (u.pn < 4) *(u32x4*)(O + (size_t)row * 1024 + u.pn * 256 + cin) = w;
                        else *(u32x4*)((bf16_t*)q2 + (size_t)row * 2048 + (u.pn - 4) * 256 + cin) = w;
                    } else if constexpr (kind == EPI_UKV) {
                        int key;
                        if (u.pm < 256) { const int b = u.pm >> 4; key = b * KEYS + CTXL + (row - b * SEQ); }
                        else { const int b = u.pm - 256; key = b * KEYS + (row - TL - b * CTXL); }
                        const int cc = wc * 32 + 8 * fq;
                        if (bj == 0) *(u32x4*)(KB + (size_t)key * 1536 + u.pn * 192 + cc) = w;
                        else *(u32x4*)(VB + (size_t)key * 1024 + u.pn * 128 + cc) = w;
                    } else {
                        *(u32x4*)(O + (size_t)row * ldc + u.pn * 256 + cin) = w;
                    }
                }
            }
        }
    }
};

DI void prep_phase(const Params& p, LAS unsigned char* lds) {
    const int tid = tid_opq();
    unsigned char* ws = (unsigned char*)p.in[opq(27)];
    LAS float* tl = (LAS float*)lds;
    const float* in_c = p.in[opq(1)]; const float* in_cctx = p.in[opq(3)]; const float* in_wada = p.in[opq(4)]; const float* in_bada = p.in[opq(5)];
    const float* in_gin = p.in[opq(8)]; const float* in_w1 = p.in[opq(9)]; const float* in_gout = p.in[opq(13)]; const float* in_mdown = p.in[opq(14)];
    const float* in_uq = p.in[opq(17)]; const float* in_ukv = p.in[opq(18)]; const float* in_mout = p.in[opq(21)]; const float* in_fup = p.in[opq(22)]; const float* in_fdown = p.in[opq(25)];
    constexpr int T0 = 1536, T2 = 512, T3 = 352, T4 = 288, T5 = 256, T6 = 512, T7 = 5632, T8 = 2816;
    constexpr int NTILE = T0 + T2 + T3 + T4 + T5 + T6 + T7 + T8;
    for (int t = blockIdx.x; t < NTILE; t += gridDim.x) {
        const float* src; int N, k0, n0, ld; bf16_t* dst;
        int q = t;
        if (q < T0) { const int j = q / 768, r = q % 768, kt = r / 48, nt = r % 48; src = in_gin + (size_t)j * 1024 * 3072; N = 3072; k0 = kt * 64; n0 = nt * 64;
            dst = (bf16_t*)(ws + WS_GIN + j * SZ_GIN) + (size_t)n0 * 1024 + k0; ld = 1024; }
        else if ((q -= T0) < T2) { const int j = q / 256, r = q % 256, kt = r / 16, nt = r % 16; src = in_gout + (size_t)j * 1024 * 1024; N = 1024; k0 = kt * 64; n0 = nt * 64;
            dst = (bf16_t*)(ws + WS_GOUT + j * SZ_SQ) + (size_t)n0 * 1024 + k0; ld = 1024; }
        else if ((q -= T2) < T3) { const int j = q / 176, r = q % 176, kt = r / 11, nt = r % 11; src = in_mdown + (size_t)j * 1024 * 704; N = 704; k0 = kt * 64; n0 = nt * 64;
            dst = (bf16_t*)(ws + WS_MDOWN + j * SZ_MDOWN) + (size_t)n0 * 1024 + k0; ld = 1024; }
        else if ((q -= T3) < T4) { const int j = q / 144, r = q % 144, kt = r / 24, nt = r % 24; src = in_uq + (size_t)j * 384 * 1536; N = 1536; k0 = kt * 64; n0 = nt * 64;
            dst = (bf16_t*)(ws + WS_MUQ + j * SZ_MUQ) + (size_t)n0 * 384 + k0; ld = 384; }
        else if ((q -= T4) < T5) { const int j = q / 128, r = q % 128, kt = r / 32, nt = r % 32; src = in_ukv + (size_t)j * 256 * 2048; N = 2048; k0 = kt * 64; n0 = nt * 64;
            dst = (bf16_t*)(ws + WS_MUKV + j * SZ_MUKV) + (size_t)n0 * 256 + k0; ld = 256; }
        else if ((q -= T5) < T6) { const int j = q / 256, r = q % 256, kt = r / 16, nt = r % 16; src = in_mout + (size_t)j * 1024 * 1024; N = 1024; k0 = kt * 64; n0 = nt * 64;
            dst = (bf16_t*)(ws + WS_MOUT + j * SZ_SQ) + (size_t)n0 * 1024 + k0; ld = 1024; }
        else if ((q -= T6) < T7) { const int i = q / 1408, r = q % 1408, kt = r / 88, nt = r % 88; src = in_fup + (size_t)i * 1024 * 5632; N = 5632; k0 = kt * 64; n0 = nt * 64;
            const int isg = n0 >= DFF ? 1 : 0, cc = n0 - isg * DFF, drow = (cc >> 7) * 256 + isg * 128 + (cc & 127);
            dst = (bf16_t*)(ws + WS_FUP + (size_t)i * SZ_FUP) + (size_t)drow * 1024 + k0; ld = 1024; }
        else { q -= T7; const int i = q / 704, r = q % 704, kt = r / 16, nt = r % 16; src = in_fdown + (size_t)i * 2816 * 1024; N = 1024; k0 = kt * 64; n0 = nt * 64;
            dst = (bf16_t*)(ws + WS_FDOWN + (size_t)i * SZ_FDOWN) + (size_t)n0 * 2816 + k0; ld = 2816; }
#pragma unroll
        for (int i = 0; i < 8; ++i) { const int r = (tid >> 6) + 8 * i, c = tid & 63; tl[c * 65 + r] = src[(size_t)(k0 + r) * N + n0 + c]; }
        __syncthreads();
#pragma unroll
        for (int i = 0; i < 4; ++i) { const int rr = (tid >> 5) + 16 * i, c2 = (tid & 31) * 2; const float a = tl[rr * 65 + c2], b = tl[rr * 65 + c2 + 1];
            *(unsigned*)(dst + (size_t)rr * ld + c2) = cvt_pk_bf16(a, b); }
        __syncthreads();
    }
    const int gtid = blockIdx.x * NTHREADS + tid, gstride = gridDim.x * NTHREADS;
    for (int idx = gtid; idx < 65536; idx += gstride) {
        const int k = idx & 1023, r = (idx >> 10) & 15, dir = (idx >> 14) & 1, j = idx >> 15;
        const float v = in_w1[((size_t)(j * 2 + dir) * 1024 + k) * 16 + r];
        ((bf16_t*)(ws + WS_GIN + j * SZ_GIN))[(size_t)(3072 + dir * 16 + r) * 1024 + k] = f2bf(v);
    }
    for (int idx = gtid; idx < 2 * 114688; idx += gstride) { const int j = idx / 114688, o = idx % 114688; ((unsigned*)(ws + WS_GIN + j * SZ_GIN + 3104ull * 1024 * 2))[o] = 0u; }
    for (int idx = gtid; idx < 2 * 32768; idx += gstride) { const int j = idx / 32768, o = idx % 32768; ((unsigned*)(ws + WS_MDOWN + j * SZ_MDOWN + 704ull * 1024 * 2))[o] = 0u; }
    for (int idx = gtid; idx < MR; idx += gstride) ((float*)(ws + WS_RS))[idx] = 0.f;
    LAS float* sl = (LAS float*)lds;
    LAS float* red = (LAS float*)(lds + 81920);
    __syncthreads();
    for (int idx = tid; idx < 17 * 1024; idx += NTHREADS) { const int r = idx >> 10, k = idx & 1023; const float v = r < 16 ? in_c[r * 1024 + k] : in_cctx[k]; sl[k * 20 + r] = v / (1.0f + __expf(-v)); }
    __syncthreads();
    float* mod = (float*)(ws + WS_MOD);
    for (int it = blockIdx.x; it < 384; it += gridDim.x) {
        const int layer = it / 96, n0 = (it % 96) * 64, nn = tid & 63, ks = tid >> 6;
        const float* W = in_wada + (size_t)layer * 1024 * 6144 + n0 + nn;
        float acc[17];
#pragma unroll
        for (int r = 0; r < 17; ++r) acc[r] = 0.f;
        for (int kk = 0; kk < 128; ++kk) {
            const int k = ks * 128 + kk; const float w = W[(size_t)k * 6144];
            const f32x4 s0 = *(const LAS f32x4*)(sl + k * 20), s1 = *(const LAS f32x4*)(sl + k * 20 + 4), s2 = *(const LAS f32x4*)(sl + k * 20 + 8), s3 = *(const LAS f32x4*)(sl + k * 20 + 12);
            const float s16 = sl[k * 20 + 16];
#pragma unroll
            for (int j = 0; j < 4; ++j) { acc[j] += s0[j] * w; acc[4 + j] += s1[j] * w; acc[8 + j] += s2[j] * w; acc[12 + j] += s3[j] * w; }
            acc[16] += s16 * w;
        }
#pragma unroll
        for (int r = 0; r < 17; ++r) red[(ks * 17 + r) * 64 + nn] = acc[r];
        __syncthreads();
        for (int o = tid; o < 17 * 64; o += NTHREADS) { const int r = o >> 6, c = o & 63; float s = in_bada[layer * 6144 + n0 + c];
#pragma unroll
            for (int k8 = 0; k8 < 8; ++k8) s += red[(k8 * 17 + r) * 64 + c];
            mod[(size_t)(layer * 17 + r) * 6144 + n0 + c] = s; }
        __syncthreads();
    }
}

DI void shw_phase(unsigned char* ws, LAS unsigned char* lds) {
    const int tid = tid_opq(), wave = tid >> 6, lane = tid & 63;
    LAS float* sl = (LAS float*)lds;
    const float* mod = (const float*)(ws + WS_MOD);
    constexpr int NCH = 4 * 44 + 6 + 26 + 6;
    for (int ch = blockIdx.x; ch < NCH; ch += gridDim.x) {
        int layer, kind, n0; const bf16_t* Bt;
        if (ch < 176) { layer = ch / 44; kind = 1; n0 = (ch % 44) * 128; Bt = (const bf16_t*)(ws + WS_FUP + (size_t)layer * SZ_FUP); }
        else if (ch < 182) { layer = 1; kind = 0; n0 = (ch - 176) * 128; Bt = (const bf16_t*)(ws + WS_MDOWN); }
        else if (ch < 208) { layer = 2; kind = 0; n0 = (ch - 182) * 128; Bt = (const bf16_t*)(ws + WS_GIN + SZ_GIN); }
        else { layer = 3; kind = 0; n0 = (ch - 208) * 128; Bt = (const bf16_t*)(ws + WS_MDOWN + SZ_MDOWN); }
        __syncthreads();
        for (int idx = tid; idx < 17 * 256; idx += NTHREADS) { const int b = idx >> 8, k4 = (idx & 255) * 4;
            *(LAS f32x4*)(sl + b * 1024 + k4) = *(const f32x4*)(mod + (size_t)(layer * 17 + b) * 6144 + (kind ? 3 * 1024 : 0) + k4); }
        __syncthreads();
        float* out = (float*)(ws + WS_SHW) + (size_t)((layer * 2 + kind) * 17) * 5632;
#pragma unroll 1
        for (int i = 0; i < 16; ++i) {
            const int n = n0 + wave * 16 + i;
            float w[16];
#pragma unroll
            for (int j = 0; j < 4; ++j) { const u32x2 t = *(const u32x2*)(Bt + (size_t)n * 1024 + j * 256 + lane * 4); w[4 * j] = bf_lo(t.x); w[4 * j + 1] = bf_hi(t.x); w[4 * j + 2] = bf_lo(t.y); w[4 * j + 3] = bf_hi(t.y); }
            float mine = 0.f;
#pragma unroll 1
            for (int b = 0; b < 17; ++b) {
                float a = 0.f;
#pragma unroll
                for (int j = 0; j < 4; ++j) { const f32x4 sv = *(const LAS f32x4*)(sl + b * 1024 + j * 256 + lane * 4); a += sv[0] * w[4 * j] + sv[1] * w[4 * j + 1] + sv[2] * w[4 * j + 2] + sv[3] * w[4 * j + 3]; }
                a = wave_sum(a);
                if (lane == b) mine = a;
            }
            if (lane < 17) out[(size_t)lane * 5632 + n] = mine;
        }
    }
    __syncthreads();
}

DI void norm_phase(const float* xl, const float* xc, const float* gain, const float* modl, int sh_off, int sc_off, bf16_t* h) {
    const int tid = tid_opq(), wave = tid >> 6, lane = tid & 63;
    for (int row0 = (blockIdx.x * 8 + wave) * 4; row0 < MR; row0 += gridDim.x * 32) {
        const float* src = row0 < TL ? xl + (size_t)row0 * 1024 : xc + (size_t)(row0 - TL) * 1024;
        const float* mb = modl + (size_t)(row0 < TL ? (row0 >> 12) : 16) * 6144;
        f32x4 v[4][4]; float ss[4];
#pragma unroll
        for (int r = 0; r < 4; ++r)
#pragma unroll
            for (int i = 0; i < 4; ++i) v[r][i] = *(const f32x4*)(src + (size_t)r * 1024 + i * 256 + lane * 4);
#pragma unroll
        for (int r = 0; r < 4; ++r) { float t = 0.f;
#pragma unroll
            for (int i = 0; i < 4; ++i) t += v[r][i][0] * v[r][i][0] + v[r][i][1] * v[r][i][1] + v[r][i][2] * v[r][i][2] + v[r][i][3] * v[r][i][3];
            ss[r] = t; }
#pragma unroll
        for (int o = 32; o >= 1; o >>= 1) {
#pragma unroll
            for (int r = 0; r < 4; ++r) ss[r] += __shfl_xor(ss[r], o);
        }
#pragma unroll
        for (int i = 0; i < 4; ++i) {
            const int c = i * 256 + lane * 4;
            const f32x4 g = *(const f32x4*)(gain + c), sc = *(const f32x4*)(mb + sc_off + c), sh = *(const f32x4*)(mb + sh_off + c);
            const f32x4 gs = g * (sc + 1.0f);
#pragma unroll
            for (int r = 0; r < 4; ++r) {
                const float rstd = rsqrtf(ss[r] * (1.0f / 1024.0f) + 1e-6f);
                const f32x4 y = (v[r][i] * rstd) * gs + sh;
                u32x2 w; w.x = cvt_pk_bf16(y[0], y[1]); w.y = cvt_pk_bf16(y[2], y[3]);
                *(u32x2*)(h + (size_t)(row0 + r) * 1024 + c) = w;
            }
        }
    }
}

DI void scan_rowbase(int dir, int b, int c, int& rb, int& sg) {
    if (dir == 0) { sg = 1; rb = c < 4 ? TL + b * CTXL + c * 64 : b * SEQ + (c - 4) * 64; }
    else { sg = -1; rb = c < 4 ? TL + b * CTXL + 255 - c * 64 : b * SEQ + 4095 - (c - 4) * 64; }
}
struct GPStage { unsigned qv[8], kv[8]; f32x4 lrv; float w2r[16][2]; f32x2 gbias; };
DI void gp_load(GPStage& S, int item, const bf16_t* qk, const float* lr, const float* w2, const float* gb, int tid, int wave, int d0) {
    const int c = item % 68, rest = item / 68, h = rest & 3, dir = (rest >> 2) & 1, b = rest >> 3;
    int rowbase, sgn; scan_rowbase(dir, b, c, rowbase, sgn);
#pragma unroll
    for (int i = 0; i < 8; ++i) { const size_t ro = (size_t)(rowbase + sgn * (wave * 8 + i)) * 1024; S.qv[i] = *(const unsigned*)(qk + ro + h * 128 + d0); S.kv[i] = *(const unsigned*)(qk + ro + 512 + h * 128 + d0); }
    S.lrv = (f32x4){0.f, 0.f, 0.f, 0.f};
    if (tid < 256) S.lrv = *(const f32x4*)(lr + (size_t)(rowbase + sgn * (tid >> 2)) * 32 + dir * 16 + (tid & 3) * 4);
#pragma unroll
    for (int r = 0; r < 16; ++r) { const f32x2 t = *(const f32x2*)(w2 + (size_t)(dir * 16 + r) * 512 + h * 128 + d0); S.w2r[r][0] = t.x; S.w2r[r][1] = t.y; }
    S.gbias = *(const f32x2*)(gb + dir * 512 + h * 128 + d0);
}
DI void gp_item(const GPStage& S, int item, bf16_t* GQ, bf16_t* GK, bf16_t* GP, float* GE, LAS unsigned char* lds, int tid, int wave, int lane) {
    constexpr int QD = 0, KI = 17408, LRS = 34816, SEG = 38912;
    const int l15 = lane & 15, lq = lane >> 4, d0 = 2 * lane;
    if (tid < 256) *(LAS f32x4*)(lds + LRS + (tid >> 2) * 64 + (tid & 3) * 16) = S.lrv;
    __syncthreads();
    const LAS float* lrs = (const LAS float*)(lds + LRS);
    float bl0[8], bl1[8]; float cum0 = 0.f, cum1 = 0.f;
#pragma unroll
    for (int i = 0; i < 8; ++i) {
        const int s = wave * 8 + i;
        float z0 = S.gbias.x, z1 = S.gbias.y;
#pragma unroll
        for (int r4 = 0; r4 < 4; ++r4) { const f32x4 lv = *(const LAS f32x4*)(lrs + s * 16 + r4 * 4);
#pragma unroll
            for (int j = 0; j < 4; ++j) { z0 += lv[j] * S.w2r[r4 * 4 + j][0]; z1 += lv[j] * S.w2r[r4 * 4 + j][1]; } }
        const float g0 = (fminf(z0, 0.f) - __logf(1.0f + __expf(-fabsf(z0)))) * 0.0625f;
        const float g1 = (fminf(z1, 0.f) - __logf(1.0f + __expf(-fabsf(z1)))) * 0.0625f;
        cum0 += g0; cum1 += g1; bl0[i] = cum0; bl1[i] = cum1;
    }
    *(LAS f32x2*)(lds + SEG + (wave * 128 + d0) * 4) = (f32x2){cum0, cum1};
    __syncthreads();
    float off0 = 0.f, off1 = 0.f, tot0 = 0.f, tot1 = 0.f;
#pragma unroll
    for (int w = 0; w < 8; ++w) { const f32x2 t = *(const LAS f32x2*)(lds + SEG + (w * 128 + d0) * 4); tot0 += t.x; tot1 += t.y; if (w < wave) { off0 += t.x; off1 += t.y; } }
    const float et0 = __expf(tot0), et1 = __expf(tot1);
    if (wave == 0) *(f32x2*)(GE + (size_t)item * 128 + d0) = (f32x2){et0, et1};
    {
        unsigned ks0[4], ks1[4];
        bf16_t* gq = GQ + (size_t)item * 8192;
#pragma unroll
        for (int i = 0; i < 8; ++i) {
            const int s = wave * 8 + i;
            const float b0 = off0 + bl0[i], b1 = off1 + bl1[i];
            const float q0 = bf_lo(S.qv[i]), q1 = bf_hi(S.qv[i]), k0 = bf_lo(S.kv[i]), k1 = bf_hi(S.kv[i]);
            const float eb0 = __expf(b0), eb1 = __expf(b1), ib0 = __builtin_amdgcn_rcpf(eb0), ib1 = __builtin_amdgcn_rcpf(eb1);
            const unsigned qd = cvt_pk_bf16(q0 * eb0, q1 * eb1);
            *(LAS unsigned*)(lds + QD + s * 272 + d0 * 2) = qd;
            *(unsigned*)(gq + s * 128 + d0) = qd;
            *(LAS unsigned*)(lds + KI + s * 272 + d0 * 2) = cvt_pk_bf16(k0 * ib0, k1 * ib1);
            const float e0 = k0 * (et0 * ib0), e1 = k1 * (et1 * ib1);
            if (i & 1) { ks0[i >> 1] = (ks0[i >> 1] & 0xffffu) | (cvt_pk_bf16(0.f, e0) & 0xffff0000u); ks1[i >> 1] = (ks1[i >> 1] & 0xffffu) | (cvt_pk_bf16(0.f, e1) & 0xffff0000u); }
            else { ks0[i >> 1] = cvt_pk_bf16(e0, 0.f) & 0xffffu; ks1[i >> 1] = cvt_pk_bf16(e1, 0.f) & 0xffffu; }
        }
        bf16_t* gk = GK + (size_t)item * 8192;
        *(u32x4*)(gk + d0 * 64 + wave * 8) = (u32x4){ks0[0], ks0[1], ks0[2], ks0[3]};
        *(u32x4*)(gk + (d0 + 1) * 64 + wave * 8) = (u32x4){ks1[0], ks1[1], ks1[2], ks1[3]};
    }
    __syncthreads();
    {
        bf16_t* gp = GP + (size_t)item * 4096;
        const int t0 = 16 * (wave >> 1);
#pragma unroll
        for (int j = 0; j < 2; ++j) {
            const int s0 = 16 * ((wave & 1) * 2 + j);
            f32x4 a4 = (f32x4){0.f, 0.f, 0.f, 0.f};
#pragma unroll
            for (int kk = 0; kk < 4; ++kk) {
                const bf16x8 af = *(const LAS bf16x8*)(lds + QD + (t0 + l15) * 272 + (kk * 32 + 8 * lq) * 2);
                const bf16x8 bf = *(const LAS bf16x8*)(lds + KI + (s0 + l15) * 272 + (kk * 32 + 8 * lq) * 2);
                a4 = __builtin_amdgcn_mfma_f32_16x16x32_bf16(af, bf, a4, 0, 0, 0);
            }
            const int sc = s0 + l15;
#pragma unroll
            for (int r = 0; r < 4; ++r) { const int t = t0 + 4 * lq + r; gp[t * 64 + sc] = f2bf(sc <= t ? a4[r] : 0.f); }
        }
    }
}
DI void gateprep_phase(const bf16_t* qk, const float* lr, const float* w2, const float* gb, bf16_t* GQ, bf16_t* GK, bf16_t* GP, float* GE, LAS unsigned char* lds) {
    const int tid = tid_opq(), wave = __builtin_amdgcn_readfirstlane(tid >> 6), lane = tid & 63, d0 = 2 * lane;
    const int G = gridDim.x;
    GPStage A, B;
    int item = opq((int)blockIdx.x);
    if (item < NCHI) gp_load(A, item, qk, lr, w2, gb, tid, wave, d0);
    for (; item < NCHI; item += 2 * G) {
        if (item + G < NCHI) gp_load(B, item + G, qk, lr, w2, gb, tid, wave, d0);
        gp_item(A, item, GQ, GK, GP, GE, lds, tid, wave, lane);
        if (item + G < NCHI) {
            if (item + 2 * G < NCHI) gp_load(A, item + 2 * G, qk, lr, w2, gb, tid, wave, d0);
            gp_item(B, item + G, GQ, GK, GP, GE, lds, tid, wave, lane);
        }
    }
    __syncthreads();
}

DI void scan_phase(const bf16_t* vr, const bf16_t* GQ, const bf16_t* GK, const bf16_t* GP, const float* GE, bf16_t* of, bf16_t* ob, LAS unsigned char* lds) {
    constexpr int QD = 0, KST = 17408, VT = 35840, ST = 54272, PP = 89088, BL = 98304;
    const int tid = tid_opq(), wave = __builtin_amdgcn_readfirstlane(tid >> 6), lane = tid & 63;
    const int l31 = lane & 31, lh = lane >> 5;
    for (int item = blockIdx.x; item < 256; item += gridDim.x) {
        const int b = item >> 4, dir = (item >> 3) & 1, h = (item >> 1) & 3, dvh = item & 1;
        bf16_t* obuf = dir ? ob : of;
        const int d0 = 2 * lane;
        const int gi0 = ((b * 2 + dir) * 4 + h) * 68;
        f32x16 Sacc[2];
#pragma unroll
        for (int i = 0; i < 16; ++i) { Sacc[0][i] = 0.f; Sacc[1][i] = 0.f; }
        __syncthreads();
        { unsigned z_ = 0u; asm volatile("" : "+v"(z_));
          for (int o = tid; o < 34816 / 16; o += NTHREADS) *(LAS u32x4*)(lds + ST + o * 16) = (u32x4){z_, z_, z_, z_}; }
        const int vcol = h * 256 + dvh * 128 + d0;
        struct ScStage { u32x4 gq0, gq1, gk0, gk1, gp0; unsigned vv[8]; float ebv; } A, B;
        A.ebv = 0.f; B.ebv = 0.f;
#define SCAN_LOAD(S, c) do { int rb_, sg_; scan_rowbase(dir, b, (c), rb_, sg_); const size_t gi_ = (size_t)(gi0 + (c)); \
        S.gq0 = *(const u32x4*)(GQ + gi_ * 8192 + tid * 8); S.gq1 = *(const u32x4*)(GQ + gi_ * 8192 + 4096 + tid * 8); \
        S.gk0 = *(const u32x4*)(GK + gi_ * 8192 + tid * 8); S.gk1 = *(const u32x4*)(GK + gi_ * 8192 + 4096 + tid * 8); \
        S.gp0 = *(const u32x4*)(GP + gi_ * 4096 + tid * 8); if (tid < 128) S.ebv = GE[gi_ * 128 + tid]; \
        _Pragma("unroll") for (int i = 0; i < 8; ++i) S.vv[i] = *(const unsigned*)(vr + (size_t)(rb_ + sg_ * (wave * 8 + i)) * 2048 + vcol); } while (0)
#define SCAN_CHUNK(S, c) do { \
            int rowbase, sgn; scan_rowbase(dir, b, (c), rowbase, sgn); \
            { const int e0 = tid * 8, e1 = 4096 + tid * 8; \
              *(LAS u32x4*)(lds + QD + (e0 >> 7) * 272 + (e0 & 127) * 2) = S.gq0; *(LAS u32x4*)(lds + QD + (e1 >> 7) * 272 + (e1 & 127) * 2) = S.gq1; \
              *(LAS u32x4*)(lds + KST + (e0 >> 6) * 144 + (e0 & 63) * 2) = S.gk0; *(LAS u32x4*)(lds + KST + (e1 >> 6) * 144 + (e1 & 63) * 2) = S.gk1; \
              *(LAS u32x4*)(lds + PP + (e0 >> 6) * 144 + (e0 & 63) * 2) = S.gp0; \
              if (tid < 128) *(LAS float*)(lds + BL + tid * 4) = S.ebv; \
              unsigned vt0[4], vt1[4]; \
              _Pragma("unroll") for (int i = 0; i < 8; ++i) { \
                  if (i & 1) { vt0[i >> 1] = (vt0[i >> 1] & 0xffffu) | (S.vv[i] << 16); vt1[i >> 1] = (vt1[i >> 1] & 0xffffu) | (S.vv[i] & 0xffff0000u); } \
                  else { vt0[i >> 1] = S.vv[i] & 0xffffu; vt1[i >> 1] = S.vv[i] >> 16; } } \
              *(LAS u32x4*)(lds + VT + d0 * 144 + wave * 16) = (u32x4){vt0[0], vt0[1], vt0[2], vt0[3]}; \
              *(LAS u32x4*)(lds + VT + (d0 + 1) * 144 + wave * 16) = (u32x4){vt1[0], vt1[1], vt1[2], vt1[3]}; \
            } \
            __syncthreads();     \
            if ((c) + 2 < 68) SCAN_LOAD(S, (c) + 2); \
            { \
                const int tq = wave >> 2, vq = wave & 3; \
                f32x16 oacc; \
                _Pragma("unroll") for (int i = 0; i < 16; ++i) oacc[i] = 0.f; \
                _Pragma("unroll") for (int kk = 0; kk < 8; ++kk) { \
                    const bf16x8 af = *(const LAS bf16x8*)(lds + QD + (32 * tq + l31) * 272 + (kk * 16 + 8 * lh) * 2); \
                    const bf16x8 bf = *(const LAS bf16x8*)(lds + ST + (32 * vq + l31) * 272 + (kk * 16 + 8 * lh) * 2); \
                    oacc = __builtin_amdgcn_mfma_f32_32x32x16_bf16(af, bf, oacc, 0, 0, 0); } \
                _Pragma("unroll") for (int kk = 0; kk < 4; ++kk) { \
                    const bf16x8 af = *(const LAS bf16x8*)(lds + PP + (32 * tq + l31) * 144 + (kk * 16 + 8 * lh) * 2); \
                    const bf16x8 bf = *(const LAS bf16x8*)(lds + VT + (32 * vq + l31) * 144 + (kk * 16 + 8 * lh) * 2); \
                    oacc = __builtin_amdgcn_mfma_f32_32x32x16_bf16(af, bf, oacc, 0, 0, 0); } \
                const int ocol = h * 256 + dvh * 128 + 32 * vq + l31; \
                _Pragma("unroll") for (int r = 0; r < 16; ++r) { const int t = 32 * tq + crow(r, lh); obuf[(size_t)(rowbase + sgn * t) * 1024 + ocol] = f2bf(oacc[r]); } \
            } \
            { \
                const int vq = wave & 3; \
                _Pragma("unroll") for (int j = 0; j < 2; ++j) { \
                    const int dq = 2 * (wave >> 2) + j; \
                    _Pragma("unroll") for (int r = 0; r < 16; ++r) Sacc[j][r] *= *(const LAS float*)(lds + BL + (32 * dq + crow(r, lh)) * 4); \
                    _Pragma("unroll") for (int kk = 0; kk < 4; ++kk) { \
                        const bf16x8 af = *(const LAS bf16x8*)(lds + KST + (32 * dq + l31) * 144 + (kk * 16 + 8 * lh) * 2); \
                        const bf16x8 bf = *(const LAS bf16x8*)(lds + VT + (32 * vq + l31) * 144 + (kk * 16 + 8 * lh) * 2); \
                        Sacc[j] = __builtin_amdgcn_mfma_f32_32x32x16_bf16(af, bf, Sacc[j], 0, 0, 0); } } \
            } \
            __syncthreads();     \
            { \
                const int vq = wave & 3; \
                _Pragma("unroll") for (int j = 0; j < 2; ++j) { \
                    const int dq = 2 * (wave >> 2) + j; \
                    _Pragma("unroll") for (int g = 0; g < 4; ++g) { \
                        u32x2 w; w.x = cvt_pk_bf16(Sacc[j][4 * g], Sacc[j][4 * g + 1]); w.y = cvt_pk_bf16(Sacc[j][4 * g + 2], Sacc[j][4 * g + 3]); \
                        *(LAS u32x2*)(lds + ST + (32 * vq + l31) * 272 + (32 * dq + 8 * g + 4 * lh) * 2) = w; } } \
            } } while (0)
        SCAN_LOAD(A, 0); SCAN_LOAD(B, 1);
        for (int c = 0; c < 68; c += 2) { SCAN_CHUNK(A, c); SCAN_CHUNK(B, c + 1); }
#undef SCAN_CHUNK
#undef SCAN_LOAD
    }
    __syncthreads();
}

DI void glapost_phase(const bf16_t* of, const bf16_t* ob, const bf16_t* vr, const float* onorm, bf16_t* a) {
    const int tid = tid_opq(), wave = tid >> 6, lane = tid & 63;
    const int c0 = lane * 16;
    float gn[16];
#pragma unroll
    for (int j = 0; j < 4; ++j) { const f32x4 t = *(const f32x4*)(onorm + (c0 & 255) + 4 * j); gn[4 * j] = t[0]; gn[4 * j + 1] = t[1]; gn[4 * j + 2] = t[2]; gn[4 * j + 3] = t[3]; }
    for (int row0 = (blockIdx.x * 8 + wave) * 4; row0 < MR; row0 += gridDim.x * 32) {
        u32x4 f0[4], f1[4], b0[4], b1[4], r0[4], r1[4];
#pragma unroll
        for (int q = 0; q < 4; ++q) { const size_t ro = (size_t)(row0 + q);
            f0[q] = *(const u32x4*)(of + ro * 1024 + c0); f1[q] = *(const u32x4*)(of + ro * 1024 + c0 + 8);
            b0[q] = *(const u32x4*)(ob + ro * 1024 + c0); b1[q] = *(const u32x4*)(ob + ro * 1024 + c0 + 8);
            r0[q] = *(const u32x4*)(vr + ro * 2048 + 1024 + c0); r1[q] = *(const u32x4*)(vr + ro * 2048 + 1024 + c0 + 8); }
        asm volatile("" ::: "memory");
#pragma unroll
        for (int q = 0; q < 4; ++q) {
            float o[16], rr[16];
#pragma unroll
            for (int j = 0; j < 4; ++j) {
                o[2 * j] = bf_lo(f0[q][j]) + bf_lo(b0[q][j]); o[2 * j + 1] = bf_hi(f0[q][j]) + bf_hi(b0[q][j]);
                o[8 + 2 * j] = bf_lo(f1[q][j]) + bf_lo(b1[q][j]); o[8 + 2 * j + 1] = bf_hi(f1[q][j]) + bf_hi(b1[q][j]);
                rr[2 * j] = bf_lo(r0[q][j]); rr[2 * j + 1] = bf_hi(r0[q][j]); rr[8 + 2 * j] = bf_lo(r1[q][j]); rr[8 + 2 * j + 1] = bf_hi(r1[q][j]);
            }
            float ss = 0.f;
#pragma unroll
            for (int j = 0; j < 16; ++j) ss += o[j] * o[j];
            ss += __shfl_xor(ss, 1); ss += __shfl_xor(ss, 2); ss += __shfl_xor(ss, 4); ss += __shfl_xor(ss, 8);
            const float rstd = rsqrtf(ss * (1.0f / 256.0f) + 1e-6f);
            unsigned w[8];
#pragma unroll
            for (int j = 0; j < 8; ++j) {
                const float y0 = o[2 * j] * rstd * gn[2 * j] * silu_f(rr[2 * j]), y1 = o[2 * j + 1] * rstd * gn[2 * j + 1] * silu_f(rr[2 * j + 1]);
                w[j] = cvt_pk_bf16(y0, y1);
            }
            *(u32x4*)(a + (size_t)(row0 + q) * 1024 + c0) = (u32x4){w[0], w[1], w[2], w[3]};
            *(u32x4*)(a + (size_t)(row0 + q) * 1024 + c0 + 8) = (u32x4){w[4], w[5], w[6], w[7]};
        }
    }
}

DI void rope_cs(int tpos, int lane, float& cs, float& sn) {
    const int f = lane & 15; const int pos = (lane >> 5) ? (tpos & 63) : (tpos >> 6);
    const float inv = exp2f(-(float)f * (13.287712379549449f / 16.0f));
    const float ang = (float)pos * inv;
    const float kf = rintf(ang * 0.15915494309189535f);
    float r = fmaf(-kf, 6.2831854820251465f, ang); r = fmaf(-kf, -1.7484556000744883e-7f, r);
    cs = __cosf(r); sn = __sinf(r);
}
DI float rope_apply(float y, int lane, float cs, float sn) {
    const float pr = __shfl_xor(y, 16);
    return (lane & 16) ? (pr * sn + y * cs) : (y * cs - pr * sn);
}
DI int key_of_row(int row) {
    if (row < TL) { const int b = row >> 12; return b * KEYS + CTXL + (row & 4095); }
    const int rc = row - TL; const int b = rc >> 8; return b * KEYS + (rc & 255);
}

DI void mlamid_phase(const bf16_t* dn, const float* qln, const float* kvln, const float* knorm, bf16_t* cqn, bf16_t* ckvn, bf16_t* KB) {
    const int tid = tid_opq(), wave = tid >> 6, lane = tid & 63;
    float gq[6];
#pragma unroll
    for (int i = 0; i < 3; ++i) { gq[2 * i] = qln[i * 128 + 2 * lane]; gq[2 * i + 1] = qln[i * 128 + 2 * lane + 1]; }
    const f32x4 gkv = *(const f32x4*)(kvln + 4 * lane);
    const float gpe = knorm[128 + lane];
    for (int row0 = (blockIdx.x * 8 + wave) * 4; row0 < MR; row0 += gridDim.x * 32) {
        unsigned q[4][3]; u32x2 kvv[4]; bf16_t pe[4];
#pragma unroll
        for (int r = 0; r < 4; ++r) { const bf16_t* src = dn + (size_t)(row0 + r) * 768;
#pragma unroll
            for (int i = 0; i < 3; ++i) q[r][i] = *(const unsigned*)(src + i * 128 + 2 * lane);
            kvv[r] = *(const u32x2*)(src + 384 + 4 * lane); pe[r] = src[640 + lane]; }
#pragma unroll
        for (int r = 0; r < 4; ++r) {
            const int row = row0 + r;
            float ss = 0.f;
#pragma unroll
            for (int i = 0; i < 3; ++i) { const float a = bf_lo(q[r][i]), b = bf_hi(q[r][i]); ss += a * a + b * b; }
            ss = wave_sum(ss);
            float rstd = rsqrtf(ss * (1.0f / 384.0f) + 1e-6f);
#pragma unroll
            for (int i = 0; i < 3; ++i) *(unsigned*)(cqn + (size_t)row * 384 + i * 128 + 2 * lane) = cvt_pk_bf16(bf_lo(q[r][i]) * rstd * gq[2 * i], bf_hi(q[r][i]) * rstd * gq[2 * i + 1]);
            const float k0 = bf_lo(kvv[r].x), k1 = bf_hi(kvv[r].x), k2 = bf_lo(kvv[r].y), k3 = bf_hi(kvv[r].y);
            ss = wave_sum(k0 * k0 + k1 * k1 + k2 * k2 + k3 * k3);
            rstd = rsqrtf(ss * (1.0f / 256.0f) + 1e-6f);
            { u32x2 w; w.x = cvt_pk_bf16(k0 * rstd * gkv[0], k1 * rstd * gkv[1]); w.y = cvt_pk_bf16(k2 * rstd * gkv[2], k3 * rstd * gkv[3]);
              *(u32x2*)(ckvn + (size_t)row * 256 + 4 * lane) = w; }
            const float x = __uint_as_float(((unsigned)pe[r]) << 16);
            ss = wave_sum(x * x);
            rstd = rsqrtf(ss * (1.0f / 64.0f) + 1e-6f);
            float y = x * rstd * gpe;
            if (row < TL) { float cs, sn; rope_cs(row & 4095, lane, cs, sn); y = rope_apply(y, lane, cs, sn); }
            const bf16_t yb = f2bf(y);
            bf16_t* kd = KB + (size_t)key_of_row(row) * 1536 + 128 + lane;
#pragma unroll
            for (int hh = 0; hh < 8; ++hh) kd[hh * 192] = yb;
        }
    }
}

DI void qkprep_phase(bf16_t* Q, bf16_t* KB, const float* qnorm, const float* knorm) {
    const int tid = tid_opq(), wave = tid >> 6, lane = tid & 63;
    const float qn0 = qnorm[2 * lane], qn1 = qnorm[2 * lane + 1], qnr = qnorm[128 + lane];
    const float kn0 = knorm[2 * lane], kn1 = knorm[2 * lane + 1];
    for (int row = blockIdx.x * 8 + wave; row < MR; row += gridDim.x * 8) {
        float cs = 1.f, sn = 0.f;
        const bool lat = row < TL;
        if (lat) rope_cs(row & 4095, lane, cs, sn);
        bf16_t* qr = Q + (size_t)row * 1536;
        bf16_t* kr = KB + (size_t)key_of_row(row) * 1536;
        unsigned qa[8], ka[8]; bf16_t xq[8];
#pragma unroll
        for (int hh = 0; hh < 8; ++hh) { qa[hh] = *(const unsigned*)(qr + hh * 192 + 2 * lane); xq[hh] = qr[hh * 192 + 128 + lane]; ka[hh] = *(const unsigned*)(kr + hh * 192 + 2 * lane); }
        asm volatile("" ::: "memory");
#pragma unroll
        for (int hh = 0; hh < 8; ++hh) {
            const float xr = __uint_as_float(((unsigned)xq[hh]) << 16);
            const float a0 = bf_lo(qa[hh]), a1 = bf_hi(qa[hh]), c0 = bf_lo(ka[hh]), c1 = bf_hi(ka[hh]);
            const float s1 = wave_sum(a0 * a0 + a1 * a1), s2 = wave_sum(xr * xr), s3 = wave_sum(c0 * c0 + c1 * c1);
            const float r1 = rsqrtf(s1 * (1.0f / 128.0f) + 1e-6f), r2 = rsqrtf(s2 * (1.0f / 64.0f) + 1e-6f), r3 = rsqrtf(s3 * (1.0f / 128.0f) + 1e-6f);
            *(unsigned*)(qr + hh * 192 + 2 * lane) = cvt_pk_bf16(a0 * r1 * qn0, a1 * r1 * qn1);
            float y = xr * r2 * qnr;
            if (lat) y = rope_apply(y, lane, cs, sn);
            qr[hh * 192 + 128 + lane] = f2bf(y);
            *(unsigned*)(kr + hh * 192 + 2 * lane) = cvt_pk_bf16(c0 * r3 * kn0, c1 * r3 * kn1);
        }
    }
}

namespace att {
constexpr int DQK = 192, DV = 128, NW = 8, QBLK = 32, KVBLK = 64;
constexpr int LDQ = 1536, LDK = 1536, LDV = 1024, LDO = 1024;
constexpr float SCALE = 0.07216878364870322f;
constexpr float THR = 8.f;
constexpr size_t SHM_V = KVBLK * DV * 2, SHM_K = KVBLK * DQK * 2;
#define KSWZ(row, colB) ((row) * 384 + ((colB) ^ ((((row) >> 1) & 7) << 4)))
#define SBAR() __builtin_amdgcn_sched_barrier(0)
DI unsigned cvtpk(float lo, float hi) { unsigned r; asm volatile("v_cvt_pk_bf16_f32 %0, %1, %2" : "=v"(r) : "v"(lo), "v"(hi)); return r; }
DI void partialSM(f32x16& p0, f32x16& p1, float& m_reg, float& mn, float& alpha) {
    constexpr float C = SCALE * 1.4426950408889634f;
    float pmax = p0[0];
#pragma unroll
    for (int r = 1; r < 16; ++r) pmax = fmaxf(pmax, p0[r]);
#pragma unroll
    for (int r = 0; r < 16; ++r) pmax = fmaxf(pmax, p1[r]);
    { auto rr = __builtin_amdgcn_permlane32_swap(__float_as_uint(pmax), __float_as_uint(pmax), false, false);
      pmax = fmaxf(__uint_as_float(rr[0]), __uint_as_float(rr[1])); }
    if (__builtin_expect(__all(pmax - m_reg <= THR / SCALE), 1)) { mn = m_reg; alpha = 1.f; }
    else { mn = fmaxf(m_reg, pmax); alpha = __builtin_amdgcn_exp2f((m_reg - mn) * C); m_reg = mn; }
    const float mnC = -mn * C;
#pragma unroll
    for (int r = 0; r < 16; ++r) p0[r] = fmaf(p0[r], C, mnC);
#pragma unroll
    for (int r = 0; r < 16; ++r) p1[r] = fmaf(p1[r], C, mnC);
#pragma unroll
    for (int r = 0; r < 16; ++r) p0[r] = __builtin_amdgcn_exp2f(p0[r]);
}
DI void finishSM(f32x16& p0, f32x16& p1, float alpha, float& l_reg, bf16x8& pa0, bf16x8& pa1, bf16x8& pa2, bf16x8& pa3) {
#pragma unroll
    for (int r = 0; r < 16; ++r) p1[r] = __builtin_amdgcn_exp2f(p1[r]);
    float ps = 0;
#pragma unroll
    for (int r = 0; r < 16; ++r) ps += p0[r];
#pragma unroll
    for (int r = 0; r < 16; ++r) ps += p1[r];
    { auto rr = __builtin_amdgcn_permlane32_swap(__float_as_uint(ps), __float_as_uint(ps), false, false);
      ps = __uint_as_float(rr[0]) + __uint_as_float(rr[1]); }
    l_reg = l_reg * alpha + ps;
#define PK4(P, BASE, OUT) do { unsigned a0 = cvtpk(P[BASE + 0], P[BASE + 1]), a1 = cvtpk(P[BASE + 2], P[BASE + 3]);   \
    unsigned b0 = cvtpk(P[BASE + 4], P[BASE + 5]), b1 = cvtpk(P[BASE + 6], P[BASE + 7]);                              \
    auto r0 = __builtin_amdgcn_permlane32_swap(a0, b0, false, false); auto r1 = __builtin_amdgcn_permlane32_swap(a1, b1, false, false); \
    u32x4 w = {r0[0], r1[0], r0[1], r1[1]}; OUT = *reinterpret_cast<bf16x8*>(&w); } while (0)
    PK4(p0, 0, pa0); PK4(p0, 8, pa1); PK4(p1, 0, pa2); PK4(p1, 8, pa3);
#undef PK4
}
DI void qkt(f32x16& p0, f32x16& p1, const char* Ks, const bf16x8* qr, int r32, int hi) {
#pragma unroll
    for (int r = 0; r < 16; ++r) { p0[r] = 0.f; p1[r] = 0.f; }
    bf16x8 ka[3], kb[3];
#define QK_RD(D0, SLOT) do { const int cb_ = ((D0) * 16 + hi * 8) * 2; ka[SLOT] = *reinterpret_cast<const bf16x8*>(Ks + KSWZ(r32, cb_)); kb[SLOT] = *reinterpret_cast<const bf16x8*>(Ks + KSWZ(32 + r32, cb_)); } while (0)
    QK_RD(0, 0); QK_RD(1, 1);
    __builtin_amdgcn_sched_barrier(0);
#pragma unroll
    for (int d0 = 0; d0 < 12; ++d0) {
        if (d0 + 2 < 12) QK_RD(d0 + 2, (d0 + 2) % 3);
        p0 = __builtin_amdgcn_mfma_f32_32x32x16_bf16(ka[d0 % 3], qr[d0], p0, 0, 0, 0);
        p1 = __builtin_amdgcn_mfma_f32_32x32x16_bf16(kb[d0 % 3], qr[d0], p1, 0, 0, 0);
        __builtin_amdgcn_sched_barrier(0);
    }
#undef QK_RD
}
DI int v_st(int k, int c) { const int kk = (k & ~0xC) | ((k & 4) << 1) | ((k & 8) >> 1); return ((kk >> 3) * 4 + (c >> 5)) * 512 + ((kk & 7) * 32 + (c & 31)) * 2; }
DI int v_rd_base(int lane) { return ((lane & 3) << 3) | (((lane >> 2) & 3) << 6) | (((lane >> 4) & 1) << 5) | (((lane >> 5) & 1) << 8); }
constexpr int v_rd_off(int d0, int ks, int half) { return d0 * 512 + ks * 4096 + half * 2048; }
template <int OFF> DI s16x4 tr_read(int vb) { s16x4 r; asm volatile("ds_read_b64_tr_b16 %0, %1 offset:%2" : "=&v"(r) : "v"(vb), "i"(OFF) : "memory"); return r; }
template <int D0> DI void pv_one(f32x16& od, int vb, bf16x8 pa0, bf16x8 pa1, bf16x8 pa2, bf16x8 pa3) {
    const s16x4 l0 = tr_read<v_rd_off(D0, 0, 0)>(vb), h0 = tr_read<v_rd_off(D0, 0, 1)>(vb), l1 = tr_read<v_rd_off(D0, 1, 0)>(vb), h1 = tr_read<v_rd_off(D0, 1, 1)>(vb);
    const s16x4 l2 = tr_read<v_rd_off(D0, 2, 0)>(vb), h2 = tr_read<v_rd_off(D0, 2, 1)>(vb), l3 = tr_read<v_rd_off(D0, 3, 0)>(vb), h3 = tr_read<v_rd_off(D0, 3, 1)>(vb);
    asm volatile("s_waitcnt lgkmcnt(0)" ::: "memory"); SBAR();
#define PK(L, H) (bf16x8){L[0], L[1], L[2], L[3], H[0], H[1], H[2], H[3]}
    od = __builtin_amdgcn_mfma_f32_32x32x16_bf16(pa0, PK(l0, h0), od, 0, 0, 0);
    od = __builtin_amdgcn_mfma_f32_32x32x16_bf16(pa1, PK(l1, h1), od, 0, 0, 0);
    od = __builtin_amdgcn_mfma_f32_32x32x16_bf16(pa2, PK(l2, h2), od, 0, 0, 0);
    od = __builtin_amdgcn_mfma_f32_32x32x16_bf16(pa3, PK(l3, h3), od, 0, 0, 0);
#undef PK
}
DI void pv_d0(f32x16* o, int vb, bf16x8 pa0, bf16x8 pa1, bf16x8 pa2, bf16x8 pa3) {
    pv_one<0>(o[0], vb, pa0, pa1, pa2, pa3); pv_one<1>(o[1], vb, pa0, pa1, pa2, pa3); pv_one<2>(o[2], vb, pa0, pa1, pa2, pa3); pv_one<3>(o[3], vb, pa0, pa1, pa2, pa3);
}
DI void attn_body(const bf16_t* __restrict__ Qb, const bf16_t* __restrict__ Kh, const bf16_t* __restrict__ Vh, bf16_t* __restrict__ Ob, int seq, char* lds) {
    const int tid = tid_opq(), wid = tid >> 6, lane = tid & 63, r32 = lane & 31, hi = lane >> 5;
    char* V_lds = lds; char* K_lds = lds + 2 * SHM_V;
    float* wsf = (float*)(lds + 2 * SHM_V + 2 * SHM_K) + wid * 64; float* li_l = wsf; float* al_l = wsf + 32;
    float m_reg = -1e30f, l_reg = 0; f32x16 o[4]; bf16x8 qr[12];
#pragma unroll
    for (int d = 0; d < 4; ++d)
#pragma unroll
        for (int r = 0; r < 16; ++r) o[d][r] = 0.f;
    const bf16_t* Qw = Qb + (long)(wid * QBLK + r32) * LDQ + hi * 8;
#pragma unroll
    for (int d0 = 0; d0 < 12; ++d0) qr[d0] = *reinterpret_cast<const bf16x8*>(Qw + d0 * 16);
    const int sr = tid >> 4, sc = (tid & 15) * 8, vst0 = v_st(sr, sc), vst1 = v_st(32 + sr, sc);
    const int pr = tid >> 3, pc = 128 + (tid & 7) * 8;
    const int vb0 = (int)(uintptr_t)V_lds + v_rd_base(lane);
    bf16x8 vs0, vs1, ks0, ks1, kp;
#define SLOAD(k0) do { vs0 = *reinterpret_cast<const bf16x8*>(&Vh[(long)((k0) + sr) * LDV + sc]); vs1 = *reinterpret_cast<const bf16x8*>(&Vh[(long)((k0) + 32 + sr) * LDV + sc]); \
    ks0 = *reinterpret_cast<const bf16x8*>(&Kh[(long)((k0) + sr) * LDK + sc]); ks1 = *reinterpret_cast<const bf16x8*>(&Kh[(long)((k0) + 32 + sr) * LDK + sc]); \
    kp = *reinterpret_cast<const bf16x8*>(&Kh[(long)((k0) + pr) * LDK + pc]); } while (0)
#define SWRITE(b) do { *(bf16x8*)(V_lds + (b) * SHM_V + vst0) = vs0; *(bf16x8*)(V_lds + (b) * SHM_V + vst1) = vs1; \
    *(bf16x8*)(K_lds + (b) * SHM_K + KSWZ(sr, sc * 2)) = ks0; *(bf16x8*)(K_lds + (b) * SHM_K + KSWZ(32 + sr, sc * 2)) = ks1; \
    *(bf16x8*)(K_lds + (b) * SHM_K + KSWZ(pr, pc * 2)) = kp; } while (0)
#define RESC(a) do { if (__any((a) < 1.f)) { if (hi == 0) al_l[r32] = (a); asm volatile("s_waitcnt lgkmcnt(0)" ::: "memory"); \
    _Pragma("unroll") for (int d = 0; d < 4; ++d) _Pragma("unroll") for (int r = 0; r < 16; ++r) o[d][r] *= al_l[crow(r, hi)]; } } while (0)
    f32x16 p0, p1; float mn, al; bf16x8 pa0, pa1, pa2, pa3; const int NT = seq / KVBLK;
    SLOAD(0); asm volatile("s_waitcnt vmcnt(0)" ::: "memory"); SWRITE(0); __syncthreads();
    for (int j = 0; j < NT; ++j) {
        const int cb = j & 1;
        if (j + 1 < NT) SLOAD((j + 1) * KVBLK);
        SBAR(); qkt(p0, p1, K_lds + cb * SHM_K, qr, r32, hi);
        partialSM(p0, p1, m_reg, mn, al);
        finishSM(p0, p1, al, l_reg, pa0, pa1, pa2, pa3);
        RESC(al); SBAR();
        pv_d0(o, vb0 + cb * (int)SHM_V, pa0, pa1, pa2, pa3);
        if (j + 1 < NT) { asm volatile("s_waitcnt vmcnt(0)" ::: "memory"); SWRITE(cb ^ 1); }
        __syncthreads();
    }
    if (hi == 0) li_l[r32] = l_reg; asm volatile("s_waitcnt lgkmcnt(0)" ::: "memory");
    float rli[16];
#pragma unroll
    for (int r = 0; r < 16; ++r) rli[r] = __builtin_amdgcn_rcpf(li_l[crow(r, hi)]);
    bf16_t* Ow = Ob + (long)(wid * QBLK) * LDO;
#pragma unroll
    for (int r = 0; r < 16; ++r) { const int orow = crow(r, hi);
#pragma unroll
        for (int d0 = 0; d0 < 4; ++d0) Ow[(long)orow * LDO + d0 * 32 + r32] = f2bf(o[d0][r] * rli[r]); }
#undef SLOAD
#undef SWRITE
#undef RESC
}
#undef KSWZ
#undef SBAR
}

DI void attn_phase(const bf16_t* Q, const bf16_t* KB, const bf16_t* VB, bf16_t* O, char* lds, int nitems) {
    for (int it = blockIdx.x; it < nitems; it += gridDim.x) {
        int b, h, qrow0, seq;
        if (it < 2048) { b = it >> 7; h = (it >> 4) & 7; qrow0 = b * SEQ + (it & 15) * 256; seq = KEYS; }
        else { const int j = it - 2048; b = j >> 3; h = j & 7; qrow0 = TL + b * CTXL; seq = CTXL; }
        att::attn_body(Q + (size_t)qrow0 * 1536 + h * 192, KB + (size_t)b * KEYS * 1536 + h * 192, VB + (size_t)b * KEYS * 1024 + h * 128,
                       O + (size_t)qrow0 * 1024 + h * 128, seq, lds);
        __syncthreads();
    }
}

DI void fixup_phase(const float* halo, const float* cw, const float* cb, bf16_t* act) {
    const int gtid = blockIdx.x * NTHREADS + tid_opq(), gstride = gridDim.x * NTHREADS;
    for (int idx = gtid; idx < 272 * 22 * 64; idx += gstride) {
        const int c4 = (idx & 31) * 4, which = (idx >> 5) & 1, t = idx >> 6, pn = t % 22, pm = t / 22;
        const float* hp = halo + (size_t)(pm * 22 + pn) * 4 * 256;
        const bool sfirst = pm >= 256 || (pm & 15) == 0, slast = pm >= 256 || (pm & 15) == 15;
        const f32x4 z4 = (f32x4){0.f, 0.f, 0.f, 0.f};
        f32x4 pa, pg, ca, cg_, na, ng; int row;
        if (which == 0) { row = pm * 256;
            if (sfirst) { pa = z4; pg = z4; } else { const float* q = halo + (size_t)((pm - 1) * 22 + pn) * 4 * 256 + 3 * 256; pa = *(const f32x4*)(q + c4); pg = *(const f32x4*)(q + 128 + c4); }
            ca = *(const f32x4*)(hp + c4); cg_ = *(const f32x4*)(hp + 128 + c4); na = *(const f32x4*)(hp + 256 + c4); ng = *(const f32x4*)(hp + 256 + 128 + c4);
        } else { row = pm * 256 + 255;
            pa = *(const f32x4*)(hp + 2 * 256 + c4); pg = *(const f32x4*)(hp + 2 * 256 + 128 + c4); ca = *(const f32x4*)(hp + 3 * 256 + c4); cg_ = *(const f32x4*)(hp + 3 * 256 + 128 + c4);
            if (slast) { na = z4; ng = z4; } else { const float* q = halo + (size_t)((pm + 1) * 22 + pn) * 4 * 256; na = *(const f32x4*)(q + c4); ng = *(const f32x4*)(q + 128 + c4); }
        }
        const int ch = pn * 128 + c4;
        const f32x4 w0a = *(const f32x4*)(cw + ch), w1a = *(const f32x4*)(cw + 5632 + ch), w2a = *(const f32x4*)(cw + 2 * 5632 + ch), ba = *(const f32x4*)(cb + ch);
        const f32x4 w0g = *(const f32x4*)(cw + 2816 + ch), w1g = *(const f32x4*)(cw + 5632 + 2816 + ch), w2g = *(const f32x4*)(cw + 2 * 5632 + 2816 + ch), bg = *(const f32x4*)(cb + 2816 + ch);
        const f32x4 av = w0a * pa + w1a * ca + w2a * na + ba, gv = w0g * pg + w1g * cg_ + w2g * ng + bg;
        u32x2 w; w.x = cvt_pk_bf16(silu_f(gv[0]) * av[0], silu_f(gv[1]) * av[1]); w.y = cvt_pk_bf16(silu_f(gv[2]) * av[2], silu_f(gv[3]) * av[3]);
        *(u32x2*)(act + (size_t)row * 2816 + ch) = w;
    }
}


#define XB_TMO      128
#define XB_XCNT(j)  (256  + 64 * (j))
#define XB_XSUB(j)  (1280 + 64 * (j))
#define XB_XGEN(j)  (2304 + 64 * (j))
#define XB_TOP      3328
#define XB_TOPGEN   3392
#define XCD_BAR_WORDS 3456
#define XB_SPIN_CAP (1u << 18)
DI unsigned xb_ld(unsigned* p)              { return __hip_atomic_load(p, __ATOMIC_RELAXED, __HIP_MEMORY_SCOPE_AGENT); }
DI unsigned xb_add(unsigned* p, unsigned v) { return __hip_atomic_fetch_add(p, v, __ATOMIC_RELAXED, __HIP_MEMORY_SCOPE_AGENT); }
DI unsigned xb_xcc_id() { return (unsigned)__builtin_amdgcn_s_getreg((3 << 11) | 20) & 0xFu; }
#define XB_SPIN(cond, bar) do { unsigned _sp = 0; while (cond) { __builtin_amdgcn_s_sleep(1); \
    if ((++_sp & 255u) == 0u) { if (xb_ld(&(bar)[XB_TMO])) break; if (_sp > XB_SPIN_CAP) { atomicAdd(&(bar)[XB_TMO], 1u); break; } } } } while (0)
struct XcdBarrier { unsigned* bar; unsigned x; volatile LAS unsigned* st; };
DI XcdBarrier xcd_barrier_post(unsigned* bar, volatile LAS unsigned* st) {
    XcdBarrier b; b.bar = bar; b.x = xb_xcc_id(); b.st = st;
    if (threadIdx.x == 0) (void)xb_add(&bar[XB_XCNT(b.x)], 1u);
    return b;
}
DI void xcd_barrier_complete(unsigned* bar, unsigned x, unsigned& nloc, unsigned& nx) {
    const unsigned G = gridDim.x * gridDim.y * gridDim.z;
    unsigned sum, cnt, mine, sp = 0u;
    for (;;) {
        sum = 0u; cnt = 0u; mine = 0u;
#pragma unroll
        for (unsigned j = 0; j < 16; ++j) { const unsigned c = xb_ld(&bar[XB_XCNT(j)]); sum += c; cnt += (c > 0u) ? 1u : 0u; mine = (j == x) ? c : mine; }
        if (sum == G) break;
        __builtin_amdgcn_s_sleep(1);
        if ((++sp & 255u) == 0u) { if (xb_ld(&bar[XB_TMO])) break; if (sp > XB_SPIN_CAP) { atomicAdd(&bar[XB_TMO], 1u); break; } }
    }
    nloc = mine > 0u ? mine : 1u; nx = cnt > 0u ? cnt : 1u;
}
DI void xcd_barrier(const XcdBarrier& b) {
    asm volatile("s_waitcnt vmcnt(0)" ::: "memory");
    __syncthreads();
    if (threadIdx.x == 0) {
        unsigned* bar = b.bar;
        __builtin_amdgcn_s_waitcnt(0);
        unsigned nloc = b.st[0], nx = b.st[1];
        if (nloc == 0u) { xcd_barrier_complete(bar, b.x, nloc, nx); b.st[0] = nloc; b.st[1] = nx; }
        const unsigned old = xb_add(&bar[XB_XSUB(b.x)], 1u);
        const unsigned gen = old / nloc;
        if (old + 1u == (gen + 1u) * nloc) {
            __builtin_amdgcn_fence(__ATOMIC_RELEASE, "agent");
            asm volatile("s_waitcnt vmcnt(0)" ::: "memory");
            const unsigned og = xb_add(&bar[XB_TOP], 1u);
            const unsigned tg = og / nx;
            if (og + 1u == (tg + 1u) * nx) xb_add(&bar[XB_TOPGEN], 1u);
            else XB_SPIN(xb_ld(&bar[XB_TOPGEN]) == tg, bar);
            __builtin_amdgcn_fence(__ATOMIC_ACQUIRE, "agent");
            xb_add(&bar[XB_XGEN(b.x)], 1u);
            asm volatile("s_waitcnt vmcnt(0)" ::: "memory");
        } else {
            XB_SPIN(xb_ld(&bar[XB_XGEN(b.x)]) == gen, bar);
            __builtin_amdgcn_fence(__ATOMIC_ACQUIRE, "agent");
            asm volatile("s_waitcnt vmcnt(0)" ::: "memory");
        }
    }
    __syncthreads();
}

__global__ void __launch_bounds__(NTHREADS) mega(Params p) {
    extern __shared__ __attribute__((aligned(16))) unsigned char smem[];
    LAS unsigned char* lds = (LAS unsigned char*)smem;
    cg::grid_group grid = cg::this_grid();
    volatile LAS unsigned* xb_st = (volatile LAS unsigned*)(lds + XB_ST_OFF);
    if (threadIdx.x < 4) xb_st[threadIdx.x] = 0u;
    __syncthreads();
    XcdBarrier xbar = xcd_barrier_post((unsigned*)((unsigned char*)p.in[27] + WS_BAR), xb_st);

    for (int ph = p.ph_lo; ph < p.ph_hi; ++ph) {
        unsigned char* ws = (unsigned char*)p.in[opq(27)];
        float* const xout = (float*)p.in[opq(26)];
        float* mod = (float*)(ws + WS_MOD);
        float* xc = (float*)(ws + WS_XC);
        bf16_t* hbuf = (bf16_t*)(ws + WS_H);
        if (ph == 0) {
            prep_phase(p, lds);
#if defined(MK_DUP_OP) && MK_DUP_OP == 99
            grid.sync(); prep_phase(p, lds);
#endif
        } else {
            const int q = ph - 1, lp = q / 21; int r = q % 21; int layer, nmix;
            if (r < 10) { layer = 2 * lp; nmix = 6; } else { layer = 2 * lp + 1; r -= 10; nmix = 7; }
            const bool is_mla = layer & 1; const int j = layer >> 1;
            const float* modl = mod + (size_t)layer * 17 * 6144;
            const bool first = (layer == 0);
            int op = -1, gsel = 0, hf = 0;
            if (r < nmix) {
                if (!is_mla) { op = r == 0 ? 0 : r == 1 ? 2 : r == 2 ? 9 : r == 3 ? 3 : r == 4 ? 4 : 2; gsel = r == 1 ? 0 : 1; }
                else { op = r == 0 ? 0 : r == 1 ? 2 : r == 2 ? 5 : r == 3 ? 2 : r == 4 ? 6 : r == 5 ? 7 : 2; gsel = r == 1 ? 2 : r == 3 ? 3 : 5; }
            } else {
                const int f = r - nmix;
                op = f == 0 ? 1 : f == 2 ? 8 : 2; gsel = f == 1 ? 6 : 7;
            }
            if (op == 1 || (op == 0 && layer > 0)) continue;
#ifdef MK_DUP_OP
            for (int rep_ = 0; rep_ < ((op == MK_DUP_OP || (op == 2 && gsel == MK_DUP_OP - 100)) ? 2 : 1); ++rep_) {
            if (rep_) grid.sync();
#else
            {
#endif
            if (op == 0) {
                norm_phase(p.in[opq(0)], p.in[opq(2)], p.in[opq(6)], modl, 0, 1024, hbuf);
                shw_phase(ws, lds);
            } else if (op == 2) {
                const int ng = (gsel == 3) ? 2 : 1;
                for (int gi = 0; gi < ng; ++gi) {
                    pg8::Gemm g; Epi E; int kind = EPI_BF16;
                    E.ldc = 0; E.xch = (LAS float*)(lds + XCH_OFF); E.q0 = nullptr; E.q1 = nullptr; E.q2 = nullptr; E.q3 = nullptr; E.q4 = nullptr; E.q5 = nullptr;
                    float* const shw_mix = (float*)(ws + WS_SHW) + (size_t)(layer * 2) * 17 * 5632; float* const shw_ffn = shw_mix + 17 * 5632;
                    float* const rs0 = (float*)(ws + WS_RS); float* const rs1 = rs0 + MR;
                    g.M = MR;
                    const int gs = gsel + gi;
                    if (gs == 0) { g.A = hbuf; g.Bt = (const bf16_t*)(ws + WS_GIN + j * SZ_GIN); g.N = 3328; g.K = 1024; g.lda = 1024; g.ldb = 1024;
                        kind = EPI_GLA_IN; E.q0 = ws + WS_QK; E.ldc = 1024; E.q1 = ws + WS_LR; E.q2 = ws + WS_VR; if (!first) { E.q3 = rs1; E.q4 = shw_mix; } }
                    else if (gs == 1 || gs == 5) { g.A = hbuf; g.Bt = (const bf16_t*)(ws + (gs == 1 ? WS_GOUT : WS_MOUT) + j * SZ_SQ); g.N = 1024; g.K = 1024; g.lda = 1024; g.ldb = 1024;
                        kind = EPI_RESID; E.ldc = 0; E.q0 = (void*)(first ? p.in[opq(0)] : xout); E.q1 = (void*)(first ? p.in[opq(2)] : xc); E.q2 = xout; E.q3 = ws; E.q4 = (void*)modl; E.q5 = (void*)(p.in[opq(7)] + layer * 1024);
                        for (int i = blockIdx.x * NTHREADS + tid_opq(); i < MR; i += gridDim.x * NTHREADS) rs1[i] = 0.f; }
                    else if (gs == 2) { g.A = hbuf; g.Bt = (const bf16_t*)(ws + WS_MDOWN + j * SZ_MDOWN); g.N = 768; g.K = 1024; g.lda = 1024; g.ldb = 1024;
                        E.q0 = ws + WS_DN; E.ldc = 768; E.q3 = rs1; E.q4 = shw_mix; }
                    else if (gs == 3) { g.A = (const bf16_t*)(ws + WS_CQN); g.Bt = (const bf16_t*)(ws + WS_MUQ + j * SZ_MUQ); g.N = 1536; g.K = 384; g.lda = 384; g.ldb = 384;
                        E.q0 = ws + WS_QRAW; E.ldc = 1536; }
                    else if (gs == 4) { g.A = (const bf16_t*)(ws + WS_CKVN); g.Bt = (const bf16_t*)(ws + WS_MUKV + j * SZ_MUKV); g.N = 2048; g.K = 256; g.lda = 256; g.ldb = 256;
                        kind = EPI_UKV; E.q0 = ws + WS_KB; E.q1 = ws + WS_VB; }
                    else if (gs == 6) { g.A = (const bf16_t*)(ws + WS_XSA); g.Bt = (const bf16_t*)(ws + WS_FUP + (size_t)layer * SZ_FUP); g.N = 5632; g.K = 1024; g.lda = 1024; g.ldb = 1024;
                        kind = EPI_FFN_UP; E.q0 = ws + WS_ACT; E.ldc = 2816; E.q1 = (void*)(p.in[opq(23)] + (size_t)layer * 3 * 2 * DFF); E.q2 = (void*)(p.in[opq(24)] + (size_t)layer * 2 * DFF);
                        E.q3 = ws + WS_HALO; E.q4 = rs0; E.q5 = shw_ffn; }
                    else { g.A = (const bf16_t*)(ws + WS_ACT); g.Bt = (const bf16_t*)(ws + WS_FDOWN + (size_t)layer * SZ_FDOWN); g.N = 1024; g.K = 2816; g.lda = 2816; g.ldb = 2816;
                        kind = EPI_RESID; E.ldc = 1; E.q0 = xout; E.q1 = xc; E.q2 = xout; E.q3 = ws; E.q4 = (void*)modl; E.q5 = layer < 3 ? (void*)(p.in[opq(6)] + (layer + 1) * 1024) : nullptr;
                        for (int i = blockIdx.x * NTHREADS + tid_opq(); i < MR; i += gridDim.x * NTHREADS) rs0[i] = 0.f; }
                    if (layer == 3 && (gs == 3 || gs == 5 || gs == 6 || gs == 7)) g.M = TL;
                    pg8::StaticOrder S; S.init(g.M, g.N, (int)gridDim.x, (int)blockIdx.x);
                    if (kind == EPI_BF16) pg8::gemm_phase<Epi, EPI_BF16>(lds, g, S, E);
                    else if (kind == EPI_GLA_IN) pg8::gemm_phase<Epi, EPI_GLA_IN>(lds, g, S, E);
                    else if (kind == EPI_RESID) pg8::gemm_phase<Epi, EPI_RESID>(lds, g, S, E);
                    else if (kind == EPI_UKV) pg8::gemm_phase<Epi, EPI_UKV>(lds, g, S, E);
                    else pg8::gemm_phase<Epi, EPI_FFN_UP>(lds, g, S, E);
                    __syncthreads();
                }
            } else if (op == 3) {
                scan_phase((const bf16_t*)(ws + WS_VR), (const bf16_t*)(ws + WS_GQ), (const bf16_t*)(ws + WS_GK), (const bf16_t*)(ws + WS_GP), (const float*)(ws + WS_GE),
                           hbuf, (bf16_t*)(ws + WS_QK), lds);
            } else if (op == 9) {
                gateprep_phase((const bf16_t*)(ws + WS_QK), (const float*)(ws + WS_LR), p.in[opq(10)] + (size_t)j * 2 * 16 * 512, p.in[opq(11)] + (size_t)j * 2 * 512,
                               (bf16_t*)(ws + WS_GQ), (bf16_t*)(ws + WS_GK), (bf16_t*)(ws + WS_GP), (float*)(ws + WS_GE), lds);
            } else if (op == 4) {
                glapost_phase(hbuf, (const bf16_t*)(ws + WS_QK), (const bf16_t*)(ws + WS_VR), p.in[opq(12)] + j * 256, hbuf);
            } else if (op == 5) {
                mlamid_phase((const bf16_t*)(ws + WS_DN), p.in[opq(15)] + j * 384, p.in[opq(16)] + j * 256, p.in[opq(20)] + j * 192, (bf16_t*)(ws + WS_CQN), (bf16_t*)(ws + WS_CKVN), (bf16_t*)(ws + WS_KB));
            } else if (op == 6) {
                qkprep_phase((bf16_t*)(ws + WS_QRAW), (bf16_t*)(ws + WS_KB), p.in[opq(19)] + j * 192, p.in[opq(20)] + j * 192);
            } else if (op == 7) {
                attn_phase((const bf16_t*)(ws + WS_QRAW), (const bf16_t*)(ws + WS_KB), (const bf16_t*)(ws + WS_VB), hbuf, (char*)smem, layer == 3 ? 2048 : 2048 + 128);
            } else if (op == 8) {
                fixup_phase((const float*)(ws + WS_HALO), p.in[opq(23)] + (size_t)layer * 3 * 2 * DFF, p.in[opq(24)] + (size_t)layer * 2 * DFF, (bf16_t*)(ws + WS_ACT));
            }
            }
        }
        if (ph + 1 < p.ph_hi) { if (p.ph_lo < 0) grid.sync(); else xcd_barrier(xbar); }
    }
}

extern "C" void kernel_launch(void* const* d_in, const int* in_sizes, int n_in, void* d_out, int out_size, void* d_ws, size_t ws_size, hipStream_t stream) {
    static int grid = 0;
    if (grid == 0) {
        if (n_in != 26 || ws_size < WS_END) { fprintf(stderr, "kernel_launch: n_in %d ws %zu (need %zu)\n", n_in, ws_size, (size_t)WS_END); grid = -1; return; }
        int dev = 0, cus = 0, per_cu = 0;
        hipGetDevice(&dev);
        hipDeviceGetAttribute(&cus, hipDeviceAttributeMultiprocessorCount, dev);
        if (hipFuncSetAttribute((const void*)mega, hipFuncAttributeMaxDynamicSharedMemorySize, LDS_BYTES) != hipSuccess) { fprintf(stderr, "kernel_launch: hipFuncSetAttribute failed\n"); grid = -1; return; }
        if (hipOccupancyMaxActiveBlocksPerMultiprocessor(&per_cu, (const void*)mega, NTHREADS, LDS_BYTES) != hipSuccess || per_cu < 1) { fprintf(stderr, "kernel_launch: occupancy query %d\n", per_cu); per_cu = 1; }
        (void)hipGetLastError();
        grid = cus * per_cu;
        fprintf(stderr, "kernel_launch: grid %d (cus %d x %d)\n", grid, cus, per_cu);
    }
    if (grid < 0) return;
    Params p{};
    for (int i = 0; i < 26; ++i) p.in[i] = (const float*)d_in[i];
    p.in[26] = (const float*)d_out; p.in[27] = (const float*)d_ws;
    (void)hipMemsetAsync((unsigned char*)d_ws + WS_BAR, 0, 16384, stream);
#if MK_MULTI
    for (int ph = 0; ph < NPH; ++ph) {
        p.ph_lo = ph; p.ph_hi = ph + 1;
        hipLaunchKernelGGL(mega, dim3(grid), dim3(NTHREADS), LDS_BYTES, stream, p);
    }
#else
    p.ph_lo = 0; p.ph_hi = NPH;
    void* args[] = {&p};
    hipError_t e = hipLaunchCooperativeKernel((const void*)mega, dim3(grid), dim3(NTHREADS), args, LDS_BYTES, stream);
    if (e != hipSuccess) fprintf(stderr, "cooperative launch failed: %s (grid %d)\n", hipGetErrorString(e), grid);
#endif
}
```

```cpp
#include <hip/hip_runtime.h>
#include <hip/hip_cooperative_groups.h>
#include <cstdio>
#include <cstdint>
namespace cg = cooperative_groups;

#ifndef MK_MULTI
#define MK_MULTI 0
#endif

#define LAS __attribute__((address_space(3)))
#define DI __device__ __forceinline__
typedef unsigned short bf16_t;
typedef short bf16x8 __attribute__((ext_vector_type(8)));
typedef short s16x4 __attribute__((ext_vector_type(4)));
typedef float f32x2 __attribute__((ext_vector_type(2)));
typedef float f32x4 __attribute__((ext_vector_type(4)));
typedef float f32x16 __attribute__((ext_vector_type(16)));
typedef unsigned u32x2 __attribute__((ext_vector_type(2)));
typedef unsigned u32x4 __attribute__((ext_vector_type(4)));

constexpr int DM = 1024, NB = 16, SEQ = 4096, CTXL = 256;
constexpr int TL = NB * SEQ, TC = NB * CTXL, MR = TL + TC;
constexpr int KEYS = CTXL + SEQ;
constexpr int DFF = 2816, DFFH = 1408;
constexpr int NTHREADS = 512;
constexpr int XB_ST_OFF = 131072 + 12288 + 2 * 5120 + 6144;
constexpr int LDS_BYTES = XB_ST_OFF + 16;
constexpr int WIMG_F = 3072, PREW_F = 3072 + 2 * 1280;
constexpr int XCH_OFF = 131072;
constexpr int NPH = 43;

constexpr size_t SZ_GIN = 3328ull * 1024 * 2, SZ_SQ = 1024ull * 1024 * 2, SZ_MDOWN = 768ull * 1024 * 2, SZ_MUQ = 1536ull * 384 * 2,
                 SZ_MUKV = 2048ull * 256 * 2, SZ_FUP = 5632ull * 1024 * 2, SZ_FDOWN = 1024ull * 2816 * 2;
constexpr size_t WS_GIN = 0;
constexpr size_t WS_GOUT = WS_GIN + 2 * SZ_GIN;
constexpr size_t WS_MDOWN = WS_GOUT + 2 * SZ_SQ;
constexpr size_t WS_MUQ = WS_MDOWN + 2 * SZ_MDOWN;
constexpr size_t WS_MUKV = WS_MUQ + 2 * SZ_MUQ;
constexpr size_t WS_MOUT = WS_MUKV + 2 * SZ_MUKV;
constexpr size_t WS_FUP = WS_MOUT + 2 * SZ_SQ;
constexpr size_t WS_FDOWN = WS_FUP + 4 * SZ_FUP;
constexpr size_t WS_MOD = WS_FDOWN + 4 * SZ_FDOWN;
constexpr size_t SZ_MOD = 4ull * 17 * 6144 * 4;
constexpr size_t WS_RS = WS_MOD + ((SZ_MOD + 255) / 256) * 256;
constexpr size_t WS_SHW = WS_RS + 2ull * MR * 4;
constexpr size_t WS_BAR = WS_SHW + 4ull * 2 * 17 * 5632 * 4;
constexpr size_t WS_XC = WS_BAR + 16384;
constexpr size_t WS_H = WS_XC + (size_t)TC * 1024 * 4;
constexpr size_t WS_R = WS_H + (size_t)MR * 1024 * 2;
constexpr size_t WS_QK = WS_R;
constexpr size_t WS_VR = WS_QK + (size_t)MR * 1024 * 2;
constexpr size_t WS_LR = WS_VR + (size_t)MR * 2048 * 2;
constexpr int NCHI = NB * 2 * 4 * 68;
constexpr size_t WS_GQ = WS_LR + (size_t)MR * 32 * 4;
constexpr size_t WS_GK = WS_GQ + (size_t)NCHI * 64 * 128 * 2;
constexpr size_t WS_GP = WS_GK + (size_t)NCHI * 64 * 128 * 2;
constexpr size_t WS_GE = WS_GP + (size_t)NCHI * 64 * 64 * 2;
constexpr size_t WS_GLA_END = WS_GE + (size_t)NCHI * 128 * 4;
constexpr size_t WS_QRAW = WS_R;
constexpr size_t WS_DN = WS_R;
constexpr size_t WS_CQN = WS_QRAW + (size_t)MR * 1536 * 2;
constexpr size_t WS_CKVN = WS_CQN + (size_t)MR * 384 * 2;
constexpr size_t WS_KB = WS_CKVN + (size_t)MR * 256 * 2;
constexpr size_t WS_VB = WS_KB + (size_t)NB * KEYS * 1536 * 2;
constexpr size_t WS_MLA_END = WS_VB + (size_t)NB * KEYS * 1024 * 2;
constexpr size_t WS_ACT = WS_R;
constexpr size_t WS_HALO = WS_ACT + (size_t)MR * 2816 * 2;
constexpr size_t WS_XSA = WS_HALO + 272ull * 22 * 4 * 256 * 4;
constexpr size_t WS_FFN_END = WS_XSA + (size_t)MR * 1024 * 2;
constexpr size_t WS_END = WS_GLA_END > WS_MLA_END ? (WS_GLA_END > WS_FFN_END ? WS_GLA_END : WS_FFN_END) : (WS_MLA_END > WS_FFN_END ? WS_MLA_END : WS_FFN_END);
static_assert(WS_END <= (1ull << 30), "workspace over 1 GiB");

struct Params { const float* in[28]; int ph_lo, ph_hi; };

DI unsigned cvt_pk_bf16(float lo, float hi) { unsigned r; asm("v_cvt_pk_bf16_f32 %0, %1, %2" : "=v"(r) : "v"(lo), "v"(hi)); return r; }
DI float bf_lo(unsigned u) { return __uint_as_float(u << 16); }
DI float bf_hi(unsigned u) { return __uint_as_float(u & 0xffff0000u); }
DI bf16_t f2bf(float f) { return (bf16_t)(cvt_pk_bf16(f, 0.f) & 0xffffu); }
DI float wave_sum(float v) {
    v += __int_as_float(__builtin_amdgcn_update_dpp(0, __float_as_int(v), 0xB1, 0xF, 0xF, false));
    v += __int_as_float(__builtin_amdgcn_update_dpp(0, __float_as_int(v), 0x4E, 0xF, 0xF, false));
    v += __int_as_float(__builtin_amdgcn_update_dpp(0, __float_as_int(v), 0x141, 0xF, 0xF, false));
    v += __int_as_float(__builtin_amdgcn_update_dpp(0, __float_as_int(v), 0x140, 0xF, 0xF, false));
    v += __int_as_float(__builtin_amdgcn_update_dpp(0, __float_as_int(v), 0x142, 0xA, 0xF, false));
    v += __int_as_float(__builtin_amdgcn_update_dpp(0, __float_as_int(v), 0x143, 0xC, 0xF, false));
    return __int_as_float(__builtin_amdgcn_readlane(__float_as_int(v), 63));
}
DI float silu_f(float v) { return v * __builtin_amdgcn_rcpf(1.0f + __expf(-v)); }
DI int crow(int r, int hi) { return (r & 3) + 8 * (r >> 2) + 4 * hi; }
DI int tid_opq() { int t = threadIdx.x; asm volatile("" : "+v"(t)); return t; }
DI int opq(int i) { asm volatile("" : "+s"(i)); return i; }

namespace pg8 {
constexpr int BM = 256, BK = 64, HALF = 128, HTB = HALF * BK * 2, STAGE_BYTES = 8 * HTB, NXCD = 8, WGM = 8;
DI int lds_byte(int r, int c) { const int st = (r >> 4) * 2 + (c >> 5), rr = r & 15, cc = c & 31, ob = rr * 64 + cc * 2; return st * 1024 + (ob ^ (((ob >> 9) & 1) << 5)); }
DI void stage_rc(int b, int& R, int& C) { const int st = b / 1024, sb = b % 1024, swz = sb ^ (((sb >> 9) & 1) << 5); R = (st >> 1) * 16 + swz / 64; C = (st & 1) * 32 + (swz % 64) / 2; }
DI int perm32(int rho) { const int n = rho >> 4, i = rho & 15; return 8 * (i >> 2) + 4 * n + (i & 3); }
struct Unit { int pm, pn; };
struct Gemm { const bf16_t* A; const bf16_t* Bt; int M, N, K, lda, ldb; };
struct StaticOrder {
    int nM, nN, nwg, G, c;
    DI void init(int M, int N, int G_, int c_) { nM = M / BM; nN = N / BM; nwg = nM * nN; G = G_; c = c_; }
    DI bool next(int i, Unit& u) const {
        const long L = (long)i * G + c; if (L >= nwg) return false;
        int wgid = (int)L; { const int q = nwg / NXCD, r = nwg % NXCD, xcd = wgid % NXCD, off = wgid / NXCD; wgid = (xcd < r ? xcd * (q + 1) : r * (q + 1) + (xcd - r) * q) + off; }
        const int nig = WGM * nN, gid = wgid / nig, fm = gid * WGM, gsz = (nM - fm) < WGM ? (nM - fm) : WGM;
        u.pm = fm + ((wgid % nig) % gsz); u.pn = (wgid % nig) / gsz; return true;
    }
};

template <class Epi, int KIND>
DI void gemm_phase(LAS unsigned char* lds, const Gemm g, const StaticOrder& S, const Epi& E) {
    constexpr bool perm = Epi::template perm_of<KIND>();
    const int tid = tid_opq(), wid = __builtin_amdgcn_readfirstlane(tid >> 6), lane = tid & 63, wr = wid >> 2, wc = wid & 3, fr = lane & 15, fq = lane >> 4;
    const int K = g.K, nt = K / BK;
    unsigned voffA[2], voffB[2];
#pragma unroll
    for (int i = 0; i < 2; ++i) { int R, C; stage_rc(tid * 16 + i * 8192, R, C); const int Rb = perm ? ((R & ~31) + perm32(R & 31)) : R;
        voffA[i] = (unsigned)(R * g.lda + C) * 2u; voffB[i] = (unsigned)(Rb * g.ldb + C) * 2u; }
    const size_t kstep = (size_t)(BK * 2);
    const size_t hstepA = (size_t)HALF * g.lda * 2, hstepB = (size_t)HALF * g.ldb * 2;
    const size_t tstepA = 2 * hstepA, tstepB = 2 * hstepB;
    const unsigned ldsw = (unsigned)wid * 1024u;
    const int aoff = lds_byte(wr * 64 + fr, fq * 8), boff = lds_byte(wc * 32 + fr, fq * 8);
#define PG8_SA(b, h) (((b) * 2 + (h)) * HTB)
#define PG8_SB(b, h) ((4 + (b) * 2 + (h)) * HTB)
#define PG8_STAGE(bufoff, gbase, voff) do { _Pragma("unroll") for (int _i = 0; _i < 2; ++_i) \
        __builtin_amdgcn_global_load_lds((const unsigned*)((const char*)(gbase) + (voff)[_i]), (LAS unsigned*)(lds + (bufoff) + ldsw + _i * 8192), 16, 0, 0); } while (0)
#define PG8_LDA(dst, b, h) do { _Pragma("unroll") for (int m = 0; m < 4; ++m) _Pragma("unroll") for (int k = 0; k < 2; ++k) dst[m][k] = *(const LAS bf16x8*)(lds + PG8_SA(b, h) + aoff + m * 2048 + k * 1024); } while (0)
#define PG8_LDB(dst, b, h) do { _Pragma("unroll") for (int n = 0; n < 2; ++n) _Pragma("unroll") for (int k = 0; k < 2; ++k) dst[n][k] = *(const LAS bf16x8*)(lds + PG8_SB(b, h) + boff + n * 2048 + k * 1024); } while (0)
#define PG8_MMA(ai, bj, At, Bt) do { __builtin_amdgcn_s_setprio(1); _Pragma("unroll") for (int m = 0; m < 4; ++m) _Pragma("unroll") for (int n = 0; n < 2; ++n) _Pragma("unroll") for (int k = 0; k < 2; ++k) \
        acc[ai][bj][m][n] = __builtin_amdgcn_mfma_f32_16x16x32_bf16(Bt[n][k], At[m][k], acc[ai][bj][m][n], 0, 0, 0); __builtin_amdgcn_s_setprio(0); } while (0)
#define PG8_WAIT_V(n) asm volatile("s_waitcnt vmcnt(" #n ")" ::: "memory")
#define PG8_WAIT_L(n) asm volatile("s_waitcnt lgkmcnt(" #n ")" ::: "memory")
#define PG8_BAR __builtin_amdgcn_s_barrier()
#define PG8_SCHED __builtin_amdgcn_sched_barrier(0)
    Unit cur, nxt; int ui = 0;
    if (!S.next(0, cur)) return;
    f32x4 acc[2][2][4][2];
#pragma unroll
    for (int a = 0; a < 2; ++a)
#pragma unroll
        for (int b = 0; b < 2; ++b)
#pragma unroll
            for (int m = 0; m < 4; ++m)
#pragma unroll
                for (int n = 0; n < 2; ++n) acc[a][b][m][n] = (f32x4){0.f, 0.f, 0.f, 0.f};
    bf16x8 At[4][2], B0[2][2], B1[2][2];
    typename Epi::Pre pre;
    const char* cA = (const char*)g.A + (size_t)cur.pm * tstepA; const char* cB = (const char*)g.Bt + (size_t)cur.pn * tstepB;
    PG8_STAGE(PG8_SB(0, 0), cB, voffB); PG8_STAGE(PG8_SA(0, 0), cA, voffA); PG8_STAGE(PG8_SB(0, 1), cB + hstepB, voffB); PG8_STAGE(PG8_SA(0, 1), cA + hstepA, voffA);
    if (wr == 1) PG8_BAR;
    PG8_WAIT_V(4); PG8_BAR;
    PG8_STAGE(PG8_SB(1, 0), cB + kstep, voffB); PG8_STAGE(PG8_SA(1, 0), cA + kstep, voffA); PG8_STAGE(PG8_SB(1, 1), cB + hstepB + kstep, voffB);
    PG8_WAIT_V(6); PG8_BAR;
    for (;;) {
        const bool has_next = S.next(ui + 1, nxt);
        const char* nA = has_next ? (const char*)g.A + (size_t)nxt.pm * tstepA : cA; const char* nB = has_next ? (const char*)g.Bt + (size_t)nxt.pn * tstepB : cB;
        E.template prefetch<KIND>(pre, cur, wr, wc, fr, fq, ui & 1);
        for (int t = 0; t < nt; t += 2) {
            const bool last = (t == nt - 2);
            const char* a1 = cA + (size_t)(t + 1) * kstep;
            const char* a2 = last ? nA : cA + (size_t)(t + 2) * kstep; const char* b2 = last ? nB : cB + (size_t)(t + 2) * kstep;
            const char* a3 = a2 + kstep; const char* b3 = b2 + kstep;
            PG8_LDB(B0, 0, 0); PG8_SCHED; PG8_LDA(At, 0, 0); PG8_STAGE(PG8_SA(1, 1), a1 + hstepA, voffA);
            PG8_WAIT_L(8); PG8_BAR; PG8_WAIT_L(0); PG8_MMA(0, 0, At, B0); PG8_BAR; PG8_SCHED;
            PG8_LDB(B1, 0, 1); PG8_STAGE(PG8_SB(0, 0), b2, voffB);
            PG8_BAR; PG8_WAIT_L(0); PG8_MMA(0, 1, At, B1); PG8_BAR;
            PG8_LDA(At, 0, 1); PG8_STAGE(PG8_SA(0, 0), a2, voffA);
            PG8_BAR; PG8_WAIT_L(0); PG8_MMA(1, 0, At, B0); PG8_BAR; PG8_SCHED;
            PG8_STAGE(PG8_SB(0, 1), b2 + hstepB, voffB);
            PG8_WAIT_V(6); PG8_BAR; PG8_MMA(1, 1, At, B1); PG8_BAR;
            PG8_LDB(B0, 1, 0); PG8_SCHED; PG8_LDA(At, 1, 0); PG8_STAGE(PG8_SA(0, 1), a2 + hstepA, voffA);
            PG8_WAIT_L(8); PG8_BAR; PG8_WAIT_L(0); PG8_MMA(0, 0, At, B0); PG8_BAR; PG8_SCHED;
            PG8_LDB(B1, 1, 1); PG8_STAGE(PG8_SB(1, 0), b3, voffB);
            PG8_BAR; PG8_WAIT_L(0); PG8_MMA(0, 1, At, B1); PG8_BAR;
            PG8_LDA(At, 1, 1); PG8_STAGE(PG8_SA(1, 0), a3, voffA);
            PG8_BAR; PG8_WAIT_L(0); PG8_MMA(1, 0, At, B0); PG8_BAR; PG8_SCHED;
            PG8_STAGE(PG8_SB(1, 1), b3 + hstepB, voffB);
            PG8_WAIT_V(6); PG8_BAR; PG8_MMA(1, 1, At, B1); PG8_BAR;
        }
        if (wr == 0) { PG8_BAR; asm volatile("" ::: "memory"); }
        E.template run<KIND>(acc, pre, cur, wr, wc, fr, fq, ui & 1);
        if (wr == 1) { asm volatile("" ::: "memory"); PG8_BAR; }
        if (!has_next) break;
#pragma unroll
        for (int a = 0; a < 2; ++a)
#pragma unroll
            for (int b = 0; b < 2; ++b)
#pragma unroll
                for (int m = 0; m < 4; ++m)
#pragma unroll
                    for (int n = 0; n < 2; ++n) acc[a][b][m][n] = (f32x4){0.f, 0.f, 0.f, 0.f};
        cur = nxt; cA = nA; cB = nB; ++ui;
    }
    PG8_WAIT_V(0);
    if (wr == 0) PG8_BAR;
    PG8_BAR;
#undef PG8_SA
#undef PG8_SB
#undef PG8_STAGE
#undef PG8_LDA
#undef PG8_LDB
#undef PG8_MMA
#undef PG8_WAIT_V
#undef PG8_WAIT_L
#undef PG8_BAR
#undef PG8_SCHED
}
}

enum { EPI_BF16 = 0, EPI_GLA_IN = 1, EPI_RESID = 2, EPI_UKV = 3, EPI_FFN_UP = 4 };
DI float dpp_ror1(float v) { return __int_as_float(__builtin_amdgcn_update_dpp(0, __float_as_int(v), 0x121, 0xf, 0xf, false)); }
DI float dpp_ror15(float v) { return __int_as_float(__builtin_amdgcn_update_dpp(0, __float_as_int(v), 0x12F, 0xf, 0xf, false)); }
struct Epi {
    struct Pre { float rsv[2][4]; f32x4 sw[2][2]; f32x2 wl0, wl1; };
    int ldc; LAS float* xch;
    void* q0; void* q1; void* q2; void* q3; void* q4; void* q5;
    static DI f32x4 ror1_4(f32x4 v) { float a, b, c, d;
        asm volatile("s_nop 1\n\tv_mov_b32_dpp %0, %4 row_ror:1 row_mask:0xf bank_mask:0xf\n\tv_mov_b32_dpp %1, %5 row_ror:1 row_mask:0xf bank_mask:0xf\n\tv_mov_b32_dpp %2, %6 row_ror:1 row_mask:0xf bank_mask:0xf\n\tv_mov_b32_dpp %3, %7 row_ror:1 row_mask:0xf bank_mask:0xf"
                     : "=&v"(a), "=&v"(b), "=&v"(c), "=&v"(d) : "v"(v[0]), "v"(v[1]), "v"(v[2]), "v"(v[3]));
        return (f32x4){a, b, c, d}; }
    static DI f32x2 ror1_2(f32x2 v) { float a, b;
        asm volatile("s_nop 1\n\tv_mov_b32_dpp %0, %2 row_ror:1 row_mask:0xf bank_mask:0xf\n\tv_mov_b32_dpp %1, %3 row_ror:1 row_mask:0xf bank_mask:0xf" : "=&v"(a), "=&v"(b) : "v"(v[0]), "v"(v[1]));
        return (f32x2){a, b}; }
    static DI f32x2 ror15_2(f32x2 v) { float a, b;
        asm volatile("s_nop 1\n\tv_mov_b32_dpp %0, %2 row_ror:15 row_mask:0xf bank_mask:0xf\n\tv_mov_b32_dpp %1, %3 row_ror:15 row_mask:0xf bank_mask:0xf" : "=&v"(a), "=&v"(b) : "v"(v[0]), "v"(v[1]));
        return (f32x2){a, b}; }
    static DI f32x4 ror15_4(f32x4 v) { float a, b, c, d;
        asm volatile("s_nop 1\n\tv_mov_b32_dpp %0, %4 row_ror:15 row_mask:0xf bank_mask:0xf\n\tv_mov_b32_dpp %1, %5 row_ror:15 row_mask:0xf bank_mask:0xf\n\tv_mov_b32_dpp %2, %6 row_ror:15 row_mask:0xf bank_mask:0xf\n\tv_mov_b32_dpp %3, %7 row_ror:15 row_mask:0xf bank_mask:0xf"
                     : "=&v"(a), "=&v"(b), "=&v"(c), "=&v"(d) : "v"(v[0]), "v"(v[1]), "v"(v[2]), "v"(v[3]));
        return (f32x4){a, b, c, d}; }
    DI void ffn_up(const f32x4 (&acc)[2][2][4][2], const pg8::Unit& u, int wr, int wc, int fr, int fq, int par) const {
        bf16_t* O = (bf16_t*)q0; float* halo = (float*)q3;
        const int cl = wc * 32 + 8 * fq;
        float rstd[2][4];
        { const LAS float* pw = xch + PREW_F + (wr * 4 + wc) * 192;
#pragma unroll
          for (int g = 0; g < 8; ++g) rstd[g >> 2][g & 3] = rsqrtf(pw[g * 16 + fr] * (1.0f / 1024.0f) + 1e-6f); }
        const LAS float* wbuf = xch + WIMG_F + par * 1280;
#define XW(ST, TB, BJ, V0, V1) do { LAS float* xp_ = xch + ((((ST) + 1) * 2 + (TB)) * 2 + (BJ)) * 128 + cl; *(LAS f32x4*)xp_ = (V0); *(LAS f32x4*)(xp_ + 4) = (V1); } while (0)
#define TR(AI, BJ, M, N) (acc[AI][BJ][M][N] * rstd[AI][M])
        if (fr == 0) { XW(wr, 0, 0, TR(0, 0, 0, 0), TR(0, 0, 0, 1)); XW(wr, 0, 1, TR(0, 1, 0, 0), TR(0, 1, 0, 1)); XW(2 + wr, 0, 0, TR(1, 0, 0, 0), TR(1, 0, 0, 1)); XW(2 + wr, 0, 1, TR(1, 1, 0, 0), TR(1, 1, 0, 1)); }
        if (fr == 15) { XW(wr, 1, 0, TR(0, 0, 3, 0), TR(0, 0, 3, 1)); XW(wr, 1, 1, TR(0, 1, 3, 0), TR(0, 1, 3, 1)); XW(2 + wr, 1, 0, TR(1, 0, 3, 0), TR(1, 0, 3, 1)); XW(2 + wr, 1, 1, TR(1, 1, 3, 0), TR(1, 1, 3, 1)); }
        { const f32x4 zz = (f32x4){0.f, 0.f, 0.f, 0.f}; if (fr == 0 && wr == 0) { XW(-1, 1, 0, zz, zz); XW(-1, 1, 1, zz, zz); } if (fr == 15 && wr == 1) { XW(4, 0, 0, zz, zz); XW(4, 0, 1, zz, zz); } }
#undef XW
        asm volatile("s_waitcnt lgkmcnt(0)" ::: "memory"); __builtin_amdgcn_s_barrier(); asm volatile("" ::: "memory"); __builtin_amdgcn_s_barrier(); asm volatile("" ::: "memory");
        {
            float* hp = halo + (size_t)(u.pm * 22 + u.pn) * 4 * 256 + cl;
            const f32x4 sa0 = *(const LAS f32x4*)(wbuf + 512 + cl), sa1 = *(const LAS f32x4*)(wbuf + 512 + cl + 4), sg0 = *(const LAS f32x4*)(wbuf + 640 + 512 + cl), sg1 = *(const LAS f32x4*)(wbuf + 640 + 512 + cl + 4);
            if (wr == 0 && fr < 2) { float* h2 = hp + fr * 256; *(f32x4*)h2 = TR(0, 0, 0, 0) + sa0; *(f32x4*)(h2 + 4) = TR(0, 0, 0, 1) + sa1; *(f32x4*)(h2 + 128) = TR(0, 1, 0, 0) + sg0; *(f32x4*)(h2 + 132) = TR(0, 1, 0, 1) + sg1; }
            if (wr == 1 && fr >= 14) { float* h2 = hp + (fr - 12) * 256; *(f32x4*)h2 = TR(1, 0, 3, 0) + sa0; *(f32x4*)(h2 + 4) = TR(1, 0, 3, 1) + sa1; *(f32x4*)(h2 + 128) = TR(1, 1, 3, 0) + sg0; *(f32x4*)(h2 + 132) = TR(1, 1, 3, 1) + sg1; }
        }
#undef TR
        asm volatile("" ::: "memory");
        const int rowt = u.pm * 256 + wr * 64 + fr;
        const bool f0 = fr == 0, f15 = fr == 15;
        f32x2 sg[2][4][4];
#define SILU2(v) (f32x2){silu_f(v[0]), silu_f(v[1])}
#define H2(V, HH) __builtin_shufflevector(V, V, 2 * (HH), 2 * (HH) + 1)
#define CONV_GROUP(BJ, Q, AI, OP) do { \
            const int st = 2 * (AI) + wr; \
            const f32x2 pb = *(const LAS f32x2*)(xch + (((st) * 2 + 1) * 2 + (BJ)) * 128 + cl + 2 * (Q)) + sw; \
            const f32x2 nb = *(const LAS f32x2*)(xch + (((st + 2) * 2 + 0) * 2 + (BJ)) * 128 + cl + 2 * (Q)) + sw; \
            const f32x2 c0 = H2(acc[AI][BJ][0][(Q) >> 1], (Q) & 1) * rstd[AI][0] + sw, c1 = H2(acc[AI][BJ][1][(Q) >> 1], (Q) & 1) * rstd[AI][1] + sw, \
                        c2 = H2(acc[AI][BJ][2][(Q) >> 1], (Q) & 1) * rstd[AI][2] + sw, c3 = H2(acc[AI][BJ][3][(Q) >> 1], (Q) & 1) * rstd[AI][3] + sw; \
            const f32x2 R0 = ror1_2(c0), L0 = ror15_2(c0), L1 = ror15_2(c1); \
            { const f32x2 v = w0 * (f0 ? pb : R0) + w1 * c0 + w2 * (f15 ? L1 : L0) + bb; OP(sg[AI][0][Q], v); } \
            __builtin_amdgcn_sched_barrier(0); \
            const f32x2 R1 = ror1_2(c1), L2 = ror15_2(c2); \
            { const f32x2 v = w0 * (f0 ? R0 : R1) + w1 * c1 + w2 * (f15 ? L2 : L1) + bb; OP(sg[AI][1][Q], v); } \
            __builtin_amdgcn_sched_barrier(0); \
            const f32x2 R2 = ror1_2(c2), L3 = ror15_2(c3); \
            { const f32x2 v = w0 * (f0 ? R1 : R2) + w1 * c2 + w2 * (f15 ? L3 : L2) + bb; OP(sg[AI][2][Q], v); } \
            __builtin_amdgcn_sched_barrier(0); \
            const f32x2 R3 = ror1_2(c3); \
            { const f32x2 v = w0 * (f0 ? R2 : R3) + w1 * c3 + w2 * (f15 ? nb : L3) + bb; OP(sg[AI][3][Q], v); } \
            __builtin_amdgcn_sched_barrier(0); } while (0)
#define OP_G(dst, v) dst = SILU2(v)
#define OP_A(dst, v) dst *= v
#define CONV_W(BJ, Q) const LAS float* wp_ = wbuf + (BJ) * 640 + cl + 2 * (Q); \
            const f32x2 w0 = *(const LAS f32x2*)wp_, w1 = *(const LAS f32x2*)(wp_ + 128), w2 = *(const LAS f32x2*)(wp_ + 256), bb = *(const LAS f32x2*)(wp_ + 384), sw = *(const LAS f32x2*)(wp_ + 512);
        { CONV_W(1, 0) CONV_GROUP(1, 0, 0, OP_G); CONV_GROUP(1, 0, 1, OP_G); }
        { CONV_W(1, 1) CONV_GROUP(1, 1, 0, OP_G); CONV_GROUP(1, 1, 1, OP_G); }
        { CONV_W(1, 2) CONV_GROUP(1, 2, 0, OP_G); CONV_GROUP(1, 2, 1, OP_G); }
        { CONV_W(1, 3) CONV_GROUP(1, 3, 0, OP_G); CONV_GROUP(1, 3, 1, OP_G); }
        { CONV_W(0, 0) CONV_GROUP(0, 0, 0, OP_A); CONV_GROUP(0, 0, 1, OP_A); }
        { CONV_W(0, 1) CONV_GROUP(0, 1, 0, OP_A); CONV_GROUP(0, 1, 1, OP_A); }
        { CONV_W(0, 2) CONV_GROUP(0, 2, 0, OP_A); CONV_GROUP(0, 2, 1, OP_A); }
        { CONV_W(0, 3) CONV_GROUP(0, 3, 0, OP_A); CONV_GROUP(0, 3, 1, OP_A); }
#undef CONV_W
#undef CONV_GROUP
#undef OP_G
#undef OP_A
#undef SILU2
#undef H2
#define ST16(AI, MM) do { u32x4 w_; w_.x = cvt_pk_bf16(sg[AI][MM][0][0], sg[AI][MM][0][1]); w_.y = cvt_pk_bf16(sg[AI][MM][1][0], sg[AI][MM][1][1]); w_.z = cvt_pk_bf16(sg[AI][MM][2][0], sg[AI][MM][2][1]); w_.w = cvt_pk_bf16(sg[AI][MM][3][0], sg[AI][MM][3][1]); \
            *(u32x4*)(O + (size_t)(rowt + (AI) * 128 + (MM) * 16) * 2816 + u.pn * 128 + cl) = w_; } while (0)
        ST16(0, 0); ST16(0, 1); ST16(0, 2); ST16(0, 3); ST16(1, 0); ST16(1, 1); ST16(1, 2); ST16(1, 3);
#undef ST16
    }
    template <int K> static constexpr bool perm_of() { return true; }
    template <int kind> DI void prefetch(Pre& P, const pg8::Unit& u, int wr, int wc, int fr, int fq, int par) const {
        (void)P;
        if constexpr (kind == EPI_GLA_IN || kind == EPI_BF16 || kind == EPI_FFN_UP) {
            const float* rsb = (const float*)(kind == EPI_FFN_UP ? q4 : q3);
            if (rsb) {
                LAS float* pw = xch + PREW_F + (wr * 4 + wc) * 192;
                const int bidx = u.pm < 256 ? (u.pm >> 4) : 16;
                if (fq == 0) {
                    const float* rsp = rsb + u.pm * 256 + wr * 64 + fr;
#pragma unroll
                    for (int g = 0; g < 8; ++g) __builtin_amdgcn_global_load_lds((const unsigned*)(rsp + (g >> 2) * 128 + (g & 3) * 16), (LAS unsigned*)(pw + g * 16), 4, 0, 0);
                    if constexpr (kind != EPI_FFN_UP) {
                        const float* sw = (const float*)q4 + (size_t)bidx * 5632 + u.pn * 256 + (fr >> 3) * 128 + wc * 32 + (fr & 7) * 4;
                        __builtin_amdgcn_global_load_lds((const unsigned*)sw, (LAS unsigned*)(pw + 128), 16, 0, 0);
                    }
                }
                if constexpr (kind == EPI_FFN_UP) {
                    const int wid = wr * 4 + wc;
                    if (wid < 5) {
                        const float* cw = (const float*)q1; const float* cb = (const float*)q2; const float* shw = (const float*)q5 + (size_t)bidx * 5632 + u.pn * 256;
                        const int i4 = (wid * 64 + fq * 16 + fr) * 4, bjw = i4 / 640, rem = i4 % 640, kw = rem >> 7, c_ = rem & 127;
                        const float* srcw = kw < 3 ? cw + kw * 5632 + bjw * 2816 + u.pn * 128 + c_ : kw == 3 ? cb + bjw * 2816 + u.pn * 128 + c_ : shw + bjw * 128 + c_;
                        __builtin_amdgcn_global_load_lds((const unsigned*)srcw, (LAS unsigned*)(xch + WIMG_F + par * 1280 + wid * 256), 16, 0, 0);
                    }
                }
            }
        }
    }
    template <int kind> DI void run(const f32x4 (&acc)[2][2][4][2], const Pre& P, const pg8::Unit& u, int wr, int wc, int fr, int fq, int par) const {
        asm volatile("" : "+v"(fr), "+v"(fq));
        if constexpr (kind == EPI_FFN_UP) { ffn_up(acc, u, wr, wc, fr, fq, par); return; }
        if constexpr (kind == EPI_RESID) {
            const float* base_l = (const float*)q0; const float* base_c = (const float*)q1; float* out_l = (float*)q2; unsigned char* wsb = (unsigned char*)q3; float* out_c = (float*)(wsb + WS_XC);
            const float* modl = (const float*)q4; const float* gnext = (const float*)q5;
            const int bidx = u.pm < 256 ? (u.pm >> 4) : 16;
            const float* gv = modl + (size_t)bidx * 6144 + (ldc ? 5 * 1024 : 2 * 1024);
            const float* bp = u.pm < 256 ? base_l + (size_t)u.pm * 256 * 1024 : base_c + (size_t)(u.pm - 256) * 256 * 1024;
            float* op = u.pm < 256 ? out_l + (size_t)u.pm * 256 * 1024 : out_c + (size_t)(u.pm - 256) * 256 * 1024;
            const int col0 = u.pn * 256 + wc * 32 + 8 * fq;
            f32x4 gt[2][2], gn[2][2];
#pragma unroll
            for (int bj = 0; bj < 2; ++bj)
#pragma unroll
                for (int n = 0; n < 2; ++n) gt[bj][n] = *(const f32x4*)(gv + col0 + bj * 128 + n * 4);
            if (gnext) {
                const float* scn = ldc ? modl + (size_t)(17 + bidx) * 6144 + 1024 : modl + (size_t)bidx * 6144 + 4 * 1024;
#pragma unroll
                for (int bj = 0; bj < 2; ++bj)
#pragma unroll
                    for (int n = 0; n < 2; ++n) gn[bj][n] = *(const f32x4*)(gnext + col0 + bj * 128 + n * 4) * (*(const f32x4*)(scn + col0 + bj * 128 + n * 4) + 1.0f);
            }
            bf16_t* xs = (bf16_t*)(wsb + (ldc ? WS_H : WS_XSA)) + (size_t)u.pm * 256 * 1024;
            float* rs = (float*)(wsb + WS_RS) + (ldc ? MR : 0) + u.pm * 256;
            f32x4 bsA[4], bsB[4];
#define RS_LOAD(K, DST) do { const size_t off_ = (size_t)(((K) >> 2) * 128 + wr * 64 + ((K) & 3) * 16 + fr) * 1024 + col0; \
                _Pragma("unroll") for (int q_ = 0; q_ < 4; ++q_) DST[q_] = *(const f32x4*)(bp + off_ + (q_ >> 1) * 128 + (q_ & 1) * 4); } while (0)
#define RS_DO(K, SRC) do { const int ai_ = (K) >> 2, m_ = (K) & 3; const int rl = ai_ * 128 + wr * 64 + m_ * 16 + fr; const size_t off = (size_t)rl * 1024 + col0; float ssq = 0.f; \
                _Pragma("unroll") for (int q_ = 0; q_ < 4; ++q_) { const int bj = q_ >> 1, n = q_ & 1; \
                    const f32x4 xn = SRC[q_] + gt[bj][n] * acc[ai_][bj][m_][n]; \
                    *(f32x4*)(op + off + bj * 128 + n * 4) = xn; \
                    if (gnext) { ssq += xn[0] * xn[0] + xn[1] * xn[1] + xn[2] * xn[2] + xn[3] * xn[3]; const f32x4 y = xn * gn[bj][n]; \
                        u32x2 w; w.x = cvt_pk_bf16(y[0], y[1]); w.y = cvt_pk_bf16(y[2], y[3]); *(u32x2*)(xs + off + bj * 128 + n * 4) = w; } } \
                if (gnext) { ssq += __shfl_xor(ssq, 16); ssq += __shfl_xor(ssq, 32); if (fq == 0) unsafeAtomicAdd(rs + rl, ssq); } } while (0)
            RS_LOAD(0, bsA);
            RS_LOAD(1, bsB); RS_DO(0, bsA);
            RS_LOAD(2, bsA); RS_DO(1, bsB);
            RS_LOAD(3, bsB); RS_DO(2, bsA);
            RS_LOAD(4, bsA); RS_DO(3, bsB);
            RS_LOAD(5, bsB); RS_DO(4, bsA);
            RS_LOAD(6, bsA); RS_DO(5, bsB);
            RS_LOAD(7, bsB); RS_DO(6, bsA);
            RS_DO(7, bsB);
#undef RS_LOAD
#undef RS_DO
            return;
        } else {
        bf16_t* O = (bf16_t*)q0; float* lr = (float*)q1; bf16_t* KB = (bf16_t*)q0; bf16_t* VB = (bf16_t*)q1;
        const int rowt = u.pm * 256 + wr * 64 + fr;
        f32x4 swv[2][2]; float rsv[2][4];
        if constexpr (kind == EPI_GLA_IN || kind == EPI_BF16) {
            if (q3) { const LAS float* pw = xch + PREW_F + (wr * 4 + wc) * 192;
#pragma unroll
                for (int g = 0; g < 8; ++g) rsv[g >> 2][g & 3] = pw[g * 16 + fr];
#pragma unroll
                for (int bj = 0; bj < 2; ++bj) { swv[bj][0] = *(const LAS f32x4*)(pw + 128 + bj * 32 + 8 * fq); swv[bj][1] = *(const LAS f32x4*)(pw + 128 + bj * 32 + 8 * fq + 4); } }
        }
#pragma unroll
        for (int ai = 0; ai < 2; ++ai)
#pragma unroll
            for (int m = 0; m < 4; ++m) {
                const int row = rowt + ai * 128 + m * 16;
#pragma unroll
                for (int bj = 0; bj < 2; ++bj) {
                    f32x4 v0 = acc[ai][bj][m][0], v1 = acc[ai][bj][m][1];
                    const int cin = bj * 128 + wc * 32 + 8 * fq;
                    if constexpr (kind == EPI_GLA_IN || kind == EPI_BF16) {
                        if (q3) {
                            const float rstd = rsqrtf(rsv[ai][m] * (1.0f / 1024.0f) + 1e-6f);
                            v0 = v0 * rstd + swv[bj][0]; v1 = v1 * rstd + swv[bj][1];
                        }
                    }
                    if constexpr (kind == EPI_GLA_IN) {
                        if (u.pn == 12) {
                            if (bj == 0 && wc == 0) { float* lp = lr + (size_t)row * 32 + 8 * fq; *(f32x4*)lp = v0; *(f32x4*)(lp + 4) = v1; }
                            continue;
                        }
                        if (u.pn < 2) { v0 *= 0.08838834764831845f; v1 *= 0.08838834764831845f; }
                    }
                    u32x4 w; w.x = cvt_pk_bf16(v0[0], v0[1]); w.y = cvt_pk_bf16(v0[2], v0[3]); w.z = cvt_pk_bf16(v1[0], v1[1]); w.w = cvt_pk_bf16(v1[2], v1[3]);
                    if constexpr (kind == EPI_GLA_IN) {
                        if (u.pn < 4) *(u32x4*)(O + (size_t)row * 1024 + u.pn * 256 + cin) = w;
                        else *(u32x4*)((bf16_t*)q2 + (size_t)row * 2048 + (u.pn - 4) * 256 + cin) = w;
                    } else if constexpr (kind == EPI_UKV) {
                        int key;
                        if (u.pm < 256) { const int b = u.pm >> 4; key = b * KEYS + CTXL + (row - b * SEQ); }
                        else { const int b = u.pm - 256; key = b * KEYS + (row - TL - b * CTXL); }
                        const int cc = wc * 32 + 8 * fq;
                        if (bj == 0) *(u32x4*)(KB + (size_t)key * 1536 + u.pn * 192 + cc) = w;
                        else *(u32x4*)(VB + (size_t)key * 1024 + u.pn * 128 + cc) = w;
                    } else {
                        *(u32x4*)(O + (size_t)row * ldc + u.pn * 256 + cin) = w;
                    }
                }
            }
        }
    }
};

DI void prep_phase(const Params& p, LAS unsigned char* lds) {
    const int tid = tid_opq();
    unsigned char* ws = (unsigned char*)p.in[opq(27)];
    LAS float* tl = (LAS float*)lds;
    const float* in_c = p.in[opq(1)]; const float* in_cctx = p.in[opq(3)]; const float* in_wada = p.in[opq(4)]; const float* in_bada = p.in[opq(5)];
    const float* in_gin = p.in[opq(8)]; const float* in_w1 = p.in[opq(9)]; const float* in_gout = p.in[opq(13)]; const float* in_mdown = p.in[opq(14)];
    const float* in_uq = p.in[opq(17)]; const float* in_ukv = p.in[opq(18)]; const float* in_mout = p.in[opq(21)]; const float* in_fup = p.in[opq(22)]; const float* in_fdown = p.in[opq(25)];
    constexpr int T0 = 1536, T2 = 512, T3 = 352, T4 = 288, T5 = 256, T6 = 512, T7 = 5632, T8 = 2816;
    constexpr int NTILE = T0 + T2 + T3 + T4 + T5 + T6 + T7 + T8;
    for (int t = blockIdx.x; t < NTILE; t += gridDim.x) {
        const float* src; int N, k0, n0, ld; bf16_t* dst;
        int q = t;
        if (q < T0) { const int j = q / 768, r = q % 768, kt = r / 48, nt = r % 48; src = in_gin + (size_t)j * 1024 * 3072; N = 3072; k0 = kt * 64; n0 = nt * 64;
            dst = (bf16_t*)(ws + WS_GIN + j * SZ_GIN) + (size_t)n0 * 1024 + k0; ld = 1024; }
        else if ((q -= T0) < T2) { const int j = q / 256, r = q % 256, kt = r / 16, nt = r % 16; src = in_gout + (size_t)j * 1024 * 1024; N = 1024; k0 = kt * 64; n0 = nt * 64;
            dst = (bf16_t*)(ws + WS_GOUT + j * SZ_SQ) + (size_t)n0 * 1024 + k0; ld = 1024; }
        else if ((q -= T2) < T3) { const int j = q / 176, r = q % 176, kt = r / 11, nt = r % 11; src = in_mdown + (size_t)j * 1024 * 704; N = 704; k0 = kt * 64; n0 = nt * 64;
            dst = (bf16_t*)(ws + WS_MDOWN + j * SZ_MDOWN) + (size_t)n0 * 1024 + k0; ld = 1024; }
        else if ((q -= T3) < T4) { const int j = q / 144, r = q % 144, kt = r / 24, nt = r % 24; src = in_uq + (size_t)j * 384 * 1536; N = 1536; k0 = kt * 64; n0 = nt * 64;
            dst = (bf16_t*)(ws + WS_MUQ + j * SZ_MUQ) + (size_t)n0 * 384 + k0; ld = 384; }
        else if ((q -= T4) < T5) { const int j = q / 128, r = q % 128, kt = r / 32, nt = r % 32; src = in_ukv + (size_t)j * 256 * 2048; N = 2048; k0 = kt * 64; n0 = nt * 64;
            dst = (bf16_t*)(ws + WS_MUKV + j * SZ_MUKV) + (size_t)n0 * 256 + k0; ld = 256; }
        else if ((q -= T5) < T6) { const int j = q / 256, r = q % 256, kt = r / 16, nt = r % 16; src = in_mout + (size_t)j * 1024 * 1024; N = 1024; k0 = kt * 64; n0 = nt * 64;
            dst = (bf16_t*)(ws + WS_MOUT + j * SZ_SQ) + (size_t)n0 * 1024 + k0; ld = 1024; }
        else if ((q -= T6) < T7) { const int i = q / 1408, r = q % 1408, kt = r / 88, nt = r % 88; src = in_fup + (size_t)i * 1024 * 5632; N = 5632; k0 = kt * 64; n0 = nt * 64;
            const int isg = n0 >= DFF ? 1 : 0, cc = n0 - isg * DFF, drow = (cc >> 7) * 256 + isg * 128 + (cc & 127);
            dst = (bf16_t*)(ws + WS_FUP + (size_t)i * SZ_FUP) + (size_t)drow * 1024 + k0; ld = 1024; }
        else { q -= T7; const int i = q / 704, r = q % 704, kt = r / 16, nt = r % 16; src = in_fdown + (size_t)i * 2816 * 1024; N = 1024; k0 = kt * 64; n0 = nt * 64;
            dst = (bf16_t*)(ws + WS_FDOWN + (size_t)i * SZ_FDOWN) + (size_t)n0 * 2816 + k0; ld = 2816; }
#pragma unroll
        for (int i = 0; i < 8; ++i) { const int r = (tid >> 6) + 8 * i, c = tid & 63; tl[c * 65 + r] = src[(size_t)(k0 + r) * N + n0 + c]; }
        __syncthreads();
#pragma unroll
        for (int i = 0; i < 4; ++i) { const int rr = (tid >> 5) + 16 * i, c2 = (tid & 31) * 2; const float a = tl[rr * 65 + c2], b = tl[rr * 65 + c2 + 1];
            *(unsigned*)(dst + (size_t)rr * ld + c2) = cvt_pk_bf16(a, b); }
        __syncthreads();
    }
    const int gtid = blockIdx.x * NTHREADS + tid, gstride = gridDim.x * NTHREADS;
    for (int idx = gtid; idx < 65536; idx += gstride) {
        const int k = idx & 1023, r = (idx >> 10) & 15, dir = (idx >> 14) & 1, j = idx >> 15;
        const float v = in_w1[((size_t)(j * 2 + dir) * 1024 + k) * 16 + r];
        ((bf16_t*)(ws + WS_GIN + j * SZ_GIN))[(size_t)(3072 + dir * 16 + r) * 1024 + k] = f2bf(v);
    }
    for (int idx = gtid; idx < 2 * 114688; idx += gstride) { const int j = idx / 114688, o = idx % 114688; ((unsigned*)(ws + WS_GIN + j * SZ_GIN + 3104ull * 1024 * 2))[o] = 0u; }
    for (int idx = gtid; idx < 2 * 32768; idx += gstride) { const int j = idx / 32768, o = idx % 32768; ((unsigned*)(ws + WS_MDOWN + j * SZ_MDOWN + 704ull * 1024 * 2))[o] = 0u; }
    for (int idx = gtid; idx < MR; idx += gstride) ((float*)(ws + WS_RS))[idx] = 0.f;
    LAS float* sl = (LAS float*)lds;
    LAS float* red = (LAS float*)(lds + 81920);
    __syncthreads();
    for (int idx = tid; idx < 17 * 1024; idx += NTHREADS) { const int r = idx >> 10, k = idx & 1023; const float v = r < 16 ? in_c[r * 1024 + k] : in_cctx[k]; sl[k * 20 + r] = v / (1.0f + __expf(-v)); }
    __syncthreads();
    float* mod = (float*)(ws + WS_MOD);
    for (int it = blockIdx.x; it < 384; it += gridDim.x) {
        const int layer = it / 96, n0 = (it % 96) * 64, nn = tid & 63, ks = tid >> 6;
        const float* W = in_wada + (size_t)layer * 1024 * 6144 + n0 + nn;
        float acc[17];
#pragma unroll
        for (int r = 0; r < 17; ++r) acc[r] = 0.f;
        for (int kk = 0; kk < 128; ++kk) {
            const int k = ks * 128 + kk; const float w = W[(size_t)k * 6144];
            const f32x4 s0 = *(const LAS f32x4*)(sl + k * 20), s1 = *(const LAS f32x4*)(sl + k * 20 + 4), s2 = *(const LAS f32x4*)(sl + k * 20 + 8), s3 = *(const LAS f32x4*)(sl + k * 20 + 12);
            const float s16 = sl[k * 20 + 16];
#pragma unroll
            for (int j = 0; j < 4; ++j) { acc[j] += s0[j] * w; acc[4 + j] += s1[j] * w; acc[8 + j] += s2[j] * w; acc[12 + j] += s3[j] * w; }
            acc[16] += s16 * w;
        }
#pragma unroll
        for (int r = 0; r < 17; ++r) red[(ks * 17 + r) * 64 + nn] = acc[r];
        __syncthreads();
        for (int o = tid; o < 17 * 64; o += NTHREADS) { const int r = o >> 6, c = o & 63; float s = in_bada[layer * 6144 + n0 + c];
#pragma unroll
            for (int k8 = 0; k8 < 8; ++k8) s += red[(k8 * 17 + r) * 64 + c];
            mod[(size_t)(layer * 17 + r) * 6144 + n0 + c] = s; }
        __syncthreads();
    }
}

DI void shw_phase(unsigned char* ws, LAS unsigned char* lds) {
    const int tid = tid_opq(), wave = tid >> 6, lane = tid & 63;
    LAS float* sl = (LAS float*)lds;
    const float* mod = (const float*)(ws + WS_MOD);
    constexpr int NCH = 4 * 44 + 6 + 26 + 6;
    for (int ch = blockIdx.x; ch < NCH; ch += gridDim.x) {
        int layer, kind, n0; const bf16_t* Bt;
        if (ch < 176) { layer = ch / 44; kind = 1; n0 = (ch % 44) * 128; Bt = (const bf16_t*)(ws + WS_FUP + (size_t)layer * SZ_FUP); }
        else if (ch < 182) { layer = 1; kind = 0; n0 = (ch - 176) * 128; Bt = (const bf16_t*)(ws + WS_MDOWN); }
        else if (ch < 208) { layer = 2; kind = 0; n0 = (ch - 182) * 128; Bt = (const bf16_t*)(ws + WS_GIN + SZ_GIN); }
        else { layer = 3; kind = 0; n0 = (ch - 208) * 128; Bt = (const bf16_t*)(ws + WS_MDOWN + SZ_MDOWN); }
        __syncthreads();
        for (int idx = tid; idx < 17 * 256; idx += NTHREADS) { const int b = idx >> 8, k4 = (idx & 255) * 4;
            *(LAS f32x4*)(sl + b * 1024 + k4) = *(const f32x4*)(mod + (size_t)(layer * 17 + b) * 6144 + (kind ? 3 * 1024 : 0) + k4); }
        __syncthreads();
        float* out = (float*)(ws + WS_SHW) + (size_t)((layer * 2 + kind) * 17) * 5632;
#pragma unroll 1
        for (int i = 0; i < 16; ++i) {
            const int n = n0 + wave * 16 + i;
            float w[16];
#pragma unroll
            for (int j = 0; j < 4; ++j) { const u32x2 t = *(const u32x2*)(Bt + (size_t)n * 1024 + j * 256 + lane * 4); w[4 * j] = bf_lo(t.x); w[4 * j + 1] = bf_hi(t.x); w[4 * j + 2] = bf_lo(t.y); w[4 * j + 3] = bf_hi(t.y); }
            float mine = 0.f;
#pragma unroll 1
            for (int b = 0; b < 17; ++b) {
                float a = 0.f;
#pragma unroll
                for (int j = 0; j < 4; ++j) { const f32x4 sv = *(const LAS f32x4*)(sl + b * 1024 + j * 256 + lane * 4); a += sv[0] * w[4 * j] + sv[1] * w[4 * j + 1] + sv[2] * w[4 * j + 2] + sv[3] * w[4 * j + 3]; }
                a = wave_sum(a);
                if (lane == b) mine = a;
            }
            if (lane < 17) out[(size_t)lane * 5632 + n] = mine;
        }
    }
    __syncthreads();
}

DI void norm_phase(const float* xl, const float* xc, const float* gain, const float* modl, int sh_off, int sc_off, bf16_t* h) {
    const int tid = tid_opq(), wave = tid >> 6, lane = tid & 63;
    for (int row0 = (blockIdx.x * 8 + wave) * 4; row0 < MR; row0 += gridDim.x * 32) {
        const float* src = row0 < TL ? xl + (size_t)row0 * 1024 : xc + (size_t)(row0 - TL) * 1024;
        const float* mb = modl + (size_t)(row0 < TL ? (row0 >> 12) : 16) * 6144;
        f32x4 v[4][4]; float ss[4];
#pragma unroll
        for (int r = 0; r < 4; ++r)
#pragma unroll
            for (int i = 0; i < 4; ++i) v[r][i] = *(const f32x4*)(src + (size_t)r * 1024 + i * 256 + lane * 4);
#pragma unroll
        for (int r = 0; r < 4; ++r) { float t = 0.f;
#pragma unroll
            for (int i = 0; i < 4; ++i) t += v[r][i][0] * v[r][i][0] + v[r][i][1] * v[r][i][1] + v[r][i][2] * v[r][i][2] + v[r][i][3] * v[r][i][3];
            ss[r] = t; }
#pragma unroll
        for (int o = 32; o >= 1; o >>= 1) {
#pragma unroll
            for (int r = 0; r < 4; ++r) ss[r] += __shfl_xor(ss[r], o);
        }
#pragma unroll
        for (int i = 0; i < 4; ++i) {
            const int c = i * 256 + lane * 4;
            const f32x4 g = *(const f32x4*)(gain + c), sc = *(const f32x4*)(mb + sc_off + c), sh = *(const f32x4*)(mb + sh_off + c);
            const f32x4 gs = g * (sc + 1.0f);
#pragma unroll
            for (int r = 0; r < 4; ++r) {
                const float rstd = rsqrtf(ss[r] * (1.0f / 1024.0f) + 1e-6f);
                const f32x4 y = (v[r][i] * rstd) * gs + sh;
                u32x2 w; w.x = cvt_pk_bf16(y[0], y[1]); w.y = cvt_pk_bf16(y[2], y[3]);
                *(u32x2*)(h + (size_t)(row0 + r) * 1024 + c) = w;
            }
        }
    }
}

DI void scan_rowbase(int dir, int b, int c, int& rb, int& sg) {
    if (dir == 0) { sg = 1; rb = c < 4 ? TL + b * CTXL + c * 64 : b * SEQ + (c - 4) * 64; }
    else { sg = -1; rb = c < 4 ? TL + b * CTXL + 255 - c * 64 : b * SEQ + 4095 - (c - 4) * 64; }
}
struct GPStage { unsigned qv[8], kv[8]; f32x4 lrv; float w2r[16][2]; f32x2 gbias; };
DI void gp_load(GPStage& S, int item, const bf16_t* qk, const float* lr, const float* w2, const float* gb, int tid, int wave, int d0) {
    const int c = item % 68, rest = item / 68, h = rest & 3, dir = (rest >> 2) & 1, b = rest >> 3;
    int rowbase, sgn; scan_rowbase(dir, b, c, rowbase, sgn);
#pragma unroll
    for (int i = 0; i < 8; ++i) { const size_t ro = (size_t)(rowbase + sgn * (wave * 8 + i)) * 1024; S.qv[i] = *(const unsigned*)(qk + ro + h * 128 + d0); S.kv[i] = *(const unsigned*)(qk + ro + 512 + h * 128 + d0); }
    S.lrv = (f32x4){0.f, 0.f, 0.f, 0.f};
    if (tid < 256) S.lrv = *(const f32x4*)(lr + (size_t)(rowbase + sgn * (tid >> 2)) * 32 + dir * 16 + (tid & 3) * 4);
#pragma unroll
    for (int r = 0; r < 16; ++r) { const f32x2 t = *(const f32x2*)(w2 + (size_t)(dir * 16 + r) * 512 + h * 128 + d0); S.w2r[r][0] = t.x; S.w2r[r][1] = t.y; }
    S.gbias = *(const f32x2*)(gb + dir * 512 + h * 128 + d0);
}
DI void gp_item(const GPStage& S, int item, bf16_t* GQ, bf16_t* GK, bf16_t* GP, float* GE, LAS unsigned char* lds, int tid, int wave, int lane) {
    constexpr int QD = 0, KI = 17408, LRS = 34816, SEG = 38912;
    const int l15 = lane & 15, lq = lane >> 4, d0 = 2 * lane;
    if (tid < 256) *(LAS f32x4*)(lds + LRS + (tid >> 2) * 64 + (tid & 3) * 16) = S.lrv;
    __syncthreads();
    const LAS float* lrs = (const LAS float*)(lds + LRS);
    float bl0[8], bl1[8]; float cum0 = 0.f, cum1 = 0.f;
#pragma unroll
    for (int i = 0; i < 8; ++i) {
        const int s = wave * 8 + i;
        float z0 = S.gbias.x, z1 = S.gbias.y;
#pragma unroll
        for (int r4 = 0; r4 < 4; ++r4) { const f32x4 lv = *(const LAS f32x4*)(lrs + s * 16 + r4 * 4);
#pragma unroll
            for (int j = 0; j < 4; ++j) { z0 += lv[j] * S.w2r[r4 * 4 + j][0]; z1 += lv[j] * S.w2r[r4 * 4 + j][1]; } }
        const float g0 = (fminf(z0, 0.f) - __logf(1.0f + __expf(-fabsf(z0)))) * 0.0625f;
        const float g1 = (fminf(z1, 0.f) - __logf(1.0f + __expf(-fabsf(z1)))) * 0.0625f;
        cum0 += g0; cum1 += g1; bl0[i] = cum0; bl1[i] = cum1;
    }
    *(LAS f32x2*)(lds + SEG + (wave * 128 + d0) * 4) = (f32x2){cum0, cum1};
    __syncthreads();
    float off0 = 0.f, off1 = 0.f, tot0 = 0.f, tot1 = 0.f;
#pragma unroll
    for (int w = 0; w < 8; ++w) { const f32x2 t = *(const LAS f32x2*)(lds + SEG + (w * 128 + d0) * 4); tot0 += t.x; tot1 += t.y; if (w < wave) { off0 += t.x; off1 += t.y; } }
    const float et0 = __expf(tot0), et1 = __expf(tot1);
    if (wave == 0) *(f32x2*)(GE + (size_t)item * 128 + d0) = (f32x2){et0, et1};
    {
        unsigned ks0[4], ks1[4];
        bf16_t* gq = GQ + (size_t)item * 8192;
#pragma unroll
        for (int i = 0; i < 8; ++i) {
            const int s = wave * 8 + i;
            const float b0 = off0 + bl0[i], b1 = off1 + bl1[i];
            const float q0 = bf_lo(S.qv[i]), q1 = bf_hi(S.qv[i]), k0 = bf_lo(S.kv[i]), k1 = bf_hi(S.kv[i]);
            const float eb0 = __expf(b0), eb1 = __expf(b1), ib0 = __builtin_amdgcn_rcpf(eb0), ib1 = __builtin_amdgcn_rcpf(eb1);
            const unsigned qd = cvt_pk_bf16(q0 * eb0, q1 * eb1);
            *(LAS unsigned*)(lds + QD + s * 272 + d0 * 2) = qd;
            *(unsigned*)(gq + s * 128 + d0) = qd;
            *(LAS unsigned*)(lds + KI + s * 272 + d0 * 2) = cvt_pk_bf16(k0 * ib0, k1 * ib1);
            const float e0 = k0 * (et0 * ib0), e1 = k1 * (et1 * ib1);
            if (i & 1) { ks0[i >> 1] = (ks0[i >> 1] & 0xffffu) | (cvt_pk_bf16(0.f, e0) & 0xffff0000u); ks1[i >> 1] = (ks1[i >> 1] & 0xffffu) | (cvt_pk_bf16(0.f, e1) & 0xffff0000u); }
            else { ks0[i >> 1] = cvt_pk_bf16(e0, 0.f) & 0xffffu; ks1[i >> 1] = cvt_pk_bf16(e1, 0.f) & 0xffffu; }
        }
        bf16_t* gk = GK + (size_t)item * 8192;
        *(u32x4*)(gk + d0 * 64 + wave * 8) = (u32x4){ks0[0], ks0[1], ks0[2], ks0[3]};
        *(u32x4*)(gk + (d0 + 1) * 64 + wave * 8) = (u32x4){ks1[0], ks1[1], ks1[2], ks1[3]};
    }
    __syncthreads();
    {
        bf16_t* gp = GP + (size_t)item * 4096;
        const int t0 = 16 * (wave >> 1);
#pragma unroll
        for (int j = 0; j < 2; ++j) {
            const int s0 = 16 * ((wave & 1) * 2 + j);
            f32x4 a4 = (f32x4){0.f, 0.f, 0.f, 0.f};
#pragma unroll
            for (int kk = 0; kk < 4; ++kk) {
                const bf16x8 af = *(const LAS bf16x8*)(lds + QD + (t0 + l15) * 272 + (kk * 32 + 8 * lq) * 2);
                const bf16x8 bf = *(const LAS bf16x8*)(lds + KI + (s0 + l15) * 272 + (kk * 32 + 8 * lq) * 2);
                a4 = __builtin_amdgcn_mfma_f32_16x16x32_bf16(af, bf, a4, 0, 0, 0);
            }
            const int sc = s0 + l15;
#pragma unroll
            for (int r = 0; r < 4; ++r) { const int t = t0 + 4 * lq + r; gp[t * 64 + sc] = f2bf(sc <= t ? a4[r] : 0.f); }
        }
    }
}
DI void gateprep_phase(const bf16_t* qk, const float* lr, const float* w2, const float* gb, bf16_t* GQ, bf16_t* GK, bf16_t* GP, float* GE, LAS unsigned char* lds) {
    const int tid = tid_opq(), wave = __builtin_amdgcn_readfirstlane(tid >> 6), lane = tid & 63, d0 = 2 * lane;
    const int G = gridDim.x;
    GPStage A, B;
    int item = opq((int)blockIdx.x);
    if (item < NCHI) gp_load(A, item, qk, lr, w2, gb, tid, wave, d0);
    for (; item < NCHI; item += 2 * G) {
        if (item + G < NCHI) gp_load(B, item + G, qk, lr, w2, gb, tid, wave, d0);
        gp_item(A, item, GQ, GK, GP, GE, lds, tid, wave, lane);
        if (item + G < NCHI) {
            if (item + 2 * G < NCHI) gp_load(A, item + 2 * G, qk, lr, w2, gb, tid, wave, d0);
            gp_item(B, item + G, GQ, GK, GP, GE, lds, tid, wave, lane);
        }
    }
    __syncthreads();
}

DI void scan_phase(const bf16_t* vr, const bf16_t* GQ, const bf16_t* GK, const bf16_t* GP, const float* GE, bf16_t* of, bf16_t* ob, LAS unsigned char* lds) {
    constexpr int QD = 0, KST = 17408, VT = 35840, ST = 54272, PP = 89088, BL = 98304;
    const int tid = tid_opq(), wave = __builtin_amdgcn_readfirstlane(tid >> 6), lane = tid & 63;
    const int l31 = lane & 31, lh = lane >> 5;
    for (int item = blockIdx.x; item < 256; item += gridDim.x) {
        const int xcd_ = item & 7, slot_ = item >> 3, dvh = slot_ & 1, pair_ = (slot_ >> 1) * 8 + xcd_;
        const int b = pair_ >> 3, dir = (pair_ >> 2) & 1, h = pair_ & 3;
        bf16_t* obuf = dir ? ob : of;
        const int d0 = 2 * lane;
        const int gi0 = ((b * 2 + dir) * 4 + h) * 68;
        f32x16 Sacc[2];
#pragma unroll
        for (int i = 0; i < 16; ++i) { Sacc[0][i] = 0.f; Sacc[1][i] = 0.f; }
        __syncthreads();
        { unsigned z_ = 0u; asm volatile("" : "+v"(z_));
          for (int o = tid; o < 34816 / 16; o += NTHREADS) *(LAS u32x4*)(lds + ST + o * 16) = (u32x4){z_, z_, z_, z_}; }
        const int vcol = h * 256 + dvh * 128 + d0;
        struct ScStage { u32x4 gq0, gq1, gk0, gk1, gp0; unsigned vv[8]; float ebv; } A, B;
        A.ebv = 0.f; B.ebv = 0.f;
#define SCAN_LOAD(S, c) do { int rb_, sg_; scan_rowbase(dir, b, (c), rb_, sg_); const size_t gi_ = (size_t)(gi0 + (c)); \
        S.gq0 = *(const u32x4*)(GQ + gi_ * 8192 + tid * 8); S.gq1 = *(const u32x4*)(GQ + gi_ * 8192 + 4096 + tid * 8); \
        S.gk0 = *(const u32x4*)(GK + gi_ * 8192 + tid * 8); S.gk1 = *(const u32x4*)(GK + gi_ * 8192 + 4096 + tid * 8); \
        S.gp0 = *(const u32x4*)(GP + gi_ * 4096 + tid * 8); if (tid < 128) S.ebv = GE[gi_ * 128 + tid]; \
        _Pragma("unroll") for (int i = 0; i < 8; ++i) S.vv[i] = *(const unsigned*)(vr + (size_t)(rb_ + sg_ * (wave * 8 + i)) * 2048 + vcol); } while (0)
#define SCAN_CHUNK(S, c) do { \
            int rowbase, sgn; scan_rowbase(dir, b, (c), rowbase, sgn); \
            { const int e0 = tid * 8, e1 = 4096 + tid * 8; \
              *(LAS u32x4*)(lds + QD + (e0 >> 7) * 272 + (e0 & 127) * 2) = S.gq0; *(LAS u32x4*)(lds + QD + (e1 >> 7) * 272 + (e1 & 127) * 2) = S.gq1; \
              *(LAS u32x4*)(lds + KST + (e0 >> 6) * 144 + (e0 & 63) * 2) = S.gk0; *(LAS u32x4*)(lds + KST + (e1 >> 6) * 144 + (e1 & 63) * 2) = S.gk1; \
              *(LAS u32x4*)(lds + PP + (e0 >> 6) * 144 + (e0 & 63) * 2) = S.gp0; \
              if (tid < 128) *(LAS float*)(lds + BL + tid * 4) = S.ebv; \
              unsigned vt0[4], vt1[4]; \
              _Pragma("unroll") for (int i = 0; i < 8; ++i) { \
                  if (i & 1) { vt0[i >> 1] = (vt0[i >> 1] & 0xffffu) | (S.vv[i] << 16); vt1[i >> 1] = (vt1[i >> 1] & 0xffffu) | (S.vv[i] & 0xffff0000u); } \
                  else { vt0[i >> 1] = S.vv[i] & 0xffffu; vt1[i >> 1] = S.vv[i] >> 16; } } \
              *(LAS u32x4*)(lds + VT + d0 * 144 + wave * 16) = (u32x4){vt0[0], vt0[1], vt0[2], vt0[3]}; \
              *(LAS u32x4*)(lds + VT + (d0 + 1) * 144 + wave * 16) = (u32x4){vt1[0], vt1[1], vt1[2], vt1[3]}; \
            } \
            __syncthreads();     \
            if ((c) + 2 < 68) SCAN_LOAD(S, (c) + 2); \
            { \
                const int tq = wave >> 2, vq = wave & 3; \
                f32x16 oacc; \
                _Pragma("unroll") for (int i = 0; i < 16; ++i) oacc[i] = 0.f; \
                _Pragma("unroll") for (int kk = 0; kk < 8; ++kk) { \
                    const bf16x8 af = *(const LAS bf16x8*)(lds + QD + (32 * tq + l31) * 272 + (kk * 16 + 8 * lh) * 2); \
                    const bf16x8 bf = *(const LAS bf16x8*)(lds + ST + (32 * vq + l31) * 272 + (kk * 16 + 8 * lh) * 2); \
                    oacc = __builtin_amdgcn_mfma_f32_32x32x16_bf16(af, bf, oacc, 0, 0, 0); } \
                _Pragma("unroll") for (int kk = 0; kk < 4; ++kk) { \
                    const bf16x8 af = *(const LAS bf16x8*)(lds + PP + (32 * tq + l31) * 144 + (kk * 16 + 8 * lh) * 2); \
                    const bf16x8 bf = *(const LAS bf16x8*)(lds + VT + (32 * vq + l31) * 144 + (kk * 16 + 8 * lh) * 2); \
                    oacc = __builtin_amdgcn_mfma_f32_32x32x16_bf16(af, bf, oacc, 0, 0, 0); } \
                const int ocol = h * 256 + dvh * 128 + 32 * vq + l31; \
                _Pragma("unroll") for (int r = 0; r < 16; ++r) { const int t = 32 * tq + crow(r, lh); obuf[(size_t)(rowbase + sgn * t) * 1024 + ocol] = f2bf(oacc[r]); } \
            } \
            { \
                const int vq = wave & 3; \
                _Pragma("unroll") for (int j = 0; j < 2; ++j) { \
                    const int dq = 2 * (wave >> 2) + j; \
                    _Pragma("unroll") for (int r = 0; r < 16; ++r) Sacc[j][r] *= *(const LAS float*)(lds + BL + (32 * dq + crow(r, lh)) * 4); \
                    _Pragma("unroll") for (int kk = 0; kk < 4; ++kk) { \
                        const bf16x8 af = *(const LAS bf16x8*)(lds + KST + (32 * dq + l31) * 144 + (kk * 16 + 8 * lh) * 2); \
                        const bf16x8 bf = *(const LAS bf16x8*)(lds + VT + (32 * vq + l31) * 144 + (kk * 16 + 8 * lh) * 2); \
                        Sacc[j] = __builtin_amdgcn_mfma_f32_32x32x16_bf16(af, bf, Sacc[j], 0, 0, 0); } } \
            } \
            __syncthreads();     \
            { \
                const int vq = wave & 3; \
                _Pragma("unroll") for (int j = 0; j < 2; ++j) { \
                    const int dq = 2 * (wave >> 2) + j; \
                    _Pragma("unroll") for (int g = 0; g < 4; ++g) { \
                        u32x2 w; w.x = cvt_pk_bf16(Sacc[j][4 * g], Sacc[j][4 * g + 1]); w.y = cvt_pk_bf16(Sacc[j][4 * g + 2], Sacc[j][4 * g + 3]); \
                        *(LAS u32x2*)(lds + ST + (32 * vq + l31) * 272 + (32 * dq + 8 * g + 4 * lh) * 2) = w; } } \
            } } while (0)
        SCAN_LOAD(A, 0); SCAN_LOAD(B, 1);
        for (int c = 0; c < 68; c += 2) { SCAN_CHUNK(A, c); SCAN_CHUNK(B, c + 1); }
#undef SCAN_CHUNK
#undef SCAN_LOAD
    }
    __syncthreads();
}

DI void glapost_phase(const bf16_t* of, const bf16_t* ob, const bf16_t* vr, const float* onorm, bf16_t* a) {
    const int tid = tid_opq(), wave = tid >> 6, lane = tid & 63;
    const int c0 = lane * 16;
    float gn[16];
#pragma unroll
    for (int j = 0; j < 4; ++j) { const f32x4 t = *(const f32x4*)(onorm + (c0 & 255) + 4 * j); gn[4 * j] = t[0]; gn[4 * j + 1] = t[1]; gn[4 * j + 2] = t[2]; gn[4 * j + 3] = t[3]; }
    for (int row0 = (blockIdx.x * 8 + wave) * 4; row0 < MR; row0 += gridDim.x * 32) {
        u32x4 f0[4], f1[4], b0[4], b1[4], r0[4], r1[4];
#pragma unroll
        for (int q = 0; q < 4; ++q) { const size_t ro = (size_t)(row0 + q);
            f0[q] = *(const u32x4*)(of + ro * 1024 + c0); f1[q] = *(const u32x4*)(of + ro * 1024 + c0 + 8);
            b0[q] = *(const u32x4*)(ob + ro * 1024 + c0); b1[q] = *(const u32x4*)(ob + ro * 1024 + c0 + 8);
            r0[q] = *(const u32x4*)(vr + ro * 2048 + 1024 + c0); r1[q] = *(const u32x4*)(vr + ro * 2048 + 1024 + c0 + 8); }
        asm volatile("" ::: "memory");
#pragma unroll
        for (int q = 0; q < 4; ++q) {
            float o[16], rr[16];
#pragma unroll
            for (int j = 0; j < 4; ++j) {
                o[2 * j] = bf_lo(f0[q][j]) + bf_lo(b0[q][j]); o[2 * j + 1] = bf_hi(f0[q][j]) + bf_hi(b0[q][j]);
                o[8 + 2 * j] = bf_lo(f1[q][j]) + bf_lo(b1[q][j]); o[8 + 2 * j + 1] = bf_hi(f1[q][j]) + bf_hi(b1[q][j]);
                rr[2 * j] = bf_lo(r0[q][j]); rr[2 * j + 1] = bf_hi(r0[q][j]); rr[8 + 2 * j] = bf_lo(r1[q][j]); rr[8 + 2 * j + 1] = bf_hi(r1[q][j]);
            }
            float ss = 0.f;
#pragma unroll
            for (int j = 0; j < 16; ++j) ss += o[j] * o[j];
            ss += __shfl_xor(ss, 1); ss += __shfl_xor(ss, 2); ss += __shfl_xor(ss, 4); ss += __shfl_xor(ss, 8);
            const float rstd = rsqrtf(ss * (1.0f / 256.0f) + 1e-6f);
            unsigned w[8];
#pragma unroll
            for (int j = 0; j < 8; ++j) {
                const float y0 = o[2 * j] * rstd * gn[2 * j] * silu_f(rr[2 * j]), y1 = o[2 * j + 1] * rstd * gn[2 * j + 1] * silu_f(rr[2 * j + 1]);
                w[j] = cvt_pk_bf16(y0, y1);
            }
            *(u32x4*)(a + (size_t)(row0 + q) * 1024 + c0) = (u32x4){w[0], w[1], w[2], w[3]};
            *(u32x4*)(a + (size_t)(row0 + q) * 1024 + c0 + 8) = (u32x4){w[4], w[5], w[6], w[7]};
        }
    }
}

DI void rope_cs(int tpos, int lane, float& cs, float& sn) {
    const int f = lane & 15; const int pos = (lane >> 5) ? (tpos & 63) : (tpos >> 6);
    const float inv = exp2f(-(float)f * (13.287712379549449f / 16.0f));
    const float ang = (float)pos * inv;
    const float kf = rintf(ang * 0.15915494309189535f);
    float r = fmaf(-kf, 6.2831854820251465f, ang); r = fmaf(-kf, -1.7484556000744883e-7f, r);
    cs = __cosf(r); sn = __sinf(r);
}
DI float rope_apply(float y, int lane, float cs, float sn) {
    const float pr = __shfl_xor(y, 16);
    return (lane & 16) ? (pr * sn + y * cs) : (y * cs - pr * sn);
}
DI int key_of_row(int row) {
    if (row < TL) { const int b = row >> 12; return b * KEYS + CTXL + (row & 4095); }
    const int rc = row - TL; const int b = rc >> 8; return b * KEYS + (rc & 255);
}

DI void mlamid_phase(const bf16_t* dn, const float* qln, const float* kvln, const float* knorm, bf16_t* cqn, bf16_t* ckvn, bf16_t* KB) {
    const int tid = tid_opq(), wave = tid >> 6, lane = tid & 63;
    float gq[6];
#pragma unroll
    for (int i = 0; i < 3; ++i) { gq[2 * i] = qln[i * 128 + 2 * lane]; gq[2 * i + 1] = qln[i * 128 + 2 * lane + 1]; }
    const f32x4 gkv = *(const f32x4*)(kvln + 4 * lane);
    const float gpe = knorm[128 + lane];
    for (int row0 = (blockIdx.x * 8 + wave) * 4; row0 < MR; row0 += gridDim.x * 32) {
        unsigned q[4][3]; u32x2 kvv[4]; bf16_t pe[4];
#pragma unroll
        for (int r = 0; r < 4; ++r) { const bf16_t* src = dn + (size_t)(row0 + r) * 768;
#pragma unroll
            for (int i = 0; i < 3; ++i) q[r][i] = *(const unsigned*)(src + i * 128 + 2 * lane);
            kvv[r] = *(const u32x2*)(src + 384 + 4 * lane); pe[r] = src[640 + lane]; }
#pragma unroll
        for (int r = 0; r < 4; ++r) {
            const int row = row0 + r;
            float ss = 0.f;
#pragma unroll
            for (int i = 0; i < 3; ++i) { const float a = bf_lo(q[r][i]), b = bf_hi(q[r][i]); ss += a * a + b * b; }
            ss = wave_sum(ss);
            float rstd = rsqrtf(ss * (1.0f / 384.0f) + 1e-6f);
#pragma unroll
            for (int i = 0; i < 3; ++i) *(unsigned*)(cqn + (size_t)row * 384 + i * 128 + 2 * lane) = cvt_pk_bf16(bf_lo(q[r][i]) * rstd * gq[2 * i], bf_hi(q[r][i]) * rstd * gq[2 * i + 1]);
            const float k0 = bf_lo(kvv[r].x), k1 = bf_hi(kvv[r].x), k2 = bf_lo(kvv[r].y), k3 = bf_hi(kvv[r].y);
            ss = wave_sum(k0 * k0 + k1 * k1 + k2 * k2 + k3 * k3);
            rstd = rsqrtf(ss * (1.0f / 256.0f) + 1e-6f);
            { u32x2 w; w.x = cvt_pk_bf16(k0 * rstd * gkv[0], k1 * rstd * gkv[1]); w.y = cvt_pk_bf16(k2 * rstd * gkv[2], k3 * rstd * gkv[3]);
              *(u32x2*)(ckvn + (size_t)row * 256 + 4 * lane) = w; }
            const float x = __uint_as_float(((unsigned)pe[r]) << 16);
            ss = wave_sum(x * x);
            rstd = rsqrtf(ss * (1.0f / 64.0f) + 1e-6f);
            float y = x * rstd * gpe;
            if (row < TL) { float cs, sn; rope_cs(row & 4095, lane, cs, sn); y = rope_apply(y, lane, cs, sn); }
            const bf16_t yb = f2bf(y);
            bf16_t* kd = KB + (size_t)key_of_row(row) * 1536 + 128 + lane;
#pragma unroll
            for (int hh = 0; hh < 8; ++hh) kd[hh * 192] = yb;
        }
    }
}

DI void qkprep_phase(bf16_t* Q, bf16_t* KB, const float* qnorm, const float* knorm) {
    const int tid = tid_opq(), wave = tid >> 6, lane = tid & 63;
    const float qn0 = qnorm[2 * lane], qn1 = qnorm[2 * lane + 1], qnr = qnorm[128 + lane];
    const float kn0 = knorm[2 * lane], kn1 = knorm[2 * lane + 1];
    for (int row = blockIdx.x * 8 + wave; row < MR; row += gridDim.x * 8) {
        float cs = 1.f, sn = 0.f;
        const bool lat = row < TL;
        if (lat) rope_cs(row & 4095, lane, cs, sn);
        bf16_t* qr = Q + (size_t)row * 1536;
        bf16_t* kr = KB + (size_t)key_of_row(row) * 1536;
        unsigned qa[8], ka[8]; bf16_t xq[8];
#pragma unroll
        for (int hh = 0; hh < 8; ++hh) { qa[hh] = *(const unsigned*)(qr + hh * 192 + 2 * lane); xq[hh] = qr[hh * 192 + 128 + lane]; ka[hh] = *(const unsigned*)(kr + hh * 192 + 2 * lane); }
        asm volatile("" ::: "memory");
#pragma unroll
        for (int hh = 0; hh < 8; ++hh) {
            const float xr = __uint_as_float(((unsigned)xq[hh]) << 16);
            const float a0 = bf_lo(qa[hh]), a1 = bf_hi(qa[hh]), c0 = bf_lo(ka[hh]), c1 = bf_hi(ka[hh]);
            const float s1 = wave_sum(a0 * a0 + a1 * a1), s2 = wave_sum(xr * xr), s3 = wave_sum(c0 * c0 + c1 * c1);
            const float r1 = rsqrtf(s1 * (1.0f / 128.0f) + 1e-6f), r2 = rsqrtf(s2 * (1.0f / 64.0f) + 1e-6f), r3 = rsqrtf(s3 * (1.0f / 128.0f) + 1e-6f);
            *(unsigned*)(qr + hh * 192 + 2 * lane) = cvt_pk_bf16(a0 * r1 * qn0, a1 * r1 * qn1);
            float y = xr * r2 * qnr;
            if (lat) y = rope_apply(y, lane, cs, sn);
            qr[hh * 192 + 128 + lane] = f2bf(y);
            *(unsigned*)(kr + hh * 192 + 2 * lane) = cvt_pk_bf16(c0 * r3 * kn0, c1 * r3 * kn1);
        }
    }
}

namespace att {
constexpr int DQK = 192, DV = 128, NW = 8, QBLK = 32, KVBLK = 64;
constexpr int LDQ = 1536, LDK = 1536, LDV = 1024, LDO = 1024;
constexpr float SCALE = 0.07216878364870322f;
constexpr float THR = 8.f;
constexpr size_t SHM_V = KVBLK * DV * 2, SHM_K = KVBLK * DQK * 2;
#define KSWZ(row, colB) ((row) * 384 + ((colB) ^ ((((row) >> 1) & 7) << 4)))
#define SBAR() __builtin_amdgcn_sched_barrier(0)
DI unsigned cvtpk(float lo, float hi) { unsigned r; asm volatile("v_cvt_pk_bf16_f32 %0, %1, %2" : "=v"(r) : "v"(lo), "v"(hi)); return r; }
DI void partialSM(f32x16& p0, f32x16& p1, float& m_reg, float& mn, float& alpha) {
    constexpr float C = SCALE * 1.4426950408889634f;
    float pmax = p0[0];
#pragma unroll
    for (int r = 1; r < 16; ++r) pmax = fmaxf(pmax, p0[r]);
#pragma unroll
    for (int r = 0; r < 16; ++r) pmax = fmaxf(pmax, p1[r]);
    { auto rr = __builtin_amdgcn_permlane32_swap(__float_as_uint(pmax), __float_as_uint(pmax), false, false);
      pmax = fmaxf(__uint_as_float(rr[0]), __uint_as_float(rr[1])); }
    if (__builtin_expect(__all(pmax - m_reg <= THR / SCALE), 1)) { mn = m_reg; alpha = 1.f; }
    else { mn = fmaxf(m_reg, pmax); alpha = __builtin_amdgcn_exp2f((m_reg - mn) * C); m_reg = mn; }
    const float mnC = -mn * C;
#pragma unroll
    for (int r = 0; r < 16; ++r) p0[r] = fmaf(p0[r], C, mnC);
#pragma unroll
    for (int r = 0; r < 16; ++r) p1[r] = fmaf(p1[r], C, mnC);
#pragma unroll
    for (int r = 0; r < 16; ++r) p0[r] = __builtin_amdgcn_exp2f(p0[r]);
}
DI void finishSM(f32x16& p0, f32x16& p1, float alpha, float& l_reg, bf16x8& pa0, bf16x8& pa1, bf16x8& pa2, bf16x8& pa3) {
#pragma unroll
    for (int r = 0; r < 16; ++r) p1[r] = __builtin_amdgcn_exp2f(p1[r]);
    float ps = 0;
#pragma unroll
    for (int r = 0; r < 16; ++r) ps += p0[r];
#pragma unroll
    for (int r = 0; r < 16; ++r) ps += p1[r];
    { auto rr = __builtin_amdgcn_permlane32_swap(__float_as_uint(ps), __float_as_uint(ps), false, false);
      ps = __uint_as_float(rr[0]) + __uint_as_float(rr[1]); }
    l_reg = l_reg * alpha + ps;
#define PK4(P, BASE, OUT) do { unsigned a0 = cvtpk(P[BASE + 0], P[BASE + 1]), a1 = cvtpk(P[BASE + 2], P[BASE + 3]);   \
    unsigned b0 = cvtpk(P[BASE + 4], P[BASE + 5]), b1 = cvtpk(P[BASE + 6], P[BASE + 7]);                              \
    auto r0 = __builtin_amdgcn_permlane32_swap(a0, b0, false, false); auto r1 = __builtin_amdgcn_permlane32_swap(a1, b1, false, false); \
    u32x4 w = {r0[0], r1[0], r0[1], r1[1]}; OUT = *reinterpret_cast<bf16x8*>(&w); } while (0)
    PK4(p0, 0, pa0); PK4(p0, 8, pa1); PK4(p1, 0, pa2); PK4(p1, 8, pa3);
#undef PK4
}
DI void qkt(f32x16& p0, f32x16& p1, const char* Ks, const bf16x8* qr, int r32, int hi) {
#pragma unroll
    for (int r = 0; r < 16; ++r) { p0[r] = 0.f; p1[r] = 0.f; }
    bf16x8 ka[3], kb[3];
#define QK_RD(D0, SLOT) do { const int cb_ = ((D0) * 16 + hi * 8) * 2; ka[SLOT] = *reinterpret_cast<const bf16x8*>(Ks + KSWZ(r32, cb_)); kb[SLOT] = *reinterpret_cast<const bf16x8*>(Ks + KSWZ(32 + r32, cb_)); } while (0)
    QK_RD(0, 0); QK_RD(1, 1);
    __builtin_amdgcn_sched_barrier(0);
#pragma unroll
    for (int d0 = 0; d0 < 12; ++d0) {
        if (d0 + 2 < 12) QK_RD(d0 + 2, (d0 + 2) % 3);
        p0 = __builtin_amdgcn_mfma_f32_32x32x16_bf16(ka[d0 % 3], qr[d0], p0, 0, 0, 0);
        p1 = __builtin_amdgcn_mfma_f32_32x32x16_bf16(kb[d0 % 3], qr[d0], p1, 0, 0, 0);
        __builtin_amdgcn_sched_barrier(0);
    }
#undef QK_RD
}
DI int v_st(int k, int c) { const int kk = (k & ~0xC) | ((k & 4) << 1) | ((k & 8) >> 1); return ((kk >> 3) * 4 + (c >> 5)) * 512 + ((kk & 7) * 32 + (c & 31)) * 2; }
DI int v_rd_base(int lane) { return ((lane & 3) << 3) | (((lane >> 2) & 3) << 6) | (((lane >> 4) & 1) << 5) | (((lane >> 5) & 1) << 8); }
constexpr int v_rd_off(int d0, int ks, int half) { return d0 * 512 + ks * 4096 + half * 2048; }
template <int OFF> DI s16x4 tr_read(int vb) { s16x4 r; asm volatile("ds_read_b64_tr_b16 %0, %1 offset:%2" : "=&v"(r) : "v"(vb), "i"(OFF) : "memory"); return r; }
template <int D0> DI void pv_one(f32x16& od, int vb, bf16x8 pa0, bf16x8 pa1, bf16x8 pa2, bf16x8 pa3) {
    const s16x4 l0 = tr_read<v_rd_off(D0, 0, 0)>(vb), h0 = tr_read<v_rd_off(D0, 0, 1)>(vb), l1 = tr_read<v_rd_off(D0, 1, 0)>(vb), h1 = tr_read<v_rd_off(D0, 1, 1)>(vb);
    const s16x4 l2 = tr_read<v_rd_off(D0, 2, 0)>(vb), h2 = tr_read<v_rd_off(D0, 2, 1)>(vb), l3 = tr_read<v_rd_off(D0, 3, 0)>(vb), h3 = tr_read<v_rd_off(D0, 3, 1)>(vb);
    asm volatile("s_waitcnt lgkmcnt(0)" ::: "memory"); SBAR();
#define PK(L, H) (bf16x8){L[0], L[1], L[2], L[3], H[0], H[1], H[2], H[3]}
    od = __builtin_amdgcn_mfma_f32_32x32x16_bf16(pa0, PK(l0, h0), od, 0, 0, 0);
    od = __builtin_amdgcn_mfma_f32_32x32x16_bf16(pa1, PK(l1, h1), od, 0, 0, 0);
    od = __builtin_amdgcn_mfma_f32_32x32x16_bf16(pa2, PK(l2, h2), od, 0, 0, 0);
    od = __builtin_amdgcn_mfma_f32_32x32x16_bf16(pa3, PK(l3, h3), od, 0, 0, 0);
#undef PK
}
DI void pv_d0(f32x16* o, int vb, bf16x8 pa0, bf16x8 pa1, bf16x8 pa2, bf16x8 pa3) {
    pv_one<0>(o[0], vb, pa0, pa1, pa2, pa3); pv_one<1>(o[1], vb, pa0, pa1, pa2, pa3); pv_one<2>(o[2], vb, pa0, pa1, pa2, pa3); pv_one<3>(o[3], vb, pa0, pa1, pa2, pa3);
}
DI void attn_body(const bf16_t* __restrict__ Qb, const bf16_t* __restrict__ Kh, const bf16_t* __restrict__ Vh, bf16_t* __restrict__ Ob, int seq, char* lds) {
    const int tid = tid_opq(), wid = tid >> 6, lane = tid & 63, r32 = lane & 31, hi = lane >> 5;
    char* V_lds = lds; char* K_lds = lds + 2 * SHM_V;
    float* wsf = (float*)(lds + 2 * SHM_V + 2 * SHM_K) + wid * 64; float* li_l = wsf; float* al_l = wsf + 32;
    float m_reg = -1e30f, l_reg = 0; f32x16 o[4]; bf16x8 qr[12];
#pragma unroll
    for (int d = 0; d < 4; ++d)
#pragma unroll
        for (int r = 0; r < 16; ++r) o[d][r] = 0.f;
    const bf16_t* Qw = Qb + (long)(wid * QBLK + r32) * LDQ + hi * 8;
#pragma unroll
    for (int d0 = 0; d0 < 12; ++d0) qr[d0] = *reinterpret_cast<const bf16x8*>(Qw + d0 * 16);
    const int sr = tid >> 4, sc = (tid & 15) * 8, vst0 = v_st(sr, sc), vst1 = v_st(32 + sr, sc);
    const int pr = tid >> 3, pc = 128 + (tid & 7) * 8;
    const int vb0 = (int)(uintptr_t)V_lds + v_rd_base(lane);
    bf16x8 vs0, vs1, ks0, ks1, kp;
#define SLOAD(k0) do { vs0 = *reinterpret_cast<const bf16x8*>(&Vh[(long)((k0) + sr) * LDV + sc]); vs1 = *reinterpret_cast<const bf16x8*>(&Vh[(long)((k0) + 32 + sr) * LDV + sc]); \
    ks0 = *reinterpret_cast<const bf16x8*>(&Kh[(long)((k0) + sr) * LDK + sc]); ks1 = *reinterpret_cast<const bf16x8*>(&Kh[(long)((k0) + 32 + sr) * LDK + sc]); \
    kp = *reinterpret_cast<const bf16x8*>(&Kh[(long)((k0) + pr) * LDK + pc]); } while (0)
#define SWRITE(b) do { *(bf16x8*)(V_lds + (b) * SHM_V + vst0) = vs0; *(bf16x8*)(V_lds + (b) * SHM_V + vst1) = vs1; \
    *(bf16x8*)(K_lds + (b) * SHM_K + KSWZ(sr, sc * 2)) = ks0; *(bf16x8*)(K_lds + (b) * SHM_K + KSWZ(32 + sr, sc * 2)) = ks1; \
    *(bf16x8*)(K_lds + (b) * SHM_K + KSWZ(pr, pc * 2)) = kp; } while (0)
#define RESC(a) do { if (__any((a) < 1.f)) { if (hi == 0) al_l[r32] = (a); asm volatile("s_waitcnt lgkmcnt(0)" ::: "memory"); \
    _Pragma("unroll") for (int d = 0; d < 4; ++d) _Pragma("unroll") for (int r = 0; r < 16; ++r) o[d][r] *= al_l[crow(r, hi)]; } } while (0)
    f32x16 p0, p1; float mn, al; bf16x8 pa0, pa1, pa2, pa3; const int NT = seq / KVBLK;
    SLOAD(0); asm volatile("s_waitcnt vmcnt(0)" ::: "memory"); SWRITE(0); __syncthreads();
    for (int j = 0; j < NT; ++j) {
        const int cb = j & 1;
        if (j + 1 < NT) SLOAD((j + 1) * KVBLK);
        SBAR(); qkt(p0, p1, K_lds + cb * SHM_K, qr, r32, hi);
        partialSM(p0, p1, m_reg, mn, al);
        finishSM(p0, p1, al, l_reg, pa0, pa1, pa2, pa3);
        RESC(al); SBAR();
        pv_d0(o, vb0 + cb * (int)SHM_V, pa0, pa1, pa2, pa3);
        if (j + 1 < NT) { asm volatile("s_waitcnt vmcnt(0)" ::: "memory"); SWRITE(cb ^ 1); }
        __syncthreads();
    }
    if (hi == 0) li_l[r32] = l_reg; asm volatile("s_waitcnt lgkmcnt(0)" ::: "memory");
    float rli[16];
#pragma unroll
    for (int r = 0; r < 16; ++r) rli[r] = __builtin_amdgcn_rcpf(li_l[crow(r, hi)]);
    bf16_t* Ow = Ob + (long)(wid * QBLK) * LDO;
#pragma unroll
    for (int r = 0; r < 16; ++r) { const int orow = crow(r, hi);
#pragma unroll
        for (int d0 = 0; d0 < 4; ++d0) Ow[(long)orow * LDO + d0 * 32 + r32] = f2bf(o[d0][r] * rli[r]); }
#undef SLOAD
#undef SWRITE
#undef RESC
}
#undef KSWZ
#undef SBAR
}

DI void attn_phase(const bf16_t* Q, const bf16_t* KB, const bf16_t* VB, bf16_t* O, char* lds, int nitems) {
    for (int it = blockIdx.x; it < nitems; it += gridDim.x) {
        int b, h, qrow0, seq;
        if (it < 2048) {
            const int rnd = it >> 8, blk = it & 255, xcd_ = blk & 7, slot_ = blk >> 3, idx = rnd * 16 + xcd_ * 2 + (slot_ >> 4);
            b = idx >> 3; h = idx & 7; qrow0 = b * SEQ + (slot_ & 15) * 256; seq = KEYS; }
        else { const int j = it - 2048; b = j >> 3; h = j & 7; qrow0 = TL + b * CTXL; seq = CTXL; }
        att::attn_body(Q + (size_t)qrow0 * 1536 + h * 192, KB + (size_t)b * KEYS * 1536 + h * 192, VB + (size_t)b * KEYS * 1024 + h * 128,
                       O + (size_t)qrow0 * 1024 + h * 128, seq, lds);
        __syncthreads();
    }
}

DI void fixup_phase(const float* halo, const float* cw, const float* cb, bf16_t* act) {
    const int gtid = blockIdx.x * NTHREADS + tid_opq(), gstride = gridDim.x * NTHREADS;
    for (int idx = gtid; idx < 272 * 22 * 64; idx += gstride) {
        const int c4 = (idx & 31) * 4, which = (idx >> 5) & 1, t = idx >> 6, pn = t % 22, pm = t / 22;
        const float* hp = halo + (size_t)(pm * 22 + pn) * 4 * 256;
        const bool sfirst = pm >= 256 || (pm & 15) == 0, slast = pm >= 256 || (pm & 15) == 15;
        const f32x4 z4 = (f32x4){0.f, 0.f, 0.f, 0.f};
        f32x4 pa, pg, ca, cg_, na, ng; int row;
        if (which == 0) { row = pm * 256;
            if (sfirst) { pa = z4; pg = z4; } else { const float* q = halo + (size_t)((pm - 1) * 22 + pn) * 4 * 256 + 3 * 256; pa = *(const f32x4*)(q + c4); pg = *(const f32x4*)(q + 128 + c4); }
            ca = *(const f32x4*)(hp + c4); cg_ = *(const f32x4*)(hp + 128 + c4); na = *(const f32x4*)(hp + 256 + c4); ng = *(const f32x4*)(hp + 256 + 128 + c4);
        } else { row = pm * 256 + 255;
            pa = *(const f32x4*)(hp + 2 * 256 + c4); pg = *(const f32x4*)(hp + 2 * 256 + 128 + c4); ca = *(const f32x4*)(hp + 3 * 256 + c4); cg_ = *(const f32x4*)(hp + 3 * 256 + 128 + c4);
            if (slast) { na = z4; ng = z4; } else { const float* q = halo + (size_t)((pm + 1) * 22 + pn) * 4 * 256; na = *(const f32x4*)(q + c4); ng = *(const f32x4*)(q + 128 + c4); }
        }
        const int ch = pn * 128 + c4;
        const f32x4 w0a = *(const f32x4*)(cw + ch), w1a = *(const f32x4*)(cw + 5632 + ch), w2a = *(const f32x4*)(cw + 2 * 5632 + ch), ba = *(const f32x4*)(cb + ch);
        const f32x4 w0g = *(const f32x4*)(cw + 2816 + ch), w1g = *(const f32x4*)(cw + 5632 + 2816 + ch), w2g = *(const f32x4*)(cw + 2 * 5632 + 2816 + ch), bg = *(const f32x4*)(cb + 2816 + ch);
        const f32x4 av = w0a * pa + w1a * ca + w2a * na + ba, gv = w0g * pg + w1g * cg_ + w2g * ng + bg;
        u32x2 w; w.x = cvt_pk_bf16(silu_f(gv[0]) * av[0], silu_f(gv[1]) * av[1]); w.y = cvt_pk_bf16(silu_f(gv[2]) * av[2], silu_f(gv[3]) * av[3]);
        *(u32x2*)(act + (size_t)row * 2816 + ch) = w;
    }
}


#define XB_TMO      128
#define XB_XCNT(j)  (256  + 64 * (j))
#define XB_XSUB(j)  (1280 + 64 * (j))
#define XB_XGEN(j)  (2304 + 64 * (j))
#define XB_TOP      3328
#define XB_TOPGEN   3392
#define XCD_BAR_WORDS 3456
#define XB_SPIN_CAP (1u << 18)
DI unsigned xb_ld(unsigned* p)              { return __hip_atomic_load(p, __ATOMIC_RELAXED, __HIP_MEMORY_SCOPE_AGENT); }
DI unsigned xb_add(unsigned* p, unsigned v) { return __hip_atomic_fetch_add(p, v, __ATOMIC_RELAXED, __HIP_MEMORY_SCOPE_AGENT); }
DI unsigned xb_xcc_id() { return (unsigned)__builtin_amdgcn_s_getreg((3 << 11) | 20) & 0xFu; }
#define XB_SPIN(cond, bar) do { unsigned _sp = 0; while (cond) { __builtin_amdgcn_s_sleep(1); \
    if ((++_sp & 255u) == 0u) { if (xb_ld(&(bar)[XB_TMO])) break; if (_sp > XB_SPIN_CAP) { atomicAdd(&(bar)[XB_TMO], 1u); break; } } } } while (0)
struct XcdBarrier { unsigned* bar; unsigned x; volatile LAS unsigned* st; };
DI XcdBarrier xcd_barrier_post(unsigned* bar, volatile LAS unsigned* st) {
    XcdBarrier b; b.bar = bar; b.x = xb_xcc_id(); b.st = st;
    if (threadIdx.x == 0) (void)xb_add(&bar[XB_XCNT(b.x)], 1u);
    return b;
}
DI void xcd_barrier_complete(unsigned* bar, unsigned x, unsigned& nloc, unsigned& nx) {
    const unsigned G = gridDim.x * gridDim.y * gridDim.z;
    unsigned sum, cnt, mine, sp = 0u;
    for (;;) {
        sum = 0u; cnt = 0u; mine = 0u;
#pragma unroll
        for (unsigned j = 0; j < 16; ++j) { const unsigned c = xb_ld(&bar[XB_XCNT(j)]); sum += c; cnt += (c > 0u) ? 1u : 0u; mine = (j == x) ? c : mine; }
        if (sum == G) break;
        __builtin_amdgcn_s_sleep(1);
        if ((++sp & 255u) == 0u) { if (xb_ld(&bar[XB_TMO])) break; if (sp > XB_SPIN_CAP) { atomicAdd(&bar[XB_TMO], 1u); break; } }
    }
    nloc = mine > 0u ? mine : 1u; nx = cnt > 0u ? cnt : 1u;
}
DI void xcd_barrier(const XcdBarrier& b) {
    asm volatile("s_waitcnt vmcnt(0)" ::: "memory");
    __syncthreads();
    if (threadIdx.x == 0) {
        unsigned* bar = b.bar;
        __builtin_amdgcn_s_waitcnt(0);
        unsigned nloc = b.st[0], nx = b.st[1];
        if (nloc == 0u) { xcd_barrier_complete(bar, b.x, nloc, nx); b.st[0] = nloc; b.st[1] = nx; }
        const unsigned old = xb_add(&bar[XB_XSUB(b.x)], 1u);
        const unsigned gen = old / nloc;
        if (old + 1u == (gen + 1u) * nloc) {
            __builtin_amdgcn_fence(__ATOMIC_RELEASE, "agent");
            asm volatile("s_waitcnt vmcnt(0)" ::: "memory");
            const unsigned og = xb_add(&bar[XB_TOP], 1u);
            const unsigned tg = og / nx;
            if (og + 1u == (tg + 1u) * nx) xb_add(&bar[XB_TOPGEN], 1u);
            else XB_SPIN(xb_ld(&bar[XB_TOPGEN]) == tg, bar);
            __builtin_amdgcn_fence(__ATOMIC_ACQUIRE, "agent");
            xb_add(&bar[XB_XGEN(b.x)], 1u);
            asm volatile("s_waitcnt vmcnt(0)" ::: "memory");
        } else {
            XB_SPIN(xb_ld(&bar[XB_XGEN(b.x)]) == gen, bar);
            __builtin_amdgcn_fence(__ATOMIC_ACQUIRE, "agent");
            asm volatile("s_waitcnt vmcnt(0)" ::: "memory");
        }
    }
    __syncthreads();
}

__global__ void __launch_bounds__(NTHREADS) mega(Params p) {
    extern __shared__ __attribute__((aligned(16))) unsigned char smem[];
    LAS unsigned char* lds = (LAS unsigned char*)smem;
    cg::grid_group grid = cg::this_grid();
    volatile LAS unsigned* xb_st = (volatile LAS unsigned*)(lds + XB_ST_OFF);
    if (threadIdx.x < 4) xb_st[threadIdx.x] = 0u;
    __syncthreads();
    XcdBarrier xbar = xcd_barrier_post((unsigned*)((unsigned char*)p.in[27] + WS_BAR), xb_st);

    for (int ph = p.ph_lo; ph < p.ph_hi; ++ph) {
        unsigned char* ws = (unsigned char*)p.in[opq(27)];
        float* const xout = (float*)p.in[opq(26)];
        float* mod = (float*)(ws + WS_MOD);
        float* xc = (float*)(ws + WS_XC);
        bf16_t* hbuf = (bf16_t*)(ws + WS_H);
        if (ph == 0) {
            prep_phase(p, lds);
#if defined(MK_DUP_OP) && MK_DUP_OP == 99
            grid.sync(); prep_phase(p, lds);
#endif
        } else {
            const int q = ph - 1, lp = q / 21; int r = q % 21; int layer, nmix;
            if (r < 10) { layer = 2 * lp; nmix = 6; } else { layer = 2 * lp + 1; r -= 10; nmix = 7; }
            const bool is_mla = layer & 1; const int j = layer >> 1;
            const float* modl = mod + (size_t)layer * 17 * 6144;
            const bool first = (layer == 0);
            int op = -1, gsel = 0, hf = 0;
            if (r < nmix) {
                if (!is_mla) { op = r == 0 ? 0 : r == 1 ? 2 : r == 2 ? 9 : r == 3 ? 3 : r == 4 ? 4 : 2; gsel = r == 1 ? 0 : 1; }
                else { op = r == 0 ? 0 : r == 1 ? 2 : r == 2 ? 5 : r == 3 ? 2 : r == 4 ? 6 : r == 5 ? 7 : 2; gsel = r == 1 ? 2 : r == 3 ? 3 : 5; }
            } else {
                const int f = r - nmix;
                op = f == 0 ? 1 : f == 2 ? 8 : 2; gsel = f == 1 ? 6 : 7;
            }
            if (op == 1 || (op == 0 && layer > 0)) continue;
#ifdef MK_DUP_OP
            for (int rep_ = 0; rep_ < ((op == MK_DUP_OP || (op == 2 && gsel == MK_DUP_OP - 100)) ? 2 : 1); ++rep_) {
            if (rep_) grid.sync();
#else
            {
#endif
            if (op == 0) {
                norm_phase(p.in[opq(0)], p.in[opq(2)], p.in[opq(6)], modl, 0, 1024, hbuf);
                shw_phase(ws, lds);
            } else if (op == 2) {
                const int ng = (gsel == 3) ? 2 : 1;
                for (int gi = 0; gi < ng; ++gi) {
                    pg8::Gemm g; Epi E; int kind = EPI_BF16;
                    E.ldc = 0; E.xch = (LAS float*)(lds + XCH_OFF); E.q0 = nullptr; E.q1 = nullptr; E.q2 = nullptr; E.q3 = nullptr; E.q4 = nullptr; E.q5 = nullptr;
                    float* const shw_mix = (float*)(ws + WS_SHW) + (size_t)(layer * 2) * 17 * 5632; float* const shw_ffn = shw_mix + 17 * 5632;
                    float* const rs0 = (float*)(ws + WS_RS); float* const rs1 = rs0 + MR;
                    g.M = MR;
                    const int gs = gsel + gi;
                    if (gs == 0) { g.A = hbuf; g.Bt = (const bf16_t*)(ws + WS_GIN + j * SZ_GIN); g.N = 3328; g.K = 1024; g.lda = 1024; g.ldb = 1024;
                        kind = EPI_GLA_IN; E.q0 = ws + WS_QK; E.ldc = 1024; E.q1 = ws + WS_LR; E.q2 = ws + WS_VR; if (!first) { E.q3 = rs1; E.q4 = shw_mix; } }
                    else if (gs == 1 || gs == 5) { g.A = hbuf; g.Bt = (const bf16_t*)(ws + (gs == 1 ? WS_GOUT : WS_MOUT) + j * SZ_SQ); g.N = 1024; g.K = 1024; g.lda = 1024; g.ldb = 1024;
                        kind = EPI_RESID; E.ldc = 0; E.q0 = (void*)(first ? p.in[opq(0)] : xout); E.q1 = (void*)(first ? p.in[opq(2)] : xc); E.q2 = xout; E.q3 = ws; E.q4 = (void*)modl; E.q5 = (void*)(p.in[opq(7)] + layer * 1024);
                        for (int i = blockIdx.x * NTHREADS + tid_opq(); i < MR; i += gridDim.x * NTHREADS) rs1[i] = 0.f; }
                    else if (gs == 2) { g.A = hbuf; g.Bt = (const bf16_t*)(ws + WS_MDOWN + j * SZ_MDOWN); g.N = 768; g.K = 1024; g.lda = 1024; g.ldb = 1024;
                        E.q0 = ws + WS_DN; E.ldc = 768; E.q3 = rs1; E.q4 = shw_mix; }
                    else if (gs == 3) { g.A = (const bf16_t*)(ws + WS_CQN); g.Bt = (const bf16_t*)(ws + WS_MUQ + j * SZ_MUQ); g.N = 1536; g.K = 384; g.lda = 384; g.ldb = 384;
                        E.q0 = ws + WS_QRAW; E.ldc = 1536; }
                    else if (gs == 4) { g.A = (const bf16_t*)(ws + WS_CKVN); g.Bt = (const bf16_t*)(ws + WS_MUKV + j * SZ_MUKV); g.N = 2048; g.K = 256; g.lda = 256; g.ldb = 256;
                        kind = EPI_UKV; E.q0 = ws + WS_KB; E.q1 = ws + WS_VB; }
                    else if (gs == 6) { g.A = (const bf16_t*)(ws + WS_XSA); g.Bt = (const bf16_t*)(ws + WS_FUP + (size_t)layer * SZ_FUP); g.N = 5632; g.K = 1024; g.lda = 1024; g.ldb = 1024;
                        kind = EPI_FFN_UP; E.q0 = ws + WS_ACT; E.ldc = 2816; E.q1 = (void*)(p.in[opq(23)] + (size_t)layer * 3 * 2 * DFF); E.q2 = (void*)(p.in[opq(24)] + (size_t)layer * 2 * DFF);
                        E.q3 = ws + WS_HALO; E.q4 = rs0; E.q5 = shw_ffn; }
                    else { g.A = (const bf16_t*)(ws + WS_ACT); g.Bt = (const bf16_t*)(ws + WS_FDOWN + (size_t)layer * SZ_FDOWN); g.N = 1024; g.K = 2816; g.lda = 2816; g.ldb = 2816;
                        kind = EPI_RESID; E.ldc = 1; E.q0 = xout; E.q1 = xc; E.q2 = xout; E.q3 = ws; E.q4 = (void*)modl; E.q5 = layer < 3 ? (void*)(p.in[opq(6)] + (layer + 1) * 1024) : nullptr;
                        for (int i = blockIdx.x * NTHREADS + tid_opq(); i < MR; i += gridDim.x * NTHREADS) rs0[i] = 0.f; }
                    if (layer == 3 && (gs == 3 || gs == 5 || gs == 6 || gs == 7)) g.M = TL;
                    pg8::StaticOrder S; S.init(g.M, g.N, (int)gridDim.x, (int)blockIdx.x);
                    if (kind == EPI_BF16) pg8::gemm_phase<Epi, EPI_BF16>(lds, g, S, E);
                    else if (kind == EPI_GLA_IN) pg8::gemm_phase<Epi, EPI_GLA_IN>(lds, g, S, E);
                    else if (kind == EPI_RESID) pg8::gemm_phase<Epi, EPI_RESID>(lds, g, S, E);
                    else if (kind == EPI_UKV) pg8::gemm_phase<Epi, EPI_UKV>(lds, g, S, E);
                    else pg8::gemm_phase<Epi, EPI_FFN_UP>(lds, g, S, E);
                    __syncthreads();
                }
            } else if (op == 3) {
                scan_phase((const bf16_t*)(ws + WS_VR), (const bf16_t*)(ws + WS_GQ), (const bf16_t*)(ws + WS_GK), (const bf16_t*)(ws + WS_GP), (const float*)(ws + WS_GE),
                           hbuf, (bf16_t*)(ws + WS_QK), lds);
            } else if (op == 9) {
                gateprep_phase((const bf16_t*)(ws + WS_QK), (const float*)(ws + WS_LR), p.in[opq(10)] + (size_t)j * 2 * 16 * 512, p.in[opq(11)] + (size_t)j * 2 * 512,
                               (bf16_t*)(ws + WS_GQ), (bf16_t*)(ws + WS_GK), (bf16_t*)(ws + WS_GP), (float*)(ws + WS_GE), lds);
            } else if (op == 4) {
                glapost_phase(hbuf, (const bf16_t*)(ws + WS_QK), (const bf16_t*)(ws + WS_VR), p.in[opq(12)] + j * 256, hbuf);
            } else if (op == 5) {
                mlamid_phase((const bf16_t*)(ws + WS_DN), p.in[opq(15)] + j * 384, p.in[opq(16)] + j * 256, p.in[opq(20)] + j * 192, (bf16_t*)(ws + WS_CQN), (bf16_t*)(ws + WS_CKVN), (bf16_t*)(ws + WS_KB));
            } else if (op == 6) {
                qkprep_phase((bf16_t*)(ws + WS_QRAW), (bf16_t*)(ws + WS_KB), p.in[opq(19)] + j * 192, p.in[opq(20)] + j * 192);
            } else if (op == 7) {
                attn_phase((const bf16_t*)(ws + WS_QRAW), (const bf16_t*)(ws + WS_KB), (const bf16_t*)(ws + WS_VB), hbuf, (char*)smem, layer == 3 ? 2048 : 2048 + 128);
            } else if (op == 8) {
                fixup_phase((const float*)(ws + WS_HALO), p.in[opq(23)] + (size_t)layer * 3 * 2 * DFF, p.in[opq(24)] + (size_t)layer * 2 * DFF, (bf16_t*)(ws + WS_ACT));
            }
            }
        }
        if (ph + 1 < p.ph_hi) { if (p.ph_lo < 0) grid.sync(); else xcd_barrier(xbar); }
    }
}

extern "C" void kernel_launch(void* const* d_in, const int* in_sizes, int n_in, void* d_out, int out_size, void* d_ws, size_t ws_size, hipStream_t stream) {
    static int grid = 0;
    if (grid == 0) {
        if (n_in != 26 || ws_size < WS_END) { fprintf(stderr, "kernel_launch: n_in %d ws %zu (need %zu)\n", n_in, ws_size, (size_t)WS_END); grid = -1; return; }
        int dev = 0, cus = 0, per_cu = 0;
        hipGetDevice(&dev);
        hipDeviceGetAttribute(&cus, hipDeviceAttributeMultiprocessorCount, dev);
        if (hipFuncSetAttribute((const void*)mega, hipFuncAttributeMaxDynamicSharedMemorySize, LDS_BYTES) != hipSuccess) { fprintf(stderr, "kernel_launch: hipFuncSetAttribute failed\n"); grid = -1; return; }
        if (hipOccupancyMaxActiveBlocksPerMultiprocessor(&per_cu, (const void*)mega, NTHREADS, LDS_BYTES) != hipSuccess || per_cu < 1) { fprintf(stderr, "kernel_launch: occupancy query %d\n", per_cu); per_cu = 1; }
        (void)hipGetLastError();
        grid = cus * per_cu;
        fprintf(stderr, "kernel_launch: grid %d (cus %d x %d)\n", grid, cus, per_cu);
    }
    if (grid < 0) return;
    Params p{};
    for (int i = 0; i < 26; ++i) p.in[i] = (const float*)d_in[i];
    p.in[26] = (const float*)d_out; p.in[27] = (const float*)d_ws;
    (void)hipMemsetAsync((unsigned char*)d_ws + WS_BAR, 0, 16384, stream);
#if MK_MULTI
    for (int ph = 0; ph < NPH; ++ph) {
        p.ph_lo = ph; p.ph_hi = ph + 1;
        hipLaunchKernelGGL(mega, dim3(grid), dim3(NTHREADS), LDS_BYTES, stream, p);
    }
#else
    p.ph_lo = 0; p.ph_hi = NPH;
    void* args[] = {&p};
    hipError_t e = hipLaunchCooperativeKernel((const void*)mega, dim3(grid), dim3(NTHREADS), args, LDS_BYTES, stream);
    if (e != hipSuccess) fprintf(stderr, "cooperative launch failed: %s (grid %d)\n", hipGetErrorString(e), grid);
#endif
}
```

```cpp
#include <hip/hip_runtime.h>
#include <hip/hip_cooperative_groups.h>
#include <cstdio>
#include <cstdint>
namespace cg = cooperative_groups;

#ifndef MK_MULTI
#define MK_MULTI 0
#endif

#define LAS __attribute__((address_space(3)))
#define DI __device__ __forceinline__
typedef unsigned short bf16_t;
typedef short bf16x8 __attribute__((ext_vector_type(8)));
typedef short s16x4 __attribute__((ext_vector_type(4)));
typedef float f32x2 __attribute__((ext_vector_type(2)));
typedef float f32x4 __attribute__((ext_vector_type(4)));
typedef float f32x16 __attribute__((ext_vector_type(16)));
typedef unsigned u32x2 __attribute__((ext_vector_type(2)));
typedef unsigned u32x4 __attribute__((ext_vector_type(4)));

constexpr int DM = 1024, NB = 16, SEQ = 4096, CTXL = 256;
constexpr int TL = NB * SEQ, TC = NB * CTXL, MR = TL + TC;
constexpr int KEYS = CTXL + SEQ;
constexpr int DFF = 2816, DFFH = 1408;
constexpr int NTHREADS = 512;
constexpr int XB_ST_OFF = 131072 + 12288 + 2 * 5120 + 6144;
constexpr int LDS_BYTES = XB_ST_OFF + 16;
constexpr int WIMG_F = 3072, PREW_F = 3072 + 2 * 1280;
constexpr int XCH_OFF = 131072;
constexpr int NPH = 43;

constexpr size_t SZ_GIN = 3328ull * 1024 * 2, SZ_SQ = 1024ull * 1024 * 2, SZ_MDOWN = 768ull * 1024 * 2, SZ_MUQ = 1536ull * 384 * 2,
                 SZ_MUKV = 2048ull * 256 * 2, SZ_FUP = 5632ull * 1024 * 2, SZ_FDOWN = 1024ull * 2816 * 2;
constexpr size_t WS_GIN = 0;
constexpr size_t WS_GOUT = WS_GIN + 2 * SZ_GIN;
constexpr size_t WS_MDOWN = WS_GOUT + 2 * SZ_SQ;
constexpr size_t WS_MUQ = WS_MDOWN + 2 * SZ_MDOWN;
constexpr size_t WS_MUKV = WS_MUQ + 2 * SZ_MUQ;
constexpr size_t WS_MOUT = WS_MUKV + 2 * SZ_MUKV;
constexpr size_t WS_FUP = WS_MOUT + 2 * SZ_SQ;
constexpr size_t WS_FDOWN = WS_FUP + 4 * SZ_FUP;
constexpr size_t WS_MOD = WS_FDOWN + 4 * SZ_FDOWN;
constexpr size_t SZ_MOD = 4ull * 17 * 6144 * 4;
constexpr size_t WS_RS = WS_MOD + ((SZ_MOD + 255) / 256) * 256;
constexpr size_t WS_SHW = WS_RS + 2ull * MR * 4;
constexpr size_t WS_BAR = WS_SHW + 4ull * 2 * 17 * 5632 * 4;
constexpr size_t WS_XC = WS_BAR + 16384;
constexpr size_t WS_H = WS_XC + (size_t)TC * 1024 * 4;
constexpr size_t WS_R = WS_H + (size_t)MR * 1024 * 2;
constexpr size_t WS_QK = WS_R;
constexpr size_t WS_VR = WS_QK + (size_t)MR * 1024 * 2;
constexpr size_t WS_LR = WS_VR + (size_t)MR * 2048 * 2;
constexpr int NCHI = NB * 2 * 4 * 68;
constexpr size_t WS_GQ = WS_LR + (size_t)MR * 32 * 4;
constexpr size_t WS_GK = WS_GQ + (size_t)NCHI * 64 * 128 * 2;
constexpr size_t WS_GP = WS_GK + (size_t)NCHI * 64 * 128 * 2;
constexpr size_t WS_GE = WS_GP + (size_t)NCHI * 64 * 64 * 2;
constexpr size_t WS_GLA_END = WS_GE + (size_t)NCHI * 128 * 4;
constexpr size_t WS_QRAW = WS_R;
constexpr size_t WS_DN = WS_R;
constexpr size_t WS_CQN = WS_QRAW + (size_t)MR * 1536 * 2;
constexpr size_t WS_CKVN = WS_CQN + (size_t)MR * 384 * 2;
constexpr size_t WS_KB = WS_CKVN + (size_t)MR * 256 * 2;
constexpr size_t WS_VB = WS_KB + (size_t)NB * KEYS * 1536 * 2;
constexpr size_t WS_MLA_END = WS_VB + (size_t)NB * KEYS * 1024 * 2;
constexpr size_t WS_ACT = WS_R;
constexpr size_t WS_HALO = WS_ACT + (size_t)MR * 2816 * 2;
constexpr size_t WS_XSA = WS_HALO + 272ull * 22 * 4 * 256 * 4;
constexpr size_t WS_FFN_END = WS_XSA + (size_t)MR * 1024 * 2;
constexpr size_t WS_END = WS_GLA_END > WS_MLA_END ? (WS_GLA_END > WS_FFN_END ? WS_GLA_END : WS_FFN_END) : (WS_MLA_END > WS_FFN_END ? WS_MLA_END : WS_FFN_END);
static_assert(WS_END <= (1ull << 30), "workspace over 1 GiB");

struct Params { const float* in[28]; int ph_lo, ph_hi; };

DI unsigned cvt_pk_bf16(float lo, float hi) { unsigned r; asm("v_cvt_pk_bf16_f32 %0, %1, %2" : "=v"(r) : "v"(lo), "v"(hi)); return r; }
DI float bf_lo(unsigned u) { return __uint_as_float(u << 16); }
DI float bf_hi(unsigned u) { return __uint_as_float(u & 0xffff0000u); }
DI bf16_t f2bf(float f) { return (bf16_t)(cvt_pk_bf16(f, 0.f) & 0xffffu); }
DI float wave_sum(float v) {
    v += __int_as_float(__builtin_amdgcn_update_dpp(0, __float_as_int(v), 0xB1, 0xF, 0xF, false));
    v += __int_as_float(__builtin_amdgcn_update_dpp(0, __float_as_int(v), 0x4E, 0xF, 0xF, false));
    v += __int_as_float(__builtin_amdgcn_update_dpp(0, __float_as_int(v), 0x141, 0xF, 0xF, false));
    v += __int_as_float(__builtin_amdgcn_update_dpp(0, __float_as_int(v), 0x140, 0xF, 0xF, false));
    v += __int_as_float(__builtin_amdgcn_update_dpp(0, __float_as_int(v), 0x142, 0xA, 0xF, false));
    v += __int_as_float(__builtin_amdgcn_update_dpp(0, __float_as_int(v), 0x143, 0xC, 0xF, false));
    return __int_as_float(__builtin_amdgcn_readlane(__float_as_int(v), 63));
}
DI float silu_f(float v) { return v * __builtin_amdgcn_rcpf(1.0f + __expf(-v)); }
DI int crow(int r, int hi) { return (r & 3) + 8 * (r >> 2) + 4 * hi; }
DI int tid_opq() { int t = threadIdx.x; asm volatile("" : "+v"(t)); return t; }
DI int opq(int i) { asm volatile("" : "+s"(i)); return i; }

namespace pg8 {
constexpr int BM = 256, BK = 64, HALF = 128, HTB = HALF * BK * 2, STAGE_BYTES = 8 * HTB, NXCD = 8, WGM = 8;
DI int lds_byte(int r, int c) { const int st = (r >> 4) * 2 + (c >> 5), rr = r & 15, cc = c & 31, ob = rr * 64 + cc * 2; return st * 1024 + (ob ^ (((ob >> 9) & 1) << 5)); }
DI void stage_rc(int b, int& R, int& C) { const int st = b / 1024, sb = b % 1024, swz = sb ^ (((sb >> 9) & 1) << 5); R = (st >> 1) * 16 + swz / 64; C = (st & 1) * 32 + (swz % 64) / 2; }
DI int perm32(int rho) { const int n = rho >> 4, i = rho & 15; return 8 * (i >> 2) + 4 * n + (i & 3); }
struct Unit { int pm, pn; };
struct Gemm { const bf16_t* A; const bf16_t* Bt; int M, N, K, lda, ldb; };
struct StaticOrder {
    int nM, nN, nwg, G, c;
    DI void init(int M, int N, int G_, int c_) { nM = M / BM; nN = N / BM; nwg = nM * nN; G = G_; c = c_; }
    DI bool next(int i, Unit& u) const {
        const long L = (long)i * G + c; if (L >= nwg) return false;
        int wgid = (int)L; { const int q = nwg / NXCD, r = nwg % NXCD, xcd = wgid % NXCD, off = wgid / NXCD; wgid = (xcd < r ? xcd * (q + 1) : r * (q + 1) + (xcd - r) * q) + off; }
        const int nig = WGM * nN, gid = wgid / nig, fm = gid * WGM, gsz = (nM - fm) < WGM ? (nM - fm) : WGM;
        u.pm = fm + ((wgid % nig) % gsz); u.pn = (wgid % nig) / gsz; return true;
    }
};

template <class Epi, int KIND>
DI void gemm_phase(LAS unsigned char* lds, const Gemm g, const StaticOrder& S, const Epi& E) {
    constexpr bool perm = Epi::template perm_of<KIND>();
    const int tid = tid_opq(), wid = __builtin_amdgcn_readfirstlane(tid >> 6), lane = tid & 63, wr = wid >> 2, wc = wid & 3, fr = lane & 15, fq = lane >> 4;
    const int K = g.K, nt = K / BK;
    unsigned voffA[2], voffB[2];
#pragma unroll
    for (int i = 0; i < 2; ++i) { int R, C; stage_rc(tid * 16 + i * 8192, R, C); const int Rb = perm ? ((R & ~31) + perm32(R & 31)) : R;
        voffA[i] = (unsigned)(R * g.lda + C) * 2u; voffB[i] = (unsigned)(Rb * g.ldb + C) * 2u; }
    const size_t kstep = (size_t)(BK * 2);
    const size_t hstepA = (size_t)HALF * g.lda * 2, hstepB = (size_t)HALF * g.ldb * 2;
    const size_t tstepA = 2 * hstepA, tstepB = 2 * hstepB;
    const unsigned ldsw = (unsigned)wid * 1024u;
    const int aoff = lds_byte(wr * 64 + fr, fq * 8), boff = lds_byte(wc * 32 + fr, fq * 8);
#define PG8_SA(b, h) (((b) * 2 + (h)) * HTB)
#define PG8_SB(b, h) ((4 + (b) * 2 + (h)) * HTB)
#define PG8_STAGE(bufoff, gbase, voff) do { _Pragma("unroll") for (int _i = 0; _i < 2; ++_i) \
        __builtin_amdgcn_global_load_lds((const unsigned*)((const char*)(gbase) + (voff)[_i]), (LAS unsigned*)(lds + (bufoff) + ldsw + _i * 8192), 16, 0, 0); } while (0)
#define PG8_LDA(dst, b, h) do { _Pragma("unroll") for (int m = 0; m < 4; ++m) _Pragma("unroll") for (int k = 0; k < 2; ++k) dst[m][k] = *(const LAS bf16x8*)(lds + PG8_SA(b, h) + aoff + m * 2048 + k * 1024); } while (0)
#define PG8_LDB(dst, b, h) do { _Pragma("unroll") for (int n = 0; n < 2; ++n) _Pragma("unroll") for (int k = 0; k < 2; ++k) dst[n][k] = *(const LAS bf16x8*)(lds + PG8_SB(b, h) + boff + n * 2048 + k * 1024); } while (0)
#define PG8_MMA(ai, bj, At, Bt) do { __builtin_amdgcn_s_setprio(1); _Pragma("unroll") for (int m = 0; m < 4; ++m) _Pragma("unroll") for (int n = 0; n < 2; ++n) _Pragma("unroll") for (int k = 0; k < 2; ++k) \
        acc[ai][bj][m][n] = __builtin_amdgcn_mfma_f32_16x16x32_bf16(Bt[n][k], At[m][k], acc[ai][bj][m][n], 0, 0, 0); __builtin_amdgcn_s_setprio(0); } while (0)
#define PG8_WAIT_V(n) asm volatile("s_waitcnt vmcnt(" #n ")" ::: "memory")
#define PG8_WAIT_L(n) asm volatile("s_waitcnt lgkmcnt(" #n ")" ::: "memory")
#define PG8_BAR __builtin_amdgcn_s_barrier()
#define PG8_SCHED __builtin_amdgcn_sched_barrier(0)
    Unit cur, nxt; int ui = 0;
    if (!S.next(0, cur)) return;
    f32x4 acc[2][2][4][2];
#pragma unroll
    for (int a = 0; a < 2; ++a)
#pragma unroll
        for (int b = 0; b < 2; ++b)
#pragma unroll
            for (int m = 0; m < 4; ++m)
#pragma unroll
                for (int n = 0; n < 2; ++n) acc[a][b][m][n] = (f32x4){0.f, 0.f, 0.f, 0.f};
    bf16x8 At[4][2], B0[2][2], B1[2][2];
    typename Epi::Pre pre;
    const char* cA = (const char*)g.A + (size_t)cur.pm * tstepA; const char* cB = (const char*)g.Bt + (size_t)cur.pn * tstepB;
    PG8_STAGE(PG8_SB(0, 0), cB, voffB); PG8_STAGE(PG8_SA(0, 0), cA, voffA); PG8_STAGE(PG8_SB(0, 1), cB + hstepB, voffB); PG8_STAGE(PG8_SA(0, 1), cA + hstepA, voffA);
    if (wr == 1) PG8_BAR;
    PG8_WAIT_V(4); PG8_BAR;
    PG8_STAGE(PG8_SB(1, 0), cB + kstep, voffB); PG8_STAGE(PG8_SA(1, 0), cA + kstep, voffA); PG8_STAGE(PG8_SB(1, 1), cB + hstepB + kstep, voffB);
    PG8_WAIT_V(6); PG8_BAR;
    for (;;) {
        const bool has_next = S.next(ui + 1, nxt);
        const char* nA = has_next ? (const char*)g.A + (size_t)nxt.pm * tstepA : cA; const char* nB = has_next ? (const char*)g.Bt + (size_t)nxt.pn * tstepB : cB;
        E.template prefetch<KIND>(pre, cur, wr, wc, fr, fq, ui & 1);
        for (int t = 0; t < nt; t += 2) {
            const bool last = (t == nt - 2);
            const char* a1 = cA + (size_t)(t + 1) * kstep;
            const char* a2 = last ? nA : cA + (size_t)(t + 2) * kstep; const char* b2 = last ? nB : cB + (size_t)(t + 2) * kstep;
            const char* a3 = a2 + kstep; const char* b3 = b2 + kstep;
            PG8_LDB(B0, 0, 0); PG8_SCHED; PG8_LDA(At, 0, 0); PG8_STAGE(PG8_SA(1, 1), a1 + hstepA, voffA);
            PG8_WAIT_L(8); PG8_BAR; PG8_WAIT_L(0); PG8_MMA(0, 0, At, B0); PG8_BAR; PG8_SCHED;
            PG8_LDB(B1, 0, 1); PG8_STAGE(PG8_SB(0, 0), b2, voffB);
            PG8_BAR; PG8_WAIT_L(0); PG8_MMA(0, 1, At, B1); PG8_BAR;
            PG8_LDA(At, 0, 1); PG8_STAGE(PG8_SA(0, 0), a2, voffA);
            PG8_BAR; PG8_WAIT_L(0); PG8_MMA(1, 0, At, B0); PG8_BAR; PG8_SCHED;
            PG8_STAGE(PG8_SB(0, 1), b2 + hstepB, voffB);
            PG8_WAIT_V(6); PG8_BAR; PG8_MMA(1, 1, At, B1); PG8_BAR;
            PG8_LDB(B0, 1, 0); PG8_SCHED; PG8_LDA(At, 1, 0); PG8_STAGE(PG8_SA(0, 1), a2 + hstepA, voffA);
            PG8_WAIT_L(8); PG8_BAR; PG8_WAIT_L(0); PG8_MMA(0, 0, At, B0); PG8_BAR; PG8_SCHED;
            PG8_LDB(B1, 1, 1); PG8_STAGE(PG8_SB(1, 0), b3, voffB);
            PG8_BAR; PG8_WAIT_L(0); PG8_MMA(0, 1, At, B1); PG8_BAR;
            PG8_LDA(At, 1, 1); PG8_STAGE(PG8_SA(1, 0), a3, voffA);
            PG8_BAR; PG8_WAIT_L(0); PG8_MMA(1, 0, At, B0); PG8_BAR; PG8_SCHED;
            PG8_STAGE(PG8_SB(1, 1), b3 + hstepB, voffB);
            PG8_WAIT_V(6); PG8_BAR; PG8_MMA(1, 1, At, B1); PG8_BAR;
        }
        if (wr == 0) { PG8_BAR; asm volatile("" ::: "memory"); }
        E.template run<KIND>(acc, pre, cur, wr, wc, fr, fq, ui & 1);
        if (wr == 1) { asm volatile("" ::: "memory"); PG8_BAR; }
        if (!has_next) break;
#pragma unroll
        for (int a = 0; a < 2; ++a)
#pragma unroll
            for (int b = 0; b < 2; ++b)
#pragma unroll
                for (int m = 0; m < 4; ++m)
#pragma unroll
                    for (int n = 0; n < 2; ++n) acc[a][b][m][n] = (f32x4){0.f, 0.f, 0.f, 0.f};
        cur = nxt; cA = nA; cB = nB; ++ui;
    }
    PG8_WAIT_V(0);
    if (wr == 0) PG8_BAR;
    PG8_BAR;
#undef PG8_SA
#undef PG8_SB
#undef PG8_STAGE
#undef PG8_LDA
#undef PG8_LDB
#undef PG8_MMA
#undef PG8_WAIT_V
#undef PG8_WAIT_L
#undef PG8_BAR
#undef PG8_SCHED
}
}

enum { EPI_BF16 = 0, EPI_GLA_IN = 1, EPI_RESID = 2, EPI_UKV = 3, EPI_FFN_UP = 4 };
DI float dpp_ror1(float v) { return __int_as_float(__builtin_amdgcn_update_dpp(0, __float_as_int(v), 0x121, 0xf, 0xf, false)); }
DI float dpp_ror15(float v) { return __int_as_float(__builtin_amdgcn_update_dpp(0, __float_as_int(v), 0x12F, 0xf, 0xf, false)); }
struct Epi {
    struct Pre { float rsv[2][4]; f32x4 sw[2][2]; f32x2 wl0, wl1; };
    int ldc; LAS float* xch;
    void* q0; void* q1; void* q2; void* q3; void* q4; void* q5;
    static DI f32x4 ror1_4(f32x4 v) { float a, b, c, d;
        asm volatile("s_nop 1\n\tv_mov_b32_dpp %0, %4 row_ror:1 row_mask:0xf bank_mask:0xf\n\tv_mov_b32_dpp %1, %5 row_ror:1 row_mask:0xf bank_mask:0xf\n\tv_mov_b32_dpp %2, %6 row_ror:1 row_mask:0xf bank_mask:0xf\n\tv_mov_b32_dpp %3, %7 row_ror:1 row_mask:0xf bank_mask:0xf"
                     : "=&v"(a), "=&v"(b), "=&v"(c), "=&v"(d) : "v"(v[0]), "v"(v[1]), "v"(v[2]), "v"(v[3]));
        return (f32x4){a, b, c, d}; }
    static DI f32x2 ror1_2(f32x2 v) { float a, b;
        asm volatile("s_nop 1\n\tv_mov_b32_dpp %0, %2 row_ror:1 row_mask:0xf bank_mask:0xf\n\tv_mov_b32_dpp %1, %3 row_ror:1 row_mask:0xf bank_mask:0xf" : "=&v"(a), "=&v"(b) : "v"(v[0]), "v"(v[1]));
        return (f32x2){a, b}; }
    static DI f32x2 ror15_2(f32x2 v) { float a, b;
        asm volatile("s_nop 1\n\tv_mov_b32_dpp %0, %2 row_ror:15 row_mask:0xf bank_mask:0xf\n\tv_mov_b32_dpp %1, %3 row_ror:15 row_mask:0xf bank_mask:0xf" : "=&v"(a), "=&v"(b) : "v"(v[0]), "v"(v[1]));
        return (f32x2){a, b}; }
    static DI f32x4 ror15_4(f32x4 v) { float a, b, c, d;
        asm volatile("s_nop 1\n\tv_mov_b32_dpp %0, %4 row_ror:15 row_mask:0xf bank_mask:0xf\n\tv_mov_b32_dpp %1, %5 row_ror:15 row_mask:0xf bank_mask:0xf\n\tv_mov_b32_dpp %2, %6 row_ror:15 row_mask:0xf bank_mask:0xf\n\tv_mov_b32_dpp %3, %7 row_ror:15 row_mask:0xf bank_mask:0xf"
                     : "=&v"(a), "=&v"(b), "=&v"(c), "=&v"(d) : "v"(v[0]), "v"(v[1]), "v"(v[2]), "v"(v[3]));
        return (f32x4){a, b, c, d}; }
    DI void ffn_up(const f32x4 (&acc)[2][2][4][2], const pg8::Unit& u, int wr, int wc, int fr, int fq, int par) const {
        bf16_t* O = (bf16_t*)q0; float* halo = (float*)q3;
        const int cl = wc * 32 + 8 * fq;
        float rstd[2][4];
        { const LAS float* pw = xch + PREW_F + (wr * 4 + wc) * 192;
#pragma unroll
          for (int g = 0; g < 8; ++g) rstd[g >> 2][g & 3] = rsqrtf(pw[g * 16 + fr] * (1.0f / 1024.0f) + 1e-6f); }
        const LAS float* wbuf = xch + WIMG_F + par * 1280;
#define XW(ST, TB, BJ, V0, V1) do { LAS float* xp_ = xch + ((((ST) + 1) * 2 + (TB)) * 2 + (BJ)) * 128 + cl; *(LAS f32x4*)xp_ = (V0); *(LAS f32x4*)(xp_ + 4) = (V1); } while (0)
#define TR(AI, BJ, M, N) (acc[AI][BJ][M][N] * rstd[AI][M])
        if (fr == 0) { XW(wr, 0, 0, TR(0, 0, 0, 0), TR(0, 0, 0, 1)); XW(wr, 0, 1, TR(0, 1, 0, 0), TR(0, 1, 0, 1)); XW(2 + wr, 0, 0, TR(1, 0, 0, 0), TR(1, 0, 0, 1)); XW(2 + wr, 0, 1, TR(1, 1, 0, 0), TR(1, 1, 0, 1)); }
        if (fr == 15) { XW(wr, 1, 0, TR(0, 0, 3, 0), TR(0, 0, 3, 1)); XW(wr, 1, 1, TR(0, 1, 3, 0), TR(0, 1, 3, 1)); XW(2 + wr, 1, 0, TR(1, 0, 3, 0), TR(1, 0, 3, 1)); XW(2 + wr, 1, 1, TR(1, 1, 3, 0), TR(1, 1, 3, 1)); }
        { const f32x4 zz = (f32x4){0.f, 0.f, 0.f, 0.f}; if (fr == 0 && wr == 0) { XW(-1, 1, 0, zz, zz); XW(-1, 1, 1, zz, zz); } if (fr == 15 && wr == 1) { XW(4, 0, 0, zz, zz); XW(4, 0, 1, zz, zz); } }
#undef XW
        asm volatile("s_waitcnt lgkmcnt(0)" ::: "memory"); __builtin_amdgcn_s_barrier(); asm volatile("" ::: "memory"); __builtin_amdgcn_s_barrier(); asm volatile("" ::: "memory");
        {
            float* hp = halo + (size_t)(u.pm * 22 + u.pn) * 4 * 256 + cl;
            const f32x4 sa0 = *(const LAS f32x4*)(wbuf + 512 + cl), sa1 = *(const LAS f32x4*)(wbuf + 512 + cl + 4), sg0 = *(const LAS f32x4*)(wbuf + 640 + 512 + cl), sg1 = *(const LAS f32x4*)(wbuf + 640 + 512 + cl + 4);
            if (wr == 0 && fr < 2) { float* h2 = hp + fr * 256; *(f32x4*)h2 = TR(0, 0, 0, 0) + sa0; *(f32x4*)(h2 + 4) = TR(0, 0, 0, 1) + sa1; *(f32x4*)(h2 + 128) = TR(0, 1, 0, 0) + sg0; *(f32x4*)(h2 + 132) = TR(0, 1, 0, 1) + sg1; }
            if (wr == 1 && fr >= 14) { float* h2 = hp + (fr - 12) * 256; *(f32x4*)h2 = TR(1, 0, 3, 0) + sa0; *(f32x4*)(h2 + 4) = TR(1, 0, 3, 1) + sa1; *(f32x4*)(h2 + 128) = TR(1, 1, 3, 0) + sg0; *(f32x4*)(h2 + 132) = TR(1, 1, 3, 1) + sg1; }
        }
#undef TR
        asm volatile("" ::: "memory");
        const int rowt = u.pm * 256 + wr * 64 + fr;
        const bool f0 = fr == 0, f15 = fr == 15;
        f32x2 sg[2][4][4];
#define SILU2(v) (f32x2){silu_f(v[0]), silu_f(v[1])}
#define H2(V, HH) __builtin_shufflevector(V, V, 2 * (HH), 2 * (HH) + 1)
#define CONV_GROUP(BJ, Q, AI, OP) do { \
            const int st = 2 * (AI) + wr; \
            const f32x2 pb = *(const LAS f32x2*)(xch + (((st) * 2 + 1) * 2 + (BJ)) * 128 + cl + 2 * (Q)) + sw; \
            const f32x2 nb = *(const LAS f32x2*)(xch + (((st + 2) * 2 + 0) * 2 + (BJ)) * 128 + cl + 2 * (Q)) + sw; \
            const f32x2 c0 = H2(acc[AI][BJ][0][(Q) >> 1], (Q) & 1) * rstd[AI][0] + sw, c1 = H2(acc[AI][BJ][1][(Q) >> 1], (Q) & 1) * rstd[AI][1] + sw, \
                        c2 = H2(acc[AI][BJ][2][(Q) >> 1], (Q) & 1) * rstd[AI][2] + sw, c3 = H2(acc[AI][BJ][3][(Q) >> 1], (Q) & 1) * rstd[AI][3] + sw; \
            const f32x2 R0 = ror1_2(c0), L0 = ror15_2(c0), L1 = ror15_2(c1); \
            { const f32x2 v = w0 * (f0 ? pb : R0) + w1 * c0 + w2 * (f15 ? L1 : L0) + bb; OP(sg[AI][0][Q], v); } \
            __builtin_amdgcn_sched_barrier(0); \
            const f32x2 R1 = ror1_2(c1), L2 = ror15_2(c2); \
            { const f32x2 v = w0 * (f0 ? R0 : R1) + w1 * c1 + w2 * (f15 ? L2 : L1) + bb; OP(sg[AI][1][Q], v); } \
            __builtin_amdgcn_sched_barrier(0); \
            const f32x2 R2 = ror1_2(c2), L3 = ror15_2(c3); \
            { const f32x2 v = w0 * (f0 ? R1 : R2) + w1 * c2 + w2 * (f15 ? L3 : L2) + bb; OP(sg[AI][2][Q], v); } \
            __builtin_amdgcn_sched_barrier(0); \
            const f32x2 R3 = ror1_2(c3); \
            { const f32x2 v = w0 * (f0 ? R2 : R3) + w1 * c3 + w2 * (f15 ? nb : L3) + bb; OP(sg[AI][3][Q], v); } \
            __builtin_amdgcn_sched_barrier(0); } while (0)
#define OP_G(dst, v) dst = SILU2(v)
#define OP_A(dst, v) dst *= v
#define CONV_W(BJ, Q) const LAS float* wp_ = wbuf + (BJ) * 640 + cl + 2 * (Q); \
            const f32x2 w0 = *(const LAS f32x2*)wp_, w1 = *(const LAS f32x2*)(wp_ + 128), w2 = *(const LAS f32x2*)(wp_ + 256), bb = *(const LAS f32x2*)(wp_ + 384), sw = *(const LAS f32x2*)(wp_ + 512);
        { CONV_W(1, 0) CONV_GROUP(1, 0, 0, OP_G); CONV_GROUP(1, 0, 1, OP_G); }
        { CONV_W(1, 1) CONV_GROUP(1, 1, 0, OP_G); CONV_GROUP(1, 1, 1, OP_G); }
        { CONV_W(1, 2) CONV_GROUP(1, 2, 0, OP_G); CONV_GROUP(1, 2, 1, OP_G); }
        { CONV_W(1, 3) CONV_GROUP(1, 3, 0, OP_G); CONV_GROUP(1, 3, 1, OP_G); }
        { CONV_W(0, 0) CONV_GROUP(0, 0, 0, OP_A); CONV_GROUP(0, 0, 1, OP_A); }
        { CONV_W(0, 1) CONV_GROUP(0, 1, 0, OP_A); CONV_GROUP(0, 1, 1, OP_A); }
        { CONV_W(0, 2) CONV_GROUP(0, 2, 0, OP_A); CONV_GROUP(0, 2, 1, OP_A); }
        { CONV_W(0, 3) CONV_GROUP(0, 3, 0, OP_A); CONV_GROUP(0, 3, 1, OP_A); }
#undef CONV_W
#undef CONV_GROUP
#undef OP_G
#undef OP_A
#undef SILU2
#undef H2
#define ST16(AI, MM) do { u32x4 w_; w_.x = cvt_pk_bf16(sg[AI][MM][0][0], sg[AI][MM][0][1]); w_.y = cvt_pk_bf16(sg[AI][MM][1][0], sg[AI][MM][1][1]); w_.z = cvt_pk_bf16(sg[AI][MM][2][0], sg[AI][MM][2][1]); w_.w = cvt_pk_bf16(sg[AI][MM][3][0], sg[AI][MM][3][1]); \
            *(u32x4*)(O + (size_t)(rowt + (AI) * 128 + (MM) * 16) * 2816 + u.pn * 128 + cl) = w_; } while (0)
        ST16(0, 0); ST16(0, 1); ST16(0, 2); ST16(0, 3); ST16(1, 0); ST16(1, 1); ST16(1, 2); ST16(1, 3);
#undef ST16
    }
    template <int K> static constexpr bool perm_of() { return true; }
    template <int kind> DI void prefetch(Pre& P, const pg8::Unit& u, int wr, int wc, int fr, int fq, int par) const {
        (void)P;
        if constexpr (kind == EPI_GLA_IN || kind == EPI_BF16 || kind == EPI_FFN_UP) {
            const float* rsb = (const float*)(kind == EPI_FFN_UP ? q4 : q3);
            if (rsb) {
                LAS float* pw = xch + PREW_F + (wr * 4 + wc) * 192;
                const int bidx = u.pm < 256 ? (u.pm >> 4) : 16;
                if (fq == 0) {
                    const float* rsp = rsb + u.pm * 256 + wr * 64 + fr;
#pragma unroll
                    for (int g = 0; g < 8; ++g) __builtin_amdgcn_global_load_lds((const unsigned*)(rsp + (g >> 2) * 128 + (g & 3) * 16), (LAS unsigned*)(pw + g * 16), 4, 0, 0);
                    if constexpr (kind != EPI_FFN_UP) {
                        const float* sw = (const float*)q4 + (size_t)bidx * 5632 + u.pn * 256 + (fr >> 3) * 128 + wc * 32 + (fr & 7) * 4;
                        __builtin_amdgcn_global_load_lds((const unsigned*)sw, (LAS unsigned*)(pw + 128), 16, 0, 0);
                    }
                }
                if constexpr (kind == EPI_FFN_UP) {
                    const int wid = wr * 4 + wc;
                    if (wid < 5) {
                        const float* cw = (const float*)q1; const float* cb = (const float*)q2; const float* shw = (const float*)q5 + (size_t)bidx * 5632 + u.pn * 256;
                        const int i4 = (wid * 64 + fq * 16 + fr) * 4, bjw = i4 / 640, rem = i4 % 640, kw = rem >> 7, c_ = rem & 127;
                        const float* srcw = kw < 3 ? cw + kw * 5632 + bjw * 2816 + u.pn * 128 + c_ : kw == 3 ? cb + bjw * 2816 + u.pn * 128 + c_ : shw + bjw * 128 + c_;
                        __builtin_amdgcn_global_load_lds((const unsigned*)srcw, (LAS unsigned*)(xch + WIMG_F + par * 1280 + wid * 256), 16, 0, 0);
                    }
                }
            }
        }
    }
    template <int kind> DI void run(const f32x4 (&acc)[2][2][4][2], const Pre& P, const pg8::Unit& u, int wr, int wc, int fr, int fq, int par) const {
        asm volatile("" : "+v"(fr), "+v"(fq));
        if constexpr (kind == EPI_FFN_UP) { ffn_up(acc, u, wr, wc, fr, fq, par); return; }
        if constexpr (kind == EPI_RESID) {
            const float* base_l = (const float*)q0; const float* base_c = (const float*)q1; float* out_l = (float*)q2; unsigned char* wsb = (unsigned char*)q3; float* out_c = (float*)(wsb + WS_XC);
            const float* modl = (const float*)q4; const float* gnext = (const float*)q5;
            const int bidx = u.pm < 256 ? (u.pm >> 4) : 16;
            const float* gv = modl + (size_t)bidx * 6144 + (ldc ? 5 * 1024 : 2 * 1024);
            const float* bp = u.pm < 256 ? base_l + (size_t)u.pm * 256 * 1024 : base_c + (size_t)(u.pm - 256) * 256 * 1024;
            float* op = u.pm < 256 ? out_l + (size_t)u.pm * 256 * 1024 : out_c + (size_t)(u.pm - 256) * 256 * 1024;
            const int col0 = u.pn * 256 + wc * 32 + 8 * fq;
            f32x4 gt[2][2], gn[2][2];
#pragma unroll
            for (int bj = 0; bj < 2; ++bj)
#pragma unroll
                for (int n = 0; n < 2; ++n) gt[bj][n] = *(const f32x4*)(gv + col0 + bj * 128 + n * 4);
            if (gnext) {
                const float* scn = ldc ? modl + (size_t)(17 + bidx) * 6144 + 1024 : modl + (size_t)bidx * 6144 + 4 * 1024;
#pragma unroll
                for (int bj = 0; bj < 2; ++bj)
#pragma unroll
                    for (int n = 0; n < 2; ++n) gn[bj][n] = *(const f32x4*)(gnext + col0 + bj * 128 + n * 4) * (*(const f32x4*)(scn + col0 + bj * 128 + n * 4) + 1.0f);
            }
            bf16_t* xs = (bf16_t*)(wsb + (ldc ? WS_H : WS_XSA)) + (size_t)u.pm * 256 * 1024;
            float* rs = (float*)(wsb + WS_RS) + (ldc ? MR : 0) + u.pm * 256;
            f32x4 bsA[4], bsB[4];
#define RS_LOAD(K, DST) do { const size_t off_ = (size_t)(((K) >> 2) * 128 + wr * 64 + ((K) & 3) * 16 + fr) * 1024 + col0; \
                _Pragma("unroll") for (int q_ = 0; q_ < 4; ++q_) DST[q_] = *(const f32x4*)(bp + off_ + (q_ >> 1) * 128 + (q_ & 1) * 4); } while (0)
#define RS_DO(K, SRC) do { const int ai_ = (K) >> 2, m_ = (K) & 3; const int rl = ai_ * 128 + wr * 64 + m_ * 16 + fr; const size_t off = (size_t)rl * 1024 + col0; float ssq = 0.f; \
                _Pragma("unroll") for (int q_ = 0; q_ < 4; ++q_) { const int bj = q_ >> 1, n = q_ & 1; \
                    const f32x4 xn = SRC[q_] + gt[bj][n] * acc[ai_][bj][m_][n]; \
                    *(f32x4*)(op + off + bj * 128 + n * 4) = xn; \
                    if (gnext) { ssq += xn[0] * xn[0] + xn[1] * xn[1] + xn[2] * xn[2] + xn[3] * xn[3]; const f32x4 y = xn * gn[bj][n]; \
                        u32x2 w; w.x = cvt_pk_bf16(y[0], y[1]); w.y = cvt_pk_bf16(y[2], y[3]); *(u32x2*)(xs + off + bj * 128 + n * 4) = w; } } \
                if (gnext) { ssq += __shfl_xor(ssq, 16); ssq += __shfl_xor(ssq, 32); if (fq == 0) unsafeAtomicAdd(rs + rl, ssq); } } while (0)
            RS_LOAD(0, bsA);
            RS_LOAD(1, bsB); RS_DO(0, bsA);
            RS_LOAD(2, bsA); RS_DO(1, bsB);
            RS_LOAD(3, bsB); RS_DO(2, bsA);
            RS_LOAD(4, bsA); RS_DO(3, bsB);
            RS_LOAD(5, bsB); RS_DO(4, bsA);
            RS_LOAD(6, bsA); RS_DO(5, bsB);
            RS_LOAD(7, bsB); RS_DO(6, bsA);
            RS_DO(7, bsB);
#undef RS_LOAD
#undef RS_DO
            return;
        } else {
        bf16_t* O = (bf16_t*)q0; float* lr = (float*)q1; bf16_t* KB = (bf16_t*)q0; bf16_t* VB = (bf16_t*)q1;
        const int rowt = u.pm * 256 + wr * 64 + fr;
        f32x4 swv[2][2]; float rsv[2][4];
        if constexpr (kind == EPI_GLA_IN || kind == EPI_BF16) {
            if (q3) { const LAS float* pw = xch + PREW_F + (wr * 4 + wc) * 192;
#pragma unroll
                for (int g = 0; g < 8; ++g) rsv[g >> 2][g & 3] = pw[g * 16 + fr];
#pragma unroll
                for (int bj = 0; bj < 2; ++bj) { swv[bj][0] = *(const LAS f32x4*)(pw + 128 + bj * 32 + 8 * fq); swv[bj][1] = *(const LAS f32x4*)(pw + 128 + bj * 32 + 8 * fq + 4); } }
        }
#pragma unroll
        for (int ai = 0; ai < 2; ++ai)
#pragma unroll
            for (int m = 0; m < 4; ++m) {
                const int row = rowt + ai * 128 + m * 16;
#pragma unroll
                for (int bj = 0; bj < 2; ++bj) {
                    f32x4 v0 = acc[ai][bj][m][0], v1 = acc[ai][bj][m][1];
                    const int cin = bj * 128 + wc * 32 + 8 * fq;
                    if constexpr (kind == EPI_GLA_IN || kind == EPI_BF16) {
                        if (q3) {
                            const float rstd = rsqrtf(rsv[ai][m] * (1.0f / 1024.0f) + 1e-6f);
                            v0 = v0 * rstd + swv[bj][0]; v1 = v1 * rstd + swv[bj][1];
                        }
                    }
                    if constexpr (kind == EPI_GLA_IN) {
                        if (u.pn == 12) {
                            if (bj == 0 && wc == 0) { float* lp = lr + (size_t)row * 32 + 8 * fq; *(f32x4*)lp = v0; *(f32x4*)(lp + 4) = v1; }
                            continue;
                        }
                        if (u.pn < 2) { v0 *= 0.08838834764831845f; v1 *= 0.08838834764831845f; }
                    }
                    u32x4 w; w.x = cvt_pk_bf16(v0[0], v0[1]); w.y = cvt_pk_bf16(v0[2], v0[3]); w.z = cvt_pk_bf16(v1[0], v1[1]); w.w = cvt_pk_bf16(v1[2], v1[3]);
                    if constexpr (kind == EPI_GLA_IN) {
                        if (u.pn < 4) *(u32x4*)(O + (size_t)row * 1024 + u.pn * 256 + cin) = w;
                        else *(u32x4*)((bf16_t*)q2 + (size_t)row * 2048 + (u.pn - 4) * 256 + cin) = w;
                    } else if constexpr (kind == EPI_UKV) {
                        int key;
                        if (u.pm < 256) { const int b = u.pm >> 4; key = b * KEYS + CTXL + (row - b * SEQ); }
                        else { const int b = u.pm - 256; key = b * KEYS + (row - TL - b * CTXL); }
                        const int cc = wc * 32 + 8 * fq;
                        if (bj == 0) *(u32x4*)(KB + (size_t)key * 1536 + u.pn * 192 + cc) = w;
                        else *(u32x4*)(VB + (size_t)key * 1024 + u.pn * 128 + cc) = w;
                    } else {
                        *(u32x4*)(O + (size_t)row * ldc + u.pn * 256 + cin) = w;
                    }
                }
            }
        }
    }
};

DI void prep_phase(const Params& p, LAS unsigned char* lds) {
    const int tid = tid_opq();
    unsigned char* ws = (unsigned char*)p.in[opq(27)];
    LAS float* tl = (LAS float*)lds;
    const float* in_c = p.in[opq(1)]; const float* in_cctx = p.in[opq(3)]; const float* in_wada = p.in[opq(4)]; const float* in_bada = p.in[opq(5)];
    const float* in_gin = p.in[opq(8)]; const float* in_w1 = p.in[opq(9)]; const float* in_gout = p.in[opq(13)]; const float* in_mdown = p.in[opq(14)];
    const float* in_uq = p.in[opq(17)]; const float* in_ukv = p.in[opq(18)]; const float* in_mout = p.in[opq(21)]; const float* in_fup = p.in[opq(22)]; const float* in_fdown = p.in[opq(25)];
    constexpr int T0 = 1536, T2 = 512, T3 = 352, T4 = 288, T5 = 256, T6 = 512, T7 = 5632, T8 = 2816;
    constexpr int NTILE = T0 + T2 + T3 + T4 + T5 + T6 + T7 + T8;
    for (int t = blockIdx.x; t < NTILE; t += gridDim.x) {
        const float* src; int N, k0, n0, ld; bf16_t* dst;
        int q = t;
        if (q < T0) { const int j = q / 768, r = q % 768, kt = r / 48, nt = r % 48; src = in_gin + (size_t)j * 1024 * 3072; N = 3072; k0 = kt * 64; n0 = nt * 64;
            dst = (bf16_t*)(ws + WS_GIN + j * SZ_GIN) + (size_t)n0 * 1024 + k0; ld = 1024; }
        else if ((q -= T0) < T2) { const int j = q / 256, r = q % 256, kt = r / 16, nt = r % 16; src = in_gout + (size_t)j * 1024 * 1024; N = 1024; k0 = kt * 64; n0 = nt * 64;
            dst = (bf16_t*)(ws + WS_GOUT + j * SZ_SQ) + (size_t)n0 * 1024 + k0; ld = 1024; }
        else if ((q -= T2) < T3) { const int j = q / 176, r = q % 176, kt = r / 11, nt = r % 11; src = in_mdown + (size_t)j * 1024 * 704; N = 704; k0 = kt * 64; n0 = nt * 64;
            dst = (bf16_t*)(ws + WS_MDOWN + j * SZ_MDOWN) + (size_t)n0 * 1024 + k0; ld = 1024; }
        else if ((q -= T3) < T4) { const int j = q / 144, r = q % 144, kt = r / 24, nt = r % 24; src = in_uq + (size_t)j * 384 * 1536; N = 1536; k0 = kt * 64; n0 = nt * 64;
            dst = (bf16_t*)(ws + WS_MUQ + j * SZ_MUQ) + (size_t)n0 * 384 + k0; ld = 384; }
        else if ((q -= T4) < T5) { const int j = q / 128, r = q % 128, kt = r / 32, nt = r % 32; src = in_ukv + (size_t)j * 256 * 2048; N = 2048; k0 = kt * 64; n0 = nt * 64;
            dst = (bf16_t*)(ws + WS_MUKV + j * SZ_MUKV) + (size_t)n0 * 256 + k0; ld = 256; }
        else if ((q -= T5) < T6) { const int j = q / 256, r = q % 256, kt = r / 16, nt = r % 16; src = in_mout + (size_t)j * 1024 * 1024; N = 1024; k0 = kt * 64; n0 = nt * 64;
            dst = (bf16_t*)(ws + WS_MOUT + j * SZ_SQ) + (size_t)n0 * 1024 + k0; ld = 1024; }
        else if ((q -= T6) < T7) { const int i = q / 1408, r = q % 1408, kt = r / 88, nt = r % 88; src = in_fup + (size_t)i * 1024 * 5632; N = 5632; k0 = kt * 64; n0 = nt * 64;
            const int isg = n0 >= DFF ? 1 : 0, cc = n0 - isg * DFF, drow = (cc >> 7) * 256 + isg * 128 + (cc & 127);
            dst = (bf16_t*)(ws + WS_FUP + (size_t)i * SZ_FUP) + (size_t)drow * 1024 + k0; ld = 1024; }
        else { q -= T7; const int i = q / 704, r = q % 704, kt = r / 16, nt = r % 16; src = in_fdown + (size_t)i * 2816 * 1024; N = 1024; k0 = kt * 64; n0 = nt * 64;
            dst = (bf16_t*)(ws + WS_FDOWN + (size_t)i * SZ_FDOWN) + (size_t)n0 * 2816 + k0; ld = 2816; }
#pragma unroll
        for (int i = 0; i < 8; ++i) { const int r = (tid >> 6) + 8 * i, c = tid & 63; tl[c * 65 + r] = src[(size_t)(k0 + r) * N + n0 + c]; }
        __syncthreads();
#pragma unroll
        for (int i = 0; i < 4; ++i) { const int rr = (tid >> 5) + 16 * i, c2 = (tid & 31) * 2; const float a = tl[rr * 65 + c2], b = tl[rr * 65 + c2 + 1];
            *(unsigned*)(dst + (size_t)rr * ld + c2) = cvt_pk_bf16(a, b); }
        __syncthreads();
    }
    const int gtid = blockIdx.x * NTHREADS + tid, gstride = gridDim.x * NTHREADS;
    for (int idx = gtid; idx < 65536; idx += gstride) {
        const int k = idx & 1023, r = (idx >> 10) & 15, dir = (idx >> 14) & 1, j = idx >> 15;
        const float v = in_w1[((size_t)(j * 2 + dir) * 1024 + k) * 16 + r];
        ((bf16_t*)(ws + WS_GIN + j * SZ_GIN))[(size_t)(3072 + dir * 16 + r) * 1024 + k] = f2bf(v);
    }
    for (int idx = gtid; idx < 2 * 114688; idx += gstride) { const int j = idx / 114688, o = idx % 114688; ((unsigned*)(ws + WS_GIN + j * SZ_GIN + 3104ull * 1024 * 2))[o] = 0u; }
    for (int idx = gtid; idx < 2 * 32768; idx += gstride) { const int j = idx / 32768, o = idx % 32768; ((unsigned*)(ws + WS_MDOWN + j * SZ_MDOWN + 704ull * 1024 * 2))[o] = 0u; }
    for (int idx = gtid; idx < MR; idx += gstride) ((float*)(ws + WS_RS))[idx] = 0.f;
    LAS float* sl = (LAS float*)lds;
    LAS float* red = (LAS float*)(lds + 81920);
    __syncthreads();
    for (int idx = tid; idx < 17 * 1024; idx += NTHREADS) { const int r = idx >> 10, k = idx & 1023; const float v = r < 16 ? in_c[r * 1024 + k] : in_cctx[k]; sl[k * 20 + r] = v / (1.0f + __expf(-v)); }
    __syncthreads();
    float* mod = (float*)(ws + WS_MOD);
    for (int it = blockIdx.x; it < 384; it += gridDim.x) {
        const int layer = it / 96, n0 = (it % 96) * 64, nn = tid & 63, ks = tid >> 6;
        const float* W = in_wada + (size_t)layer * 1024 * 6144 + n0 + nn;
        float acc[17];
#pragma unroll
        for (int r = 0; r < 17; ++r) acc[r] = 0.f;
        for (int kk = 0; kk < 128; ++kk) {
            const int k = ks * 128 + kk; const float w = W[(size_t)k * 6144];
            const f32x4 s0 = *(const LAS f32x4*)(sl + k * 20), s1 = *(const LAS f32x4*)(sl + k * 20 + 4), s2 = *(const LAS f32x4*)(sl + k * 20 + 8), s3 = *(const LAS f32x4*)(sl + k * 20 + 12);
            const float s16 = sl[k * 20 + 16];
#pragma unroll
            for (int j = 0; j < 4; ++j) { acc[j] += s0[j] * w; acc[4 + j] += s1[j] * w; acc[8 + j] += s2[j] * w; acc[12 + j] += s3[j] * w; }
            acc[16] += s16 * w;
        }
#pragma unroll
        for (int r = 0; r < 17; ++r) red[(ks * 17 + r) * 64 + nn] = acc[r];
        __syncthreads();
        for (int o = tid; o < 17 * 64; o += NTHREADS) { const int r = o >> 6, c = o & 63; float s = in_bada[layer * 6144 + n0 + c];
#pragma unroll
            for (int k8 = 0; k8 < 8; ++k8) s += red[(k8 * 17 + r) * 64 + c];
            mod[(size_t)(layer * 17 + r) * 6144 + n0 + c] = s; }
        __syncthreads();
    }
}

DI void shw_phase(unsigned char* ws, LAS unsigned char* lds) {
    const int tid = tid_opq(), wave = tid >> 6, lane = tid & 63;
    LAS float* sl = (LAS float*)lds;
    const float* mod = (const float*)(ws + WS_MOD);
    constexpr int NCH = 4 * 44 + 6 + 26 + 6;
    for (int ch = blockIdx.x; ch < NCH; ch += gridDim.x) {
        int layer, kind, n0; const bf16_t* Bt;
        if (ch < 176) { layer = ch / 44; kind = 1; n0 = (ch % 44) * 128; Bt = (const bf16_t*)(ws + WS_FUP + (size_t)layer * SZ_FUP); }
        else if (ch < 182) { layer = 1; kind = 0; n0 = (ch - 176) * 128; Bt = (const bf16_t*)(ws + WS_MDOWN); }
        else if (ch < 208) { layer = 2; kind = 0; n0 = (ch - 182) * 128; Bt = (const bf16_t*)(ws + WS_GIN + SZ_GIN); }
        else { layer = 3; kind = 0; n0 = (ch - 208) * 128; Bt = (const bf16_t*)(ws + WS_MDOWN + SZ_MDOWN); }
        __syncthreads();
        for (int idx = tid; idx < 17 * 256; idx += NTHREADS) { const int b = idx >> 8, k4 = (idx & 255) * 4;
            *(LAS f32x4*)(sl + b * 1024 + k4) = *(const f32x4*)(mod + (size_t)(layer * 17 + b) * 6144 + (kind ? 3 * 1024 : 0) + k4); }
        __syncthreads();
        float* out = (float*)(ws + WS_SHW) + (size_t)((layer * 2 + kind) * 17) * 5632;
#pragma unroll 1
        for (int i = 0; i < 16; ++i) {
            const int n = n0 + wave * 16 + i;
            float w[16];
#pragma unroll
            for (int j = 0; j < 4; ++j) { const u32x2 t = *(const u32x2*)(Bt + (size_t)n * 1024 + j * 256 + lane * 4); w[4 * j] = bf_lo(t.x); w[4 * j + 1] = bf_hi(t.x); w[4 * j + 2] = bf_lo(t.y); w[4 * j + 3] = bf_hi(t.y); }
            float mine = 0.f;
#pragma unroll 1
            for (int b = 0; b < 17; ++b) {
                float a = 0.f;
#pragma unroll
                for (int j = 0; j < 4; ++j) { const f32x4 sv = *(const LAS f32x4*)(sl + b * 1024 + j * 256 + lane * 4); a += sv[0] * w[4 * j] + sv[1] * w[4 * j + 1] + sv[2] * w[4 * j + 2] + sv[3] * w[4 * j + 3]; }
                a = wave_sum(a);
                if (lane == b) mine = a;
            }
            if (lane < 17) out[(size_t)lane * 5632 + n] = mine;
        }
    }
    __syncthreads();
}

DI void norm_phase(const float* xl, const float* xc, const float* gain, const float* modl, int sh_off, int sc_off, bf16_t* h) {
    const int tid = tid_opq(), wave = tid >> 6, lane = tid & 63;
    for (int row0 = (blockIdx.x * 8 + wave) * 4; row0 < MR; row0 += gridDim.x * 32) {
        const float* src = row0 < TL ? xl + (size_t)row0 * 1024 : xc + (size_t)(row0 - TL) * 1024;
        const float* mb = modl + (size_t)(row0 < TL ? (row0 >> 12) : 16) * 6144;
        f32x4 v[4][4]; float ss[4];
#pragma unroll
        for (int r = 0; r < 4; ++r)
#pragma unroll
            for (int i = 0; i < 4; ++i) v[r][i] = *(const f32x4*)(src + (size_t)r * 1024 + i * 256 + lane * 4);
#pragma unroll
        for (int r = 0; r < 4; ++r) { float t = 0.f;
#pragma unroll
            for (int i = 0; i < 4; ++i) t += v[r][i][0] * v[r][i][0] + v[r][i][1] * v[r][i][1] + v[r][i][2] * v[r][i][2] + v[r][i][3] * v[r][i][3];
            ss[r] = t; }
#pragma unroll
        for (int o = 32; o >= 1; o >>= 1) {
#pragma unroll
            for (int r = 0; r < 4; ++r) ss[r] += __shfl_xor(ss[r], o);
        }
#pragma unroll
        for (int i = 0; i < 4; ++i) {
            const int c = i * 256 + lane * 4;
            const f32x4 g = *(const f32x4*)(gain + c), sc = *(const f32x4*)(mb + sc_off + c), sh = *(const f32x4*)(mb + sh_off + c);
            const f32x4 gs = g * (sc + 1.0f);
#pragma unroll
            for (int r = 0; r < 4; ++r) {
                const float rstd = rsqrtf(ss[r] * (1.0f / 1024.0f) + 1e-6f);
                const f32x4 y = (v[r][i] * rstd) * gs + sh;
                u32x2 w; w.x = cvt_pk_bf16(y[0], y[1]); w.y = cvt_pk_bf16(y[2], y[3]);
                *(u32x2*)(h + (size_t)(row0 + r) * 1024 + c) = w;
            }
        }
    }
}

DI void scan_rowbase(int dir, int b, int c, int& rb, int& sg) {
    if (dir == 0) { sg = 1; rb = c < 4 ? TL + b * CTXL + c * 64 : b * SEQ + (c - 4) * 64; }
    else { sg = -1; rb = c < 4 ? TL + b * CTXL + 255 - c * 64 : b * SEQ + 4095 - (c - 4) * 64; }
}
struct GPStage { unsigned qv[8], kv[8]; f32x4 lrv; float w2r[16][2]; f32x2 gbias; };
DI void gp_load(GPStage& S, int item, const bf16_t* qk, const float* lr, const float* w2, const float* gb, int tid, int wave, int d0) {
    const int c = item % 68, rest = item / 68, h = rest & 3, dir = (rest >> 2) & 1, b = rest >> 3;
    int rowbase, sgn; scan_rowbase(dir, b, c, rowbase, sgn);
#pragma unroll
    for (int i = 0; i < 8; ++i) { const size_t ro = (size_t)(rowbase + sgn * (wave * 8 + i)) * 1024; S.qv[i] = *(const unsigned*)(qk + ro + h * 128 + d0); S.kv[i] = *(const unsigned*)(qk + ro + 512 + h * 128 + d0); }
    S.lrv = (f32x4){0.f, 0.f, 0.f, 0.f};
    if (tid < 256) S.lrv = *(const f32x4*)(lr + (size_t)(rowbase + sgn * (tid >> 2)) * 32 + dir * 16 + (tid & 3) * 4);
#pragma unroll
    for (int r = 0; r < 16; ++r) { const f32x2 t = *(const f32x2*)(w2 + (size_t)(dir * 16 + r) * 512 + h * 128 + d0); S.w2r[r][0] = t.x; S.w2r[r][1] = t.y; }
    S.gbias = *(const f32x2*)(gb + dir * 512 + h * 128 + d0);
}
DI void gp_item(const GPStage& S, int item, bf16_t* GQ, bf16_t* GK, bf16_t* GP, float* GE, LAS unsigned char* lds, int tid, int wave, int lane) {
    constexpr int QD = 0, KI = 17408, LRS = 34816, SEG = 38912;
    const int l15 = lane & 15, lq = lane >> 4, d0 = 2 * lane;
    if (tid < 256) *(LAS f32x4*)(lds + LRS + (tid >> 2) * 64 + (tid & 3) * 16) = S.lrv;
    __syncthreads();
    const LAS float* lrs = (const LAS float*)(lds + LRS);
    float bl0[8], bl1[8]; float cum0 = 0.f, cum1 = 0.f;
#pragma unroll
    for (int i = 0; i < 8; ++i) {
        const int s = wave * 8 + i;
        float z0 = S.gbias.x, z1 = S.gbias.y;
#pragma unroll
        for (int r4 = 0; r4 < 4; ++r4) { const f32x4 lv = *(const LAS f32x4*)(lrs + s * 16 + r4 * 4);
#pragma unroll
            for (int j = 0; j < 4; ++j) { z0 += lv[j] * S.w2r[r4 * 4 + j][0]; z1 += lv[j] * S.w2r[r4 * 4 + j][1]; } }
        const float g0 = (fminf(z0, 0.f) - __logf(1.0f + __expf(-fabsf(z0)))) * 0.0625f;
        const float g1 = (fminf(z1, 0.f) - __logf(1.0f + __expf(-fabsf(z1)))) * 0.0625f;
        cum0 += g0; cum1 += g1; bl0[i] = cum0; bl1[i] = cum1;
    }
    *(LAS f32x2*)(lds + SEG + (wave * 128 + d0) * 4) = (f32x2){cum0, cum1};
    __syncthreads();
    float off0 = 0.f, off1 = 0.f, tot0 = 0.f, tot1 = 0.f;
#pragma unroll
    for (int w = 0; w < 8; ++w) { const f32x2 t = *(const LAS f32x2*)(lds + SEG + (w * 128 + d0) * 4); tot0 += t.x; tot1 += t.y; if (w < wave) { off0 += t.x; off1 += t.y; } }
    const float et0 = __expf(tot0), et1 = __expf(tot1);
    if (wave == 0) *(f32x2*)(GE + (size_t)item * 128 + d0) = (f32x2){et0, et1};
    {
        unsigned ks0[4], ks1[4];
        bf16_t* gq = GQ + (size_t)item * 8192;
#pragma unroll
        for (int i = 0; i < 8; ++i) {
            const int s = wave * 8 + i;
            const float b0 = off0 + bl0[i], b1 = off1 + bl1[i];
            const float q0 = bf_lo(S.qv[i]), q1 = bf_hi(S.qv[i]), k0 = bf_lo(S.kv[i]), k1 = bf_hi(S.kv[i]);
            const float eb0 = __expf(b0), eb1 = __expf(b1), ib0 = __builtin_amdgcn_rcpf(eb0), ib1 = __builtin_amdgcn_rcpf(eb1);
            const unsigned qd = cvt_pk_bf16(q0 * eb0, q1 * eb1);
            *(LAS unsigned*)(lds + QD + s * 272 + d0 * 2) = qd;
            *(unsigned*)(gq + s * 128 + d0) = qd;
            *(LAS unsigned*)(lds + KI + s * 272 + d0 * 2) = cvt_pk_bf16(k0 * ib0, k1 * ib1);
            const float e0 = k0 * (et0 * ib0), e1 = k1 * (et1 * ib1);
            if (i & 1) { ks0[i >> 1] = (ks0[i >> 1] & 0xffffu) | (cvt_pk_bf16(0.f, e0) & 0xffff0000u); ks1[i >> 1] = (ks1[i >> 1] & 0xffffu) | (cvt_pk_bf16(0.f, e1) & 0xffff0000u); }
            else { ks0[i >> 1] = cvt_pk_bf16(e0, 0.f) & 0xffffu; ks1[i >> 1] = cvt_pk_bf16(e1, 0.f) & 0xffffu; }
        }
        bf16_t* gk = GK + (size_t)item * 8192;
        *(u32x4*)(gk + d0 * 64 + wave * 8) = (u32x4){ks0[0], ks0[1], ks0[2], ks0[3]};
        *(u32x4*)(gk + (d0 + 1) * 64 + wave * 8) = (u32x4){ks1[0], ks1[1], ks1[2], ks1[3]};
    }
    __syncthreads();
    {
        bf16_t* gp = GP + (size_t)item * 4096;
        const int t0 = 16 * (wave >> 1);
#pragma unroll
        for (int j = 0; j < 2; ++j) {
            const int s0 = 16 * ((wave & 1) * 2 + j);
            f32x4 a4 = (f32x4){0.f, 0.f, 0.f, 0.f};
#pragma unroll
            for (int kk = 0; kk < 4; ++kk) {
                const bf16x8 af = *(const LAS bf16x8*)(lds + QD + (t0 + l15) * 272 + (kk * 32 + 8 * lq) * 2);
                const bf16x8 bf = *(const LAS bf16x8*)(lds + KI + (s0 + l15) * 272 + (kk * 32 + 8 * lq) * 2);
                a4 = __builtin_amdgcn_mfma_f32_16x16x32_bf16(af, bf, a4, 0, 0, 0);
            }
            const int sc = s0 + l15;
#pragma unroll
            for (int r = 0; r < 4; ++r) { const int t = t0 + 4 * lq + r; gp[t * 64 + sc] = f2bf(sc <= t ? a4[r] : 0.f); }
        }
    }
}
DI void gateprep_phase(const bf16_t* qk, const float* lr, const float* w2, const float* gb, bf16_t* GQ, bf16_t* GK, bf16_t* GP, float* GE, LAS unsigned char* lds) {
    const int tid = tid_opq(), wave = __builtin_amdgcn_readfirstlane(tid >> 6), lane = tid & 63, d0 = 2 * lane;
    const int G = gridDim.x;
    GPStage A, B;
    int item = opq((int)blockIdx.x);
    if (item < NCHI) gp_load(A, item, qk, lr, w2, gb, tid, wave, d0);
    for (; item < NCHI; item += 2 * G) {
        if (item + G < NCHI) gp_load(B, item + G, qk, lr, w2, gb, tid, wave, d0);
        gp_item(A, item, GQ, GK, GP, GE, lds, tid, wave, lane);
        if (item + G < NCHI) {
            if (item + 2 * G < NCHI) gp_load(A, item + 2 * G, qk, lr, w2, gb, tid, wave, d0);
            gp_item(B, item + G, GQ, GK, GP, GE, lds, tid, wave, lane);
        }
    }
    __syncthreads();
}

DI void scan_phase(const bf16_t* vr, const bf16_t* GQ, const bf16_t* GK, const bf16_t* GP, const float* GE, bf16_t* of, bf16_t* ob, LAS unsigned char* lds) {
    constexpr int QD = 0, KST = 17408, VT = 35840, ST = 54272, PP = 89088, BL = 98304;
    const int tid = tid_opq(), wave = __builtin_amdgcn_readfirstlane(tid >> 6), lane = tid & 63;
    const int l31 = lane & 31, lh = lane >> 5;
    for (int item = blockIdx.x; item < 256; item += gridDim.x) {
        const int xcd_ = item & 7, slot_ = item >> 3, dvh = slot_ & 1, pair_ = (slot_ >> 1) * 8 + xcd_;
        const int b = pair_ >> 3, dir = (pair_ >> 2) & 1, h = pair_ & 3;
        bf16_t* obuf = dir ? ob : of;
        const int d0 = 2 * lane;
        const int gi0 = ((b * 2 + dir) * 4 + h) * 68;
        f32x16 Sacc[2];
#pragma unroll
        for (int i = 0; i < 16; ++i) { Sacc[0][i] = 0.f; Sacc[1][i] = 0.f; }
        __syncthreads();
        { unsigned z_ = 0u; asm volatile("" : "+v"(z_));
          for (int o = tid; o < 34816 / 16; o += NTHREADS) *(LAS u32x4*)(lds + ST + o * 16) = (u32x4){z_, z_, z_, z_}; }
        const int vcol = h * 256 + dvh * 128 + d0;
        struct ScStage { u32x4 gq0, gq1, gk0, gk1, gp0; unsigned vv[8]; float ebv; } A, B;
        A.ebv = 0.f; B.ebv = 0.f;
#define SCAN_LOAD(S, c) do { int rb_, sg_; scan_rowbase(dir, b, (c), rb_, sg_); const size_t gi_ = (size_t)(gi0 + (c)); \
        S.gq0 = *(const u32x4*)(GQ + gi_ * 8192 + tid * 8); S.gq1 = *(const u32x4*)(GQ + gi_ * 8192 + 4096 + tid * 8); \
        S.gk0 = *(const u32x4*)(GK + gi_ * 8192 + tid * 8); S.gk1 = *(const u32x4*)(GK + gi_ * 8192 + 4096 + tid * 8); \
        S.gp0 = *(const u32x4*)(GP + gi_ * 4096 + tid * 8); if (tid < 128) S.ebv = GE[gi_ * 128 + tid]; \
        _Pragma("unroll") for (int i = 0; i < 8; ++i) S.vv[i] = *(const unsigned*)(vr + (size_t)(rb_ + sg_ * (wave * 8 + i)) * 2048 + vcol); } while (0)
#define SCAN_CHUNK(S, c) do { \
            int rowbase, sgn; scan_rowbase(dir, b, (c), rowbase, sgn); \
            { const int e0 = tid * 8, e1 = 4096 + tid * 8; \
              *(LAS u32x4*)(lds + QD + (e0 >> 7) * 272 + (e0 & 127) * 2) = S.gq0; *(LAS u32x4*)(lds + QD + (e1 >> 7) * 272 + (e1 & 127) * 2) = S.gq1; \
              *(LAS u32x4*)(lds + KST + (e0 >> 6) * 144 + (e0 & 63) * 2) = S.gk0; *(LAS u32x4*)(lds + KST + (e1 >> 6) * 144 + (e1 & 63) * 2) = S.gk1; \
              *(LAS u32x4*)(lds + PP + (e0 >> 6) * 144 + (e0 & 63) * 2) = S.gp0; \
              if (tid < 128) *(LAS float*)(lds + BL + tid * 4) = S.ebv; \
              unsigned vt0[4], vt1[4]; \
              _Pragma("unroll") for (int i = 0; i < 8; ++i) { \
                  if (i & 1) { vt0[i >> 1] = (vt0[i >> 1] & 0xffffu) | (S.vv[i] << 16); vt1[i >> 1] = (vt1[i >> 1] & 0xffffu) | (S.vv[i] & 0xffff0000u); } \
                  else { vt0[i >> 1] = S.vv[i] & 0xffffu; vt1[i >> 1] = S.vv[i] >> 16; } } \
              *(LAS u32x4*)(lds + VT + d0 * 144 + wave * 16) = (u32x4){vt0[0], vt0[1], vt0[2], vt0[3]}; \
              *(LAS u32x4*)(lds + VT + (d0 + 1) * 144 + wave * 16) = (u32x4){vt1[0], vt1[1], vt1[2], vt1[3]}; \
            } \
            __syncthreads();     \
            if ((c) + 2 < 68) SCAN_LOAD(S, (c) + 2); \
            { \
                const int tq = wave >> 2, vq = wave & 3; \
                f32x16 oacc; \
                _Pragma("unroll") for (int i = 0; i < 16; ++i) oacc[i] = 0.f; \
                _Pragma("unroll") for (int kk = 0; kk < 8; ++kk) { \
                    const bf16x8 af = *(const LAS bf16x8*)(lds + QD + (32 * tq + l31) * 272 + (kk * 16 + 8 * lh) * 2); \
                    const bf16x8 bf = *(const LAS bf16x8*)(lds + ST + (32 * vq + l31) * 272 + (kk * 16 + 8 * lh) * 2); \
                    oacc = __builtin_amdgcn_mfma_f32_32x32x16_bf16(af, bf, oacc, 0, 0, 0); } \
                _Pragma("unroll") for (int kk = 0; kk < 4; ++kk) { \
                    const bf16x8 af = *(const LAS bf16x8*)(lds + PP + (32 * tq + l31) * 144 + (kk * 16 + 8 * lh) * 2); \
                    const bf16x8 bf = *(const LAS bf16x8*)(lds + VT + (32 * vq + l31) * 144 + (kk * 16 + 8 * lh) * 2); \
                    oacc = __builtin_amdgcn_mfma_f32_32x32x16_bf16(af, bf, oacc, 0, 0, 0); } \
                const int ocol = h * 256 + dvh * 128 + 32 * vq + l31; \
                _Pragma("unroll") for (int r = 0; r < 16; ++r) { const int t = 32 * tq + crow(r, lh); obuf[(size_t)(rowbase + sgn * t) * 1024 + ocol] = f2bf(oacc[r]); } \
            } \
            { \
                const int vq = wave & 3; \
                _Pragma("unroll") for (int j = 0; j < 2; ++j) { \
                    const int dq = 2 * (wave >> 2) + j; \
                    _Pragma("unroll") for (int r = 0; r < 16; ++r) Sacc[j][r] *= *(const LAS float*)(lds + BL + (32 * dq + crow(r, lh)) * 4); \
                    _Pragma("unroll") for (int kk = 0; kk < 4; ++kk) { \
                        const bf16x8 af = *(const LAS bf16x8*)(lds + KST + (32 * dq + l31) * 144 + (kk * 16 + 8 * lh) * 2); \
                        const bf16x8 bf = *(const LAS bf16x8*)(lds + VT + (32 * vq + l31) * 144 + (kk * 16 + 8 * lh) * 2); \
                        Sacc[j] = __builtin_amdgcn_mfma_f32_32x32x16_bf16(af, bf, Sacc[j], 0, 0, 0); } } \
            } \
            __syncthreads();     \
            { \
                const int vq = wave & 3; \
                _Pragma("unroll") for (int j = 0; j < 2; ++j) { \
                    const int dq = 2 * (wave >> 2) + j; \
                    _Pragma("unroll") for (int g = 0; g < 4; ++g) { \
                        u32x2 w; w.x = cvt_pk_bf16(Sacc[j][4 * g], Sacc[j][4 * g + 1]); w.y = cvt_pk_bf16(Sacc[j][4 * g + 2], Sacc[j][4 * g + 3]); \
                        *(LAS u32x2*)(lds + ST + (32 * vq + l31) * 272 + (32 * dq + 8 * g + 4 * lh) * 2) = w; } } \
            } } while (0)
        SCAN_LOAD(A, 0); SCAN_LOAD(B, 1);
        for (int c = 0; c < 68; c += 2) { SCAN_CHUNK(A, c); SCAN_CHUNK(B, c + 1); }
#undef SCAN_CHUNK
#undef SCAN_LOAD
    }
    __syncthreads();
}

DI void glapost_phase(const bf16_t* of, const bf16_t* ob, const bf16_t* vr, const float* onorm, bf16_t* a) {
    const int tid = tid_opq(), wave = tid >> 6, lane = tid & 63;
    const int c0 = lane * 16;
    float gn[16];
#pragma unroll
    for (int j = 0; j < 4; ++j) { const f32x4 t = *(const f32x4*)(onorm + (c0 & 255) + 4 * j); gn[4 * j] = t[0]; gn[4 * j + 1] = t[1]; gn[4 * j + 2] = t[2]; gn[4 * j + 3] = t[3]; }
    for (int row0 = (blockIdx.x * 8 + wave) * 4; row0 < MR; row0 += gridDim.x * 32) {
        u32x4 f0[4], f1[4], b0[4], b1[4], r0[4], r1[4];
#pragma unroll
        for (int q = 0; q < 4; ++q) { const size_t ro = (size_t)(row0 + q);
            f0[q] = *(const u32x4*)(of + ro * 1024 + c0); f1[q] = *(const u32x4*)(of + ro * 1024 + c0 + 8);
            b0[q] = *(const u32x4*)(ob + ro * 1024 + c0); b1[q] = *(const u32x4*)(ob + ro * 1024 + c0 + 8);
            r0[q] = *(const u32x4*)(vr + ro * 2048 + 1024 + c0); r1[q] = *(const u32x4*)(vr + ro * 2048 + 1024 + c0 + 8); }
        asm volatile("" ::: "memory");
#pragma unroll
        for (int q = 0; q < 4; ++q) {
            float o[16], rr[16];
#pragma unroll
            for (int j = 0; j < 4; ++j) {
                o[2 * j] = bf_lo(f0[q][j]) + bf_lo(b0[q][j]); o[2 * j + 1] = bf_hi(f0[q][j]) + bf_hi(b0[q][j]);
                o[8 + 2 * j] = bf_lo(f1[q][j]) + bf_lo(b1[q][j]); o[8 + 2 * j + 1] = bf_hi(f1[q][j]) + bf_hi(b1[q][j]);
                rr[2 * j] = bf_lo(r0[q][j]); rr[2 * j + 1] = bf_hi(r0[q][j]); rr[8 + 2 * j] = bf_lo(r1[q][j]); rr[8 + 2 * j + 1] = bf_hi(r1[q][j]);
            }
            float ss = 0.f;
#pragma unroll
            for (int j = 0; j < 16; ++j) ss += o[j] * o[j];
            ss += __shfl_xor(ss, 1); ss += __shfl_xor(ss, 2); ss += __shfl_xor(ss, 4); ss += __shfl_xor(ss, 8);
            const float rstd = rsqrtf(ss * (1.0f / 256.0f) + 1e-6f);
            unsigned w[8];
#pragma unroll
            for (int j = 0; j < 8; ++j) {
                const float y0 = o[2 * j] * rstd * gn[2 * j] * silu_f(rr[2 * j]), y1 = o[2 * j + 1] * rstd * gn[2 * j + 1] * silu_f(rr[2 * j + 1]);
                w[j] = cvt_pk_bf16(y0, y1);
            }
            *(u32x4*)(a + (size_t)(row0 + q) * 1024 + c0) = (u32x4){w[0], w[1], w[2], w[3]};
            *(u32x4*)(a + (size_t)(row0 + q) * 1024 + c0 + 8) = (u32x4){w[4], w[5], w[6], w[7]};
        }
    }
}

DI void rope_cs(int tpos, int lane, float& cs, float& sn) {
    const int f = lane & 15; const int pos = (lane >> 5) ? (tpos & 63) : (tpos >> 6);
    const float inv = exp2f(-(float)f * (13.287712379549449f / 16.0f));
    const float ang = (float)pos * inv;
    const float kf = rintf(ang * 0.15915494309189535f);
    float r = fmaf(-kf, 6.2831854820251465f, ang); r = fmaf(-kf, -1.7484556000744883e-7f, r);
    cs = __cosf(r); sn = __sinf(r);
}
DI float rope_apply(float y, int lane, float cs, float sn) {
    const float pr = __shfl_xor(y, 16);
    return (lane & 16) ? (pr * sn + y * cs) : (y * cs - pr * sn);
}
DI int key_of_row(int row) {
    if (row < TL) { const int b = row >> 12; return b * KEYS + CTXL + (row & 4095); }
    const int rc = row - TL; const int b = rc >> 8; return b * KEYS + (rc & 255);
}

DI void mlamid_phase(const bf16_t* dn, const float* qln, const float* kvln, const float* knorm, bf16_t* cqn, bf16_t* ckvn, bf16_t* KB) {
    const int tid = tid_opq(), wave = tid >> 6, lane = tid & 63;
    float gq[6];
#pragma unroll
    for (int i = 0; i < 3; ++i) { gq[2 * i] = qln[i * 128 + 2 * lane]; gq[2 * i + 1] = qln[i * 128 + 2 * lane + 1]; }
    const f32x4 gkv = *(const f32x4*)(kvln + 4 * lane);
    const float gpe = knorm[128 + lane];
    for (int row0 = (blockIdx.x * 8 + wave) * 4; row0 < MR; row0 += gridDim.x * 32) {
        unsigned q[4][3]; u32x2 kvv[4]; bf16_t pe[4];
#pragma unroll
        for (int r = 0; r < 4; ++r) { const bf16_t* src = dn + (size_t)(row0 + r) * 768;
#pragma unroll
            for (int i = 0; i < 3; ++i) q[r][i] = *(const unsigned*)(src + i * 128 + 2 * lane);
            kvv[r] = *(const u32x2*)(src + 384 + 4 * lane); pe[r] = src[640 + lane]; }
#pragma unroll
        for (int r = 0; r < 4; ++r) {
            const int row = row0 + r;
            float ss = 0.f;
#pragma unroll
            for (int i = 0; i < 3; ++i) { const float a = bf_lo(q[r][i]), b = bf_hi(q[r][i]); ss += a * a + b * b; }
            ss = wave_sum(ss);
            float rstd = rsqrtf(ss * (1.0f / 384.0f) + 1e-6f);
#pragma unroll
            for (int i = 0; i < 3; ++i) *(unsigned*)(cqn + (size_t)row * 384 + i * 128 + 2 * lane) = cvt_pk_bf16(bf_lo(q[r][i]) * rstd * gq[2 * i], bf_hi(q[r][i]) * rstd * gq[2 * i + 1]);
            const float k0 = bf_lo(kvv[r].x), k1 = bf_hi(kvv[r].x), k2 = bf_lo(kvv[r].y), k3 = bf_hi(kvv[r].y);
            ss = wave_sum(k0 * k0 + k1 * k1 + k2 * k2 + k3 * k3);
            rstd = rsqrtf(ss * (1.0f / 256.0f) + 1e-6f);
            { u32x2 w; w.x = cvt_pk_bf16(k0 * rstd * gkv[0], k1 * rstd * gkv[1]); w.y = cvt_pk_bf16(k2 * rstd * gkv[2], k3 * rstd * gkv[3]);
              *(u32x2*)(ckvn + (size_t)row * 256 + 4 * lane) = w; }
            const float x = __uint_as_float(((unsigned)pe[r]) << 16);
            ss = wave_sum(x * x);
            rstd = rsqrtf(ss * (1.0f / 64.0f) + 1e-6f);
            float y = x * rstd * gpe;
            if (row < TL) { float cs, sn; rope_cs(row & 4095, lane, cs, sn); y = rope_apply(y, lane, cs, sn); }
            const bf16_t yb = f2bf(y);
            bf16_t* kd = KB + (size_t)key_of_row(row) * 1536 + 128 + lane;
#pragma unroll
            for (int hh = 0; hh < 8; ++hh) kd[hh * 192] = yb;
        }
    }
}

DI void qkprep_phase(bf16_t* KB, const float* knorm) {
    const int tid = tid_opq(), wave = tid >> 6, lane = tid & 63;
    const float kn0 = knorm[2 * lane], kn1 = knorm[2 * lane + 1];
    for (int row0 = (blockIdx.x * 8 + wave) * 2; row0 < MR; row0 += gridDim.x * 16) {
        unsigned ka[2][8];
        bf16_t* kr0 = KB + (size_t)key_of_row(row0) * 1536; bf16_t* kr1 = KB + (size_t)key_of_row(row0 + 1) * 1536;
#pragma unroll
        for (int hh = 0; hh < 8; ++hh) { ka[0][hh] = *(const unsigned*)(kr0 + hh * 192 + 2 * lane); ka[1][hh] = *(const unsigned*)(kr1 + hh * 192 + 2 * lane); }
        asm volatile("" ::: "memory");
#pragma unroll
        for (int r = 0; r < 2; ++r) {
            bf16_t* kr = r ? kr1 : kr0;
#pragma unroll
            for (int hh = 0; hh < 8; ++hh) {
                const float c0 = bf_lo(ka[r][hh]), c1 = bf_hi(ka[r][hh]);
                const float s3 = wave_sum(c0 * c0 + c1 * c1);
                const float r3 = rsqrtf(s3 * (1.0f / 128.0f) + 1e-6f);
                *(unsigned*)(kr + hh * 192 + 2 * lane) = cvt_pk_bf16(c0 * r3 * kn0, c1 * r3 * kn1);
            }
        }
    }
}

namespace att {
constexpr int DQK = 192, DV = 128, NW = 8, QBLK = 32, KVBLK = 64;
constexpr int LDQ = 1536, LDK = 1536, LDV = 1024, LDO = 1024;
constexpr float SCALE = 0.07216878364870322f;
constexpr float THR = 8.f;
constexpr size_t SHM_V = KVBLK * DV * 2, SHM_K = KVBLK * DQK * 2;
#define KSWZ(row, colB) ((row) * 384 + ((colB) ^ ((((row) >> 1) & 7) << 4)))
#define SBAR() __builtin_amdgcn_sched_barrier(0)
DI unsigned cvtpk(float lo, float hi) { unsigned r; asm volatile("v_cvt_pk_bf16_f32 %0, %1, %2" : "=v"(r) : "v"(lo), "v"(hi)); return r; }
DI void partialSM(f32x16& p0, f32x16& p1, float& m_reg, float& mn, float& alpha) {
    constexpr float C = SCALE * 1.4426950408889634f;
    float pmax = p0[0];
#pragma unroll
    for (int r = 1; r < 16; ++r) pmax = fmaxf(pmax, p0[r]);
#pragma unroll
    for (int r = 0; r < 16; ++r) pmax = fmaxf(pmax, p1[r]);
    { auto rr = __builtin_amdgcn_permlane32_swap(__float_as_uint(pmax), __float_as_uint(pmax), false, false);
      pmax = fmaxf(__uint_as_float(rr[0]), __uint_as_float(rr[1])); }
    if (__builtin_expect(__all(pmax - m_reg <= THR / SCALE), 1)) { mn = m_reg; alpha = 1.f; }
    else { mn = fmaxf(m_reg, pmax); alpha = __builtin_amdgcn_exp2f((m_reg - mn) * C); m_reg = mn; }
    const float mnC = -mn * C;
#pragma unroll
    for (int r = 0; r < 16; ++r) p0[r] = fmaf(p0[r], C, mnC);
#pragma unroll
    for (int r = 0; r < 16; ++r) p1[r] = fmaf(p1[r], C, mnC);
#pragma unroll
    for (int r = 0; r < 16; ++r) p0[r] = __builtin_amdgcn_exp2f(p0[r]);
}
DI void finishSM(f32x16& p0, f32x16& p1, float alpha, float& l_reg, bf16x8& pa0, bf16x8& pa1, bf16x8& pa2, bf16x8& pa3) {
#pragma unroll
    for (int r = 0; r < 16; ++r) p1[r] = __builtin_amdgcn_exp2f(p1[r]);
    float ps = 0;
#pragma unroll
    for (int r = 0; r < 16; ++r) ps += p0[r];
#pragma unroll
    for (int r = 0; r < 16; ++r) ps += p1[r];
    { auto rr = __builtin_amdgcn_permlane32_swap(__float_as_uint(ps), __float_as_uint(ps), false, false);
      ps = __uint_as_float(rr[0]) + __uint_as_float(rr[1]); }
    l_reg = l_reg * alpha + ps;
#define PK4(P, BASE, OUT) do { unsigned a0 = cvtpk(P[BASE + 0], P[BASE + 1]), a1 = cvtpk(P[BASE + 2], P[BASE + 3]);   \
    unsigned b0 = cvtpk(P[BASE + 4], P[BASE + 5]), b1 = cvtpk(P[BASE + 6], P[BASE + 7]);                              \
    auto r0 = __builtin_amdgcn_permlane32_swap(a0, b0, false, false); auto r1 = __builtin_amdgcn_permlane32_swap(a1, b1, false, false); \
    u32x4 w = {r0[0], r1[0], r0[1], r1[1]}; OUT = *reinterpret_cast<bf16x8*>(&w); } while (0)
    PK4(p0, 0, pa0); PK4(p0, 8, pa1); PK4(p1, 0, pa2); PK4(p1, 8, pa3);
#undef PK4
}
DI void qkt(f32x16& p0, f32x16& p1, const char* Ks, const bf16x8* qr, int r32, int hi) {
#pragma unroll
    for (int r = 0; r < 16; ++r) { p0[r] = 0.f; p1[r] = 0.f; }
    bf16x8 ka[3], kb[3];
#define QK_RD(D0, SLOT) do { const int cb_ = ((D0) * 16 + hi * 8) * 2; ka[SLOT] = *reinterpret_cast<const bf16x8*>(Ks + KSWZ(r32, cb_)); kb[SLOT] = *reinterpret_cast<const bf16x8*>(Ks + KSWZ(32 + r32, cb_)); } while (0)
    QK_RD(0, 0); QK_RD(1, 1);
    __builtin_amdgcn_sched_barrier(0);
#pragma unroll
    for (int d0 = 0; d0 < 12; ++d0) {
        if (d0 + 2 < 12) QK_RD(d0 + 2, (d0 + 2) % 3);
        p0 = __builtin_amdgcn_mfma_f32_32x32x16_bf16(ka[d0 % 3], qr[d0], p0, 0, 0, 0);
        p1 = __builtin_amdgcn_mfma_f32_32x32x16_bf16(kb[d0 % 3], qr[d0], p1, 0, 0, 0);
        __builtin_amdgcn_sched_barrier(0);
    }
#undef QK_RD
}
DI int v_st(int k, int c) { const int kk = (k & ~0xC) | ((k & 4) << 1) | ((k & 8) >> 1); return ((kk >> 3) * 4 + (c >> 5)) * 512 + ((kk & 7) * 32 + (c & 31)) * 2; }
DI int v_rd_base(int lane) { return ((lane & 3) << 3) | (((lane >> 2) & 3) << 6) | (((lane >> 4) & 1) << 5) | (((lane >> 5) & 1) << 8); }
constexpr int v_rd_off(int d0, int ks, int half) { return d0 * 512 + ks * 4096 + half * 2048; }
template <int OFF> DI s16x4 tr_read(int vb) { s16x4 r; asm volatile("ds_read_b64_tr_b16 %0, %1 offset:%2" : "=&v"(r) : "v"(vb), "i"(OFF) : "memory"); return r; }
template <int D0> DI void pv_one(f32x16& od, int vb, bf16x8 pa0, bf16x8 pa1, bf16x8 pa2, bf16x8 pa3) {
    const s16x4 l0 = tr_read<v_rd_off(D0, 0, 0)>(vb), h0 = tr_read<v_rd_off(D0, 0, 1)>(vb), l1 = tr_read<v_rd_off(D0, 1, 0)>(vb), h1 = tr_read<v_rd_off(D0, 1, 1)>(vb);
    const s16x4 l2 = tr_read<v_rd_off(D0, 2, 0)>(vb), h2 = tr_read<v_rd_off(D0, 2, 1)>(vb), l3 = tr_read<v_rd_off(D0, 3, 0)>(vb), h3 = tr_read<v_rd_off(D0, 3, 1)>(vb);
    asm volatile("s_waitcnt lgkmcnt(0)" ::: "memory"); SBAR();
#define PK(L, H) (bf16x8){L[0], L[1], L[2], L[3], H[0], H[1], H[2], H[3]}
    od = __builtin_amdgcn_mfma_f32_32x32x16_bf16(pa0, PK(l0, h0), od, 0, 0, 0);
    od = __builtin_amdgcn_mfma_f32_32x32x16_bf16(pa1, PK(l1, h1), od, 0, 0, 0);
    od = __builtin_amdgcn_mfma_f32_32x32x16_bf16(pa2, PK(l2, h2), od, 0, 0, 0);
    od = __builtin_amdgcn_mfma_f32_32x32x16_bf16(pa3, PK(l3, h3), od, 0, 0, 0);
#undef PK
}
DI void pv_d0(f32x16* o, int vb, bf16x8 pa0, bf16x8 pa1, bf16x8 pa2, bf16x8 pa3) {
    pv_one<0>(o[0], vb, pa0, pa1, pa2, pa3); pv_one<1>(o[1], vb, pa0, pa1, pa2, pa3); pv_one<2>(o[2], vb, pa0, pa1, pa2, pa3); pv_one<3>(o[3], vb, pa0, pa1, pa2, pa3);
}
DI void attn_body(const bf16_t* __restrict__ Qb, const bf16_t* __restrict__ Kh, const bf16_t* __restrict__ Vh, bf16_t* __restrict__ Ob, int seq, char* lds, const float* __restrict__ qnorm, int tpos0) {
    const int tid = tid_opq(), wid = tid >> 6, lane = tid & 63, r32 = lane & 31, hi = lane >> 5;
    char* V_lds = lds; char* K_lds = lds + 2 * SHM_V;
    float* wsf = (float*)(lds + 2 * SHM_V + 2 * SHM_K) + wid * 64; float* li_l = wsf; float* al_l = wsf + 32;
    float m_reg = -1e30f, l_reg = 0; f32x16 o[4]; bf16x8 qr[12];
#pragma unroll
    for (int d = 0; d < 4; ++d)
#pragma unroll
        for (int r = 0; r < 16; ++r) o[d][r] = 0.f;
    const bf16_t* Qw = Qb + (long)(wid * QBLK + r32) * LDQ + hi * 8;
#pragma unroll
    for (int d0 = 0; d0 < 12; ++d0) qr[d0] = *reinterpret_cast<const bf16x8*>(Qw + d0 * 16);
    {
        float ssn = 0.f, ssr = 0.f;
#pragma unroll
        for (int d0 = 0; d0 < 12; ++d0) {
            const u32x4 w = *reinterpret_cast<const u32x4*>(&qr[d0]); float t = 0.f;
#pragma unroll
            for (int j = 0; j < 4; ++j) { const float a = bf_lo(w[j]), b = bf_hi(w[j]); t += a * a + b * b; }
            if (d0 < 8) ssn += t; else ssr += t;
        }
        ssn += __shfl_xor(ssn, 32); ssr += __shfl_xor(ssr, 32);
        const float rn = rsqrtf(ssn * (1.0f / 128.0f) + 1e-6f), rr = rsqrtf(ssr * (1.0f / 64.0f) + 1e-6f);
        float cs[2][8], sn[2][8];
        if (tpos0 >= 0) {
            const int t = tpos0 + wid * QBLK + r32;
#pragma unroll
            for (int a = 0; a < 2; ++a) { const float pos = (float)(a ? (t & 63) : (t >> 6));
#pragma unroll
                for (int j = 0; j < 8; ++j) { const float inv = exp2f(-(float)(hi * 8 + j) * (13.287712379549449f / 16.0f)); const float ang = pos * inv;
                    const float kf = rintf(ang * 0.15915494309189535f); float r = fmaf(-kf, 6.2831854820251465f, ang); r = fmaf(-kf, -1.7484556000744883e-7f, r);
                    cs[a][j] = __cosf(r); sn[a][j] = __sinf(r); } }
        } else {
#pragma unroll
            for (int a = 0; a < 2; ++a)
#pragma unroll
                for (int j = 0; j < 8; ++j) { cs[a][j] = 1.f; sn[a][j] = 0.f; }
        }
#pragma unroll
        for (int d0 = 0; d0 < 8; ++d0) {
            const u32x4 w = *reinterpret_cast<const u32x4*>(&qr[d0]); const float* gp = qnorm + d0 * 16 + hi * 8; const f32x4 g0 = *(const f32x4*)gp, g1 = *(const f32x4*)(gp + 4);
            u32x4 o4; o4.x = cvt_pk_bf16(bf_lo(w.x) * rn * g0[0], bf_hi(w.x) * rn * g0[1]); o4.y = cvt_pk_bf16(bf_lo(w.y) * rn * g0[2], bf_hi(w.y) * rn * g0[3]);
            o4.z = cvt_pk_bf16(bf_lo(w.z) * rn * g1[0], bf_hi(w.z) * rn * g1[1]); o4.w = cvt_pk_bf16(bf_lo(w.w) * rn * g1[2], bf_hi(w.w) * rn * g1[3]);
            qr[d0] = *reinterpret_cast<const bf16x8*>(&o4);
        }
#pragma unroll
        for (int a = 0; a < 2; ++a) {
            const u32x4 w1 = *reinterpret_cast<const u32x4*>(&qr[8 + 2 * a]), w2 = *reinterpret_cast<const u32x4*>(&qr[9 + 2 * a]);
            const float* g1p = qnorm + (8 + 2 * a) * 16 + hi * 8; const float* g2p = g1p + 16;
            float x1[8], x2[8], y1[8], y2[8];
#pragma unroll
            for (int j = 0; j < 4; ++j) { x1[2 * j] = bf_lo(w1[j]) * rr * g1p[2 * j]; x1[2 * j + 1] = bf_hi(w1[j]) * rr * g1p[2 * j + 1]; x2[2 * j] = bf_lo(w2[j]) * rr * g2p[2 * j]; x2[2 * j + 1] = bf_hi(w2[j]) * rr * g2p[2 * j + 1]; }
#pragma unroll
            for (int j = 0; j < 8; ++j) { y1[j] = x1[j] * cs[a][j] - x2[j] * sn[a][j]; y2[j] = x1[j] * sn[a][j] + x2[j] * cs[a][j]; }
            u32x4 o1, o2;
            o1.x = cvt_pk_bf16(y1[0], y1[1]); o1.y = cvt_pk_bf16(y1[2], y1[3]); o1.z = cvt_pk_bf16(y1[4], y1[5]); o1.w = cvt_pk_bf16(y1[6], y1[7]);
            o2.x = cvt_pk_bf16(y2[0], y2[1]); o2.y = cvt_pk_bf16(y2[2], y2[3]); o2.z = cvt_pk_bf16(y2[4], y2[5]); o2.w = cvt_pk_bf16(y2[6], y2[7]);
            qr[8 + 2 * a] = *reinterpret_cast<const bf16x8*>(&o1); qr[9 + 2 * a] = *reinterpret_cast<const bf16x8*>(&o2);
        }
    }
    const int sr = tid >> 4, sc = (tid & 15) * 8, vst0 = v_st(sr, sc), vst1 = v_st(32 + sr, sc);
    const int pr = tid >> 3, pc = 128 + (tid & 7) * 8;
    const int vb0 = (int)(uintptr_t)V_lds + v_rd_base(lane);
    bf16x8 vs0, vs1, ks0, ks1, kp;
#define SLOAD(k0) do { vs0 = *reinterpret_cast<const bf16x8*>(&Vh[(long)((k0) + sr) * LDV + sc]); vs1 = *reinterpret_cast<const bf16x8*>(&Vh[(long)((k0) + 32 + sr) * LDV + sc]); \
    ks0 = *reinterpret_cast<const bf16x8*>(&Kh[(long)((k0) + sr) * LDK + sc]); ks1 = *reinterpret_cast<const bf16x8*>(&Kh[(long)((k0) + 32 + sr) * LDK + sc]); \
    kp = *reinterpret_cast<const bf16x8*>(&Kh[(long)((k0) + pr) * LDK + pc]); } while (0)
#define SWRITE(b) do { *(bf16x8*)(V_lds + (b) * SHM_V + vst0) = vs0; *(bf16x8*)(V_lds + (b) * SHM_V + vst1) = vs1; \
    *(bf16x8*)(K_lds + (b) * SHM_K + KSWZ(sr, sc * 2)) = ks0; *(bf16x8*)(K_lds + (b) * SHM_K + KSWZ(32 + sr, sc * 2)) = ks1; \
    *(bf16x8*)(K_lds + (b) * SHM_K + KSWZ(pr, pc * 2)) = kp; } while (0)
#define RESC(a) do { if (__any((a) < 1.f)) { if (hi == 0) al_l[r32] = (a); asm volatile("s_waitcnt lgkmcnt(0)" ::: "memory"); \
    _Pragma("unroll") for (int d = 0; d < 4; ++d) _Pragma("unroll") for (int r = 0; r < 16; ++r) o[d][r] *= al_l[crow(r, hi)]; } } while (0)
    f32x16 p0, p1; float mn, al; bf16x8 pa0, pa1, pa2, pa3; const int NT = seq / KVBLK;
    SLOAD(0); asm volatile("s_waitcnt vmcnt(0)" ::: "memory"); SWRITE(0); __syncthreads();
    for (int j = 0; j < NT; ++j) {
        const int cb = j & 1;
        if (j + 1 < NT) SLOAD((j + 1) * KVBLK);
        SBAR(); qkt(p0, p1, K_lds + cb * SHM_K, qr, r32, hi);
        partialSM(p0, p1, m_reg, mn, al);
        finishSM(p0, p1, al, l_reg, pa0, pa1, pa2, pa3);
        RESC(al); SBAR();
        pv_d0(o, vb0 + cb * (int)SHM_V, pa0, pa1, pa2, pa3);
        if (j + 1 < NT) { asm volatile("s_waitcnt vmcnt(0)" ::: "memory"); SWRITE(cb ^ 1); }
        __syncthreads();
    }
    if (hi == 0) li_l[r32] = l_reg; asm volatile("s_waitcnt lgkmcnt(0)" ::: "memory");
    float rli[16];
#pragma unroll
    for (int r = 0; r < 16; ++r) rli[r] = __builtin_amdgcn_rcpf(li_l[crow(r, hi)]);
    bf16_t* Ow = Ob + (long)(wid * QBLK) * LDO;
#pragma unroll
    for (int r = 0; r < 16; ++r) { const int orow = crow(r, hi);
#pragma unroll
        for (int d0 = 0; d0 < 4; ++d0) Ow[(long)orow * LDO + d0 * 32 + r32] = f2bf(o[d0][r] * rli[r]); }
#undef SLOAD
#undef SWRITE
#undef RESC
}
#undef KSWZ
#undef SBAR
}

DI void attn_phase(const bf16_t* Q, const bf16_t* KB, const bf16_t* VB, bf16_t* O, char* lds, int nitems, const float* qnorm) {
    for (int it = blockIdx.x; it < nitems; it += gridDim.x) {
        int b, h, qrow0, seq, tpos0;
        if (it < 2048) {
            const int rnd = it >> 8, blk = it & 255, xcd_ = blk & 7, slot_ = blk >> 3, idx = rnd * 16 + xcd_ * 2 + (slot_ >> 4);
            b = idx >> 3; h = idx & 7; tpos0 = (slot_ & 15) * 256; qrow0 = b * SEQ + tpos0; seq = KEYS; }
        else { const int j = it - 2048; b = j >> 3; h = j & 7; qrow0 = TL + b * CTXL; seq = CTXL; tpos0 = -1; }
        att::attn_body(Q + (size_t)qrow0 * 1536 + h * 192, KB + (size_t)b * KEYS * 1536 + h * 192, VB + (size_t)b * KEYS * 1024 + h * 128,
                       O + (size_t)qrow0 * 1024 + h * 128, seq, lds, qnorm, tpos0);
        __syncthreads();
    }
}

DI void fixup_phase(const float* halo, const float* cw, const float* cb, bf16_t* act) {
    const int gtid = blockIdx.x * NTHREADS + tid_opq(), gstride = gridDim.x * NTHREADS;
    for (int idx = gtid; idx < 272 * 22 * 64; idx += gstride) {
        const int c4 = (idx & 31) * 4, which = (idx >> 5) & 1, t = idx >> 6, pn = t % 22, pm = t / 22;
        const float* hp = halo + (size_t)(pm * 22 + pn) * 4 * 256;
        const bool sfirst = pm >= 256 || (pm & 15) == 0, slast = pm >= 256 || (pm & 15) == 15;
        const f32x4 z4 = (f32x4){0.f, 0.f, 0.f, 0.f};
        f32x4 pa, pg, ca, cg_, na, ng; int row;
        if (which == 0) { row = pm * 256;
            if (sfirst) { pa = z4; pg = z4; } else { const float* q = halo + (size_t)((pm - 1) * 22 + pn) * 4 * 256 + 3 * 256; pa = *(const f32x4*)(q + c4); pg = *(const f32x4*)(q + 128 + c4); }
            ca = *(const f32x4*)(hp + c4); cg_ = *(const f32x4*)(hp + 128 + c4); na = *(const f32x4*)(hp + 256 + c4); ng = *(const f32x4*)(hp + 256 + 128 + c4);
        } else { row = pm * 256 + 255;
            pa = *(const f32x4*)(hp + 2 * 256 + c4); pg = *(const f32x4*)(hp + 2 * 256 + 128 + c4); ca = *(const f32x4*)(hp + 3 * 256 + c4); cg_ = *(const f32x4*)(hp + 3 * 256 + 128 + c4);
            if (slast) { na = z4; ng = z4; } else { const float* q = halo + (size_t)((pm + 1) * 22 + pn) * 4 * 256; na = *(const f32x4*)(q + c4); ng = *(const f32x4*)(q + 128 + c4); }
        }
        const int ch = pn * 128 + c4;
        const f32x4 w0a = *(const f32x4*)(cw + ch), w1a = *(const f32x4*)(cw + 5632 + ch), w2a = *(const f32x4*)(cw + 2 * 5632 + ch), ba = *(const f32x4*)(cb + ch);
        const f32x4 w0g = *(const f32x4*)(cw + 2816 + ch), w1g = *(const f32x4*)(cw + 5632 + 2816 + ch), w2g = *(const f32x4*)(cw + 2 * 5632 + 2816 + ch), bg = *(const f32x4*)(cb + 2816 + ch);
        const f32x4 av = w0a * pa + w1a * ca + w2a * na + ba, gv = w0g * pg + w1g * cg_ + w2g * ng + bg;
        u32x2 w; w.x = cvt_pk_bf16(silu_f(gv[0]) * av[0], silu_f(gv[1]) * av[1]); w.y = cvt_pk_bf16(silu_f(gv[2]) * av[2], silu_f(gv[3]) * av[3]);
        *(u32x2*)(act + (size_t)row * 2816 + ch) = w;
    }
}


#define XB_TMO      128
#define XB_XCNT(j)  (256  + 64 * (j))
#define XB_XSUB(j)  (1280 + 64 * (j))
#define XB_XGEN(j)  (2304 + 64 * (j))
#define XB_TOP      3328
#define XB_TOPGEN   3392
#define XCD_BAR_WORDS 3456
#define XB_SPIN_CAP (1u << 18)
DI unsigned xb_ld(unsigned* p)              { return __hip_atomic_load(p, __ATOMIC_RELAXED, __HIP_MEMORY_SCOPE_AGENT); }
DI unsigned xb_add(unsigned* p, unsigned v) { return __hip_atomic_fetch_add(p, v, __ATOMIC_RELAXED, __HIP_MEMORY_SCOPE_AGENT); }
DI unsigned xb_xcc_id() { return (unsigned)__builtin_amdgcn_s_getreg((3 << 11) | 20) & 0xFu; }
#define XB_SPIN(cond, bar) do { unsigned _sp = 0; while (cond) { __builtin_amdgcn_s_sleep(1); \
    if ((++_sp & 255u) == 0u) { if (xb_ld(&(bar)[XB_TMO])) break; if (_sp > XB_SPIN_CAP) { atomicAdd(&(bar)[XB_TMO], 1u); break; } } } } while (0)
struct XcdBarrier { unsigned* bar; unsigned x; volatile LAS unsigned* st; };
DI XcdBarrier xcd_barrier_post(unsigned* bar, volatile LAS unsigned* st) {
    XcdBarrier b; b.bar = bar; b.x = xb_xcc_id(); b.st = st;
    if (threadIdx.x == 0) (void)xb_add(&bar[XB_XCNT(b.x)], 1u);
    return b;
}
DI void xcd_barrier_complete(unsigned* bar, unsigned x, unsigned& nloc, unsigned& nx) {
    const unsigned G = gridDim.x * gridDim.y * gridDim.z;
    unsigned sum, cnt, mine, sp = 0u;
    for (;;) {
        sum = 0u; cnt = 0u; mine = 0u;
#pragma unroll
        for (unsigned j = 0; j < 16; ++j) { const unsigned c = xb_ld(&bar[XB_XCNT(j)]); sum += c; cnt += (c > 0u) ? 1u : 0u; mine = (j == x) ? c : mine; }
        if (sum == G) break;
        __builtin_amdgcn_s_sleep(1);
        if ((++sp & 255u) == 0u) { if (xb_ld(&bar[XB_TMO])) break; if (sp > XB_SPIN_CAP) { atomicAdd(&bar[XB_TMO], 1u); break; } }
    }
    nloc = mine > 0u ? mine : 1u; nx = cnt > 0u ? cnt : 1u;
}
DI void xcd_barrier(const XcdBarrier& b) {
    asm volatile("s_waitcnt vmcnt(0)" ::: "memory");
    __syncthreads();
    if (threadIdx.x == 0) {
        unsigned* bar = b.bar;
        __builtin_amdgcn_s_waitcnt(0);
        unsigned nloc = b.st[0], nx = b.st[1];
        if (nloc == 0u) { xcd_barrier_complete(bar, b.x, nloc, nx); b.st[0] = nloc; b.st[1] = nx; }
        const unsigned old = xb_add(&bar[XB_XSUB(b.x)], 1u);
        const unsigned gen = old / nloc;
        if (old + 1u == (gen + 1u) * nloc) {
            __builtin_amdgcn_fence(__ATOMIC_RELEASE, "agent");
            asm volatile("s_waitcnt vmcnt(0)" ::: "memory");
            const unsigned og = xb_add(&bar[XB_TOP], 1u);
            const unsigned tg = og / nx;
            if (og + 1u == (tg + 1u) * nx) xb_add(&bar[XB_TOPGEN], 1u);
            else XB_SPIN(xb_ld(&bar[XB_TOPGEN]) == tg, bar);
            __builtin_amdgcn_fence(__ATOMIC_ACQUIRE, "agent");
            xb_add(&bar[XB_XGEN(b.x)], 1u);
            asm volatile("s_waitcnt vmcnt(0)" ::: "memory");
        } else {
            XB_SPIN(xb_ld(&bar[XB_XGEN(b.x)]) == gen, bar);
            __builtin_amdgcn_fence(__ATOMIC_ACQUIRE, "agent");
            asm volatile("s_waitcnt vmcnt(0)" ::: "memory");
        }
    }
    __syncthreads();
}

__global__ void __launch_bounds__(NTHREADS) mega(Params p) {
    extern __shared__ __attribute__((aligned(16))) unsigned char smem[];
    LAS unsigned char* lds = (LAS unsigned char*)smem;
    cg::grid_group grid = cg::this_grid();
    volatile LAS unsigned* xb_st = (volatile LAS unsigned*)(lds + XB_ST_OFF);
    if (threadIdx.x < 4) xb_st[threadIdx.x] = 0u;
    __syncthreads();
    XcdBarrier xbar = xcd_barrier_post((unsigned*)((unsigned char*)p.in[27] + WS_BAR), xb_st);

    for (int ph = p.ph_lo; ph < p.ph_hi; ++ph) {
        unsigned char* ws = (unsigned char*)p.in[opq(27)];
        float* const xout = (float*)p.in[opq(26)];
        float* mod = (float*)(ws + WS_MOD);
        float* xc = (float*)(ws + WS_XC);
        bf16_t* hbuf = (bf16_t*)(ws + WS_H);
        if (ph == 0) {
            prep_phase(p, lds);
#if defined(MK_DUP_OP) && MK_DUP_OP == 99
            grid.sync(); prep_phase(p, lds);
#endif
        } else {
            const int q = ph - 1, lp = q / 21; int r = q % 21; int layer, nmix;
            if (r < 10) { layer = 2 * lp; nmix = 6; } else { layer = 2 * lp + 1; r -= 10; nmix = 7; }
            const bool is_mla = layer & 1; const int j = layer >> 1;
            const float* modl = mod + (size_t)layer * 17 * 6144;
            const bool first = (layer == 0);
            int op = -1, gsel = 0, hf = 0;
            if (r < nmix) {
                if (!is_mla) { op = r == 0 ? 0 : r == 1 ? 2 : r == 2 ? 9 : r == 3 ? 3 : r == 4 ? 4 : 2; gsel = r == 1 ? 0 : 1; }
                else { op = r == 0 ? 0 : r == 1 ? 2 : r == 2 ? 5 : r == 3 ? 2 : r == 4 ? 6 : r == 5 ? 7 : 2; gsel = r == 1 ? 2 : r == 3 ? 3 : 5; }
            } else {
                const int f = r - nmix;
                op = f == 0 ? 1 : f == 2 ? 8 : 2; gsel = f == 1 ? 6 : 7;
            }
            if (op == 1 || (op == 0 && layer > 0)) continue;
#ifdef MK_DUP_OP
            for (int rep_ = 0; rep_ < ((op == MK_DUP_OP || (op == 2 && gsel == MK_DUP_OP - 100)) ? 2 : 1); ++rep_) {
            if (rep_) grid.sync();
#else
            {
#endif
            if (op == 0) {
                norm_phase(p.in[opq(0)], p.in[opq(2)], p.in[opq(6)], modl, 0, 1024, hbuf);
                shw_phase(ws, lds);
            } else if (op == 2) {
                const int ng = (gsel == 3) ? 2 : 1;
                for (int gi = 0; gi < ng; ++gi) {
                    pg8::Gemm g; Epi E; int kind = EPI_BF16;
                    E.ldc = 0; E.xch = (LAS float*)(lds + XCH_OFF); E.q0 = nullptr; E.q1 = nullptr; E.q2 = nullptr; E.q3 = nullptr; E.q4 = nullptr; E.q5 = nullptr;
                    float* const shw_mix = (float*)(ws + WS_SHW) + (size_t)(layer * 2) * 17 * 5632; float* const shw_ffn = shw_mix + 17 * 5632;
                    float* const rs0 = (float*)(ws + WS_RS); float* const rs1 = rs0 + MR;
                    g.M = MR;
                    const int gs = gsel + gi;
                    if (gs == 0) { g.A = hbuf; g.Bt = (const bf16_t*)(ws + WS_GIN + j * SZ_GIN); g.N = 3328; g.K = 1024; g.lda = 1024; g.ldb = 1024;
                        kind = EPI_GLA_IN; E.q0 = ws + WS_QK; E.ldc = 1024; E.q1 = ws + WS_LR; E.q2 = ws + WS_VR; if (!first) { E.q3 = rs1; E.q4 = shw_mix; } }
                    else if (gs == 1 || gs == 5) { g.A = hbuf; g.Bt = (const bf16_t*)(ws + (gs == 1 ? WS_GOUT : WS_MOUT) + j * SZ_SQ); g.N = 1024; g.K = 1024; g.lda = 1024; g.ldb = 1024;
                        kind = EPI_RESID; E.ldc = 0; E.q0 = (void*)(first ? p.in[opq(0)] : xout); E.q1 = (void*)(first ? p.in[opq(2)] : xc); E.q2 = xout; E.q3 = ws; E.q4 = (void*)modl; E.q5 = (void*)(p.in[opq(7)] + layer * 1024);
                        for (int i = blockIdx.x * NTHREADS + tid_opq(); i < MR; i += gridDim.x * NTHREADS) rs1[i] = 0.f; }
                    else if (gs == 2) { g.A = hbuf; g.Bt = (const bf16_t*)(ws + WS_MDOWN + j * SZ_MDOWN); g.N = 768; g.K = 1024; g.lda = 1024; g.ldb = 1024;
                        E.q0 = ws + WS_DN; E.ldc = 768; E.q3 = rs1; E.q4 = shw_mix; }
                    else if (gs == 3) { g.A = (const bf16_t*)(ws + WS_CQN); g.Bt = (const bf16_t*)(ws + WS_MUQ + j * SZ_MUQ); g.N = 1536; g.K = 384; g.lda = 384; g.ldb = 384;
                        E.q0 = ws + WS_QRAW; E.ldc = 1536; }
                    else if (gs == 4) { g.A = (const bf16_t*)(ws + WS_CKVN); g.Bt = (const bf16_t*)(ws + WS_MUKV + j * SZ_MUKV); g.N = 2048; g.K = 256; g.lda = 256; g.ldb = 256;
                        kind = EPI_UKV; E.q0 = ws + WS_KB; E.q1 = ws + WS_VB; }
                    else if (gs == 6) { g.A = (const bf16_t*)(ws + WS_XSA); g.Bt = (const bf16_t*)(ws + WS_FUP + (size_t)layer * SZ_FUP); g.N = 5632; g.K = 1024; g.lda = 1024; g.ldb = 1024;
                        kind = EPI_FFN_UP; E.q0 = ws + WS_ACT; E.ldc = 2816; E.q1 = (void*)(p.in[opq(23)] + (size_t)layer * 3 * 2 * DFF); E.q2 = (void*)(p.in[opq(24)] + (size_t)layer * 2 * DFF);
                        E.q3 = ws + WS_HALO; E.q4 = rs0; E.q5 = shw_ffn; }
                    else { g.A = (const bf16_t*)(ws + WS_ACT); g.Bt = (const bf16_t*)(ws + WS_FDOWN + (size_t)layer * SZ_FDOWN); g.N = 1024; g.K = 2816; g.lda = 2816; g.ldb = 2816;
                        kind = EPI_RESID; E.ldc = 1; E.q0 = xout; E.q1 = xc; E.q2 = xout; E.q3 = ws; E.q4 = (void*)modl; E.q5 = layer < 3 ? (void*)(p.in[opq(6)] + (layer + 1) * 1024) : nullptr;
                        for (int i = blockIdx.x * NTHREADS + tid_opq(); i < MR; i += gridDim.x * NTHREADS) rs0[i] = 0.f; }
                    if (layer == 3 && (gs == 3 || gs == 5 || gs == 6 || gs == 7)) g.M = TL;
                    pg8::StaticOrder S; S.init(g.M, g.N, (int)gridDim.x, (int)blockIdx.x);
                    if (kind == EPI_BF16) pg8::gemm_phase<Epi, EPI_BF16>(lds, g, S, E);
                    else if (kind == EPI_GLA_IN) pg8::gemm_phase<Epi, EPI_GLA_IN>(lds, g, S, E);
                    else if (kind == EPI_RESID) pg8::gemm_phase<Epi, EPI_RESID>(lds, g, S, E);
                    else if (kind == EPI_UKV) pg8::gemm_phase<Epi, EPI_UKV>(lds, g, S, E);
                    else pg8::gemm_phase<Epi, EPI_FFN_UP>(lds, g, S, E);
                    __syncthreads();
                }
            } else if (op == 3) {
                scan_phase((const bf16_t*)(ws + WS_VR), (const bf16_t*)(ws + WS_GQ), (const bf16_t*)(ws + WS_GK), (const bf16_t*)(ws + WS_GP), (const float*)(ws + WS_GE),
                           hbuf, (bf16_t*)(ws + WS_QK), lds);
            } else if (op == 9) {
                gateprep_phase((const bf16_t*)(ws + WS_QK), (const float*)(ws + WS_LR), p.in[opq(10)] + (size_t)j * 2 * 16 * 512, p.in[opq(11)] + (size_t)j * 2 * 512,
                               (bf16_t*)(ws + WS_GQ), (bf16_t*)(ws + WS_GK), (bf16_t*)(ws + WS_GP), (float*)(ws + WS_GE), lds);
            } else if (op == 4) {
                glapost_phase(hbuf, (const bf16_t*)(ws + WS_QK), (const bf16_t*)(ws + WS_VR), p.in[opq(12)] + j * 256, hbuf);
            } else if (op == 5) {
                mlamid_phase((const bf16_t*)(ws + WS_DN), p.in[opq(15)] + j * 384, p.in[opq(16)] + j * 256, p.in[opq(20)] + j * 192, (bf16_t*)(ws + WS_CQN), (bf16_t*)(ws + WS_CKVN), (bf16_t*)(ws + WS_KB));
            } else if (op == 6) {
                qkprep_phase((bf16_t*)(ws + WS_KB), p.in[opq(20)] + j * 192);
            } else if (op == 7) {
                attn_phase((const bf16_t*)(ws + WS_QRAW), (const bf16_t*)(ws + WS_KB), (const bf16_t*)(ws + WS_VB), hbuf, (char*)smem, layer == 3 ? 2048 : 2048 + 128, p.in[opq(19)] + j * 192);
            } else if (op == 8) {
                fixup_phase((const float*)(ws + WS_HALO), p.in[opq(23)] + (size_t)layer * 3 * 2 * DFF, p.in[opq(24)] + (size_t)layer * 2 * DFF, (bf16_t*)(ws + WS_ACT));
            }
            }
        }
        if (ph + 1 < p.ph_hi) { if (p.ph_lo < 0) grid.sync(); else xcd_barrier(xbar); }
    }
}

extern "C" void kernel_launch(void* const* d_in, const int* in_sizes, int n_in, void* d_out, int out_size, void* d_ws, size_t ws_size, hipStream_t stream) {
    static int grid = 0;
    if (grid == 0) {
        if (n_in != 26 || ws_size < WS_END) { fprintf(stderr, "kernel_launch: n_in %d ws %zu (need %zu)\n", n_in, ws_size, (size_t)WS_END); grid = -1; return; }
        int dev = 0, cus = 0, per_cu = 0;
        hipGetDevice(&dev);
        hipDeviceGetAttribute(&cus, hipDeviceAttributeMultiprocessorCount, dev);
        if (hipFuncSetAttribute((const void*)mega, hipFuncAttributeMaxDynamicSharedMemorySize, LDS_BYTES) != hipSuccess) { fprintf(stderr, "kernel_launch: hipFuncSetAttribute failed\n"); grid = -1; return; }
        if (hipOccupancyMaxActiveBlocksPerMultiprocessor(&per_cu, (const void*)mega, NTHREADS, LDS_BYTES) != hipSuccess || per_cu < 1) { fprintf(stderr, "kernel_launch: occupancy query %d\n", per_cu); per_cu = 1; }
        (void)hipGetLastError();
        grid = cus * per_cu;
        fprintf(stderr, "kernel_launch: grid %d (cus %d x %d)\n", grid, cus, per_cu);
    }
    if (grid < 0) return;
    Params p{};
    for (int i = 0; i < 26; ++i) p.in[i] = (const float*)d_in[i];
    p.in[26] = (const float*)d_out; p.in[27] = (const float*)d_ws;
    (void)hipMemsetAsync((unsigned char*)d_ws + WS_BAR, 0, 16384, stream);
#if MK_MULTI
    for (int ph = 0; ph < NPH; ++ph) {
        p.ph_lo = ph; p.ph_hi = ph + 1;
        hipLaunchKernelGGL(mega, dim3(grid), dim3(NTHREADS), LDS_BYTES, stream, p);
    }
#else
    p.ph_lo = 0; p.ph_hi = NPH;
    void* args[] = {&p};
    hipError_t e = hipLaunchCooperativeKernel((const void*)mega, dim3(grid), dim3(NTHREADS), args, LDS_BYTES, stream);
    if (e != hipSuccess) fprintf(stderr, "cooperative launch failed: %s (grid %d)\n", hipGetErrorString(e), grid);
#endif
}
```

```cpp
#include <hip/hip_runtime.h>
#include <hip/hip_cooperative_groups.h>
#include <cstdio>
#include <cstdint>
namespace cg = cooperative_groups;

#ifndef MK_MULTI
#define MK_MULTI 0
#endif

#define LAS __attribute__((address_space(3)))
#define DI __device__ __forceinline__
typedef unsigned short bf16_t;
typedef short bf16x8 __attribute__((ext_vector_type(8)));
typedef short s16x4 __attribute__((ext_vector_type(4)));
typedef float f32x2 __attribute__((ext_vector_type(2)));
typedef float f32x4 __attribute__((ext_vector_type(4)));
typedef float f32x16 __attribute__((ext_vector_type(16)));
typedef unsigned u32x2 __attribute__((ext_vector_type(2)));
typedef unsigned u32x4 __attribute__((ext_vector_type(4)));

constexpr int DM = 1024, NB = 16, SEQ = 4096, CTXL = 256;
constexpr int TL = NB * SEQ, TC = NB * CTXL, MR = TL + TC;
constexpr int KEYS = CTXL + SEQ;
constexpr int DFF = 2816, DFFH = 1408;
constexpr int NTHREADS = 512;
constexpr int XB_ST_OFF = 131072 + 12288 + 2 * 5120 + 6144;
constexpr int LDS_BYTES = XB_ST_OFF + 16;
constexpr int WIMG_F = 3072, PREW_F = 3072 + 2 * 1280;
constexpr int XCH_OFF = 131072;
constexpr int NPH = 43;

constexpr size_t SZ_GIN = 3328ull * 1024 * 2, SZ_SQ = 1024ull * 1024 * 2, SZ_MDOWN = 768ull * 1024 * 2, SZ_MUQ = 1536ull * 384 * 2,
                 SZ_MUKV = 2048ull * 256 * 2, SZ_FUP = 5632ull * 1024 * 2, SZ_FDOWN = 1024ull * 2816 * 2;
constexpr size_t WS_GIN = 0;
constexpr size_t WS_GOUT = WS_GIN + 2 * SZ_GIN;
constexpr size_t WS_MDOWN = WS_GOUT + 2 * SZ_SQ;
constexpr size_t WS_MUQ = WS_MDOWN + 2 * SZ_MDOWN;
constexpr size_t WS_MUKV = WS_MUQ + 2 * SZ_MUQ;
constexpr size_t WS_MOUT = WS_MUKV + 2 * SZ_MUKV;
constexpr size_t WS_FUP = WS_MOUT + 2 * SZ_SQ;
constexpr size_t WS_FDOWN = WS_FUP + 4 * SZ_FUP;
constexpr size_t WS_MOD = WS_FDOWN + 4 * SZ_FDOWN;
constexpr size_t SZ_MOD = 4ull * 17 * 6144 * 4;
constexpr size_t WS_RS = WS_MOD + ((SZ_MOD + 255) / 256) * 256;
constexpr size_t WS_SHW = WS_RS + 2ull * MR * 4;
constexpr size_t WS_BAR = WS_SHW + 4ull * 2 * 17 * 5632 * 4;
constexpr size_t WS_XC = WS_BAR + 16384;
constexpr size_t WS_H = WS_XC + (size_t)TC * 1024 * 4;
constexpr size_t WS_R = WS_H + (size_t)MR * 1024 * 2;
constexpr size_t WS_QK = WS_R;
constexpr size_t WS_VR = WS_QK + (size_t)MR * 1024 * 2;
constexpr size_t WS_LR = WS_VR + (size_t)MR * 2048 * 2;
constexpr int NCHI = NB * 2 * 4 * 68;
constexpr size_t WS_GQ = WS_LR + (size_t)MR * 32 * 4;
constexpr size_t WS_GK = WS_GQ + (size_t)NCHI * 64 * 128 * 2;
constexpr size_t WS_GP = WS_GK + (size_t)NCHI * 64 * 128 * 2;
constexpr size_t WS_GE = WS_GP + (size_t)NCHI * 64 * 64 * 2;
constexpr size_t WS_GLA_END = WS_GE + (size_t)NCHI * 128 * 4;
constexpr size_t WS_QRAW = WS_R;
constexpr size_t WS_DN = WS_R;
constexpr size_t WS_CQN = WS_QRAW + (size_t)MR * 1536 * 2;
constexpr size_t WS_CKVN = WS_CQN + (size_t)MR * 384 * 2;
constexpr size_t WS_KB = WS_CKVN + (size_t)MR * 256 * 2;
constexpr size_t WS_VB = WS_KB + (size_t)NB * KEYS * 1536 * 2;
constexpr size_t WS_MLA_END = WS_VB + (size_t)NB * KEYS * 1024 * 2;
constexpr size_t WS_ACT = WS_R;
constexpr size_t WS_HALO = WS_ACT + (size_t)MR * 2816 * 2;
constexpr size_t WS_XSA = WS_HALO + 272ull * 22 * 4 * 256 * 4;
constexpr size_t WS_FFN_END = WS_XSA + (size_t)MR * 1024 * 2;
constexpr size_t WS_END = WS_GLA_END > WS_MLA_END ? (WS_GLA_END > WS_FFN_END ? WS_GLA_END : WS_FFN_END) : (WS_MLA_END > WS_FFN_END ? WS_MLA_END : WS_FFN_END);
static_assert(WS_END <= (1ull << 30), "workspace over 1 GiB");

struct Params { const float* in[28]; int ph_lo, ph_hi; };

DI unsigned cvt_pk_bf16(float lo, float hi) { unsigned r; asm("v_cvt_pk_bf16_f32 %0, %1, %2" : "=v"(r) : "v"(lo), "v"(hi)); return r; }
DI float bf_lo(unsigned u) { return __uint_as_float(u << 16); }
DI float bf_hi(unsigned u) { return __uint_as_float(u & 0xffff0000u); }
DI bf16_t f2bf(float f) { return (bf16_t)(cvt_pk_bf16(f, 0.f) & 0xffffu); }
DI float wave_sum(float v) {
    v += __int_as_float(__builtin_amdgcn_update_dpp(0, __float_as_int(v), 0xB1, 0xF, 0xF, false));
    v += __int_as_float(__builtin_amdgcn_update_dpp(0, __float_as_int(v), 0x4E, 0xF, 0xF, false));
    v += __int_as_float(__builtin_amdgcn_update_dpp(0, __float_as_int(v), 0x141, 0xF, 0xF, false));
    v += __int_as_float(__builtin_amdgcn_update_dpp(0, __float_as_int(v), 0x140, 0xF, 0xF, false));
    v += __int_as_float(__builtin_amdgcn_update_dpp(0, __float_as_int(v), 0x142, 0xA, 0xF, false));
    v += __int_as_float(__builtin_amdgcn_update_dpp(0, __float_as_int(v), 0x143, 0xC, 0xF, false));
    return __int_as_float(__builtin_amdgcn_readlane(__float_as_int(v), 63));
}
DI float silu_f(float v) { return v * __builtin_amdgcn_rcpf(1.0f + __expf(-v)); }
DI int crow(int r, int hi) { return (r & 3) + 8 * (r >> 2) + 4 * hi; }
DI int tid_opq() { int t = threadIdx.x; asm volatile("" : "+v"(t)); return t; }
DI int opq(int i) { asm volatile("" : "+s"(i)); return i; }

namespace pg8 {
constexpr int BM = 256, BK = 64, HALF = 128, HTB = HALF * BK * 2, STAGE_BYTES = 8 * HTB, NXCD = 8, WGM = 8;
DI int lds_byte(int r, int c) { const int st = (r >> 4) * 2 + (c >> 5), rr = r & 15, cc = c & 31, ob = rr * 64 + cc * 2; return st * 1024 + (ob ^ (((ob >> 9) & 1) << 5)); }
DI void stage_rc(int b, int& R, int& C) { const int st = b / 1024, sb = b % 1024, swz = sb ^ (((sb >> 9) & 1) << 5); R = (st >> 1) * 16 + swz / 64; C = (st & 1) * 32 + (swz % 64) / 2; }
DI int perm32(int rho) { const int n = rho >> 4, i = rho & 15; return 8 * (i >> 2) + 4 * n + (i & 3); }
struct Unit { int pm, pn; };
struct Gemm { const bf16_t* A; const bf16_t* Bt; int M, N, K, lda, ldb; };
struct StaticOrder {
    int nM, nN, nwg, G, c;
    DI void init(int M, int N, int G_, int c_) { nM = M / BM; nN = N / BM; nwg = nM * nN; G = G_; c = c_; }
    DI bool next(int i, Unit& u) const {
        const long L = (long)i * G + c; if (L >= nwg) return false;
        int wgid = (int)L; { const int q = nwg / NXCD, r = nwg % NXCD, xcd = wgid % NXCD, off = wgid / NXCD; wgid = (xcd < r ? xcd * (q + 1) : r * (q + 1) + (xcd - r) * q) + off; }
        const int nig = WGM * nN, gid = wgid / nig, fm = gid * WGM, gsz = (nM - fm) < WGM ? (nM - fm) : WGM;
        u.pm = fm + ((wgid % nig) % gsz); u.pn = (wgid % nig) / gsz; return true;
    }
};

template <class Epi, int KIND>
DI void gemm_phase(LAS unsigned char* lds, const Gemm g, const StaticOrder& S, const Epi& E) {
    constexpr bool perm = Epi::template perm_of<KIND>();
    const int tid = tid_opq(), wid = __builtin_amdgcn_readfirstlane(tid >> 6), lane = tid & 63, wr = wid >> 2, wc = wid & 3, fr = lane & 15, fq = lane >> 4;
    const int K = g.K, nt = K / BK;
    unsigned voffA[2], voffB[2];
#pragma unroll
    for (int i = 0; i < 2; ++i) { int R, C; stage_rc(tid * 16 + i * 8192, R, C); const int Rb = perm ? ((R & ~31) + perm32(R & 31)) : R;
        voffA[i] = (unsigned)(R * g.lda + C) * 2u; voffB[i] = (unsigned)(Rb * g.ldb + C) * 2u; }
    const size_t kstep = (size_t)(BK * 2);
    const size_t hstepA = (size_t)HALF * g.lda * 2, hstepB = (size_t)HALF * g.ldb * 2;
    const size_t tstepA = 2 * hstepA, tstepB = 2 * hstepB;
    const unsigned ldsw = (unsigned)wid * 1024u;
    const int aoff = lds_byte(wr * 64 + fr, fq * 8), boff = lds_byte(wc * 32 + fr, fq * 8);
#define PG8_SA(b, h) (((b) * 2 + (h)) * HTB)
#define PG8_SB(b, h) ((4 + (b) * 2 + (h)) * HTB)
#define PG8_STAGE(bufoff, gbase, voff) do { _Pragma("unroll") for (int _i = 0; _i < 2; ++_i) \
        __builtin_amdgcn_global_load_lds((const unsigned*)((const char*)(gbase) + (voff)[_i]), (LAS unsigned*)(lds + (bufoff) + ldsw + _i * 8192), 16, 0, 0); } while (0)
#define PG8_LDA(dst, b, h) do { _Pragma("unroll") for (int m = 0; m < 4; ++m) _Pragma("unroll") for (int k = 0; k < 2; ++k) dst[m][k] = *(const LAS bf16x8*)(lds + PG8_SA(b, h) + aoff + m * 2048 + k * 1024); } while (0)
#define PG8_LDB(dst, b, h) do { _Pragma("unroll") for (int n = 0; n < 2; ++n) _Pragma("unroll") for (int k = 0; k < 2; ++k) dst[n][k] = *(const LAS bf16x8*)(lds + PG8_SB(b, h) + boff + n * 2048 + k * 1024); } while (0)
#define PG8_MMA(ai, bj, At, Bt) do { __builtin_amdgcn_s_setprio(1); _Pragma("unroll") for (int m = 0; m < 4; ++m) _Pragma("unroll") for (int n = 0; n < 2; ++n) _Pragma("unroll") for (int k = 0; k < 2; ++k) \
        acc[ai][bj][m][n] = __builtin_amdgcn_mfma_f32_16x16x32_bf16(Bt[n][k], At[m][k], acc[ai][bj][m][n], 0, 0, 0); __builtin_amdgcn_s_setprio(0); } while (0)
#define PG8_WAIT_V(n) asm volatile("s_waitcnt vmcnt(" #n ")" ::: "memory")
#define PG8_WAIT_L(n) asm volatile("s_waitcnt lgkmcnt(" #n ")" ::: "memory")
#define PG8_BAR __builtin_amdgcn_s_barrier()
#define PG8_SCHED __builtin_amdgcn_sched_barrier(0)
    Unit cur, nxt; int ui = 0;
    if (!S.next(0, cur)) return;
    f32x4 acc[2][2][4][2];
#pragma unroll
    for (int a = 0; a < 2; ++a)
#pragma unroll
        for (int b = 0; b < 2; ++b)
#pragma unroll
            for (int m = 0; m < 4; ++m)
#pragma unroll
                for (int n = 0; n < 2; ++n) acc[a][b][m][n] = (f32x4){0.f, 0.f, 0.f, 0.f};
    bf16x8 At[4][2], B0[2][2], B1[2][2];
    typename Epi::Pre pre;
    const char* cA = (const char*)g.A + (size_t)cur.pm * tstepA; const char* cB = (const char*)g.Bt + (size_t)cur.pn * tstepB;
    PG8_STAGE(PG8_SB(0, 0), cB, voffB); PG8_STAGE(PG8_SA(0, 0), cA, voffA); PG8_STAGE(PG8_SB(0, 1), cB + hstepB, voffB); PG8_STAGE(PG8_SA(0, 1), cA + hstepA, voffA);
    if (wr == 1) PG8_BAR;
    PG8_WAIT_V(4); PG8_BAR;
    PG8_STAGE(PG8_SB(1, 0), cB + kstep, voffB); PG8_STAGE(PG8_SA(1, 0), cA + kstep, voffA); PG8_STAGE(PG8_SB(1, 1), cB + hstepB + kstep, voffB);
    PG8_WAIT_V(6); PG8_BAR;
    for (;;) {
        const bool has_next = S.next(ui + 1, nxt);
        const char* nA = has_next ? (const char*)g.A + (size_t)nxt.pm * tstepA : cA; const char* nB = has_next ? (const char*)g.Bt + (size_t)nxt.pn * tstepB : cB;
        E.template prefetch<KIND>(pre, cur, wr, wc, fr, fq, ui & 1);
        for (int t = 0; t < nt; t += 2) {
            const bool last = (t == nt - 2);
            const char* a1 = cA + (size_t)(t + 1) * kstep;
            const char* a2 = last ? nA : cA + (size_t)(t + 2) * kstep; const char* b2 = last ? nB : cB + (size_t)(t + 2) * kstep;
            const char* a3 = a2 + kstep; const char* b3 = b2 + kstep;
            PG8_LDB(B0, 0, 0); PG8_SCHED; PG8_LDA(At, 0, 0); PG8_STAGE(PG8_SA(1, 1), a1 + hstepA, voffA);
            PG8_WAIT_L(8); PG8_BAR; PG8_WAIT_L(0); PG8_MMA(0, 0, At, B0); PG8_BAR; PG8_SCHED;
            PG8_LDB(B1, 0, 1); PG8_STAGE(PG8_SB(0, 0), b2, voffB);
            PG8_BAR; PG8_WAIT_L(0); PG8_MMA(0, 1, At, B1); PG8_BAR;
            PG8_LDA(At, 0, 1); PG8_STAGE(PG8_SA(0, 0), a2, voffA);
            PG8_BAR; PG8_WAIT_L(0); PG8_MMA(1, 0, At, B0); PG8_BAR; PG8_SCHED;
            PG8_STAGE(PG8_SB(0, 1), b2 + hstepB, voffB);
            PG8_WAIT_V(6); PG8_BAR; PG8_MMA(1, 1, At, B1); PG8_BAR;
            PG8_LDB(B0, 1, 0); PG8_SCHED; PG8_LDA(At, 1, 0); PG8_STAGE(PG8_SA(0, 1), a2 + hstepA, voffA);
            PG8_WAIT_L(8); PG8_BAR; PG8_WAIT_L(0); PG8_MMA(0, 0, At, B0); PG8_BAR; PG8_SCHED;
            PG8_LDB(B1, 1, 1); PG8_STAGE(PG8_SB(1, 0), b3, voffB);
            PG8_BAR; PG8_WAIT_L(0); PG8_MMA(0, 1, At, B1); PG8_BAR;
            PG8_LDA(At, 1, 1); PG8_STAGE(PG8_SA(1, 0), a3, voffA);
            PG8_BAR; PG8_WAIT_L(0); PG8_MMA(1, 0, At, B0); PG8_BAR; PG8_SCHED;
            PG8_STAGE(PG8_SB(1, 1), b3 + hstepB, voffB);
            PG8_WAIT_V(6); PG8_BAR; PG8_MMA(1, 1, At, B1); PG8_BAR;
        }
        if (wr == 0) { PG8_BAR; asm volatile("" ::: "memory"); }
        E.template run<KIND>(acc, pre, cur, wr, wc, fr, fq, ui & 1);
        if (wr == 1) { asm volatile("" ::: "memory"); PG8_BAR; }
        if (!has_next) break;
#pragma unroll
        for (int a = 0; a < 2; ++a)
#pragma unroll
            for (int b = 0; b < 2; ++b)
#pragma unroll
                for (int m = 0; m < 4; ++m)
#pragma unroll
                    for (int n = 0; n < 2; ++n) acc[a][b][m][n] = (f32x4){0.f, 0.f, 0.f, 0.f};
        cur = nxt; cA = nA; cB = nB; ++ui;
    }
    PG8_WAIT_V(0);
    if (wr == 0) PG8_BAR;
    PG8_BAR;
#undef PG8_SA
#undef PG8_SB
#undef PG8_STAGE
#undef PG8_LDA
#undef PG8_LDB
#undef PG8_MMA
#undef PG8_WAIT_V
#undef PG8_WAIT_L
#undef PG8_BAR
#undef PG8_SCHED
}
}

enum { EPI_BF16 = 0, EPI_GLA_IN = 1, EPI_RESID = 2, EPI_UKV = 3, EPI_FFN_UP = 4 };
DI float dpp_ror1(float v) { return __int_as_float(__builtin_amdgcn_update_dpp(0, __float_as_int(v), 0x121, 0xf, 0xf, false)); }
DI float dpp_ror15(float v) { return __int_as_float(__builtin_amdgcn_update_dpp(0, __float_as_int(v), 0x12F, 0xf, 0xf, false)); }
struct Epi {
    struct Pre { float rsv[2][4]; f32x4 sw[2][2]; f32x2 wl0, wl1; };
    int ldc; LAS float* xch;
    void* q0; void* q1; void* q2; void* q3; void* q4; void* q5;
    static DI f32x4 ror1_4(f32x4 v) { float a, b, c, d;
        asm volatile("s_nop 1\n\tv_mov_b32_dpp %0, %4 row_ror:1 row_mask:0xf bank_mask:0xf\n\tv_mov_b32_dpp %1, %5 row_ror:1 row_mask:0xf bank_mask:0xf\n\tv_mov_b32_dpp %2, %6 row_ror:1 row_mask:0xf bank_mask:0xf\n\tv_mov_b32_dpp %3, %7 row_ror:1 row_mask:0xf bank_mask:0xf"
                     : "=&v"(a), "=&v"(b), "=&v"(c), "=&v"(d) : "v"(v[0]), "v"(v[1]), "v"(v[2]), "v"(v[3]));
        return (f32x4){a, b, c, d}; }
    static DI f32x2 ror1_2(f32x2 v) { float a, b;
        asm volatile("s_nop 1\n\tv_mov_b32_dpp %0, %2 row_ror:1 row_mask:0xf bank_mask:0xf\n\tv_mov_b32_dpp %1, %3 row_ror:1 row_mask:0xf bank_mask:0xf" : "=&v"(a), "=&v"(b) : "v"(v[0]), "v"(v[1]));
        return (f32x2){a, b}; }
    static DI f32x2 ror15_2(f32x2 v) { float a, b;
        asm volatile("s_nop 1\n\tv_mov_b32_dpp %0, %2 row_ror:15 row_mask:0xf bank_mask:0xf\n\tv_mov_b32_dpp %1, %3 row_ror:15 row_mask:0xf bank_mask:0xf" : "=&v"(a), "=&v"(b) : "v"(v[0]), "v"(v[1]));
        return (f32x2){a, b}; }
    static DI f32x4 ror15_4(f32x4 v) { float a, b, c, d;
        asm volatile("s_nop 1\n\tv_mov_b32_dpp %0, %4 row_ror:15 row_mask:0xf bank_mask:0xf\n\tv_mov_b32_dpp %1, %5 row_ror:15 row_mask:0xf bank_mask:0xf\n\tv_mov_b32_dpp %2, %6 row_ror:15 row_mask:0xf bank_mask:0xf\n\tv_mov_b32_dpp %3, %7 row_ror:15 row_mask:0xf bank_mask:0xf"
                     : "=&v"(a), "=&v"(b), "=&v"(c), "=&v"(d) : "v"(v[0]), "v"(v[1]), "v"(v[2]), "v"(v[3]));
        return (f32x4){a, b, c, d}; }
    DI void ffn_up(const f32x4 (&acc)[2][2][4][2], const pg8::Unit& u, int wr, int wc, int fr, int fq, int par) const {
        bf16_t* O = (bf16_t*)q0; float* halo = (float*)q3;
        const int cl = wc * 32 + 8 * fq;
        float rstd[2][4];
        { const LAS float* pw = xch + PREW_F + (wr * 4 + wc) * 192;
#pragma unroll
          for (int g = 0; g < 8; ++g) rstd[g >> 2][g & 3] = rsqrtf(pw[g * 16 + fr] * (1.0f / 1024.0f) + 1e-6f); }
        const LAS float* wbuf = xch + WIMG_F + par * 1280;
#define XW(ST, TB, BJ, V0, V1) do { LAS float* xp_ = xch + ((((ST) + 1) * 2 + (TB)) * 2 + (BJ)) * 128 + cl; *(LAS f32x4*)xp_ = (V0); *(LAS f32x4*)(xp_ + 4) = (V1); } while (0)
#define TR(AI, BJ, M, N) (acc[AI][BJ][M][N] * rstd[AI][M])
        if (fr == 0) { XW(wr, 0, 0, TR(0, 0, 0, 0), TR(0, 0, 0, 1)); XW(wr, 0, 1, TR(0, 1, 0, 0), TR(0, 1, 0, 1)); XW(2 + wr, 0, 0, TR(1, 0, 0, 0), TR(1, 0, 0, 1)); XW(2 + wr, 0, 1, TR(1, 1, 0, 0), TR(1, 1, 0, 1)); }
        if (fr == 15) { XW(wr, 1, 0, TR(0, 0, 3, 0), TR(0, 0, 3, 1)); XW(wr, 1, 1, TR(0, 1, 3, 0), TR(0, 1, 3, 1)); XW(2 + wr, 1, 0, TR(1, 0, 3, 0), TR(1, 0, 3, 1)); XW(2 + wr, 1, 1, TR(1, 1, 3, 0), TR(1, 1, 3, 1)); }
        { const f32x4 zz = (f32x4){0.f, 0.f, 0.f, 0.f}; if (fr == 0 && wr == 0) { XW(-1, 1, 0, zz, zz); XW(-1, 1, 1, zz, zz); } if (fr == 15 && wr == 1) { XW(4, 0, 0, zz, zz); XW(4, 0, 1, zz, zz); } }
#undef XW
        asm volatile("s_waitcnt lgkmcnt(0)" ::: "memory"); __builtin_amdgcn_s_barrier(); asm volatile("" ::: "memory"); __builtin_amdgcn_s_barrier(); asm volatile("" ::: "memory");
        {
            float* hp = halo + (size_t)(u.pm * 22 + u.pn) * 4 * 256 + cl;
            const f32x4 sa0 = *(const LAS f32x4*)(wbuf + 512 + cl), sa1 = *(const LAS f32x4*)(wbuf + 512 + cl + 4), sg0 = *(const LAS f32x4*)(wbuf + 640 + 512 + cl), sg1 = *(const LAS f32x4*)(wbuf + 640 + 512 + cl + 4);
            if (wr == 0 && fr < 2) { float* h2 = hp + fr * 256; *(f32x4*)h2 = TR(0, 0, 0, 0) + sa0; *(f32x4*)(h2 + 4) = TR(0, 0, 0, 1) + sa1; *(f32x4*)(h2 + 128) = TR(0, 1, 0, 0) + sg0; *(f32x4*)(h2 + 132) = TR(0, 1, 0, 1) + sg1; }
            if (wr == 1 && fr >= 14) { float* h2 = hp + (fr - 12) * 256; *(f32x4*)h2 = TR(1, 0, 3, 0) + sa0; *(f32x4*)(h2 + 4) = TR(1, 0, 3, 1) + sa1; *(f32x4*)(h2 + 128) = TR(1, 1, 3, 0) + sg0; *(f32x4*)(h2 + 132) = TR(1, 1, 3, 1) + sg1; }
        }
#undef TR
        asm volatile("" ::: "memory");
        const int rowt = u.pm * 256 + wr * 64 + fr;
        const bool f0 = fr == 0, f15 = fr == 15;
        f32x2 sg[2][4][4];
#define SILU2(v) (f32x2){silu_f(v[0]), silu_f(v[1])}
#define H2(V, HH) __builtin_shufflevector(V, V, 2 * (HH), 2 * (HH) + 1)
#define CONV_GROUP(BJ, Q, AI, OP) do { \
            const int st = 2 * (AI) + wr; \
            const f32x2 pb = *(const LAS f32x2*)(xch + (((st) * 2 + 1) * 2 + (BJ)) * 128 + cl + 2 * (Q)) + sw; \
            const f32x2 nb = *(const LAS f32x2*)(xch + (((st + 2) * 2 + 0) * 2 + (BJ)) * 128 + cl + 2 * (Q)) + sw; \
            const f32x2 c0 = H2(acc[AI][BJ][0][(Q) >> 1], (Q) & 1) * rstd[AI][0] + sw, c1 = H2(acc[AI][BJ][1][(Q) >> 1], (Q) & 1) * rstd[AI][1] + sw, \
                        c2 = H2(acc[AI][BJ][2][(Q) >> 1], (Q) & 1) * rstd[AI][2] + sw, c3 = H2(acc[AI][BJ][3][(Q) >> 1], (Q) & 1) * rstd[AI][3] + sw; \
            const f32x2 R0 = ror1_2(c0), L0 = ror15_2(c0), L1 = ror15_2(c1); \
            { const f32x2 v = w0 * (f0 ? pb : R0) + w1 * c0 + w2 * (f15 ? L1 : L0) + bb; OP(sg[AI][0][Q], v); } \
            __builtin_amdgcn_sched_barrier(0); \
            const f32x2 R1 = ror1_2(c1), L2 = ror15_2(c2); \
            { const f32x2 v = w0 * (f0 ? R0 : R1) + w1 * c1 + w2 * (f15 ? L2 : L1) + bb; OP(sg[AI][1][Q], v); } \
            __builtin_amdgcn_sched_barrier(0); \
            const f32x2 R2 = ror1_2(c2), L3 = ror15_2(c3); \
            { const f32x2 v = w0 * (f0 ? R1 : R2) + w1 * c2 + w2 * (f15 ? L3 : L2) + bb; OP(sg[AI][2][Q], v); } \
            __builtin_amdgcn_sched_barrier(0); \
            const f32x2 R3 = ror1_2(c3); \
            { const f32x2 v = w0 * (f0 ? R2 : R3) + w1 * c3 + w2 * (f15 ? nb : L3) + bb; OP(sg[AI][3][Q], v); } \
            __builtin_amdgcn_sched_barrier(0); } while (0)
#define OP_G(dst, v) dst = SILU2(v)
#define OP_A(dst, v) dst *= v
#define CONV_W(BJ, Q) const LAS float* wp_ = wbuf + (BJ) * 640 + cl + 2 * (Q); \
            const f32x2 w0 = *(const LAS f32x2*)wp_, w1 = *(const LAS f32x2*)(wp_ + 128), w2 = *(const LAS f32x2*)(wp_ + 256), bb = *(const LAS f32x2*)(wp_ + 384), sw = *(const LAS f32x2*)(wp_ + 512);
        { CONV_W(1, 0) CONV_GROUP(1, 0, 0, OP_G); CONV_GROUP(1, 0, 1, OP_G); }
        { CONV_W(1, 1) CONV_GROUP(1, 1, 0, OP_G); CONV_GROUP(1, 1, 1, OP_G); }
        { CONV_W(1, 2) CONV_GROUP(1, 2, 0, OP_G); CONV_GROUP(1, 2, 1, OP_G); }
        { CONV_W(1, 3) CONV_GROUP(1, 3, 0, OP_G); CONV_GROUP(1, 3, 1, OP_G); }
        { CONV_W(0, 0) CONV_GROUP(0, 0, 0, OP_A); CONV_GROUP(0, 0, 1, OP_A); }
        { CONV_W(0, 1) CONV_GROUP(0, 1, 0, OP_A); CONV_GROUP(0, 1, 1, OP_A); }
        { CONV_W(0, 2) CONV_GROUP(0, 2, 0, OP_A); CONV_GROUP(0, 2, 1, OP_A); }
        { CONV_W(0, 3) CONV_GROUP(0, 3, 0, OP_A); CONV_GROUP(0, 3, 1, OP_A); }
#undef CONV_W
#undef CONV_GROUP
#undef OP_G
#undef OP_A
#undef SILU2
#undef H2
#define ST16(AI, MM) do { u32x4 w_; w_.x = cvt_pk_bf16(sg[AI][MM][0][0], sg[AI][MM][0][1]); w_.y = cvt_pk_bf16(sg[AI][MM][1][0], sg[AI][MM][1][1]); w_.z = cvt_pk_bf16(sg[AI][MM][2][0], sg[AI][MM][2][1]); w_.w = cvt_pk_bf16(sg[AI][MM][3][0], sg[AI][MM][3][1]); \
            *(u32x4*)(O + (size_t)(rowt + (AI) * 128 + (MM) * 16) * 2816 + u.pn * 128 + cl) = w_; } while (0)
        ST16(0, 0); ST16(0, 1); ST16(0, 2); ST16(0, 3); ST16(1, 0); ST16(1, 1); ST16(1, 2); ST16(1, 3);
#undef ST16
    }
    template <int K> static constexpr bool perm_of() { return true; }
    template <int kind> DI void prefetch(Pre& P, const pg8::Unit& u, int wr, int wc, int fr, int fq, int par) const {
        (void)P;
        if constexpr (kind == EPI_UKV) {
            if (fq == 0 && fr < 8) __builtin_amdgcn_global_load_lds((const unsigned*)((const float*)q2 + wc * 32 + fr * 4), (LAS unsigned*)(xch + PREW_F + (wr * 4 + wc) * 192 + 128), 16, 0, 0);
        }
        if constexpr (kind == EPI_GLA_IN || kind == EPI_BF16 || kind == EPI_FFN_UP) {
            const float* rsb = (const float*)(kind == EPI_FFN_UP ? q4 : q3);
            if (rsb) {
                LAS float* pw = xch + PREW_F + (wr * 4 + wc) * 192;
                const int bidx = u.pm < 256 ? (u.pm >> 4) : 16;
                if (fq == 0) {
                    const float* rsp = rsb + u.pm * 256 + wr * 64 + fr;
#pragma unroll
                    for (int g = 0; g < 8; ++g) __builtin_amdgcn_global_load_lds((const unsigned*)(rsp + (g >> 2) * 128 + (g & 3) * 16), (LAS unsigned*)(pw + g * 16), 4, 0, 0);
                    if constexpr (kind != EPI_FFN_UP) {
                        const float* sw = (const float*)q4 + (size_t)bidx * 5632 + u.pn * 256 + (fr >> 3) * 128 + wc * 32 + (fr & 7) * 4;
                        __builtin_amdgcn_global_load_lds((const unsigned*)sw, (LAS unsigned*)(pw + 128), 16, 0, 0);
                    }
                }
                if constexpr (kind == EPI_FFN_UP) {
                    const int wid = wr * 4 + wc;
                    if (wid < 5) {
                        const float* cw = (const float*)q1; const float* cb = (const float*)q2; const float* shw = (const float*)q5 + (size_t)bidx * 5632 + u.pn * 256;
                        const int i4 = (wid * 64 + fq * 16 + fr) * 4, bjw = i4 / 640, rem = i4 % 640, kw = rem >> 7, c_ = rem & 127;
                        const float* srcw = kw < 3 ? cw + kw * 5632 + bjw * 2816 + u.pn * 128 + c_ : kw == 3 ? cb + bjw * 2816 + u.pn * 128 + c_ : shw + bjw * 128 + c_;
                        __builtin_amdgcn_global_load_lds((const unsigned*)srcw, (LAS unsigned*)(xch + WIMG_F + par * 1280 + wid * 256), 16, 0, 0);
                    }
                }
            }
        }
    }
    template <int kind> DI void run(const f32x4 (&acc)[2][2][4][2], const Pre& P, const pg8::Unit& u, int wr, int wc, int fr, int fq, int par) const {
        asm volatile("" : "+v"(fr), "+v"(fq));
        if constexpr (kind == EPI_FFN_UP) { ffn_up(acc, u, wr, wc, fr, fq, par); return; }
        if constexpr (kind == EPI_RESID) {
            const float* base_l = (const float*)q0; const float* base_c = (const float*)q1; float* out_l = (float*)q2; unsigned char* wsb = (unsigned char*)q3; float* out_c = (float*)(wsb + WS_XC);
            const float* modl = (const float*)q4; const float* gnext = (const float*)q5;
            const int bidx = u.pm < 256 ? (u.pm >> 4) : 16;
            const float* gv = modl + (size_t)bidx * 6144 + (ldc ? 5 * 1024 : 2 * 1024);
            const float* bp = u.pm < 256 ? base_l + (size_t)u.pm * 256 * 1024 : base_c + (size_t)(u.pm - 256) * 256 * 1024;
            float* op = u.pm < 256 ? out_l + (size_t)u.pm * 256 * 1024 : out_c + (size_t)(u.pm - 256) * 256 * 1024;
            const int col0 = u.pn * 256 + wc * 32 + 8 * fq;
            f32x4 gt[2][2], gn[2][2];
#pragma unroll
            for (int bj = 0; bj < 2; ++bj)
#pragma unroll
                for (int n = 0; n < 2; ++n) gt[bj][n] = *(const f32x4*)(gv + col0 + bj * 128 + n * 4);
            if (gnext) {
                const float* scn = ldc ? modl + (size_t)(17 + bidx) * 6144 + 1024 : modl + (size_t)bidx * 6144 + 4 * 1024;
#pragma unroll
                for (int bj = 0; bj < 2; ++bj)
#pragma unroll
                    for (int n = 0; n < 2; ++n) gn[bj][n] = *(const f32x4*)(gnext + col0 + bj * 128 + n * 4) * (*(const f32x4*)(scn + col0 + bj * 128 + n * 4) + 1.0f);
            }
            bf16_t* xs = (bf16_t*)(wsb + (ldc ? WS_H : WS_XSA)) + (size_t)u.pm * 256 * 1024;
            float* rs = (float*)(wsb + WS_RS) + (ldc ? MR : 0) + u.pm * 256;
            f32x4 bsA[4], bsB[4];
#define RS_LOAD(K, DST) do { const size_t off_ = (size_t)(((K) >> 2) * 128 + wr * 64 + ((K) & 3) * 16 + fr) * 1024 + col0; \
                _Pragma("unroll") for (int q_ = 0; q_ < 4; ++q_) DST[q_] = *(const f32x4*)(bp + off_ + (q_ >> 1) * 128 + (q_ & 1) * 4); } while (0)
#define RS_DO(K, SRC) do { const int ai_ = (K) >> 2, m_ = (K) & 3; const int rl = ai_ * 128 + wr * 64 + m_ * 16 + fr; const size_t off = (size_t)rl * 1024 + col0; float ssq = 0.f; \
                _Pragma("unroll") for (int q_ = 0; q_ < 4; ++q_) { const int bj = q_ >> 1, n = q_ & 1; \
                    const f32x4 xn = SRC[q_] + gt[bj][n] * acc[ai_][bj][m_][n]; \
                    *(f32x4*)(op + off + bj * 128 + n * 4) = xn; \
                    if (gnext) { ssq += xn[0] * xn[0] + xn[1] * xn[1] + xn[2] * xn[2] + xn[3] * xn[3]; const f32x4 y = xn * gn[bj][n]; \
                        u32x2 w; w.x = cvt_pk_bf16(y[0], y[1]); w.y = cvt_pk_bf16(y[2], y[3]); *(u32x2*)(xs + off + bj * 128 + n * 4) = w; } } \
                if (gnext) { ssq += __shfl_xor(ssq, 16); ssq += __shfl_xor(ssq, 32); if (fq == 0) unsafeAtomicAdd(rs + rl, ssq); } } while (0)
            RS_LOAD(0, bsA);
            RS_LOAD(1, bsB); RS_DO(0, bsA);
            RS_LOAD(2, bsA); RS_DO(1, bsB);
            RS_LOAD(3, bsB); RS_DO(2, bsA);
            RS_LOAD(4, bsA); RS_DO(3, bsB);
            RS_LOAD(5, bsB); RS_DO(4, bsA);
            RS_LOAD(6, bsA); RS_DO(5, bsB);
            RS_LOAD(7, bsB); RS_DO(6, bsA);
            RS_DO(7, bsB);
#undef RS_LOAD
#undef RS_DO
            return;
        } else {
        bf16_t* O = (bf16_t*)q0; float* lr = (float*)q1; bf16_t* KB = (bf16_t*)q0; bf16_t* VB = (bf16_t*)q1;
        const int rowt = u.pm * 256 + wr * 64 + fr;
        f32x4 swv[2][2]; float rsv[2][4];
        float krs[2][4]; f32x4 kg0, kg1;
        if constexpr (kind == EPI_UKV) {
            LAS float* P = xch;
#pragma unroll
            for (int ai = 0; ai < 2; ++ai)
#pragma unroll
                for (int m = 0; m < 4; ++m) {
                    const f32x4 a = acc[ai][0][m][0], b = acc[ai][0][m][1];
                    float t = a[0] * a[0] + a[1] * a[1] + a[2] * a[2] + a[3] * a[3] + b[0] * b[0] + b[1] * b[1] + b[2] * b[2] + b[3] * b[3];
                    t += __shfl_xor(t, 16); t += __shfl_xor(t, 32);
                    if (fq == 0) P[(ai * 128 + wr * 64 + m * 16 + fr) * 4 + wc] = t;
                }
            asm volatile("s_waitcnt lgkmcnt(0)" ::: "memory"); __builtin_amdgcn_s_barrier(); asm volatile("" ::: "memory");
#pragma unroll
            for (int ai = 0; ai < 2; ++ai)
#pragma unroll
                for (int m = 0; m < 4; ++m) { const f32x4 t4 = *(const LAS f32x4*)(P + (ai * 128 + wr * 64 + m * 16 + fr) * 4); krs[ai][m] = rsqrtf((t4[0] + t4[1] + t4[2] + t4[3]) * (1.0f / 128.0f) + 1e-6f); }
            { const LAS float* pw = xch + PREW_F + (wr * 4 + wc) * 192 + 128 + 8 * fq; kg0 = *(const LAS f32x4*)pw; kg1 = *(const LAS f32x4*)(pw + 4); }
        }
        if constexpr (kind == EPI_GLA_IN || kind == EPI_BF16) {
            if (q3) { const LAS float* pw = xch + PREW_F + (wr * 4 + wc) * 192;
#pragma unroll
                for (int g = 0; g < 8; ++g) rsv[g >> 2][g & 3] = pw[g * 16 + fr];
#pragma unroll
                for (int bj = 0; bj < 2; ++bj) { swv[bj][0] = *(const LAS f32x4*)(pw + 128 + bj * 32 + 8 * fq); swv[bj][1] = *(const LAS f32x4*)(pw + 128 + bj * 32 + 8 * fq + 4); } }
        }
#pragma unroll
        for (int ai = 0; ai < 2; ++ai)
#pragma unroll
            for (int m = 0; m < 4; ++m) {
                const int row = rowt + ai * 128 + m * 16;
#pragma unroll
                for (int bj = 0; bj < 2; ++bj) {
                    f32x4 v0 = acc[ai][bj][m][0], v1 = acc[ai][bj][m][1];
                    const int cin = bj * 128 + wc * 32 + 8 * fq;
                    if constexpr (kind == EPI_GLA_IN || kind == EPI_BF16) {
                        if (q3) {
                            const float rstd = rsqrtf(rsv[ai][m] * (1.0f / 1024.0f) + 1e-6f);
                            v0 = v0 * rstd + swv[bj][0]; v1 = v1 * rstd + swv[bj][1];
                        }
                    }
                    if constexpr (kind == EPI_GLA_IN) {
                        if (u.pn == 12) {
                            if (bj == 0 && wc == 0) { float* lp = lr + (size_t)row * 32 + 8 * fq; *(f32x4*)lp = v0; *(f32x4*)(lp + 4) = v1; }
                            continue;
                        }
                        if (u.pn < 2) { v0 *= 0.08838834764831845f; v1 *= 0.08838834764831845f; }
                    }
                    u32x4 w; w.x = cvt_pk_bf16(v0[0], v0[1]); w.y = cvt_pk_bf16(v0[2], v0[3]); w.z = cvt_pk_bf16(v1[0], v1[1]); w.w = cvt_pk_bf16(v1[2], v1[3]);
                    if constexpr (kind == EPI_GLA_IN) {
                        if (u.pn < 4) *(u32x4*)(O + (size_t)row * 1024 + u.pn * 256 + cin) = w;
                        else *(u32x4*)((bf16_t*)q2 + (size_t)row * 2048 + (u.pn - 4) * 256 + cin) = w;
                    } else if constexpr (kind == EPI_UKV) {
                        if (bj == 0) { const f32x4 n0 = v0 * krs[ai][m] * kg0, n1 = v1 * krs[ai][m] * kg1;
                            w.x = cvt_pk_bf16(n0[0], n0[1]); w.y = cvt_pk_bf16(n0[2], n0[3]); w.z = cvt_pk_bf16(n1[0], n1[1]); w.w = cvt_pk_bf16(n1[2], n1[3]); }
                        int key;
                        if (u.pm < 256) { const int b = u.pm >> 4; key = b * KEYS + CTXL + (row - b * SEQ); }
                        else { const int b = u.pm - 256; key = b * KEYS + (row - TL - b * CTXL); }
                        const int cc = wc * 32 + 8 * fq;
                        if (bj == 0) *(u32x4*)(KB + (size_t)key * 1536 + u.pn * 192 + cc) = w;
                        else *(u32x4*)(VB + (size_t)key * 1024 + u.pn * 128 + cc) = w;
                    } else {
                        *(u32x4*)(O + (size_t)row * ldc + u.pn * 256 + cin) = w;
                    }
                }
            }
        }
    }
};

DI void prep_phase(const Params& p, LAS unsigned char* lds) {
    const int tid = tid_opq();
    unsigned char* ws = (unsigned char*)p.in[opq(27)];
    LAS float* tl = (LAS float*)lds;
    const float* in_c = p.in[opq(1)]; const float* in_cctx = p.in[opq(3)]; const float* in_wada = p.in[opq(4)]; const float* in_bada = p.in[opq(5)];
    const float* in_gin = p.in[opq(8)]; const float* in_w1 = p.in[opq(9)]; const float* in_gout = p.in[opq(13)]; const float* in_mdown = p.in[opq(14)];
    const float* in_uq = p.in[opq(17)]; const float* in_ukv = p.in[opq(18)]; const float* in_mout = p.in[opq(21)]; const float* in_fup = p.in[opq(22)]; const float* in_fdown = p.in[opq(25)];
    constexpr int T0 = 1536, T2 = 512, T3 = 352, T4 = 288, T5 = 256, T6 = 512, T7 = 5632, T8 = 2816;
    constexpr int NTILE = T0 + T2 + T3 + T4 + T5 + T6 + T7 + T8;
    for (int t = blockIdx.x; t < NTILE; t += gridDim.x) {
        const float* src; int N, k0, n0, ld; bf16_t* dst;
        int q = t;
        if (q < T0) { const int j = q / 768, r = q % 768, kt = r / 48, nt = r % 48; src = in_gin + (size_t)j * 1024 * 3072; N = 3072; k0 = kt * 64; n0 = nt * 64;
            dst = (bf16_t*)(ws + WS_GIN + j * SZ_GIN) + (size_t)n0 * 1024 + k0; ld = 1024; }
        else if ((q -= T0) < T2) { const int j = q / 256, r = q % 256, kt = r / 16, nt = r % 16; src = in_gout + (size_t)j * 1024 * 1024; N = 1024; k0 = kt * 64; n0 = nt * 64;
            dst = (bf16_t*)(ws + WS_GOUT + j * SZ_SQ) + (size_t)n0 * 1024 + k0; ld = 1024; }
        else if ((q -= T2) < T3) { const int j = q / 176, r = q % 176, kt = r / 11, nt = r % 11; src = in_mdown + (size_t)j * 1024 * 704; N = 704; k0 = kt * 64; n0 = nt * 64;
            dst = (bf16_t*)(ws + WS_MDOWN + j * SZ_MDOWN) + (size_t)n0 * 1024 + k0; ld = 1024; }
        else if ((q -= T3) < T4) { const int j = q / 144, r = q % 144, kt = r / 24, nt = r % 24; src = in_uq + (size_t)j * 384 * 1536; N = 1536; k0 = kt * 64; n0 = nt * 64;
            dst = (bf16_t*)(ws + WS_MUQ + j * SZ_MUQ) + (size_t)n0 * 384 + k0; ld = 384; }
        else if ((q -= T4) < T5) { const int j = q / 128, r = q % 128, kt = r / 32, nt = r % 32; src = in_ukv + (size_t)j * 256 * 2048; N = 2048; k0 = kt * 64; n0 = nt * 64;
            dst = (bf16_t*)(ws + WS_MUKV + j * SZ_MUKV) + (size_t)n0 * 256 + k0; ld = 256; }
        else if ((q -= T5) < T6) { const int j = q / 256, r = q % 256, kt = r / 16, nt = r % 16; src = in_mout + (size_t)j * 1024 * 1024; N = 1024; k0 = kt * 64; n0 = nt * 64;
            dst = (bf16_t*)(ws + WS_MOUT + j * SZ_SQ) + (size_t)n0 * 1024 + k0; ld = 1024; }
        else if ((q -= T6) < T7) { const int i = q / 1408, r = q % 1408, kt = r / 88, nt = r % 88; src = in_fup + (size_t)i * 1024 * 5632; N = 5632; k0 = kt * 64; n0 = nt * 64;
            const int isg = n0 >= DFF ? 1 : 0, cc = n0 - isg * DFF, drow = (cc >> 7) * 256 + isg * 128 + (cc & 127);
            dst = (bf16_t*)(ws + WS_FUP + (size_t)i * SZ_FUP) + (size_t)drow * 1024 + k0; ld = 1024; }
        else { q -= T7; const int i = q / 704, r = q % 704, kt = r / 16, nt = r % 16; src = in_fdown + (size_t)i * 2816 * 1024; N = 1024; k0 = kt * 64; n0 = nt * 64;
            dst = (bf16_t*)(ws + WS_FDOWN + (size_t)i * SZ_FDOWN) + (size_t)n0 * 2816 + k0; ld = 2816; }
#pragma unroll
        for (int i = 0; i < 8; ++i) { const int r = (tid >> 6) + 8 * i, c = tid & 63; tl[c * 65 + r] = src[(size_t)(k0 + r) * N + n0 + c]; }
        __syncthreads();
#pragma unroll
        for (int i = 0; i < 4; ++i) { const int rr = (tid >> 5) + 16 * i, c2 = (tid & 31) * 2; const float a = tl[rr * 65 + c2], b = tl[rr * 65 + c2 + 1];
            *(unsigned*)(dst + (size_t)rr * ld + c2) = cvt_pk_bf16(a, b); }
        __syncthreads();
    }
    const int gtid = blockIdx.x * NTHREADS + tid, gstride = gridDim.x * NTHREADS;
    for (int idx = gtid; idx < 65536; idx += gstride) {
        const int k = idx & 1023, r = (idx >> 10) & 15, dir = (idx >> 14) & 1, j = idx >> 15;
        const float v = in_w1[((size_t)(j * 2 + dir) * 1024 + k) * 16 + r];
        ((bf16_t*)(ws + WS_GIN + j * SZ_GIN))[(size_t)(3072 + dir * 16 + r) * 1024 + k] = f2bf(v);
    }
    for (int idx = gtid; idx < 2 * 114688; idx += gstride) { const int j = idx / 114688, o = idx % 114688; ((unsigned*)(ws + WS_GIN + j * SZ_GIN + 3104ull * 1024 * 2))[o] = 0u; }
    for (int idx = gtid; idx < 2 * 32768; idx += gstride) { const int j = idx / 32768, o = idx % 32768; ((unsigned*)(ws + WS_MDOWN + j * SZ_MDOWN + 704ull * 1024 * 2))[o] = 0u; }
    for (int idx = gtid; idx < MR; idx += gstride) ((float*)(ws + WS_RS))[idx] = 0.f;
    LAS float* sl = (LAS float*)lds;
    LAS float* red = (LAS float*)(lds + 81920);
    __syncthreads();
    for (int idx = tid; idx < 17 * 1024; idx += NTHREADS) { const int r = idx >> 10, k = idx & 1023; const float v = r < 16 ? in_c[r * 1024 + k] : in_cctx[k]; sl[k * 20 + r] = v / (1.0f + __expf(-v)); }
    __syncthreads();
    float* mod = (float*)(ws + WS_MOD);
    for (int it = blockIdx.x; it < 384; it += gridDim.x) {
        const int layer = it / 96, n0 = (it % 96) * 64, nn = tid & 63, ks = tid >> 6;
        const float* W = in_wada + (size_t)layer * 1024 * 6144 + n0 + nn;
        float acc[17];
#pragma unroll
        for (int r = 0; r < 17; ++r) acc[r] = 0.f;
        for (int kk = 0; kk < 128; ++kk) {
            const int k = ks * 128 + kk; const float w = W[(size_t)k * 6144];
            const f32x4 s0 = *(const LAS f32x4*)(sl + k * 20), s1 = *(const LAS f32x4*)(sl + k * 20 + 4), s2 = *(const LAS f32x4*)(sl + k * 20 + 8), s3 = *(const LAS f32x4*)(sl + k * 20 + 12);
            const float s16 = sl[k * 20 + 16];
#pragma unroll
            for (int j = 0; j < 4; ++j) { acc[j] += s0[j] * w; acc[4 + j] += s1[j] * w; acc[8 + j] += s2[j] * w; acc[12 + j] += s3[j] * w; }
            acc[16] += s16 * w;
        }
#pragma unroll
        for (int r = 0; r < 17; ++r) red[(ks * 17 + r) * 64 + nn] = acc[r];
        __syncthreads();
        for (int o = tid; o < 17 * 64; o += NTHREADS) { const int r = o >> 6, c = o & 63; float s = in_bada[layer * 6144 + n0 + c];
#pragma unroll
            for (int k8 = 0; k8 < 8; ++k8) s += red[(k8 * 17 + r) * 64 + c];
            mod[(size_t)(layer * 17 + r) * 6144 + n0 + c] = s; }
        __syncthreads();
    }
}

DI void shw_phase(unsigned char* ws, LAS unsigned char* lds) {
    const int tid = tid_opq(), wave = tid >> 6, lane = tid & 63;
    LAS float* sl = (LAS float*)lds;
    const float* mod = (const float*)(ws + WS_MOD);
    constexpr int NCH = 4 * 44 + 6 + 26 + 6;
    for (int ch = blockIdx.x; ch < NCH; ch += gridDim.x) {
        int layer, kind, n0; const bf16_t* Bt;
        if (ch < 176) { layer = ch / 44; kind = 1; n0 = (ch % 44) * 128; Bt = (const bf16_t*)(ws + WS_FUP + (size_t)layer * SZ_FUP); }
        else if (ch < 182) { layer = 1; kind = 0; n0 = (ch - 176) * 128; Bt = (const bf16_t*)(ws + WS_MDOWN); }
        else if (ch < 208) { layer = 2; kind = 0; n0 = (ch - 182) * 128; Bt = (const bf16_t*)(ws + WS_GIN + SZ_GIN); }
        else { layer = 3; kind = 0; n0 = (ch - 208) * 128; Bt = (const bf16_t*)(ws + WS_MDOWN + SZ_MDOWN); }
        __syncthreads();
        for (int idx = tid; idx < 17 * 256; idx += NTHREADS) { const int b = idx >> 8, k4 = (idx & 255) * 4;
            *(LAS f32x4*)(sl + b * 1024 + k4) = *(const f32x4*)(mod + (size_t)(layer * 17 + b) * 6144 + (kind ? 3 * 1024 : 0) + k4); }
        __syncthreads();
        float* out = (float*)(ws + WS_SHW) + (size_t)((layer * 2 + kind) * 17) * 5632;
#pragma unroll 1
        for (int i = 0; i < 16; ++i) {
            const int n = n0 + wave * 16 + i;
            float w[16];
#pragma unroll
            for (int j = 0; j < 4; ++j) { const u32x2 t = *(const u32x2*)(Bt + (size_t)n * 1024 + j * 256 + lane * 4); w[4 * j] = bf_lo(t.x); w[4 * j + 1] = bf_hi(t.x); w[4 * j + 2] = bf_lo(t.y); w[4 * j + 3] = bf_hi(t.y); }
            float mine = 0.f;
#pragma unroll 1
            for (int b = 0; b < 17; ++b) {
                float a = 0.f;
#pragma unroll
                for (int j = 0; j < 4; ++j) { const f32x4 sv = *(const LAS f32x4*)(sl + b * 1024 + j * 256 + lane * 4); a += sv[0] * w[4 * j] + sv[1] * w[4 * j + 1] + sv[2] * w[4 * j + 2] + sv[3] * w[4 * j + 3]; }
                a = wave_sum(a);
                if (lane == b) mine = a;
            }
            if (lane < 17) out[(size_t)lane * 5632 + n] = mine;
        }
    }
    __syncthreads();
}

DI void norm_phase(const float* xl, const float* xc, const float* gain, const float* modl, int sh_off, int sc_off, bf16_t* h) {
    const int tid = tid_opq(), wave = tid >> 6, lane = tid & 63;
    for (int row0 = (blockIdx.x * 8 + wave) * 4; row0 < MR; row0 += gridDim.x * 32) {
        const float* src = row0 < TL ? xl + (size_t)row0 * 1024 : xc + (size_t)(row0 - TL) * 1024;
        const float* mb = modl + (size_t)(row0 < TL ? (row0 >> 12) : 16) * 6144;
        f32x4 v[4][4]; float ss[4];
#pragma unroll
        for (int r = 0; r < 4; ++r)
#pragma unroll
            for (int i = 0; i < 4; ++i) v[r][i] = *(const f32x4*)(src + (size_t)r * 1024 + i * 256 + lane * 4);
#pragma unroll
        for (int r = 0; r < 4; ++r) { float t = 0.f;
#pragma unroll
            for (int i = 0; i < 4; ++i) t += v[r][i][0] * v[r][i][0] + v[r][i][1] * v[r][i][1] + v[r][i][2] * v[r][i][2] + v[r][i][3] * v[r][i][3];
            ss[r] = t; }
#pragma unroll
        for (int o = 32; o >= 1; o >>= 1) {
#pragma unroll
            for (int r = 0; r < 4; ++r) ss[r] += __shfl_xor(ss[r], o);
        }
#pragma unroll
        for (int i = 0; i < 4; ++i) {
            const int c = i * 256 + lane * 4;
            const f32x4 g = *(const f32x4*)(gain + c), sc = *(const f32x4*)(mb + sc_off + c), sh = *(const f32x4*)(mb + sh_off + c);
            const f32x4 gs = g * (sc + 1.0f);
#pragma unroll
            for (int r = 0; r < 4; ++r) {
                const float rstd = rsqrtf(ss[r] * (1.0f / 1024.0f) + 1e-6f);
                const f32x4 y = (v[r][i] * rstd) * gs + sh;
                u32x2 w; w.x = cvt_pk_bf16(y[0], y[1]); w.y = cvt_pk_bf16(y[2], y[3]);
                *(u32x2*)(h + (size_t)(row0 + r) * 1024 + c) = w;
            }
        }
    }
}

DI void scan_rowbase(int dir, int b, int c, int& rb, int& sg) {
    if (dir == 0) { sg = 1; rb = c < 4 ? TL + b * CTXL + c * 64 : b * SEQ + (c - 4) * 64; }
    else { sg = -1; rb = c < 4 ? TL + b * CTXL + 255 - c * 64 : b * SEQ + 4095 - (c - 4) * 64; }
}
struct GPStage { unsigned qv[8], kv[8]; f32x4 lrv; float w2r[16][2]; f32x2 gbias; };
DI void gp_load(GPStage& S, int item, const bf16_t* qk, const float* lr, const float* w2, const float* gb, int tid, int wave, int d0) {
    const int c = item % 68, rest = item / 68, h = rest & 3, dir = (rest >> 2) & 1, b = rest >> 3;
    int rowbase, sgn; scan_rowbase(dir, b, c, rowbase, sgn);
#pragma unroll
    for (int i = 0; i < 8; ++i) { const size_t ro = (size_t)(rowbase + sgn * (wave * 8 + i)) * 1024; S.qv[i] = *(const unsigned*)(qk + ro + h * 128 + d0); S.kv[i] = *(const unsigned*)(qk + ro + 512 + h * 128 + d0); }
    S.lrv = (f32x4){0.f, 0.f, 0.f, 0.f};
    if (tid < 256) S.lrv = *(const f32x4*)(lr + (size_t)(rowbase + sgn * (tid >> 2)) * 32 + dir * 16 + (tid & 3) * 4);
#pragma unroll
    for (int r = 0; r < 16; ++r) { const f32x2 t = *(const f32x2*)(w2 + (size_t)(dir * 16 + r) * 512 + h * 128 + d0); S.w2r[r][0] = t.x; S.w2r[r][1] = t.y; }
    S.gbias = *(const f32x2*)(gb + dir * 512 + h * 128 + d0);
}
DI void gp_item(const GPStage& S, int item, bf16_t* GQ, bf16_t* GK, bf16_t* GP, float* GE, LAS unsigned char* lds, int tid, int wave, int lane) {
    constexpr int QD = 0, KI = 17408, LRS = 34816, SEG = 38912;
    const int l15 = lane & 15, lq = lane >> 4, d0 = 2 * lane;
    if (tid < 256) *(LAS f32x4*)(lds + LRS + (tid >> 2) * 64 + (tid & 3) * 16) = S.lrv;
    __syncthreads();
    const LAS float* lrs = (const LAS float*)(lds + LRS);
    float bl0[8], bl1[8]; float cum0 = 0.f, cum1 = 0.f;
#pragma unroll
    for (int i = 0; i < 8; ++i) {
        const int s = wave * 8 + i;
        float z0 = S.gbias.x, z1 = S.gbias.y;
#pragma unroll
        for (int r4 = 0; r4 < 4; ++r4) { const f32x4 lv = *(const LAS f32x4*)(lrs + s * 16 + r4 * 4);
#pragma unroll
            for (int j = 0; j < 4; ++j) { z0 += lv[j] * S.w2r[r4 * 4 + j][0]; z1 += lv[j] * S.w2r[r4 * 4 + j][1]; } }
        const float g0 = (fminf(z0, 0.f) - __logf(1.0f + __expf(-fabsf(z0)))) * 0.0625f;
        const float g1 = (fminf(z1, 0.f) - __logf(1.0f + __expf(-fabsf(z1)))) * 0.0625f;
        cum0 += g0; cum1 += g1; bl0[i] = cum0; bl1[i] = cum1;
    }
    *(LAS f32x2*)(lds + SEG + (wave * 128 + d0) * 4) = (f32x2){cum0, cum1};
    __syncthreads();
    float off0 = 0.f, off1 = 0.f, tot0 = 0.f, tot1 = 0.f;
#pragma unroll
    for (int w = 0; w < 8; ++w) { const f32x2 t = *(const LAS f32x2*)(lds + SEG + (w * 128 + d0) * 4); tot0 += t.x; tot1 += t.y; if (w < wave) { off0 += t.x; off1 += t.y; } }
    const float et0 = __expf(tot0), et1 = __expf(tot1);
    if (wave == 0) *(f32x2*)(GE + (size_t)item * 128 + d0) = (f32x2){et0, et1};
    {
        unsigned ks0[4], ks1[4];
        bf16_t* gq = GQ + (size_t)item * 8192;
#pragma unroll
        for (int i = 0; i < 8; ++i) {
            const int s = wave * 8 + i;
            const float b0 = off0 + bl0[i], b1 = off1 + bl1[i];
            const float q0 = bf_lo(S.qv[i]), q1 = bf_hi(S.qv[i]), k0 = bf_lo(S.kv[i]), k1 = bf_hi(S.kv[i]);
            const float eb0 = __expf(b0), eb1 = __expf(b1), ib0 = __builtin_amdgcn_rcpf(eb0), ib1 = __builtin_amdgcn_rcpf(eb1);
            const unsigned qd = cvt_pk_bf16(q0 * eb0, q1 * eb1);
            *(LAS unsigned*)(lds + QD + s * 272 + d0 * 2) = qd;
            *(unsigned*)(gq + s * 128 + d0) = qd;
            *(LAS unsigned*)(lds + KI + s * 272 + d0 * 2) = cvt_pk_bf16(k0 * ib0, k1 * ib1);
            const float e0 = k0 * (et0 * ib0), e1 = k1 * (et1 * ib1);
            if (i & 1) { ks0[i >> 1] = (ks0[i >> 1] & 0xffffu) | (cvt_pk_bf16(0.f, e0) & 0xffff0000u); ks1[i >> 1] = (ks1[i >> 1] & 0xffffu) | (cvt_pk_bf16(0.f, e1) & 0xffff0000u); }
            else { ks0[i >> 1] = cvt_pk_bf16(e0, 0.f) & 0xffffu; ks1[i >> 1] = cvt_pk_bf16(e1, 0.f) & 0xffffu; }
        }
        bf16_t* gk = GK + (size_t)item * 8192;
        *(u32x4*)(gk + d0 * 64 + wave * 8) = (u32x4){ks0[0], ks0[1], ks0[2], ks0[3]};
        *(u32x4*)(gk + (d0 + 1) * 64 + wave * 8) = (u32x4){ks1[0], ks1[1], ks1[2], ks1[3]};
    }
    __syncthreads();
    {
        bf16_t* gp = GP + (size_t)item * 4096;
        const int t0 = 16 * (wave >> 1);
#pragma unroll
        for (int j = 0; j < 2; ++j) {
            const int s0 = 16 * ((wave & 1) * 2 + j);
            f32x4 a4 = (f32x4){0.f, 0.f, 0.f, 0.f};
#pragma unroll
            for (int kk = 0; kk < 4; ++kk) {
                const bf16x8 af = *(const LAS bf16x8*)(lds + QD + (t0 + l15) * 272 + (kk * 32 + 8 * lq) * 2);
                const bf16x8 bf = *(const LAS bf16x8*)(lds + KI + (s0 + l15) * 272 + (kk * 32 + 8 * lq) * 2);
                a4 = __builtin_amdgcn_mfma_f32_16x16x32_bf16(af, bf, a4, 0, 0, 0);
            }
            const int sc = s0 + l15;
#pragma unroll
            for (int r = 0; r < 4; ++r) { const int t = t0 + 4 * lq + r; gp[t * 64 + sc] = f2bf(sc <= t ? a4[r] : 0.f); }
        }
    }
}
DI void gateprep_phase(const bf16_t* qk, const float* lr, const float* w2, const float* gb, bf16_t* GQ, bf16_t* GK, bf16_t* GP, float* GE, LAS unsigned char* lds) {
    const int tid = tid_opq(), wave = __builtin_amdgcn_readfirstlane(tid >> 6), lane = tid & 63, d0 = 2 * lane;
    const int G = gridDim.x;
    GPStage A, B;
    int item = opq((int)blockIdx.x);
    if (item < NCHI) gp_load(A, item, qk, lr, w2, gb, tid, wave, d0);
    for (; item < NCHI; item += 2 * G) {
        if (item + G < NCHI) gp_load(B, item + G, qk, lr, w2, gb, tid, wave, d0);
        gp_item(A, item, GQ, GK, GP, GE, lds, tid, wave, lane);
        if (item + G < NCHI) {
            if (item + 2 * G < NCHI) gp_load(A, item + 2 * G, qk, lr, w2, gb, tid, wave, d0);
            gp_item(B, item + G, GQ, GK, GP, GE, lds, tid, wave, lane);
        }
    }
    __syncthreads();
}

DI void scan_phase(const bf16_t* vr, const bf16_t* GQ, const bf16_t* GK, const bf16_t* GP, const float* GE, bf16_t* of, bf16_t* ob, LAS unsigned char* lds) {
    constexpr int QD = 0, KST = 17408, VT = 35840, ST = 54272, PP = 89088, BL = 98304;
    const int tid = tid_opq(), wave = __builtin_amdgcn_readfirstlane(tid >> 6), lane = tid & 63;
    const int l31 = lane & 31, lh = lane >> 5;
    for (int item = blockIdx.x; item < 256; item += gridDim.x) {
        const int xcd_ = item & 7, slot_ = item >> 3, dvh = slot_ & 1, pair_ = (slot_ >> 1) * 8 + xcd_;
        const int b = pair_ >> 3, dir = (pair_ >> 2) & 1, h = pair_ & 3;
        bf16_t* obuf = dir ? ob : of;
        const int d0 = 2 * lane;
        const int gi0 = ((b * 2 + dir) * 4 + h) * 68;
        f32x16 Sacc[2];
#pragma unroll
        for (int i = 0; i < 16; ++i) { Sacc[0][i] = 0.f; Sacc[1][i] = 0.f; }
        __syncthreads();
        { unsigned z_ = 0u; asm volatile("" : "+v"(z_));
          for (int o = tid; o < 34816 / 16; o += NTHREADS) *(LAS u32x4*)(lds + ST + o * 16) = (u32x4){z_, z_, z_, z_}; }
        const int vcol = h * 256 + dvh * 128 + d0;
        struct ScStage { u32x4 gq0, gq1, gk0, gk1, gp0; unsigned vv[8]; float ebv; } A, B;
        A.ebv = 0.f; B.ebv = 0.f;
#define SCAN_LOAD(S, c) do { int rb_, sg_; scan_rowbase(dir, b, (c), rb_, sg_); const size_t gi_ = (size_t)(gi0 + (c)); \
        S.gq0 = *(const u32x4*)(GQ + gi_ * 8192 + tid * 8); S.gq1 = *(const u32x4*)(GQ + gi_ * 8192 + 4096 + tid * 8); \
        S.gk0 = *(const u32x4*)(GK + gi_ * 8192 + tid * 8); S.gk1 = *(const u32x4*)(GK + gi_ * 8192 + 4096 + tid * 8); \
        S.gp0 = *(const u32x4*)(GP + gi_ * 4096 + tid * 8); if (tid < 128) S.ebv = GE[gi_ * 128 + tid]; \
        _Pragma("unroll") for (int i = 0; i < 8; ++i) S.vv[i] = *(const unsigned*)(vr + (size_t)(rb_ + sg_ * (wave * 8 + i)) * 2048 + vcol); } while (0)
#define SCAN_CHUNK(S, c) do { \
            int rowbase, sgn; scan_rowbase(dir, b, (c), rowbase, sgn); \
            { const int e0 = tid * 8, e1 = 4096 + tid * 8; \
              *(LAS u32x4*)(lds + QD + (e0 >> 7) * 272 + (e0 & 127) * 2) = S.gq0; *(LAS u32x4*)(lds + QD + (e1 >> 7) * 272 + (e1 & 127) * 2) = S.gq1; \
              *(LAS u32x4*)(lds + KST + (e0 >> 6) * 144 + (e0 & 63) * 2) = S.gk0; *(LAS u32x4*)(lds + KST + (e1 >> 6) * 144 + (e1 & 63) * 2) = S.gk1; \
              *(LAS u32x4*)(lds + PP + (e0 >> 6) * 144 + (e0 & 63) * 2) = S.gp0; \
              if (tid < 128) *(LAS float*)(lds + BL + tid * 4) = S.ebv; \
              unsigned vt0[4], vt1[4]; \
              _Pragma("unroll") for (int i = 0; i < 8; ++i) { \
                  if (i & 1) { vt0[i >> 1] = (vt0[i >> 1] & 0xffffu) | (S.vv[i] << 16); vt1[i >> 1] = (vt1[i >> 1] & 0xffffu) | (S.vv[i] & 0xffff0000u); } \
                  else { vt0[i >> 1] = S.vv[i] & 0xffffu; vt1[i >> 1] = S.vv[i] >> 16; } } \
              *(LAS u32x4*)(lds + VT + d0 * 144 + wave * 16) = (u32x4){vt0[0], vt0[1], vt0[2], vt0[3]}; \
              *(LAS u32x4*)(lds + VT + (d0 + 1) * 144 + wave * 16) = (u32x4){vt1[0], vt1[1], vt1[2], vt1[3]}; \
            } \
            __syncthreads();     \
            if ((c) + 2 < 68) SCAN_LOAD(S, (c) + 2); \
            { \
                const int tq = wave >> 2, vq = wave & 3; \
                f32x16 oacc; \
                _Pragma("unroll") for (int i = 0; i < 16; ++i) oacc[i] = 0.f; \
                _Pragma("unroll") for (int kk = 0; kk < 8; ++kk) { \
                    const bf16x8 af = *(const LAS bf16x8*)(lds + QD + (32 * tq + l31) * 272 + (kk * 16 + 8 * lh) * 2); \
                    const bf16x8 bf = *(const LAS bf16x8*)(lds + ST + (32 * vq + l31) * 272 + (kk * 16 + 8 * lh) * 2); \
                    oacc = __builtin_amdgcn_mfma_f32_32x32x16_bf16(af, bf, oacc, 0, 0, 0); } \
                _Pragma("unroll") for (int kk = 0; kk < 4; ++kk) { \
                    const bf16x8 af = *(const LAS bf16x8*)(lds + PP + (32 * tq + l31) * 144 + (kk * 16 + 8 * lh) * 2); \
                    const bf16x8 bf = *(const LAS bf16x8*)(lds + VT + (32 * vq + l31) * 144 + (kk * 16 + 8 * lh) * 2); \
                    oacc = __builtin_amdgcn_mfma_f32_32x32x16_bf16(af, bf, oacc, 0, 0, 0); } \
                const int ocol = h * 256 + dvh * 128 + 32 * vq + l31; \
                _Pragma("unroll") for (int r = 0; r < 16; ++r) { const int t = 32 * tq + crow(r, lh); obuf[(size_t)(rowbase + sgn * t) * 1024 + ocol] = f2bf(oacc[r]); } \
            } \
            { \
                const int vq = wave & 3; \
                _Pragma("unroll") for (int j = 0; j < 2; ++j) { \
                    const int dq = 2 * (wave >> 2) + j; \
                    _Pragma("unroll") for (int r = 0; r < 16; ++r) Sacc[j][r] *= *(const LAS float*)(lds + BL + (32 * dq + crow(r, lh)) * 4); \
                    _Pragma("unroll") for (int kk = 0; kk < 4; ++kk) { \
                        const bf16x8 af = *(const LAS bf16x8*)(lds + KST + (32 * dq + l31) * 144 + (kk * 16 + 8 * lh) * 2); \
                        const bf16x8 bf = *(const LAS bf16x8*)(lds + VT + (32 * vq + l31) * 144 + (kk * 16 + 8 * lh) * 2); \
                        Sacc[j] = __builtin_amdgcn_mfma_f32_32x32x16_bf16(af, bf, Sacc[j], 0, 0, 0); } } \
            } \
            __syncthreads();     \
            { \
                const int vq = wave & 3; \
                _Pragma("unroll") for (int j = 0; j < 2; ++j) { \
                    const int dq = 2 * (wave >> 2) + j; \
                    _Pragma("unroll") for (int g = 0; g < 4; ++g) { \
                        u32x2 w; w.x = cvt_pk_bf16(Sacc[j][4 * g], Sacc[j][4 * g + 1]); w.y = cvt_pk_bf16(Sacc[j][4 * g + 2], Sacc[j][4 * g + 3]); \
                        *(LAS u32x2*)(lds + ST + (32 * vq + l31) * 272 + (32 * dq + 8 * g + 4 * lh) * 2) = w; } } \
            } } while (0)
        SCAN_LOAD(A, 0); SCAN_LOAD(B, 1);
        for (int c = 0; c < 68; c += 2) { SCAN_CHUNK(A, c); SCAN_CHUNK(B, c + 1); }
#undef SCAN_CHUNK
#undef SCAN_LOAD
    }
    __syncthreads();
}

DI void glapost_phase(const bf16_t* of, const bf16_t* ob, const bf16_t* vr, const float* onorm, bf16_t* a) {
    const int tid = tid_opq(), wave = tid >> 6, lane = tid & 63;
    const int c0 = lane * 16;
    float gn[16];
#pragma unroll
    for (int j = 0; j < 4; ++j) { const f32x4 t = *(const f32x4*)(onorm + (c0 & 255) + 4 * j); gn[4 * j] = t[0]; gn[4 * j + 1] = t[1]; gn[4 * j + 2] = t[2]; gn[4 * j + 3] = t[3]; }
    for (int row0 = (blockIdx.x * 8 + wave) * 4; row0 < MR; row0 += gridDim.x * 32) {
        u32x4 f0[4], f1[4], b0[4], b1[4], r0[4], r1[4];
#pragma unroll
        for (int q = 0; q < 4; ++q) { const size_t ro = (size_t)(row0 + q);
            f0[q] = *(const u32x4*)(of + ro * 1024 + c0); f1[q] = *(const u32x4*)(of + ro * 1024 + c0 + 8);
            b0[q] = *(const u32x4*)(ob + ro * 1024 + c0); b1[q] = *(const u32x4*)(ob + ro * 1024 + c0 + 8);
            r0[q] = *(const u32x4*)(vr + ro * 2048 + 1024 + c0); r1[q] = *(const u32x4*)(vr + ro * 2048 + 1024 + c0 + 8); }
        asm volatile("" ::: "memory");
#pragma unroll
        for (int q = 0; q < 4; ++q) {
            float o[16], rr[16];
#pragma unroll
            for (int j = 0; j < 4; ++j) {
                o[2 * j] = bf_lo(f0[q][j]) + bf_lo(b0[q][j]); o[2 * j + 1] = bf_hi(f0[q][j]) + bf_hi(b0[q][j]);
                o[8 + 2 * j] = bf_lo(f1[q][j]) + bf_lo(b1[q][j]); o[8 + 2 * j + 1] = bf_hi(f1[q][j]) + bf_hi(b1[q][j]);
                rr[2 * j] = bf_lo(r0[q][j]); rr[2 * j + 1] = bf_hi(r0[q][j]); rr[8 + 2 * j] = bf_lo(r1[q][j]); rr[8 + 2 * j + 1] = bf_hi(r1[q][j]);
            }
            float ss = 0.f;
#pragma unroll
            for (int j = 0; j < 16; ++j) ss += o[j] * o[j];
            ss += __shfl_xor(ss, 1); ss += __shfl_xor(ss, 2); ss += __shfl_xor(ss, 4); ss += __shfl_xor(ss, 8);
            const float rstd = rsqrtf(ss * (1.0f / 256.0f) + 1e-6f);
            unsigned w[8];
#pragma unroll
            for (int j = 0; j < 8; ++j) {
                const float y0 = o[2 * j] * rstd * gn[2 * j] * silu_f(rr[2 * j]), y1 = o[2 * j + 1] * rstd * gn[2 * j + 1] * silu_f(rr[2 * j + 1]);
                w[j] = cvt_pk_bf16(y0, y1);
            }
            *(u32x4*)(a + (size_t)(row0 + q) * 1024 + c0) = (u32x4){w[0], w[1], w[2], w[3]};
            *(u32x4*)(a + (size_t)(row0 + q) * 1024 + c0 + 8) = (u32x4){w[4], w[5], w[6], w[7]};
        }
    }
}

DI void rope_cs(int tpos, int lane, float& cs, float& sn) {
    const int f = lane & 15; const int pos = (lane >> 5) ? (tpos & 63) : (tpos >> 6);
    const float inv = exp2f(-(float)f * (13.287712379549449f / 16.0f));
    const float ang = (float)pos * inv;
    const float kf = rintf(ang * 0.15915494309189535f);
    float r = fmaf(-kf, 6.2831854820251465f, ang); r = fmaf(-kf, -1.7484556000744883e-7f, r);
    cs = __cosf(r); sn = __sinf(r);
}
DI float rope_apply(float y, int lane, float cs, float sn) {
    const float pr = __shfl_xor(y, 16);
    return (lane & 16) ? (pr * sn + y * cs) : (y * cs - pr * sn);
}
DI int key_of_row(int row) {
    if (row < TL) { const int b = row >> 12; return b * KEYS + CTXL + (row & 4095); }
    const int rc = row - TL; const int b = rc >> 8; return b * KEYS + (rc & 255);
}

DI void mlamid_phase(const bf16_t* dn, const float* qln, const float* kvln, const float* knorm, bf16_t* cqn, bf16_t* ckvn, bf16_t* KB) {
    const int tid = tid_opq(), wave = tid >> 6, lane = tid & 63;
    float gq[6];
#pragma unroll
    for (int i = 0; i < 3; ++i) { gq[2 * i] = qln[i * 128 + 2 * lane]; gq[2 * i + 1] = qln[i * 128 + 2 * lane + 1]; }
    const f32x4 gkv = *(const f32x4*)(kvln + 4 * lane);
    const float gpe = knorm[128 + lane];
    for (int row0 = (blockIdx.x * 8 + wave) * 4; row0 < MR; row0 += gridDim.x * 32) {
        unsigned q[4][3]; u32x2 kvv[4]; bf16_t pe[4];
#pragma unroll
        for (int r = 0; r < 4; ++r) { const bf16_t* src = dn + (size_t)(row0 + r) * 768;
#pragma unroll
            for (int i = 0; i < 3; ++i) q[r][i] = *(const unsigned*)(src + i * 128 + 2 * lane);
            kvv[r] = *(const u32x2*)(src + 384 + 4 * lane); pe[r] = src[640 + lane]; }
#pragma unroll
        for (int r = 0; r < 4; ++r) {
            const int row = row0 + r;
            float ss = 0.f;
#pragma unroll
            for (int i = 0; i < 3; ++i) { const float a = bf_lo(q[r][i]), b = bf_hi(q[r][i]); ss += a * a + b * b; }
            ss = wave_sum(ss);
            float rstd = rsqrtf(ss * (1.0f / 384.0f) + 1e-6f);
#pragma unroll
            for (int i = 0; i < 3; ++i) *(unsigned*)(cqn + (size_t)row * 384 + i * 128 + 2 * lane) = cvt_pk_bf16(bf_lo(q[r][i]) * rstd * gq[2 * i], bf_hi(q[r][i]) * rstd * gq[2 * i + 1]);
            const float k0 = bf_lo(kvv[r].x), k1 = bf_hi(kvv[r].x), k2 = bf_lo(kvv[r].y), k3 = bf_hi(kvv[r].y);
            ss = wave_sum(k0 * k0 + k1 * k1 + k2 * k2 + k3 * k3);
            rstd = rsqrtf(ss * (1.0f / 256.0f) + 1e-6f);
            { u32x2 w; w.x = cvt_pk_bf16(k0 * rstd * gkv[0], k1 * rstd * gkv[1]); w.y = cvt_pk_bf16(k2 * rstd * gkv[2], k3 * rstd * gkv[3]);
              *(u32x2*)(ckvn + (size_t)row * 256 + 4 * lane) = w; }
            const float x = __uint_as_float(((unsigned)pe[r]) << 16);
            ss = wave_sum(x * x);
            rstd = rsqrtf(ss * (1.0f / 64.0f) + 1e-6f);
            float y = x * rstd * gpe;
            if (row < TL) { float cs, sn; rope_cs(row & 4095, lane, cs, sn); y = rope_apply(y, lane, cs, sn); }
            const bf16_t yb = f2bf(y);
            bf16_t* kd = KB + (size_t)key_of_row(row) * 1536 + 128 + lane;
#pragma unroll
            for (int hh = 0; hh < 8; ++hh) kd[hh * 192] = yb;
        }
    }
}

DI void qkprep_phase(bf16_t* KB, const float* knorm) {
    const int tid = tid_opq(), wave = tid >> 6, lane = tid & 63;
    const float kn0 = knorm[2 * lane], kn1 = knorm[2 * lane + 1];
    for (int row0 = (blockIdx.x * 8 + wave) * 2; row0 < MR; row0 += gridDim.x * 16) {
        unsigned ka[2][8];
        bf16_t* kr0 = KB + (size_t)key_of_row(row0) * 1536; bf16_t* kr1 = KB + (size_t)key_of_row(row0 + 1) * 1536;
#pragma unroll
        for (int hh = 0; hh < 8; ++hh) { ka[0][hh] = *(const unsigned*)(kr0 + hh * 192 + 2 * lane); ka[1][hh] = *(const unsigned*)(kr1 + hh * 192 + 2 * lane); }
        asm volatile("" ::: "memory");
#pragma unroll
        for (int r = 0; r < 2; ++r) {
            bf16_t* kr = r ? kr1 : kr0;
#pragma unroll
            for (int hh = 0; hh < 8; ++hh) {
                const float c0 = bf_lo(ka[r][hh]), c1 = bf_hi(ka[r][hh]);
                const float s3 = wave_sum(c0 * c0 + c1 * c1);
                const float r3 = rsqrtf(s3 * (1.0f / 128.0f) + 1e-6f);
                *(unsigned*)(kr + hh * 192 + 2 * lane) = cvt_pk_bf16(c0 * r3 * kn0, c1 * r3 * kn1);
            }
        }
    }
}

namespace att {
constexpr int DQK = 192, DV = 128, NW = 8, QBLK = 32, KVBLK = 64;
constexpr int LDQ = 1536, LDK = 1536, LDV = 1024, LDO = 1024;
constexpr float SCALE = 0.07216878364870322f;
constexpr float THR = 8.f;
constexpr size_t SHM_V = KVBLK * DV * 2, SHM_K = KVBLK * DQK * 2;
#define KSWZ(row, colB) ((row) * 384 + ((colB) ^ ((((row) >> 1) & 7) << 4)))
#define SBAR() __builtin_amdgcn_sched_barrier(0)
DI unsigned cvtpk(float lo, float hi) { unsigned r; asm volatile("v_cvt_pk_bf16_f32 %0, %1, %2" : "=v"(r) : "v"(lo), "v"(hi)); return r; }
DI void partialSM(f32x16& p0, f32x16& p1, float& m_reg, float& mn, float& alpha) {
    constexpr float C = SCALE * 1.4426950408889634f;
    float pmax = p0[0];
#pragma unroll
    for (int r = 1; r < 16; ++r) pmax = fmaxf(pmax, p0[r]);
#pragma unroll
    for (int r = 0; r < 16; ++r) pmax = fmaxf(pmax, p1[r]);
    { auto rr = __builtin_amdgcn_permlane32_swap(__float_as_uint(pmax), __float_as_uint(pmax), false, false);
      pmax = fmaxf(__uint_as_float(rr[0]), __uint_as_float(rr[1])); }
    if (__builtin_expect(__all(pmax - m_reg <= THR / SCALE), 1)) { mn = m_reg; alpha = 1.f; }
    else { mn = fmaxf(m_reg, pmax); alpha = __builtin_amdgcn_exp2f((m_reg - mn) * C); m_reg = mn; }
    const float mnC = -mn * C;
#pragma unroll
    for (int r = 0; r < 16; ++r) p0[r] = fmaf(p0[r], C, mnC);
#pragma unroll
    for (int r = 0; r < 16; ++r) p1[r] = fmaf(p1[r], C, mnC);
#pragma unroll
    for (int r = 0; r < 16; ++r) p0[r] = __builtin_amdgcn_exp2f(p0[r]);
}
DI void finishSM(f32x16& p0, f32x16& p1, float alpha, float& l_reg, bf16x8& pa0, bf16x8& pa1, bf16x8& pa2, bf16x8& pa3) {
#pragma unroll
    for (int r = 0; r < 16; ++r) p1[r] = __builtin_amdgcn_exp2f(p1[r]);
    float ps = 0;
#pragma unroll
    for (int r = 0; r < 16; ++r) ps += p0[r];
#pragma unroll
    for (int r = 0; r < 16; ++r) ps += p1[r];
    { auto rr = __builtin_amdgcn_permlane32_swap(__float_as_uint(ps), __float_as_uint(ps), false, false);
      ps = __uint_as_float(rr[0]) + __uint_as_float(rr[1]); }
    l_reg = l_reg * alpha + ps;
#define PK4(P, BASE, OUT) do { unsigned a0 = cvtpk(P[BASE + 0], P[BASE + 1]), a1 = cvtpk(P[BASE + 2], P[BASE + 3]);   \
    unsigned b0 = cvtpk(P[BASE + 4], P[BASE + 5]), b1 = cvtpk(P[BASE + 6], P[BASE + 7]);                              \
    auto r0 = __builtin_amdgcn_permlane32_swap(a0, b0, false, false); auto r1 = __builtin_amdgcn_permlane32_swap(a1, b1, false, false); \
    u32x4 w = {r0[0], r1[0], r0[1], r1[1]}; OUT = *reinterpret_cast<bf16x8*>(&w); } while (0)
    PK4(p0, 0, pa0); PK4(p0, 8, pa1); PK4(p1, 0, pa2); PK4(p1, 8, pa3);
#undef PK4
}
DI void qkt(f32x16& p0, f32x16& p1, const char* Ks, const bf16x8* qr, int r32, int hi) {
#pragma unroll
    for (int r = 0; r < 16; ++r) { p0[r] = 0.f; p1[r] = 0.f; }
    bf16x8 ka[3], kb[3];
#define QK_RD(D0, SLOT) do { const int cb_ = ((D0) * 16 + hi * 8) * 2; ka[SLOT] = *reinterpret_cast<const bf16x8*>(Ks + KSWZ(r32, cb_)); kb[SLOT] = *reinterpret_cast<const bf16x8*>(Ks + KSWZ(32 + r32, cb_)); } while (0)
    QK_RD(0, 0); QK_RD(1, 1);
    __builtin_amdgcn_sched_barrier(0);
#pragma unroll
    for (int d0 = 0; d0 < 12; ++d0) {
        if (d0 + 2 < 12) QK_RD(d0 + 2, (d0 + 2) % 3);
        p0 = __builtin_amdgcn_mfma_f32_32x32x16_bf16(ka[d0 % 3], qr[d0], p0, 0, 0, 0);
        p1 = __builtin_amdgcn_mfma_f32_32x32x16_bf16(kb[d0 % 3], qr[d0], p1, 0, 0, 0);
        __builtin_amdgcn_sched_barrier(0);
    }
#undef QK_RD
}
DI int v_st(int k, int c) { const int kk = (k & ~0xC) | ((k & 4) << 1) | ((k & 8) >> 1); return ((kk >> 3) * 4 + (c >> 5)) * 512 + ((kk & 7) * 32 + (c & 31)) * 2; }
DI int v_rd_base(int lane) { return ((lane & 3) << 3) | (((lane >> 2) & 3) << 6) | (((lane >> 4) & 1) << 5) | (((lane >> 5) & 1) << 8); }
constexpr int v_rd_off(int d0, int ks, int half) { return d0 * 512 + ks * 4096 + half * 2048; }
template <int OFF> DI s16x4 tr_read(int vb) { s16x4 r; asm volatile("ds_read_b64_tr_b16 %0, %1 offset:%2" : "=&v"(r) : "v"(vb), "i"(OFF) : "memory"); return r; }
template <int D0> DI void pv_one(f32x16& od, int vb, bf16x8 pa0, bf16x8 pa1, bf16x8 pa2, bf16x8 pa3) {
    const s16x4 l0 = tr_read<v_rd_off(D0, 0, 0)>(vb), h0 = tr_read<v_rd_off(D0, 0, 1)>(vb), l1 = tr_read<v_rd_off(D0, 1, 0)>(vb), h1 = tr_read<v_rd_off(D0, 1, 1)>(vb);
    const s16x4 l2 = tr_read<v_rd_off(D0, 2, 0)>(vb), h2 = tr_read<v_rd_off(D0, 2, 1)>(vb), l3 = tr_read<v_rd_off(D0, 3, 0)>(vb), h3 = tr_read<v_rd_off(D0, 3, 1)>(vb);
    asm volatile("s_waitcnt lgkmcnt(0)" ::: "memory"); SBAR();
#define PK(L, H) (bf16x8){L[0], L[1], L[2], L[3], H[0], H[1], H[2], H[3]}
    od = __builtin_amdgcn_mfma_f32_32x32x16_bf16(pa0, PK(l0, h0), od, 0, 0, 0);
    od = __builtin_amdgcn_mfma_f32_32x32x16_bf16(pa1, PK(l1, h1), od, 0, 0, 0);
    od = __builtin_amdgcn_mfma_f32_32x32x16_bf16(pa2, PK(l2, h2), od, 0, 0, 0);
    od = __builtin_amdgcn_mfma_f32_32x32x16_bf16(pa3, PK(l3, h3), od, 0, 0, 0);
#undef PK
}
DI void pv_d0(f32x16* o, int vb, bf16x8 pa0, bf16x8 pa1, bf16x8 pa2, bf16x8 pa3) {
    pv_one<0>(o[0], vb, pa0, pa1, pa2, pa3); pv_one<1>(o[1], vb, pa0, pa1, pa2, pa3); pv_one<2>(o[2], vb, pa0, pa1, pa2, pa3); pv_one<3>(o[3], vb, pa0, pa1, pa2, pa3);
}
DI void attn_body(const bf16_t* __restrict__ Qb, const bf16_t* __restrict__ Kh, const bf16_t* __restrict__ Vh, bf16_t* __restrict__ Ob, int seq, char* lds, const float* __restrict__ qnorm, int tpos0) {
    const int tid = tid_opq(), wid = tid >> 6, lane = tid & 63, r32 = lane & 31, hi = lane >> 5;
    char* V_lds = lds; char* K_lds = lds + 2 * SHM_V;
    float* wsf = (float*)(lds + 2 * SHM_V + 2 * SHM_K) + wid * 64; float* li_l = wsf; float* al_l = wsf + 32;
    float m_reg = -1e30f, l_reg = 0; f32x16 o[4]; bf16x8 qr[12];
#pragma unroll
    for (int d = 0; d < 4; ++d)
#pragma unroll
        for (int r = 0; r < 16; ++r) o[d][r] = 0.f;
    const bf16_t* Qw = Qb + (long)(wid * QBLK + r32) * LDQ + hi * 8;
#pragma unroll
    for (int d0 = 0; d0 < 12; ++d0) qr[d0] = *reinterpret_cast<const bf16x8*>(Qw + d0 * 16);
    {
        float ssn = 0.f, ssr = 0.f;
#pragma unroll
        for (int d0 = 0; d0 < 12; ++d0) {
            const u32x4 w = *reinterpret_cast<const u32x4*>(&qr[d0]); float t = 0.f;
#pragma unroll
            for (int j = 0; j < 4; ++j) { const float a = bf_lo(w[j]), b = bf_hi(w[j]); t += a * a + b * b; }
            if (d0 < 8) ssn += t; else ssr += t;
        }
        ssn += __shfl_xor(ssn, 32); ssr += __shfl_xor(ssr, 32);
        const float rn = rsqrtf(ssn * (1.0f / 128.0f) + 1e-6f), rr = rsqrtf(ssr * (1.0f / 64.0f) + 1e-6f);
        float cs[2][8], sn[2][8];
        if (tpos0 >= 0) {
            const int t = tpos0 + wid * QBLK + r32;
#pragma unroll
            for (int a = 0; a < 2; ++a) { const float pos = (float)(a ? (t & 63) : (t >> 6));
#pragma unroll
                for (int j = 0; j < 8; ++j) { const float inv = exp2f(-(float)(hi * 8 + j) * (13.287712379549449f / 16.0f)); const float ang = pos * inv;
                    const float kf = rintf(ang * 0.15915494309189535f); float r = fmaf(-kf, 6.2831854820251465f, ang); r = fmaf(-kf, -1.7484556000744883e-7f, r);
                    cs[a][j] = __cosf(r); sn[a][j] = __sinf(r); } }
        } else {
#pragma unroll
            for (int a = 0; a < 2; ++a)
#pragma unroll
                for (int j = 0; j < 8; ++j) { cs[a][j] = 1.f; sn[a][j] = 0.f; }
        }
#pragma unroll
        for (int d0 = 0; d0 < 8; ++d0) {
            const u32x4 w = *reinterpret_cast<const u32x4*>(&qr[d0]); const float* gp = qnorm + d0 * 16 + hi * 8; const f32x4 g0 = *(const f32x4*)gp, g1 = *(const f32x4*)(gp + 4);
            u32x4 o4; o4.x = cvt_pk_bf16(bf_lo(w.x) * rn * g0[0], bf_hi(w.x) * rn * g0[1]); o4.y = cvt_pk_bf16(bf_lo(w.y) * rn * g0[2], bf_hi(w.y) * rn * g0[3]);
            o4.z = cvt_pk_bf16(bf_lo(w.z) * rn * g1[0], bf_hi(w.z) * rn * g1[1]); o4.w = cvt_pk_bf16(bf_lo(w.w) * rn * g1[2], bf_hi(w.w) * rn * g1[3]);
            qr[d0] = *reinterpret_cast<const bf16x8*>(&o4);
        }
#pragma unroll
        for (int a = 0; a < 2; ++a) {
            const u32x4 w1 = *reinterpret_cast<const u32x4*>(&qr[8 + 2 * a]), w2 = *reinterpret_cast<const u32x4*>(&qr[9 + 2 * a]);
            const float* g1p = qnorm + (8 + 2 * a) * 16 + hi * 8; const float* g2p = g1p + 16;
            float x1[8], x2[8], y1[8], y2[8];
#pragma unroll
            for (int j = 0; j < 4; ++j) { x1[2 * j] = bf_lo(w1[j]) * rr * g1p[2 * j]; x1[2 * j + 1] = bf_hi(w1[j]) * rr * g1p[2 * j + 1]; x2[2 * j] = bf_lo(w2[j]) * rr * g2p[2 * j]; x2[2 * j + 1] = bf_hi(w2[j]) * rr * g2p[2 * j + 1]; }
#pragma unroll
            for (int j = 0; j < 8; ++j) { y1[j] = x1[j] * cs[a][j] - x2[j] * sn[a][j]; y2[j] = x1[j] * sn[a][j] + x2[j] * cs[a][j]; }
            u32x4 o1, o2;
            o1.x = cvt_pk_bf16(y1[0], y1[1]); o1.y = cvt_pk_bf16(y1[2], y1[3]); o1.z = cvt_pk_bf16(y1[4], y1[5]); o1.w = cvt_pk_bf16(y1[6], y1[7]);
            o2.x = cvt_pk_bf16(y2[0], y2[1]); o2.y = cvt_pk_bf16(y2[2], y2[3]); o2.z = cvt_pk_bf16(y2[4], y2[5]); o2.w = cvt_pk_bf16(y2[6], y2[7]);
            qr[8 + 2 * a] = *reinterpret_cast<const bf16x8*>(&o1); qr[9 + 2 * a] = *reinterpret_cast<const bf16x8*>(&o2);
        }
    }
    const int sr = tid >> 4, sc = (tid & 15) * 8, vst0 = v_st(sr, sc), vst1 = v_st(32 + sr, sc);
    const int pr = tid >> 3, pc = 128 + (tid & 7) * 8;
    const int vb0 = (int)(uintptr_t)V_lds + v_rd_base(lane);
    bf16x8 vs0, vs1, ks0, ks1, kp;
#define SLOAD(k0) do { vs0 = *reinterpret_cast<const bf16x8*>(&Vh[(long)((k0) + sr) * LDV + sc]); vs1 = *reinterpret_cast<const bf16x8*>(&Vh[(long)((k0) + 32 + sr) * LDV + sc]); \
    ks0 = *reinterpret_cast<const bf16x8*>(&Kh[(long)((k0) + sr) * LDK + sc]); ks1 = *reinterpret_cast<const bf16x8*>(&Kh[(long)((k0) + 32 + sr) * LDK + sc]); \
    kp = *reinterpret_cast<const bf16x8*>(&Kh[(long)((k0) + pr) * LDK + pc]); } while (0)
#define SWRITE(b) do { *(bf16x8*)(V_lds + (b) * SHM_V + vst0) = vs0; *(bf16x8*)(V_lds + (b) * SHM_V + vst1) = vs1; \
    *(bf16x8*)(K_lds + (b) * SHM_K + KSWZ(sr, sc * 2)) = ks0; *(bf16x8*)(K_lds + (b) * SHM_K + KSWZ(32 + sr, sc * 2)) = ks1; \
    *(bf16x8*)(K_lds + (b) * SHM_K + KSWZ(pr, pc * 2)) = kp; } while (0)
#define RESC(a) do { if (__any((a) < 1.f)) { if (hi == 0) al_l[r32] = (a); asm volatile("s_waitcnt lgkmcnt(0)" ::: "memory"); \
    _Pragma("unroll") for (int d = 0; d < 4; ++d) _Pragma("unroll") for (int r = 0; r < 16; ++r) o[d][r] *= al_l[crow(r, hi)]; } } while (0)
    f32x16 p0, p1; float mn, al; bf16x8 pa0, pa1, pa2, pa3; const int NT = seq / KVBLK;
    SLOAD(0); asm volatile("s_waitcnt vmcnt(0)" ::: "memory"); SWRITE(0); __syncthreads();
    for (int j = 0; j < NT; ++j) {
        const int cb = j & 1;
        if (j + 1 < NT) SLOAD((j + 1) * KVBLK);
        SBAR(); qkt(p0, p1, K_lds + cb * SHM_K, qr, r32, hi);
        partialSM(p0, p1, m_reg, mn, al);
        finishSM(p0, p1, al, l_reg, pa0, pa1, pa2, pa3);
        RESC(al); SBAR();
        pv_d0(o, vb0 + cb * (int)SHM_V, pa0, pa1, pa2, pa3);
        if (j + 1 < NT) { asm volatile("s_waitcnt vmcnt(0)" ::: "memory"); SWRITE(cb ^ 1); }
        __syncthreads();
    }
    if (hi == 0) li_l[r32] = l_reg; asm volatile("s_waitcnt lgkmcnt(0)" ::: "memory");
    float rli[16];
#pragma unroll
    for (int r = 0; r < 16; ++r) rli[r] = __builtin_amdgcn_rcpf(li_l[crow(r, hi)]);
    bf16_t* Ow = Ob + (long)(wid * QBLK) * LDO;
#pragma unroll
    for (int r = 0; r < 16; ++r) { const int orow = crow(r, hi);
#pragma unroll
        for (int d0 = 0; d0 < 4; ++d0) Ow[(long)orow * LDO + d0 * 32 + r32] = f2bf(o[d0][r] * rli[r]); }
#undef SLOAD
#undef SWRITE
#undef RESC
}
#undef KSWZ
#undef SBAR
}

DI void attn_phase(const bf16_t* Q, const bf16_t* KB, const bf16_t* VB, bf16_t* O, char* lds, int nitems, const float* qnorm) {
    for (int it = blockIdx.x; it < nitems; it += gridDim.x) {
        int b, h, qrow0, seq, tpos0;
        if (it < 2048) {
            const int rnd = it >> 8, blk = it & 255, xcd_ = blk & 7, slot_ = blk >> 3, idx = rnd * 16 + xcd_ * 2 + (slot_ >> 4);
            b = idx >> 3; h = idx & 7; tpos0 = (slot_ & 15) * 256; qrow0 = b * SEQ + tpos0; seq = KEYS; }
        else { const int j = it - 2048; b = j >> 3; h = j & 7; qrow0 = TL + b * CTXL; seq = CTXL; tpos0 = -1; }
        att::attn_body(Q + (size_t)qrow0 * 1536 + h * 192, KB + (size_t)b * KEYS * 1536 + h * 192, VB + (size_t)b * KEYS * 1024 + h * 128,
                       O + (size_t)qrow0 * 1024 + h * 128, seq, lds, qnorm, tpos0);
        __syncthreads();
    }
}

DI void fixup_phase(const float* halo, const float* cw, const float* cb, bf16_t* act) {
    const int gtid = blockIdx.x * NTHREADS + tid_opq(), gstride = gridDim.x * NTHREADS;
    for (int idx = gtid; idx < 272 * 22 * 64; idx += gstride) {
        const int c4 = (idx & 31) * 4, which = (idx >> 5) & 1, t = idx >> 6, pn = t % 22, pm = t / 22;
        const float* hp = halo + (size_t)(pm * 22 + pn) * 4 * 256;
        const bool sfirst = pm >= 256 || (pm & 15) == 0, slast = pm >= 256 || (pm & 15) == 15;
        const f32x4 z4 = (f32x4){0.f, 0.f, 0.f, 0.f};
        f32x4 pa, pg, ca, cg_, na, ng; int row;
        if (which == 0) { row = pm * 256;
            if (sfirst) { pa = z4; pg = z4; } else { const float* q = halo + (size_t)((pm - 1) * 22 + pn) * 4 * 256 + 3 * 256; pa = *(const f32x4*)(q + c4); pg = *(const f32x4*)(q + 128 + c4); }
            ca = *(const f32x4*)(hp + c4); cg_ = *(const f32x4*)(hp + 128 + c4); na = *(const f32x4*)(hp + 256 + c4); ng = *(const f32x4*)(hp + 256 + 128 + c4);
        } else { row = pm * 256 + 255;
            pa = *(const f32x4*)(hp + 2 * 256 + c4); pg = *(const f32x4*)(hp + 2 * 256 + 128 + c4); ca = *(const f32x4*)(hp + 3 * 256 + c4); cg_ = *(const f32x4*)(hp + 3 * 256 + 128 + c4);
            if (slast) { na = z4; ng = z4; } else { const float* q = halo + (size_t)((pm + 1) * 22 + pn) * 4 * 256; na = *(const f32x4*)(q + c4); ng = *(const f32x4*)(q + 128 + c4); }
        }
        const int ch = pn * 128 + c4;
        const f32x4 w0a = *(const f32x4*)(cw + ch), w1a = *(const f32x4*)(cw + 5632 + ch), w2a = *(const f32x4*)(cw + 2 * 5632 + ch), ba = *(const f32x4*)(cb + ch);
        const f32x4 w0g = *(const f32x4*)(cw + 2816 + ch), w1g = *(const f32x4*)(cw + 5632 + 2816 + ch), w2g = *(const f32x4*)(cw + 2 * 5632 + 2816 + ch), bg = *(const f32x4*)(cb + 2816 + ch);
        const f32x4 av = w0a * pa + w1a * ca + w2a * na + ba, gv = w0g * pg + w1g * cg_ + w2g * ng + bg;
        u32x2 w; w.x = cvt_pk_bf16(silu_f(gv[0]) * av[0], silu_f(gv[1]) * av[1]); w.y = cvt_pk_bf16(silu_f(gv[2]) * av[2], silu_f(gv[3]) * av[3]);
        *(u32x2*)(act + (size_t)row * 2816 + ch) = w;
    }
}


#define XB_TMO      128
#define XB_XCNT(j)  (256  + 64 * (j))
#define XB_XSUB(j)  (1280 + 64 * (j))
#define XB_XGEN(j)  (2304 + 64 * (j))
#define XB_TOP      3328
#define XB_TOPGEN   3392
#define XCD_BAR_WORDS 3456
#define XB_SPIN_CAP (1u << 18)
DI unsigned xb_ld(unsigned* p)              { return __hip_atomic_load(p, __ATOMIC_RELAXED, __HIP_MEMORY_SCOPE_AGENT); }
DI unsigned xb_add(unsigned* p, unsigned v) { return __hip_atomic_fetch_add(p, v, __ATOMIC_RELAXED, __HIP_MEMORY_SCOPE_AGENT); }
DI unsigned xb_xcc_id() { return (unsigned)__builtin_amdgcn_s_getreg((3 << 11) | 20) & 0xFu; }
#define XB_SPIN(cond, bar) do { unsigned _sp = 0; while (cond) { __builtin_amdgcn_s_sleep(1); \
    if ((++_sp & 255u) == 0u) { if (xb_ld(&(bar)[XB_TMO])) break; if (_sp > XB_SPIN_CAP) { atomicAdd(&(bar)[XB_TMO], 1u); break; } } } } while (0)
struct XcdBarrier { unsigned* bar; unsigned x; volatile LAS unsigned* st; };
DI XcdBarrier xcd_barrier_post(unsigned* bar, volatile LAS unsigned* st) {
    XcdBarrier b; b.bar = bar; b.x = xb_xcc_id(); b.st = st;
    if (threadIdx.x == 0) (void)xb_add(&bar[XB_XCNT(b.x)], 1u);
    return b;
}
DI void xcd_barrier_complete(unsigned* bar, unsigned x, unsigned& nloc, unsigned& nx) {
    const unsigned G = gridDim.x * gridDim.y * gridDim.z;
    unsigned sum, cnt, mine, sp = 0u;
    for (;;) {
        sum = 0u; cnt = 0u; mine = 0u;
#pragma unroll
        for (unsigned j = 0; j < 16; ++j) { const unsigned c = xb_ld(&bar[XB_XCNT(j)]); sum += c; cnt += (c > 0u) ? 1u : 0u; mine = (j == x) ? c : mine; }
        if (sum == G) break;
        __builtin_amdgcn_s_sleep(1);
        if ((++sp & 255u) == 0u) { if (xb_ld(&bar[XB_TMO])) break; if (sp > XB_SPIN_CAP) { atomicAdd(&bar[XB_TMO], 1u); break; } }
    }
    nloc = mine > 0u ? mine : 1u; nx = cnt > 0u ? cnt : 1u;
}
DI void xcd_barrier(const XcdBarrier& b) {
    asm volatile("s_waitcnt vmcnt(0)" ::: "memory");
    __syncthreads();
    if (threadIdx.x == 0) {
        unsigned* bar = b.bar;
        __builtin_amdgcn_s_waitcnt(0);
        unsigned nloc = b.st[0], nx = b.st[1];
        if (nloc == 0u) { xcd_barrier_complete(bar, b.x, nloc, nx); b.st[0] = nloc; b.st[1] = nx; }
        const unsigned old = xb_add(&bar[XB_XSUB(b.x)], 1u);
        const unsigned gen = old / nloc;
        if (old + 1u == (gen + 1u) * nloc) {
            __builtin_amdgcn_fence(__ATOMIC_RELEASE, "agent");
            asm volatile("s_waitcnt vmcnt(0)" ::: "memory");
            const unsigned og = xb_add(&bar[XB_TOP], 1u);
            const unsigned tg = og / nx;
            if (og + 1u == (tg + 1u) * nx) xb_add(&bar[XB_TOPGEN], 1u);
            else XB_SPIN(xb_ld(&bar[XB_TOPGEN]) == tg, bar);
            __builtin_amdgcn_fence(__ATOMIC_ACQUIRE, "agent");
            xb_add(&bar[XB_XGEN(b.x)], 1u);
            asm volatile("s_waitcnt vmcnt(0)" ::: "memory");
        } else {
            XB_SPIN(xb_ld(&bar[XB_XGEN(b.x)]) == gen, bar);
            __builtin_amdgcn_fence(__ATOMIC_ACQUIRE, "agent");
            asm volatile("s_waitcnt vmcnt(0)" ::: "memory");
        }
    }
    __syncthreads();
}

__global__ void __launch_bounds__(NTHREADS) mega(Params p) {
    extern __shared__ __attribute__((aligned(16))) unsigned char smem[];
    LAS unsigned char* lds = (LAS unsigned char*)smem;
    cg::grid_group grid = cg::this_grid();
    volatile LAS unsigned* xb_st = (volatile LAS unsigned*)(lds + XB_ST_OFF);
    if (threadIdx.x < 4) xb_st[threadIdx.x] = 0u;
    __syncthreads();
    XcdBarrier xbar = xcd_barrier_post((unsigned*)((unsigned char*)p.in[27] + WS_BAR), xb_st);

    for (int ph = p.ph_lo; ph < p.ph_hi; ++ph) {
        unsigned char* ws = (unsigned char*)p.in[opq(27)];
        float* const xout = (float*)p.in[opq(26)];
        float* mod = (float*)(ws + WS_MOD);
        float* xc = (float*)(ws + WS_XC);
        bf16_t* hbuf = (bf16_t*)(ws + WS_H);
        if (ph == 0) {
            prep_phase(p, lds);
#if defined(MK_DUP_OP) && MK_DUP_OP == 99
            grid.sync(); prep_phase(p, lds);
#endif
        } else {
            const int q = ph - 1, lp = q / 21; int r = q % 21; int layer, nmix;
            if (r < 10) { layer = 2 * lp; nmix = 6; } else { layer = 2 * lp + 1; r -= 10; nmix = 7; }
            const bool is_mla = layer & 1; const int j = layer >> 1;
            const float* modl = mod + (size_t)layer * 17 * 6144;
            const bool first = (layer == 0);
            int op = -1, gsel = 0, hf = 0;
            if (r < nmix) {
                if (!is_mla) { op = r == 0 ? 0 : r == 1 ? 2 : r == 2 ? 9 : r == 3 ? 3 : r == 4 ? 4 : 2; gsel = r == 1 ? 0 : 1; }
                else { op = r == 0 ? 0 : r == 1 ? 2 : r == 2 ? 5 : r == 3 ? 2 : r == 4 ? 6 : r == 5 ? 7 : 2; gsel = r == 1 ? 2 : r == 3 ? 3 : 5; }
            } else {
                const int f = r - nmix;
                op = f == 0 ? 1 : f == 2 ? 8 : 2; gsel = f == 1 ? 6 : 7;
            }
            if (op == 1 || op == 6 || (op == 0 && layer > 0)) continue;
#ifdef MK_DUP_OP
            for (int rep_ = 0; rep_ < ((op == MK_DUP_OP || (op == 2 && gsel == MK_DUP_OP - 100)) ? 2 : 1); ++rep_) {
            if (rep_) grid.sync();
#else
            {
#endif
            if (op == 0) {
                norm_phase(p.in[opq(0)], p.in[opq(2)], p.in[opq(6)], modl, 0, 1024, hbuf);
                shw_phase(ws, lds);
            } else if (op == 2) {
                const int ng = (gsel == 3) ? 2 : 1;
                for (int gi = 0; gi < ng; ++gi) {
                    pg8::Gemm g; Epi E; int kind = EPI_BF16;
                    E.ldc = 0; E.xch = (LAS float*)(lds + XCH_OFF); E.q0 = nullptr; E.q1 = nullptr; E.q2 = nullptr; E.q3 = nullptr; E.q4 = nullptr; E.q5 = nullptr;
                    float* const shw_mix = (float*)(ws + WS_SHW) + (size_t)(layer * 2) * 17 * 5632; float* const shw_ffn = shw_mix + 17 * 5632;
                    float* const rs0 = (float*)(ws + WS_RS); float* const rs1 = rs0 + MR;
                    g.M = MR;
                    const int gs = gsel + gi;
                    if (gs == 0) { g.A = hbuf; g.Bt = (const bf16_t*)(ws + WS_GIN + j * SZ_GIN); g.N = 3328; g.K = 1024; g.lda = 1024; g.ldb = 1024;
                        kind = EPI_GLA_IN; E.q0 = ws + WS_QK; E.ldc = 1024; E.q1 = ws + WS_LR; E.q2 = ws + WS_VR; if (!first) { E.q3 = rs1; E.q4 = shw_mix; } }
                    else if (gs == 1 || gs == 5) { g.A = hbuf; g.Bt = (const bf16_t*)(ws + (gs == 1 ? WS_GOUT : WS_MOUT) + j * SZ_SQ); g.N = 1024; g.K = 1024; g.lda = 1024; g.ldb = 1024;
                        kind = EPI_RESID; E.ldc = 0; E.q0 = (void*)(first ? p.in[opq(0)] : xout); E.q1 = (void*)(first ? p.in[opq(2)] : xc); E.q2 = xout; E.q3 = ws; E.q4 = (void*)modl; E.q5 = (void*)(p.in[opq(7)] + layer * 1024);
                        for (int i = blockIdx.x * NTHREADS + tid_opq(); i < MR; i += gridDim.x * NTHREADS) rs1[i] = 0.f; }
                    else if (gs == 2) { g.A = hbuf; g.Bt = (const bf16_t*)(ws + WS_MDOWN + j * SZ_MDOWN); g.N = 768; g.K = 1024; g.lda = 1024; g.ldb = 1024;
                        E.q0 = ws + WS_DN; E.ldc = 768; E.q3 = rs1; E.q4 = shw_mix; }
                    else if (gs == 3) { g.A = (const bf16_t*)(ws + WS_CQN); g.Bt = (const bf16_t*)(ws + WS_MUQ + j * SZ_MUQ); g.N = 1536; g.K = 384; g.lda = 384; g.ldb = 384;
                        E.q0 = ws + WS_QRAW; E.ldc = 1536; }
                    else if (gs == 4) { g.A = (const bf16_t*)(ws + WS_CKVN); g.Bt = (const bf16_t*)(ws + WS_MUKV + j * SZ_MUKV); g.N = 2048; g.K = 256; g.lda = 256; g.ldb = 256;
                        kind = EPI_UKV; E.q0 = ws + WS_KB; E.q1 = ws + WS_VB; E.q2 = (void*)(p.in[opq(20)] + j * 192); }
                    else if (gs == 6) { g.A = (const bf16_t*)(ws + WS_XSA); g.Bt = (const bf16_t*)(ws + WS_FUP + (size_t)layer * SZ_FUP); g.N = 5632; g.K = 1024; g.lda = 1024; g.ldb = 1024;
                        kind = EPI_FFN_UP; E.q0 = ws + WS_ACT; E.ldc = 2816; E.q1 = (void*)(p.in[opq(23)] + (size_t)layer * 3 * 2 * DFF); E.q2 = (void*)(p.in[opq(24)] + (size_t)layer * 2 * DFF);
                        E.q3 = ws + WS_HALO; E.q4 = rs0; E.q5 = shw_ffn; }
                    else { g.A = (const bf16_t*)(ws + WS_ACT); g.Bt = (const bf16_t*)(ws + WS_FDOWN + (size_t)layer * SZ_FDOWN); g.N = 1024; g.K = 2816; g.lda = 2816; g.ldb = 2816;
                        kind = EPI_RESID; E.ldc = 1; E.q0 = xout; E.q1 = xc; E.q2 = xout; E.q3 = ws; E.q4 = (void*)modl; E.q5 = layer < 3 ? (void*)(p.in[opq(6)] + (layer + 1) * 1024) : nullptr;
                        for (int i = blockIdx.x * NTHREADS + tid_opq(); i < MR; i += gridDim.x * NTHREADS) rs0[i] = 0.f; }
                    if (layer == 3 && (gs == 3 || gs == 5 || gs == 6 || gs == 7)) g.M = TL;
                    pg8::StaticOrder S; S.init(g.M, g.N, (int)gridDim.x, (int)blockIdx.x);
                    if (kind == EPI_BF16) pg8::gemm_phase<Epi, EPI_BF16>(lds, g, S, E);
                    else if (kind == EPI_GLA_IN) pg8::gemm_phase<Epi, EPI_GLA_IN>(lds, g, S, E);
                    else if (kind == EPI_RESID) pg8::gemm_phase<Epi, EPI_RESID>(lds, g, S, E);
                    else if (kind == EPI_UKV) pg8::gemm_phase<Epi, EPI_UKV>(lds, g, S, E);
                    else pg8::gemm_phase<Epi, EPI_FFN_UP>(lds, g, S, E);
                    __syncthreads();
                }
            } else if (op == 3) {
                scan_phase((const bf16_t*)(ws + WS_VR), (const bf16_t*)(ws + WS_GQ), (const bf16_t*)(ws + WS_GK), (const bf16_t*)(ws + WS_GP), (const float*)(ws + WS_GE),
                           hbuf, (bf16_t*)(ws + WS_QK), lds);
            } else if (op == 9) {
                gateprep_phase((const bf16_t*)(ws + WS_QK), (const float*)(ws + WS_LR), p.in[opq(10)] + (size_t)j * 2 * 16 * 512, p.in[opq(11)] + (size_t)j * 2 * 512,
                               (bf16_t*)(ws + WS_GQ), (bf16_t*)(ws + WS_GK), (bf16_t*)(ws + WS_GP), (float*)(ws + WS_GE), lds);
            } else if (op == 4) {
                glapost_phase(hbuf, (const bf16_t*)(ws + WS_QK), (const bf16_t*)(ws + WS_VR), p.in[opq(12)] + j * 256, hbuf);
            } else if (op == 5) {
                mlamid_phase((const bf16_t*)(ws + WS_DN), p.in[opq(15)] + j * 384, p.in[opq(16)] + j * 256, p.in[opq(20)] + j * 192, (bf16_t*)(ws + WS_CQN), (bf16_t*)(ws + WS_CKVN), (bf16_t*)(ws + WS_KB));
            } else if (op == 6) {
                qkprep_phase((bf16_t*)(ws + WS_KB), p.in[opq(20)] + j * 192);
            } else if (op == 7) {
                attn_phase((const bf16_t*)(ws + WS_QRAW), (const bf16_t*)(ws + WS_KB), (const bf16_t*)(ws + WS_VB), hbuf, (char*)smem, layer == 3 ? 2048 : 2048 + 128, p.in[opq(19)] + j * 192);
            } else if (op == 8) {
                fixup_phase((const float*)(ws + WS_HALO), p.in[opq(23)] + (size_t)layer * 3 * 2 * DFF, p.in[opq(24)] + (size_t)layer * 2 * DFF, (bf16_t*)(ws + WS_ACT));
            }
            }
        }
        if (ph + 1 < p.ph_hi) { if (p.ph_lo < 0) grid.sync(); else xcd_barrier(xbar); }
    }
}

extern "C" void kernel_launch(void* const* d_in, const int* in_sizes, int n_in, void* d_out, int out_size, void* d_ws, size_t ws_size, hipStream_t stream) {
    static int grid = 0;
    if (grid == 0) {
        if (n_in != 26 || ws_size < WS_END) { fprintf(stderr, "kernel_launch: n_in %d ws %zu (need %zu)\n", n_in, ws_size, (size_t)WS_END); grid = -1; return; }
        int dev = 0, cus = 0, per_cu = 0;
        hipGetDevice(&dev);
        hipDeviceGetAttribute(&cus, hipDeviceAttributeMultiprocessorCount, dev);
        if (hipFuncSetAttribute((const void*)mega, hipFuncAttributeMaxDynamicSharedMemorySize, LDS_BYTES) != hipSuccess) { fprintf(stderr, "kernel_launch: hipFuncSetAttribute failed\n"); grid = -1; return; }
        if (hipOccupancyMaxActiveBlocksPerMultiprocessor(&per_cu, (const void*)mega, NTHREADS, LDS_BYTES) != hipSuccess || per_cu < 1) { fprintf(stderr, "kernel_launch: occupancy query %d\n", per_cu); per_cu = 1; }
        (void)hipGetLastError();
        grid = cus * per_cu;
        fprintf(stderr, "kernel_launch: grid %d (cus %d x %d)\n", grid, cus, per_cu);
    }
    if (grid < 0) return;
    Params p{};
    for (int i = 0; i < 26; ++i) p.in[i] = (const float*)d_in[i];
    p.in[26] = (const float*)d_out; p.in[27] = (const float*)d_ws;
    (void)hipMemsetAsync((unsigned char*)d_ws + WS_BAR, 0, 16384, stream);
#if MK_MULTI
    for (int ph = 0; ph < NPH; ++ph) {
        p.ph_lo = ph; p.ph_hi = ph + 1;
        hipLaunchKernelGGL(mega, dim3(grid), dim3(NTHREADS), LDS_BYTES, stream, p);
    }
#else
    p.ph_lo = 0; p.ph_hi = NPH;
    void* args[] = {&p};
    hipError_t e = hipLaunchCooperativeKernel((const void*)mega, dim3(grid), dim3(NTHREADS), args, LDS_BYTES, stream);
    if (e != hipSuccess) fprintf(stderr, "cooperative launch failed: %s (grid %d)\n", hipGetErrorString(e), grid);
#endif
}
```

```cpp
#include <hip/hip_runtime.h>
#include <hip/hip_cooperative_groups.h>
#include <cstdio>
#include <cstdint>
namespace cg = cooperative_groups;

#ifndef MK_MULTI
#define MK_MULTI 0
#endif

#define LAS __attribute__((address_space(3)))
#define DI __device__ __forceinline__
typedef unsigned short bf16_t;
typedef short bf16x8 __attribute__((ext_vector_type(8)));
typedef short s16x4 __attribute__((ext_vector_type(4)));
typedef float f32x2 __attribute__((ext_vector_type(2)));
typedef float f32x4 __attribute__((ext_vector_type(4)));
typedef float f32x16 __attribute__((ext_vector_type(16)));
typedef unsigned u32x2 __attribute__((ext_vector_type(2)));
typedef unsigned u32x4 __attribute__((ext_vector_type(4)));

constexpr int DM = 1024, NB = 16, SEQ = 4096, CTXL = 256;
constexpr int TL = NB * SEQ, TC = NB * CTXL, MR = TL + TC;
constexpr int KEYS = CTXL + SEQ;
constexpr int DFF = 2816, DFFH = 1408;
constexpr int NTHREADS = 512;
constexpr int XB_ST_OFF = 131072 + 12288 + 2 * 5120 + 6144;
constexpr int LDS_BYTES = XB_ST_OFF + 16;
constexpr int WIMG_F = 3072, PREW_F = 3072 + 2 * 1280;
constexpr int XCH_OFF = 131072;
constexpr int NPH = 43;

constexpr size_t SZ_GIN = 3328ull * 1024 * 2, SZ_SQ = 1024ull * 1024 * 2, SZ_MDOWN = 768ull * 1024 * 2, SZ_MUQ = 1536ull * 384 * 2,
                 SZ_MUKV = 2048ull * 256 * 2, SZ_FUP = 5632ull * 1024 * 2, SZ_FDOWN = 1024ull * 2816 * 2;
constexpr size_t WS_GIN = 0;
constexpr size_t WS_GOUT = WS_GIN + 2 * SZ_GIN;
constexpr size_t WS_MDOWN = WS_GOUT + 2 * SZ_SQ;
constexpr size_t WS_MUQ = WS_MDOWN + 2 * SZ_MDOWN;
constexpr size_t WS_MUKV = WS_MUQ + 2 * SZ_MUQ;
constexpr size_t WS_MOUT = WS_MUKV + 2 * SZ_MUKV;
constexpr size_t WS_FUP = WS_MOUT + 2 * SZ_SQ;
constexpr size_t WS_FDOWN = WS_FUP + 4 * SZ_FUP;
constexpr size_t WS_MOD = WS_FDOWN + 4 * SZ_FDOWN;
constexpr size_t SZ_MOD = 4ull * 17 * 6144 * 4;
constexpr size_t WS_RS = WS_MOD + ((SZ_MOD + 255) / 256) * 256;
constexpr size_t WS_SHW = WS_RS + 2ull * MR * 4;
constexpr size_t WS_BAR = WS_SHW + 4ull * 2 * 17 * 5632 * 4;
constexpr size_t WS_XC = WS_BAR + 16384;
constexpr size_t WS_H = WS_XC + (size_t)TC * 1024 * 4;
constexpr size_t WS_R = WS_H + (size_t)MR * 1024 * 2;
constexpr size_t WS_QK = WS_R;
constexpr size_t WS_VR = WS_QK + (size_t)MR * 1024 * 2;
constexpr size_t WS_LR = WS_VR + (size_t)MR * 2048 * 2;
constexpr int NCHI = NB * 2 * 4 * 68;
constexpr size_t WS_GQ = WS_LR + (size_t)MR * 32 * 4;
constexpr size_t WS_GK = WS_GQ + (size_t)NCHI * 64 * 128 * 2;
constexpr size_t WS_GP = WS_GK + (size_t)NCHI * 64 * 128 * 2;
constexpr size_t WS_GE = WS_GP + (size_t)NCHI * 64 * 64 * 2;
constexpr size_t WS_GLA_END = WS_GE + (size_t)NCHI * 128 * 4;
constexpr size_t WS_QRAW = WS_R;
constexpr size_t WS_DN = WS_R;
constexpr size_t WS_CQN = WS_QRAW + (size_t)MR * 1536 * 2;
constexpr size_t WS_CKVN = WS_CQN + (size_t)MR * 384 * 2;
constexpr size_t WS_KB = WS_CKVN + (size_t)MR * 256 * 2;
constexpr size_t WS_VB = WS_KB + (size_t)NB * KEYS * 1536 * 2;
constexpr size_t WS_MLA_END = WS_VB + (size_t)NB * KEYS * 1024 * 2;
constexpr size_t WS_ACT = WS_R;
constexpr size_t WS_HALO = WS_ACT + (size_t)MR * 2816 * 2;
constexpr size_t WS_XSA = WS_HALO + 272ull * 22 * 4 * 256 * 4;
constexpr size_t WS_FFN_END = WS_XSA + (size_t)MR * 1024 * 2;
constexpr size_t WS_END = WS_GLA_END > WS_MLA_END ? (WS_GLA_END > WS_FFN_END ? WS_GLA_END : WS_FFN_END) : (WS_MLA_END > WS_FFN_END ? WS_MLA_END : WS_FFN_END);
static_assert(WS_END <= (1ull << 30), "workspace over 1 GiB");

struct Params { const float* in[28]; int ph_lo, ph_hi; };

DI unsigned cvt_pk_bf16(float lo, float hi) { unsigned r; asm("v_cvt_pk_bf16_f32 %0, %1, %2" : "=v"(r) : "v"(lo), "v"(hi)); return r; }
DI float bf_lo(unsigned u) { return __uint_as_float(u << 16); }
DI float bf_hi(unsigned u) { return __uint_as_float(u & 0xffff0000u); }
DI bf16_t f2bf(float f) { return (bf16_t)(cvt_pk_bf16(f, 0.f) & 0xffffu); }
DI float wave_sum(float v) {
    v += __int_as_float(__builtin_amdgcn_update_dpp(0, __float_as_int(v), 0xB1, 0xF, 0xF, false));
    v += __int_as_float(__builtin_amdgcn_update_dpp(0, __float_as_int(v), 0x4E, 0xF, 0xF, false));
    v += __int_as_float(__builtin_amdgcn_update_dpp(0, __float_as_int(v), 0x141, 0xF, 0xF, false));
    v += __int_as_float(__builtin_amdgcn_update_dpp(0, __float_as_int(v), 0x140, 0xF, 0xF, false));
    v += __int_as_float(__builtin_amdgcn_update_dpp(0, __float_as_int(v), 0x142, 0xA, 0xF, false));
    v += __int_as_float(__builtin_amdgcn_update_dpp(0, __float_as_int(v), 0x143, 0xC, 0xF, false));
    return __int_as_float(__builtin_amdgcn_readlane(__float_as_int(v), 63));
}
DI float silu_f(float v) { return v * __builtin_amdgcn_rcpf(1.0f + __expf(-v)); }
DI int crow(int r, int hi) { return (r & 3) + 8 * (r >> 2) + 4 * hi; }
DI int tid_opq() { int t = threadIdx.x; asm volatile("" : "+v"(t)); return t; }
DI int opq(int i) { asm volatile("" : "+s"(i)); return i; }

namespace pg8 {
constexpr int BM = 256, BK = 64, HALF = 128, HTB = HALF * BK * 2, STAGE_BYTES = 8 * HTB, NXCD = 8, WGM = 8;
DI int lds_byte(int r, int c) { const int st = (r >> 4) * 2 + (c >> 5), rr = r & 15, cc = c & 31, ob = rr * 64 + cc * 2; return st * 1024 + (ob ^ (((ob >> 9) & 1) << 5)); }
DI void stage_rc(int b, int& R, int& C) { const int st = b / 1024, sb = b % 1024, swz = sb ^ (((sb >> 9) & 1) << 5); R = (st >> 1) * 16 + swz / 64; C = (st & 1) * 32 + (swz % 64) / 2; }
DI int perm32(int rho) { const int n = rho >> 4, i = rho & 15; return 8 * (i >> 2) + 4 * n + (i & 3); }
struct Unit { int pm, pn; };
struct Gemm { const bf16_t* A; const bf16_t* Bt; int M, N, K, lda, ldb; };
struct StaticOrder {
    int nM, nN, nwg, G, c;
    DI void init(int M, int N, int G_, int c_) { nM = M / BM; nN = N / BM; nwg = nM * nN; G = G_; c = c_; }
    DI bool next(int i, Unit& u) const {
        const long L = (long)i * G + c; if (L >= nwg) return false;
        int wgid = (int)L; { const int q = nwg / NXCD, r = nwg % NXCD, xcd = wgid % NXCD, off = wgid / NXCD; wgid = (xcd < r ? xcd * (q + 1) : r * (q + 1) + (xcd - r) * q) + off; }
        const int nig = WGM * nN, gid = wgid / nig, fm = gid * WGM, gsz = (nM - fm) < WGM ? (nM - fm) : WGM;
        u.pm = fm + ((wgid % nig) % gsz); u.pn = (wgid % nig) / gsz; return true;
    }
};

template <class Epi, int KIND>
DI void gemm_phase(LAS unsigned char* lds, const Gemm g, const StaticOrder& S, const Epi& E) {
    constexpr bool perm = Epi::template perm_of<KIND>();
    const int tid = tid_opq(), wid = __builtin_amdgcn_readfirstlane(tid >> 6), lane = tid & 63, wr = wid >> 2, wc = wid & 3, fr = lane & 15, fq = lane >> 4;
    const int K = g.K, nt = K / BK;
    unsigned voffA[2], voffB[2];
#pragma unroll
    for (int i = 0; i < 2; ++i) { int R, C; stage_rc(tid * 16 + i * 8192, R, C); const int Rb = perm ? ((R & ~31) + perm32(R & 31)) : R;
        voffA[i] = (unsigned)(R * g.lda + C) * 2u; voffB[i] = (unsigned)(Rb * g.ldb + C) * 2u; }
    const size_t kstep = (size_t)(BK * 2);
    const size_t hstepA = (size_t)HALF * g.lda * 2, hstepB = (size_t)HALF * g.ldb * 2;
    const size_t tstepA = 2 * hstepA, tstepB = 2 * hstepB;
    const unsigned ldsw = (unsigned)wid * 1024u;
    const int aoff = lds_byte(wr * 64 + fr, fq * 8), boff = lds_byte(wc * 32 + fr, fq * 8);
#define PG8_SA(b, h) (((b) * 2 + (h)) * HTB)
#define PG8_SB(b, h) ((4 + (b) * 2 + (h)) * HTB)
#define PG8_STAGE(bufoff, gbase, voff) do { _Pragma("unroll") for (int _i = 0; _i < 2; ++_i) \
        __builtin_amdgcn_global_load_lds((const unsigned*)((const char*)(gbase) + (voff)[_i]), (LAS unsigned*)(lds + (bufoff) + ldsw + _i * 8192), 16, 0, 0); } while (0)
#define PG8_LDA(dst, b, h) do { _Pragma("unroll") for (int m = 0; m < 4; ++m) _Pragma("unroll") for (int k = 0; k < 2; ++k) dst[m][k] = *(const LAS bf16x8*)(lds + PG8_SA(b, h) + aoff + m * 2048 + k * 1024); } while (0)
#define PG8_LDB(dst, b, h) do { _Pragma("unroll") for (int n = 0; n < 2; ++n) _Pragma("unroll") for (int k = 0; k < 2; ++k) dst[n][k] = *(const LAS bf16x8*)(lds + PG8_SB(b, h) + boff + n * 2048 + k * 1024); } while (0)
#define PG8_MMA(ai, bj, At, Bt) do { __builtin_amdgcn_s_setprio(1); _Pragma("unroll") for (int m = 0; m < 4; ++m) _Pragma("unroll") for (int n = 0; n < 2; ++n) _Pragma("unroll") for (int k = 0; k < 2; ++k) \
        acc[ai][bj][m][n] = __builtin_amdgcn_mfma_f32_16x16x32_bf16(Bt[n][k], At[m][k], acc[ai][bj][m][n], 0, 0, 0); __builtin_amdgcn_s_setprio(0); } while (0)
#define PG8_WAIT_V(n) asm volatile("s_waitcnt vmcnt(" #n ")" ::: "memory")
#define PG8_WAIT_L(n) asm volatile("s_waitcnt lgkmcnt(" #n ")" ::: "memory")
#define PG8_BAR __builtin_amdgcn_s_barrier()
#define PG8_SCHED __builtin_amdgcn_sched_barrier(0)
    Unit cur, nxt; int ui = 0;
    if (!S.next(0, cur)) return;
    f32x4 acc[2][2][4][2];
#pragma unroll
    for (int a = 0; a < 2; ++a)
#pragma unroll
        for (int b = 0; b < 2; ++b)
#pragma unroll
            for (int m = 0; m < 4; ++m)
#pragma unroll
                for (int n = 0; n < 2; ++n) acc[a][b][m][n] = (f32x4){0.f, 0.f, 0.f, 0.f};
    bf16x8 At[4][2], B0[2][2], B1[2][2];
    typename Epi::Pre pre;
    const char* cA = (const char*)g.A + (size_t)cur.pm * tstepA; const char* cB = (const char*)g.Bt + (size_t)cur.pn * tstepB;
    PG8_STAGE(PG8_SB(0, 0), cB, voffB); PG8_STAGE(PG8_SA(0, 0), cA, voffA); PG8_STAGE(PG8_SB(0, 1), cB + hstepB, voffB); PG8_STAGE(PG8_SA(0, 1), cA + hstepA, voffA);
    if (wr == 1) PG8_BAR;
    PG8_WAIT_V(4); PG8_BAR;
    PG8_STAGE(PG8_SB(1, 0), cB + kstep, voffB); PG8_STAGE(PG8_SA(1, 0), cA + kstep, voffA); PG8_STAGE(PG8_SB(1, 1), cB + hstepB + kstep, voffB);
    PG8_WAIT_V(6); PG8_BAR;
    for (;;) {
        const bool has_next = S.next(ui + 1, nxt);
        const char* nA = has_next ? (const char*)g.A + (size_t)nxt.pm * tstepA : cA; const char* nB = has_next ? (const char*)g.Bt + (size_t)nxt.pn * tstepB : cB;
        E.template prefetch<KIND>(pre, cur, wr, wc, fr, fq, ui & 1);
        for (int t = 0; t < nt; t += 2) {
            const bool last = (t == nt - 2);
            const char* a1 = cA + (size_t)(t + 1) * kstep;
            const char* a2 = last ? nA : cA + (size_t)(t + 2) * kstep; const char* b2 = last ? nB : cB + (size_t)(t + 2) * kstep;
            const char* a3 = a2 + kstep; const char* b3 = b2 + kstep;
            PG8_LDB(B0, 0, 0); PG8_SCHED; PG8_LDA(At, 0, 0); PG8_STAGE(PG8_SA(1, 1), a1 + hstepA, voffA);
            PG8_WAIT_L(8); PG8_BAR; PG8_WAIT_L(0); PG8_MMA(0, 0, At, B0); PG8_BAR; PG8_SCHED;
            PG8_LDB(B1, 0, 1); PG8_STAGE(PG8_SB(0, 0), b2, voffB);
            PG8_BAR; PG8_WAIT_L(0); PG8_MMA(0, 1, At, B1); PG8_BAR;
            PG8_LDA(At, 0, 1); PG8_STAGE(PG8_SA(0, 0), a2, voffA);
            PG8_BAR; PG8_WAIT_L(0); PG8_MMA(1, 0, At, B0); PG8_BAR; PG8_SCHED;
            PG8_STAGE(PG8_SB(0, 1), b2 + hstepB, voffB);
            PG8_WAIT_V(6); PG8_BAR; PG8_MMA(1, 1, At, B1); PG8_BAR;
            PG8_LDB(B0, 1, 0); PG8_SCHED; PG8_LDA(At, 1, 0); PG8_STAGE(PG8_SA(0, 1), a2 + hstepA, voffA);
            PG8_WAIT_L(8); PG8_BAR; PG8_WAIT_L(0); PG8_MMA(0, 0, At, B0); PG8_BAR; PG8_SCHED;
            PG8_LDB(B1, 1, 1); PG8_STAGE(PG8_SB(1, 0), b3, voffB);
            PG8_BAR; PG8_WAIT_L(0); PG8_MMA(0, 1, At, B1); PG8_BAR;
            PG8_LDA(At, 1, 1); PG8_STAGE(PG8_SA(1, 0), a3, voffA);
            PG8_BAR; PG8_WAIT_L(0); PG8_MMA(1, 0, At, B0); PG8_BAR; PG8_SCHED;
            PG8_STAGE(PG8_SB(1, 1), b3 + hstepB, voffB);
            PG8_WAIT_V(6); PG8_BAR; PG8_MMA(1, 1, At, B1); PG8_BAR;
        }
        if (wr == 0) { PG8_BAR; asm volatile("" ::: "memory"); }
        E.template run<KIND>(acc, pre, cur, wr, wc, fr, fq, ui & 1);
        if (wr == 1) { asm volatile("" ::: "memory"); PG8_BAR; }
        if (!has_next) break;
#pragma unroll
        for (int a = 0; a < 2; ++a)
#pragma unroll
            for (int b = 0; b < 2; ++b)
#pragma unroll
                for (int m = 0; m < 4; ++m)
#pragma unroll
                    for (int n = 0; n < 2; ++n) acc[a][b][m][n] = (f32x4){0.f, 0.f, 0.f, 0.f};
        cur = nxt; cA = nA; cB = nB; ++ui;
    }
    PG8_WAIT_V(0);
    if (wr == 0) PG8_BAR;
    PG8_BAR;
#undef PG8_SA
#undef PG8_SB
#undef PG8_STAGE
#undef PG8_LDA
#undef PG8_LDB
#undef PG8_MMA
#undef PG8_WAIT_V
#undef PG8_WAIT_L
#undef PG8_BAR
#undef PG8_SCHED
}
}

enum { EPI_BF16 = 0, EPI_GLA_IN = 1, EPI_RESID = 2, EPI_UKV = 3, EPI_FFN_UP = 4 };
DI float dpp_ror1(float v) { return __int_as_float(__builtin_amdgcn_update_dpp(0, __float_as_int(v), 0x121, 0xf, 0xf, false)); }
DI float dpp_ror15(float v) { return __int_as_float(__builtin_amdgcn_update_dpp(0, __float_as_int(v), 0x12F, 0xf, 0xf, false)); }
struct Epi {
    struct Pre { float rsv[2][4]; f32x4 sw[2][2]; f32x2 wl0, wl1; };
    int ldc; LAS float* xch;
    void* q0; void* q1; void* q2; void* q3; void* q4; void* q5;
    static DI f32x4 ror1_4(f32x4 v) { float a, b, c, d;
        asm volatile("s_nop 1\n\tv_mov_b32_dpp %0, %4 row_ror:1 row_mask:0xf bank_mask:0xf\n\tv_mov_b32_dpp %1, %5 row_ror:1 row_mask:0xf bank_mask:0xf\n\tv_mov_b32_dpp %2, %6 row_ror:1 row_mask:0xf bank_mask:0xf\n\tv_mov_b32_dpp %3, %7 row_ror:1 row_mask:0xf bank_mask:0xf"
                     : "=&v"(a), "=&v"(b), "=&v"(c), "=&v"(d) : "v"(v[0]), "v"(v[1]), "v"(v[2]), "v"(v[3]));
        return (f32x4){a, b, c, d}; }
    static DI f32x2 ror1_2(f32x2 v) { float a, b;
        asm volatile("s_nop 1\n\tv_mov_b32_dpp %0, %2 row_ror:1 row_mask:0xf bank_mask:0xf\n\tv_mov_b32_dpp %1, %3 row_ror:1 row_mask:0xf bank_mask:0xf" : "=&v"(a), "=&v"(b) : "v"(v[0]), "v"(v[1]));
        return (f32x2){a, b}; }
    static DI f32x2 ror15_2(f32x2 v) { float a, b;
        asm volatile("s_nop 1\n\tv_mov_b32_dpp %0, %2 row_ror:15 row_mask:0xf bank_mask:0xf\n\tv_mov_b32_dpp %1, %3 row_ror:15 row_mask:0xf bank_mask:0xf" : "=&v"(a), "=&v"(b) : "v"(v[0]), "v"(v[1]));
        return (f32x2){a, b}; }
    static DI f32x4 ror15_4(f32x4 v) { float a, b, c, d;
        asm volatile("s_nop 1\n\tv_mov_b32_dpp %0, %4 row_ror:15 row_mask:0xf bank_mask:0xf\n\tv_mov_b32_dpp %1, %5 row_ror:15 row_mask:0xf bank_mask:0xf\n\tv_mov_b32_dpp %2, %6 row_ror:15 row_mask:0xf bank_mask:0xf\n\tv_mov_b32_dpp %3, %7 row_ror:15 row_mask:0xf bank_mask:0xf"
                     : "=&v"(a), "=&v"(b), "=&v"(c), "=&v"(d) : "v"(v[0]), "v"(v[1]), "v"(v[2]), "v"(v[3]));
        return (f32x4){a, b, c, d}; }
    DI void ffn_up(const f32x4 (&acc)[2][2][4][2], const pg8::Unit& u, int wr, int wc, int fr, int fq, int par) const {
        bf16_t* O = (bf16_t*)q0; float* halo = (float*)q3;
        const int cl = wc * 32 + 8 * fq;
        float rstd[2][4];
        { const LAS float* pw = xch + PREW_F + (wr * 4 + wc) * 192;
#pragma unroll
          for (int g = 0; g < 8; ++g) rstd[g >> 2][g & 3] = rsqrtf(pw[g * 16 + fr] * (1.0f / 1024.0f) + 1e-6f); }
        const LAS float* wbuf = xch + WIMG_F + par * 1280;
#define XW(ST, TB, BJ, V0, V1) do { LAS float* xp_ = xch + ((((ST) + 1) * 2 + (TB)) * 2 + (BJ)) * 128 + cl; *(LAS f32x4*)xp_ = (V0); *(LAS f32x4*)(xp_ + 4) = (V1); } while (0)
#define TR(AI, BJ, M, N) (acc[AI][BJ][M][N] * rstd[AI][M])
        if (fr == 0) { XW(wr, 0, 0, TR(0, 0, 0, 0), TR(0, 0, 0, 1)); XW(wr, 0, 1, TR(0, 1, 0, 0), TR(0, 1, 0, 1)); XW(2 + wr, 0, 0, TR(1, 0, 0, 0), TR(1, 0, 0, 1)); XW(2 + wr, 0, 1, TR(1, 1, 0, 0), TR(1, 1, 0, 1)); }
        if (fr == 15) { XW(wr, 1, 0, TR(0, 0, 3, 0), TR(0, 0, 3, 1)); XW(wr, 1, 1, TR(0, 1, 3, 0), TR(0, 1, 3, 1)); XW(2 + wr, 1, 0, TR(1, 0, 3, 0), TR(1, 0, 3, 1)); XW(2 + wr, 1, 1, TR(1, 1, 3, 0), TR(1, 1, 3, 1)); }
        { const f32x4 zz = (f32x4){0.f, 0.f, 0.f, 0.f}; if (fr == 0 && wr == 0) { XW(-1, 1, 0, zz, zz); XW(-1, 1, 1, zz, zz); } if (fr == 15 && wr == 1) { XW(4, 0, 0, zz, zz); XW(4, 0, 1, zz, zz); } }
#undef XW
        asm volatile("s_waitcnt lgkmcnt(0)" ::: "memory"); __builtin_amdgcn_s_barrier(); asm volatile("" ::: "memory"); __builtin_amdgcn_s_barrier(); asm volatile("" ::: "memory");
        {
            float* hp = halo + (size_t)(u.pm * 22 + u.pn) * 4 * 256 + cl;
            const f32x4 sa0 = *(const LAS f32x4*)(wbuf + 512 + cl), sa1 = *(const LAS f32x4*)(wbuf + 512 + cl + 4), sg0 = *(const LAS f32x4*)(wbuf + 640 + 512 + cl), sg1 = *(const LAS f32x4*)(wbuf + 640 + 512 + cl + 4);
            if (wr == 0 && fr < 2) { float* h2 = hp + fr * 256; *(f32x4*)h2 = TR(0, 0, 0, 0) + sa0; *(f32x4*)(h2 + 4) = TR(0, 0, 0, 1) + sa1; *(f32x4*)(h2 + 128) = TR(0, 1, 0, 0) + sg0; *(f32x4*)(h2 + 132) = TR(0, 1, 0, 1) + sg1; }
            if (wr == 1 && fr >= 14) { float* h2 = hp + (fr - 12) * 256; *(f32x4*)h2 = TR(1, 0, 3, 0) + sa0; *(f32x4*)(h2 + 4) = TR(1, 0, 3, 1) + sa1; *(f32x4*)(h2 + 128) = TR(1, 1, 3, 0) + sg0; *(f32x4*)(h2 + 132) = TR(1, 1, 3, 1) + sg1; }
        }
#undef TR
        asm volatile("" ::: "memory");
        const int rowt = u.pm * 256 + wr * 64 + fr;
        const bool f0 = fr == 0, f15 = fr == 15;
        f32x2 sg[2][4][4];
#define SILU2(v) (f32x2){silu_f(v[0]), silu_f(v[1])}
#define H2(V, HH) __builtin_shufflevector(V, V, 2 * (HH), 2 * (HH) + 1)
#define CONV_GROUP(BJ, Q, AI, OP) do { \
            const int st = 2 * (AI) + wr; \
            const f32x2 pb = *(const LAS f32x2*)(xch + (((st) * 2 + 1) * 2 + (BJ)) * 128 + cl + 2 * (Q)) + sw; \
            const f32x2 nb = *(const LAS f32x2*)(xch + (((st + 2) * 2 + 0) * 2 + (BJ)) * 128 + cl + 2 * (Q)) + sw; \
            const f32x2 c0 = H2(acc[AI][BJ][0][(Q) >> 1], (Q) & 1) * rstd[AI][0] + sw, c1 = H2(acc[AI][BJ][1][(Q) >> 1], (Q) & 1) * rstd[AI][1] + sw, \
                        c2 = H2(acc[AI][BJ][2][(Q) >> 1], (Q) & 1) * rstd[AI][2] + sw, c3 = H2(acc[AI][BJ][3][(Q) >> 1], (Q) & 1) * rstd[AI][3] + sw; \
            const f32x2 R0 = ror1_2(c0), L0 = ror15_2(c0), L1 = ror15_2(c1); \
            { const f32x2 v = w0 * (f0 ? pb : R0) + w1 * c0 + w2 * (f15 ? L1 : L0) + bb; OP(sg[AI][0][Q], v); } \
            __builtin_amdgcn_sched_barrier(0); \
            const f32x2 R1 = ror1_2(c1), L2 = ror15_2(c2); \
            { const f32x2 v = w0 * (f0 ? R0 : R1) + w1 * c1 + w2 * (f15 ? L2 : L1) + bb; OP(sg[AI][1][Q], v); } \
            __builtin_amdgcn_sched_barrier(0); \
            const f32x2 R2 = ror1_2(c2), L3 = ror15_2(c3); \
            { const f32x2 v = w0 * (f0 ? R1 : R2) + w1 * c2 + w2 * (f15 ? L3 : L2) + bb; OP(sg[AI][2][Q], v); } \
            __builtin_amdgcn_sched_barrier(0); \
            const f32x2 R3 = ror1_2(c3); \
            { const f32x2 v = w0 * (f0 ? R2 : R3) + w1 * c3 + w2 * (f15 ? nb : L3) + bb; OP(sg[AI][3][Q], v); } \
            __builtin_amdgcn_sched_barrier(0); } while (0)
#define OP_G(dst, v) dst = SILU2(v)
#define OP_A(dst, v) dst *= v
#define CONV_W(BJ, Q) const LAS float* wp_ = wbuf + (BJ) * 640 + cl + 2 * (Q); \
            const f32x2 w0 = *(const LAS f32x2*)wp_, w1 = *(const LAS f32x2*)(wp_ + 128), w2 = *(const LAS f32x2*)(wp_ + 256), bb = *(const LAS f32x2*)(wp_ + 384), sw = *(const LAS f32x2*)(wp_ + 512);
        { CONV_W(1, 0) CONV_GROUP(1, 0, 0, OP_G); CONV_GROUP(1, 0, 1, OP_G); }
        { CONV_W(1, 1) CONV_GROUP(1, 1, 0, OP_G); CONV_GROUP(1, 1, 1, OP_G); }
        { CONV_W(1, 2) CONV_GROUP(1, 2, 0, OP_G); CONV_GROUP(1, 2, 1, OP_G); }
        { CONV_W(1, 3) CONV_GROUP(1, 3, 0, OP_G); CONV_GROUP(1, 3, 1, OP_G); }
        { CONV_W(0, 0) CONV_GROUP(0, 0, 0, OP_A); CONV_GROUP(0, 0, 1, OP_A); }
        { CONV_W(0, 1) CONV_GROUP(0, 1, 0, OP_A); CONV_GROUP(0, 1, 1, OP_A); }
        { CONV_W(0, 2) CONV_GROUP(0, 2, 0, OP_A); CONV_GROUP(0, 2, 1, OP_A); }
        { CONV_W(0, 3) CONV_GROUP(0, 3, 0, OP_A); CONV_GROUP(0, 3, 1, OP_A); }
#undef CONV_W
#undef CONV_GROUP
#undef OP_G
#undef OP_A
#undef SILU2
#undef H2
#define ST16(AI, MM) do { u32x4 w_; w_.x = cvt_pk_bf16(sg[AI][MM][0][0], sg[AI][MM][0][1]); w_.y = cvt_pk_bf16(sg[AI][MM][1][0], sg[AI][MM][1][1]); w_.z = cvt_pk_bf16(sg[AI][MM][2][0], sg[AI][MM][2][1]); w_.w = cvt_pk_bf16(sg[AI][MM][3][0], sg[AI][MM][3][1]); \
            *(u32x4*)(O + (size_t)(rowt + (AI) * 128 + (MM) * 16) * 2816 + u.pn * 128 + cl) = w_; } while (0)
        ST16(0, 0); ST16(0, 1); ST16(0, 2); ST16(0, 3); ST16(1, 0); ST16(1, 1); ST16(1, 2); ST16(1, 3);
#undef ST16
    }
    template <int K> static constexpr bool perm_of() { return true; }
    template <int kind> DI void prefetch(Pre& P, const pg8::Unit& u, int wr, int wc, int fr, int fq, int par) const {
        (void)P;
        if constexpr (kind == EPI_UKV) {
            if (fq == 0 && fr < 8) __builtin_amdgcn_global_load_lds((const unsigned*)((const float*)q2 + wc * 32 + fr * 4), (LAS unsigned*)(xch + PREW_F + (wr * 4 + wc) * 192 + 128), 16, 0, 0);
        }
        if constexpr (kind == EPI_GLA_IN || kind == EPI_BF16 || kind == EPI_FFN_UP) {
            const float* rsb = (const float*)(kind == EPI_FFN_UP ? q4 : q3);
            if (rsb) {
                LAS float* pw = xch + PREW_F + (wr * 4 + wc) * 192;
                const int bidx = u.pm < 256 ? (u.pm >> 4) : 16;
                if (fq == 0) {
                    const float* rsp = rsb + u.pm * 256 + wr * 64 + fr;
#pragma unroll
                    for (int g = 0; g < 8; ++g) __builtin_amdgcn_global_load_lds((const unsigned*)(rsp + (g >> 2) * 128 + (g & 3) * 16), (LAS unsigned*)(pw + g * 16), 4, 0, 0);
                    if constexpr (kind != EPI_FFN_UP) {
                        const float* sw = (const float*)q4 + (size_t)bidx * 5632 + u.pn * 256 + (fr >> 3) * 128 + wc * 32 + (fr & 7) * 4;
                        __builtin_amdgcn_global_load_lds((const unsigned*)sw, (LAS unsigned*)(pw + 128), 16, 0, 0);
                    }
                }
                if constexpr (kind == EPI_FFN_UP) {
                    const int wid = wr * 4 + wc;
                    if (wid < 5) {
                        const float* cw = (const float*)q1; const float* cb = (const float*)q2; const float* shw = (const float*)q5 + (size_t)bidx * 5632 + u.pn * 256;
                        const int i4 = (wid * 64 + fq * 16 + fr) * 4, bjw = i4 / 640, rem = i4 % 640, kw = rem >> 7, c_ = rem & 127;
                        const float* srcw = kw < 3 ? cw + kw * 5632 + bjw * 2816 + u.pn * 128 + c_ : kw == 3 ? cb + bjw * 2816 + u.pn * 128 + c_ : shw + bjw * 128 + c_;
                        __builtin_amdgcn_global_load_lds((const unsigned*)srcw, (LAS unsigned*)(xch + WIMG_F + par * 1280 + wid * 256), 16, 0, 0);
                    }
                }
            }
        }
    }
    template <int kind> DI void run(const f32x4 (&acc)[2][2][4][2], const Pre& P, const pg8::Unit& u, int wr, int wc, int fr, int fq, int par) const {
        asm volatile("" : "+v"(fr), "+v"(fq));
        if constexpr (kind == EPI_FFN_UP) { ffn_up(acc, u, wr, wc, fr, fq, par); return; }
        if constexpr (kind == EPI_RESID) {
            const float* base_l = (const float*)q0; const float* base_c = (const float*)q1; float* out_l = (float*)q2; unsigned char* wsb = (unsigned char*)q3; float* out_c = (float*)(wsb + WS_XC);
            const float* modl = (const float*)q4; const float* gnext = (const float*)q5;
            const int bidx = u.pm < 256 ? (u.pm >> 4) : 16;
            const float* gv = modl + (size_t)bidx * 6144 + (ldc ? 5 * 1024 : 2 * 1024);
            const float* bp = u.pm < 256 ? base_l + (size_t)u.pm * 256 * 1024 : base_c + (size_t)(u.pm - 256) * 256 * 1024;
            float* op = u.pm < 256 ? out_l + (size_t)u.pm * 256 * 1024 : out_c + (size_t)(u.pm - 256) * 256 * 1024;
            const int col0 = u.pn * 256 + wc * 32 + 8 * fq;
            f32x4 gt[2][2], gn[2][2];
#pragma unroll
            for (int bj = 0; bj < 2; ++bj)
#pragma unroll
                for (int n = 0; n < 2; ++n) gt[bj][n] = *(const f32x4*)(gv + col0 + bj * 128 + n * 4);
            if (gnext) {
                const float* scn = ldc ? modl + (size_t)(17 + bidx) * 6144 + 1024 : modl + (size_t)bidx * 6144 + 4 * 1024;
#pragma unroll
                for (int bj = 0; bj < 2; ++bj)
#pragma unroll
                    for (int n = 0; n < 2; ++n) gn[bj][n] = *(const f32x4*)(gnext + col0 + bj * 128 + n * 4) * (*(const f32x4*)(scn + col0 + bj * 128 + n * 4) + 1.0f);
            }
            bf16_t* xs = (bf16_t*)(wsb + (ldc ? WS_H : WS_XSA)) + (size_t)u.pm * 256 * 1024;
            float* rs = (float*)(wsb + WS_RS) + (ldc ? MR : 0) + u.pm * 256;
            f32x4 bsA[4], bsB[4];
#define RS_LOAD(K, DST) do { const size_t off_ = (size_t)(((K) >> 2) * 128 + wr * 64 + ((K) & 3) * 16 + fr) * 1024 + col0; \
                _Pragma("unroll") for (int q_ = 0; q_ < 4; ++q_) DST[q_] = *(const f32x4*)(bp + off_ + (q_ >> 1) * 128 + (q_ & 1) * 4); } while (0)
#define RS_DO(K, SRC) do { const int ai_ = (K) >> 2, m_ = (K) & 3; const int rl = ai_ * 128 + wr * 64 + m_ * 16 + fr; const size_t off = (size_t)rl * 1024 + col0; float ssq = 0.f; \
                _Pragma("unroll") for (int bj = 0; bj < 2; ++bj) { \
                    const f32x4 xa = SRC[2 * bj] + gt[bj][0] * acc[ai_][bj][m_][0], xb = SRC[2 * bj + 1] + gt[bj][1] * acc[ai_][bj][m_][1]; \
                    *(f32x4*)(op + off + bj * 128) = xa; *(f32x4*)(op + off + bj * 128 + 4) = xb; \
                    if (gnext) { ssq += xa[0] * xa[0] + xa[1] * xa[1] + xa[2] * xa[2] + xa[3] * xa[3] + xb[0] * xb[0] + xb[1] * xb[1] + xb[2] * xb[2] + xb[3] * xb[3]; \
                        const f32x4 ya = xa * gn[bj][0], yb = xb * gn[bj][1]; \
                        u32x4 w; w.x = cvt_pk_bf16(ya[0], ya[1]); w.y = cvt_pk_bf16(ya[2], ya[3]); w.z = cvt_pk_bf16(yb[0], yb[1]); w.w = cvt_pk_bf16(yb[2], yb[3]); \
                        *(u32x4*)(xs + off + bj * 128) = w; } } \
                if (gnext) { ssq += __shfl_xor(ssq, 16); ssq += __shfl_xor(ssq, 32); if (fq == 0) unsafeAtomicAdd(rs + rl, ssq); } } while (0)
            RS_LOAD(0, bsA);
            RS_LOAD(1, bsB); RS_DO(0, bsA);
            RS_LOAD(2, bsA); RS_DO(1, bsB);
            RS_LOAD(3, bsB); RS_DO(2, bsA);
            RS_LOAD(4, bsA); RS_DO(3, bsB);
            RS_LOAD(5, bsB); RS_DO(4, bsA);
            RS_LOAD(6, bsA); RS_DO(5, bsB);
            RS_LOAD(7, bsB); RS_DO(6, bsA);
            RS_DO(7, bsB);
#undef RS_LOAD
#undef RS_DO
            return;
        } else {
        bf16_t* O = (bf16_t*)q0; float* lr = (float*)q1; bf16_t* KB = (bf16_t*)q0; bf16_t* VB = (bf16_t*)q1;
        const int rowt = u.pm * 256 + wr * 64 + fr;
        f32x4 swv[2][2]; float rsv[2][4];
        float krs[2][4]; f32x4 kg0, kg1;
        if constexpr (kind == EPI_UKV) {
            LAS float* P = xch;
#pragma unroll
            for (int ai = 0; ai < 2; ++ai)
#pragma unroll
                for (int m = 0; m < 4; ++m) {
                    const f32x4 a = acc[ai][0][m][0], b = acc[ai][0][m][1];
                    float t = a[0] * a[0] + a[1] * a[1] + a[2] * a[2] + a[3] * a[3] + b[0] * b[0] + b[1] * b[1] + b[2] * b[2] + b[3] * b[3];
                    t += __shfl_xor(t, 16); t += __shfl_xor(t, 32);
                    if (fq == 0) P[(ai * 128 + wr * 64 + m * 16 + fr) * 4 + wc] = t;
                }
            asm volatile("s_waitcnt lgkmcnt(0)" ::: "memory"); __builtin_amdgcn_s_barrier(); asm volatile("" ::: "memory");
#pragma unroll
            for (int ai = 0; ai < 2; ++ai)
#pragma unroll
                for (int m = 0; m < 4; ++m) { const f32x4 t4 = *(const LAS f32x4*)(P + (ai * 128 + wr * 64 + m * 16 + fr) * 4); krs[ai][m] = rsqrtf((t4[0] + t4[1] + t4[2] + t4[3]) * (1.0f / 128.0f) + 1e-6f); }
            { const LAS float* pw = xch + PREW_F + (wr * 4 + wc) * 192 + 128 + 8 * fq; kg0 = *(const LAS f32x4*)pw; kg1 = *(const LAS f32x4*)(pw + 4); }
        }
        if constexpr (kind == EPI_GLA_IN || kind == EPI_BF16) {
            if (q3) { const LAS float* pw = xch + PREW_F + (wr * 4 + wc) * 192;
#pragma unroll
                for (int g = 0; g < 8; ++g) rsv[g >> 2][g & 3] = pw[g * 16 + fr];
#pragma unroll
                for (int bj = 0; bj < 2; ++bj) { swv[bj][0] = *(const LAS f32x4*)(pw + 128 + bj * 32 + 8 * fq); swv[bj][1] = *(const LAS f32x4*)(pw + 128 + bj * 32 + 8 * fq + 4); } }
        }
#pragma unroll
        for (int ai = 0; ai < 2; ++ai)
#pragma unroll
            for (int m = 0; m < 4; ++m) {
                const int row = rowt + ai * 128 + m * 16;
#pragma unroll
                for (int bj = 0; bj < 2; ++bj) {
                    f32x4 v0 = acc[ai][bj][m][0], v1 = acc[ai][bj][m][1];
                    const int cin = bj * 128 + wc * 32 + 8 * fq;
                    if constexpr (kind == EPI_GLA_IN || kind == EPI_BF16) {
                        if (q3) {
                            const float rstd = rsqrtf(rsv[ai][m] * (1.0f / 1024.0f) + 1e-6f);
                            v0 = v0 * rstd + swv[bj][0]; v1 = v1 * rstd + swv[bj][1];
                        }
                    }
                    if constexpr (kind == EPI_GLA_IN) {
                        if (u.pn == 12) {
                            if (bj == 0 && wc == 0) { float* lp = lr + (size_t)row * 32 + 8 * fq; *(f32x4*)lp = v0; *(f32x4*)(lp + 4) = v1; }
                            continue;
                        }
                        if (u.pn < 2) { v0 *= 0.08838834764831845f; v1 *= 0.08838834764831845f; }
                    }
                    u32x4 w; w.x = cvt_pk_bf16(v0[0], v0[1]); w.y = cvt_pk_bf16(v0[2], v0[3]); w.z = cvt_pk_bf16(v1[0], v1[1]); w.w = cvt_pk_bf16(v1[2], v1[3]);
                    if constexpr (kind == EPI_GLA_IN) {
                        if (u.pn < 4) *(u32x4*)(O + (size_t)row * 1024 + u.pn * 256 + cin) = w;
                        else *(u32x4*)((bf16_t*)q2 + (size_t)row * 2048 + (u.pn - 4) * 256 + cin) = w;
                    } else if constexpr (kind == EPI_UKV) {
                        if (bj == 0) { const f32x4 n0 = v0 * krs[ai][m] * kg0, n1 = v1 * krs[ai][m] * kg1;
                            w.x = cvt_pk_bf16(n0[0], n0[1]); w.y = cvt_pk_bf16(n0[2], n0[3]); w.z = cvt_pk_bf16(n1[0], n1[1]); w.w = cvt_pk_bf16(n1[2], n1[3]); }
                        int key;
                        if (u.pm < 256) { const int b = u.pm >> 4; key = b * KEYS + CTXL + (row - b * SEQ); }
                        else { const int b = u.pm - 256; key = b * KEYS + (row - TL - b * CTXL); }
                        const int cc = wc * 32 + 8 * fq;
                        if (bj == 0) *(u32x4*)(KB + (size_t)key * 1536 + u.pn * 192 + cc) = w;
                        else *(u32x4*)(VB + (size_t)key * 1024 + u.pn * 128 + cc) = w;
                    } else {
                        *(u32x4*)(O + (size_t)row * ldc + u.pn * 256 + cin) = w;
                    }
                }
            }
        }
    }
};

DI void prep_phase(const Params& p, LAS unsigned char* lds) {
    const int tid = tid_opq();
    unsigned char* ws = (unsigned char*)p.in[opq(27)];
    LAS float* tl = (LAS float*)lds;
    const float* in_c = p.in[opq(1)]; const float* in_cctx = p.in[opq(3)]; const float* in_wada = p.in[opq(4)]; const float* in_bada = p.in[opq(5)];
    const float* in_gin = p.in[opq(8)]; const float* in_w1 = p.in[opq(9)]; const float* in_gout = p.in[opq(13)]; const float* in_mdown = p.in[opq(14)];
    const float* in_uq = p.in[opq(17)]; const float* in_ukv = p.in[opq(18)]; const float* in_mout = p.in[opq(21)]; const float* in_fup = p.in[opq(22)]; const float* in_fdown = p.in[opq(25)];
    constexpr int T0 = 1536, T2 = 512, T3 = 352, T4 = 288, T5 = 256, T6 = 512, T7 = 5632, T8 = 2816;
    constexpr int NTILE = T0 + T2 + T3 + T4 + T5 + T6 + T7 + T8;
    for (int t = blockIdx.x; t < NTILE; t += gridDim.x) {
        const float* src; int N, k0, n0, ld; bf16_t* dst;
        int q = t;
        if (q < T0) { const int j = q / 768, r = q % 768, kt = r / 48, nt = r % 48; src = in_gin + (size_t)j * 1024 * 3072; N = 3072; k0 = kt * 64; n0 = nt * 64;
            dst = (bf16_t*)(ws + WS_GIN + j * SZ_GIN) + (size_t)n0 * 1024 + k0; ld = 1024; }
        else if ((q -= T0) < T2) { const int j = q / 256, r = q % 256, kt = r / 16, nt = r % 16; src = in_gout + (size_t)j * 1024 * 1024; N = 1024; k0 = kt * 64; n0 = nt * 64;
            dst = (bf16_t*)(ws + WS_GOUT + j * SZ_SQ) + (size_t)n0 * 1024 + k0; ld = 1024; }
        else if ((q -= T2) < T3) { const int j = q / 176, r = q % 176, kt = r / 11, nt = r % 11; src = in_mdown + (size_t)j * 1024 * 704; N = 704; k0 = kt * 64; n0 = nt * 64;
            dst = (bf16_t*)(ws + WS_MDOWN + j * SZ_MDOWN) + (size_t)n0 * 1024 + k0; ld = 1024; }
        else if ((q -= T3) < T4) { const int j = q / 144, r = q % 144, kt = r / 24, nt = r % 24; src = in_uq + (size_t)j * 384 * 1536; N = 1536; k0 = kt * 64; n0 = nt * 64;
            dst = (bf16_t*)(ws + WS_MUQ + j * SZ_MUQ) + (size_t)n0 * 384 + k0; ld = 384; }
        else if ((q -= T4) < T5) { const int j = q / 128, r = q % 128, kt = r / 32, nt = r % 32; src = in_ukv + (size_t)j * 256 * 2048; N = 2048; k0 = kt * 64; n0 = nt * 64;
            dst = (bf16_t*)(ws + WS_MUKV + j * SZ_MUKV) + (size_t)n0 * 256 + k0; ld = 256; }
        else if ((q -= T5) < T6) { const int j = q / 256, r = q % 256, kt = r / 16, nt = r % 16; src = in_mout + (size_t)j * 1024 * 1024; N = 1024; k0 = kt * 64; n0 = nt * 64;
            dst = (bf16_t*)(ws + WS_MOUT + j * SZ_SQ) + (size_t)n0 * 1024 + k0; ld = 1024; }
        else if ((q -= T6) < T7) { const int i = q / 1408, r = q % 1408, kt = r / 88, nt = r % 88; src = in_fup + (size_t)i * 1024 * 5632; N = 5632; k0 = kt * 64; n0 = nt * 64;
            const int isg = n0 >= DFF ? 1 : 0, cc = n0 - isg * DFF, drow = (cc >> 7) * 256 + isg * 128 + (cc & 127);
            dst = (bf16_t*)(ws + WS_FUP + (size_t)i * SZ_FUP) + (size_t)drow * 1024 + k0; ld = 1024; }
        else { q -= T7; const int i = q / 704, r = q % 704, kt = r / 16, nt = r % 16; src = in_fdown + (size_t)i * 2816 * 1024; N = 1024; k0 = kt * 64; n0 = nt * 64;
            dst = (bf16_t*)(ws + WS_FDOWN + (size_t)i * SZ_FDOWN) + (size_t)n0 * 2816 + k0; ld = 2816; }
#pragma unroll
        for (int i = 0; i < 8; ++i) { const int r = (tid >> 6) + 8 * i, c = tid & 63; tl[c * 65 + r] = src[(size_t)(k0 + r) * N + n0 + c]; }
        __syncthreads();
#pragma unroll
        for (int i = 0; i < 4; ++i) { const int rr = (tid >> 5) + 16 * i, c2 = (tid & 31) * 2; const float a = tl[rr * 65 + c2], b = tl[rr * 65 + c2 + 1];
            *(unsigned*)(dst + (size_t)rr * ld + c2) = cvt_pk_bf16(a, b); }
        __syncthreads();
    }
    const int gtid = blockIdx.x * NTHREADS + tid, gstride = gridDim.x * NTHREADS;
    for (int idx = gtid; idx < 65536; idx += gstride) {
        const int k = idx & 1023, r = (idx >> 10) & 15, dir = (idx >> 14) & 1, j = idx >> 15;
        const float v = in_w1[((size_t)(j * 2 + dir) * 1024 + k) * 16 + r];
        ((bf16_t*)(ws + WS_GIN + j * SZ_GIN))[(size_t)(3072 + dir * 16 + r) * 1024 + k] = f2bf(v);
    }
    for (int idx = gtid; idx < 2 * 114688; idx += gstride) { const int j = idx / 114688, o = idx % 114688; ((unsigned*)(ws + WS_GIN + j * SZ_GIN + 3104ull * 1024 * 2))[o] = 0u; }
    for (int idx = gtid; idx < 2 * 32768; idx += gstride) { const int j = idx / 32768, o = idx % 32768; ((unsigned*)(ws + WS_MDOWN + j * SZ_MDOWN + 704ull * 1024 * 2))[o] = 0u; }
    for (int idx = gtid; idx < MR; idx += gstride) ((float*)(ws + WS_RS))[idx] = 0.f;
    LAS float* sl = (LAS float*)lds;
    LAS float* red = (LAS float*)(lds + 81920);
    __syncthreads();
    for (int idx = tid; idx < 17 * 1024; idx += NTHREADS) { const int r = idx >> 10, k = idx & 1023; const float v = r < 16 ? in_c[r * 1024 + k] : in_cctx[k]; sl[k * 20 + r] = v / (1.0f + __expf(-v)); }
    __syncthreads();
    float* mod = (float*)(ws + WS_MOD);
    for (int it = blockIdx.x; it < 384; it += gridDim.x) {
        const int layer = it / 96, n0 = (it % 96) * 64, nn = tid & 63, ks = tid >> 6;
        const float* W = in_wada + (size_t)layer * 1024 * 6144 + n0 + nn;
        float acc[17];
#pragma unroll
        for (int r = 0; r < 17; ++r) acc[r] = 0.f;
        for (int kk = 0; kk < 128; ++kk) {
            const int k = ks * 128 + kk; const float w = W[(size_t)k * 6144];
            const f32x4 s0 = *(const LAS f32x4*)(sl + k * 20), s1 = *(const LAS f32x4*)(sl + k * 20 + 4), s2 = *(const LAS f32x4*)(sl + k * 20 + 8), s3 = *(const LAS f32x4*)(sl + k * 20 + 12);
            const float s16 = sl[k * 20 + 16];
#pragma unroll
            for (int j = 0; j < 4; ++j) { acc[j] += s0[j] * w; acc[4 + j] += s1[j] * w; acc[8 + j] += s2[j] * w; acc[12 + j] += s3[j] * w; }
            acc[16] += s16 * w;
        }
#pragma unroll
        for (int r = 0; r < 17; ++r) red[(ks * 17 + r) * 64 + nn] = acc[r];
        __syncthreads();
        for (int o = tid; o < 17 * 64; o += NTHREADS) { const int r = o >> 6, c = o & 63; float s = in_bada[layer * 6144 + n0 + c];
#pragma unroll
            for (int k8 = 0; k8 < 8; ++k8) s += red[(k8 * 17 + r) * 64 + c];
            mod[(size_t)(layer * 17 + r) * 6144 + n0 + c] = s; }
        __syncthreads();
    }
}

DI void shw_phase(unsigned char* ws, LAS unsigned char* lds) {
    const int tid = tid_opq(), wave = tid >> 6, lane = tid & 63;
    LAS float* sl = (LAS float*)lds;
    const float* mod = (const float*)(ws + WS_MOD);
    constexpr int NCH = 4 * 44 + 6 + 26 + 6;
    for (int ch = blockIdx.x; ch < NCH; ch += gridDim.x) {
        int layer, kind, n0; const bf16_t* Bt;
        if (ch < 176) { layer = ch / 44; kind = 1; n0 = (ch % 44) * 128; Bt = (const bf16_t*)(ws + WS_FUP + (size_t)layer * SZ_FUP); }
        else if (ch < 182) { layer = 1; kind = 0; n0 = (ch - 176) * 128; Bt = (const bf16_t*)(ws + WS_MDOWN); }
        else if (ch < 208) { layer = 2; kind = 0; n0 = (ch - 182) * 128; Bt = (const bf16_t*)(ws + WS_GIN + SZ_GIN); }
        else { layer = 3; kind = 0; n0 = (ch - 208) * 128; Bt = (const bf16_t*)(ws + WS_MDOWN + SZ_MDOWN); }
        __syncthreads();
        for (int idx = tid; idx < 17 * 256; idx += NTHREADS) { const int b = idx >> 8, k4 = (idx & 255) * 4;
            *(LAS f32x4*)(sl + b * 1024 + k4) = *(const f32x4*)(mod + (size_t)(layer * 17 + b) * 6144 + (kind ? 3 * 1024 : 0) + k4); }
        __syncthreads();
        float* out = (float*)(ws + WS_SHW) + (size_t)((layer * 2 + kind) * 17) * 5632;
#pragma unroll 1
        for (int i = 0; i < 16; ++i) {
            const int n = n0 + wave * 16 + i;
            float w[16];
#pragma unroll
            for (int j = 0; j < 4; ++j) { const u32x2 t = *(const u32x2*)(Bt + (size_t)n * 1024 + j * 256 + lane * 4); w[4 * j] = bf_lo(t.x); w[4 * j + 1] = bf_hi(t.x); w[4 * j + 2] = bf_lo(t.y); w[4 * j + 3] = bf_hi(t.y); }
            float mine = 0.f;
#pragma unroll 1
            for (int b = 0; b < 17; ++b) {
                float a = 0.f;
#pragma unroll
                for (int j = 0; j < 4; ++j) { const f32x4 sv = *(const LAS f32x4*)(sl + b * 1024 + j * 256 + lane * 4); a += sv[0] * w[4 * j] + sv[1] * w[4 * j + 1] + sv[2] * w[4 * j + 2] + sv[3] * w[4 * j + 3]; }
                a = wave_sum(a);
                if (lane == b) mine = a;
            }
            if (lane < 17) out[(size_t)lane * 5632 + n] = mine;
        }
    }
    __syncthreads();
}

DI void norm_phase(const float* xl, const float* xc, const float* gain, const float* modl, int sh_off, int sc_off, bf16_t* h) {
    const int tid = tid_opq(), wave = tid >> 6, lane = tid & 63;
    for (int row0 = (blockIdx.x * 8 + wave) * 4; row0 < MR; row0 += gridDim.x * 32) {
        const float* src = row0 < TL ? xl + (size_t)row0 * 1024 : xc + (size_t)(row0 - TL) * 1024;
        const float* mb = modl + (size_t)(row0 < TL ? (row0 >> 12) : 16) * 6144;
        f32x4 v[4][4]; float ss[4];
#pragma unroll
        for (int r = 0; r < 4; ++r)
#pragma unroll
            for (int i = 0; i < 4; ++i) v[r][i] = *(const f32x4*)(src + (size_t)r * 1024 + i * 256 + lane * 4);
#pragma unroll
        for (int r = 0; r < 4; ++r) { float t = 0.f;
#pragma unroll
            for (int i = 0; i < 4; ++i) t += v[r][i][0] * v[r][i][0] + v[r][i][1] * v[r][i][1] + v[r][i][2] * v[r][i][2] + v[r][i][3] * v[r][i][3];
            ss[r] = t; }
#pragma unroll
        for (int o = 32; o >= 1; o >>= 1) {
#pragma unroll
            for (int r = 0; r < 4; ++r) ss[r] += __shfl_xor(ss[r], o);
        }
#pragma unroll
        for (int i = 0; i < 4; ++i) {
            const int c = i * 256 + lane * 4;
            const f32x4 g = *(const f32x4*)(gain + c), sc = *(const f32x4*)(mb + sc_off + c), sh = *(const f32x4*)(mb + sh_off + c);
            const f32x4 gs = g * (sc + 1.0f);
#pragma unroll
            for (int r = 0; r < 4; ++r) {
                const float rstd = rsqrtf(ss[r] * (1.0f / 1024.0f) + 1e-6f);
                const f32x4 y = (v[r][i] * rstd) * gs + sh;
                u32x2 w; w.x = cvt_pk_bf16(y[0], y[1]); w.y = cvt_pk_bf16(y[2], y[3]);
                *(u32x2*)(h + (size_t)(row0 + r) * 1024 + c) = w;
            }
        }
    }
}

DI void scan_rowbase(int dir, int b, int c, int& rb, int& sg) {
    if (dir == 0) { sg = 1; rb = c < 4 ? TL + b * CTXL + c * 64 : b * SEQ + (c - 4) * 64; }
    else { sg = -1; rb = c < 4 ? TL + b * CTXL + 255 - c * 64 : b * SEQ + 4095 - (c - 4) * 64; }
}
struct GPStage { unsigned qv[8], kv[8]; f32x4 lrv; float w2r[16][2]; f32x2 gbias; };
DI void gp_load(GPStage& S, int item, const bf16_t* qk, const float* lr, const float* w2, const float* gb, int tid, int wave, int d0) {
    const int c = item % 68, rest = item / 68, h = rest & 3, dir = (rest >> 2) & 1, b = rest >> 3;
    int rowbase, sgn; scan_rowbase(dir, b, c, rowbase, sgn);
#pragma unroll
    for (int i = 0; i < 8; ++i) { const size_t ro = (size_t)(rowbase + sgn * (wave * 8 + i)) * 1024; S.qv[i] = *(const unsigned*)(qk + ro + h * 128 + d0); S.kv[i] = *(const unsigned*)(qk + ro + 512 + h * 128 + d0); }
    S.lrv = (f32x4){0.f, 0.f, 0.f, 0.f};
    if (tid < 256) S.lrv = *(const f32x4*)(lr + (size_t)(rowbase + sgn * (tid >> 2)) * 32 + dir * 16 + (tid & 3) * 4);
#pragma unroll
    for (int r = 0; r < 16; ++r) { const f32x2 t = *(const f32x2*)(w2 + (size_t)(dir * 16 + r) * 512 + h * 128 + d0); S.w2r[r][0] = t.x; S.w2r[r][1] = t.y; }
    S.gbias = *(const f32x2*)(gb + dir * 512 + h * 128 + d0);
}
DI void gp_item(const GPStage& S, int item, bf16_t* GQ, bf16_t* GK, bf16_t* GP, float* GE, LAS unsigned char* lds, int tid, int wave, int lane) {
    constexpr int QD = 0, KI = 17408, LRS = 34816, SEG = 38912;
    const int l15 = lane & 15, lq = lane >> 4, d0 = 2 * lane;
    if (tid < 256) *(LAS f32x4*)(lds + LRS + (tid >> 2) * 64 + (tid & 3) * 16) = S.lrv;
    __syncthreads();
    const LAS float* lrs = (const LAS float*)(lds + LRS);
    float bl0[8], bl1[8]; float cum0 = 0.f, cum1 = 0.f;
#pragma unroll
    for (int i = 0; i < 8; ++i) {
        const int s = wave * 8 + i;
        float z0 = S.gbias.x, z1 = S.gbias.y;
#pragma unroll
        for (int r4 = 0; r4 < 4; ++r4) { const f32x4 lv = *(const LAS f32x4*)(lrs + s * 16 + r4 * 4);
#pragma unroll
            for (int j = 0; j < 4; ++j) { z0 += lv[j] * S.w2r[r4 * 4 + j][0]; z1 += lv[j] * S.w2r[r4 * 4 + j][1]; } }
        const float g0 = (fminf(z0, 0.f) - __logf(1.0f + __expf(-fabsf(z0)))) * 0.0625f;
        const float g1 = (fminf(z1, 0.f) - __logf(1.0f + __expf(-fabsf(z1)))) * 0.0625f;
        cum0 += g0; cum1 += g1; bl0[i] = cum0; bl1[i] = cum1;
    }
    *(LAS f32x2*)(lds + SEG + (wave * 128 + d0) * 4) = (f32x2){cum0, cum1};
    __syncthreads();
    float off0 = 0.f, off1 = 0.f, tot0 = 0.f, tot1 = 0.f;
#pragma unroll
    for (int w = 0; w < 8; ++w) { const f32x2 t = *(const LAS f32x2*)(lds + SEG + (w * 128 + d0) * 4); tot0 += t.x; tot1 += t.y; if (w < wave) { off0 += t.x; off1 += t.y; } }
    const float et0 = __expf(tot0), et1 = __expf(tot1);
    if (wave == 0) *(f32x2*)(GE + (size_t)item * 128 + d0) = (f32x2){et0, et1};
    {
        unsigned ks0[4], ks1[4];
        bf16_t* gq = GQ + (size_t)item * 8192;
#pragma unroll
        for (int i = 0; i < 8; ++i) {
            const int s = wave * 8 + i;
            const float b0 = off0 + bl0[i], b1 = off1 + bl1[i];
            const float q0 = bf_lo(S.qv[i]), q1 = bf_hi(S.qv[i]), k0 = bf_lo(S.kv[i]), k1 = bf_hi(S.kv[i]);
            const float eb0 = __expf(b0), eb1 = __expf(b1), ib0 = __builtin_amdgcn_rcpf(eb0), ib1 = __builtin_amdgcn_rcpf(eb1);
            const unsigned qd = cvt_pk_bf16(q0 * eb0, q1 * eb1);
            *(LAS unsigned*)(lds + QD + s * 272 + d0 * 2) = qd;
            *(unsigned*)(gq + s * 128 + d0) = qd;
            *(LAS unsigned*)(lds + KI + s * 272 + d0 * 2) = cvt_pk_bf16(k0 * ib0, k1 * ib1);
            const float e0 = k0 * (et0 * ib0), e1 = k1 * (et1 * ib1);
            if (i & 1) { ks0[i >> 1] = (ks0[i >> 1] & 0xffffu) | (cvt_pk_bf16(0.f, e0) & 0xffff0000u); ks1[i >> 1] = (ks1[i >> 1] & 0xffffu) | (cvt_pk_bf16(0.f, e1) & 0xffff0000u); }
            else { ks0[i >> 1] = cvt_pk_bf16(e0, 0.f) & 0xffffu; ks1[i >> 1] = cvt_pk_bf16(e1, 0.f) & 0xffffu; }
        }
        bf16_t* gk = GK + (size_t)item * 8192;
        *(u32x4*)(gk + d0 * 64 + wave * 8) = (u32x4){ks0[0], ks0[1], ks0[2], ks0[3]};
        *(u32x4*)(gk + (d0 + 1) * 64 + wave * 8) = (u32x4){ks1[0], ks1[1], ks1[2], ks1[3]};
    }
    __syncthreads();
    {
        bf16_t* gp = GP + (size_t)item * 4096;
        const int t0 = 16 * (wave >> 1);
#pragma unroll
        for (int j = 0; j < 2; ++j) {
            const int s0 = 16 * ((wave & 1) * 2 + j);
            f32x4 a4 = (f32x4){0.f, 0.f, 0.f, 0.f};
#pragma unroll
            for (int kk = 0; kk < 4; ++kk) {
                const bf16x8 af = *(const LAS bf16x8*)(lds + QD + (t0 + l15) * 272 + (kk * 32 + 8 * lq) * 2);
                const bf16x8 bf = *(const LAS bf16x8*)(lds + KI + (s0 + l15) * 272 + (kk * 32 + 8 * lq) * 2);
                a4 = __builtin_amdgcn_mfma_f32_16x16x32_bf16(af, bf, a4, 0, 0, 0);
            }
            const int sc = s0 + l15;
#pragma unroll
            for (int r = 0; r < 4; ++r) { const int t = t0 + 4 * lq + r; gp[t * 64 + sc] = f2bf(sc <= t ? a4[r] : 0.f); }
        }
    }
}
DI void gateprep_phase(const bf16_t* qk, const float* lr, const float* w2, const float* gb, bf16_t* GQ, bf16_t* GK, bf16_t* GP, float* GE, LAS unsigned char* lds) {
    const int tid = tid_opq(), wave = __builtin_amdgcn_readfirstlane(tid >> 6), lane = tid & 63, d0 = 2 * lane;
    const int G = gridDim.x;
    GPStage A, B;
    int item = opq((int)blockIdx.x);
    if (item < NCHI) gp_load(A, item, qk, lr, w2, gb, tid, wave, d0);
    for (; item < NCHI; item += 2 * G) {
        if (item + G < NCHI) gp_load(B, item + G, qk, lr, w2, gb, tid, wave, d0);
        gp_item(A, item, GQ, GK, GP, GE, lds, tid, wave, lane);
        if (item + G < NCHI) {
            if (item + 2 * G < NCHI) gp_load(A, item + 2 * G, qk, lr, w2, gb, tid, wave, d0);
            gp_item(B, item + G, GQ, GK, GP, GE, lds, tid, wave, lane);
        }
    }
    __syncthreads();
}

DI void scan_phase(const bf16_t* vr, const bf16_t* GQ, const bf16_t* GK, const bf16_t* GP, const float* GE, bf16_t* of, bf16_t* ob, LAS unsigned char* lds) {
    constexpr int QD = 0, KST = 17408, VT = 35840, ST = 54272, PP = 89088, BL = 98304;
    const int tid = tid_opq(), wave = __builtin_amdgcn_readfirstlane(tid >> 6), lane = tid & 63;
    const int l31 = lane & 31, lh = lane >> 5;
    for (int item = blockIdx.x; item < 256; item += gridDim.x) {
        const int xcd_ = item & 7, slot_ = item >> 3, dvh = slot_ & 1, pair_ = (slot_ >> 1) * 8 + xcd_;
        const int b = pair_ >> 3, dir = (pair_ >> 2) & 1, h = pair_ & 3;
        bf16_t* obuf = dir ? ob : of;
        const int d0 = 2 * lane;
        const int gi0 = ((b * 2 + dir) * 4 + h) * 68;
        f32x16 Sacc[2];
#pragma unroll
        for (int i = 0; i < 16; ++i) { Sacc[0][i] = 0.f; Sacc[1][i] = 0.f; }
        __syncthreads();
        { unsigned z_ = 0u; asm volatile("" : "+v"(z_));
          for (int o = tid; o < 34816 / 16; o += NTHREADS) *(LAS u32x4*)(lds + ST + o * 16) = (u32x4){z_, z_, z_, z_}; }
        const int vcol = h * 256 + dvh * 128 + d0;
        struct ScStage { u32x4 gq0, gq1, gk0, gk1, gp0; unsigned vv[8]; float ebv; } A, B;
        A.ebv = 0.f; B.ebv = 0.f;
#define SCAN_LOAD(S, c) do { int rb_, sg_; scan_rowbase(dir, b, (c), rb_, sg_); const size_t gi_ = (size_t)(gi0 + (c)); \
        S.gq0 = *(const u32x4*)(GQ + gi_ * 8192 + tid * 8); S.gq1 = *(const u32x4*)(GQ + gi_ * 8192 + 4096 + tid * 8); \
        S.gk0 = *(const u32x4*)(GK + gi_ * 8192 + tid * 8); S.gk1 = *(const u32x4*)(GK + gi_ * 8192 + 4096 + tid * 8); \
        S.gp0 = *(const u32x4*)(GP + gi_ * 4096 + tid * 8); if (tid < 128) S.ebv = GE[gi_ * 128 + tid]; \
        _Pragma("unroll") for (int i = 0; i < 8; ++i) S.vv[i] = *(const unsigned*)(vr + (size_t)(rb_ + sg_ * (wave * 8 + i)) * 2048 + vcol); } while (0)
#define SCAN_CHUNK(S, c) do { \
            int rowbase, sgn; scan_rowbase(dir, b, (c), rowbase, sgn); \
            { const int e0 = tid * 8, e1 = 4096 + tid * 8; \
              *(LAS u32x4*)(lds + QD + (e0 >> 7) * 272 + (e0 & 127) * 2) = S.gq0; *(LAS u32x4*)(lds + QD + (e1 >> 7) * 272 + (e1 & 127) * 2) = S.gq1; \
              *(LAS u32x4*)(lds + KST + (e0 >> 6) * 144 + (e0 & 63) * 2) = S.gk0; *(LAS u32x4*)(lds + KST + (e1 >> 6) * 144 + (e1 & 63) * 2) = S.gk1; \
              *(LAS u32x4*)(lds + PP + (e0 >> 6) * 144 + (e0 & 63) * 2) = S.gp0; \
              if (tid < 128) *(LAS float*)(lds + BL + tid * 4) = S.ebv; \
              unsigned vt0[4], vt1[4]; \
              _Pragma("unroll") for (int i = 0; i < 8; ++i) { \
                  if (i & 1) { vt0[i >> 1] = (vt0[i >> 1] & 0xffffu) | (S.vv[i] << 16); vt1[i >> 1] = (vt1[i >> 1] & 0xffffu) | (S.vv[i] & 0xffff0000u); } \
                  else { vt0[i >> 1] = S.vv[i] & 0xffffu; vt1[i >> 1] = S.vv[i] >> 16; } } \
              *(LAS u32x4*)(lds + VT + d0 * 144 + wave * 16) = (u32x4){vt0[0], vt0[1], vt0[2], vt0[3]}; \
              *(LAS u32x4*)(lds + VT + (d0 + 1) * 144 + wave * 16) = (u32x4){vt1[0], vt1[1], vt1[2], vt1[3]}; \
            } \
            __syncthreads();     \
            if ((c) + 2 < 68) SCAN_LOAD(S, (c) + 2); \
            { \
                const int tq = wave >> 2, vq = wave & 3; \
                f32x16 oacc; \
                _Pragma("unroll") for (int i = 0; i < 16; ++i) oacc[i] = 0.f; \
                _Pragma("unroll") for (int kk = 0; kk < 8; ++kk) { \
                    const bf16x8 af = *(const LAS bf16x8*)(lds + QD + (32 * tq + l31) * 272 + (kk * 16 + 8 * lh) * 2); \
                    const bf16x8 bf = *(const LAS bf16x8*)(lds + ST + (32 * vq + l31) * 272 + (kk * 16 + 8 * lh) * 2); \
                    oacc = __builtin_amdgcn_mfma_f32_32x32x16_bf16(af, bf, oacc, 0, 0, 0); } \
                _Pragma("unroll") for (int kk = 0; kk < 4; ++kk) { \
                    const bf16x8 af = *(const LAS bf16x8*)(lds + PP + (32 * tq + l31) * 144 + (kk * 16 + 8 * lh) * 2); \
                    const bf16x8 bf = *(const LAS bf16x8*)(lds + VT + (32 * vq + l31) * 144 + (kk * 16 + 8 * lh) * 2); \
                    oacc = __builtin_amdgcn_mfma_f32_32x32x16_bf16(af, bf, oacc, 0, 0, 0); } \
                const int ocol = h * 256 + dvh * 128 + 32 * vq + l31; \
                _Pragma("unroll") for (int r = 0; r < 16; ++r) { const int t = 32 * tq + crow(r, lh); obuf[(size_t)(rowbase + sgn * t) * 1024 + ocol] = f2bf(oacc[r]); } \
            } \
            { \
                const int vq = wave & 3; \
                _Pragma("unroll") for (int j = 0; j < 2; ++j) { \
                    const int dq = 2 * (wave >> 2) + j; \
                    _Pragma("unroll") for (int r = 0; r < 16; ++r) Sacc[j][r] *= *(const LAS float*)(lds + BL + (32 * dq + crow(r, lh)) * 4); \
                    _Pragma("unroll") for (int kk = 0; kk < 4; ++kk) { \
                        const bf16x8 af = *(const LAS bf16x8*)(lds + KST + (32 * dq + l31) * 144 + (kk * 16 + 8 * lh) * 2); \
                        const bf16x8 bf = *(const LAS bf16x8*)(lds + VT + (32 * vq + l31) * 144 + (kk * 16 + 8 * lh) * 2); \
                        Sacc[j] = __builtin_amdgcn_mfma_f32_32x32x16_bf16(af, bf, Sacc[j], 0, 0, 0); } } \
            } \
            __syncthreads();     \
            { \
                const int vq = wave & 3; \
                _Pragma("unroll") for (int j = 0; j < 2; ++j) { \
                    const int dq = 2 * (wave >> 2) + j; \
                    _Pragma("unroll") for (int g = 0; g < 4; ++g) { \
                        u32x2 w; w.x = cvt_pk_bf16(Sacc[j][4 * g], Sacc[j][4 * g + 1]); w.y = cvt_pk_bf16(Sacc[j][4 * g + 2], Sacc[j][4 * g + 3]); \
                        *(LAS u32x2*)(lds + ST + (32 * vq + l31) * 272 + (32 * dq + 8 * g + 4 * lh) * 2) = w; } } \
            } } while (0)
        SCAN_LOAD(A, 0); SCAN_LOAD(B, 1);
        for (int c = 0; c < 68; c += 2) { SCAN_CHUNK(A, c); SCAN_CHUNK(B, c + 1); }
#undef SCAN_CHUNK
#undef SCAN_LOAD
    }
    __syncthreads();
}

DI void glapost_phase(const bf16_t* of, const bf16_t* ob, const bf16_t* vr, const float* onorm, bf16_t* a) {
    const int tid = tid_opq(), wave = tid >> 6, lane = tid & 63;
    const int c0 = lane * 16;
    float gn[16];
#pragma unroll
    for (int j = 0; j < 4; ++j) { const f32x4 t = *(const f32x4*)(onorm + (c0 & 255) + 4 * j); gn[4 * j] = t[0]; gn[4 * j + 1] = t[1]; gn[4 * j + 2] = t[2]; gn[4 * j + 3] = t[3]; }
    for (int row0 = (blockIdx.x * 8 + wave) * 4; row0 < MR; row0 += gridDim.x * 32) {
        u32x4 f0[4], f1[4], b0[4], b1[4], r0[4], r1[4];
#pragma unroll
        for (int q = 0; q < 4; ++q) { const size_t ro = (size_t)(row0 + q);
            f0[q] = *(const u32x4*)(of + ro * 1024 + c0); f1[q] = *(const u32x4*)(of + ro * 1024 + c0 + 8);
            b0[q] = *(const u32x4*)(ob + ro * 1024 + c0); b1[q] = *(const u32x4*)(ob + ro * 1024 + c0 + 8);
            r0[q] = *(const u32x4*)(vr + ro * 2048 + 1024 + c0); r1[q] = *(const u32x4*)(vr + ro * 2048 + 1024 + c0 + 8); }
        asm volatile("" ::: "memory");
#pragma unroll
        for (int q = 0; q < 4; ++q) {
            float o[16], rr[16];
#pragma unroll
            for (int j = 0; j < 4; ++j) {
                o[2 * j] = bf_lo(f0[q][j]) + bf_lo(b0[q][j]); o[2 * j + 1] = bf_hi(f0[q][j]) + bf_hi(b0[q][j]);
                o[8 + 2 * j] = bf_lo(f1[q][j]) + bf_lo(b1[q][j]); o[8 + 2 * j + 1] = bf_hi(f1[q][j]) + bf_hi(b1[q][j]);
                rr[2 * j] = bf_lo(r0[q][j]); rr[2 * j + 1] = bf_hi(r0[q][j]); rr[8 + 2 * j] = bf_lo(r1[q][j]); rr[8 + 2 * j + 1] = bf_hi(r1[q][j]);
            }
            float ss = 0.f;
#pragma unroll
            for (int j = 0; j < 16; ++j) ss += o[j] * o[j];
            ss += __shfl_xor(ss, 1); ss += __shfl_xor(ss, 2); ss += __shfl_xor(ss, 4); ss += __shfl_xor(ss, 8);
            const float rstd = rsqrtf(ss * (1.0f / 256.0f) + 1e-6f);
            unsigned w[8];
#pragma unroll
            for (int j = 0; j < 8; ++j) {
                const float y0 = o[2 * j] * rstd * gn[2 * j] * silu_f(rr[2 * j]), y1 = o[2 * j + 1] * rstd * gn[2 * j + 1] * silu_f(rr[2 * j + 1]);
                w[j] = cvt_pk_bf16(y0, y1);
            }
            *(u32x4*)(a + (size_t)(row0 + q) * 1024 + c0) = (u32x4){w[0], w[1], w[2], w[3]};
            *(u32x4*)(a + (size_t)(row0 + q) * 1024 + c0 + 8) = (u32x4){w[4], w[5], w[6], w[7]};
        }
    }
}

DI void rope_cs(int tpos, int lane, float& cs, float& sn) {
    const int f = lane & 15; const int pos = (lane >> 5) ? (tpos & 63) : (tpos >> 6);
    const float inv = exp2f(-(float)f * (13.287712379549449f / 16.0f));
    const float ang = (float)pos * inv;
    const float kf = rintf(ang * 0.15915494309189535f);
    float r = fmaf(-kf, 6.2831854820251465f, ang); r = fmaf(-kf, -1.7484556000744883e-7f, r);
    cs = __cosf(r); sn = __sinf(r);
}
DI float rope_apply(float y, int lane, float cs, float sn) {
    const float pr = __shfl_xor(y, 16);
    return (lane & 16) ? (pr * sn + y * cs) : (y * cs - pr * sn);
}
DI int key_of_row(int row) {
    if (row < TL) { const int b = row >> 12; return b * KEYS + CTXL + (row & 4095); }
    const int rc = row - TL; const int b = rc >> 8; return b * KEYS + (rc & 255);
}

DI void mlamid_phase(const bf16_t* dn, const float* qln, const float* kvln, const float* knorm, bf16_t* cqn, bf16_t* ckvn, bf16_t* KB) {
    const int tid = tid_opq(), wave = tid >> 6, lane = tid & 63;
    float gq[6];
#pragma unroll
    for (int i = 0; i < 3; ++i) { gq[2 * i] = qln[i * 128 + 2 * lane]; gq[2 * i + 1] = qln[i * 128 + 2 * lane + 1]; }
    const f32x4 gkv = *(const f32x4*)(kvln + 4 * lane);
    const float gpe = knorm[128 + lane];
    for (int row0 = (blockIdx.x * 8 + wave) * 4; row0 < MR; row0 += gridDim.x * 32) {
        unsigned q[4][3]; u32x2 kvv[4]; bf16_t pe[4];
#pragma unroll
        for (int r = 0; r < 4; ++r) { const bf16_t* src = dn + (size_t)(row0 + r) * 768;
#pragma unroll
            for (int i = 0; i < 3; ++i) q[r][i] = *(const unsigned*)(src + i * 128 + 2 * lane);
            kvv[r] = *(const u32x2*)(src + 384 + 4 * lane); pe[r] = src[640 + lane]; }
#pragma unroll
        for (int r = 0; r < 4; ++r) {
            const int row = row0 + r;
            float ss = 0.f;
#pragma unroll
            for (int i = 0; i < 3; ++i) { const float a = bf_lo(q[r][i]), b = bf_hi(q[r][i]); ss += a * a + b * b; }
            ss = wave_sum(ss);
            float rstd = rsqrtf(ss * (1.0f / 384.0f) + 1e-6f);
#pragma unroll
            for (int i = 0; i < 3; ++i) *(unsigned*)(cqn + (size_t)row * 384 + i * 128 + 2 * lane) = cvt_pk_bf16(bf_lo(q[r][i]) * rstd * gq[2 * i], bf_hi(q[r][i]) * rstd * gq[2 * i + 1]);
            const float k0 = bf_lo(kvv[r].x), k1 = bf_hi(kvv[r].x), k2 = bf_lo(kvv[r].y), k3 = bf_hi(kvv[r].y);
            ss = wave_sum(k0 * k0 + k1 * k1 + k2 * k2 + k3 * k3);
            rstd = rsqrtf(ss * (1.0f / 256.0f) + 1e-6f);
            { u32x2 w; w.x = cvt_pk_bf16(k0 * rstd * gkv[0], k1 * rstd * gkv[1]); w.y = cvt_pk_bf16(k2 * rstd * gkv[2], k3 * rstd * gkv[3]);
              *(u32x2*)(ckvn + (size_t)row * 256 + 4 * lane) = w; }
            const float x = __uint_as_float(((unsigned)pe[r]) << 16);
            ss = wave_sum(x * x);
            rstd = rsqrtf(ss * (1.0f / 64.0f) + 1e-6f);
            float y = x * rstd * gpe;
            if (row < TL) { float cs, sn; rope_cs(row & 4095, lane, cs, sn); y = rope_apply(y, lane, cs, sn); }
            const bf16_t yb = f2bf(y);
            bf16_t* kd = KB + (size_t)key_of_row(row) * 1536 + 128 + lane;
#pragma unroll
            for (int hh = 0; hh < 8; ++hh) kd[hh * 192] = yb;
        }
    }
}

DI void qkprep_phase(bf16_t* KB, const float* knorm) {
    const int tid = tid_opq(), wave = tid >> 6, lane = tid & 63;
    const float kn0 = knorm[2 * lane], kn1 = knorm[2 * lane + 1];
    for (int row0 = (blockIdx.x * 8 + wave) * 2; row0 < MR; row0 += gridDim.x * 16) {
        unsigned ka[2][8];
        bf16_t* kr0 = KB + (size_t)key_of_row(row0) * 1536; bf16_t* kr1 = KB + (size_t)key_of_row(row0 + 1) * 1536;
#pragma unroll
        for (int hh = 0; hh < 8; ++hh) { ka[0][hh] = *(const unsigned*)(kr0 + hh * 192 + 2 * lane); ka[1][hh] = *(const unsigned*)(kr1 + hh * 192 + 2 * lane); }
        asm volatile("" ::: "memory");
#pragma unroll
        for (int r = 0; r < 2; ++r) {
            bf16_t* kr = r ? kr1 : kr0;
#pragma unroll
            for (int hh = 0; hh < 8; ++hh) {
                const float c0 = bf_lo(ka[r][hh]), c1 = bf_hi(ka[r][hh]);
                const float s3 = wave_sum(c0 * c0 + c1 * c1);
                const float r3 = rsqrtf(s3 * (1.0f / 128.0f) + 1e-6f);
                *(unsigned*)(kr + hh * 192 + 2 * lane) = cvt_pk_bf16(c0 * r3 * kn0, c1 * r3 * kn1);
            }
        }
    }
}

namespace att {
constexpr int DQK = 192, DV = 128, NW = 8, QBLK = 32, KVBLK = 64;
constexpr int LDQ = 1536, LDK = 1536, LDV = 1024, LDO = 1024;
constexpr float SCALE = 0.07216878364870322f;
constexpr float THR = 8.f;
constexpr size_t SHM_V = KVBLK * DV * 2, SHM_K = KVBLK * DQK * 2;
#define KSWZ(row, colB) ((row) * 384 + ((colB) ^ ((((row) >> 1) & 7) << 4)))
#define SBAR() __builtin_amdgcn_sched_barrier(0)
DI unsigned cvtpk(float lo, float hi) { unsigned r; asm volatile("v_cvt_pk_bf16_f32 %0, %1, %2" : "=v"(r) : "v"(lo), "v"(hi)); return r; }
DI void partialSM(f32x16& p0, f32x16& p1, float& m_reg, float& mn, float& alpha) {
    constexpr float C = SCALE * 1.4426950408889634f;
    float pmax = p0[0];
#pragma unroll
    for (int r = 1; r < 16; ++r) pmax = fmaxf(pmax, p0[r]);
#pragma unroll
    for (int r = 0; r < 16; ++r) pmax = fmaxf(pmax, p1[r]);
    { auto rr = __builtin_amdgcn_permlane32_swap(__float_as_uint(pmax), __float_as_uint(pmax), false, false);
      pmax = fmaxf(__uint_as_float(rr[0]), __uint_as_float(rr[1])); }
    if (__builtin_expect(__all(pmax - m_reg <= THR / SCALE), 1)) { mn = m_reg; alpha = 1.f; }
    else { mn = fmaxf(m_reg, pmax); alpha = __builtin_amdgcn_exp2f((m_reg - mn) * C); m_reg = mn; }
    const float mnC = -mn * C;
#pragma unroll
    for (int r = 0; r < 16; ++r) p0[r] = fmaf(p0[r], C, mnC);
#pragma unroll
    for (int r = 0; r < 16; ++r) p1[r] = fmaf(p1[r], C, mnC);
#pragma unroll
    for (int r = 0; r < 16; ++r) p0[r] = __builtin_amdgcn_exp2f(p0[r]);
}
DI void finishSM(f32x16& p0, f32x16& p1, float alpha, float& l_reg, bf16x8& pa0, bf16x8& pa1, bf16x8& pa2, bf16x8& pa3) {
#pragma unroll
    for (int r = 0; r < 16; ++r) p1[r] = __builtin_amdgcn_exp2f(p1[r]);
    float ps = 0;
#pragma unroll
    for (int r = 0; r < 16; ++r) ps += p0[r];
#pragma unroll
    for (int r = 0; r < 16; ++r) ps += p1[r];
    { auto rr = __builtin_amdgcn_permlane32_swap(__float_as_uint(ps), __float_as_uint(ps), false, false);
      ps = __uint_as_float(rr[0]) + __uint_as_float(rr[1]); }
    l_reg = l_reg * alpha + ps;
#define PK4(P, BASE, OUT) do { unsigned a0 = cvtpk(P[BASE + 0], P[BASE + 1]), a1 = cvtpk(P[BASE + 2], P[BASE + 3]);   \
    unsigned b0 = cvtpk(P[BASE + 4], P[BASE + 5]), b1 = cvtpk(P[BASE + 6], P[BASE + 7]);                              \
    auto r0 = __builtin_amdgcn_permlane32_swap(a0, b0, false, false); auto r1 = __builtin_amdgcn_permlane32_swap(a1, b1, false, false); \
    u32x4 w = {r0[0], r1[0], r0[1], r1[1]}; OUT = *reinterpret_cast<bf16x8*>(&w); } while (0)
    PK4(p0, 0, pa0); PK4(p0, 8, pa1); PK4(p1, 0, pa2); PK4(p1, 8, pa3);
#undef PK4
}
DI void qkt(f32x16& p0, f32x16& p1, const char* Ks, const bf16x8* qr, int r32, int hi) {
#pragma unroll
    for (int r = 0; r < 16; ++r) { p0[r] = 0.f; p1[r] = 0.f; }
    bf16x8 ka[3], kb[3];
#define QK_RD(D0, SLOT) do { const int cb_ = ((D0) * 16 + hi * 8) * 2; ka[SLOT] = *reinterpret_cast<const bf16x8*>(Ks + KSWZ(r32, cb_)); kb[SLOT] = *reinterpret_cast<const bf16x8*>(Ks + KSWZ(32 + r32, cb_)); } while (0)
    QK_RD(0, 0); QK_RD(1, 1);
    __builtin_amdgcn_sched_barrier(0);
#pragma unroll
    for (int d0 = 0; d0 < 12; ++d0) {
        if (d0 + 2 < 12) QK_RD(d0 + 2, (d0 + 2) % 3);
        p0 = __builtin_amdgcn_mfma_f32_32x32x16_bf16(ka[d0 % 3], qr[d0], p0, 0, 0, 0);
        p1 = __builtin_amdgcn_mfma_f32_32x32x16_bf16(kb[d0 % 3], qr[d0], p1, 0, 0, 0);
        __builtin_amdgcn_sched_barrier(0);
    }
#undef QK_RD
}
DI int v_st(int k, int c) { const int kk = (k & ~0xC) | ((k & 4) << 1) | ((k & 8) >> 1); return ((kk >> 3) * 4 + (c >> 5)) * 512 + ((kk & 7) * 32 + (c & 31)) * 2; }
DI int v_rd_base(int lane) { return ((lane & 3) << 3) | (((lane >> 2) & 3) << 6) | (((lane >> 4) & 1) << 5) | (((lane >> 5) & 1) << 8); }
constexpr int v_rd_off(int d0, int ks, int half) { return d0 * 512 + ks * 4096 + half * 2048; }
template <int OFF> DI s16x4 tr_read(int vb) { s16x4 r; asm volatile("ds_read_b64_tr_b16 %0, %1 offset:%2" : "=&v"(r) : "v"(vb), "i"(OFF) : "memory"); return r; }
template <int D0> DI void pv_one(f32x16& od, int vb, bf16x8 pa0, bf16x8 pa1, bf16x8 pa2, bf16x8 pa3) {
    const s16x4 l0 = tr_read<v_rd_off(D0, 0, 0)>(vb), h0 = tr_read<v_rd_off(D0, 0, 1)>(vb), l1 = tr_read<v_rd_off(D0, 1, 0)>(vb), h1 = tr_read<v_rd_off(D0, 1, 1)>(vb);
    const s16x4 l2 = tr_read<v_rd_off(D0, 2, 0)>(vb), h2 = tr_read<v_rd_off(D0, 2, 1)>(vb), l3 = tr_read<v_rd_off(D0, 3, 0)>(vb), h3 = tr_read<v_rd_off(D0, 3, 1)>(vb);
    asm volatile("s_waitcnt lgkmcnt(0)" ::: "memory"); SBAR();
#define PK(L, H) (bf16x8){L[0], L[1], L[2], L[3], H[0], H[1], H[2], H[3]}
    od = __builtin_amdgcn_mfma_f32_32x32x16_bf16(pa0, PK(l0, h0), od, 0, 0, 0);
    od = __builtin_amdgcn_mfma_f32_32x32x16_bf16(pa1, PK(l1, h1), od, 0, 0, 0);
    od = __builtin_amdgcn_mfma_f32_32x32x16_bf16(pa2, PK(l2, h2), od, 0, 0, 0);
    od = __builtin_amdgcn_mfma_f32_32x32x16_bf16(pa3, PK(l3, h3), od, 0, 0, 0);
#undef PK
}
DI void pv_d0(f32x16* o, int vb, bf16x8 pa0, bf16x8 pa1, bf16x8 pa2, bf16x8 pa3) {
    pv_one<0>(o[0], vb, pa0, pa1, pa2, pa3); pv_one<1>(o[1], vb, pa0, pa1, pa2, pa3); pv_one<2>(o[2], vb, pa0, pa1, pa2, pa3); pv_one<3>(o[3], vb, pa0, pa1, pa2, pa3);
}
DI void attn_body(const bf16_t* __restrict__ Qb, const bf16_t* __restrict__ Kh, const bf16_t* __restrict__ Vh, bf16_t* __restrict__ Ob, int seq, char* lds, const float* __restrict__ qnorm, int tpos0) {
    const int tid = tid_opq(), wid = tid >> 6, lane = tid & 63, r32 = lane & 31, hi = lane >> 5;
    char* V_lds = lds; char* K_lds = lds + 2 * SHM_V;
    float* wsf = (float*)(lds + 2 * SHM_V + 2 * SHM_K) + wid * 64; float* li_l = wsf; float* al_l = wsf + 32;
    float m_reg = -1e30f, l_reg = 0; f32x16 o[4]; bf16x8 qr[12];
#pragma unroll
    for (int d = 0; d < 4; ++d)
#pragma unroll
        for (int r = 0; r < 16; ++r) o[d][r] = 0.f;
    const bf16_t* Qw = Qb + (long)(wid * QBLK + r32) * LDQ + hi * 8;
#pragma unroll
    for (int d0 = 0; d0 < 12; ++d0) qr[d0] = *reinterpret_cast<const bf16x8*>(Qw + d0 * 16);
    {
        float ssn = 0.f, ssr = 0.f;
#pragma unroll
        for (int d0 = 0; d0 < 12; ++d0) {
            const u32x4 w = *reinterpret_cast<const u32x4*>(&qr[d0]); float t = 0.f;
#pragma unroll
            for (int j = 0; j < 4; ++j) { const float a = bf_lo(w[j]), b = bf_hi(w[j]); t += a * a + b * b; }
            if (d0 < 8) ssn += t; else ssr += t;
        }
        ssn += __shfl_xor(ssn, 32); ssr += __shfl_xor(ssr, 32);
        const float rn = rsqrtf(ssn * (1.0f / 128.0f) + 1e-6f), rr = rsqrtf(ssr * (1.0f / 64.0f) + 1e-6f);
        float cs[2][8], sn[2][8];
        if (tpos0 >= 0) {
            const int t = tpos0 + wid * QBLK + r32;
#pragma unroll
            for (int a = 0; a < 2; ++a) { const float pos = (float)(a ? (t & 63) : (t >> 6));
#pragma unroll
                for (int j = 0; j < 8; ++j) { const float inv = exp2f(-(float)(hi * 8 + j) * (13.287712379549449f / 16.0f)); const float ang = pos * inv;
                    const float kf = rintf(ang * 0.15915494309189535f); float r = fmaf(-kf, 6.2831854820251465f, ang); r = fmaf(-kf, -1.7484556000744883e-7f, r);
                    cs[a][j] = __cosf(r); sn[a][j] = __sinf(r); } }
        } else {
#pragma unroll
            for (int a = 0; a < 2; ++a)
#pragma unroll
                for (int j = 0; j < 8; ++j) { cs[a][j] = 1.f; sn[a][j] = 0.f; }
        }
#pragma unroll
        for (int d0 = 0; d0 < 8; ++d0) {
            const u32x4 w = *reinterpret_cast<const u32x4*>(&qr[d0]); const float* gp = qnorm + d0 * 16 + hi * 8; const f32x4 g0 = *(const f32x4*)gp, g1 = *(const f32x4*)(gp + 4);
            u32x4 o4; o4.x = cvt_pk_bf16(bf_lo(w.x) * rn * g0[0], bf_hi(w.x) * rn * g0[1]); o4.y = cvt_pk_bf16(bf_lo(w.y) * rn * g0[2], bf_hi(w.y) * rn * g0[3]);
            o4.z = cvt_pk_bf16(bf_lo(w.z) * rn * g1[0], bf_hi(w.z) * rn * g1[1]); o4.w = cvt_pk_bf16(bf_lo(w.w) * rn * g1[2], bf_hi(w.w) * rn * g1[3]);
            qr[d0] = *reinterpret_cast<const bf16x8*>(&o4);
        }
#pragma unroll
        for (int a = 0; a < 2; ++a) {
            const u32x4 w1 = *reinterpret_cast<const u32x4*>(&qr[8 + 2 * a]), w2 = *reinterpret_cast<const u32x4*>(&qr[9 + 2 * a]);
            const float* g1p = qnorm + (8 + 2 * a) * 16 + hi * 8; const float* g2p = g1p + 16;
            float x1[8], x2[8], y1[8], y2[8];
#pragma unroll
            for (int j = 0; j < 4; ++j) { x1[2 * j] = bf_lo(w1[j]) * rr * g1p[2 * j]; x1[2 * j + 1] = bf_hi(w1[j]) * rr * g1p[2 * j + 1]; x2[2 * j] = bf_lo(w2[j]) * rr * g2p[2 * j]; x2[2 * j + 1] = bf_hi(w2[j]) * rr * g2p[2 * j + 1]; }
#pragma unroll
            for (int j = 0; j < 8; ++j) { y1[j] = x1[j] * cs[a][j] - x2[j] * sn[a][j]; y2[j] = x1[j] * sn[a][j] + x2[j] * cs[a][j]; }
            u32x4 o1, o2;
            o1.x = cvt_pk_bf16(y1[0], y1[1]); o1.y = cvt_pk_bf16(y1[2], y1[3]); o1.z = cvt_pk_bf16(y1[4], y1[5]); o1.w = cvt_pk_bf16(y1[6], y1[7]);
            o2.x = cvt_pk_bf16(y2[0], y2[1]); o2.y = cvt_pk_bf16(y2[2], y2[3]); o2.z = cvt_pk_bf16(y2[4], y2[5]); o2.w = cvt_pk_bf16(y2[6], y2[7]);
            qr[8 + 2 * a] = *reinterpret_cast<const bf16x8*>(&o1); qr[9 + 2 * a] = *reinterpret_cast<const bf16x8*>(&o2);
        }
    }
    const int sr = tid >> 4, sc = (tid & 15) * 8, vst0 = v_st(sr, sc), vst1 = v_st(32 + sr, sc);
    const int pr = tid >> 3, pc = 128 + (tid & 7) * 8;
    const int vb0 = (int)(uintptr_t)V_lds + v_rd_base(lane);
    bf16x8 vs0, vs1, ks0, ks1, kp;
#define SLOAD(k0) do { vs0 = *reinterpret_cast<const bf16x8*>(&Vh[(long)((k0) + sr) * LDV + sc]); vs1 = *reinterpret_cast<const bf16x8*>(&Vh[(long)((k0) + 32 + sr) * LDV + sc]); \
    ks0 = *reinterpret_cast<const bf16x8*>(&Kh[(long)((k0) + sr) * LDK + sc]); ks1 = *reinterpret_cast<const bf16x8*>(&Kh[(long)((k0) + 32 + sr) * LDK + sc]); \
    kp = *reinterpret_cast<const bf16x8*>(&Kh[(long)((k0) + pr) * LDK + pc]); } while (0)
#define SWRITE(b) do { *(bf16x8*)(V_lds + (b) * SHM_V + vst0) = vs0; *(bf16x8*)(V_lds + (b) * SHM_V + vst1) = vs1; \
    *(bf16x8*)(K_lds + (b) * SHM_K + KSWZ(sr, sc * 2)) = ks0; *(bf16x8*)(K_lds + (b) * SHM_K + KSWZ(32 + sr, sc * 2)) = ks1; \
    *(bf16x8*)(K_lds + (b) * SHM_K + KSWZ(pr, pc * 2)) = kp; } while (0)
#define RESC(a) do { if (__any((a) < 1.f)) { if (hi == 0) al_l[r32] = (a); asm volatile("s_waitcnt lgkmcnt(0)" ::: "memory"); \
    _Pragma("unroll") for (int d = 0; d < 4; ++d) _Pragma("unroll") for (int r = 0; r < 16; ++r) o[d][r] *= al_l[crow(r, hi)]; } } while (0)
    f32x16 p0, p1; float mn, al; bf16x8 pa0, pa1, pa2, pa3; const int NT = seq / KVBLK;
    SLOAD(0); asm volatile("s_waitcnt vmcnt(0)" ::: "memory"); SWRITE(0); __syncthreads();
    for (int j = 0; j < NT; ++j) {
        const int cb = j & 1;
        if (j + 1 < NT) SLOAD((j + 1) * KVBLK);
        SBAR(); qkt(p0, p1, K_lds + cb * SHM_K, qr, r32, hi);
        partialSM(p0, p1, m_reg, mn, al);
        finishSM(p0, p1, al, l_reg, pa0, pa1, pa2, pa3);
        RESC(al); SBAR();
        pv_d0(o, vb0 + cb * (int)SHM_V, pa0, pa1, pa2, pa3);
        if (j + 1 < NT) { asm volatile("s_waitcnt vmcnt(0)" ::: "memory"); SWRITE(cb ^ 1); }
        __syncthreads();
    }
    if (hi == 0) li_l[r32] = l_reg; asm volatile("s_waitcnt lgkmcnt(0)" ::: "memory");
    float rli[16];
#pragma unroll
    for (int r = 0; r < 16; ++r) rli[r] = __builtin_amdgcn_rcpf(li_l[crow(r, hi)]);
    bf16_t* Ow = Ob + (long)(wid * QBLK) * LDO;
#pragma unroll
    for (int r = 0; r < 16; ++r) { const int orow = crow(r, hi);
#pragma unroll
        for (int d0 = 0; d0 < 4; ++d0) Ow[(long)orow * LDO + d0 * 32 + r32] = f2bf(o[d0][r] * rli[r]); }
#undef SLOAD
#undef SWRITE
#undef RESC
}
#undef KSWZ
#undef SBAR
}

DI void attn_phase(const bf16_t* Q, const bf16_t* KB, const bf16_t* VB, bf16_t* O, char* lds, int nitems, const float* qnorm) {
    for (int it = blockIdx.x; it < nitems; it += gridDim.x) {
        int b, h, qrow0, seq, tpos0;
        if (it < 2048) {
            const int rnd = it >> 8, blk = it & 255, xcd_ = blk & 7, slot_ = blk >> 3, idx = rnd * 16 + xcd_ * 2 + (slot_ >> 4);
            b = idx >> 3; h = idx & 7; tpos0 = (slot_ & 15) * 256; qrow0 = b * SEQ + tpos0; seq = KEYS; }
        else { const int j = it - 2048; b = j >> 3; h = j & 7; qrow0 = TL + b * CTXL; seq = CTXL; tpos0 = -1; }
        att::attn_body(Q + (size_t)qrow0 * 1536 + h * 192, KB + (size_t)b * KEYS * 1536 + h * 192, VB + (size_t)b * KEYS * 1024 + h * 128,
                       O + (size_t)qrow0 * 1024 + h * 128, seq, lds, qnorm, tpos0);
        __syncthreads();
    }
}

DI void fixup_phase(const float* halo, const float* cw, const float* cb, bf16_t* act) {
    const int gtid = blockIdx.x * NTHREADS + tid_opq(), gstride = gridDim.x * NTHREADS;
    for (int idx = gtid; idx < 272 * 22 * 64; idx += gstride) {
        const int c4 = (idx & 31) * 4, which = (idx >> 5) & 1, t = idx >> 6, pn = t % 22, pm = t / 22;
        const float* hp = halo + (size_t)(pm * 22 + pn) * 4 * 256;
        const bool sfirst = pm >= 256 || (pm & 15) == 0, slast = pm >= 256 || (pm & 15) == 15;
        const f32x4 z4 = (f32x4){0.f, 0.f, 0.f, 0.f};
        f32x4 pa, pg, ca, cg_, na, ng; int row;
        if (which == 0) { row = pm * 256;
            if (sfirst) { pa = z4; pg = z4; } else { const float* q = halo + (size_t)((pm - 1) * 22 + pn) * 4 * 256 + 3 * 256; pa = *(const f32x4*)(q + c4); pg = *(const f32x4*)(q + 128 + c4); }
            ca = *(const f32x4*)(hp + c4); cg_ = *(const f32x4*)(hp + 128 + c4); na = *(const f32x4*)(hp + 256 + c4); ng = *(const f32x4*)(hp + 256 + 128 + c4);
        } else { row = pm * 256 + 255;
            pa = *(const f32x4*)(hp + 2 * 256 + c4); pg = *(const f32x4*)(hp + 2 * 256 + 128 + c4); ca = *(const f32x4*)(hp + 3 * 256 + c4); cg_ = *(const f32x4*)(hp + 3 * 256 + 128 + c4);
            if (slast) { na = z4; ng = z4; } else { const float* q = halo + (size_t)((pm + 1) * 22 + pn) * 4 * 256; na = *(const f32x4*)(q + c4); ng = *(const f32x4*)(q + 128 + c4); }
        }
        const int ch = pn * 128 + c4;
        const f32x4 w0a = *(const f32x4*)(cw + ch), w1a = *(const f32x4*)(cw + 5632 + ch), w2a = *(const f32x4*)(cw + 2 * 5632 + ch), ba = *(const f32x4*)(cb + ch);
        const f32x4 w0g = *(const f32x4*)(cw + 2816 + ch), w1g = *(const f32x4*)(cw + 5632 + 2816 + ch), w2g = *(const f32x4*)(cw + 2 * 5632 + 2816 + ch), bg = *(const f32x4*)(cb + 2816 + ch);
        const f32x4 av = w0a * pa + w1a * ca + w2a * na + ba, gv = w0g * pg + w1g * cg_ + w2g * ng + bg;
        u32x2 w; w.x = cvt_pk_bf16(silu_f(gv[0]) * av[0], silu_f(gv[1]) * av[1]); w.y = cvt_pk_bf16(silu_f(gv[2]) * av[2], silu_f(gv[3]) * av[3]);
        *(u32x2*)(act + (size_t)row * 2816 + ch) = w;
    }
}


#define XB_TMO      128
#define XB_XCNT(j)  (256  + 64 * (j))
#define XB_XSUB(j)  (1280 + 64 * (j))
#define XB_XGEN(j)  (2304 + 64 * (j))
#define XB_TOP      3328
#define XB_TOPGEN   3392
#define XCD_BAR_WORDS 3456
#define XB_SPIN_CAP (1u << 18)
DI unsigned xb_ld(unsigned* p)              { return __hip_atomic_load(p, __ATOMIC_RELAXED, __HIP_MEMORY_SCOPE_AGENT); }
DI unsigned xb_add(unsigned* p, unsigned v) { return __hip_atomic_fetch_add(p, v, __ATOMIC_RELAXED, __HIP_MEMORY_SCOPE_AGENT); }
DI unsigned xb_xcc_id() { return (unsigned)__builtin_amdgcn_s_getreg((3 << 11) | 20) & 0xFu; }
#define XB_SPIN(cond, bar) do { unsigned _sp = 0; while (cond) { __builtin_amdgcn_s_sleep(1); \
    if ((++_sp & 255u) == 0u) { if (xb_ld(&(bar)[XB_TMO])) break; if (_sp > XB_SPIN_CAP) { atomicAdd(&(bar)[XB_TMO], 1u); break; } } } } while (0)
struct XcdBarrier { unsigned* bar; unsigned x; volatile LAS unsigned* st; };
DI XcdBarrier xcd_barrier_post(unsigned* bar, volatile LAS unsigned* st) {
    XcdBarrier b; b.bar = bar; b.x = xb_xcc_id(); b.st = st;
    if (threadIdx.x == 0) (void)xb_add(&bar[XB_XCNT(b.x)], 1u);
    return b;
}
DI void xcd_barrier_complete(unsigned* bar, unsigned x, unsigned& nloc, unsigned& nx) {
    const unsigned G = gridDim.x * gridDim.y * gridDim.z;
    unsigned sum, cnt, mine, sp = 0u;
    for (;;) {
        sum = 0u; cnt = 0u; mine = 0u;
#pragma unroll
        for (unsigned j = 0; j < 16; ++j) { const unsigned c = xb_ld(&bar[XB_XCNT(j)]); sum += c; cnt += (c > 0u) ? 1u : 0u; mine = (j == x) ? c : mine; }
        if (sum == G) break;
        __builtin_amdgcn_s_sleep(1);
        if ((++sp & 255u) == 0u) { if (xb_ld(&bar[XB_TMO])) break; if (sp > XB_SPIN_CAP) { atomicAdd(&bar[XB_TMO], 1u); break; } }
    }
    nloc = mine > 0u ? mine : 1u; nx = cnt > 0u ? cnt : 1u;
}
DI void xcd_barrier(const XcdBarrier& b) {
    asm volatile("s_waitcnt vmcnt(0)" ::: "memory");
    __syncthreads();
    if (threadIdx.x == 0) {
        unsigned* bar = b.bar;
        __builtin_amdgcn_s_waitcnt(0);
        unsigned nloc = b.st[0], nx = b.st[1];
        if (nloc == 0u) { xcd_barrier_complete(bar, b.x, nloc, nx); b.st[0] = nloc; b.st[1] = nx; }
        const unsigned old = xb_add(&bar[XB_XSUB(b.x)], 1u);
        const unsigned gen = old / nloc;
        if (old + 1u == (gen + 1u) * nloc) {
            __builtin_amdgcn_fence(__ATOMIC_RELEASE, "agent");
            asm volatile("s_waitcnt vmcnt(0)" ::: "memory");
            const unsigned og = xb_add(&bar[XB_TOP], 1u);
            const unsigned tg = og / nx;
            if (og + 1u == (tg + 1u) * nx) xb_add(&bar[XB_TOPGEN], 1u);
            else XB_SPIN(xb_ld(&bar[XB_TOPGEN]) == tg, bar);
            __builtin_amdgcn_fence(__ATOMIC_ACQUIRE, "agent");
            xb_add(&bar[XB_XGEN(b.x)], 1u);
            asm volatile("s_waitcnt vmcnt(0)" ::: "memory");
        } else {
            XB_SPIN(xb_ld(&bar[XB_XGEN(b.x)]) == gen, bar);
            __builtin_amdgcn_fence(__ATOMIC_ACQUIRE, "agent");
            asm volatile("s_waitcnt vmcnt(0)" ::: "memory");
        }
    }
    __syncthreads();
}

__global__ void __launch_bounds__(NTHREADS) mega(Params p) {
    extern __shared__ __attribute__((aligned(16))) unsigned char smem[];
    LAS unsigned char* lds = (LAS unsigned char*)smem;
    cg::grid_group grid = cg::this_grid();
    volatile LAS unsigned* xb_st = (volatile LAS unsigned*)(lds + XB_ST_OFF);
    if (threadIdx.x < 4) xb_st[threadIdx.x] = 0u;
    __syncthreads();
    XcdBarrier xbar = xcd_barrier_post((unsigned*)((unsigned char*)p.in[27] + WS_BAR), xb_st);

    for (int ph = p.ph_lo; ph < p.ph_hi; ++ph) {
        unsigned char* ws = (unsigned char*)p.in[opq(27)];
        float* const xout = (float*)p.in[opq(26)];
        float* mod = (float*)(ws + WS_MOD);
        float* xc = (float*)(ws + WS_XC);
        bf16_t* hbuf = (bf16_t*)(ws + WS_H);
        if (ph == 0) {
            prep_phase(p, lds);
#if defined(MK_DUP_OP) && MK_DUP_OP == 99
            grid.sync(); prep_phase(p, lds);
#endif
        } else {
            const int q = ph - 1, lp = q / 21; int r = q % 21; int layer, nmix;
            if (r < 10) { layer = 2 * lp; nmix = 6; } else { layer = 2 * lp + 1; r -= 10; nmix = 7; }
            const bool is_mla = layer & 1; const int j = layer >> 1;
            const float* modl = mod + (size_t)layer * 17 * 6144;
            const bool first = (layer == 0);
            int op = -1, gsel = 0, hf = 0;
            if (r < nmix) {
                if (!is_mla) { op = r == 0 ? 0 : r == 1 ? 2 : r == 2 ? 9 : r == 3 ? 3 : r == 4 ? 4 : 2; gsel = r == 1 ? 0 : 1; }
                else { op = r == 0 ? 0 : r == 1 ? 2 : r == 2 ? 5 : r == 3 ? 2 : r == 4 ? 6 : r == 5 ? 7 : 2; gsel = r == 1 ? 2 : r == 3 ? 3 : 5; }
            } else {
                const int f = r - nmix;
                op = f == 0 ? 1 : f == 2 ? 8 : 2; gsel = f == 1 ? 6 : 7;
            }
            if (op == 1 || op == 6 || (op == 0 && layer > 0)) continue;
#ifdef MK_DUP_OP
            for (int rep_ = 0; rep_ < ((op == MK_DUP_OP || (op == 2 && gsel == MK_DUP_OP - 100)) ? 2 : 1); ++rep_) {
            if (rep_) grid.sync();
#else
            {
#endif
            if (op == 0) {
                norm_phase(p.in[opq(0)], p.in[opq(2)], p.in[opq(6)], modl, 0, 1024, hbuf);
                shw_phase(ws, lds);
            } else if (op == 2) {
                const int ng = (gsel == 3) ? 2 : 1;
                for (int gi = 0; gi < ng; ++gi) {
                    pg8::Gemm g; Epi E; int kind = EPI_BF16;
                    E.ldc = 0; E.xch = (LAS float*)(lds + XCH_OFF); E.q0 = nullptr; E.q1 = nullptr; E.q2 = nullptr; E.q3 = nullptr; E.q4 = nullptr; E.q5 = nullptr;
                    float* const shw_mix = (float*)(ws + WS_SHW) + (size_t)(layer * 2) * 17 * 5632; float* const shw_ffn = shw_mix + 17 * 5632;
                    float* const rs0 = (float*)(ws + WS_RS); float* const rs1 = rs0 + MR;
                    g.M = MR;
                    const int gs = gsel + gi;
                    if (gs == 0) { g.A = hbuf; g.Bt = (const bf16_t*)(ws + WS_GIN + j * SZ_GIN); g.N = 3328; g.K = 1024; g.lda = 1024; g.ldb = 1024;
                        kind = EPI_GLA_IN; E.q0 = ws + WS_QK; E.ldc = 1024; E.q1 = ws + WS_LR; E.q2 = ws + WS_VR; if (!first) { E.q3 = rs1; E.q4 = shw_mix; } }
                    else if (gs == 1 || gs == 5) { g.A = hbuf; g.Bt = (const bf16_t*)(ws + (gs == 1 ? WS_GOUT : WS_MOUT) + j * SZ_SQ); g.N = 1024; g.K = 1024; g.lda = 1024; g.ldb = 1024;
                        kind = EPI_RESID; E.ldc = 0; E.q0 = (void*)(first ? p.in[opq(0)] : xout); E.q1 = (void*)(first ? p.in[opq(2)] : xc); E.q2 = xout; E.q3 = ws; E.q4 = (void*)modl; E.q5 = (void*)(p.in[opq(7)] + layer * 1024);
                        for (int i = blockIdx.x * NTHREADS + tid_opq(); i < MR; i += gridDim.x * NTHREADS) rs1[i] = 0.f; }
                    else if (gs == 2) { g.A = hbuf; g.Bt = (const bf16_t*)(ws + WS_MDOWN + j * SZ_MDOWN); g.N = 768; g.K = 1024; g.lda = 1024; g.ldb = 1024;
                        E.q0 = ws + WS_DN; E.ldc = 768; E.q3 = rs1; E.q4 = shw_mix; }
                    else if (gs == 3) { g.A = (const bf16_t*)(ws + WS_CQN); g.Bt = (const bf16_t*)(ws + WS_MUQ + j * SZ_MUQ); g.N = 1536; g.K = 384; g.lda = 384; g.ldb = 384;
                        E.q0 = ws + WS_QRAW; E.ldc = 1536; }
                    else if (gs == 4) { g.A = (const bf16_t*)(ws + WS_CKVN); g.Bt = (const bf16_t*)(ws + WS_MUKV + j * SZ_MUKV); g.N = 2048; g.K = 256; g.lda = 256; g.ldb = 256;
                        kind = EPI_UKV; E.q0 = ws + WS_KB; E.q1 = ws + WS_VB; E.q2 = (void*)(p.in[opq(20)] + j * 192); }
                    else if (gs == 6) { g.A = (const bf16_t*)(ws + WS_XSA); g.Bt = (const bf16_t*)(ws + WS_FUP + (size_t)layer * SZ_FUP); g.N = 5632; g.K = 1024; g.lda = 1024; g.ldb = 1024;
                        kind = EPI_FFN_UP; E.q0 = ws + WS_ACT; E.ldc = 2816; E.q1 = (void*)(p.in[opq(23)] + (size_t)layer * 3 * 2 * DFF); E.q2 = (void*)(p.in[opq(24)] + (size_t)layer * 2 * DFF);
                        E.q3 = ws + WS_HALO; E.q4 = rs0; E.q5 = shw_ffn; }
                    else { g.A = (const bf16_t*)(ws + WS_ACT); g.Bt = (const bf16_t*)(ws + WS_FDOWN + (size_t)layer * SZ_FDOWN); g.N = 1024; g.K = 2816; g.lda = 2816; g.ldb = 2816;
                        kind = EPI_RESID; E.ldc = 1; E.q0 = xout; E.q1 = xc; E.q2 = xout; E.q3 = ws; E.q4 = (void*)modl; E.q5 = layer < 3 ? (void*)(p.in[opq(6)] + (layer + 1) * 1024) : nullptr;
                        for (int i = blockIdx.x * NTHREADS + tid_opq(); i < MR; i += gridDim.x * NTHREADS) rs0[i] = 0.f; }
                    if (layer == 3 && (gs == 3 || gs == 5 || gs == 6 || gs == 7)) g.M = TL;
                    pg8::StaticOrder S; S.init(g.M, g.N, (int)gridDim.x, (int)blockIdx.x);
                    if (kind == EPI_BF16) pg8::gemm_phase<Epi, EPI_BF16>(lds, g, S, E);
                    else if (kind == EPI_GLA_IN) pg8::gemm_phase<Epi, EPI_GLA_IN>(lds, g, S, E);
                    else if (kind == EPI_RESID) pg8::gemm_phase<Epi, EPI_RESID>(lds, g, S, E);
                    else if (kind == EPI_UKV) pg8::gemm_phase<Epi, EPI_UKV>(lds, g, S, E);
                    else pg8::gemm_phase<Epi, EPI_FFN_UP>(lds, g, S, E);
                    __syncthreads();
                }
            } else if (op == 3) {
                scan_phase((const bf16_t*)(ws + WS_VR), (const bf16_t*)(ws + WS_GQ), (const bf16_t*)(ws + WS_GK), (const bf16_t*)(ws + WS_GP), (const float*)(ws + WS_GE),
                           hbuf, (bf16_t*)(ws + WS_QK), lds);
            } else if (op == 9) {
                gateprep_phase((const bf16_t*)(ws + WS_QK), (const float*)(ws + WS_LR), p.in[opq(10)] + (size_t)j * 2 * 16 * 512, p.in[opq(11)] + (size_t)j * 2 * 512,
                               (bf16_t*)(ws + WS_GQ), (bf16_t*)(ws + WS_GK), (bf16_t*)(ws + WS_GP), (float*)(ws + WS_GE), lds);
            } else if (op == 4) {
                glapost_phase(hbuf, (const bf16_t*)(ws + WS_QK), (const bf16_t*)(ws + WS_VR), p.in[opq(12)] + j * 256, hbuf);
            } else if (op == 5) {
                mlamid_phase((const bf16_t*)(ws + WS_DN), p.in[opq(15)] + j * 384, p.in[opq(16)] + j * 256, p.in[opq(20)] + j * 192, (bf16_t*)(ws + WS_CQN), (bf16_t*)(ws + WS_CKVN), (bf16_t*)(ws + WS_KB));
            } else if (op == 6) {
                qkprep_phase((bf16_t*)(ws + WS_KB), p.in[opq(20)] + j * 192);
            } else if (op == 7) {
                attn_phase((const bf16_t*)(ws + WS_QRAW), (const bf16_t*)(ws + WS_KB), (const bf16_t*)(ws + WS_VB), hbuf, (char*)smem, layer == 3 ? 2048 : 2048 + 128, p.in[opq(19)] + j * 192);
            } else if (op == 8) {
                fixup_phase((const float*)(ws + WS_HALO), p.in[opq(23)] + (size_t)layer * 3 * 2 * DFF, p.in[opq(24)] + (size_t)layer * 2 * DFF, (bf16_t*)(ws + WS_ACT));
            }
            }
        }
        if (ph + 1 < p.ph_hi) { if (p.ph_lo < 0) grid.sync(); else xcd_barrier(xbar); }
    }
}

extern "C" void kernel_launch(void* const* d_in, const int* in_sizes, int n_in, void* d_out, int out_size, void* d_ws, size_t ws_size, hipStream_t stream) {
    static int grid = 0;
    if (grid == 0) {
        if (n_in != 26 || ws_size < WS_END) { fprintf(stderr, "kernel_launch: n_in %d ws %zu (need %zu)\n", n_in, ws_size, (size_t)WS_END); grid = -1; return; }
        int dev = 0, cus = 0, per_cu = 0;
        hipGetDevice(&dev);
        hipDeviceGetAttribute(&cus, hipDeviceAttributeMultiprocessorCount, dev);
        if (hipFuncSetAttribute((const void*)mega, hipFuncAttributeMaxDynamicSharedMemorySize, LDS_BYTES) != hipSuccess) { fprintf(stderr, "kernel_launch: hipFuncSetAttribute failed\n"); grid = -1; return; }
        if (hipOccupancyMaxActiveBlocksPerMultiprocessor(&per_cu, (const void*)mega, NTHREADS, LDS_BYTES) != hipSuccess || per_cu < 1) { fprintf(stderr, "kernel_launch: occupancy query %d\n", per_cu); per_cu = 1; }
        (void)hipGetLastError();
        grid = cus * per_cu;
        fprintf(stderr, "kernel_launch: grid %d (cus %d x %d)\n", grid, cus, per_cu);
    }
    if (grid < 0) return;
    Params p{};
    for (int i = 0; i < 26; ++i) p.in[i] = (const float*)d_in[i];
    p.in[26] = (const float*)d_out; p.in[27] = (const float*)d_ws;
    (void)hipMemsetAsync((unsigned char*)d_ws + WS_BAR, 0, 16384, stream);
#if MK_MULTI
    for (int ph = 0; ph < NPH; ++ph) {
        p.ph_lo = ph; p.ph_hi = ph + 1;
        hipLaunchKernelGGL(mega, dim3(grid), dim3(NTHREADS), LDS_BYTES, stream, p);
    }
#else
    p.ph_lo = 0; p.ph_hi = NPH;
    void* args[] = {&p};
    hipError_t e = hipLaunchCooperativeKernel((const void*)mega, dim3(grid), dim3(NTHREADS), args, LDS_BYTES, stream);
    if (e != hipSuccess) fprintf(stderr, "cooperative launch failed: %s (grid %d)\n", hipGetErrorString(e), grid);
#endif
}
```

```cpp
#include <hip/hip_runtime.h>
#include <hip/hip_cooperative_groups.h>
#include <cstdio>
#include <cstdint>
namespace cg = cooperative_groups;

#ifndef MK_MULTI
#define MK_MULTI 0
#endif

#define LAS __attribute__((address_space(3)))
#define DI __device__ __forceinline__
typedef unsigned short bf16_t;
typedef short bf16x8 __attribute__((ext_vector_type(8)));
typedef short s16x4 __attribute__((ext_vector_type(4)));
typedef float f32x2 __attribute__((ext_vector_type(2)));
typedef float f32x4 __attribute__((ext_vector_type(4)));
typedef float f32x16 __attribute__((ext_vector_type(16)));
typedef unsigned u32x2 __attribute__((ext_vector_type(2)));
typedef unsigned u32x4 __attribute__((ext_vector_type(4)));

constexpr int DM = 1024, NB = 16, SEQ = 4096, CTXL = 256;
constexpr int TL = NB * SEQ, TC = NB * CTXL, MR = TL + TC;
constexpr int KEYS = CTXL + SEQ;
constexpr int DFF = 2816, DFFH = 1408;
constexpr int NTHREADS = 512;
constexpr int XB_ST_OFF = 131072 + 12288 + 2 * 5120 + 6144;
constexpr int LDS_BYTES = XB_ST_OFF + 16;
constexpr int WIMG_F = 3072, PREW_F = 3072 + 2 * 1280;
constexpr int XCH_OFF = 131072;
constexpr int NPH = 43;

constexpr size_t SZ_GIN = 3328ull * 1024 * 2, SZ_SQ = 1024ull * 1024 * 2, SZ_MDOWN = 768ull * 1024 * 2, SZ_MUQ = 1536ull * 384 * 2,
                 SZ_MUKV = 2048ull * 256 * 2, SZ_FUP = 5632ull * 1024 * 2, SZ_FDOWN = 1024ull * 2816 * 2;
constexpr size_t WS_GIN = 0;
constexpr size_t WS_GOUT = WS_GIN + 2 * SZ_GIN;
constexpr size_t WS_MDOWN = WS_GOUT + 2 * SZ_SQ;
constexpr size_t WS_MUQ = WS_MDOWN + 2 * SZ_MDOWN;
constexpr size_t WS_MUKV = WS_MUQ + 2 * SZ_MUQ;
constexpr size_t WS_MOUT = WS_MUKV + 2 * SZ_MUKV;
constexpr size_t WS_FUP = WS_MOUT + 2 * SZ_SQ;
constexpr size_t WS_FDOWN = WS_FUP + 4 * SZ_FUP;
constexpr size_t WS_MOD = WS_FDOWN + 4 * SZ_FDOWN;
constexpr size_t SZ_MOD = 4ull * 17 * 6144 * 4;
constexpr size_t WS_RS = WS_MOD + ((SZ_MOD + 255) / 256) * 256;
constexpr size_t WS_SHW = WS_RS + 2ull * MR * 4;
constexpr size_t WS_BAR = WS_SHW + 4ull * 2 * 17 * 5632 * 4;
constexpr size_t WS_XC = WS_BAR + 16384;
constexpr size_t WS_H = WS_XC + (size_t)TC * 1024 * 4;
constexpr size_t WS_R = WS_H + (size_t)MR * 1024 * 2;
constexpr size_t WS_QK = WS_R;
constexpr size_t WS_VR = WS_QK + (size_t)MR * 1024 * 2;
constexpr size_t WS_LR = WS_VR + (size_t)MR * 2048 * 2;
constexpr int NCHI = NB * 2 * 4 * 68;
constexpr size_t WS_GQ = WS_LR + (size_t)MR * 32 * 4;
constexpr size_t WS_GK = WS_GQ + (size_t)NCHI * 64 * 128 * 2;
constexpr size_t WS_GP = WS_GK + (size_t)NCHI * 64 * 128 * 2;
constexpr size_t WS_GE = WS_GP + (size_t)NCHI * 64 * 64 * 2;
constexpr size_t WS_GLA_END = WS_GE + (size_t)NCHI * 128 * 4;
constexpr size_t WS_QRAW = WS_R;
constexpr size_t WS_DN = WS_R;
constexpr size_t WS_CQN = WS_QRAW + (size_t)MR * 1536 * 2;
constexpr size_t WS_CKVN = WS_CQN + (size_t)MR * 384 * 2;
constexpr size_t WS_KB = WS_CKVN + (size_t)MR * 256 * 2;
constexpr size_t WS_VB = WS_KB + (size_t)NB * KEYS * 1536 * 2;
constexpr size_t WS_MLA_END = WS_VB + (size_t)NB * KEYS * 1024 * 2;
constexpr size_t WS_ACT = WS_R;
constexpr size_t WS_HALO = WS_ACT + (size_t)MR * 2816 * 2;
constexpr size_t WS_XSA = WS_HALO + 272ull * 22 * 4 * 256 * 4;
constexpr size_t WS_FFN_END = WS_XSA + (size_t)MR * 1024 * 2;
constexpr size_t WS_END = WS_GLA_END > WS_MLA_END ? (WS_GLA_END > WS_FFN_END ? WS_GLA_END : WS_FFN_END) : (WS_MLA_END > WS_FFN_END ? WS_MLA_END : WS_FFN_END);
static_assert(WS_END <= (1ull << 30), "workspace over 1 GiB");

struct Params { const float* in[28]; int ph_lo, ph_hi; };

DI unsigned cvt_pk_bf16(float lo, float hi) { unsigned r; asm("v_cvt_pk_bf16_f32 %0, %1, %2" : "=v"(r) : "v"(lo), "v"(hi)); return r; }
DI float bf_lo(unsigned u) { return __uint_as_float(u << 16); }
DI float bf_hi(unsigned u) { return __uint_as_float(u & 0xffff0000u); }
DI bf16_t f2bf(float f) { return (bf16_t)(cvt_pk_bf16(f, 0.f) & 0xffffu); }
DI float wave_sum(float v) {
    v += __int_as_float(__builtin_amdgcn_update_dpp(0, __float_as_int(v), 0xB1, 0xF, 0xF, false));
    v += __int_as_float(__builtin_amdgcn_update_dpp(0, __float_as_int(v), 0x4E, 0xF, 0xF, false));
    v += __int_as_float(__builtin_amdgcn_update_dpp(0, __float_as_int(v), 0x141, 0xF, 0xF, false));
    v += __int_as_float(__builtin_amdgcn_update_dpp(0, __float_as_int(v), 0x140, 0xF, 0xF, false));
    v += __int_as_float(__builtin_amdgcn_update_dpp(0, __float_as_int(v), 0x142, 0xA, 0xF, false));
    v += __int_as_float(__builtin_amdgcn_update_dpp(0, __float_as_int(v), 0x143, 0xC, 0xF, false));
    return __int_as_float(__builtin_amdgcn_readlane(__float_as_int(v), 63));
}
DI float silu_f(float v) { return v * __builtin_amdgcn_rcpf(1.0f + __expf(-v)); }
DI int crow(int r, int hi) { return (r & 3) + 8 * (r >> 2) + 4 * hi; }
DI int tid_opq() { int t = threadIdx.x; asm volatile("" : "+v"(t)); return t; }
DI int opq(int i) { asm volatile("" : "+s"(i)); return i; }

namespace pg8 {
constexpr int BM = 256, BK = 64, HALF = 128, HTB = HALF * BK * 2, STAGE_BYTES = 8 * HTB, NXCD = 8, WGM = 8;
DI int lds_byte(int r, int c) { const int st = (r >> 4) * 2 + (c >> 5), rr = r & 15, cc = c & 31, ob = rr * 64 + cc * 2; return st * 1024 + (ob ^ (((ob >> 9) & 1) << 5)); }
DI void stage_rc(int b, int& R, int& C) { const int st = b / 1024, sb = b % 1024, swz = sb ^ (((sb >> 9) & 1) << 5); R = (st >> 1) * 16 + swz / 64; C = (st & 1) * 32 + (swz % 64) / 2; }
DI int perm32(int rho) { const int n = rho >> 4, i = rho & 15; return 8 * (i >> 2) + 4 * n + (i & 3); }
struct Unit { int pm, pn; };
struct Gemm { const bf16_t* A; const bf16_t* Bt; int M, N, K, lda, ldb; };
struct StaticOrder {
    int nM, nN, nwg, G, c, rev;
    DI void init(int M, int N, int G_, int c_, int rev_ = 0) { nM = M / BM; nN = N / BM; nwg = nM * nN; G = G_; c = c_; rev = rev_; }
    DI bool next(int i, Unit& u) const {
        const long L = (long)i * G + c; if (L >= nwg) return false;
        int wgid = (int)L; { const int q = nwg / NXCD, r = nwg % NXCD, xcd = wgid % NXCD, off = wgid / NXCD; wgid = (xcd < r ? xcd * (q + 1) : r * (q + 1) + (xcd - r) * q) + off; }
        const int nig = WGM * nN, gid = wgid / nig, fm = gid * WGM, gsz = (nM - fm) < WGM ? (nM - fm) : WGM;
        u.pm = fm + ((wgid % nig) % gsz); u.pn = (wgid % nig) / gsz; if (rev) u.pm = nM - 1 - u.pm; return true;
    }
};

template <class Epi, int KIND>
DI void gemm_phase(LAS unsigned char* lds, const Gemm g, const StaticOrder& S, const Epi& E) {
    constexpr bool perm = Epi::template perm_of<KIND>();
    const int tid = tid_opq(), wid = __builtin_amdgcn_readfirstlane(tid >> 6), lane = tid & 63, wr = wid >> 2, wc = wid & 3, fr = lane & 15, fq = lane >> 4;
    const int K = g.K, nt = K / BK;
    unsigned voffA[2], voffB[2];
#pragma unroll
    for (int i = 0; i < 2; ++i) { int R, C; stage_rc(tid * 16 + i * 8192, R, C); const int Rb = perm ? ((R & ~31) + perm32(R & 31)) : R;
        voffA[i] = (unsigned)(R * g.lda + C) * 2u; voffB[i] = (unsigned)(Rb * g.ldb + C) * 2u; }
    const size_t kstep = (size_t)(BK * 2);
    const size_t hstepA = (size_t)HALF * g.lda * 2, hstepB = (size_t)HALF * g.ldb * 2;
    const size_t tstepA = 2 * hstepA, tstepB = 2 * hstepB;
    const unsigned ldsw = (unsigned)wid * 1024u;
    const int aoff = lds_byte(wr * 64 + fr, fq * 8), boff = lds_byte(wc * 32 + fr, fq * 8);
#define PG8_SA(b, h) (((b) * 2 + (h)) * HTB)
#define PG8_SB(b, h) ((4 + (b) * 2 + (h)) * HTB)
#define PG8_STAGE(bufoff, gbase, voff) do { _Pragma("unroll") for (int _i = 0; _i < 2; ++_i) \
        __builtin_amdgcn_global_load_lds((const unsigned*)((const char*)(gbase) + (voff)[_i]), (LAS unsigned*)(lds + (bufoff) + ldsw + _i * 8192), 16, 0, 0); } while (0)
#define PG8_LDA(dst, b, h) do { _Pragma("unroll") for (int m = 0; m < 4; ++m) _Pragma("unroll") for (int k = 0; k < 2; ++k) dst[m][k] = *(const LAS bf16x8*)(lds + PG8_SA(b, h) + aoff + m * 2048 + k * 1024); } while (0)
#define PG8_LDB(dst, b, h) do { _Pragma("unroll") for (int n = 0; n < 2; ++n) _Pragma("unroll") for (int k = 0; k < 2; ++k) dst[n][k] = *(const LAS bf16x8*)(lds + PG8_SB(b, h) + boff + n * 2048 + k * 1024); } while (0)
#define PG8_MMA(ai, bj, At, Bt) do { __builtin_amdgcn_s_setprio(1); _Pragma("unroll") for (int m = 0; m < 4; ++m) _Pragma("unroll") for (int n = 0; n < 2; ++n) _Pragma("unroll") for (int k = 0; k < 2; ++k) \
        acc[ai][bj][m][n] = __builtin_amdgcn_mfma_f32_16x16x32_bf16(Bt[n][k], At[m][k], acc[ai][bj][m][n], 0, 0, 0); __builtin_amdgcn_s_setprio(0); } while (0)
#define PG8_WAIT_V(n) asm volatile("s_waitcnt vmcnt(" #n ")" ::: "memory")
#define PG8_WAIT_L(n) asm volatile("s_waitcnt lgkmcnt(" #n ")" ::: "memory")
#define PG8_BAR __builtin_amdgcn_s_barrier()
#define PG8_SCHED __builtin_amdgcn_sched_barrier(0)
    Unit cur, nxt; int ui = 0;
    if (!S.next(0, cur)) return;
    f32x4 acc[2][2][4][2];
#pragma unroll
    for (int a = 0; a < 2; ++a)
#pragma unroll
        for (int b = 0; b < 2; ++b)
#pragma unroll
            for (int m = 0; m < 4; ++m)
#pragma unroll
                for (int n = 0; n < 2; ++n) acc[a][b][m][n] = (f32x4){0.f, 0.f, 0.f, 0.f};
    bf16x8 At[4][2], B0[2][2], B1[2][2];
    typename Epi::Pre pre;
    const char* cA = (const char*)g.A + (size_t)cur.pm * tstepA; const char* cB = (const char*)g.Bt + (size_t)cur.pn * tstepB;
    PG8_STAGE(PG8_SB(0, 0), cB, voffB); PG8_STAGE(PG8_SA(0, 0), cA, voffA); PG8_STAGE(PG8_SB(0, 1), cB + hstepB, voffB); PG8_STAGE(PG8_SA(0, 1), cA + hstepA, voffA);
    if (wr == 1) PG8_BAR;
    PG8_WAIT_V(4); PG8_BAR;
    PG8_STAGE(PG8_SB(1, 0), cB + kstep, voffB); PG8_STAGE(PG8_SA(1, 0), cA + kstep, voffA); PG8_STAGE(PG8_SB(1, 1), cB + hstepB + kstep, voffB);
    PG8_WAIT_V(6); PG8_BAR;
    for (;;) {
        const bool has_next = S.next(ui + 1, nxt);
        const char* nA = has_next ? (const char*)g.A + (size_t)nxt.pm * tstepA : cA; const char* nB = has_next ? (const char*)g.Bt + (size_t)nxt.pn * tstepB : cB;
        E.template prefetch<KIND>(pre, cur, wr, wc, fr, fq, ui & 1);
        for (int t = 0; t < nt; t += 2) {
            const bool last = (t == nt - 2);
            const char* a1 = cA + (size_t)(t + 1) * kstep;
            const char* a2 = last ? nA : cA + (size_t)(t + 2) * kstep; const char* b2 = last ? nB : cB + (size_t)(t + 2) * kstep;
            const char* a3 = a2 + kstep; const char* b3 = b2 + kstep;
            PG8_LDB(B0, 0, 0); PG8_SCHED; PG8_LDA(At, 0, 0); PG8_STAGE(PG8_SA(1, 1), a1 + hstepA, voffA);
            PG8_WAIT_L(8); PG8_BAR; PG8_WAIT_L(0); PG8_MMA(0, 0, At, B0); PG8_BAR; PG8_SCHED;
            PG8_LDB(B1, 0, 1); PG8_STAGE(PG8_SB(0, 0), b2, voffB);
            PG8_BAR; PG8_WAIT_L(0); PG8_MMA(0, 1, At, B1); PG8_BAR;
            PG8_LDA(At, 0, 1); PG8_STAGE(PG8_SA(0, 0), a2, voffA);
            PG8_BAR; PG8_WAIT_L(0); PG8_MMA(1, 0, At, B0); PG8_BAR; PG8_SCHED;
            PG8_STAGE(PG8_SB(0, 1), b2 + hstepB, voffB);
            PG8_WAIT_V(6); PG8_BAR; PG8_MMA(1, 1, At, B1); PG8_BAR;
            PG8_LDB(B0, 1, 0); PG8_SCHED; PG8_LDA(At, 1, 0); PG8_STAGE(PG8_SA(0, 1), a2 + hstepA, voffA);
            PG8_WAIT_L(8); PG8_BAR; PG8_WAIT_L(0); PG8_MMA(0, 0, At, B0); PG8_BAR; PG8_SCHED;
            PG8_LDB(B1, 1, 1); PG8_STAGE(PG8_SB(1, 0), b3, voffB);
            PG8_BAR; PG8_WAIT_L(0); PG8_MMA(0, 1, At, B1); PG8_BAR;
            PG8_LDA(At, 1, 1); PG8_STAGE(PG8_SA(1, 0), a3, voffA);
            PG8_BAR; PG8_WAIT_L(0); PG8_MMA(1, 0, At, B0); PG8_BAR; PG8_SCHED;
            PG8_STAGE(PG8_SB(1, 1), b3 + hstepB, voffB);
            PG8_WAIT_V(6); PG8_BAR; PG8_MMA(1, 1, At, B1); PG8_BAR;
        }
        if (wr == 0) { PG8_BAR; asm volatile("" ::: "memory"); }
        E.template run<KIND>(acc, pre, cur, wr, wc, fr, fq, ui & 1);
        if (wr == 1) { asm volatile("" ::: "memory"); PG8_BAR; }
        if (!has_next) break;
#pragma unroll
        for (int a = 0; a < 2; ++a)
#pragma unroll
            for (int b = 0; b < 2; ++b)
#pragma unroll
                for (int m = 0; m < 4; ++m)
#pragma unroll
                    for (int n = 0; n < 2; ++n) acc[a][b][m][n] = (f32x4){0.f, 0.f, 0.f, 0.f};
        cur = nxt; cA = nA; cB = nB; ++ui;
    }
    PG8_WAIT_V(0);
    if (wr == 0) PG8_BAR;
    PG8_BAR;
#undef PG8_SA
#undef PG8_SB
#undef PG8_STAGE
#undef PG8_LDA
#undef PG8_LDB
#undef PG8_MMA
#undef PG8_WAIT_V
#undef PG8_WAIT_L
#undef PG8_BAR
#undef PG8_SCHED
}
}

enum { EPI_BF16 = 0, EPI_GLA_IN = 1, EPI_RESID = 2, EPI_UKV = 3, EPI_FFN_UP = 4 };
DI float dpp_ror1(float v) { return __int_as_float(__builtin_amdgcn_update_dpp(0, __float_as_int(v), 0x121, 0xf, 0xf, false)); }
DI float dpp_ror15(float v) { return __int_as_float(__builtin_amdgcn_update_dpp(0, __float_as_int(v), 0x12F, 0xf, 0xf, false)); }
struct Epi {
    struct Pre { float rsv[2][4]; f32x4 sw[2][2]; f32x2 wl0, wl1; };
    int ldc; LAS float* xch;
    void* q0; void* q1; void* q2; void* q3; void* q4; void* q5;
    static DI f32x4 ror1_4(f32x4 v) { float a, b, c, d;
        asm volatile("s_nop 1\n\tv_mov_b32_dpp %0, %4 row_ror:1 row_mask:0xf bank_mask:0xf\n\tv_mov_b32_dpp %1, %5 row_ror:1 row_mask:0xf bank_mask:0xf\n\tv_mov_b32_dpp %2, %6 row_ror:1 row_mask:0xf bank_mask:0xf\n\tv_mov_b32_dpp %3, %7 row_ror:1 row_mask:0xf bank_mask:0xf"
                     : "=&v"(a), "=&v"(b), "=&v"(c), "=&v"(d) : "v"(v[0]), "v"(v[1]), "v"(v[2]), "v"(v[3]));
        return (f32x4){a, b, c, d}; }
    static DI f32x2 ror1_2(f32x2 v) { float a, b;
        asm volatile("s_nop 1\n\tv_mov_b32_dpp %0, %2 row_ror:1 row_mask:0xf bank_mask:0xf\n\tv_mov_b32_dpp %1, %3 row_ror:1 row_mask:0xf bank_mask:0xf" : "=&v"(a), "=&v"(b) : "v"(v[0]), "v"(v[1]));
        return (f32x2){a, b}; }
    static DI f32x2 ror15_2(f32x2 v) { float a, b;
        asm volatile("s_nop 1\n\tv_mov_b32_dpp %0, %2 row_ror:15 row_mask:0xf bank_mask:0xf\n\tv_mov_b32_dpp %1, %3 row_ror:15 row_mask:0xf bank_mask:0xf" : "=&v"(a), "=&v"(b) : "v"(v[0]), "v"(v[1]));
        return (f32x2){a, b}; }
    static DI f32x4 ror15_4(f32x4 v) { float a, b, c, d;
        asm volatile("s_nop 1\n\tv_mov_b32_dpp %0, %4 row_ror:15 row_mask:0xf bank_mask:0xf\n\tv_mov_b32_dpp %1, %5 row_ror:15 row_mask:0xf bank_mask:0xf\n\tv_mov_b32_dpp %2, %6 row_ror:15 row_mask:0xf bank_mask:0xf\n\tv_mov_b32_dpp %3, %7 row_ror:15 row_mask:0xf bank_mask:0xf"
                     : "=&v"(a), "=&v"(b), "=&v"(c), "=&v"(d) : "v"(v[0]), "v"(v[1]), "v"(v[2]), "v"(v[3]));
        return (f32x4){a, b, c, d}; }
    DI void ffn_up(const f32x4 (&acc)[2][2][4][2], const pg8::Unit& u, int wr, int wc, int fr, int fq, int par) const {
        bf16_t* O = (bf16_t*)q0; float* halo = (float*)q3;
        const int cl = wc * 32 + 8 * fq;
        float rstd[2][4];
        { const LAS float* pw = xch + PREW_F + (wr * 4 + wc) * 192;
#pragma unroll
          for (int g = 0; g < 8; ++g) rstd[g >> 2][g & 3] = rsqrtf(pw[g * 16 + fr] * (1.0f / 1024.0f) + 1e-6f); }
        const LAS float* wbuf = xch + WIMG_F + par * 1280;
#define XW(ST, TB, BJ, V0, V1) do { LAS float* xp_ = xch + ((((ST) + 1) * 2 + (TB)) * 2 + (BJ)) * 128 + cl; *(LAS f32x4*)xp_ = (V0); *(LAS f32x4*)(xp_ + 4) = (V1); } while (0)
#define TR(AI, BJ, M, N) (acc[AI][BJ][M][N] * rstd[AI][M])
        if (fr == 0) { XW(wr, 0, 0, TR(0, 0, 0, 0), TR(0, 0, 0, 1)); XW(wr, 0, 1, TR(0, 1, 0, 0), TR(0, 1, 0, 1)); XW(2 + wr, 0, 0, TR(1, 0, 0, 0), TR(1, 0, 0, 1)); XW(2 + wr, 0, 1, TR(1, 1, 0, 0), TR(1, 1, 0, 1)); }
        if (fr == 15) { XW(wr, 1, 0, TR(0, 0, 3, 0), TR(0, 0, 3, 1)); XW(wr, 1, 1, TR(0, 1, 3, 0), TR(0, 1, 3, 1)); XW(2 + wr, 1, 0, TR(1, 0, 3, 0), TR(1, 0, 3, 1)); XW(2 + wr, 1, 1, TR(1, 1, 3, 0), TR(1, 1, 3, 1)); }
        { const f32x4 zz = (f32x4){0.f, 0.f, 0.f, 0.f}; if (fr == 0 && wr == 0) { XW(-1, 1, 0, zz, zz); XW(-1, 1, 1, zz, zz); } if (fr == 15 && wr == 1) { XW(4, 0, 0, zz, zz); XW(4, 0, 1, zz, zz); } }
#undef XW
        asm volatile("s_waitcnt lgkmcnt(0)" ::: "memory"); __builtin_amdgcn_s_barrier(); asm volatile("" ::: "memory"); __builtin_amdgcn_s_barrier(); asm volatile("" ::: "memory");
        {
            float* hp = halo + (size_t)(u.pm * 22 + u.pn) * 4 * 256 + cl;
            const f32x4 sa0 = *(const LAS f32x4*)(wbuf + 512 + cl), sa1 = *(const LAS f32x4*)(wbuf + 512 + cl + 4), sg0 = *(const LAS f32x4*)(wbuf + 640 + 512 + cl), sg1 = *(const LAS f32x4*)(wbuf + 640 + 512 + cl + 4);
            if (wr == 0 && fr < 2) { float* h2 = hp + fr * 256; *(f32x4*)h2 = TR(0, 0, 0, 0) + sa0; *(f32x4*)(h2 + 4) = TR(0, 0, 0, 1) + sa1; *(f32x4*)(h2 + 128) = TR(0, 1, 0, 0) + sg0; *(f32x4*)(h2 + 132) = TR(0, 1, 0, 1) + sg1; }
            if (wr == 1 && fr >= 14) { float* h2 = hp + (fr - 12) * 256; *(f32x4*)h2 = TR(1, 0, 3, 0) + sa0; *(f32x4*)(h2 + 4) = TR(1, 0, 3, 1) + sa1; *(f32x4*)(h2 + 128) = TR(1, 1, 3, 0) + sg0; *(f32x4*)(h2 + 132) = TR(1, 1, 3, 1) + sg1; }
        }
#undef TR
        asm volatile("" ::: "memory");
        const int rowt = u.pm * 256 + wr * 64 + fr;
        const bool f0 = fr == 0, f15 = fr == 15;
        f32x2 sg[2][4][4];
#define SILU2(v) (f32x2){silu_f(v[0]), silu_f(v[1])}
#define H2(V, HH) __builtin_shufflevector(V, V, 2 * (HH), 2 * (HH) + 1)
#define CONV_GROUP(BJ, Q, AI, OP) do { \
            const int st = 2 * (AI) + wr; \
            const f32x2 pb = *(const LAS f32x2*)(xch + (((st) * 2 + 1) * 2 + (BJ)) * 128 + cl + 2 * (Q)) + sw; \
            const f32x2 nb = *(const LAS f32x2*)(xch + (((st + 2) * 2 + 0) * 2 + (BJ)) * 128 + cl + 2 * (Q)) + sw; \
            const f32x2 c0 = H2(acc[AI][BJ][0][(Q) >> 1], (Q) & 1) * rstd[AI][0] + sw, c1 = H2(acc[AI][BJ][1][(Q) >> 1], (Q) & 1) * rstd[AI][1] + sw, \
                        c2 = H2(acc[AI][BJ][2][(Q) >> 1], (Q) & 1) * rstd[AI][2] + sw, c3 = H2(acc[AI][BJ][3][(Q) >> 1], (Q) & 1) * rstd[AI][3] + sw; \
            const f32x2 R0 = ror1_2(c0), L0 = ror15_2(c0), L1 = ror15_2(c1); \
            { const f32x2 v = w0 * (f0 ? pb : R0) + w1 * c0 + w2 * (f15 ? L1 : L0) + bb; OP(sg[AI][0][Q], v); } \
            __builtin_amdgcn_sched_barrier(0); \
            const f32x2 R1 = ror1_2(c1), L2 = ror15_2(c2); \
            { const f32x2 v = w0 * (f0 ? R0 : R1) + w1 * c1 + w2 * (f15 ? L2 : L1) + bb; OP(sg[AI][1][Q], v); } \
            __builtin_amdgcn_sched_barrier(0); \
            const f32x2 R2 = ror1_2(c2), L3 = ror15_2(c3); \
            { const f32x2 v = w0 * (f0 ? R1 : R2) + w1 * c2 + w2 * (f15 ? L3 : L2) + bb; OP(sg[AI][2][Q], v); } \
            __builtin_amdgcn_sched_barrier(0); \
            const f32x2 R3 = ror1_2(c3); \
            { const f32x2 v = w0 * (f0 ? R2 : R3) + w1 * c3 + w2 * (f15 ? nb : L3) + bb; OP(sg[AI][3][Q], v); } \
            __builtin_amdgcn_sched_barrier(0); } while (0)
#define OP_G(dst, v) dst = SILU2(v)
#define OP_A(dst, v) dst *= v
#define CONV_W(BJ, Q) const LAS float* wp_ = wbuf + (BJ) * 640 + cl + 2 * (Q); \
            const f32x2 w0 = *(const LAS f32x2*)wp_, w1 = *(const LAS f32x2*)(wp_ + 128), w2 = *(const LAS f32x2*)(wp_ + 256), bb = *(const LAS f32x2*)(wp_ + 384), sw = *(const LAS f32x2*)(wp_ + 512);
        { CONV_W(1, 0) CONV_GROUP(1, 0, 0, OP_G); CONV_GROUP(1, 0, 1, OP_G); }
        { CONV_W(1, 1) CONV_GROUP(1, 1, 0, OP_G); CONV_GROUP(1, 1, 1, OP_G); }
        { CONV_W(1, 2) CONV_GROUP(1, 2, 0, OP_G); CONV_GROUP(1, 2, 1, OP_G); }
        { CONV_W(1, 3) CONV_GROUP(1, 3, 0, OP_G); CONV_GROUP(1, 3, 1, OP_G); }
        { CONV_W(0, 0) CONV_GROUP(0, 0, 0, OP_A); CONV_GROUP(0, 0, 1, OP_A); }
        { CONV_W(0, 1) CONV_GROUP(0, 1, 0, OP_A); CONV_GROUP(0, 1, 1, OP_A); }
        { CONV_W(0, 2) CONV_GROUP(0, 2, 0, OP_A); CONV_GROUP(0, 2, 1, OP_A); }
        { CONV_W(0, 3) CONV_GROUP(0, 3, 0, OP_A); CONV_GROUP(0, 3, 1, OP_A); }
#undef CONV_W
#undef CONV_GROUP
#undef OP_G
#undef OP_A
#undef SILU2
#undef H2
#define ST16(AI, MM) do { u32x4 w_; w_.x = cvt_pk_bf16(sg[AI][MM][0][0], sg[AI][MM][0][1]); w_.y = cvt_pk_bf16(sg[AI][MM][1][0], sg[AI][MM][1][1]); w_.z = cvt_pk_bf16(sg[AI][MM][2][0], sg[AI][MM][2][1]); w_.w = cvt_pk_bf16(sg[AI][MM][3][0], sg[AI][MM][3][1]); \
            *(u32x4*)(O + (size_t)(rowt + (AI) * 128 + (MM) * 16) * 2816 + u.pn * 128 + cl) = w_; } while (0)
        ST16(0, 0); ST16(0, 1); ST16(0, 2); ST16(0, 3); ST16(1, 0); ST16(1, 1); ST16(1, 2); ST16(1, 3);
#undef ST16
    }
    template <int K> static constexpr bool perm_of() { return true; }
    template <int kind> DI void prefetch(Pre& P, const pg8::Unit& u, int wr, int wc, int fr, int fq, int par) const {
        (void)P;
        if constexpr (kind == EPI_UKV) {
            if (fq == 0 && fr < 8) __builtin_amdgcn_global_load_lds((const unsigned*)((const float*)q2 + wc * 32 + fr * 4), (LAS unsigned*)(xch + PREW_F + (wr * 4 + wc) * 192 + 128), 16, 0, 0);
        }
        if constexpr (kind == EPI_GLA_IN || kind == EPI_BF16 || kind == EPI_FFN_UP) {
            const float* rsb = (const float*)(kind == EPI_FFN_UP ? q4 : q3);
            if (rsb) {
                LAS float* pw = xch + PREW_F + (wr * 4 + wc) * 192;
                const int bidx = u.pm < 256 ? (u.pm >> 4) : 16;
                if (fq == 0) {
                    const float* rsp = rsb + u.pm * 256 + wr * 64 + fr;
#pragma unroll
                    for (int g = 0; g < 8; ++g) __builtin_amdgcn_global_load_lds((const unsigned*)(rsp + (g >> 2) * 128 + (g & 3) * 16), (LAS unsigned*)(pw + g * 16), 4, 0, 0);
                    if constexpr (kind != EPI_FFN_UP) {
                        const float* sw = (const float*)q4 + (size_t)bidx * 5632 + u.pn * 256 + (fr >> 3) * 128 + wc * 32 + (fr & 7) * 4;
                        __builtin_amdgcn_global_load_lds((const unsigned*)sw, (LAS unsigned*)(pw + 128), 16, 0, 0);
                    }
                }
                if constexpr (kind == EPI_FFN_UP) {
                    const int wid = wr * 4 + wc;
                    if (wid < 5) {
                        const float* cw = (const float*)q1; const float* cb = (const float*)q2; const float* shw = (const float*)q5 + (size_t)bidx * 5632 + u.pn * 256;
                        const int i4 = (wid * 64 + fq * 16 + fr) * 4, bjw = i4 / 640, rem = i4 % 640, kw = rem >> 7, c_ = rem & 127;
                        const float* srcw = kw < 3 ? cw + kw * 5632 + bjw * 2816 + u.pn * 128 + c_ : kw == 3 ? cb + bjw * 2816 + u.pn * 128 + c_ : shw + bjw * 128 + c_;
                        __builtin_amdgcn_global_load_lds((const unsigned*)srcw, (LAS unsigned*)(xch + WIMG_F + par * 1280 + wid * 256), 16, 0, 0);
                    }
                }
            }
        }
    }
    template <int kind> DI void run(const f32x4 (&acc)[2][2][4][2], const Pre& P, const pg8::Unit& u, int wr, int wc, int fr, int fq, int par) const {
        asm volatile("" : "+v"(fr), "+v"(fq));
        if constexpr (kind == EPI_FFN_UP) { ffn_up(acc, u, wr, wc, fr, fq, par); return; }
        if constexpr (kind == EPI_RESID) {
            const float* base_l = (const float*)q0; const float* base_c = (const float*)q1; float* out_l = (float*)q2; unsigned char* wsb = (unsigned char*)q3; float* out_c = (float*)(wsb + WS_XC);
            const float* modl = (const float*)q4; const float* gnext = (const float*)q5;
            const int bidx = u.pm < 256 ? (u.pm >> 4) : 16;
            const float* gv = modl + (size_t)bidx * 6144 + (ldc ? 5 * 1024 : 2 * 1024);
            const float* bp = u.pm < 256 ? base_l + (size_t)u.pm * 256 * 1024 : base_c + (size_t)(u.pm - 256) * 256 * 1024;
            float* op = u.pm < 256 ? out_l + (size_t)u.pm * 256 * 1024 : out_c + (size_t)(u.pm - 256) * 256 * 1024;
            const int col0 = u.pn * 256 + wc * 32 + 8 * fq;
            f32x4 gt[2][2], gn[2][2];
#pragma unroll
            for (int bj = 0; bj < 2; ++bj)
#pragma unroll
                for (int n = 0; n < 2; ++n) gt[bj][n] = *(const f32x4*)(gv + col0 + bj * 128 + n * 4);
            if (gnext) {
                const float* scn = ldc ? modl + (size_t)(17 + bidx) * 6144 + 1024 : modl + (size_t)bidx * 6144 + 4 * 1024;
#pragma unroll
                for (int bj = 0; bj < 2; ++bj)
#pragma unroll
                    for (int n = 0; n < 2; ++n) gn[bj][n] = *(const f32x4*)(gnext + col0 + bj * 128 + n * 4) * (*(const f32x4*)(scn + col0 + bj * 128 + n * 4) + 1.0f);
            }
            bf16_t* xs = (bf16_t*)(wsb + (ldc ? WS_H : WS_XSA)) + (size_t)u.pm * 256 * 1024;
            float* rs = (float*)(wsb + WS_RS) + (ldc ? MR : 0) + u.pm * 256;
            f32x4 bsA[4], bsB[4];
#define RS_LOAD(K, DST) do { const size_t off_ = (size_t)(((K) >> 2) * 128 + wr * 64 + ((K) & 3) * 16 + fr) * 1024 + col0; \
                _Pragma("unroll") for (int q_ = 0; q_ < 4; ++q_) DST[q_] = *(const f32x4*)(bp + off_ + (q_ >> 1) * 128 + (q_ & 1) * 4); } while (0)
#define RS_DO(K, SRC) do { const int ai_ = (K) >> 2, m_ = (K) & 3; const int rl = ai_ * 128 + wr * 64 + m_ * 16 + fr; const size_t off = (size_t)rl * 1024 + col0; float ssq = 0.f; \
                _Pragma("unroll") for (int bj = 0; bj < 2; ++bj) { \
                    const f32x4 xa = SRC[2 * bj] + gt[bj][0] * acc[ai_][bj][m_][0], xb = SRC[2 * bj + 1] + gt[bj][1] * acc[ai_][bj][m_][1]; \
                    *(f32x4*)(op + off + bj * 128) = xa; *(f32x4*)(op + off + bj * 128 + 4) = xb; \
                    if (gnext) { ssq += xa[0] * xa[0] + xa[1] * xa[1] + xa[2] * xa[2] + xa[3] * xa[3] + xb[0] * xb[0] + xb[1] * xb[1] + xb[2] * xb[2] + xb[3] * xb[3]; \
                        const f32x4 ya = xa * gn[bj][0], yb = xb * gn[bj][1]; \
                        u32x4 w; w.x = cvt_pk_bf16(ya[0], ya[1]); w.y = cvt_pk_bf16(ya[2], ya[3]); w.z = cvt_pk_bf16(yb[0], yb[1]); w.w = cvt_pk_bf16(yb[2], yb[3]); \
                        *(u32x4*)(xs + off + bj * 128) = w; } } \
                if (gnext) { ssq += __shfl_xor(ssq, 16); ssq += __shfl_xor(ssq, 32); if (fq == 0) unsafeAtomicAdd(rs + rl, ssq); } } while (0)
            RS_LOAD(0, bsA);
            RS_LOAD(1, bsB); RS_DO(0, bsA);
            RS_LOAD(2, bsA); RS_DO(1, bsB);
            RS_LOAD(3, bsB); RS_DO(2, bsA);
            RS_LOAD(4, bsA); RS_DO(3, bsB);
            RS_LOAD(5, bsB); RS_DO(4, bsA);
            RS_LOAD(6, bsA); RS_DO(5, bsB);
            RS_LOAD(7, bsB); RS_DO(6, bsA);
            RS_DO(7, bsB);
#undef RS_LOAD
#undef RS_DO
            return;
        } else {
        bf16_t* O = (bf16_t*)q0; float* lr = (float*)q1; bf16_t* KB = (bf16_t*)q0; bf16_t* VB = (bf16_t*)q1;
        const int rowt = u.pm * 256 + wr * 64 + fr;
        f32x4 swv[2][2]; float rsv[2][4];
        float krs[2][4]; f32x4 kg0, kg1;
        if constexpr (kind == EPI_UKV) {
            LAS float* P = xch;
#pragma unroll
            for (int ai = 0; ai < 2; ++ai)
#pragma unroll
                for (int m = 0; m < 4; ++m) {
                    const f32x4 a = acc[ai][0][m][0], b = acc[ai][0][m][1];
                    float t = a[0] * a[0] + a[1] * a[1] + a[2] * a[2] + a[3] * a[3] + b[0] * b[0] + b[1] * b[1] + b[2] * b[2] + b[3] * b[3];
                    t += __shfl_xor(t, 16); t += __shfl_xor(t, 32);
                    if (fq == 0) P[(ai * 128 + wr * 64 + m * 16 + fr) * 4 + wc] = t;
                }
            asm volatile("s_waitcnt lgkmcnt(0)" ::: "memory"); __builtin_amdgcn_s_barrier(); asm volatile("" ::: "memory");
#pragma unroll
            for (int ai = 0; ai < 2; ++ai)
#pragma unroll
                for (int m = 0; m < 4; ++m) { const f32x4 t4 = *(const LAS f32x4*)(P + (ai * 128 + wr * 64 + m * 16 + fr) * 4); krs[ai][m] = rsqrtf((t4[0] + t4[1] + t4[2] + t4[3]) * (1.0f / 128.0f) + 1e-6f); }
            { const LAS float* pw = xch + PREW_F + (wr * 4 + wc) * 192 + 128 + 8 * fq; kg0 = *(const LAS f32x4*)pw; kg1 = *(const LAS f32x4*)(pw + 4); }
        }
        if constexpr (kind == EPI_GLA_IN || kind == EPI_BF16) {
            if (q3) { const LAS float* pw = xch + PREW_F + (wr * 4 + wc) * 192;
#pragma unroll
                for (int g = 0; g < 8; ++g) rsv[g >> 2][g & 3] = pw[g * 16 + fr];
#pragma unroll
                for (int bj = 0; bj < 2; ++bj) { swv[bj][0] = *(const LAS f32x4*)(pw + 128 + bj * 32 + 8 * fq); swv[bj][1] = *(const LAS f32x4*)(pw + 128 + bj * 32 + 8 * fq + 4); } }
        }
#pragma unroll
        for (int ai = 0; ai < 2; ++ai)
#pragma unroll
            for (int m = 0; m < 4; ++m) {
                const int row = rowt + ai * 128 + m * 16;
#pragma unroll
                for (int bj = 0; bj < 2; ++bj) {
                    f32x4 v0 = acc[ai][bj][m][0], v1 = acc[ai][bj][m][1];
                    const int cin = bj * 128 + wc * 32 + 8 * fq;
                    if constexpr (kind == EPI_GLA_IN || kind == EPI_BF16) {
                        if (q3) {
                            const float rstd = rsqrtf(rsv[ai][m] * (1.0f / 1024.0f) + 1e-6f);
                            v0 = v0 * rstd + swv[bj][0]; v1 = v1 * rstd + swv[bj][1];
                        }
                    }
                    if constexpr (kind == EPI_GLA_IN) {
                        if (u.pn == 12) {
                            if (bj == 0 && wc == 0) { float* lp = lr + (size_t)row * 32 + 8 * fq; *(f32x4*)lp = v0; *(f32x4*)(lp + 4) = v1; }
                            continue;
                        }
                        if (u.pn < 2) { v0 *= 0.08838834764831845f; v1 *= 0.08838834764831845f; }
                    }
                    u32x4 w; w.x = cvt_pk_bf16(v0[0], v0[1]); w.y = cvt_pk_bf16(v0[2], v0[3]); w.z = cvt_pk_bf16(v1[0], v1[1]); w.w = cvt_pk_bf16(v1[2], v1[3]);
                    if constexpr (kind == EPI_GLA_IN) {
                        if (u.pn < 4) *(u32x4*)(O + (size_t)row * 1024 + u.pn * 256 + cin) = w;
                        else *(u32x4*)((bf16_t*)q2 + (size_t)row * 2048 + (u.pn - 4) * 256 + cin) = w;
                    } else if constexpr (kind == EPI_UKV) {
                        if (bj == 0) { const f32x4 n0 = v0 * krs[ai][m] * kg0, n1 = v1 * krs[ai][m] * kg1;
                            w.x = cvt_pk_bf16(n0[0], n0[1]); w.y = cvt_pk_bf16(n0[2], n0[3]); w.z = cvt_pk_bf16(n1[0], n1[1]); w.w = cvt_pk_bf16(n1[2], n1[3]); }
                        int key;
                        if (u.pm < 256) { const int b = u.pm >> 4; key = b * KEYS + CTXL + (row - b * SEQ); }
                        else { const int b = u.pm - 256; key = b * KEYS + (row - TL - b * CTXL); }
                        const int cc = wc * 32 + 8 * fq;
                        if (bj == 0) *(u32x4*)(KB + (size_t)key * 1536 + u.pn * 192 + cc) = w;
                        else *(u32x4*)(VB + (size_t)key * 1024 + u.pn * 128 + cc) = w;
                    } else {
                        *(u32x4*)(O + (size_t)row * ldc + u.pn * 256 + cin) = w;
                    }
                }
            }
        }
    }
};

DI void prep_phase(const Params& p, LAS unsigned char* lds) {
    const int tid = tid_opq();
    unsigned char* ws = (unsigned char*)p.in[opq(27)];
    LAS float* tl = (LAS float*)lds;
    const float* in_c = p.in[opq(1)]; const float* in_cctx = p.in[opq(3)]; const float* in_wada = p.in[opq(4)]; const float* in_bada = p.in[opq(5)];
    const float* in_gin = p.in[opq(8)]; const float* in_w1 = p.in[opq(9)]; const float* in_gout = p.in[opq(13)]; const float* in_mdown = p.in[opq(14)];
    const float* in_uq = p.in[opq(17)]; const float* in_ukv = p.in[opq(18)]; const float* in_mout = p.in[opq(21)]; const float* in_fup = p.in[opq(22)]; const float* in_fdown = p.in[opq(25)];
    constexpr int T0 = 1536, T2 = 512, T3 = 352, T4 = 288, T5 = 256, T6 = 512, T7 = 5632, T8 = 2816;
    constexpr int NTILE = T0 + T2 + T3 + T4 + T5 + T6 + T7 + T8;
    for (int t = blockIdx.x; t < NTILE; t += gridDim.x) {
        const float* src; int N, k0, n0, ld; bf16_t* dst;
        int q = t;
        if (q < T0) { const int j = q / 768, r = q % 768, kt = r / 48, nt = r % 48; src = in_gin + (size_t)j * 1024 * 3072; N = 3072; k0 = kt * 64; n0 = nt * 64;
            dst = (bf16_t*)(ws + WS_GIN + j * SZ_GIN) + (size_t)n0 * 1024 + k0; ld = 1024; }
        else if ((q -= T0) < T2) { const int j = q / 256, r = q % 256, kt = r / 16, nt = r % 16; src = in_gout + (size_t)j * 1024 * 1024; N = 1024; k0 = kt * 64; n0 = nt * 64;
            dst = (bf16_t*)(ws + WS_GOUT + j * SZ_SQ) + (size_t)n0 * 1024 + k0; ld = 1024; }
        else if ((q -= T2) < T3) { const int j = q / 176, r = q % 176, kt = r / 11, nt = r % 11; src = in_mdown + (size_t)j * 1024 * 704; N = 704; k0 = kt * 64; n0 = nt * 64;
            dst = (bf16_t*)(ws + WS_MDOWN + j * SZ_MDOWN) + (size_t)n0 * 1024 + k0; ld = 1024; }
        else if ((q -= T3) < T4) { const int j = q / 144, r = q % 144, kt = r / 24, nt = r % 24; src = in_uq + (size_t)j * 384 * 1536; N = 1536; k0 = kt * 64; n0 = nt * 64;
            dst = (bf16_t*)(ws + WS_MUQ + j * SZ_MUQ) + (size_t)n0 * 384 + k0; ld = 384; }
        else if ((q -= T4) < T5) { const int j = q / 128, r = q % 128, kt = r / 32, nt = r % 32; src = in_ukv + (size_t)j * 256 * 2048; N = 2048; k0 = kt * 64; n0 = nt * 64;
            dst = (bf16_t*)(ws + WS_MUKV + j * SZ_MUKV) + (size_t)n0 * 256 + k0; ld = 256; }
        else if ((q -= T5) < T6) { const int j = q / 256, r = q % 256, kt = r / 16, nt = r % 16; src = in_mout + (size_t)j * 1024 * 1024; N = 1024; k0 = kt * 64; n0 = nt * 64;
            dst = (bf16_t*)(ws + WS_MOUT + j * SZ_SQ) + (size_t)n0 * 1024 + k0; ld = 1024; }
        else if ((q -= T6) < T7) { const int i = q / 1408, r = q % 1408, kt = r / 88, nt = r % 88; src = in_fup + (size_t)i * 1024 * 5632; N = 5632; k0 = kt * 64; n0 = nt * 64;
            const int isg = n0 >= DFF ? 1 : 0, cc = n0 - isg * DFF, drow = (cc >> 7) * 256 + isg * 128 + (cc & 127);
            dst = (bf16_t*)(ws + WS_FUP + (size_t)i * SZ_FUP) + (size_t)drow * 1024 + k0; ld = 1024; }
        else { q -= T7; const int i = q / 704, r = q % 704, kt = r / 16, nt = r % 16; src = in_fdown + (size_t)i * 2816 * 1024; N = 1024; k0 = kt * 64; n0 = nt * 64;
            dst = (bf16_t*)(ws + WS_FDOWN + (size_t)i * SZ_FDOWN) + (size_t)n0 * 2816 + k0; ld = 2816; }
#pragma unroll
        for (int i = 0; i < 8; ++i) { const int r = (tid >> 6) + 8 * i, c = tid & 63; tl[c * 65 + r] = src[(size_t)(k0 + r) * N + n0 + c]; }
        __syncthreads();
#pragma unroll
        for (int i = 0; i < 4; ++i) { const int rr = (tid >> 5) + 16 * i, c2 = (tid & 31) * 2; const float a = tl[rr * 65 + c2], b = tl[rr * 65 + c2 + 1];
            *(unsigned*)(dst + (size_t)rr * ld + c2) = cvt_pk_bf16(a, b); }
        __syncthreads();
    }
    const int gtid = blockIdx.x * NTHREADS + tid, gstride = gridDim.x * NTHREADS;
    for (int idx = gtid; idx < 65536; idx += gstride) {
        const int k = idx & 1023, r = (idx >> 10) & 15, dir = (idx >> 14) & 1, j = idx >> 15;
        const float v = in_w1[((size_t)(j * 2 + dir) * 1024 + k) * 16 + r];
        ((bf16_t*)(ws + WS_GIN + j * SZ_GIN))[(size_t)(3072 + dir * 16 + r) * 1024 + k] = f2bf(v);
    }
    for (int idx = gtid; idx < 2 * 114688; idx += gstride) { const int j = idx / 114688, o = idx % 114688; ((unsigned*)(ws + WS_GIN + j * SZ_GIN + 3104ull * 1024 * 2))[o] = 0u; }
    for (int idx = gtid; idx < 2 * 32768; idx += gstride) { const int j = idx / 32768, o = idx % 32768; ((unsigned*)(ws + WS_MDOWN + j * SZ_MDOWN + 704ull * 1024 * 2))[o] = 0u; }
    for (int idx = gtid; idx < MR; idx += gstride) ((float*)(ws + WS_RS))[idx] = 0.f;
    LAS float* sl = (LAS float*)lds;
    LAS float* red = (LAS float*)(lds + 81920);
    __syncthreads();
    for (int idx = tid; idx < 17 * 1024; idx += NTHREADS) { const int r = idx >> 10, k = idx & 1023; const float v = r < 16 ? in_c[r * 1024 + k] : in_cctx[k]; sl[k * 20 + r] = v / (1.0f + __expf(-v)); }
    __syncthreads();
    float* mod = (float*)(ws + WS_MOD);
    for (int it = blockIdx.x; it < 384; it += gridDim.x) {
        const int layer = it / 96, n0 = (it % 96) * 64, nn = tid & 63, ks = tid >> 6;
        const float* W = in_wada + (size_t)layer * 1024 * 6144 + n0 + nn;
        float acc[17];
#pragma unroll
        for (int r = 0; r < 17; ++r) acc[r] = 0.f;
        for (int kk = 0; kk < 128; ++kk) {
            const int k = ks * 128 + kk; const float w = W[(size_t)k * 6144];
            const f32x4 s0 = *(const LAS f32x4*)(sl + k * 20), s1 = *(const LAS f32x4*)(sl + k * 20 + 4), s2 = *(const LAS f32x4*)(sl + k * 20 + 8), s3 = *(const LAS f32x4*)(sl + k * 20 + 12);
            const float s16 = sl[k * 20 + 16];
#pragma unroll
            for (int j = 0; j < 4; ++j) { acc[j] += s0[j] * w; acc[4 + j] += s1[j] * w; acc[8 + j] += s2[j] * w; acc[12 + j] += s3[j] * w; }
            acc[16] += s16 * w;
        }
#pragma unroll
        for (int r = 0; r < 17; ++r) red[(ks * 17 + r) * 64 + nn] = acc[r];
        __syncthreads();
        for (int o = tid; o < 17 * 64; o += NTHREADS) { const int r = o >> 6, c = o & 63; float s = in_bada[layer * 6144 + n0 + c];
#pragma unroll
            for (int k8 = 0; k8 < 8; ++k8) s += red[(k8 * 17 + r) * 64 + c];
            mod[(size_t)(layer * 17 + r) * 6144 + n0 + c] = s; }
        __syncthreads();
    }
}

DI void shw_phase(unsigned char* ws, LAS unsigned char* lds) {
    const int tid = tid_opq(), wave = tid >> 6, lane = tid & 63;
    LAS float* sl = (LAS float*)lds;
    const float* mod = (const float*)(ws + WS_MOD);
    constexpr int NCH = 4 * 44 + 6 + 26 + 6;
    for (int ch = blockIdx.x; ch < NCH; ch += gridDim.x) {
        int layer, kind, n0; const bf16_t* Bt;
        if (ch < 176) { layer = ch / 44; kind = 1; n0 = (ch % 44) * 128; Bt = (const bf16_t*)(ws + WS_FUP + (size_t)layer * SZ_FUP); }
        else if (ch < 182) { layer = 1; kind = 0; n0 = (ch - 176) * 128; Bt = (const bf16_t*)(ws + WS_MDOWN); }
        else if (ch < 208) { layer = 2; kind = 0; n0 = (ch - 182) * 128; Bt = (const bf16_t*)(ws + WS_GIN + SZ_GIN); }
        else { layer = 3; kind = 0; n0 = (ch - 208) * 128; Bt = (const bf16_t*)(ws + WS_MDOWN + SZ_MDOWN); }
        __syncthreads();
        for (int idx = tid; idx < 17 * 256; idx += NTHREADS) { const int b = idx >> 8, k4 = (idx & 255) * 4;
            *(LAS f32x4*)(sl + b * 1024 + k4) = *(const f32x4*)(mod + (size_t)(layer * 17 + b) * 6144 + (kind ? 3 * 1024 : 0) + k4); }
        __syncthreads();
        float* out = (float*)(ws + WS_SHW) + (size_t)((layer * 2 + kind) * 17) * 5632;
#pragma unroll 1
        for (int i = 0; i < 16; ++i) {
            const int n = n0 + wave * 16 + i;
            float w[16];
#pragma unroll
            for (int j = 0; j < 4; ++j) { const u32x2 t = *(const u32x2*)(Bt + (size_t)n * 1024 + j * 256 + lane * 4); w[4 * j] = bf_lo(t.x); w[4 * j + 1] = bf_hi(t.x); w[4 * j + 2] = bf_lo(t.y); w[4 * j + 3] = bf_hi(t.y); }
            float mine = 0.f;
#pragma unroll 1
            for (int b = 0; b < 17; ++b) {
                float a = 0.f;
#pragma unroll
                for (int j = 0; j < 4; ++j) { const f32x4 sv = *(const LAS f32x4*)(sl + b * 1024 + j * 256 + lane * 4); a += sv[0] * w[4 * j] + sv[1] * w[4 * j + 1] + sv[2] * w[4 * j + 2] + sv[3] * w[4 * j + 3]; }
                a = wave_sum(a);
                if (lane == b) mine = a;
            }
            if (lane < 17) out[(size_t)lane * 5632 + n] = mine;
        }
    }
    __syncthreads();
}

DI void norm_phase(const float* xl, const float* xc, const float* gain, const float* modl, int sh_off, int sc_off, bf16_t* h) {
    const int tid = tid_opq(), wave = tid >> 6, lane = tid & 63;
    for (int row0 = (blockIdx.x * 8 + wave) * 4; row0 < MR; row0 += gridDim.x * 32) {
        const float* src = row0 < TL ? xl + (size_t)row0 * 1024 : xc + (size_t)(row0 - TL) * 1024;
        const float* mb = modl + (size_t)(row0 < TL ? (row0 >> 12) : 16) * 6144;
        f32x4 v[4][4]; float ss[4];
#pragma unroll
        for (int r = 0; r < 4; ++r)
#pragma unroll
            for (int i = 0; i < 4; ++i) v[r][i] = *(const f32x4*)(src + (size_t)r * 1024 + i * 256 + lane * 4);
#pragma unroll
        for (int r = 0; r < 4; ++r) { float t = 0.f;
#pragma unroll
            for (int i = 0; i < 4; ++i) t += v[r][i][0] * v[r][i][0] + v[r][i][1] * v[r][i][1] + v[r][i][2] * v[r][i][2] + v[r][i][3] * v[r][i][3];
            ss[r] = t; }
#pragma unroll
        for (int o = 32; o >= 1; o >>= 1) {
#pragma unroll
            for (int r = 0; r < 4; ++r) ss[r] += __shfl_xor(ss[r], o);
        }
#pragma unroll
        for (int i = 0; i < 4; ++i) {
            const int c = i * 256 + lane * 4;
            const f32x4 g = *(const f32x4*)(gain + c), sc = *(const f32x4*)(mb + sc_off + c), sh = *(const f32x4*)(mb + sh_off + c);
            const f32x4 gs = g * (sc + 1.0f);
#pragma unroll
            for (int r = 0; r < 4; ++r) {
                const float rstd = rsqrtf(ss[r] * (1.0f / 1024.0f) + 1e-6f);
                const f32x4 y = (v[r][i] * rstd) * gs + sh;
                u32x2 w; w.x = cvt_pk_bf16(y[0], y[1]); w.y = cvt_pk_bf16(y[2], y[3]);
                *(u32x2*)(h + (size_t)(row0 + r) * 1024 + c) = w;
            }
        }
    }
}

DI void scan_rowbase(int dir, int b, int c, int& rb, int& sg) {
    if (dir == 0) { sg = 1; rb = c < 4 ? TL + b * CTXL + c * 64 : b * SEQ + (c - 4) * 64; }
    else { sg = -1; rb = c < 4 ? TL + b * CTXL + 255 - c * 64 : b * SEQ + 4095 - (c - 4) * 64; }
}
struct GPStage { unsigned qv[8], kv[8]; f32x4 lrv; float w2r[16][2]; f32x2 gbias; };
DI void gp_load(GPStage& S, int item, const bf16_t* qk, const float* lr, const float* w2, const float* gb, int tid, int wave, int d0) {
    const int c = item % 68, rest = item / 68, h = rest & 3, dir = (rest >> 2) & 1, b = rest >> 3;
    int rowbase, sgn; scan_rowbase(dir, b, c, rowbase, sgn);
#pragma unroll
    for (int i = 0; i < 8; ++i) { const size_t ro = (size_t)(rowbase + sgn * (wave * 8 + i)) * 1024; S.qv[i] = *(const unsigned*)(qk + ro + h * 128 + d0); S.kv[i] = *(const unsigned*)(qk + ro + 512 + h * 128 + d0); }
    S.lrv = (f32x4){0.f, 0.f, 0.f, 0.f};
    if (tid < 256) S.lrv = *(const f32x4*)(lr + (size_t)(rowbase + sgn * (tid >> 2)) * 32 + dir * 16 + (tid & 3) * 4);
#pragma unroll
    for (int r = 0; r < 16; ++r) { const f32x2 t = *(const f32x2*)(w2 + (size_t)(dir * 16 + r) * 512 + h * 128 + d0); S.w2r[r][0] = t.x; S.w2r[r][1] = t.y; }
    S.gbias = *(const f32x2*)(gb + dir * 512 + h * 128 + d0);
}
DI void gp_item(const GPStage& S, int item, bf16_t* GQ, bf16_t* GK, bf16_t* GP, float* GE, LAS unsigned char* lds, int tid, int wave, int lane) {
    constexpr int QD = 0, KI = 17408, LRS = 34816, SEG = 38912;
    const int l15 = lane & 15, lq = lane >> 4, d0 = 2 * lane;
    if (tid < 256) *(LAS f32x4*)(lds + LRS + (tid >> 2) * 64 + (tid & 3) * 16) = S.lrv;
    __syncthreads();
    const LAS float* lrs = (const LAS float*)(lds + LRS);
    float bl0[8], bl1[8]; float cum0 = 0.f, cum1 = 0.f;
#pragma unroll
    for (int i = 0; i < 8; ++i) {
        const int s = wave * 8 + i;
        float z0 = S.gbias.x, z1 = S.gbias.y;
#pragma unroll
        for (int r4 = 0; r4 < 4; ++r4) { const f32x4 lv = *(const LAS f32x4*)(lrs + s * 16 + r4 * 4);
#pragma unroll
            for (int j = 0; j < 4; ++j) { z0 += lv[j] * S.w2r[r4 * 4 + j][0]; z1 += lv[j] * S.w2r[r4 * 4 + j][1]; } }
        const float g0 = (fminf(z0, 0.f) - __logf(1.0f + __expf(-fabsf(z0)))) * 0.0625f;
        const float g1 = (fminf(z1, 0.f) - __logf(1.0f + __expf(-fabsf(z1)))) * 0.0625f;
        cum0 += g0; cum1 += g1; bl0[i] = cum0; bl1[i] = cum1;
    }
    *(LAS f32x2*)(lds + SEG + (wave * 128 + d0) * 4) = (f32x2){cum0, cum1};
    __syncthreads();
    float off0 = 0.f, off1 = 0.f, tot0 = 0.f, tot1 = 0.f;
#pragma unroll
    for (int w = 0; w < 8; ++w) { const f32x2 t = *(const LAS f32x2*)(lds + SEG + (w * 128 + d0) * 4); tot0 += t.x; tot1 += t.y; if (w < wave) { off0 += t.x; off1 += t.y; } }
    const float et0 = __expf(tot0), et1 = __expf(tot1);
    if (wave == 0) *(f32x2*)(GE + (size_t)item * 128 + d0) = (f32x2){et0, et1};
    {
        unsigned ks0[4], ks1[4];
        bf16_t* gq = GQ + (size_t)item * 8192;
#pragma unroll
        for (int i = 0; i < 8; ++i) {
            const int s = wave * 8 + i;
            const float b0 = off0 + bl0[i], b1 = off1 + bl1[i];
            const float q0 = bf_lo(S.qv[i]), q1 = bf_hi(S.qv[i]), k0 = bf_lo(S.kv[i]), k1 = bf_hi(S.kv[i]);
            const float eb0 = __expf(b0), eb1 = __expf(b1), ib0 = __builtin_amdgcn_rcpf(eb0), ib1 = __builtin_amdgcn_rcpf(eb1);
            const unsigned qd = cvt_pk_bf16(q0 * eb0, q1 * eb1);
            *(LAS unsigned*)(lds + QD + s * 272 + d0 * 2) = qd;
            *(unsigned*)(gq + s * 128 + d0) = qd;
            *(LAS unsigned*)(lds + KI + s * 272 + d0 * 2) = cvt_pk_bf16(k0 * ib0, k1 * ib1);
            const float e0 = k0 * (et0 * ib0), e1 = k1 * (et1 * ib1);
            if (i & 1) { ks0[i >> 1] = (ks0[i >> 1] & 0xffffu) | (cvt_pk_bf16(0.f, e0) & 0xffff0000u); ks1[i >> 1] = (ks1[i >> 1] & 0xffffu) | (cvt_pk_bf16(0.f, e1) & 0xffff0000u); }
            else { ks0[i >> 1] = cvt_pk_bf16(e0, 0.f) & 0xffffu; ks1[i >> 1] = cvt_pk_bf16(e1, 0.f) & 0xffffu; }
        }
        bf16_t* gk = GK + (size_t)item * 8192;
        *(u32x4*)(gk + d0 * 64 + wave * 8) = (u32x4){ks0[0], ks0[1], ks0[2], ks0[3]};
        *(u32x4*)(gk + (d0 + 1) * 64 + wave * 8) = (u32x4){ks1[0], ks1[1], ks1[2], ks1[3]};
    }
    __syncthreads();
    {
        bf16_t* gp = GP + (size_t)item * 4096;
        const int t0 = 16 * (wave >> 1);
#pragma unroll
        for (int j = 0; j < 2; ++j) {
            const int s0 = 16 * ((wave & 1) * 2 + j);
            f32x4 a4 = (f32x4){0.f, 0.f, 0.f, 0.f};
#pragma unroll
            for (int kk = 0; kk < 4; ++kk) {
                const bf16x8 af = *(const LAS bf16x8*)(lds + QD + (t0 + l15) * 272 + (kk * 32 + 8 * lq) * 2);
                const bf16x8 bf = *(const LAS bf16x8*)(lds + KI + (s0 + l15) * 272 + (kk * 32 + 8 * lq) * 2);
                a4 = __builtin_amdgcn_mfma_f32_16x16x32_bf16(af, bf, a4, 0, 0, 0);
            }
            const int sc = s0 + l15;
#pragma unroll
            for (int r = 0; r < 4; ++r) { const int t = t0 + 4 * lq + r; gp[t * 64 + sc] = f2bf(sc <= t ? a4[r] : 0.f); }
        }
    }
}
DI void gateprep_phase(const bf16_t* qk, const float* lr, const float* w2, const float* gb, bf16_t* GQ, bf16_t* GK, bf16_t* GP, float* GE, LAS unsigned char* lds) {
    const int tid = tid_opq(), wave = __builtin_amdgcn_readfirstlane(tid >> 6), lane = tid & 63, d0 = 2 * lane;
    const int G = gridDim.x;
    GPStage A, B;
    int item = opq((int)blockIdx.x);
    if (item < NCHI) gp_load(A, item, qk, lr, w2, gb, tid, wave, d0);
    for (; item < NCHI; item += 2 * G) {
        if (item + G < NCHI) gp_load(B, item + G, qk, lr, w2, gb, tid, wave, d0);
        gp_item(A, item, GQ, GK, GP, GE, lds, tid, wave, lane);
        if (item + G < NCHI) {
            if (item + 2 * G < NCHI) gp_load(A, item + 2 * G, qk, lr, w2, gb, tid, wave, d0);
            gp_item(B, item + G, GQ, GK, GP, GE, lds, tid, wave, lane);
        }
    }
    __syncthreads();
}

DI void scan_phase(const bf16_t* vr, const bf16_t* GQ, const bf16_t* GK, const bf16_t* GP, const float* GE, bf16_t* of, bf16_t* ob, LAS unsigned char* lds) {
    constexpr int QD = 0, KST = 17408, VT = 35840, ST = 54272, PP = 89088, BL = 98304;
    const int tid = tid_opq(), wave = __builtin_amdgcn_readfirstlane(tid >> 6), lane = tid & 63;
    const int l31 = lane & 31, lh = lane >> 5;
    for (int item = blockIdx.x; item < 256; item += gridDim.x) {
        const int xcd_ = item & 7, slot_ = item >> 3, dvh = slot_ & 1, pair_ = (slot_ >> 1) * 8 + xcd_;
        const int b = pair_ >> 3, dir = (pair_ >> 2) & 1, h = pair_ & 3;
        bf16_t* obuf = dir ? ob : of;
        const int d0 = 2 * lane;
        const int gi0 = ((b * 2 + dir) * 4 + h) * 68;
        f32x16 Sacc[2];
#pragma unroll
        for (int i = 0; i < 16; ++i) { Sacc[0][i] = 0.f; Sacc[1][i] = 0.f; }
        __syncthreads();
        { unsigned z_ = 0u; asm volatile("" : "+v"(z_));
          for (int o = tid; o < 34816 / 16; o += NTHREADS) *(LAS u32x4*)(lds + ST + o * 16) = (u32x4){z_, z_, z_, z_}; }
        const int vcol = h * 256 + dvh * 128 + d0;
        struct ScStage { u32x4 gq0, gq1, gk0, gk1, gp0; unsigned vv[8]; float ebv; } A, B;
        A.ebv = 0.f; B.ebv = 0.f;
#define SCAN_LOAD(S, c) do { int rb_, sg_; scan_rowbase(dir, b, (c), rb_, sg_); const size_t gi_ = (size_t)(gi0 + (c)); \
        S.gq0 = *(const u32x4*)(GQ + gi_ * 8192 + tid * 8); S.gq1 = *(const u32x4*)(GQ + gi_ * 8192 + 4096 + tid * 8); \
        S.gk0 = *(const u32x4*)(GK + gi_ * 8192 + tid * 8); S.gk1 = *(const u32x4*)(GK + gi_ * 8192 + 4096 + tid * 8); \
        S.gp0 = *(const u32x4*)(GP + gi_ * 4096 + tid * 8); if (tid < 128) S.ebv = GE[gi_ * 128 + tid]; \
        _Pragma("unroll") for (int i = 0; i < 8; ++i) S.vv[i] = *(const unsigned*)(vr + (size_t)(rb_ + sg_ * (wave * 8 + i)) * 2048 + vcol); } while (0)
#define SCAN_CHUNK(S, c) do { \
            int rowbase, sgn; scan_rowbase(dir, b, (c), rowbase, sgn); \
            { const int e0 = tid * 8, e1 = 4096 + tid * 8; \
              *(LAS u32x4*)(lds + QD + (e0 >> 7) * 272 + (e0 & 127) * 2) = S.gq0; *(LAS u32x4*)(lds + QD + (e1 >> 7) * 272 + (e1 & 127) * 2) = S.gq1; \
              *(LAS u32x4*)(lds + KST + (e0 >> 6) * 144 + (e0 & 63) * 2) = S.gk0; *(LAS u32x4*)(lds + KST + (e1 >> 6) * 144 + (e1 & 63) * 2) = S.gk1; \
              *(LAS u32x4*)(lds + PP + (e0 >> 6) * 144 + (e0 & 63) * 2) = S.gp0; \
              if (tid < 128) *(LAS float*)(lds + BL + tid * 4) = S.ebv; \
              unsigned vt0[4], vt1[4]; \
              _Pragma("unroll") for (int i = 0; i < 8; ++i) { \
                  if (i & 1) { vt0[i >> 1] = (vt0[i >> 1] & 0xffffu) | (S.vv[i] << 16); vt1[i >> 1] = (vt1[i >> 1] & 0xffffu) | (S.vv[i] & 0xffff0000u); } \
                  else { vt0[i >> 1] = S.vv[i] & 0xffffu; vt1[i >> 1] = S.vv[i] >> 16; } } \
              *(LAS u32x4*)(lds + VT + d0 * 144 + wave * 16) = (u32x4){vt0[0], vt0[1], vt0[2], vt0[3]}; \
              *(LAS u32x4*)(lds + VT + (d0 + 1) * 144 + wave * 16) = (u32x4){vt1[0], vt1[1], vt1[2], vt1[3]}; \
            } \
            __syncthreads();     \
            if ((c) + 2 < 68) SCAN_LOAD(S, (c) + 2); \
            { \
                const int tq = wave >> 2, vq = wave & 3; \
                f32x16 oacc; \
                _Pragma("unroll") for (int i = 0; i < 16; ++i) oacc[i] = 0.f; \
                _Pragma("unroll") for (int kk = 0; kk < 8; ++kk) { \
                    const bf16x8 af = *(const LAS bf16x8*)(lds + QD + (32 * tq + l31) * 272 + (kk * 16 + 8 * lh) * 2); \
                    const bf16x8 bf = *(const LAS bf16x8*)(lds + ST + (32 * vq + l31) * 272 + (kk * 16 + 8 * lh) * 2); \
                    oacc = __builtin_amdgcn_mfma_f32_32x32x16_bf16(af, bf, oacc, 0, 0, 0); } \
                _Pragma("unroll") for (int kk = 0; kk < 4; ++kk) { \
                    const bf16x8 af = *(const LAS bf16x8*)(lds + PP + (32 * tq + l31) * 144 + (kk * 16 + 8 * lh) * 2); \
                    const bf16x8 bf = *(const LAS bf16x8*)(lds + VT + (32 * vq + l31) * 144 + (kk * 16 + 8 * lh) * 2); \
                    oacc = __builtin_amdgcn_mfma_f32_32x32x16_bf16(af, bf, oacc, 0, 0, 0); } \
                const int ocol = h * 256 + dvh * 128 + 32 * vq + l31; \
                _Pragma("unroll") for (int r = 0; r < 16; ++r) { const int t = 32 * tq + crow(r, lh); obuf[(size_t)(rowbase + sgn * t) * 1024 + ocol] = f2bf(oacc[r]); } \
            } \
            { \
                const int vq = wave & 3; \
                _Pragma("unroll") for (int j = 0; j < 2; ++j) { \
                    const int dq = 2 * (wave >> 2) + j; \
                    _Pragma("unroll") for (int r = 0; r < 16; ++r) Sacc[j][r] *= *(const LAS float*)(lds + BL + (32 * dq + crow(r, lh)) * 4); \
                    _Pragma("unroll") for (int kk = 0; kk < 4; ++kk) { \
                        const bf16x8 af = *(const LAS bf16x8*)(lds + KST + (32 * dq + l31) * 144 + (kk * 16 + 8 * lh) * 2); \
                        const bf16x8 bf = *(const LAS bf16x8*)(lds + VT + (32 * vq + l31) * 144 + (kk * 16 + 8 * lh) * 2); \
                        Sacc[j] = __builtin_amdgcn_mfma_f32_32x32x16_bf16(af, bf, Sacc[j], 0, 0, 0); } } \
            } \
            __syncthreads();     \
            { \
                const int vq = wave & 3; \
                _Pragma("unroll") for (int j = 0; j < 2; ++j) { \
                    const int dq = 2 * (wave >> 2) + j; \
                    _Pragma("unroll") for (int g = 0; g < 4; ++g) { \
                        u32x2 w; w.x = cvt_pk_bf16(Sacc[j][4 * g], Sacc[j][4 * g + 1]); w.y = cvt_pk_bf16(Sacc[j][4 * g + 2], Sacc[j][4 * g + 3]); \
                        *(LAS u32x2*)(lds + ST + (32 * vq + l31) * 272 + (32 * dq + 8 * g + 4 * lh) * 2) = w; } } \
            } } while (0)
        SCAN_LOAD(A, 0); SCAN_LOAD(B, 1);
        for (int c = 0; c < 68; c += 2) { SCAN_CHUNK(A, c); SCAN_CHUNK(B, c + 1); }
#undef SCAN_CHUNK
#undef SCAN_LOAD
    }
    __syncthreads();
}

DI void glapost_phase(const bf16_t* of, const bf16_t* ob, const bf16_t* vr, const float* onorm, bf16_t* a) {
    const int tid = tid_opq(), wave = tid >> 6, lane = tid & 63;
    const int c0 = lane * 16;
    float gn[16];
#pragma unroll
    for (int j = 0; j < 4; ++j) { const f32x4 t = *(const f32x4*)(onorm + (c0 & 255) + 4 * j); gn[4 * j] = t[0]; gn[4 * j + 1] = t[1]; gn[4 * j + 2] = t[2]; gn[4 * j + 3] = t[3]; }
    for (int row0 = (blockIdx.x * 8 + wave) * 4; row0 < MR; row0 += gridDim.x * 32) {
        u32x4 f0[4], f1[4], b0[4], b1[4], r0[4], r1[4];
#pragma unroll
        for (int q = 0; q < 4; ++q) { const size_t ro = (size_t)(row0 + q);
            f0[q] = *(const u32x4*)(of + ro * 1024 + c0); f1[q] = *(const u32x4*)(of + ro * 1024 + c0 + 8);
            b0[q] = *(const u32x4*)(ob + ro * 1024 + c0); b1[q] = *(const u32x4*)(ob + ro * 1024 + c0 + 8);
            r0[q] = *(const u32x4*)(vr + ro * 2048 + 1024 + c0); r1[q] = *(const u32x4*)(vr + ro * 2048 + 1024 + c0 + 8); }
        asm volatile("" ::: "memory");
#pragma unroll
        for (int q = 0; q < 4; ++q) {
            float o[16], rr[16];
#pragma unroll
            for (int j = 0; j < 4; ++j) {
                o[2 * j] = bf_lo(f0[q][j]) + bf_lo(b0[q][j]); o[2 * j + 1] = bf_hi(f0[q][j]) + bf_hi(b0[q][j]);
                o[8 + 2 * j] = bf_lo(f1[q][j]) + bf_lo(b1[q][j]); o[8 + 2 * j + 1] = bf_hi(f1[q][j]) + bf_hi(b1[q][j]);
                rr[2 * j] = bf_lo(r0[q][j]); rr[2 * j + 1] = bf_hi(r0[q][j]); rr[8 + 2 * j] = bf_lo(r1[q][j]); rr[8 + 2 * j + 1] = bf_hi(r1[q][j]);
            }
            float ss = 0.f;
#pragma unroll
            for (int j = 0; j < 16; ++j) ss += o[j] * o[j];
            ss += __shfl_xor(ss, 1); ss += __shfl_xor(ss, 2); ss += __shfl_xor(ss, 4); ss += __shfl_xor(ss, 8);
            const float rstd = rsqrtf(ss * (1.0f / 256.0f) + 1e-6f);
            unsigned w[8];
#pragma unroll
            for (int j = 0; j < 8; ++j) {
                const float y0 = o[2 * j] * rstd * gn[2 * j] * silu_f(rr[2 * j]), y1 = o[2 * j + 1] * rstd * gn[2 * j + 1] * silu_f(rr[2 * j + 1]);
                w[j] = cvt_pk_bf16(y0, y1);
            }
            *(u32x4*)(a + (size_t)(row0 + q) * 1024 + c0) = (u32x4){w[0], w[1], w[2], w[3]};
            *(u32x4*)(a + (size_t)(row0 + q) * 1024 + c0 + 8) = (u32x4){w[4], w[5], w[6], w[7]};
        }
    }
}

DI void rope_cs(int tpos, int lane, float& cs, float& sn) {
    const int f = lane & 15; const int pos = (lane >> 5) ? (tpos & 63) : (tpos >> 6);
    const float inv = exp2f(-(float)f * (13.287712379549449f / 16.0f));
    const float ang = (float)pos * inv;
    const float kf = rintf(ang * 0.15915494309189535f);
    float r = fmaf(-kf, 6.2831854820251465f, ang); r = fmaf(-kf, -1.7484556000744883e-7f, r);
    cs = __cosf(r); sn = __sinf(r);
}
DI float rope_apply(float y, int lane, float cs, float sn) {
    const float pr = __shfl_xor(y, 16);
    return (lane & 16) ? (pr * sn + y * cs) : (y * cs - pr * sn);
}
DI int key_of_row(int row) {
    if (row < TL) { const int b = row >> 12; return b * KEYS + CTXL + (row & 4095); }
    const int rc = row - TL; const int b = rc >> 8; return b * KEYS + (rc & 255);
}

DI void mlamid_phase(const bf16_t* dn, const float* qln, const float* kvln, const float* knorm, bf16_t* cqn, bf16_t* ckvn, bf16_t* KB) {
    const int tid = tid_opq(), wave = tid >> 6, lane = tid & 63;
    float gq[6];
#pragma unroll
    for (int i = 0; i < 3; ++i) { gq[2 * i] = qln[i * 128 + 2 * lane]; gq[2 * i + 1] = qln[i * 128 + 2 * lane + 1]; }
    const f32x4 gkv = *(const f32x4*)(kvln + 4 * lane);
    const float gpe = knorm[128 + lane];
    for (int row0 = (blockIdx.x * 8 + wave) * 4; row0 < MR; row0 += gridDim.x * 32) {
        unsigned q[4][3]; u32x2 kvv[4]; bf16_t pe[4];
#pragma unroll
        for (int r = 0; r < 4; ++r) { const bf16_t* src = dn + (size_t)(row0 + r) * 768;
#pragma unroll
            for (int i = 0; i < 3; ++i) q[r][i] = *(const unsigned*)(src + i * 128 + 2 * lane);
            kvv[r] = *(const u32x2*)(src + 384 + 4 * lane); pe[r] = src[640 + lane]; }
#pragma unroll
        for (int r = 0; r < 4; ++r) {
            const int row = row0 + r;
            float ss = 0.f;
#pragma unroll
            for (int i = 0; i < 3; ++i) { const float a = bf_lo(q[r][i]), b = bf_hi(q[r][i]); ss += a * a + b * b; }
            ss = wave_sum(ss);
            float rstd = rsqrtf(ss * (1.0f / 384.0f) + 1e-6f);
#pragma unroll
            for (int i = 0; i < 3; ++i) *(unsigned*)(cqn + (size_t)row * 384 + i * 128 + 2 * lane) = cvt_pk_bf16(bf_lo(q[r][i]) * rstd * gq[2 * i], bf_hi(q[r][i]) * rstd * gq[2 * i + 1]);
            const float k0 = bf_lo(kvv[r].x), k1 = bf_hi(kvv[r].x), k2 = bf_lo(kvv[r].y), k3 = bf_hi(kvv[r].y);
            ss = wave_sum(k0 * k0 + k1 * k1 + k2 * k2 + k3 * k3);
            rstd = rsqrtf(ss * (1.0f / 256.0f) + 1e-6f);
            { u32x2 w; w.x = cvt_pk_bf16(k0 * rstd * gkv[0], k1 * rstd * gkv[1]); w.y = cvt_pk_bf16(k2 * rstd * gkv[2], k3 * rstd * gkv[3]);
              *(u32x2*)(ckvn + (size_t)row * 256 + 4 * lane) = w; }
            const float x = __uint_as_float(((unsigned)pe[r]) << 16);
            ss = wave_sum(x * x);
            rstd = rsqrtf(ss * (1.0f / 64.0f) + 1e-6f);
            float y = x * rstd * gpe;
            if (row < TL) { float cs, sn; rope_cs(row & 4095, lane, cs, sn); y = rope_apply(y, lane, cs, sn); }
            const bf16_t yb = f2bf(y);
            bf16_t* kd = KB + (size_t)key_of_row(row) * 1536 + 128 + lane;
#pragma unroll
            for (int hh = 0; hh < 8; ++hh) kd[hh * 192] = yb;
        }
    }
}

DI void qkprep_phase(bf16_t* KB, const float* knorm) {
    const int tid = tid_opq(), wave = tid >> 6, lane = tid & 63;
    const float kn0 = knorm[2 * lane], kn1 = knorm[2 * lane + 1];
    for (int row0 = (blockIdx.x * 8 + wave) * 2; row0 < MR; row0 += gridDim.x * 16) {
        unsigned ka[2][8];
        bf16_t* kr0 = KB + (size_t)key_of_row(row0) * 1536; bf16_t* kr1 = KB + (size_t)key_of_row(row0 + 1) * 1536;
#pragma unroll
        for (int hh = 0; hh < 8; ++hh) { ka[0][hh] = *(const unsigned*)(kr0 + hh * 192 + 2 * lane); ka[1][hh] = *(const unsigned*)(kr1 + hh * 192 + 2 * lane); }
        asm volatile("" ::: "memory");
#pragma unroll
        for (int r = 0; r < 2; ++r) {
            bf16_t* kr = r ? kr1 : kr0;
#pragma unroll
            for (int hh = 0; hh < 8; ++hh) {
                const float c0 = bf_lo(ka[r][hh]), c1 = bf_hi(ka[r][hh]);
                const float s3 = wave_sum(c0 * c0 + c1 * c1);
                const float r3 = rsqrtf(s3 * (1.0f / 128.0f) + 1e-6f);
                *(unsigned*)(kr + hh * 192 + 2 * lane) = cvt_pk_bf16(c0 * r3 * kn0, c1 * r3 * kn1);
            }
        }
    }
}

namespace att {
constexpr int DQK = 192, DV = 128, NW = 8, QBLK = 32, KVBLK = 64;
constexpr int LDQ = 1536, LDK = 1536, LDV = 1024, LDO = 1024;
constexpr float SCALE = 0.07216878364870322f;
constexpr float THR = 8.f;
constexpr size_t SHM_V = KVBLK * DV * 2, SHM_K = KVBLK * DQK * 2;
#define KSWZ(row, colB) ((row) * 384 + ((colB) ^ ((((row) >> 1) & 7) << 4)))
#define SBAR() __builtin_amdgcn_sched_barrier(0)
DI unsigned cvtpk(float lo, float hi) { unsigned r; asm volatile("v_cvt_pk_bf16_f32 %0, %1, %2" : "=v"(r) : "v"(lo), "v"(hi)); return r; }
DI void partialSM(f32x16& p0, f32x16& p1, float& m_reg, float& mn, float& alpha) {
    constexpr float C = SCALE * 1.4426950408889634f;
    float pmax = p0[0];
#pragma unroll
    for (int r = 1; r < 16; ++r) pmax = fmaxf(pmax, p0[r]);
#pragma unroll
    for (int r = 0; r < 16; ++r) pmax = fmaxf(pmax, p1[r]);
    { auto rr = __builtin_amdgcn_permlane32_swap(__float_as_uint(pmax), __float_as_uint(pmax), false, false);
      pmax = fmaxf(__uint_as_float(rr[0]), __uint_as_float(rr[1])); }
    if (__builtin_expect(__all(pmax - m_reg <= THR / SCALE), 1)) { mn = m_reg; alpha = 1.f; }
    else { mn = fmaxf(m_reg, pmax); alpha = __builtin_amdgcn_exp2f((m_reg - mn) * C); m_reg = mn; }
    const float mnC = -mn * C;
#pragma unroll
    for (int r = 0; r < 16; ++r) p0[r] = fmaf(p0[r], C, mnC);
#pragma unroll
    for (int r = 0; r < 16; ++r) p1[r] = fmaf(p1[r], C, mnC);
#pragma unroll
    for (int r = 0; r < 16; ++r) p0[r] = __builtin_amdgcn_exp2f(p0[r]);
}
DI void finishSM(f32x16& p0, f32x16& p1, float alpha, float& l_reg, bf16x8& pa0, bf16x8& pa1, bf16x8& pa2, bf16x8& pa3) {
#pragma unroll
    for (int r = 0; r < 16; ++r) p1[r] = __builtin_amdgcn_exp2f(p1[r]);
    float ps = 0;
#pragma unroll
    for (int r = 0; r < 16; ++r) ps += p0[r];
#pragma unroll
    for (int r = 0; r < 16; ++r) ps += p1[r];
    { auto rr = __builtin_amdgcn_permlane32_swap(__float_as_uint(ps), __float_as_uint(ps), false, false);
      ps = __uint_as_float(rr[0]) + __uint_as_float(rr[1]); }
    l_reg = l_reg * alpha + ps;
#define PK4(P, BASE, OUT) do { unsigned a0 = cvtpk(P[BASE + 0], P[BASE + 1]), a1 = cvtpk(P[BASE + 2], P[BASE + 3]);   \
    unsigned b0 = cvtpk(P[BASE + 4], P[BASE + 5]), b1 = cvtpk(P[BASE + 6], P[BASE + 7]);                              \
    auto r0 = __builtin_amdgcn_permlane32_swap(a0, b0, false, false); auto r1 = __builtin_amdgcn_permlane32_swap(a1, b1, false, false); \
    u32x4 w = {r0[0], r1[0], r0[1], r1[1]}; OUT = *reinterpret_cast<bf16x8*>(&w); } while (0)
    PK4(p0, 0, pa0); PK4(p0, 8, pa1); PK4(p1, 0, pa2); PK4(p1, 8, pa3);
#undef PK4
}
DI void qkt(f32x16& p0, f32x16& p1, const char* Ks, const bf16x8* qr, int r32, int hi) {
#pragma unroll
    for (int r = 0; r < 16; ++r) { p0[r] = 0.f; p1[r] = 0.f; }
    bf16x8 ka[3], kb[3];
#define QK_RD(D0, SLOT) do { const int cb_ = ((D0) * 16 + hi * 8) * 2; ka[SLOT] = *reinterpret_cast<const bf16x8*>(Ks + KSWZ(r32, cb_)); kb[SLOT] = *reinterpret_cast<const bf16x8*>(Ks + KSWZ(32 + r32, cb_)); } while (0)
    QK_RD(0, 0); QK_RD(1, 1);
    __builtin_amdgcn_sched_barrier(0);
#pragma unroll
    for (int d0 = 0; d0 < 12; ++d0) {
        if (d0 + 2 < 12) QK_RD(d0 + 2, (d0 + 2) % 3);
        p0 = __builtin_amdgcn_mfma_f32_32x32x16_bf16(ka[d0 % 3], qr[d0], p0, 0, 0, 0);
        p1 = __builtin_amdgcn_mfma_f32_32x32x16_bf16(kb[d0 % 3], qr[d0], p1, 0, 0, 0);
        __builtin_amdgcn_sched_barrier(0);
    }
#undef QK_RD
}
DI int v_st(int k, int c) { const int kk = (k & ~0xC) | ((k & 4) << 1) | ((k & 8) >> 1); return ((kk >> 3) * 4 + (c >> 5)) * 512 + ((kk & 7) * 32 + (c & 31)) * 2; }
DI int v_rd_base(int lane) { return ((lane & 3) << 3) | (((lane >> 2) & 3) << 6) | (((lane >> 4) & 1) << 5) | (((lane >> 5) & 1) << 8); }
constexpr int v_rd_off(int d0, int ks, int half) { return d0 * 512 + ks * 4096 + half * 2048; }
template <int OFF> DI s16x4 tr_read(int vb) { s16x4 r; asm volatile("ds_read_b64_tr_b16 %0, %1 offset:%2" : "=&v"(r) : "v"(vb), "i"(OFF) : "memory"); return r; }
template <int D0> DI void pv_one(f32x16& od, int vb, bf16x8 pa0, bf16x8 pa1, bf16x8 pa2, bf16x8 pa3) {
    const s16x4 l0 = tr_read<v_rd_off(D0, 0, 0)>(vb), h0 = tr_read<v_rd_off(D0, 0, 1)>(vb), l1 = tr_read<v_rd_off(D0, 1, 0)>(vb), h1 = tr_read<v_rd_off(D0, 1, 1)>(vb);
    const s16x4 l2 = tr_read<v_rd_off(D0, 2, 0)>(vb), h2 = tr_read<v_rd_off(D0, 2, 1)>(vb), l3 = tr_read<v_rd_off(D0, 3, 0)>(vb), h3 = tr_read<v_rd_off(D0, 3, 1)>(vb);
    asm volatile("s_waitcnt lgkmcnt(0)" ::: "memory"); SBAR();
#define PK(L, H) (bf16x8){L[0], L[1], L[2], L[3], H[0], H[1], H[2], H[3]}
    od = __builtin_amdgcn_mfma_f32_32x32x16_bf16(pa0, PK(l0, h0), od, 0, 0, 0);
    od = __builtin_amdgcn_mfma_f32_32x32x16_bf16(pa1, PK(l1, h1), od, 0, 0, 0);
    od = __builtin_amdgcn_mfma_f32_32x32x16_bf16(pa2, PK(l2, h2), od, 0, 0, 0);
    od = __builtin_amdgcn_mfma_f32_32x32x16_bf16(pa3, PK(l3, h3), od, 0, 0, 0);
#undef PK
}
DI void pv_d0(f32x16* o, int vb, bf16x8 pa0, bf16x8 pa1, bf16x8 pa2, bf16x8 pa3) {
    pv_one<0>(o[0], vb, pa0, pa1, pa2, pa3); pv_one<1>(o[1], vb, pa0, pa1, pa2, pa3); pv_one<2>(o[2], vb, pa0, pa1, pa2, pa3); pv_one<3>(o[3], vb, pa0, pa1, pa2, pa3);
}
DI void attn_body(const bf16_t* __restrict__ Qb, const bf16_t* __restrict__ Kh, const bf16_t* __restrict__ Vh, bf16_t* __restrict__ Ob, int seq, char* lds, const float* __restrict__ qnorm, int tpos0) {
    const int tid = tid_opq(), wid = tid >> 6, lane = tid & 63, r32 = lane & 31, hi = lane >> 5;
    char* V_lds = lds; char* K_lds = lds + 2 * SHM_V;
    float* wsf = (float*)(lds + 2 * SHM_V + 2 * SHM_K) + wid * 64; float* li_l = wsf; float* al_l = wsf + 32;
    float m_reg = -1e30f, l_reg = 0; f32x16 o[4]; bf16x8 qr[12];
#pragma unroll
    for (int d = 0; d < 4; ++d)
#pragma unroll
        for (int r = 0; r < 16; ++r) o[d][r] = 0.f;
    const bf16_t* Qw = Qb + (long)(wid * QBLK + r32) * LDQ + hi * 8;
#pragma unroll
    for (int d0 = 0; d0 < 12; ++d0) qr[d0] = *reinterpret_cast<const bf16x8*>(Qw + d0 * 16);
    {
        float ssn = 0.f, ssr = 0.f;
#pragma unroll
        for (int d0 = 0; d0 < 12; ++d0) {
            const u32x4 w = *reinterpret_cast<const u32x4*>(&qr[d0]); float t = 0.f;
#pragma unroll
            for (int j = 0; j < 4; ++j) { const float a = bf_lo(w[j]), b = bf_hi(w[j]); t += a * a + b * b; }
            if (d0 < 8) ssn += t; else ssr += t;
        }
        ssn += __shfl_xor(ssn, 32); ssr += __shfl_xor(ssr, 32);
        const float rn = rsqrtf(ssn * (1.0f / 128.0f) + 1e-6f), rr = rsqrtf(ssr * (1.0f / 64.0f) + 1e-6f);
        float cs[2][8], sn[2][8];
        if (tpos0 >= 0) {
            const int t = tpos0 + wid * QBLK + r32;
#pragma unroll
            for (int a = 0; a < 2; ++a) { const float pos = (float)(a ? (t & 63) : (t >> 6));
#pragma unroll
                for (int j = 0; j < 8; ++j) { const float inv = exp2f(-(float)(hi * 8 + j) * (13.287712379549449f / 16.0f)); const float ang = pos * inv;
                    const float kf = rintf(ang * 0.15915494309189535f); float r = fmaf(-kf, 6.2831854820251465f, ang); r = fmaf(-kf, -1.7484556000744883e-7f, r);
                    cs[a][j] = __cosf(r); sn[a][j] = __sinf(r); } }
        } else {
#pragma unroll
            for (int a = 0; a < 2; ++a)
#pragma unroll
                for (int j = 0; j < 8; ++j) { cs[a][j] = 1.f; sn[a][j] = 0.f; }
        }
#pragma unroll
        for (int d0 = 0; d0 < 8; ++d0) {
            const u32x4 w = *reinterpret_cast<const u32x4*>(&qr[d0]); const float* gp = qnorm + d0 * 16 + hi * 8; const f32x4 g0 = *(const f32x4*)gp, g1 = *(const f32x4*)(gp + 4);
            u32x4 o4; o4.x = cvt_pk_bf16(bf_lo(w.x) * rn * g0[0], bf_hi(w.x) * rn * g0[1]); o4.y = cvt_pk_bf16(bf_lo(w.y) * rn * g0[2], bf_hi(w.y) * rn * g0[3]);
            o4.z = cvt_pk_bf16(bf_lo(w.z) * rn * g1[0], bf_hi(w.z) * rn * g1[1]); o4.w = cvt_pk_bf16(bf_lo(w.w) * rn * g1[2], bf_hi(w.w) * rn * g1[3]);
            qr[d0] = *reinterpret_cast<const bf16x8*>(&o4);
        }
#pragma unroll
        for (int a = 0; a < 2; ++a) {
            const u32x4 w1 = *reinterpret_cast<const u32x4*>(&qr[8 + 2 * a]), w2 = *reinterpret_cast<const u32x4*>(&qr[9 + 2 * a]);
            const float* g1p = qnorm + (8 + 2 * a) * 16 + hi * 8; const float* g2p = g1p + 16;
            float x1[8], x2[8], y1[8], y2[8];
#pragma unroll
            for (int j = 0; j < 4; ++j) { x1[2 * j] = bf_lo(w1[j]) * rr * g1p[2 * j]; x1[2 * j + 1] = bf_hi(w1[j]) * rr * g1p[2 * j + 1]; x2[2 * j] = bf_lo(w2[j]) * rr * g2p[2 * j]; x2[2 * j + 1] = bf_hi(w2[j]) * rr * g2p[2 * j + 1]; }
#pragma unroll
            for (int j = 0; j < 8; ++j) { y1[j] = x1[j] * cs[a][j] - x2[j] * sn[a][j]; y2[j] = x1[j] * sn[a][j] + x2[j] * cs[a][j]; }
            u32x4 o1, o2;
            o1.x = cvt_pk_bf16(y1[0], y1[1]); o1.y = cvt_pk_bf16(y1[2], y1[3]); o1.z = cvt_pk_bf16(y1[4], y1[5]); o1.w = cvt_pk_bf16(y1[6], y1[7]);
            o2.x = cvt_pk_bf16(y2[0], y2[1]); o2.y = cvt_pk_bf16(y2[2], y2[3]); o2.z = cvt_pk_bf16(y2[4], y2[5]); o2.w = cvt_pk_bf16(y2[6], y2[7]);
            qr[8 + 2 * a] = *reinterpret_cast<const bf16x8*>(&o1); qr[9 + 2 * a] = *reinterpret_cast<const bf16x8*>(&o2);
        }
    }
    const int sr = tid >> 4, sc = (tid & 15) * 8, vst0 = v_st(sr, sc), vst1 = v_st(32 + sr, sc);
    const int pr = tid >> 3, pc = 128 + (tid & 7) * 8;
    const int vb0 = (int)(uintptr_t)V_lds + v_rd_base(lane);
    bf16x8 vs0, vs1, ks0, ks1, kp;
#define SLOAD(k0) do { vs0 = *reinterpret_cast<const bf16x8*>(&Vh[(long)((k0) + sr) * LDV + sc]); vs1 = *reinterpret_cast<const bf16x8*>(&Vh[(long)((k0) + 32 + sr) * LDV + sc]); \
    ks0 = *reinterpret_cast<const bf16x8*>(&Kh[(long)((k0) + sr) * LDK + sc]); ks1 = *reinterpret_cast<const bf16x8*>(&Kh[(long)((k0) + 32 + sr) * LDK + sc]); \
    kp = *reinterpret_cast<const bf16x8*>(&Kh[(long)((k0) + pr) * LDK + pc]); } while (0)
#define SWRITE(b) do { *(bf16x8*)(V_lds + (b) * SHM_V + vst0) = vs0; *(bf16x8*)(V_lds + (b) * SHM_V + vst1) = vs1; \
    *(bf16x8*)(K_lds + (b) * SHM_K + KSWZ(sr, sc * 2)) = ks0; *(bf16x8*)(K_lds + (b) * SHM_K + KSWZ(32 + sr, sc * 2)) = ks1; \
    *(bf16x8*)(K_lds + (b) * SHM_K + KSWZ(pr, pc * 2)) = kp; } while (0)
#define RESC(a) do { if (__any((a) < 1.f)) { if (hi == 0) al_l[r32] = (a); asm volatile("s_waitcnt lgkmcnt(0)" ::: "memory"); \
    _Pragma("unroll") for (int d = 0; d < 4; ++d) _Pragma("unroll") for (int r = 0; r < 16; ++r) o[d][r] *= al_l[crow(r, hi)]; } } while (0)
    f32x16 p0, p1; float mn, al; bf16x8 pa0, pa1, pa2, pa3; const int NT = seq / KVBLK;
    SLOAD(0); asm volatile("s_waitcnt vmcnt(0)" ::: "memory"); SWRITE(0); __syncthreads();
    for (int j = 0; j < NT; ++j) {
        const int cb = j & 1;
        if (j + 1 < NT) SLOAD((j + 1) * KVBLK);
        SBAR(); qkt(p0, p1, K_lds + cb * SHM_K, qr, r32, hi);
        partialSM(p0, p1, m_reg, mn, al);
        finishSM(p0, p1, al, l_reg, pa0, pa1, pa2, pa3);
        RESC(al); SBAR();
        pv_d0(o, vb0 + cb * (int)SHM_V, pa0, pa1, pa2, pa3);
        if (j + 1 < NT) { asm volatile("s_waitcnt vmcnt(0)" ::: "memory"); SWRITE(cb ^ 1); }
        __syncthreads();
    }
    if (hi == 0) li_l[r32] = l_reg; asm volatile("s_waitcnt lgkmcnt(0)" ::: "memory");
    float rli[16];
#pragma unroll
    for (int r = 0; r < 16; ++r) rli[r] = __builtin_amdgcn_rcpf(li_l[crow(r, hi)]);
    bf16_t* Ow = Ob + (long)(wid * QBLK) * LDO;
#pragma unroll
    for (int r = 0; r < 16; ++r) { const int orow = crow(r, hi);
#pragma unroll
        for (int d0 = 0; d0 < 4; ++d0) Ow[(long)orow * LDO + d0 * 32 + r32] = f2bf(o[d0][r] * rli[r]); }
#undef SLOAD
#undef SWRITE
#undef RESC
}
#undef KSWZ
#undef SBAR
}

DI void attn_phase(const bf16_t* Q, const bf16_t* KB, const bf16_t* VB, bf16_t* O, char* lds, int nitems, const float* qnorm) {
    for (int it = blockIdx.x; it < nitems; it += gridDim.x) {
        int b, h, qrow0, seq, tpos0;
        if (it < 2048) {
            const int rnd = it >> 8, blk = it & 255, xcd_ = blk & 7, slot_ = blk >> 3, idx = rnd * 16 + xcd_ * 2 + (slot_ >> 4);
            b = idx >> 3; h = idx & 7; tpos0 = (slot_ & 15) * 256; qrow0 = b * SEQ + tpos0; seq = KEYS; }
        else { const int j = it - 2048; b = j >> 3; h = j & 7; qrow0 = TL + b * CTXL; seq = CTXL; tpos0 = -1; }
        att::attn_body(Q + (size_t)qrow0 * 1536 + h * 192, KB + (size_t)b * KEYS * 1536 + h * 192, VB + (size_t)b * KEYS * 1024 + h * 128,
                       O + (size_t)qrow0 * 1024 + h * 128, seq, lds, qnorm, tpos0);
        __syncthreads();
    }
}

DI void fixup_phase(const float* halo, const float* cw, const float* cb, bf16_t* act) {
    const int gtid = blockIdx.x * NTHREADS + tid_opq(), gstride = gridDim.x * NTHREADS;
    for (int idx = gtid; idx < 272 * 22 * 64; idx += gstride) {
        const int c4 = (idx & 31) * 4, which = (idx >> 5) & 1, t = idx >> 6, pn = t % 22, pm = t / 22;
        const float* hp = halo + (size_t)(pm * 22 + pn) * 4 * 256;
        const bool sfirst = pm >= 256 || (pm & 15) == 0, slast = pm >= 256 || (pm & 15) == 15;
        const f32x4 z4 = (f32x4){0.f, 0.f, 0.f, 0.f};
        f32x4 pa, pg, ca, cg_, na, ng; int row;
        if (which == 0) { row = pm * 256;
            if (sfirst) { pa = z4; pg = z4; } else { const float* q = halo + (size_t)((pm - 1) * 22 + pn) * 4 * 256 + 3 * 256; pa = *(const f32x4*)(q + c4); pg = *(const f32x4*)(q + 128 + c4); }
            ca = *(const f32x4*)(hp + c4); cg_ = *(const f32x4*)(hp + 128 + c4); na = *(const f32x4*)(hp + 256 + c4); ng = *(const f32x4*)(hp + 256 + 128 + c4);
        } else { row = pm * 256 + 255;
            pa = *(const f32x4*)(hp + 2 * 256 + c4); pg = *(const f32x4*)(hp + 2 * 256 + 128 + c4); ca = *(const f32x4*)(hp + 3 * 256 + c4); cg_ = *(const f32x4*)(hp + 3 * 256 + 128 + c4);
            if (slast) { na = z4; ng = z4; } else { const float* q = halo + (size_t)((pm + 1) * 22 + pn) * 4 * 256; na = *(const f32x4*)(q + c4); ng = *(const f32x4*)(q + 128 + c4); }
        }
        const int ch = pn * 128 + c4;
        const f32x4 w0a = *(const f32x4*)(cw + ch), w1a = *(const f32x4*)(cw + 5632 + ch), w2a = *(const f32x4*)(cw + 2 * 5632 + ch), ba = *(const f32x4*)(cb + ch);
        const f32x4 w0g = *(const f32x4*)(cw + 2816 + ch), w1g = *(const f32x4*)(cw + 5632 + 2816 + ch), w2g = *(const f32x4*)(cw + 2 * 5632 + 2816 + ch), bg = *(const f32x4*)(cb + 2816 + ch);
        const f32x4 av = w0a * pa + w1a * ca + w2a * na + ba, gv = w0g * pg + w1g * cg_ + w2g * ng + bg;
        u32x2 w; w.x = cvt_pk_bf16(silu_f(gv[0]) * av[0], silu_f(gv[1]) * av[1]); w.y = cvt_pk_bf16(silu_f(gv[2]) * av[2], silu_f(gv[3]) * av[3]);
        *(u32x2*)(act + (size_t)row * 2816 + ch) = w;
    }
}


#define XB_TMO      128
#define XB_XCNT(j)  (256  + 64 * (j))
#define XB_XSUB(j)  (1280 + 64 * (j))
#define XB_XGEN(j)  (2304 + 64 * (j))
#define XB_TOP      3328
#define XB_TOPGEN   3392
#define XCD_BAR_WORDS 3456
#define XB_SPIN_CAP (1u << 18)
DI unsigned xb_ld(unsigned* p)              { return __hip_atomic_load(p, __ATOMIC_RELAXED, __HIP_MEMORY_SCOPE_AGENT); }
DI unsigned xb_add(unsigned* p, unsigned v) { return __hip_atomic_fetch_add(p, v, __ATOMIC_RELAXED, __HIP_MEMORY_SCOPE_AGENT); }
DI unsigned xb_xcc_id() { return (unsigned)__builtin_amdgcn_s_getreg((3 << 11) | 20) & 0xFu; }
#define XB_SPIN(cond, bar) do { unsigned _sp = 0; while (cond) { __builtin_amdgcn_s_sleep(1); \
    if ((++_sp & 255u) == 0u) { if (xb_ld(&(bar)[XB_TMO])) break; if (_sp > XB_SPIN_CAP) { atomicAdd(&(bar)[XB_TMO], 1u); break; } } } } while (0)
struct XcdBarrier { unsigned* bar; unsigned x; volatile LAS unsigned* st; };
DI XcdBarrier xcd_barrier_post(unsigned* bar, volatile LAS unsigned* st) {
    XcdBarrier b; b.bar = bar; b.x = xb_xcc_id(); b.st = st;
    if (threadIdx.x == 0) (void)xb_add(&bar[XB_XCNT(b.x)], 1u);
    return b;
}
DI void xcd_barrier_complete(unsigned* bar, unsigned x, unsigned& nloc, unsigned& nx) {
    const unsigned G = gridDim.x * gridDim.y * gridDim.z;
    unsigned sum, cnt, mine, sp = 0u;
    for (;;) {
        sum = 0u; cnt = 0u; mine = 0u;
#pragma unroll
        for (unsigned j = 0; j < 16; ++j) { const unsigned c = xb_ld(&bar[XB_XCNT(j)]); sum += c; cnt += (c > 0u) ? 1u : 0u; mine = (j == x) ? c : mine; }
        if (sum == G) break;
        __builtin_amdgcn_s_sleep(1);
        if ((++sp & 255u) == 0u) { if (xb_ld(&bar[XB_TMO])) break; if (sp > XB_SPIN_CAP) { atomicAdd(&bar[XB_TMO], 1u); break; } }
    }
    nloc = mine > 0u ? mine : 1u; nx = cnt > 0u ? cnt : 1u;
}
DI void xcd_barrier(const XcdBarrier& b) {
    asm volatile("s_waitcnt vmcnt(0)" ::: "memory");
    __syncthreads();
    if (threadIdx.x == 0) {
        unsigned* bar = b.bar;
        __builtin_amdgcn_s_waitcnt(0);
        unsigned nloc = b.st[0], nx = b.st[1];
        if (nloc == 0u) { xcd_barrier_complete(bar, b.x, nloc, nx); b.st[0] = nloc; b.st[1] = nx; }
        const unsigned old = xb_add(&bar[XB_XSUB(b.x)], 1u);
        const unsigned gen = old / nloc;
        if (old + 1u == (gen + 1u) * nloc) {
            __builtin_amdgcn_fence(__ATOMIC_RELEASE, "agent");
            asm volatile("s_waitcnt vmcnt(0)" ::: "memory");
            const unsigned og = xb_add(&bar[XB_TOP], 1u);
            const unsigned tg = og / nx;
            if (og + 1u == (tg + 1u) * nx) xb_add(&bar[XB_TOPGEN], 1u);
            else XB_SPIN(xb_ld(&bar[XB_TOPGEN]) == tg, bar);
            __builtin_amdgcn_fence(__ATOMIC_ACQUIRE, "agent");
            xb_add(&bar[XB_XGEN(b.x)], 1u);
            asm volatile("s_waitcnt vmcnt(0)" ::: "memory");
        } else {
            XB_SPIN(xb_ld(&bar[XB_XGEN(b.x)]) == gen, bar);
            __builtin_amdgcn_fence(__ATOMIC_ACQUIRE, "agent");
            asm volatile("s_waitcnt vmcnt(0)" ::: "memory");
        }
    }
    __syncthreads();
}

__global__ void __launch_bounds__(NTHREADS) mega(Params p) {
    extern __shared__ __attribute__((aligned(16))) unsigned char smem[];
    LAS unsigned char* lds = (LAS unsigned char*)smem;
    cg::grid_group grid = cg::this_grid();
    volatile LAS unsigned* xb_st = (volatile LAS unsigned*)(lds + XB_ST_OFF);
    if (threadIdx.x < 4) xb_st[threadIdx.x] = 0u;
    __syncthreads();
    XcdBarrier xbar = xcd_barrier_post((unsigned*)((unsigned char*)p.in[27] + WS_BAR), xb_st);

    for (int ph = p.ph_lo; ph < p.ph_hi; ++ph) {
        unsigned char* ws = (unsigned char*)p.in[opq(27)];
        float* const xout = (float*)p.in[opq(26)];
        float* mod = (float*)(ws + WS_MOD);
        float* xc = (float*)(ws + WS_XC);
        bf16_t* hbuf = (bf16_t*)(ws + WS_H);
        if (ph == 0) {
            prep_phase(p, lds);
#if defined(MK_DUP_OP) && MK_DUP_OP == 99
            grid.sync(); prep_phase(p, lds);
#endif
        } else {
            const int q = ph - 1, lp = q / 21; int r = q % 21; int layer, nmix;
            if (r < 10) { layer = 2 * lp; nmix = 6; } else { layer = 2 * lp + 1; r -= 10; nmix = 7; }
            const bool is_mla = layer & 1; const int j = layer >> 1;
            const float* modl = mod + (size_t)layer * 17 * 6144;
            const bool first = (layer == 0);
            int op = -1, gsel = 0, hf = 0;
            if (r < nmix) {
                if (!is_mla) { op = r == 0 ? 0 : r == 1 ? 2 : r == 2 ? 9 : r == 3 ? 3 : r == 4 ? 4 : 2; gsel = r == 1 ? 0 : 1; }
                else { op = r == 0 ? 0 : r == 1 ? 2 : r == 2 ? 5 : r == 3 ? 2 : r == 4 ? 6 : r == 5 ? 7 : 2; gsel = r == 1 ? 2 : r == 3 ? 3 : 5; }
            } else {
                const int f = r - nmix;
                op = f == 0 ? 1 : f == 2 ? 8 : 2; gsel = f == 1 ? 6 : 7;
            }
            if (op == 1 || op == 6 || (op == 0 && layer > 0)) continue;
#ifdef MK_DUP_OP
            for (int rep_ = 0; rep_ < ((op == MK_DUP_OP || (op == 2 && gsel == MK_DUP_OP - 100)) ? 2 : 1); ++rep_) {
            if (rep_) grid.sync();
#else
            {
#endif
            if (op == 0) {
                norm_phase(p.in[opq(0)], p.in[opq(2)], p.in[opq(6)], modl, 0, 1024, hbuf);
                shw_phase(ws, lds);
            } else if (op == 2) {
                const int ng = (gsel == 3) ? 2 : 1;
                for (int gi = 0; gi < ng; ++gi) {
                    pg8::Gemm g; Epi E; int kind = EPI_BF16;
                    E.ldc = 0; E.xch = (LAS float*)(lds + XCH_OFF); E.q0 = nullptr; E.q1 = nullptr; E.q2 = nullptr; E.q3 = nullptr; E.q4 = nullptr; E.q5 = nullptr;
                    float* const shw_mix = (float*)(ws + WS_SHW) + (size_t)(layer * 2) * 17 * 5632; float* const shw_ffn = shw_mix + 17 * 5632;
                    float* const rs0 = (float*)(ws + WS_RS); float* const rs1 = rs0 + MR;
                    g.M = MR;
                    const int gs = gsel + gi;
                    if (gs == 0) { g.A = hbuf; g.Bt = (const bf16_t*)(ws + WS_GIN + j * SZ_GIN); g.N = 3328; g.K = 1024; g.lda = 1024; g.ldb = 1024;
                        kind = EPI_GLA_IN; E.q0 = ws + WS_QK; E.ldc = 1024; E.q1 = ws + WS_LR; E.q2 = ws + WS_VR; if (!first) { E.q3 = rs1; E.q4 = shw_mix; } }
                    else if (gs == 1 || gs == 5) { g.A = hbuf; g.Bt = (const bf16_t*)(ws + (gs == 1 ? WS_GOUT : WS_MOUT) + j * SZ_SQ); g.N = 1024; g.K = 1024; g.lda = 1024; g.ldb = 1024;
                        kind = EPI_RESID; E.ldc = 0; E.q0 = (void*)(first ? p.in[opq(0)] : xout); E.q1 = (void*)(first ? p.in[opq(2)] : xc); E.q2 = xout; E.q3 = ws; E.q4 = (void*)modl; E.q5 = (void*)(p.in[opq(7)] + layer * 1024);
                        for (int i = blockIdx.x * NTHREADS + tid_opq(); i < MR; i += gridDim.x * NTHREADS) rs1[i] = 0.f; }
                    else if (gs == 2) { g.A = hbuf; g.Bt = (const bf16_t*)(ws + WS_MDOWN + j * SZ_MDOWN); g.N = 768; g.K = 1024; g.lda = 1024; g.ldb = 1024;
                        E.q0 = ws + WS_DN; E.ldc = 768; E.q3 = rs1; E.q4 = shw_mix; }
                    else if (gs == 3) { g.A = (const bf16_t*)(ws + WS_CQN); g.Bt = (const bf16_t*)(ws + WS_MUQ + j * SZ_MUQ); g.N = 1536; g.K = 384; g.lda = 384; g.ldb = 384;
                        E.q0 = ws + WS_QRAW; E.ldc = 1536; }
                    else if (gs == 4) { g.A = (const bf16_t*)(ws + WS_CKVN); g.Bt = (const bf16_t*)(ws + WS_MUKV + j * SZ_MUKV); g.N = 2048; g.K = 256; g.lda = 256; g.ldb = 256;
                        kind = EPI_UKV; E.q0 = ws + WS_KB; E.q1 = ws + WS_VB; E.q2 = (void*)(p.in[opq(20)] + j * 192); }
                    else if (gs == 6) { g.A = (const bf16_t*)(ws + WS_XSA); g.Bt = (const bf16_t*)(ws + WS_FUP + (size_t)layer * SZ_FUP); g.N = 5632; g.K = 1024; g.lda = 1024; g.ldb = 1024;
                        kind = EPI_FFN_UP; E.q0 = ws + WS_ACT; E.ldc = 2816; E.q1 = (void*)(p.in[opq(23)] + (size_t)layer * 3 * 2 * DFF); E.q2 = (void*)(p.in[opq(24)] + (size_t)layer * 2 * DFF);
                        E.q3 = ws + WS_HALO; E.q4 = rs0; E.q5 = shw_ffn; }
                    else { g.A = (const bf16_t*)(ws + WS_ACT); g.Bt = (const bf16_t*)(ws + WS_FDOWN + (size_t)layer * SZ_FDOWN); g.N = 1024; g.K = 2816; g.lda = 2816; g.ldb = 2816;
                        kind = EPI_RESID; E.ldc = 1; E.q0 = xout; E.q1 = xc; E.q2 = xout; E.q3 = ws; E.q4 = (void*)modl; E.q5 = layer < 3 ? (void*)(p.in[opq(6)] + (layer + 1) * 1024) : nullptr;
                        for (int i = blockIdx.x * NTHREADS + tid_opq(); i < MR; i += gridDim.x * NTHREADS) rs0[i] = 0.f; }
                    if (layer == 3 && (gs == 3 || gs == 5 || gs == 6 || gs == 7)) g.M = TL;
                    pg8::StaticOrder S; S.init(g.M, g.N, (int)gridDim.x, (int)blockIdx.x, (gs == 1 || gs == 5 || gs == 7) ? 1 : 0);
                    if (kind == EPI_BF16) pg8::gemm_phase<Epi, EPI_BF16>(lds, g, S, E);
                    else if (kind == EPI_GLA_IN) pg8::gemm_phase<Epi, EPI_GLA_IN>(lds, g, S, E);
                    else if (kind == EPI_RESID) pg8::gemm_phase<Epi, EPI_RESID>(lds, g, S, E);
                    else if (kind == EPI_UKV) pg8::gemm_phase<Epi, EPI_UKV>(lds, g, S, E);
                    else pg8::gemm_phase<Epi, EPI_FFN_UP>(lds, g, S, E);
                    __syncthreads();
                }
            } else if (op == 3) {
                scan_phase((const bf16_t*)(ws + WS_VR), (const bf16_t*)(ws + WS_GQ), (const bf16_t*)(ws + WS_GK), (const bf16_t*)(ws + WS_GP), (const float*)(ws + WS_GE),
                           hbuf, (bf16_t*)(ws + WS_QK), lds);
            } else if (op == 9) {
                gateprep_phase((const bf16_t*)(ws + WS_QK), (const float*)(ws + WS_LR), p.in[opq(10)] + (size_t)j * 2 * 16 * 512, p.in[opq(11)] + (size_t)j * 2 * 512,
                               (bf16_t*)(ws + WS_GQ), (bf16_t*)(ws + WS_GK), (bf16_t*)(ws + WS_GP), (float*)(ws + WS_GE), lds);
            } else if (op == 4) {
                glapost_phase(hbuf, (const bf16_t*)(ws + WS_QK), (const bf16_t*)(ws + WS_VR), p.in[opq(12)] + j * 256, hbuf);
            } else if (op == 5) {
                mlamid_phase((const bf16_t*)(ws + WS_DN), p.in[opq(15)] + j * 384, p.in[opq(16)] + j * 256, p.in[opq(20)] + j * 192, (bf16_t*)(ws + WS_CQN), (bf16_t*)(ws + WS_CKVN), (bf16_t*)(ws + WS_KB));
            } else if (op == 6) {
                qkprep_phase((bf16_t*)(ws + WS_KB), p.in[opq(20)] + j * 192);
            } else if (op == 7) {
                attn_phase((const bf16_t*)(ws + WS_QRAW), (const bf16_t*)(ws + WS_KB), (const bf16_t*)(ws + WS_VB), hbuf, (char*)smem, layer == 3 ? 2048 : 2048 + 128, p.in[opq(19)] + j * 192);
            } else if (op == 8) {
                fixup_phase((const float*)(ws + WS_HALO), p.in[opq(23)] + (size_t)layer * 3 * 2 * DFF, p.in[opq(24)] + (size_t)layer * 2 * DFF, (bf16_t*)(ws + WS_ACT));
            }
            }
        }
        if (ph + 1 < p.ph_hi) { if (p.ph_lo < 0) grid.sync(); else xcd_barrier(xbar); }
    }
}

extern "C" void kernel_launch(void* const* d_in, const int* in_sizes, int n_in, void* d_out, int out_size, void* d_ws, size_t ws_size, hipStream_t stream) {
    static int grid = 0;
    if (grid == 0) {
        if (n_in != 26 || ws_size < WS_END) { fprintf(stderr, "kernel_launch: n_in %d ws %zu (need %zu)\n", n_in, ws_size, (size_t)WS_END); grid = -1; return; }
        int dev = 0, cus = 0, per_cu = 0;
        hipGetDevice(&dev);
        hipDeviceGetAttribute(&cus, hipDeviceAttributeMultiprocessorCount, dev);
        if (hipFuncSetAttribute((const void*)mega, hipFuncAttributeMaxDynamicSharedMemorySize, LDS_BYTES) != hipSuccess) { fprintf(stderr, "kernel_launch: hipFuncSetAttribute failed\n"); grid = -1; return; }
        if (hipOccupancyMaxActiveBlocksPerMultiprocessor(&per_cu, (const void*)mega, NTHREADS, LDS_BYTES) != hipSuccess || per_cu < 1) { fprintf(stderr, "kernel_launch: occupancy query %d\n", per_cu); per_cu = 1; }
        (void)hipGetLastError();
        grid = cus * per_cu;
        fprintf(stderr, "kernel_launch: grid %d (cus %d x %d)\n", grid, cus, per_cu);
    }
    if (grid < 0) return;
    Params p{};
    for (int i = 0; i < 26; ++i) p.in[i] = (const float*)d_in[i];
    p.in[26] = (const float*)d_out; p.in[27] = (const float*)d_ws;
    (void)hipMemsetAsync((unsigned char*)d_ws + WS_BAR, 0, 16384, stream);
#if MK_MULTI
    for (int ph = 0; ph < NPH; ++ph) {
        p.ph_lo = ph; p.ph_hi = ph + 1;
        hipLaunchKernelGGL(mega, dim3(grid), dim3(NTHREADS), LDS_BYTES, stream, p);
    }
#else
    p.ph_lo = 0; p.ph_hi = NPH;
    void* args[] = {&p};
    hipError_t e = hipLaunchCooperativeKernel((const void*)mega, dim3(grid), dim3(NTHREADS), args, LDS_BYTES, stream);
    if (e != hipSuccess) fprintf(stderr, "cooperative launch failed: %s (grid %d)\n", hipGetErrorString(e), grid);
#endif
}
```

```cpp
#include <hip/hip_runtime.h>
#include <hip/hip_cooperative_groups.h>
#include <cstdio>
#include <cstdint>
namespace cg = cooperative_groups;

#ifndef MK_MULTI
#define MK_MULTI 0
#endif

#define LAS __attribute__((address_space(3)))
#define DI __device__ __forceinline__
typedef unsigned short bf16_t;
typedef short bf16x8 __attribute__((ext_vector_type(8)));
typedef short s16x4 __attribute__((ext_vector_type(4)));
typedef float f32x2 __attribute__((ext_vector_type(2)));
typedef float f32x4 __attribute__((ext_vector_type(4)));
typedef float f32x16 __attribute__((ext_vector_type(16)));
typedef unsigned u32x2 __attribute__((ext_vector_type(2)));
typedef unsigned u32x4 __attribute__((ext_vector_type(4)));

constexpr int DM = 1024, NB = 16, SEQ = 4096, CTXL = 256;
constexpr int TL = NB * SEQ, TC = NB * CTXL, MR = TL + TC;
constexpr int KEYS = CTXL + SEQ;
constexpr int DFF = 2816, DFFH = 1408;
constexpr int NTHREADS = 512;
constexpr int XB_ST_OFF = 131072 + 12288 + 2 * 5120 + 6144;
constexpr int LDS_BYTES = XB_ST_OFF + 16;
constexpr int WIMG_F = 3072, PREW_F = 3072 + 2 * 1280;
constexpr int XCH_OFF = 131072;
constexpr int NPH = 43;

constexpr size_t SZ_GIN = 3328ull * 1024 * 2, SZ_SQ = 1024ull * 1024 * 2, SZ_MDOWN = 768ull * 1024 * 2, SZ_MUQ = 1536ull * 384 * 2,
                 SZ_MUKV = 2048ull * 256 * 2, SZ_FUP = 5632ull * 1024 * 2, SZ_FDOWN = 1024ull * 2816 * 2;
constexpr size_t WS_GIN = 0;
constexpr size_t WS_GOUT = WS_GIN + 2 * SZ_GIN;
constexpr size_t WS_MDOWN = WS_GOUT + 2 * SZ_SQ;
constexpr size_t WS_MUQ = WS_MDOWN + 2 * SZ_MDOWN;
constexpr size_t WS_MUKV = WS_MUQ + 2 * SZ_MUQ;
constexpr size_t WS_MOUT = WS_MUKV + 2 * SZ_MUKV;
constexpr size_t WS_FUP = WS_MOUT + 2 * SZ_SQ;
constexpr size_t WS_FDOWN = WS_FUP + 4 * SZ_FUP;
constexpr size_t WS_MOD = WS_FDOWN + 4 * SZ_FDOWN;
constexpr size_t SZ_MOD = 4ull * 17 * 6144 * 4;
constexpr size_t WS_RS = WS_MOD + ((SZ_MOD + 255) / 256) * 256;
constexpr size_t WS_SHW = WS_RS + 2ull * MR * 4;
constexpr size_t WS_BAR = WS_SHW + 4ull * 2 * 17 * 5632 * 4;
constexpr size_t WS_XC = WS_BAR + 16384;
constexpr size_t WS_H = WS_XC + (size_t)TC * 1024 * 4;
constexpr size_t WS_R = WS_H + (size_t)MR * 1024 * 2;
constexpr size_t WS_QK = WS_R;
constexpr size_t WS_VR = WS_QK + (size_t)MR * 1024 * 2;
constexpr size_t WS_LR = WS_VR + (size_t)MR * 2048 * 2;
constexpr int NCHI = NB * 2 * 4 * 68;
constexpr size_t WS_GQ = WS_LR + (size_t)MR * 32 * 4;
constexpr size_t WS_GK = WS_GQ + (size_t)NCHI * 64 * 128 * 2;
constexpr size_t WS_GP = WS_GK + (size_t)NCHI * 64 * 128 * 2;
constexpr size_t WS_GE = WS_GP + (size_t)NCHI * 64 * 64 * 2;
constexpr size_t WS_GLA_END = WS_GE + (size_t)NCHI * 128 * 4;
constexpr size_t WS_QRAW = WS_R;
constexpr size_t WS_DN = WS_R;
constexpr size_t WS_CQN = WS_QRAW + (size_t)MR * 1536 * 2;
constexpr size_t WS_CKVN = WS_CQN + (size_t)MR * 384 * 2;
constexpr size_t WS_KB = WS_CKVN + (size_t)MR * 256 * 2;
constexpr size_t WS_VB = WS_KB + (size_t)NB * KEYS * 1536 * 2;
constexpr size_t WS_MLA_END = WS_VB + (size_t)NB * KEYS * 1024 * 2;
constexpr size_t WS_ACT = WS_R;
constexpr size_t WS_HALO = WS_ACT + (size_t)MR * 2816 * 2;
constexpr size_t WS_XSA = WS_HALO + 272ull * 22 * 4 * 256 * 4;
constexpr size_t WS_FFN_END = WS_XSA + (size_t)MR * 1024 * 2;
constexpr size_t WS_END = WS_GLA_END > WS_MLA_END ? (WS_GLA_END > WS_FFN_END ? WS_GLA_END : WS_FFN_END) : (WS_MLA_END > WS_FFN_END ? WS_MLA_END : WS_FFN_END);
static_assert(WS_END <= (1ull << 30), "workspace over 1 GiB");

struct Params { const float* in[28]; int ph_lo, ph_hi; };

DI unsigned cvt_pk_bf16(float lo, float hi) { unsigned r; asm("v_cvt_pk_bf16_f32 %0, %1, %2" : "=v"(r) : "v"(lo), "v"(hi)); return r; }
DI float bf_lo(unsigned u) { return __uint_as_float(u << 16); }
DI float bf_hi(unsigned u) { return __uint_as_float(u & 0xffff0000u); }
DI bf16_t f2bf(float f) { return (bf16_t)(cvt_pk_bf16(f, 0.f) & 0xffffu); }
DI float wave_sum(float v) {
    v += __int_as_float(__builtin_amdgcn_update_dpp(0, __float_as_int(v), 0xB1, 0xF, 0xF, false));
    v += __int_as_float(__builtin_amdgcn_update_dpp(0, __float_as_int(v), 0x4E, 0xF, 0xF, false));
    v += __int_as_float(__builtin_amdgcn_update_dpp(0, __float_as_int(v), 0x141, 0xF, 0xF, false));
    v += __int_as_float(__builtin_amdgcn_update_dpp(0, __float_as_int(v), 0x140, 0xF, 0xF, false));
    v += __int_as_float(__builtin_amdgcn_update_dpp(0, __float_as_int(v), 0x142, 0xA, 0xF, false));
    v += __int_as_float(__builtin_amdgcn_update_dpp(0, __float_as_int(v), 0x143, 0xC, 0xF, false));
    return __int_as_float(__builtin_amdgcn_readlane(__float_as_int(v), 63));
}
DI float silu_f(float v) { return v * __builtin_amdgcn_rcpf(1.0f + __expf(-v)); }
DI int crow(int r, int hi) { return (r & 3) + 8 * (r >> 2) + 4 * hi; }
DI int tid_opq() { int t = threadIdx.x; asm volatile("" : "+v"(t)); return t; }
DI int opq(int i) { asm volatile("" : "+s"(i)); return i; }

namespace pg8 {
constexpr int BM = 256, BK = 64, HALF = 128, HTB = HALF * BK * 2, STAGE_BYTES = 8 * HTB, NXCD = 8, WGM = 4;
DI int lds_byte(int r, int c) { const int st = (r >> 4) * 2 + (c >> 5), rr = r & 15, cc = c & 31, ob = rr * 64 + cc * 2; return st * 1024 + (ob ^ (((ob >> 9) & 1) << 5)); }
DI void stage_rc(int b, int& R, int& C) { const int st = b / 1024, sb = b % 1024, swz = sb ^ (((sb >> 9) & 1) << 5); R = (st >> 1) * 16 + swz / 64; C = (st & 1) * 32 + (swz % 64) / 2; }
DI int perm32(int rho) { const int n = rho >> 4, i = rho & 15; return 8 * (i >> 2) + 4 * n + (i & 3); }
struct Unit { int pm, pn; };
struct Gemm { const bf16_t* A; const bf16_t* Bt; int M, N, K, lda, ldb; };
struct StaticOrder {
    int nM, nN, nwg, G, c, rev;
    DI void init(int M, int N, int G_, int c_, int rev_ = 0) { nM = M / BM; nN = N / BM; nwg = nM * nN; G = G_; c = c_; rev = rev_; }
    DI bool next(int i, Unit& u) const {
        const long L = (long)i * G + c; if (L >= nwg) return false;
        int wgid = (int)L; { const int q = nwg / NXCD, r = nwg % NXCD, xcd = wgid % NXCD, off = wgid / NXCD; wgid = (xcd < r ? xcd * (q + 1) : r * (q + 1) + (xcd - r) * q) + off; }
        const int nig = WGM * nN, gid = wgid / nig, fm = gid * WGM, gsz = (nM - fm) < WGM ? (nM - fm) : WGM;
        u.pm = fm + ((wgid % nig) % gsz); u.pn = (wgid % nig) / gsz; if (rev) u.pm = nM - 1 - u.pm; return true;
    }
};

template <class Epi, int KIND>
DI void gemm_phase(LAS unsigned char* lds, const Gemm g, const StaticOrder& S, const Epi& E) {
    constexpr bool perm = Epi::template perm_of<KIND>();
    const int tid = tid_opq(), wid = __builtin_amdgcn_readfirstlane(tid >> 6), lane = tid & 63, wr = wid >> 2, wc = wid & 3, fr = lane & 15, fq = lane >> 4;
    const int K = g.K, nt = K / BK;
    unsigned voffA[2], voffB[2];
#pragma unroll
    for (int i = 0; i < 2; ++i) { int R, C; stage_rc(tid * 16 + i * 8192, R, C); const int Rb = perm ? ((R & ~31) + perm32(R & 31)) : R;
        voffA[i] = (unsigned)(R * g.lda + C) * 2u; voffB[i] = (unsigned)(Rb * g.ldb + C) * 2u; }
    const size_t kstep = (size_t)(BK * 2);
    const size_t hstepA = (size_t)HALF * g.lda * 2, hstepB = (size_t)HALF * g.ldb * 2;
    const size_t tstepA = 2 * hstepA, tstepB = 2 * hstepB;
    const unsigned ldsw = (unsigned)wid * 1024u;
    const int aoff = lds_byte(wr * 64 + fr, fq * 8), boff = lds_byte(wc * 32 + fr, fq * 8);
#define PG8_SA(b, h) (((b) * 2 + (h)) * HTB)
#define PG8_SB(b, h) ((4 + (b) * 2 + (h)) * HTB)
#define PG8_STAGE(bufoff, gbase, voff) do { _Pragma("unroll") for (int _i = 0; _i < 2; ++_i) \
        __builtin_amdgcn_global_load_lds((const unsigned*)((const char*)(gbase) + (voff)[_i]), (LAS unsigned*)(lds + (bufoff) + ldsw + _i * 8192), 16, 0, 0); } while (0)
#define PG8_LDA(dst, b, h) do { _Pragma("unroll") for (int m = 0; m < 4; ++m) _Pragma("unroll") for (int k = 0; k < 2; ++k) dst[m][k] = *(const LAS bf16x8*)(lds + PG8_SA(b, h) + aoff + m * 2048 + k * 1024); } while (0)
#define PG8_LDB(dst, b, h) do { _Pragma("unroll") for (int n = 0; n < 2; ++n) _Pragma("unroll") for (int k = 0; k < 2; ++k) dst[n][k] = *(const LAS bf16x8*)(lds + PG8_SB(b, h) + boff + n * 2048 + k * 1024); } while (0)
#define PG8_MMA(ai, bj, At, Bt) do { __builtin_amdgcn_s_setprio(1); _Pragma("unroll") for (int m = 0; m < 4; ++m) _Pragma("unroll") for (int n = 0; n < 2; ++n) _Pragma("unroll") for (int k = 0; k < 2; ++k) \
        acc[ai][bj][m][n] = __builtin_amdgcn_mfma_f32_16x16x32_bf16(Bt[n][k], At[m][k], acc[ai][bj][m][n], 0, 0, 0); __builtin_amdgcn_s_setprio(0); } while (0)
#define PG8_WAIT_V(n) asm volatile("s_waitcnt vmcnt(" #n ")" ::: "memory")
#define PG8_WAIT_L(n) asm volatile("s_waitcnt lgkmcnt(" #n ")" ::: "memory")
#define PG8_BAR __builtin_amdgcn_s_barrier()
#define PG8_SCHED __builtin_amdgcn_sched_barrier(0)
    Unit cur, nxt; int ui = 0;
    if (!S.next(0, cur)) return;
    f32x4 acc[2][2][4][2];
#pragma unroll
    for (int a = 0; a < 2; ++a)
#pragma unroll
        for (int b = 0; b < 2; ++b)
#pragma unroll
            for (int m = 0; m < 4; ++m)
#pragma unroll
                for (int n = 0; n < 2; ++n) acc[a][b][m][n] = (f32x4){0.f, 0.f, 0.f, 0.f};
    bf16x8 At[4][2], B0[2][2], B1[2][2];
    typename Epi::Pre pre;
    const char* cA = (const char*)g.A + (size_t)cur.pm * tstepA; const char* cB = (const char*)g.Bt + (size_t)cur.pn * tstepB;
    PG8_STAGE(PG8_SB(0, 0), cB, voffB); PG8_STAGE(PG8_SA(0, 0), cA, voffA); PG8_STAGE(PG8_SB(0, 1), cB + hstepB, voffB); PG8_STAGE(PG8_SA(0, 1), cA + hstepA, voffA);
    if (wr == 1) PG8_BAR;
    PG8_WAIT_V(4); PG8_BAR;
    PG8_STAGE(PG8_SB(1, 0), cB + kstep, voffB); PG8_STAGE(PG8_SA(1, 0), cA + kstep, voffA); PG8_STAGE(PG8_SB(1, 1), cB + hstepB + kstep, voffB);
    PG8_WAIT_V(6); PG8_BAR;
    for (;;) {
        const bool has_next = S.next(ui + 1, nxt);
        const char* nA = has_next ? (const char*)g.A + (size_t)nxt.pm * tstepA : cA; const char* nB = has_next ? (const char*)g.Bt + (size_t)nxt.pn * tstepB : cB;
        E.template prefetch<KIND>(pre, cur, wr, wc, fr, fq, ui & 1);
        for (int t = 0; t < nt; t += 2) {
            const bool last = (t == nt - 2);
            const char* a1 = cA + (size_t)(t + 1) * kstep;
            const char* a2 = last ? nA : cA + (size_t)(t + 2) * kstep; const char* b2 = last ? nB : cB + (size_t)(t + 2) * kstep;
            const char* a3 = a2 + kstep; const char* b3 = b2 + kstep;
            PG8_LDB(B0, 0, 0); PG8_SCHED; PG8_LDA(At, 0, 0); PG8_STAGE(PG8_SA(1, 1), a1 + hstepA, voffA);
            PG8_WAIT_L(8); PG8_BAR; PG8_WAIT_L(0); PG8_MMA(0, 0, At, B0); PG8_BAR; PG8_SCHED;
            PG8_LDB(B1, 0, 1); PG8_STAGE(PG8_SB(0, 0), b2, voffB);
            PG8_BAR; PG8_WAIT_L(0); PG8_MMA(0, 1, At, B1); PG8_BAR;
            PG8_LDA(At, 0, 1); PG8_STAGE(PG8_SA(0, 0), a2, voffA);
            PG8_BAR; PG8_WAIT_L(0); PG8_MMA(1, 0, At, B0); PG8_BAR; PG8_SCHED;
            PG8_STAGE(PG8_SB(0, 1), b2 + hstepB, voffB);
            PG8_WAIT_V(6); PG8_BAR; PG8_MMA(1, 1, At, B1); PG8_BAR;
            PG8_LDB(B0, 1, 0); PG8_SCHED; PG8_LDA(At, 1, 0); PG8_STAGE(PG8_SA(0, 1), a2 + hstepA, voffA);
            PG8_WAIT_L(8); PG8_BAR; PG8_WAIT_L(0); PG8_MMA(0, 0, At, B0); PG8_BAR; PG8_SCHED;
            PG8_LDB(B1, 1, 1); PG8_STAGE(PG8_SB(1, 0), b3, voffB);
            PG8_BAR; PG8_WAIT_L(0); PG8_MMA(0, 1, At, B1); PG8_BAR;
            PG8_LDA(At, 1, 1); PG8_STAGE(PG8_SA(1, 0), a3, voffA);
            PG8_BAR; PG8_WAIT_L(0); PG8_MMA(1, 0, At, B0); PG8_BAR; PG8_SCHED;
            PG8_STAGE(PG8_SB(1, 1), b3 + hstepB, voffB);
            PG8_WAIT_V(6); PG8_BAR; PG8_MMA(1, 1, At, B1); PG8_BAR;
        }
        if (wr == 0) { PG8_BAR; asm volatile("" ::: "memory"); }
        E.template run<KIND>(acc, pre, cur, wr, wc, fr, fq, ui & 1);
        if (wr == 1) { asm volatile("" ::: "memory"); PG8_BAR; }
        if (!has_next) break;
#pragma unroll
        for (int a = 0; a < 2; ++a)
#pragma unroll
            for (int b = 0; b < 2; ++b)
#pragma unroll
                for (int m = 0; m < 4; ++m)
#pragma unroll
                    for (int n = 0; n < 2; ++n) acc[a][b][m][n] = (f32x4){0.f, 0.f, 0.f, 0.f};
        cur = nxt; cA = nA; cB = nB; ++ui;
    }
    PG8_WAIT_V(0);
    if (wr == 0) PG8_BAR;
    PG8_BAR;
#undef PG8_SA
#undef PG8_SB
#undef PG8_STAGE
#undef PG8_LDA
#undef PG8_LDB
#undef PG8_MMA
#undef PG8_WAIT_V
#undef PG8_WAIT_L
#undef PG8_BAR
#undef PG8_SCHED
}
}

enum { EPI_BF16 = 0, EPI_GLA_IN = 1, EPI_RESID = 2, EPI_UKV = 3, EPI_FFN_UP = 4 };
DI float dpp_ror1(float v) { return __int_as_float(__builtin_amdgcn_update_dpp(0, __float_as_int(v), 0x121, 0xf, 0xf, false)); }
DI float dpp_ror15(float v) { return __int_as_float(__builtin_amdgcn_update_dpp(0, __float_as_int(v), 0x12F, 0xf, 0xf, false)); }
struct Epi {
    struct Pre { float rsv[2][4]; f32x4 sw[2][2]; f32x2 wl0, wl1; };
    int ldc; LAS float* xch;
    void* q0; void* q1; void* q2; void* q3; void* q4; void* q5;
    static DI f32x4 ror1_4(f32x4 v) { float a, b, c, d;
        asm volatile("s_nop 1\n\tv_mov_b32_dpp %0, %4 row_ror:1 row_mask:0xf bank_mask:0xf\n\tv_mov_b32_dpp %1, %5 row_ror:1 row_mask:0xf bank_mask:0xf\n\tv_mov_b32_dpp %2, %6 row_ror:1 row_mask:0xf bank_mask:0xf\n\tv_mov_b32_dpp %3, %7 row_ror:1 row_mask:0xf bank_mask:0xf"
                     : "=&v"(a), "=&v"(b), "=&v"(c), "=&v"(d) : "v"(v[0]), "v"(v[1]), "v"(v[2]), "v"(v[3]));
        return (f32x4){a, b, c, d}; }
    static DI f32x2 ror1_2(f32x2 v) { float a, b;
        asm volatile("s_nop 1\n\tv_mov_b32_dpp %0, %2 row_ror:1 row_mask:0xf bank_mask:0xf\n\tv_mov_b32_dpp %1, %3 row_ror:1 row_mask:0xf bank_mask:0xf" : "=&v"(a), "=&v"(b) : "v"(v[0]), "v"(v[1]));
        return (f32x2){a, b}; }
    static DI f32x2 ror15_2(f32x2 v) { float a, b;
        asm volatile("s_nop 1\n\tv_mov_b32_dpp %0, %2 row_ror:15 row_mask:0xf bank_mask:0xf\n\tv_mov_b32_dpp %1, %3 row_ror:15 row_mask:0xf bank_mask:0xf" : "=&v"(a), "=&v"(b) : "v"(v[0]), "v"(v[1]));
        return (f32x2){a, b}; }
    static DI f32x4 ror15_4(f32x4 v) { float a, b, c, d;
        asm volatile("s_nop 1\n\tv_mov_b32_dpp %0, %4 row_ror:15 row_mask:0xf bank_mask:0xf\n\tv_mov_b32_dpp %1, %5 row_ror:15 row_mask:0xf bank_mask:0xf\n\tv_mov_b32_dpp %2, %6 row_ror:15 row_mask:0xf bank_mask:0xf\n\tv_mov_b32_dpp %3, %7 row_ror:15 row_mask:0xf bank_mask:0xf"
                     : "=&v"(a), "=&v"(b), "=&v"(c), "=&v"(d) : "v"(v[0]), "v"(v[1]), "v"(v[2]), "v"(v[3]));
        return (f32x4){a, b, c, d}; }
    DI void ffn_up(const f32x4 (&acc)[2][2][4][2], const pg8::Unit& u, int wr, int wc, int fr, int fq, int par) const {
        bf16_t* O = (bf16_t*)q0; float* halo = (float*)q3;
        const int cl = wc * 32 + 8 * fq;
        float rstd[2][4];
        { const LAS float* pw = xch + PREW_F + (wr * 4 + wc) * 192;
#pragma unroll
          for (int g = 0; g < 8; ++g) rstd[g >> 2][g & 3] = rsqrtf(pw[g * 16 + fr] * (1.0f / 1024.0f) + 1e-6f); }
        const LAS float* wbuf = xch + WIMG_F + par * 1280;
#define XW(ST, TB, BJ, V0, V1) do { LAS float* xp_ = xch + ((((ST) + 1) * 2 + (TB)) * 2 + (BJ)) * 128 + cl; *(LAS f32x4*)xp_ = (V0); *(LAS f32x4*)(xp_ + 4) = (V1); } while (0)
#define TR(AI, BJ, M, N) (acc[AI][BJ][M][N] * rstd[AI][M])
        if (fr == 0) { XW(wr, 0, 0, TR(0, 0, 0, 0), TR(0, 0, 0, 1)); XW(wr, 0, 1, TR(0, 1, 0, 0), TR(0, 1, 0, 1)); XW(2 + wr, 0, 0, TR(1, 0, 0, 0), TR(1, 0, 0, 1)); XW(2 + wr, 0, 1, TR(1, 1, 0, 0), TR(1, 1, 0, 1)); }
        if (fr == 15) { XW(wr, 1, 0, TR(0, 0, 3, 0), TR(0, 0, 3, 1)); XW(wr, 1, 1, TR(0, 1, 3, 0), TR(0, 1, 3, 1)); XW(2 + wr, 1, 0, TR(1, 0, 3, 0), TR(1, 0, 3, 1)); XW(2 + wr, 1, 1, TR(1, 1, 3, 0), TR(1, 1, 3, 1)); }
        { const f32x4 zz = (f32x4){0.f, 0.f, 0.f, 0.f}; if (fr == 0 && wr == 0) { XW(-1, 1, 0, zz, zz); XW(-1, 1, 1, zz, zz); } if (fr == 15 && wr == 1) { XW(4, 0, 0, zz, zz); XW(4, 0, 1, zz, zz); } }
#undef XW
        asm volatile("s_waitcnt lgkmcnt(0)" ::: "memory"); __builtin_amdgcn_s_barrier(); asm volatile("" ::: "memory"); __builtin_amdgcn_s_barrier(); asm volatile("" ::: "memory");
        {
            float* hp = halo + (size_t)(u.pm * 22 + u.pn) * 4 * 256 + cl;
            const f32x4 sa0 = *(const LAS f32x4*)(wbuf + 512 + cl), sa1 = *(const LAS f32x4*)(wbuf + 512 + cl + 4), sg0 = *(const LAS f32x4*)(wbuf + 640 + 512 + cl), sg1 = *(const LAS f32x4*)(wbuf + 640 + 512 + cl + 4);
            if (wr == 0 && fr < 2) { float* h2 = hp + fr * 256; *(f32x4*)h2 = TR(0, 0, 0, 0) + sa0; *(f32x4*)(h2 + 4) = TR(0, 0, 0, 1) + sa1; *(f32x4*)(h2 + 128) = TR(0, 1, 0, 0) + sg0; *(f32x4*)(h2 + 132) = TR(0, 1, 0, 1) + sg1; }
            if (wr == 1 && fr >= 14) { float* h2 = hp + (fr - 12) * 256; *(f32x4*)h2 = TR(1, 0, 3, 0) + sa0; *(f32x4*)(h2 + 4) = TR(1, 0, 3, 1) + sa1; *(f32x4*)(h2 + 128) = TR(1, 1, 3, 0) + sg0; *(f32x4*)(h2 + 132) = TR(1, 1, 3, 1) + sg1; }
        }
#undef TR
        asm volatile("" ::: "memory");
        const int rowt = u.pm * 256 + wr * 64 + fr;
        const bool f0 = fr == 0, f15 = fr == 15;
        f32x2 sg[2][4][4];
#define SILU2(v) (f32x2){silu_f(v[0]), silu_f(v[1])}
#define H2(V, HH) __builtin_shufflevector(V, V, 2 * (HH), 2 * (HH) + 1)
#define CONV_GROUP(BJ, Q, AI, OP) do { \
            const int st = 2 * (AI) + wr; \
            const f32x2 pb = *(const LAS f32x2*)(xch + (((st) * 2 + 1) * 2 + (BJ)) * 128 + cl + 2 * (Q)) + sw; \
            const f32x2 nb = *(const LAS f32x2*)(xch + (((st + 2) * 2 + 0) * 2 + (BJ)) * 128 + cl + 2 * (Q)) + sw; \
            const f32x2 c0 = H2(acc[AI][BJ][0][(Q) >> 1], (Q) & 1) * rstd[AI][0] + sw, c1 = H2(acc[AI][BJ][1][(Q) >> 1], (Q) & 1) * rstd[AI][1] + sw, \
                        c2 = H2(acc[AI][BJ][2][(Q) >> 1], (Q) & 1) * rstd[AI][2] + sw, c3 = H2(acc[AI][BJ][3][(Q) >> 1], (Q) & 1) * rstd[AI][3] + sw; \
            const f32x2 R0 = ror1_2(c0), L0 = ror15_2(c0), L1 = ror15_2(c1); \
            { const f32x2 v = w0 * (f0 ? pb : R0) + w1 * c0 + w2 * (f15 ? L1 : L0) + bb; OP(sg[AI][0][Q], v); } \
            __builtin_amdgcn_sched_barrier(0); \
            const f32x2 R1 = ror1_2(c1), L2 = ror15_2(c2); \
            { const f32x2 v = w0 * (f0 ? R0 : R1) + w1 * c1 + w2 * (f15 ? L2 : L1) + bb; OP(sg[AI][1][Q], v); } \
            __builtin_amdgcn_sched_barrier(0); \
            const f32x2 R2 = ror1_2(c2), L3 = ror15_2(c3); \
            { const f32x2 v = w0 * (f0 ? R1 : R2) + w1 * c2 + w2 * (f15 ? L3 : L2) + bb; OP(sg[AI][2][Q], v); } \
            __builtin_amdgcn_sched_barrier(0); \
            const f32x2 R3 = ror1_2(c3); \
            { const f32x2 v = w0 * (f0 ? R2 : R3) + w1 * c3 + w2 * (f15 ? nb : L3) + bb; OP(sg[AI][3][Q], v); } \
            __builtin_amdgcn_sched_barrier(0); } while (0)
#define OP_G(dst, v) dst = SILU2(v)
#define OP_A(dst, v) dst *= v
#define CONV_W(BJ, Q) const LAS float* wp_ = wbuf + (BJ) * 640 + cl + 2 * (Q); \
            const f32x2 w0 = *(const LAS f32x2*)wp_, w1 = *(const LAS f32x2*)(wp_ + 128), w2 = *(const LAS f32x2*)(wp_ + 256), bb = *(const LAS f32x2*)(wp_ + 384), sw = *(const LAS f32x2*)(wp_ + 512);
        { CONV_W(1, 0) CONV_GROUP(1, 0, 0, OP_G); CONV_GROUP(1, 0, 1, OP_G); }
        { CONV_W(1, 1) CONV_GROUP(1, 1, 0, OP_G); CONV_GROUP(1, 1, 1, OP_G); }
        { CONV_W(1, 2) CONV_GROUP(1, 2, 0, OP_G); CONV_GROUP(1, 2, 1, OP_G); }
        { CONV_W(1, 3) CONV_GROUP(1, 3, 0, OP_G); CONV_GROUP(1, 3, 1, OP_G); }
        { CONV_W(0, 0) CONV_GROUP(0, 0, 0, OP_A); CONV_GROUP(0, 0, 1, OP_A); }
        { CONV_W(0, 1) CONV_GROUP(0, 1, 0, OP_A); CONV_GROUP(0, 1, 1, OP_A); }
        { CONV_W(0, 2) CONV_GROUP(0, 2, 0, OP_A); CONV_GROUP(0, 2, 1, OP_A); }
        { CONV_W(0, 3) CONV_GROUP(0, 3, 0, OP_A); CONV_GROUP(0, 3, 1, OP_A); }
#undef CONV_W
#undef CONV_GROUP
#undef OP_G
#undef OP_A
#undef SILU2
#undef H2
#define ST16(AI, MM) do { u32x4 w_; w_.x = cvt_pk_bf16(sg[AI][MM][0][0], sg[AI][MM][0][1]); w_.y = cvt_pk_bf16(sg[AI][MM][1][0], sg[AI][MM][1][1]); w_.z = cvt_pk_bf16(sg[AI][MM][2][0], sg[AI][MM][2][1]); w_.w = cvt_pk_bf16(sg[AI][MM][3][0], sg[AI][MM][3][1]); \
            *(u32x4*)(O + (size_t)(rowt + (AI) * 128 + (MM) * 16) * 2816 + u.pn * 128 + cl) = w_; } while (0)
        ST16(0, 0); ST16(0, 1); ST16(0, 2); ST16(0, 3); ST16(1, 0); ST16(1, 1); ST16(1, 2); ST16(1, 3);
#undef ST16
    }
    template <int K> static constexpr bool perm_of() { return true; }
    template <int kind> DI void prefetch(Pre& P, const pg8::Unit& u, int wr, int wc, int fr, int fq, int par) const {
        (void)P;
        if constexpr (kind == EPI_UKV) {
            if (fq == 0 && fr < 8) __builtin_amdgcn_global_load_lds((const unsigned*)((const float*)q2 + wc * 32 + fr * 4), (LAS unsigned*)(xch + PREW_F + (wr * 4 + wc) * 192 + 128), 16, 0, 0);
        }
        if constexpr (kind == EPI_GLA_IN || kind == EPI_BF16 || kind == EPI_FFN_UP) {
            const float* rsb = (const float*)(kind == EPI_FFN_UP ? q4 : q3);
            if (rsb) {
                LAS float* pw = xch + PREW_F + (wr * 4 + wc) * 192;
                const int bidx = u.pm < 256 ? (u.pm >> 4) : 16;
                if (fq == 0) {
                    const float* rsp = rsb + u.pm * 256 + wr * 64 + fr;
#pragma unroll
                    for (int g = 0; g < 8; ++g) __builtin_amdgcn_global_load_lds((const unsigned*)(rsp + (g >> 2) * 128 + (g & 3) * 16), (LAS unsigned*)(pw + g * 16), 4, 0, 0);
                    if constexpr (kind != EPI_FFN_UP) {
                        const float* sw = (const float*)q4 + (size_t)bidx * 5632 + u.pn * 256 + (fr >> 3) * 128 + wc * 32 + (fr & 7) * 4;
                        __builtin_amdgcn_global_load_lds((const unsigned*)sw, (LAS unsigned*)(pw + 128), 16, 0, 0);
                    }
                }
                if constexpr (kind == EPI_FFN_UP) {
                    const int wid = wr * 4 + wc;
                    if (wid < 5) {
                        const float* cw = (const float*)q1; const float* cb = (const float*)q2; const float* shw = (const float*)q5 + (size_t)bidx * 5632 + u.pn * 256;
                        const int i4 = (wid * 64 + fq * 16 + fr) * 4, bjw = i4 / 640, rem = i4 % 640, kw = rem >> 7, c_ = rem & 127;
                        const float* srcw = kw < 3 ? cw + kw * 5632 + bjw * 2816 + u.pn * 128 + c_ : kw == 3 ? cb + bjw * 2816 + u.pn * 128 + c_ : shw + bjw * 128 + c_;
                        __builtin_amdgcn_global_load_lds((const unsigned*)srcw, (LAS unsigned*)(xch + WIMG_F + par * 1280 + wid * 256), 16, 0, 0);
                    }
                }
            }
        }
    }
    template <int kind> DI void run(const f32x4 (&acc)[2][2][4][2], const Pre& P, const pg8::Unit& u, int wr, int wc, int fr, int fq, int par) const {
        asm volatile("" : "+v"(fr), "+v"(fq));
        if constexpr (kind == EPI_FFN_UP) { ffn_up(acc, u, wr, wc, fr, fq, par); return; }
        if constexpr (kind == EPI_RESID) {
            const float* base_l = (const float*)q0; const float* base_c = (const float*)q1; float* out_l = (float*)q2; unsigned char* wsb = (unsigned char*)q3; float* out_c = (float*)(wsb + WS_XC);
            const float* modl = (const float*)q4; const float* gnext = (const float*)q5;
            const int bidx = u.pm < 256 ? (u.pm >> 4) : 16;
            const float* gv = modl + (size_t)bidx * 6144 + (ldc ? 5 * 1024 : 2 * 1024);
            const float* bp = u.pm < 256 ? base_l + (size_t)u.pm * 256 * 1024 : base_c + (size_t)(u.pm - 256) * 256 * 1024;
            float* op = u.pm < 256 ? out_l + (size_t)u.pm * 256 * 1024 : out_c + (size_t)(u.pm - 256) * 256 * 1024;
            const int col0 = u.pn * 256 + wc * 32 + 8 * fq;
            f32x4 gt[2][2], gn[2][2];
#pragma unroll
            for (int bj = 0; bj < 2; ++bj)
#pragma unroll
                for (int n = 0; n < 2; ++n) gt[bj][n] = *(const f32x4*)(gv + col0 + bj * 128 + n * 4);
            if (gnext) {
                const float* scn = ldc ? modl + (size_t)(17 + bidx) * 6144 + 1024 : modl + (size_t)bidx * 6144 + 4 * 1024;
#pragma unroll
                for (int bj = 0; bj < 2; ++bj)
#pragma unroll
                    for (int n = 0; n < 2; ++n) gn[bj][n] = *(const f32x4*)(gnext + col0 + bj * 128 + n * 4) * (*(const f32x4*)(scn + col0 + bj * 128 + n * 4) + 1.0f);
            }
            bf16_t* xs = (bf16_t*)(wsb + (ldc ? WS_H : WS_XSA)) + (size_t)u.pm * 256 * 1024;
            float* rs = (float*)(wsb + WS_RS) + (ldc ? MR : 0) + u.pm * 256;
            f32x4 bsA[4], bsB[4];
#define RS_LOAD(K, DST) do { const size_t off_ = (size_t)(((K) >> 2) * 128 + wr * 64 + ((K) & 3) * 16 + fr) * 1024 + col0; \
                _Pragma("unroll") for (int q_ = 0; q_ < 4; ++q_) DST[q_] = *(const f32x4*)(bp + off_ + (q_ >> 1) * 128 + (q_ & 1) * 4); } while (0)
#define RS_DO(K, SRC) do { const int ai_ = (K) >> 2, m_ = (K) & 3; const int rl = ai_ * 128 + wr * 64 + m_ * 16 + fr; const size_t off = (size_t)rl * 1024 + col0; float ssq = 0.f; \
                _Pragma("unroll") for (int bj = 0; bj < 2; ++bj) { \
                    const f32x4 xa = SRC[2 * bj] + gt[bj][0] * acc[ai_][bj][m_][0], xb = SRC[2 * bj + 1] + gt[bj][1] * acc[ai_][bj][m_][1]; \
                    *(f32x4*)(op + off + bj * 128) = xa; *(f32x4*)(op + off + bj * 128 + 4) = xb; \
                    if (gnext) { ssq += xa[0] * xa[0] + xa[1] * xa[1] + xa[2] * xa[2] + xa[3] * xa[3] + xb[0] * xb[0] + xb[1] * xb[1] + xb[2] * xb[2] + xb[3] * xb[3]; \
                        const f32x4 ya = xa * gn[bj][0], yb = xb * gn[bj][1]; \
                        u32x4 w; w.x = cvt_pk_bf16(ya[0], ya[1]); w.y = cvt_pk_bf16(ya[2], ya[3]); w.z = cvt_pk_bf16(yb[0], yb[1]); w.w = cvt_pk_bf16(yb[2], yb[3]); \
                        *(u32x4*)(xs + off + bj * 128) = w; } } \
                if (gnext) { ssq += __shfl_xor(ssq, 16); ssq += __shfl_xor(ssq, 32); if (fq == 0) unsafeAtomicAdd(rs + rl, ssq); } } while (0)
            RS_LOAD(0, bsA);
            RS_LOAD(1, bsB); RS_DO(0, bsA);
            RS_LOAD(2, bsA); RS_DO(1, bsB);
            RS_LOAD(3, bsB); RS_DO(2, bsA);
            RS_LOAD(4, bsA); RS_DO(3, bsB);
            RS_LOAD(5, bsB); RS_DO(4, bsA);
            RS_LOAD(6, bsA); RS_DO(5, bsB);
            RS_LOAD(7, bsB); RS_DO(6, bsA);
            RS_DO(7, bsB);
#undef RS_LOAD
#undef RS_DO
            return;
        } else {
        bf16_t* O = (bf16_t*)q0; float* lr = (float*)q1; bf16_t* KB = (bf16_t*)q0; bf16_t* VB = (bf16_t*)q1;
        const int rowt = u.pm * 256 + wr * 64 + fr;
        f32x4 swv[2][2]; float rsv[2][4];
        float krs[2][4]; f32x4 kg0, kg1;
        if constexpr (kind == EPI_UKV) {
            LAS float* P = xch;
#pragma unroll
            for (int ai = 0; ai < 2; ++ai)
#pragma unroll
                for (int m = 0; m < 4; ++m) {
                    const f32x4 a = acc[ai][0][m][0], b = acc[ai][0][m][1];
                    float t = a[0] * a[0] + a[1] * a[1] + a[2] * a[2] + a[3] * a[3] + b[0] * b[0] + b[1] * b[1] + b[2] * b[2] + b[3] * b[3];
                    t += __shfl_xor(t, 16); t += __shfl_xor(t, 32);
                    if (fq == 0) P[(ai * 128 + wr * 64 + m * 16 + fr) * 4 + wc] = t;
                }
            asm volatile("s_waitcnt lgkmcnt(0)" ::: "memory"); __builtin_amdgcn_s_barrier(); asm volatile("" ::: "memory");
#pragma unroll
            for (int ai = 0; ai < 2; ++ai)
#pragma unroll
                for (int m = 0; m < 4; ++m) { const f32x4 t4 = *(const LAS f32x4*)(P + (ai * 128 + wr * 64 + m * 16 + fr) * 4); krs[ai][m] = rsqrtf((t4[0] + t4[1] + t4[2] + t4[3]) * (1.0f / 128.0f) + 1e-6f); }
            { const LAS float* pw = xch + PREW_F + (wr * 4 + wc) * 192 + 128 + 8 * fq; kg0 = *(const LAS f32x4*)pw; kg1 = *(const LAS f32x4*)(pw + 4); }
        }
        if constexpr (kind == EPI_GLA_IN || kind == EPI_BF16) {
            if (q3) { const LAS float* pw = xch + PREW_F + (wr * 4 + wc) * 192;
#pragma unroll
                for (int g = 0; g < 8; ++g) rsv[g >> 2][g & 3] = pw[g * 16 + fr];
#pragma unroll
                for (int bj = 0; bj < 2; ++bj) { swv[bj][0] = *(const LAS f32x4*)(pw + 128 + bj * 32 + 8 * fq); swv[bj][1] = *(const LAS f32x4*)(pw + 128 + bj * 32 + 8 * fq + 4); } }
        }
#pragma unroll
        for (int ai = 0; ai < 2; ++ai)
#pragma unroll
            for (int m = 0; m < 4; ++m) {
                const int row = rowt + ai * 128 + m * 16;
#pragma unroll
                for (int bj = 0; bj < 2; ++bj) {
                    f32x4 v0 = acc[ai][bj][m][0], v1 = acc[ai][bj][m][1];
                    const int cin = bj * 128 + wc * 32 + 8 * fq;
                    if constexpr (kind == EPI_GLA_IN || kind == EPI_BF16) {
                        if (q3) {
                            const float rstd = rsqrtf(rsv[ai][m] * (1.0f / 1024.0f) + 1e-6f);
                            v0 = v0 * rstd + swv[bj][0]; v1 = v1 * rstd + swv[bj][1];
                        }
                    }
                    if constexpr (kind == EPI_GLA_IN) {
                        if (u.pn == 12) {
                            if (bj == 0 && wc == 0) { float* lp = lr + (size_t)row * 32 + 8 * fq; *(f32x4*)lp = v0; *(f32x4*)(lp + 4) = v1; }
                            continue;
                        }
                        if (u.pn < 2) { v0 *= 0.08838834764831845f; v1 *= 0.08838834764831845f; }
                    }
                    u32x4 w; w.x = cvt_pk_bf16(v0[0], v0[1]); w.y = cvt_pk_bf16(v0[2], v0[3]); w.z = cvt_pk_bf16(v1[0], v1[1]); w.w = cvt_pk_bf16(v1[2], v1[3]);
                    if constexpr (kind == EPI_GLA_IN) {
                        if (u.pn < 4) *(u32x4*)(O + (size_t)row * 1024 + u.pn * 256 + cin) = w;
                        else *(u32x4*)((bf16_t*)q2 + (size_t)row * 2048 + (u.pn - 4) * 256 + cin) = w;
                    } else if constexpr (kind == EPI_UKV) {
                        if (bj == 0) { const f32x4 n0 = v0 * krs[ai][m] * kg0, n1 = v1 * krs[ai][m] * kg1;
                            w.x = cvt_pk_bf16(n0[0], n0[1]); w.y = cvt_pk_bf16(n0[2], n0[3]); w.z = cvt_pk_bf16(n1[0], n1[1]); w.w = cvt_pk_bf16(n1[2], n1[3]); }
                        int key;
                        if (u.pm < 256) { const int b = u.pm >> 4; key = b * KEYS + CTXL + (row - b * SEQ); }
                        else { const int b = u.pm - 256; key = b * KEYS + (row - TL - b * CTXL); }
                        const int cc = wc * 32 + 8 * fq;
                        if (bj == 0) *(u32x4*)(KB + (size_t)key * 1536 + u.pn * 192 + cc) = w;
                        else *(u32x4*)(VB + (size_t)key * 1024 + u.pn * 128 + cc) = w;
                    } else {
                        *(u32x4*)(O + (size_t)row * ldc + u.pn * 256 + cin) = w;
                    }
                }
            }
        }
    }
};

DI void prep_phase(const Params& p, LAS unsigned char* lds) {
    const int tid = tid_opq();
    unsigned char* ws = (unsigned char*)p.in[opq(27)];
    LAS float* tl = (LAS float*)lds;
    const float* in_c = p.in[opq(1)]; const float* in_cctx = p.in[opq(3)]; const float* in_wada = p.in[opq(4)]; const float* in_bada = p.in[opq(5)];
    const float* in_gin = p.in[opq(8)]; const float* in_w1 = p.in[opq(9)]; const float* in_gout = p.in[opq(13)]; const float* in_mdown = p.in[opq(14)];
    const float* in_uq = p.in[opq(17)]; const float* in_ukv = p.in[opq(18)]; const float* in_mout = p.in[opq(21)]; const float* in_fup = p.in[opq(22)]; const float* in_fdown = p.in[opq(25)];
    constexpr int T0 = 1536, T2 = 512, T3 = 352, T4 = 288, T5 = 256, T6 = 512, T7 = 5632, T8 = 2816;
    constexpr int NTILE = T0 + T2 + T3 + T4 + T5 + T6 + T7 + T8;
    for (int t = blockIdx.x; t < NTILE; t += gridDim.x) {
        const float* src; int N, k0, n0, ld; bf16_t* dst;
        int q = t;
        if (q < T0) { const int j = q / 768, r = q % 768, kt = r / 48, nt = r % 48; src = in_gin + (size_t)j * 1024 * 3072; N = 3072; k0 = kt * 64; n0 = nt * 64;
            dst = (bf16_t*)(ws + WS_GIN + j * SZ_GIN) + (size_t)n0 * 1024 + k0; ld = 1024; }
        else if ((q -= T0) < T2) { const int j = q / 256, r = q % 256, kt = r / 16, nt = r % 16; src = in_gout + (size_t)j * 1024 * 1024; N = 1024; k0 = kt * 64; n0 = nt * 64;
            dst = (bf16_t*)(ws + WS_GOUT + j * SZ_SQ) + (size_t)n0 * 1024 + k0; ld = 1024; }
        else if ((q -= T2) < T3) { const int j = q / 176, r = q % 176, kt = r / 11, nt = r % 11; src = in_mdown + (size_t)j * 1024 * 704; N = 704; k0 = kt * 64; n0 = nt * 64;
            dst = (bf16_t*)(ws + WS_MDOWN + j * SZ_MDOWN) + (size_t)n0 * 1024 + k0; ld = 1024; }
        else if ((q -= T3) < T4) { const int j = q / 144, r = q % 144, kt = r / 24, nt = r % 24; src = in_uq + (size_t)j * 384 * 1536; N = 1536; k0 = kt * 64; n0 = nt * 64;
            dst = (bf16_t*)(ws + WS_MUQ + j * SZ_MUQ) + (size_t)n0 * 384 + k0; ld = 384; }
        else if ((q -= T4) < T5) { const int j = q / 128, r = q % 128, kt = r / 32, nt = r % 32; src = in_ukv + (size_t)j * 256 * 2048; N = 2048; k0 = kt * 64; n0 = nt * 64;
            dst = (bf16_t*)(ws + WS_MUKV + j * SZ_MUKV) + (size_t)n0 * 256 + k0; ld = 256; }
        else if ((q -= T5) < T6) { const int j = q / 256, r = q % 256, kt = r / 16, nt = r % 16; src = in_mout + (size_t)j * 1024 * 1024; N = 1024; k0 = kt * 64; n0 = nt * 64;
            dst = (bf16_t*)(ws + WS_MOUT + j * SZ_SQ) + (size_t)n0 * 1024 + k0; ld = 1024; }
        else if ((q -= T6) < T7) { const int i = q / 1408, r = q % 1408, kt = r / 88, nt = r % 88; src = in_fup + (size_t)i * 1024 * 5632; N = 5632; k0 = kt * 64; n0 = nt * 64;
            const int isg = n0 >= DFF ? 1 : 0, cc = n0 - isg * DFF, drow = (cc >> 7) * 256 + isg * 128 + (cc & 127);
            dst = (bf16_t*)(ws + WS_FUP + (size_t)i * SZ_FUP) + (size_t)drow * 1024 + k0; ld = 1024; }
        else { q -= T7; const int i = q / 704, r = q % 704, kt = r / 16, nt = r % 16; src = in_fdown + (size_t)i * 2816 * 1024; N = 1024; k0 = kt * 64; n0 = nt * 64;
            dst = (bf16_t*)(ws + WS_FDOWN + (size_t)i * SZ_FDOWN) + (size_t)n0 * 2816 + k0; ld = 2816; }
#pragma unroll
        for (int i = 0; i < 8; ++i) { const int r = (tid >> 6) + 8 * i, c = tid & 63; tl[c * 65 + r] = src[(size_t)(k0 + r) * N + n0 + c]; }
        __syncthreads();
#pragma unroll
        for (int i = 0; i < 4; ++i) { const int rr = (tid >> 5) + 16 * i, c2 = (tid & 31) * 2; const float a = tl[rr * 65 + c2], b = tl[rr * 65 + c2 + 1];
            *(unsigned*)(dst + (size_t)rr * ld + c2) = cvt_pk_bf16(a, b); }
        __syncthreads();
    }
    const int gtid = blockIdx.x * NTHREADS + tid, gstride = gridDim.x * NTHREADS;
    for (int idx = gtid; idx < 65536; idx += gstride) {
        const int k = idx & 1023, r = (idx >> 10) & 15, dir = (idx >> 14) & 1, j = idx >> 15;
        const float v = in_w1[((size_t)(j * 2 + dir) * 1024 + k) * 16 + r];
        ((bf16_t*)(ws + WS_GIN + j * SZ_GIN))[(size_t)(3072 + dir * 16 + r) * 1024 + k] = f2bf(v);
    }
    for (int idx = gtid; idx < 2 * 114688; idx += gstride) { const int j = idx / 114688, o = idx % 114688; ((unsigned*)(ws + WS_GIN + j * SZ_GIN + 3104ull * 1024 * 2))[o] = 0u; }
    for (int idx = gtid; idx < 2 * 32768; idx += gstride) { const int j = idx / 32768, o = idx % 32768; ((unsigned*)(ws + WS_MDOWN + j * SZ_MDOWN + 704ull * 1024 * 2))[o] = 0u; }
    for (int idx = gtid; idx < MR; idx += gstride) ((float*)(ws + WS_RS))[idx] = 0.f;
    LAS float* sl = (LAS float*)lds;
    LAS float* red = (LAS float*)(lds + 81920);
    __syncthreads();
    for (int idx = tid; idx < 17 * 1024; idx += NTHREADS) { const int r = idx >> 10, k = idx & 1023; const float v = r < 16 ? in_c[r * 1024 + k] : in_cctx[k]; sl[k * 20 + r] = v / (1.0f + __expf(-v)); }
    __syncthreads();
    float* mod = (float*)(ws + WS_MOD);
    for (int it = blockIdx.x; it < 384; it += gridDim.x) {
        const int layer = it / 96, n0 = (it % 96) * 64, nn = tid & 63, ks = tid >> 6;
        const float* W = in_wada + (size_t)layer * 1024 * 6144 + n0 + nn;
        float acc[17];
#pragma unroll
        for (int r = 0; r < 17; ++r) acc[r] = 0.f;
        for (int kk = 0; kk < 128; ++kk) {
            const int k = ks * 128 + kk; const float w = W[(size_t)k * 6144];
            const f32x4 s0 = *(const LAS f32x4*)(sl + k * 20), s1 = *(const LAS f32x4*)(sl + k * 20 + 4), s2 = *(const LAS f32x4*)(sl + k * 20 + 8), s3 = *(const LAS f32x4*)(sl + k * 20 + 12);
            const float s16 = sl[k * 20 + 16];
#pragma unroll
            for (int j = 0; j < 4; ++j) { acc[j] += s0[j] * w; acc[4 + j] += s1[j] * w; acc[8 + j] += s2[j] * w; acc[12 + j] += s3[j] * w; }
            acc[16] += s16 * w;
        }
#pragma unroll
        for (int r = 0; r < 17; ++r) red[(ks * 17 + r) * 64 + nn] = acc[r];
        __syncthreads();
        for (int o = tid; o < 17 * 64; o += NTHREADS) { const int r = o >> 6, c = o & 63; float s = in_bada[layer * 6144 + n0 + c];
#pragma unroll
            for (int k8 = 0; k8 < 8; ++k8) s += red[(k8 * 17 + r) * 64 + c];
            mod[(size_t)(layer * 17 + r) * 6144 + n0 + c] = s; }
        __syncthreads();
    }
}

DI void shw_phase(unsigned char* ws, LAS unsigned char* lds) {
    const int tid = tid_opq(), wave = tid >> 6, lane = tid & 63;
    LAS float* sl = (LAS float*)lds;
    const float* mod = (const float*)(ws + WS_MOD);
    constexpr int NCH = 4 * 44 + 6 + 26 + 6;
    for (int ch = blockIdx.x; ch < NCH; ch += gridDim.x) {
        int layer, kind, n0; const bf16_t* Bt;
        if (ch < 176) { layer = ch / 44; kind = 1; n0 = (ch % 44) * 128; Bt = (const bf16_t*)(ws + WS_FUP + (size_t)layer * SZ_FUP); }
        else if (ch < 182) { layer = 1; kind = 0; n0 = (ch - 176) * 128; Bt = (const bf16_t*)(ws + WS_MDOWN); }
        else if (ch < 208) { layer = 2; kind = 0; n0 = (ch - 182) * 128; Bt = (const bf16_t*)(ws + WS_GIN + SZ_GIN); }
        else { layer = 3; kind = 0; n0 = (ch - 208) * 128; Bt = (const bf16_t*)(ws + WS_MDOWN + SZ_MDOWN); }
        __syncthreads();
        for (int idx = tid; idx < 17 * 256; idx += NTHREADS) { const int b = idx >> 8, k4 = (idx & 255) * 4;
            *(LAS f32x4*)(sl + b * 1024 + k4) = *(const f32x4*)(mod + (size_t)(layer * 17 + b) * 6144 + (kind ? 3 * 1024 : 0) + k4); }
        __syncthreads();
        float* out = (float*)(ws + WS_SHW) + (size_t)((layer * 2 + kind) * 17) * 5632;
#pragma unroll 1
        for (int i = 0; i < 16; ++i) {
            const int n = n0 + wave * 16 + i;
            float w[16];
#pragma unroll
            for (int j = 0; j < 4; ++j) { const u32x2 t = *(const u32x2*)(Bt + (size_t)n * 1024 + j * 256 + lane * 4); w[4 * j] = bf_lo(t.x); w[4 * j + 1] = bf_hi(t.x); w[4 * j + 2] = bf_lo(t.y); w[4 * j + 3] = bf_hi(t.y); }
            float mine = 0.f;
#pragma unroll 1
            for (int b = 0; b < 17; ++b) {
                float a = 0.f;
#pragma unroll
                for (int j = 0; j < 4; ++j) { const f32x4 sv = *(const LAS f32x4*)(sl + b * 1024 + j * 256 + lane * 4); a += sv[0] * w[4 * j] + sv[1] * w[4 * j + 1] + sv[2] * w[4 * j + 2] + sv[3] * w[4 * j + 3]; }
                a = wave_sum(a);
                if (lane == b) mine = a;
            }
            if (lane < 17) out[(size_t)lane * 5632 + n] = mine;
        }
    }
    __syncthreads();
}

DI void norm_phase(const float* xl, const float* xc, const float* gain, const float* modl, int sh_off, int sc_off, bf16_t* h) {
    const int tid = tid_opq(), wave = tid >> 6, lane = tid & 63;
    for (int row0 = (blockIdx.x * 8 + wave) * 4; row0 < MR; row0 += gridDim.x * 32) {
        const float* src = row0 < TL ? xl + (size_t)row0 * 1024 : xc + (size_t)(row0 - TL) * 1024;
        const float* mb = modl + (size_t)(row0 < TL ? (row0 >> 12) : 16) * 6144;
        f32x4 v[4][4]; float ss[4];
#pragma unroll
        for (int r = 0; r < 4; ++r)
#pragma unroll
            for (int i = 0; i < 4; ++i) v[r][i] = *(const f32x4*)(src + (size_t)r * 1024 + i * 256 + lane * 4);
#pragma unroll
        for (int r = 0; r < 4; ++r) { float t = 0.f;
#pragma unroll
            for (int i = 0; i < 4; ++i) t += v[r][i][0] * v[r][i][0] + v[r][i][1] * v[r][i][1] + v[r][i][2] * v[r][i][2] + v[r][i][3] * v[r][i][3];
            ss[r] = t; }
#pragma unroll
        for (int o = 32; o >= 1; o >>= 1) {
#pragma unroll
            for (int r = 0; r < 4; ++r) ss[r] += __shfl_xor(ss[r], o);
        }
#pragma unroll
        for (int i = 0; i < 4; ++i) {
            const int c = i * 256 + lane * 4;
            const f32x4 g = *(const f32x4*)(gain + c), sc = *(const f32x4*)(mb + sc_off + c), sh = *(const f32x4*)(mb + sh_off + c);
            const f32x4 gs = g * (sc + 1.0f);
#pragma unroll
            for (int r = 0; r < 4; ++r) {
                const float rstd = rsqrtf(ss[r] * (1.0f / 1024.0f) + 1e-6f);
                const f32x4 y = (v[r][i] * rstd) * gs + sh;
                u32x2 w; w.x = cvt_pk_bf16(y[0], y[1]); w.y = cvt_pk_bf16(y[2], y[3]);
                *(u32x2*)(h + (size_t)(row0 + r) * 1024 + c) = w;
            }
        }
    }
}

DI void scan_rowbase(int dir, int b, int c, int& rb, int& sg) {
    if (dir == 0) { sg = 1; rb = c < 4 ? TL + b * CTXL + c * 64 : b * SEQ + (c - 4) * 64; }
    else { sg = -1; rb = c < 4 ? TL + b * CTXL + 255 - c * 64 : b * SEQ + 4095 - (c - 4) * 64; }
}
struct GPStage { unsigned qv[8], kv[8]; f32x4 lrv; float w2r[16][2]; f32x2 gbias; };
DI void gp_load(GPStage& S, int item, const bf16_t* qk, const float* lr, const float* w2, const float* gb, int tid, int wave, int d0) {
    const int c = item % 68, rest = item / 68, h = rest & 3, dir = (rest >> 2) & 1, b = rest >> 3;
    int rowbase, sgn; scan_rowbase(dir, b, c, rowbase, sgn);
#pragma unroll
    for (int i = 0; i < 8; ++i) { const size_t ro = (size_t)(rowbase + sgn * (wave * 8 + i)) * 1024; S.qv[i] = *(const unsigned*)(qk + ro + h * 128 + d0); S.kv[i] = *(const unsigned*)(qk + ro + 512 + h * 128 + d0); }
    S.lrv = (f32x4){0.f, 0.f, 0.f, 0.f};
    if (tid < 256) S.lrv = *(const f32x4*)(lr + (size_t)(rowbase + sgn * (tid >> 2)) * 32 + dir * 16 + (tid & 3) * 4);
#pragma unroll
    for (int r = 0; r < 16; ++r) { const f32x2 t = *(const f32x2*)(w2 + (size_t)(dir * 16 + r) * 512 + h * 128 + d0); S.w2r[r][0] = t.x; S.w2r[r][1] = t.y; }
    S.gbias = *(const f32x2*)(gb + dir * 512 + h * 128 + d0);
}
DI void gp_item(const GPStage& S, int item, bf16_t* GQ, bf16_t* GK, bf16_t* GP, float* GE, LAS unsigned char* lds, int tid, int wave, int lane) {
    constexpr int QD = 0, KI = 17408, LRS = 34816, SEG = 38912;
    const int l15 = lane & 15, lq = lane >> 4, d0 = 2 * lane;
    if (tid < 256) *(LAS f32x4*)(lds + LRS + (tid >> 2) * 64 + (tid & 3) * 16) = S.lrv;
    __syncthreads();
    const LAS float* lrs = (const LAS float*)(lds + LRS);
    float bl0[8], bl1[8]; float cum0 = 0.f, cum1 = 0.f;
#pragma unroll
    for (int i = 0; i < 8; ++i) {
        const int s = wave * 8 + i;
        float z0 = S.gbias.x, z1 = S.gbias.y;
#pragma unroll
        for (int r4 = 0; r4 < 4; ++r4) { const f32x4 lv = *(const LAS f32x4*)(lrs + s * 16 + r4 * 4);
#pragma unroll
            for (int j = 0; j < 4; ++j) { z0 += lv[j] * S.w2r[r4 * 4 + j][0]; z1 += lv[j] * S.w2r[r4 * 4 + j][1]; } }
        const float g0 = (fminf(z0, 0.f) - __logf(1.0f + __expf(-fabsf(z0)))) * 0.0625f;
        const float g1 = (fminf(z1, 0.f) - __logf(1.0f + __expf(-fabsf(z1)))) * 0.0625f;
        cum0 += g0; cum1 += g1; bl0[i] = cum0; bl1[i] = cum1;
    }
    *(LAS f32x2*)(lds + SEG + (wave * 128 + d0) * 4) = (f32x2){cum0, cum1};
    __syncthreads();
    float off0 = 0.f, off1 = 0.f, tot0 = 0.f, tot1 = 0.f;
#pragma unroll
    for (int w = 0; w < 8; ++w) { const f32x2 t = *(const LAS f32x2*)(lds + SEG + (w * 128 + d0) * 4); tot0 += t.x; tot1 += t.y; if (w < wave) { off0 += t.x; off1 += t.y; } }
    const float et0 = __expf(tot0), et1 = __expf(tot1);
    if (wave == 0) *(f32x2*)(GE + (size_t)item * 128 + d0) = (f32x2){et0, et1};
    {
        unsigned ks0[4], ks1[4];
        bf16_t* gq = GQ + (size_t)item * 8192;
#pragma unroll
        for (int i = 0; i < 8; ++i) {
            const int s = wave * 8 + i;
            const float b0 = off0 + bl0[i], b1 = off1 + bl1[i];
            const float q0 = bf_lo(S.qv[i]), q1 = bf_hi(S.qv[i]), k0 = bf_lo(S.kv[i]), k1 = bf_hi(S.kv[i]);
            const float eb0 = __expf(b0), eb1 = __expf(b1), ib0 = __builtin_amdgcn_rcpf(eb0), ib1 = __builtin_amdgcn_rcpf(eb1);
            const unsigned qd = cvt_pk_bf16(q0 * eb0, q1 * eb1);
            *(LAS unsigned*)(lds + QD + s * 272 + d0 * 2) = qd;
            *(unsigned*)(gq + s * 128 + d0) = qd;
            *(LAS unsigned*)(lds + KI + s * 272 + d0 * 2) = cvt_pk_bf16(k0 * ib0, k1 * ib1);
            const float e0 = k0 * (et0 * ib0), e1 = k1 * (et1 * ib1);
            if (i & 1) { ks0[i >> 1] = (ks0[i >> 1] & 0xffffu) | (cvt_pk_bf16(0.f, e0) & 0xffff0000u); ks1[i >> 1] = (ks1[i >> 1] & 0xffffu) | (cvt_pk_bf16(0.f, e1) & 0xffff0000u); }
            else { ks0[i >> 1] = cvt_pk_bf16(e0, 0.f) & 0xffffu; ks1[i >> 1] = cvt_pk_bf16(e1, 0.f) & 0xffffu; }
        }
        bf16_t* gk = GK + (size_t)item * 8192;
        *(u32x4*)(gk + d0 * 64 + wave * 8) = (u32x4){ks0[0], ks0[1], ks0[2], ks0[3]};
        *(u32x4*)(gk + (d0 + 1) * 64 + wave * 8) = (u32x4){ks1[0], ks1[1], ks1[2], ks1[3]};
    }
    __syncthreads();
    {
        bf16_t* gp = GP + (size_t)item * 4096;
        const int t0 = 16 * (wave >> 1);
#pragma unroll
        for (int j = 0; j < 2; ++j) {
            const int s0 = 16 * ((wave & 1) * 2 + j);
            f32x4 a4 = (f32x4){0.f, 0.f, 0.f, 0.f};
#pragma unroll
            for (int kk = 0; kk < 4; ++kk) {
                const bf16x8 af = *(const LAS bf16x8*)(lds + QD + (t0 + l15) * 272 + (kk * 32 + 8 * lq) * 2);
                const bf16x8 bf = *(const LAS bf16x8*)(lds + KI + (s0 + l15) * 272 + (kk * 32 + 8 * lq) * 2);
                a4 = __builtin_amdgcn_mfma_f32_16x16x32_bf16(af, bf, a4, 0, 0, 0);
            }
            const int sc = s0 + l15;
#pragma unroll
            for (int r = 0; r < 4; ++r) { const int t = t0 + 4 * lq + r; gp[t * 64 + sc] = f2bf(sc <= t ? a4[r] : 0.f); }
        }
    }
}
DI void gateprep_phase(const bf16_t* qk, const float* lr, const float* w2, const float* gb, bf16_t* GQ, bf16_t* GK, bf16_t* GP, float* GE, LAS unsigned char* lds) {
    const int tid = tid_opq(), wave = __builtin_amdgcn_readfirstlane(tid >> 6), lane = tid & 63, d0 = 2 * lane;
    const int G = gridDim.x;
    GPStage A, B;
    int item = opq((int)blockIdx.x);
    if (item < NCHI) gp_load(A, item, qk, lr, w2, gb, tid, wave, d0);
    for (; item < NCHI; item += 2 * G) {
        if (item + G < NCHI) gp_load(B, item + G, qk, lr, w2, gb, tid, wave, d0);
        gp_item(A, item, GQ, GK, GP, GE, lds, tid, wave, lane);
        if (item + G < NCHI) {
            if (item + 2 * G < NCHI) gp_load(A, item + 2 * G, qk, lr, w2, gb, tid, wave, d0);
            gp_item(B, item + G, GQ, GK, GP, GE, lds, tid, wave, lane);
        }
    }
    __syncthreads();
}

DI void scan_phase(const bf16_t* vr, const bf16_t* GQ, const bf16_t* GK, const bf16_t* GP, const float* GE, bf16_t* of, bf16_t* ob, LAS unsigned char* lds) {
    constexpr int QD = 0, KST = 17408, VT = 35840, ST = 54272, PP = 89088, BL = 98304;
    const int tid = tid_opq(), wave = __builtin_amdgcn_readfirstlane(tid >> 6), lane = tid & 63;
    const int l31 = lane & 31, lh = lane >> 5;
    for (int item = blockIdx.x; item < 256; item += gridDim.x) {
        const int xcd_ = item & 7, slot_ = item >> 3, dvh = slot_ & 1, pair_ = (slot_ >> 1) * 8 + xcd_;
        const int b = pair_ >> 3, dir = (pair_ >> 2) & 1, h = pair_ & 3;
        bf16_t* obuf = dir ? ob : of;
        const int d0 = 2 * lane;
        const int gi0 = ((b * 2 + dir) * 4 + h) * 68;
        f32x16 Sacc[2];
#pragma unroll
        for (int i = 0; i < 16; ++i) { Sacc[0][i] = 0.f; Sacc[1][i] = 0.f; }
        __syncthreads();
        { unsigned z_ = 0u; asm volatile("" : "+v"(z_));
          for (int o = tid; o < 34816 / 16; o += NTHREADS) *(LAS u32x4*)(lds + ST + o * 16) = (u32x4){z_, z_, z_, z_}; }
        const int vcol = h * 256 + dvh * 128 + d0;
        struct ScStage { u32x4 gq0, gq1, gk0, gk1, gp0; unsigned vv[8]; float ebv; } A, B;
        A.ebv = 0.f; B.ebv = 0.f;
#define SCAN_LOAD(S, c) do { int rb_, sg_; scan_rowbase(dir, b, (c), rb_, sg_); const size_t gi_ = (size_t)(gi0 + (c)); \
        S.gq0 = *(const u32x4*)(GQ + gi_ * 8192 + tid * 8); S.gq1 = *(const u32x4*)(GQ + gi_ * 8192 + 4096 + tid * 8); \
        S.gk0 = *(const u32x4*)(GK + gi_ * 8192 + tid * 8); S.gk1 = *(const u32x4*)(GK + gi_ * 8192 + 4096 + tid * 8); \
        S.gp0 = *(const u32x4*)(GP + gi_ * 4096 + tid * 8); if (tid < 128) S.ebv = GE[gi_ * 128 + tid]; \
        _Pragma("unroll") for (int i = 0; i < 8; ++i) S.vv[i] = *(const unsigned*)(vr + (size_t)(rb_ + sg_ * (wave * 8 + i)) * 2048 + vcol); } while (0)
#define SCAN_CHUNK(S, c) do { \
            int rowbase, sgn; scan_rowbase(dir, b, (c), rowbase, sgn); \
            { const int e0 = tid * 8, e1 = 4096 + tid * 8; \
              *(LAS u32x4*)(lds + QD + (e0 >> 7) * 272 + (e0 & 127) * 2) = S.gq0; *(LAS u32x4*)(lds + QD + (e1 >> 7) * 272 + (e1 & 127) * 2) = S.gq1; \
              *(LAS u32x4*)(lds + KST + (e0 >> 6) * 144 + (e0 & 63) * 2) = S.gk0; *(LAS u32x4*)(lds + KST + (e1 >> 6) * 144 + (e1 & 63) * 2) = S.gk1; \
              *(LAS u32x4*)(lds + PP + (e0 >> 6) * 144 + (e0 & 63) * 2) = S.gp0; \
              if (tid < 128) *(LAS float*)(lds + BL + tid * 4) = S.ebv; \
              unsigned vt0[4], vt1[4]; \
              _Pragma("unroll") for (int i = 0; i < 8; ++i) { \
                  if (i & 1) { vt0[i >> 1] = (vt0[i >> 1] & 0xffffu) | (S.vv[i] << 16); vt1[i >> 1] = (vt1[i >> 1] & 0xffffu) | (S.vv[i] & 0xffff0000u); } \
                  else { vt0[i >> 1] = S.vv[i] & 0xffffu; vt1[i >> 1] = S.vv[i] >> 16; } } \
              *(LAS u32x4*)(lds + VT + d0 * 144 + wave * 16) = (u32x4){vt0[0], vt0[1], vt0[2], vt0[3]}; \
              *(LAS u32x4*)(lds + VT + (d0 + 1) * 144 + wave * 16) = (u32x4){vt1[0], vt1[1], vt1[2], vt1[3]}; \
            } \
            __syncthreads();     \
            if ((c) + 2 < 68) SCAN_LOAD(S, (c) + 2); \
            { \
                const int tq = wave >> 2, vq = wave & 3; \
                f32x16 oacc; \
                _Pragma("unroll") for (int i = 0; i < 16; ++i) oacc[i] = 0.f; \
                _Pragma("unroll") for (int kk = 0; kk < 8; ++kk) { \
                    const bf16x8 af = *(const LAS bf16x8*)(lds + QD + (32 * tq + l31) * 272 + (kk * 16 + 8 * lh) * 2); \
                    const bf16x8 bf = *(const LAS bf16x8*)(lds + ST + (32 * vq + l31) * 272 + (kk * 16 + 8 * lh) * 2); \
                    oacc = __builtin_amdgcn_mfma_f32_32x32x16_bf16(af, bf, oacc, 0, 0, 0); } \
                _Pragma("unroll") for (int kk = 0; kk < 4; ++kk) { \
                    const bf16x8 af = *(const LAS bf16x8*)(lds + PP + (32 * tq + l31) * 144 + (kk * 16 + 8 * lh) * 2); \
                    const bf16x8 bf = *(const LAS bf16x8*)(lds + VT + (32 * vq + l31) * 144 + (kk * 16 + 8 * lh) * 2); \
                    oacc = __builtin_amdgcn_mfma_f32_32x32x16_bf16(af, bf, oacc, 0, 0, 0); } \
                const int ocol = h * 256 + dvh * 128 + 32 * vq + l31; \
                _Pragma("unroll") for (int r = 0; r < 16; ++r) { const int t = 32 * tq + crow(r, lh); obuf[(size_t)(rowbase + sgn * t) * 1024 + ocol] = f2bf(oacc[r]); } \
            } \
            { \
                const int vq = wave & 3; \
                _Pragma("unroll") for (int j = 0; j < 2; ++j) { \
                    const int dq = 2 * (wave >> 2) + j; \
                    _Pragma("unroll") for (int r = 0; r < 16; ++r) Sacc[j][r] *= *(const LAS float*)(lds + BL + (32 * dq + crow(r, lh)) * 4); \
                    _Pragma("unroll") for (int kk = 0; kk < 4; ++kk) { \
                        const bf16x8 af = *(const LAS bf16x8*)(lds + KST + (32 * dq + l31) * 144 + (kk * 16 + 8 * lh) * 2); \
                        const bf16x8 bf = *(const LAS bf16x8*)(lds + VT + (32 * vq + l31) * 144 + (kk * 16 + 8 * lh) * 2); \
                        Sacc[j] = __builtin_amdgcn_mfma_f32_32x32x16_bf16(af, bf, Sacc[j], 0, 0, 0); } } \
            } \
            __syncthreads();     \
            { \
                const int vq = wave & 3; \
                _Pragma("unroll") for (int j = 0; j < 2; ++j) { \
                    const int dq = 2 * (wave >> 2) + j; \
                    _Pragma("unroll") for (int g = 0; g < 4; ++g) { \
                        u32x2 w; w.x = cvt_pk_bf16(Sacc[j][4 * g], Sacc[j][4 * g + 1]); w.y = cvt_pk_bf16(Sacc[j][4 * g + 2], Sacc[j][4 * g + 3]); \
                        *(LAS u32x2*)(lds + ST + (32 * vq + l31) * 272 + (32 * dq + 8 * g + 4 * lh) * 2) = w; } } \
            } } while (0)
        SCAN_LOAD(A, 0); SCAN_LOAD(B, 1);
        for (int c = 0; c < 68; c += 2) { SCAN_CHUNK(A, c); SCAN_CHUNK(B, c + 1); }
#undef SCAN_CHUNK
#undef SCAN_LOAD
    }
    __syncthreads();
}

DI void glapost_phase(const bf16_t* of, const bf16_t* ob, const bf16_t* vr, const float* onorm, bf16_t* a) {
    const int tid = tid_opq(), wave = tid >> 6, lane = tid & 63;
    const int c0 = lane * 16;
    float gn[16];
#pragma unroll
    for (int j = 0; j < 4; ++j) { const f32x4 t = *(const f32x4*)(onorm + (c0 & 255) + 4 * j); gn[4 * j] = t[0]; gn[4 * j + 1] = t[1]; gn[4 * j + 2] = t[2]; gn[4 * j + 3] = t[3]; }
    for (int row0 = (blockIdx.x * 8 + wave) * 4; row0 < MR; row0 += gridDim.x * 32) {
        u32x4 f0[4], f1[4], b0[4], b1[4], r0[4], r1[4];
#pragma unroll
        for (int q = 0; q < 4; ++q) { const size_t ro = (size_t)(row0 + q);
            f0[q] = *(const u32x4*)(of + ro * 1024 + c0); f1[q] = *(const u32x4*)(of + ro * 1024 + c0 + 8);
            b0[q] = *(const u32x4*)(ob + ro * 1024 + c0); b1[q] = *(const u32x4*)(ob + ro * 1024 + c0 + 8);
            r0[q] = *(const u32x4*)(vr + ro * 2048 + 1024 + c0); r1[q] = *(const u32x4*)(vr + ro * 2048 + 1024 + c0 + 8); }
        asm volatile("" ::: "memory");
#pragma unroll
        for (int q = 0; q < 4; ++q) {
            float o[16], rr[16];
#pragma unroll
            for (int j = 0; j < 4; ++j) {
                o[2 * j] = bf_lo(f0[q][j]) + bf_lo(b0[q][j]); o[2 * j + 1] = bf_hi(f0[q][j]) + bf_hi(b0[q][j]);
                o[8 + 2 * j] = bf_lo(f1[q][j]) + bf_lo(b1[q][j]); o[8 + 2 * j + 1] = bf_hi(f1[q][j]) + bf_hi(b1[q][j]);
                rr[2 * j] = bf_lo(r0[q][j]); rr[2 * j + 1] = bf_hi(r0[q][j]); rr[8 + 2 * j] = bf_lo(r1[q][j]); rr[8 + 2 * j + 1] = bf_hi(r1[q][j]);
            }
            float ss = 0.f;
#pragma unroll
            for (int j = 0; j < 16; ++j) ss += o[j] * o[j];
            ss += __shfl_xor(ss, 1); ss += __shfl_xor(ss, 2); ss += __shfl_xor(ss, 4); ss += __shfl_xor(ss, 8);
            const float rstd = rsqrtf(ss * (1.0f / 256.0f) + 1e-6f);
            unsigned w[8];
#pragma unroll
            for (int j = 0; j < 8; ++j) {
                const float y0 = o[2 * j] * rstd * gn[2 * j] * silu_f(rr[2 * j]), y1 = o[2 * j + 1] * rstd * gn[2 * j + 1] * silu_f(rr[2 * j + 1]);
                w[j] = cvt_pk_bf16(y0, y1);
            }
            *(u32x4*)(a + (size_t)(row0 + q) * 1024 + c0) = (u32x4){w[0], w[1], w[2], w[3]};
            *(u32x4*)(a + (size_t)(row0 + q) * 1024 + c0 + 8) = (u32x4){w[4], w[5], w[6], w[7]};
        }
    }
}

DI void rope_cs(int tpos, int lane, float& cs, float& sn) {
    const int f = lane & 15; const int pos = (lane >> 5) ? (tpos & 63) : (tpos >> 6);
    const float inv = exp2f(-(float)f * (13.287712379549449f / 16.0f));
    const float ang = (float)pos * inv;
    const float kf = rintf(ang * 0.15915494309189535f);
    float r = fmaf(-kf, 6.2831854820251465f, ang); r = fmaf(-kf, -1.7484556000744883e-7f, r);
    cs = __cosf(r); sn = __sinf(r);
}
DI float rope_apply(float y, int lane, float cs, float sn) {
    const float pr = __shfl_xor(y, 16);
    return (lane & 16) ? (pr * sn + y * cs) : (y * cs - pr * sn);
}
DI int key_of_row(int row) {
    if (row < TL) { const int b = row >> 12; return b * KEYS + CTXL + (row & 4095); }
    const int rc = row - TL; const int b = rc >> 8; return b * KEYS + (rc & 255);
}

DI void mlamid_phase(const bf16_t* dn, const float* qln, const float* kvln, const float* knorm, bf16_t* cqn, bf16_t* ckvn, bf16_t* KB) {
    const int tid = tid_opq(), wave = tid >> 6, lane = tid & 63;
    float gq[6];
#pragma unroll
    for (int i = 0; i < 3; ++i) { gq[2 * i] = qln[i * 128 + 2 * lane]; gq[2 * i + 1] = qln[i * 128 + 2 * lane + 1]; }
    const f32x4 gkv = *(const f32x4*)(kvln + 4 * lane);
    const float gpe = knorm[128 + lane];
    for (int row0 = (blockIdx.x * 8 + wave) * 4; row0 < MR; row0 += gridDim.x * 32) {
        unsigned q[4][3]; u32x2 kvv[4]; bf16_t pe[4];
#pragma unroll
        for (int r = 0; r < 4; ++r) { const bf16_t* src = dn + (size_t)(row0 + r) * 768;
#pragma unroll
            for (int i = 0; i < 3; ++i) q[r][i] = *(const unsigned*)(src + i * 128 + 2 * lane);
            kvv[r] = *(const u32x2*)(src + 384 + 4 * lane); pe[r] = src[640 + lane]; }
#pragma unroll
        for (int r = 0; r < 4; ++r) {
            const int row = row0 + r;
            float ss = 0.f;
#pragma unroll
            for (int i = 0; i < 3; ++i) { const float a = bf_lo(q[r][i]), b = bf_hi(q[r][i]); ss += a * a + b * b; }
            ss = wave_sum(ss);
            float rstd = rsqrtf(ss * (1.0f / 384.0f) + 1e-6f);
#pragma unroll
            for (int i = 0; i < 3; ++i) *(unsigned*)(cqn + (size_t)row * 384 + i * 128 + 2 * lane) = cvt_pk_bf16(bf_lo(q[r][i]) * rstd * gq[2 * i], bf_hi(q[r][i]) * rstd * gq[2 * i + 1]);
            const float k0 = bf_lo(kvv[r].x), k1 = bf_hi(kvv[r].x), k2 = bf_lo(kvv[r].y), k3 = bf_hi(kvv[r].y);
            ss = wave_sum(k0 * k0 + k1 * k1 + k2 * k2 + k3 * k3);
            rstd = rsqrtf(ss * (1.0f / 256.0f) + 1e-6f);
            { u32x2 w; w.x = cvt_pk_bf16(k0 * rstd * gkv[0], k1 * rstd * gkv[1]); w.y = cvt_pk_bf16(k2 * rstd * gkv[2], k3 * rstd * gkv[3]);
              *(u32x2*)(ckvn + (size_t)row * 256 + 4 * lane) = w; }
            const float x = __uint_as_float(((unsigned)pe[r]) << 16);
            ss = wave_sum(x * x);
            rstd = rsqrtf(ss * (1.0f / 64.0f) + 1e-6f);
            float y = x * rstd * gpe;
            if (row < TL) { float cs, sn; rope_cs(row & 4095, lane, cs, sn); y = rope_apply(y, lane, cs, sn); }
            const bf16_t yb = f2bf(y);
            bf16_t* kd = KB + (size_t)key_of_row(row) * 1536 + 128 + lane;
#pragma unroll
            for (int hh = 0; hh < 8; ++hh) kd[hh * 192] = yb;
        }
    }
}

DI void qkprep_phase(bf16_t* KB, const float* knorm) {
    const int tid = tid_opq(), wave = tid >> 6, lane = tid & 63;
    const float kn0 = knorm[2 * lane], kn1 = knorm[2 * lane + 1];
    for (int row0 = (blockIdx.x * 8 + wave) * 2; row0 < MR; row0 += gridDim.x * 16) {
        unsigned ka[2][8];
        bf16_t* kr0 = KB + (size_t)key_of_row(row0) * 1536; bf16_t* kr1 = KB + (size_t)key_of_row(row0 + 1) * 1536;
#pragma unroll
        for (int hh = 0; hh < 8; ++hh) { ka[0][hh] = *(const unsigned*)(kr0 + hh * 192 + 2 * lane); ka[1][hh] = *(const unsigned*)(kr1 + hh * 192 + 2 * lane); }
        asm volatile("" ::: "memory");
#pragma unroll
        for (int r = 0; r < 2; ++r) {
            bf16_t* kr = r ? kr1 : kr0;
#pragma unroll
            for (int hh = 0; hh < 8; ++hh) {
                const float c0 = bf_lo(ka[r][hh]), c1 = bf_hi(ka[r][hh]);
                const float s3 = wave_sum(c0 * c0 + c1 * c1);
                const float r3 = rsqrtf(s3 * (1.0f / 128.0f) + 1e-6f);
                *(unsigned*)(kr + hh * 192 + 2 * lane) = cvt_pk_bf16(c0 * r3 * kn0, c1 * r3 * kn1);
            }
        }
    }
}

namespace att {
constexpr int DQK = 192, DV = 128, NW = 8, QBLK = 32, KVBLK = 64;
constexpr int LDQ = 1536, LDK = 1536, LDV = 1024, LDO = 1024;
constexpr float SCALE = 0.07216878364870322f;
constexpr float THR = 8.f;
constexpr size_t SHM_V = KVBLK * DV * 2, SHM_K = KVBLK * DQK * 2;
#define KSWZ(row, colB) ((row) * 384 + ((colB) ^ ((((row) >> 1) & 7) << 4)))
#define SBAR() __builtin_amdgcn_sched_barrier(0)
DI unsigned cvtpk(float lo, float hi) { unsigned r; asm volatile("v_cvt_pk_bf16_f32 %0, %1, %2" : "=v"(r) : "v"(lo), "v"(hi)); return r; }
DI void partialSM(f32x16& p0, f32x16& p1, float& m_reg, float& mn, float& alpha) {
    constexpr float C = SCALE * 1.4426950408889634f;
    float pmax = p0[0];
#pragma unroll
    for (int r = 1; r < 16; ++r) pmax = fmaxf(pmax, p0[r]);
#pragma unroll
    for (int r = 0; r < 16; ++r) pmax = fmaxf(pmax, p1[r]);
    { auto rr = __builtin_amdgcn_permlane32_swap(__float_as_uint(pmax), __float_as_uint(pmax), false, false);
      pmax = fmaxf(__uint_as_float(rr[0]), __uint_as_float(rr[1])); }
    if (__builtin_expect(__all(pmax - m_reg <= THR / SCALE), 1)) { mn = m_reg; alpha = 1.f; }
    else { mn = fmaxf(m_reg, pmax); alpha = __builtin_amdgcn_exp2f((m_reg - mn) * C); m_reg = mn; }
    const float mnC = -mn * C;
#pragma unroll
    for (int r = 0; r < 16; ++r) p0[r] = fmaf(p0[r], C, mnC);
#pragma unroll
    for (int r = 0; r < 16; ++r) p1[r] = fmaf(p1[r], C, mnC);
#pragma unroll
    for (int r = 0; r < 16; ++r) p0[r] = __builtin_amdgcn_exp2f(p0[r]);
}
DI void finishSM(f32x16& p0, f32x16& p1, float alpha, float& l_reg, bf16x8& pa0, bf16x8& pa1, bf16x8& pa2, bf16x8& pa3) {
#pragma unroll
    for (int r = 0; r < 16; ++r) p1[r] = __builtin_amdgcn_exp2f(p1[r]);
    float ps = 0;
#pragma unroll
    for (int r = 0; r < 16; ++r) ps += p0[r];
#pragma unroll
    for (int r = 0; r < 16; ++r) ps += p1[r];
    { auto rr = __builtin_amdgcn_permlane32_swap(__float_as_uint(ps), __float_as_uint(ps), false, false);
      ps = __uint_as_float(rr[0]) + __uint_as_float(rr[1]); }
    l_reg = l_reg * alpha + ps;
#define PK4(P, BASE, OUT) do { unsigned a0 = cvtpk(P[BASE + 0], P[BASE + 1]), a1 = cvtpk(P[BASE + 2], P[BASE + 3]);   \
    unsigned b0 = cvtpk(P[BASE + 4], P[BASE + 5]), b1 = cvtpk(P[BASE + 6], P[BASE + 7]);                              \
    auto r0 = __builtin_amdgcn_permlane32_swap(a0, b0, false, false); auto r1 = __builtin_amdgcn_permlane32_swap(a1, b1, false, false); \
    u32x4 w = {r0[0], r1[0], r0[1], r1[1]}; OUT = *reinterpret_cast<bf16x8*>(&w); } while (0)
    PK4(p0, 0, pa0); PK4(p0, 8, pa1); PK4(p1, 0, pa2); PK4(p1, 8, pa3);
#undef PK4
}
DI void qkt(f32x16& p0, f32x16& p1, const char* Ks, const bf16x8* qr, int r32, int hi) {
#pragma unroll
    for (int r = 0; r < 16; ++r) { p0[r] = 0.f; p1[r] = 0.f; }
    bf16x8 ka[3], kb[3];
#define QK_RD(D0, SLOT) do { const int cb_ = ((D0) * 16 + hi * 8) * 2; ka[SLOT] = *reinterpret_cast<const bf16x8*>(Ks + KSWZ(r32, cb_)); kb[SLOT] = *reinterpret_cast<const bf16x8*>(Ks + KSWZ(32 + r32, cb_)); } while (0)
    QK_RD(0, 0); QK_RD(1, 1);
    __builtin_amdgcn_sched_barrier(0);
#pragma unroll
    for (int d0 = 0; d0 < 12; ++d0) {
        if (d0 + 2 < 12) QK_RD(d0 + 2, (d0 + 2) % 3);
        p0 = __builtin_amdgcn_mfma_f32_32x32x16_bf16(ka[d0 % 3], qr[d0], p0, 0, 0, 0);
        p1 = __builtin_amdgcn_mfma_f32_32x32x16_bf16(kb[d0 % 3], qr[d0], p1, 0, 0, 0);
        __builtin_amdgcn_sched_barrier(0);
    }
#undef QK_RD
}
DI int v_st(int k, int c) { const int kk = (k & ~0xC) | ((k & 4) << 1) | ((k & 8) >> 1); return ((kk >> 3) * 4 + (c >> 5)) * 512 + ((kk & 7) * 32 + (c & 31)) * 2; }
DI int v_rd_base(int lane) { return ((lane & 3) << 3) | (((lane >> 2) & 3) << 6) | (((lane >> 4) & 1) << 5) | (((lane >> 5) & 1) << 8); }
constexpr int v_rd_off(int d0, int ks, int half) { return d0 * 512 + ks * 4096 + half * 2048; }
template <int OFF> DI s16x4 tr_read(int vb) { s16x4 r; asm volatile("ds_read_b64_tr_b16 %0, %1 offset:%2" : "=&v"(r) : "v"(vb), "i"(OFF) : "memory"); return r; }
template <int D0> DI void pv_one(f32x16& od, int vb, bf16x8 pa0, bf16x8 pa1, bf16x8 pa2, bf16x8 pa3) {
    const s16x4 l0 = tr_read<v_rd_off(D0, 0, 0)>(vb), h0 = tr_read<v_rd_off(D0, 0, 1)>(vb), l1 = tr_read<v_rd_off(D0, 1, 0)>(vb), h1 = tr_read<v_rd_off(D0, 1, 1)>(vb);
    const s16x4 l2 = tr_read<v_rd_off(D0, 2, 0)>(vb), h2 = tr_read<v_rd_off(D0, 2, 1)>(vb), l3 = tr_read<v_rd_off(D0, 3, 0)>(vb), h3 = tr_read<v_rd_off(D0, 3, 1)>(vb);
    asm volatile("s_waitcnt lgkmcnt(0)" ::: "memory"); SBAR();
#define PK(L, H) (bf16x8){L[0], L[1], L[2], L[3], H[0], H[1], H[2], H[3]}
    od = __builtin_amdgcn_mfma_f32_32x32x16_bf16(pa0, PK(l0, h0), od, 0, 0, 0);
    od = __builtin_amdgcn_mfma_f32_32x32x16_bf16(pa1, PK(l1, h1), od, 0, 0, 0);
    od = __builtin_amdgcn_mfma_f32_32x32x16_bf16(pa2, PK(l2, h2), od, 0, 0, 0);
    od = __builtin_amdgcn_mfma_f32_32x32x16_bf16(pa3, PK(l3, h3), od, 0, 0, 0);
#undef PK
}
DI void pv_d0(f32x16* o, int vb, bf16x8 pa0, bf16x8 pa1, bf16x8 pa2, bf16x8 pa3) {
    pv_one<0>(o[0], vb, pa0, pa1, pa2, pa3); pv_one<1>(o[1], vb, pa0, pa1, pa2, pa3); pv_one<2>(o[2], vb, pa0, pa1, pa2, pa3); pv_one<3>(o[3], vb, pa0, pa1, pa2, pa3);
}
DI void attn_body(const bf16_t* __restrict__ Qb, const bf16_t* __restrict__ Kh, const bf16_t* __restrict__ Vh, bf16_t* __restrict__ Ob, int seq, char* lds, const float* __restrict__ qnorm, int tpos0) {
    const int tid = tid_opq(), wid = tid >> 6, lane = tid & 63, r32 = lane & 31, hi = lane >> 5;
    char* V_lds = lds; char* K_lds = lds + 2 * SHM_V;
    float* wsf = (float*)(lds + 2 * SHM_V + 2 * SHM_K) + wid * 64; float* li_l = wsf; float* al_l = wsf + 32;
    float m_reg = -1e30f, l_reg = 0; f32x16 o[4]; bf16x8 qr[12];
#pragma unroll
    for (int d = 0; d < 4; ++d)
#pragma unroll
        for (int r = 0; r < 16; ++r) o[d][r] = 0.f;
    const bf16_t* Qw = Qb + (long)(wid * QBLK + r32) * LDQ + hi * 8;
#pragma unroll
    for (int d0 = 0; d0 < 12; ++d0) qr[d0] = *reinterpret_cast<const bf16x8*>(Qw + d0 * 16);
    {
        float ssn = 0.f, ssr = 0.f;
#pragma unroll
        for (int d0 = 0; d0 < 12; ++d0) {
            const u32x4 w = *reinterpret_cast<const u32x4*>(&qr[d0]); float t = 0.f;
#pragma unroll
            for (int j = 0; j < 4; ++j) { const float a = bf_lo(w[j]), b = bf_hi(w[j]); t += a * a + b * b; }
            if (d0 < 8) ssn += t; else ssr += t;
        }
        ssn += __shfl_xor(ssn, 32); ssr += __shfl_xor(ssr, 32);
        const float rn = rsqrtf(ssn * (1.0f / 128.0f) + 1e-6f), rr = rsqrtf(ssr * (1.0f / 64.0f) + 1e-6f);
        float cs[2][8], sn[2][8];
        if (tpos0 >= 0) {
            const int t = tpos0 + wid * QBLK + r32;
#pragma unroll
            for (int a = 0; a < 2; ++a) { const float pos = (float)(a ? (t & 63) : (t >> 6));
#pragma unroll
                for (int j = 0; j < 8; ++j) { const float inv = exp2f(-(float)(hi * 8 + j) * (13.287712379549449f / 16.0f)); const float ang = pos * inv;
                    const float kf = rintf(ang * 0.15915494309189535f); float r = fmaf(-kf, 6.2831854820251465f, ang); r = fmaf(-kf, -1.7484556000744883e-7f, r);
                    cs[a][j] = __cosf(r); sn[a][j] = __sinf(r); } }
        } else {
#pragma unroll
            for (int a = 0; a < 2; ++a)
#pragma unroll
                for (int j = 0; j < 8; ++j) { cs[a][j] = 1.f; sn[a][j] = 0.f; }
        }
#pragma unroll
        for (int d0 = 0; d0 < 8; ++d0) {
            const u32x4 w = *reinterpret_cast<const u32x4*>(&qr[d0]); const float* gp = qnorm + d0 * 16 + hi * 8; const f32x4 g0 = *(const f32x4*)gp, g1 = *(const f32x4*)(gp + 4);
            u32x4 o4; o4.x = cvt_pk_bf16(bf_lo(w.x) * rn * g0[0], bf_hi(w.x) * rn * g0[1]); o4.y = cvt_pk_bf16(bf_lo(w.y) * rn * g0[2], bf_hi(w.y) * rn * g0[3]);
            o4.z = cvt_pk_bf16(bf_lo(w.z) * rn * g1[0], bf_hi(w.z) * rn * g1[1]); o4.w = cvt_pk_bf16(bf_lo(w.w) * rn * g1[2], bf_hi(w.w) * rn * g1[3]);
            qr[d0] = *reinterpret_cast<const bf16x8*>(&o4);
        }
#pragma unroll
        for (int a = 0; a < 2; ++a) {
            const u32x4 w1 = *reinterpret_cast<const u32x4*>(&qr[8 + 2 * a]), w2 = *reinterpret_cast<const u32x4*>(&qr[9 + 2 * a]);
            const float* g1p = qnorm + (8 + 2 * a) * 16 + hi * 8; const float* g2p = g1p + 16;
            float x1[8], x2[8], y1[8], y2[8];
#pragma unroll
            for (int j = 0; j < 4; ++j) { x1[2 * j] = bf_lo(w1[j]) * rr * g1p[2 * j]; x1[2 * j + 1] = bf_hi(w1[j]) * rr * g1p[2 * j + 1]; x2[2 * j] = bf_lo(w2[j]) * rr * g2p[2 * j]; x2[2 * j + 1] = bf_hi(w2[j]) * rr * g2p[2 * j + 1]; }
#pragma unroll
            for (int j = 0; j < 8; ++j) { y1[j] = x1[j] * cs[a][j] - x2[j] * sn[a][j]; y2[j] = x1[j] * sn[a][j] + x2[j] * cs[a][j]; }
            u32x4 o1, o2;
            o1.x = cvt_pk_bf16(y1[0], y1[1]); o1.y = cvt_pk_bf16(y1[2], y1[3]); o1.z = cvt_pk_bf16(y1[4], y1[5]); o1.w = cvt_pk_bf16(y1[6], y1[7]);
            o2.x = cvt_pk_bf16(y2[0], y2[1]); o2.y = cvt_pk_bf16(y2[2], y2[3]); o2.z = cvt_pk_bf16(y2[4], y2[5]); o2.w = cvt_pk_bf16(y2[6], y2[7]);
            qr[8 + 2 * a] = *reinterpret_cast<const bf16x8*>(&o1); qr[9 + 2 * a] = *reinterpret_cast<const bf16x8*>(&o2);
        }
    }
    const int sr = tid >> 4, sc = (tid & 15) * 8, vst0 = v_st(sr, sc), vst1 = v_st(32 + sr, sc);
    const int pr = tid >> 3, pc = 128 + (tid & 7) * 8;
    const int vb0 = (int)(uintptr_t)V_lds + v_rd_base(lane);
    bf16x8 vs0, vs1, ks0, ks1, kp;
#define SLOAD(k0) do { vs0 = *reinterpret_cast<const bf16x8*>(&Vh[(long)((k0) + sr) * LDV + sc]); vs1 = *reinterpret_cast<const bf16x8*>(&Vh[(long)((k0) + 32 + sr) * LDV + sc]); \
    ks0 = *reinterpret_cast<const bf16x8*>(&Kh[(long)((k0) + sr) * LDK + sc]); ks1 = *reinterpret_cast<const bf16x8*>(&Kh[(long)((k0) + 32 + sr) * LDK + sc]); \
    kp = *reinterpret_cast<const bf16x8*>(&Kh[(long)((k0) + pr) * LDK + pc]); } while (0)
#define SWRITE(b) do { *(bf16x8*)(V_lds + (b) * SHM_V + vst0) = vs0; *(bf16x8*)(V_lds + (b) * SHM_V + vst1) = vs1; \
    *(bf16x8*)(K_lds + (b) * SHM_K + KSWZ(sr, sc * 2)) = ks0; *(bf16x8*)(K_lds + (b) * SHM_K + KSWZ(32 + sr, sc * 2)) = ks1; \
    *(bf16x8*)(K_lds + (b) * SHM_K + KSWZ(pr, pc * 2)) = kp; } while (0)
#define RESC(a) do { if (__any((a) < 1.f)) { if (hi == 0) al_l[r32] = (a); asm volatile("s_waitcnt lgkmcnt(0)" ::: "memory"); \
    _Pragma("unroll") for (int d = 0; d < 4; ++d) _Pragma("unroll") for (int r = 0; r < 16; ++r) o[d][r] *= al_l[crow(r, hi)]; } } while (0)
    f32x16 p0, p1; float mn, al; bf16x8 pa0, pa1, pa2, pa3; const int NT = seq / KVBLK;
    SLOAD(0); asm volatile("s_waitcnt vmcnt(0)" ::: "memory"); SWRITE(0); __syncthreads();
    for (int j = 0; j < NT; ++j) {
        const int cb = j & 1;
        if (j + 1 < NT) SLOAD((j + 1) * KVBLK);
        SBAR(); qkt(p0, p1, K_lds + cb * SHM_K, qr, r32, hi);
        partialSM(p0, p1, m_reg, mn, al);
        finishSM(p0, p1, al, l_reg, pa0, pa1, pa2, pa3);
        RESC(al); SBAR();
        pv_d0(o, vb0 + cb * (int)SHM_V, pa0, pa1, pa2, pa3);
        if (j + 1 < NT) { asm volatile("s_waitcnt vmcnt(0)" ::: "memory"); SWRITE(cb ^ 1); }
        __syncthreads();
    }
    if (hi == 0) li_l[r32] = l_reg; asm volatile("s_waitcnt lgkmcnt(0)" ::: "memory");
    float rli[16];
#pragma unroll
    for (int r = 0; r < 16; ++r) rli[r] = __builtin_amdgcn_rcpf(li_l[crow(r, hi)]);
    bf16_t* Ow = Ob + (long)(wid * QBLK) * LDO;
#pragma unroll
    for (int r = 0; r < 16; ++r) { const int orow = crow(r, hi);
#pragma unroll
        for (int d0 = 0; d0 < 4; ++d0) Ow[(long)orow * LDO + d0 * 32 + r32] = f2bf(o[d0][r] * rli[r]); }
#undef SLOAD
#undef SWRITE
#undef RESC
}
#undef KSWZ
#undef SBAR
}

DI void attn_phase(const bf16_t* Q, const bf16_t* KB, const bf16_t* VB, bf16_t* O, char* lds, int nitems, const float* qnorm) {
    for (int it = blockIdx.x; it < nitems; it += gridDim.x) {
        int b, h, qrow0, seq, tpos0;
        if (it < 2048) {
            const int rnd = it >> 8, blk = it & 255, xcd_ = blk & 7, slot_ = blk >> 3, idx = rnd * 16 + xcd_ * 2 + (slot_ >> 4);
            b = idx >> 3; h = idx & 7; tpos0 = (slot_ & 15) * 256; qrow0 = b * SEQ + tpos0; seq = KEYS; }
        else { const int j = it - 2048; b = j >> 3; h = j & 7; qrow0 = TL + b * CTXL; seq = CTXL; tpos0 = -1; }
        att::attn_body(Q + (size_t)qrow0 * 1536 + h * 192, KB + (size_t)b * KEYS * 1536 + h * 192, VB + (size_t)b * KEYS * 1024 + h * 128,
                       O + (size_t)qrow0 * 1024 + h * 128, seq, lds, qnorm, tpos0);
        __syncthreads();
    }
}

DI void fixup_phase(const float* halo, const float* cw, const float* cb, bf16_t* act) {
    const int gtid = blockIdx.x * NTHREADS + tid_opq(), gstride = gridDim.x * NTHREADS;
    for (int idx = gtid; idx < 272 * 22 * 64; idx += gstride) {
        const int c4 = (idx & 31) * 4, which = (idx >> 5) & 1, t = idx >> 6, pn = t % 22, pm = t / 22;
        const float* hp = halo + (size_t)(pm * 22 + pn) * 4 * 256;
        const bool sfirst = pm >= 256 || (pm & 15) == 0, slast = pm >= 256 || (pm & 15) == 15;
        const f32x4 z4 = (f32x4){0.f, 0.f, 0.f, 0.f};
        f32x4 pa, pg, ca, cg_, na, ng; int row;
        if (which == 0) { row = pm * 256;
            if (sfirst) { pa = z4; pg = z4; } else { const float* q = halo + (size_t)((pm - 1) * 22 + pn) * 4 * 256 + 3 * 256; pa = *(const f32x4*)(q + c4); pg = *(const f32x4*)(q + 128 + c4); }
            ca = *(const f32x4*)(hp + c4); cg_ = *(const f32x4*)(hp + 128 + c4); na = *(const f32x4*)(hp + 256 + c4); ng = *(const f32x4*)(hp + 256 + 128 + c4);
        } else { row = pm * 256 + 255;
            pa = *(const f32x4*)(hp + 2 * 256 + c4); pg = *(const f32x4*)(hp + 2 * 256 + 128 + c4); ca = *(const f32x4*)(hp + 3 * 256 + c4); cg_ = *(const f32x4*)(hp + 3 * 256 + 128 + c4);
            if (slast) { na = z4; ng = z4; } else { const float* q = halo + (size_t)((pm + 1) * 22 + pn) * 4 * 256; na = *(const f32x4*)(q + c4); ng = *(const f32x4*)(q + 128 + c4); }
        }
        const int ch = pn * 128 + c4;
        const f32x4 w0a = *(const f32x4*)(cw + ch), w1a = *(const f32x4*)(cw + 5632 + ch), w2a = *(const f32x4*)(cw + 2 * 5632 + ch), ba = *(const f32x4*)(cb + ch);
        const f32x4 w0g = *(const f32x4*)(cw + 2816 + ch), w1g = *(const f32x4*)(cw + 5632 + 2816 + ch), w2g = *(const f32x4*)(cw + 2 * 5632 + 2816 + ch), bg = *(const f32x4*)(cb + 2816 + ch);
        const f32x4 av = w0a * pa + w1a * ca + w2a * na + ba, gv = w0g * pg + w1g * cg_ + w2g * ng + bg;
        u32x2 w; w.x = cvt_pk_bf16(silu_f(gv[0]) * av[0], silu_f(gv[1]) * av[1]); w.y = cvt_pk_bf16(silu_f(gv[2]) * av[2], silu_f(gv[3]) * av[3]);
        *(u32x2*)(act + (size_t)row * 2816 + ch) = w;
    }
}


#define XB_TMO      128
#define XB_XCNT(j)  (256  + 64 * (j))
#define XB_XSUB(j)  (1280 + 64 * (j))
#define XB_XGEN(j)  (2304 + 64 * (j))
#define XB_TOP      3328
#define XB_TOPGEN   3392
#define XCD_BAR_WORDS 3456
#define XB_SPIN_CAP (1u << 18)
DI unsigned xb_ld(unsigned* p)              { return __hip_atomic_load(p, __ATOMIC_RELAXED, __HIP_MEMORY_SCOPE_AGENT); }
DI unsigned xb_add(unsigned* p, unsigned v) { return __hip_atomic_fetch_add(p, v, __ATOMIC_RELAXED, __HIP_MEMORY_SCOPE_AGENT); }
DI unsigned xb_xcc_id() { return (unsigned)__builtin_amdgcn_s_getreg((3 << 11) | 20) & 0xFu; }
#define XB_SPIN(cond, bar) do { unsigned _sp = 0; while (cond) { __builtin_amdgcn_s_sleep(1); \
    if ((++_sp & 255u) == 0u) { if (xb_ld(&(bar)[XB_TMO])) break; if (_sp > XB_SPIN_CAP) { atomicAdd(&(bar)[XB_TMO], 1u); break; } } } } while (0)
struct XcdBarrier { unsigned* bar; unsigned x; volatile LAS unsigned* st; };
DI XcdBarrier xcd_barrier_post(unsigned* bar, volatile LAS unsigned* st) {
    XcdBarrier b; b.bar = bar; b.x = xb_xcc_id(); b.st = st;
    if (threadIdx.x == 0) (void)xb_add(&bar[XB_XCNT(b.x)], 1u);
    return b;
}
DI void xcd_barrier_complete(unsigned* bar, unsigned x, unsigned& nloc, unsigned& nx) {
    const unsigned G = gridDim.x * gridDim.y * gridDim.z;
    unsigned sum, cnt, mine, sp = 0u;
    for (;;) {
        sum = 0u; cnt = 0u; mine = 0u;
#pragma unroll
        for (unsigned j = 0; j < 16; ++j) { const unsigned c = xb_ld(&bar[XB_XCNT(j)]); sum += c; cnt += (c > 0u) ? 1u : 0u; mine = (j == x) ? c : mine; }
        if (sum == G) break;
        __builtin_amdgcn_s_sleep(1);
        if ((++sp & 255u) == 0u) { if (xb_ld(&bar[XB_TMO])) break; if (sp > XB_SPIN_CAP) { atomicAdd(&bar[XB_TMO], 1u); break; } }
    }
    nloc = mine > 0u ? mine : 1u; nx = cnt > 0u ? cnt : 1u;
}
DI void xcd_barrier(const XcdBarrier& b) {
    asm volatile("s_waitcnt vmcnt(0)" ::: "memory");
    __syncthreads();
    if (threadIdx.x == 0) {
        unsigned* bar = b.bar;
        __builtin_amdgcn_s_waitcnt(0);
        unsigned nloc = b.st[0], nx = b.st[1];
        if (nloc == 0u) { xcd_barrier_complete(bar, b.x, nloc, nx); b.st[0] = nloc; b.st[1] = nx; }
        const unsigned old = xb_add(&bar[XB_XSUB(b.x)], 1u);
        const unsigned gen = old / nloc;
        if (old + 1u == (gen + 1u) * nloc) {
            __builtin_amdgcn_fence(__ATOMIC_RELEASE, "agent");
            asm volatile("s_waitcnt vmcnt(0)" ::: "memory");
            const unsigned og = xb_add(&bar[XB_TOP], 1u);
            const unsigned tg = og / nx;
            if (og + 1u == (tg + 1u) * nx) xb_add(&bar[XB_TOPGEN], 1u);
            else XB_SPIN(xb_ld(&bar[XB_TOPGEN]) == tg, bar);
            __builtin_amdgcn_fence(__ATOMIC_ACQUIRE, "agent");
            xb_add(&bar[XB_XGEN(b.x)], 1u);
            asm volatile("s_waitcnt vmcnt(0)" ::: "memory");
        } else {
            XB_SPIN(xb_ld(&bar[XB_XGEN(b.x)]) == gen, bar);
            __builtin_amdgcn_fence(__ATOMIC_ACQUIRE, "agent");
            asm volatile("s_waitcnt vmcnt(0)" ::: "memory");
        }
    }
    __syncthreads();
}

__global__ void __launch_bounds__(NTHREADS) mega(Params p) {
    extern __shared__ __attribute__((aligned(16))) unsigned char smem[];
    LAS unsigned char* lds = (LAS unsigned char*)smem;
    cg::grid_group grid = cg::this_grid();
    volatile LAS unsigned* xb_st = (volatile LAS unsigned*)(lds + XB_ST_OFF);
    if (threadIdx.x < 4) xb_st[threadIdx.x] = 0u;
    __syncthreads();
    XcdBarrier xbar = xcd_barrier_post((unsigned*)((unsigned char*)p.in[27] + WS_BAR), xb_st);

    for (int ph = p.ph_lo; ph < p.ph_hi; ++ph) {
        unsigned char* ws = (unsigned char*)p.in[opq(27)];
        float* const xout = (float*)p.in[opq(26)];
        float* mod = (float*)(ws + WS_MOD);
        float* xc = (float*)(ws + WS_XC);
        bf16_t* hbuf = (bf16_t*)(ws + WS_H);
        if (ph == 0) {
            prep_phase(p, lds);
#if defined(MK_DUP_OP) && MK_DUP_OP == 99
            grid.sync(); prep_phase(p, lds);
#endif
        } else {
            const int q = ph - 1, lp = q / 21; int r = q % 21; int layer, nmix;
            if (r < 10) { layer = 2 * lp; nmix = 6; } else { layer = 2 * lp + 1; r -= 10; nmix = 7; }
            const bool is_mla = layer & 1; const int j = layer >> 1;
            const float* modl = mod + (size_t)layer * 17 * 6144;
            const bool first = (layer == 0);
            int op = -1, gsel = 0, hf = 0;
            if (r < nmix) {
                if (!is_mla) { op = r == 0 ? 0 : r == 1 ? 2 : r == 2 ? 9 : r == 3 ? 3 : r == 4 ? 4 : 2; gsel = r == 1 ? 0 : 1; }
                else { op = r == 0 ? 0 : r == 1 ? 2 : r == 2 ? 5 : r == 3 ? 2 : r == 4 ? 6 : r == 5 ? 7 : 2; gsel = r == 1 ? 2 : r == 3 ? 3 : 5; }
            } else {
                const int f = r - nmix;
                op = f == 0 ? 1 : f == 2 ? 8 : 2; gsel = f == 1 ? 6 : 7;
            }
            if (op == 1 || op == 6 || (op == 0 && layer > 0)) continue;
#ifdef MK_DUP_OP
            for (int rep_ = 0; rep_ < ((op == MK_DUP_OP || (op == 2 && gsel == MK_DUP_OP - 100)) ? 2 : 1); ++rep_) {
            if (rep_) grid.sync();
#else
            {
#endif
            if (op == 0) {
                norm_phase(p.in[opq(0)], p.in[opq(2)], p.in[opq(6)], modl, 0, 1024, hbuf);
                shw_phase(ws, lds);
            } else if (op == 2) {
                const int ng = (gsel == 3) ? 2 : 1;
                for (int gi = 0; gi < ng; ++gi) {
                    pg8::Gemm g; Epi E; int kind = EPI_BF16;
                    E.ldc = 0; E.xch = (LAS float*)(lds + XCH_OFF); E.q0 = nullptr; E.q1 = nullptr; E.q2 = nullptr; E.q3 = nullptr; E.q4 = nullptr; E.q5 = nullptr;
                    float* const shw_mix = (float*)(ws + WS_SHW) + (size_t)(layer * 2) * 17 * 5632; float* const shw_ffn = shw_mix + 17 * 5632;
                    float* const rs0 = (float*)(ws + WS_RS); float* const rs1 = rs0 + MR;
                    g.M = MR;
                    const int gs = gsel + gi;
                    if (gs == 0) { g.A = hbuf; g.Bt = (const bf16_t*)(ws + WS_GIN + j * SZ_GIN); g.N = 3328; g.K = 1024; g.lda = 1024; g.ldb = 1024;
                        kind = EPI_GLA_IN; E.q0 = ws + WS_QK; E.ldc = 1024; E.q1 = ws + WS_LR; E.q2 = ws + WS_VR; if (!first) { E.q3 = rs1; E.q4 = shw_mix; } }
                    else if (gs == 1 || gs == 5) { g.A = hbuf; g.Bt = (const bf16_t*)(ws + (gs == 1 ? WS_GOUT : WS_MOUT) + j * SZ_SQ); g.N = 1024; g.K = 1024; g.lda = 1024; g.ldb = 1024;
                        kind = EPI_RESID; E.ldc = 0; E.q0 = (void*)(first ? p.in[opq(0)] : xout); E.q1 = (void*)(first ? p.in[opq(2)] : xc); E.q2 = xout; E.q3 = ws; E.q4 = (void*)modl; E.q5 = (void*)(p.in[opq(7)] + layer * 1024);
                        for (int i = blockIdx.x * NTHREADS + tid_opq(); i < MR; i += gridDim.x * NTHREADS) rs1[i] = 0.f; }
                    else if (gs == 2) { g.A = hbuf; g.Bt = (const bf16_t*)(ws + WS_MDOWN + j * SZ_MDOWN); g.N = 768; g.K = 1024; g.lda = 1024; g.ldb = 1024;
                        E.q0 = ws + WS_DN; E.ldc = 768; E.q3 = rs1; E.q4 = shw_mix; }
                    else if (gs == 3) { g.A = (const bf16_t*)(ws + WS_CQN); g.Bt = (const bf16_t*)(ws + WS_MUQ + j * SZ_MUQ); g.N = 1536; g.K = 384; g.lda = 384; g.ldb = 384;
                        E.q0 = ws + WS_QRAW; E.ldc = 1536; }
                    else if (gs == 4) { g.A = (const bf16_t*)(ws + WS_CKVN); g.Bt = (const bf16_t*)(ws + WS_MUKV + j * SZ_MUKV); g.N = 2048; g.K = 256; g.lda = 256; g.ldb = 256;
                        kind = EPI_UKV; E.q0 = ws + WS_KB; E.q1 = ws + WS_VB; E.q2 = (void*)(p.in[opq(20)] + j * 192); }
                    else if (gs == 6) { g.A = (const bf16_t*)(ws + WS_XSA); g.Bt = (const bf16_t*)(ws + WS_FUP + (size_t)layer * SZ_FUP); g.N = 5632; g.K = 1024; g.lda = 1024; g.ldb = 1024;
                        kind = EPI_FFN_UP; E.q0 = ws + WS_ACT; E.ldc = 2816; E.q1 = (void*)(p.in[opq(23)] + (size_t)layer * 3 * 2 * DFF); E.q2 = (void*)(p.in[opq(24)] + (size_t)layer * 2 * DFF);
                        E.q3 = ws + WS_HALO; E.q4 = rs0; E.q5 = shw_ffn; }
                    else { g.A = (const bf16_t*)(ws + WS_ACT); g.Bt = (const bf16_t*)(ws + WS_FDOWN + (size_t)layer * SZ_FDOWN); g.N = 1024; g.K = 2816; g.lda = 2816; g.ldb = 2816;
                        kind = EPI_RESID; E.ldc = 1; E.q0 = xout; E.q1 = xc; E.q2 = xout; E.q3 = ws; E.q4 = (void*)modl; E.q5 = layer < 3 ? (void*)(p.in[opq(6)] + (layer + 1) * 1024) : nullptr;
                        for (int i = blockIdx.x * NTHREADS + tid_opq(); i < MR; i += gridDim.x * NTHREADS) rs0[i] = 0.f; }
                    if (layer == 3 && (gs == 3 || gs == 5 || gs == 6 || gs == 7)) g.M = TL;
                    pg8::StaticOrder S; S.init(g.M, g.N, (int)gridDim.x, (int)blockIdx.x, (gs == 1 || gs == 5 || gs == 7) ? 1 : 0);
                    if (kind == EPI_BF16) pg8::gemm_phase<Epi, EPI_BF16>(lds, g, S, E);
                    else if (kind == EPI_GLA_IN) pg8::gemm_phase<Epi, EPI_GLA_IN>(lds, g, S, E);
                    else if (kind == EPI_RESID) pg8::gemm_phase<Epi, EPI_RESID>(lds, g, S, E);
                    else if (kind == EPI_UKV) pg8::gemm_phase<Epi, EPI_UKV>(lds, g, S, E);
                    else pg8::gemm_phase<Epi, EPI_FFN_UP>(lds, g, S, E);
                    __syncthreads();
                }
            } else if (op == 3) {
                scan_phase((const bf16_t*)(ws + WS_VR), (const bf16_t*)(ws + WS_GQ), (const bf16_t*)(ws + WS_GK), (const bf16_t*)(ws + WS_GP), (const float*)(ws + WS_GE),
                           hbuf, (bf16_t*)(ws + WS_QK), lds);
            } else if (op == 9) {
                gateprep_phase((const bf16_t*)(ws + WS_QK), (const float*)(ws + WS_LR), p.in[opq(10)] + (size_t)j * 2 * 16 * 512, p.in[opq(11)] + (size_t)j * 2 * 512,
                               (bf16_t*)(ws + WS_GQ), (bf16_t*)(ws + WS_GK), (bf16_t*)(ws + WS_GP), (float*)(ws + WS_GE), lds);
            } else if (op == 4) {
                glapost_phase(hbuf, (const bf16_t*)(ws + WS_QK), (const bf16_t*)(ws + WS_VR), p.in[opq(12)] + j * 256, hbuf);
            } else if (op == 5) {
                mlamid_phase((const bf16_t*)(ws + WS_DN), p.in[opq(15)] + j * 384, p.in[opq(16)] + j * 256, p.in[opq(20)] + j * 192, (bf16_t*)(ws + WS_CQN), (bf16_t*)(ws + WS_CKVN), (bf16_t*)(ws + WS_KB));
            } else if (op == 6) {
                qkprep_phase((bf16_t*)(ws + WS_KB), p.in[opq(20)] + j * 192);
            } else if (op == 7) {
                attn_phase((const bf16_t*)(ws + WS_QRAW), (const bf16_t*)(ws + WS_KB), (const bf16_t*)(ws + WS_VB), hbuf, (char*)smem, layer == 3 ? 2048 : 2048 + 128, p.in[opq(19)] + j * 192);
            } else if (op == 8) {
                fixup_phase((const float*)(ws + WS_HALO), p.in[opq(23)] + (size_t)layer * 3 * 2 * DFF, p.in[opq(24)] + (size_t)layer * 2 * DFF, (bf16_t*)(ws + WS_ACT));
            }
            }
        }
        if (ph + 1 < p.ph_hi) { if (p.ph_lo < 0) grid.sync(); else xcd_barrier(xbar); }
    }
}

extern "C" void kernel_launch(void* const* d_in, const int* in_sizes, int n_in, void* d_out, int out_size, void* d_ws, size_t ws_size, hipStream_t stream) {
    static int grid = 0;
    if (grid == 0) {
        if (n_in != 26 || ws_size < WS_END) { fprintf(stderr, "kernel_launch: n_in %d ws %zu (need %zu)\n", n_in, ws_size, (size_t)WS_END); grid = -1; return; }
        int dev = 0, cus = 0, per_cu = 0;
        hipGetDevice(&dev);
        hipDeviceGetAttribute(&cus, hipDeviceAttributeMultiprocessorCount, dev);
        if (hipFuncSetAttribute((const void*)mega, hipFuncAttributeMaxDynamicSharedMemorySize, LDS_BYTES) != hipSuccess) { fprintf(stderr, "kernel_launch: hipFuncSetAttribute failed\n"); grid = -1; return; }
        if (hipOccupancyMaxActiveBlocksPerMultiprocessor(&per_cu, (const void*)mega, NTHREADS, LDS_BYTES) != hipSuccess || per_cu < 1) { fprintf(stderr, "kernel_launch: occupancy query %d\n", per_cu); per_cu = 1; }
        (void)hipGetLastError();
        grid = cus * per_cu;
        fprintf(stderr, "kernel_launch: grid %d (cus %d x %d)\n", grid, cus, per_cu);
    }
    if (grid < 0) return;
    Params p{};
    for (int i = 0; i < 26; ++i) p.in[i] = (const float*)d_in[i];
    p.in[26] = (const float*)d_out; p.in[27] = (const float*)d_ws;
    (void)hipMemsetAsync((unsigned char*)d_ws + WS_BAR, 0, 16384, stream);
#if MK_MULTI
    for (int ph = 0; ph < NPH; ++ph) {
        p.ph_lo = ph; p.ph_hi = ph + 1;
        hipLaunchKernelGGL(mega, dim3(grid), dim3(NTHREADS), LDS_BYTES, stream, p);
    }
#else
    p.ph_lo = 0; p.ph_hi = NPH;
    void* args[] = {&p};
    hipError_t e = hipLaunchCooperativeKernel((const void*)mega, dim3(grid), dim3(NTHREADS), args, LDS_BYTES, stream);
    if (e != hipSuccess) fprintf(stderr, "cooperative launch failed: %s (grid %d)\n", hipGetErrorString(e), grid);
#endif
}
```

```cpp
#include <hip/hip_runtime.h>
#include <hip/hip_cooperative_groups.h>
#include <cstdio>
#include <cstdint>
namespace cg = cooperative_groups;

#ifndef MK_MULTI
#define MK_MULTI 0
#endif

#define LAS __attribute__((address_space(3)))
#define DI __device__ __forceinline__
typedef unsigned short bf16_t;
typedef short bf16x8 __attribute__((ext_vector_type(8)));
typedef short s16x4 __attribute__((ext_vector_type(4)));
typedef float f32x2 __attribute__((ext_vector_type(2)));
typedef float f32x4 __attribute__((ext_vector_type(4)));
typedef float f32x16 __attribute__((ext_vector_type(16)));
typedef unsigned u32x2 __attribute__((ext_vector_type(2)));
typedef unsigned u32x4 __attribute__((ext_vector_type(4)));

constexpr int DM = 1024, NB = 16, SEQ = 4096, CTXL = 256;
constexpr int TL = NB * SEQ, TC = NB * CTXL, MR = TL + TC;
constexpr int KEYS = CTXL + SEQ;
constexpr int DFF = 2816, DFFH = 1408;
constexpr int NTHREADS = 512;
constexpr int XB_ST_OFF = 131072 + 12288 + 2 * 5120 + 6144;
constexpr int LDS_BYTES = XB_ST_OFF + 16;
constexpr int WIMG_F = 3072, PREW_F = 3072 + 2 * 1280;
constexpr int XCH_OFF = 131072;
constexpr int NPH = 43;

constexpr size_t SZ_GIN = 3328ull * 1024 * 2, SZ_SQ = 1024ull * 1024 * 2, SZ_MDOWN = 768ull * 1024 * 2, SZ_MUQ = 1536ull * 384 * 2,
                 SZ_MUKV = 2048ull * 256 * 2, SZ_FUP = 5632ull * 1024 * 2, SZ_FDOWN = 1024ull * 2816 * 2;
constexpr size_t WS_GIN = 0;
constexpr size_t WS_GOUT = WS_GIN + 2 * SZ_GIN;
constexpr size_t WS_MDOWN = WS_GOUT + 2 * SZ_SQ;
constexpr size_t WS_MUQ = WS_MDOWN + 2 * SZ_MDOWN;
constexpr size_t WS_MUKV = WS_MUQ + 2 * SZ_MUQ;
constexpr size_t WS_MOUT = WS_MUKV + 2 * SZ_MUKV;
constexpr size_t WS_FUP = WS_MOUT + 2 * SZ_SQ;
constexpr size_t WS_FDOWN = WS_FUP + 4 * SZ_FUP;
constexpr size_t WS_MOD = WS_FDOWN + 4 * SZ_FDOWN;
constexpr size_t SZ_MOD = 4ull * 17 * 6144 * 4;
constexpr size_t WS_RS = WS_MOD + ((SZ_MOD + 255) / 256) * 256;
constexpr size_t WS_SHW = WS_RS + 2ull * MR * 4;
constexpr size_t WS_BAR = WS_SHW + 4ull * 2 * 17 * 5632 * 4;
constexpr size_t WS_XC = WS_BAR + 16384;
constexpr size_t WS_H = WS_XC + (size_t)TC * 1024 * 4;
constexpr size_t WS_R = WS_H + (size_t)MR * 1024 * 2;
constexpr size_t WS_QK = WS_R;
constexpr size_t WS_VR = WS_QK + (size_t)MR * 1024 * 2;
constexpr size_t WS_LR = WS_VR + (size_t)MR * 2048 * 2;
constexpr int NCHI = NB * 2 * 4 * 68;
constexpr size_t WS_GQ = WS_LR + (size_t)MR * 32 * 4;
constexpr size_t WS_GK = WS_GQ + (size_t)NCHI * 64 * 128 * 2;
constexpr size_t WS_GP = WS_GK + (size_t)NCHI * 64 * 128 * 2;
constexpr size_t WS_GE = WS_GP + (size_t)NCHI * 64 * 64 * 2;
constexpr size_t WS_GLA_END = WS_GE + (size_t)NCHI * 128 * 4;
constexpr size_t WS_QRAW = WS_R;
constexpr size_t WS_DN = WS_R;
constexpr size_t WS_CQN = WS_QRAW + (size_t)MR * 1536 * 2;
constexpr size_t WS_CKVN = WS_CQN + (size_t)MR * 384 * 2;
constexpr size_t WS_KB = WS_CKVN + (size_t)MR * 256 * 2;
constexpr size_t WS_VB = WS_KB + (size_t)NB * KEYS * 1536 * 2;
constexpr size_t WS_MLA_END = WS_VB + (size_t)NB * KEYS * 1024 * 2;
constexpr size_t WS_ACT = WS_R;
constexpr size_t WS_HALO = WS_ACT + (size_t)MR * 2816 * 2;
constexpr size_t WS_XSA = WS_HALO + 272ull * 22 * 4 * 256 * 4;
constexpr size_t WS_FFN_END = WS_XSA + (size_t)MR * 1024 * 2;
constexpr size_t WS_END = WS_GLA_END > WS_MLA_END ? (WS_GLA_END > WS_FFN_END ? WS_GLA_END : WS_FFN_END) : (WS_MLA_END > WS_FFN_END ? WS_MLA_END : WS_FFN_END);
static_assert(WS_END <= (1ull << 30), "workspace over 1 GiB");

struct Params { const float* in[28]; int ph_lo, ph_hi; };

DI unsigned cvt_pk_bf16(float lo, float hi) { unsigned r; asm("v_cvt_pk_bf16_f32 %0, %1, %2" : "=v"(r) : "v"(lo), "v"(hi)); return r; }
DI float bf_lo(unsigned u) { return __uint_as_float(u << 16); }
DI float bf_hi(unsigned u) { return __uint_as_float(u & 0xffff0000u); }
DI bf16_t f2bf(float f) { return (bf16_t)(cvt_pk_bf16(f, 0.f) & 0xffffu); }
DI float wave_sum(float v) {
    v += __int_as_float(__builtin_amdgcn_update_dpp(0, __float_as_int(v), 0xB1, 0xF, 0xF, false));
    v += __int_as_float(__builtin_amdgcn_update_dpp(0, __float_as_int(v), 0x4E, 0xF, 0xF, false));
    v += __int_as_float(__builtin_amdgcn_update_dpp(0, __float_as_int(v), 0x141, 0xF, 0xF, false));
    v += __int_as_float(__builtin_amdgcn_update_dpp(0, __float_as_int(v), 0x140, 0xF, 0xF, false));
    v += __int_as_float(__builtin_amdgcn_update_dpp(0, __float_as_int(v), 0x142, 0xA, 0xF, false));
    v += __int_as_float(__builtin_amdgcn_update_dpp(0, __float_as_int(v), 0x143, 0xC, 0xF, false));
    return __int_as_float(__builtin_amdgcn_readlane(__float_as_int(v), 63));
}
DI float silu_f(float v) { return v * __builtin_amdgcn_rcpf(1.0f + __expf(-v)); }
DI int crow(int r, int hi) { return (r & 3) + 8 * (r >> 2) + 4 * hi; }
DI int tid_opq() { int t = threadIdx.x; asm volatile("" : "+v"(t)); return t; }
DI int opq(int i) { asm volatile("" : "+s"(i)); return i; }

namespace pg8 {
constexpr int BM = 256, BK = 64, HALF = 128, HTB = HALF * BK * 2, STAGE_BYTES = 8 * HTB, NXCD = 8, WGM = 4;
DI int lds_byte(int r, int c) { const int st = (r >> 4) * 2 + (c >> 5), rr = r & 15, cc = c & 31, ob = rr * 64 + cc * 2; return st * 1024 + (ob ^ (((ob >> 9) & 1) << 5)); }
DI void stage_rc(int b, int& R, int& C) { const int st = b / 1024, sb = b % 1024, swz = sb ^ (((sb >> 9) & 1) << 5); R = (st >> 1) * 16 + swz / 64; C = (st & 1) * 32 + (swz % 64) / 2; }
DI int perm32(int rho) { const int n = rho >> 4, i = rho & 15; return 8 * (i >> 2) + 4 * n + (i & 3); }
struct Unit { int pm, pn; };
struct Gemm { const bf16_t* A; const bf16_t* Bt; int M, N, K, lda, ldb; };
struct StaticOrder {
    int nM, nN, nwg, G, c, rev;
    DI void init(int M, int N, int G_, int c_, int rev_ = 0) { nM = M / BM; nN = N / BM; nwg = nM * nN; G = G_; c = c_; rev = rev_; }
    DI bool next(int i, Unit& u) const {
        const long L = (long)i * G + c; if (L >= nwg) return false;
        int wgid = (int)L; { const int q = nwg / NXCD, r = nwg % NXCD, xcd = wgid % NXCD, off = wgid / NXCD; wgid = (xcd < r ? xcd * (q + 1) : r * (q + 1) + (xcd - r) * q) + off; }
        const int nig = WGM * nN, gid = wgid / nig, fm = gid * WGM, gsz = (nM - fm) < WGM ? (nM - fm) : WGM;
        u.pm = fm + ((wgid % nig) % gsz); u.pn = (wgid % nig) / gsz; if (rev) u.pm = nM - 1 - u.pm; return true;
    }
};

template <class Epi, int KIND>
DI void gemm_phase(LAS unsigned char* lds, const Gemm g, const StaticOrder& S, const Epi& E) {
    constexpr bool perm = Epi::template perm_of<KIND>();
    const int tid = tid_opq(), wid = __builtin_amdgcn_readfirstlane(tid >> 6), lane = tid & 63, wr = wid >> 2, wc = wid & 3, fr = lane & 15, fq = lane >> 4;
    const int K = g.K, nt = K / BK;
    unsigned voffA[2], voffB[2];
#pragma unroll
    for (int i = 0; i < 2; ++i) { int R, C; stage_rc(tid * 16 + i * 8192, R, C); const int Rb = perm ? ((R & ~31) + perm32(R & 31)) : R;
        voffA[i] = (unsigned)(R * g.lda + C) * 2u; voffB[i] = (unsigned)(Rb * g.ldb + C) * 2u; }
    const size_t kstep = (size_t)(BK * 2);
    const size_t hstepA = (size_t)HALF * g.lda * 2, hstepB = (size_t)HALF * g.ldb * 2;
    const size_t tstepA = 2 * hstepA, tstepB = 2 * hstepB;
    const unsigned ldsw = (unsigned)wid * 1024u;
    const int aoff = lds_byte(wr * 64 + fr, fq * 8), boff = lds_byte(wc * 32 + fr, fq * 8);
#define PG8_SA(b, h) (((b) * 2 + (h)) * HTB)
#define PG8_SB(b, h) ((4 + (b) * 2 + (h)) * HTB)
#define PG8_STAGE(bufoff, gbase, voff) do { _Pragma("unroll") for (int _i = 0; _i < 2; ++_i) \
        __builtin_amdgcn_global_load_lds((const unsigned*)((const char*)(gbase) + (voff)[_i]), (LAS unsigned*)(lds + (bufoff) + ldsw + _i * 8192), 16, 0, 0); } while (0)
#define PG8_LDA(dst, b, h) do { _Pragma("unroll") for (int m = 0; m < 4; ++m) _Pragma("unroll") for (int k = 0; k < 2; ++k) dst[m][k] = *(const LAS bf16x8*)(lds + PG8_SA(b, h) + aoff + m * 2048 + k * 1024); } while (0)
#define PG8_LDB(dst, b, h) do { _Pragma("unroll") for (int n = 0; n < 2; ++n) _Pragma("unroll") for (int k = 0; k < 2; ++k) dst[n][k] = *(const LAS bf16x8*)(lds + PG8_SB(b, h) + boff + n * 2048 + k * 1024); } while (0)
#define PG8_MMA(ai, bj, At, Bt) do { __builtin_amdgcn_s_setprio(1); _Pragma("unroll") for (int m = 0; m < 4; ++m) _Pragma("unroll") for (int n = 0; n < 2; ++n) _Pragma("unroll") for (int k = 0; k < 2; ++k) \
        acc[ai][bj][m][n] = __builtin_amdgcn_mfma_f32_16x16x32_bf16(Bt[n][k], At[m][k], acc[ai][bj][m][n], 0, 0, 0); __builtin_amdgcn_s_setprio(0); } while (0)
#define PG8_WAIT_V(n) asm volatile("s_waitcnt vmcnt(" #n ")" ::: "memory")
#define PG8_WAIT_L(n) asm volatile("s_waitcnt lgkmcnt(" #n ")" ::: "memory")
#define PG8_BAR __builtin_amdgcn_s_barrier()
#define PG8_SCHED __builtin_amdgcn_sched_barrier(0)
    Unit cur, nxt; int ui = 0;
    if (!S.next(0, cur)) return;
    f32x4 acc[2][2][4][2];
#pragma unroll
    for (int a = 0; a < 2; ++a)
#pragma unroll
        for (int b = 0; b < 2; ++b)
#pragma unroll
            for (int m = 0; m < 4; ++m)
#pragma unroll
                for (int n = 0; n < 2; ++n) acc[a][b][m][n] = (f32x4){0.f, 0.f, 0.f, 0.f};
    bf16x8 At[4][2], B0[2][2], B1[2][2];
    typename Epi::Pre pre;
    const char* cA = (const char*)g.A + (size_t)cur.pm * tstepA; const char* cB = (const char*)g.Bt + (size_t)cur.pn * tstepB;
    PG8_STAGE(PG8_SB(0, 0), cB, voffB); PG8_STAGE(PG8_SA(0, 0), cA, voffA); PG8_STAGE(PG8_SB(0, 1), cB + hstepB, voffB); PG8_STAGE(PG8_SA(0, 1), cA + hstepA, voffA);
    if (wr == 1) PG8_BAR;
    PG8_WAIT_V(4); PG8_BAR;
    PG8_STAGE(PG8_SB(1, 0), cB + kstep, voffB); PG8_STAGE(PG8_SA(1, 0), cA + kstep, voffA); PG8_STAGE(PG8_SB(1, 1), cB + hstepB + kstep, voffB);
    PG8_WAIT_V(6); PG8_BAR;
    for (;;) {
        const bool has_next = S.next(ui + 1, nxt);
        const char* nA = has_next ? (const char*)g.A + (size_t)nxt.pm * tstepA : cA; const char* nB = has_next ? (const char*)g.Bt + (size_t)nxt.pn * tstepB : cB;
        E.template prefetch<KIND>(pre, cur, wr, wc, fr, fq, ui & 1);
        for (int t = 0; t < nt; t += 2) {
            const bool last = (t == nt - 2);
            const char* a1 = cA + (size_t)(t + 1) * kstep;
            const char* a2 = last ? nA : cA + (size_t)(t + 2) * kstep; const char* b2 = last ? nB : cB + (size_t)(t + 2) * kstep;
            const char* a3 = a2 + kstep; const char* b3 = b2 + kstep;
            PG8_LDB(B0, 0, 0); PG8_SCHED; PG8_LDA(At, 0, 0); PG8_STAGE(PG8_SA(1, 1), a1 + hstepA, voffA);
            PG8_WAIT_L(8); PG8_BAR; PG8_WAIT_L(0); PG8_MMA(0, 0, At, B0); PG8_BAR; PG8_SCHED;
            PG8_LDB(B1, 0, 1); PG8_STAGE(PG8_SB(0, 0), b2, voffB);
            PG8_BAR; PG8_WAIT_L(0); PG8_MMA(0, 1, At, B1); PG8_BAR;
            PG8_LDA(At, 0, 1); PG8_STAGE(PG8_SA(0, 0), a2, voffA);
            PG8_BAR; PG8_WAIT_L(0); PG8_MMA(1, 0, At, B0); PG8_BAR; PG8_SCHED;
            PG8_STAGE(PG8_SB(0, 1), b2 + hstepB, voffB);
            PG8_WAIT_V(6); PG8_BAR; PG8_MMA(1, 1, At, B1); PG8_BAR;
            PG8_LDB(B0, 1, 0); PG8_SCHED; PG8_LDA(At, 1, 0); PG8_STAGE(PG8_SA(0, 1), a2 + hstepA, voffA);
            PG8_WAIT_L(8); PG8_BAR; PG8_WAIT_L(0); PG8_MMA(0, 0, At, B0); PG8_BAR; PG8_SCHED;
            PG8_LDB(B1, 1, 1); PG8_STAGE(PG8_SB(1, 0), b3, voffB);
            PG8_BAR; PG8_WAIT_L(0); PG8_MMA(0, 1, At, B1); PG8_BAR;
            PG8_LDA(At, 1, 1); PG8_STAGE(PG8_SA(1, 0), a3, voffA);
            PG8_BAR; PG8_WAIT_L(0); PG8_MMA(1, 0, At, B0); PG8_BAR; PG8_SCHED;
            PG8_STAGE(PG8_SB(1, 1), b3 + hstepB, voffB);
            PG8_WAIT_V(6); PG8_BAR; PG8_MMA(1, 1, At, B1); PG8_BAR;
        }
        if (wr == 0) { PG8_BAR; asm volatile("" ::: "memory"); }
        E.template run<KIND>(acc, pre, cur, wr, wc, fr, fq, ui & 1);
        if (wr == 1) { asm volatile("" ::: "memory"); PG8_BAR; }
        if (!has_next) break;
#pragma unroll
        for (int a = 0; a < 2; ++a)
#pragma unroll
            for (int b = 0; b < 2; ++b)
#pragma unroll
                for (int m = 0; m < 4; ++m)
#pragma unroll
                    for (int n = 0; n < 2; ++n) acc[a][b][m][n] = (f32x4){0.f, 0.f, 0.f, 0.f};
        cur = nxt; cA = nA; cB = nB; ++ui;
    }
    PG8_WAIT_V(0);
    if (wr == 0) PG8_BAR;
    PG8_BAR;
#undef PG8_SA
#undef PG8_SB
#undef PG8_STAGE
#undef PG8_LDA
#undef PG8_LDB
#undef PG8_MMA
#undef PG8_WAIT_V
#undef PG8_WAIT_L
#undef PG8_BAR
#undef PG8_SCHED
}
}

enum { EPI_BF16 = 0, EPI_GLA_IN = 1, EPI_RESID = 2, EPI_UKV = 3, EPI_FFN_UP = 4 };
DI float dpp_ror1(float v) { return __int_as_float(__builtin_amdgcn_update_dpp(0, __float_as_int(v), 0x121, 0xf, 0xf, false)); }
DI float dpp_ror15(float v) { return __int_as_float(__builtin_amdgcn_update_dpp(0, __float_as_int(v), 0x12F, 0xf, 0xf, false)); }
struct Epi {
    struct Pre { float rsv[2][4]; f32x4 sw[2][2]; f32x2 wl0, wl1; };
    int ldc; LAS float* xch;
    void* q0; void* q1; void* q2; void* q3; void* q4; void* q5;
    static DI f32x4 ror1_4(f32x4 v) { float a, b, c, d;
        asm volatile("s_nop 1\n\tv_mov_b32_dpp %0, %4 row_ror:1 row_mask:0xf bank_mask:0xf\n\tv_mov_b32_dpp %1, %5 row_ror:1 row_mask:0xf bank_mask:0xf\n\tv_mov_b32_dpp %2, %6 row_ror:1 row_mask:0xf bank_mask:0xf\n\tv_mov_b32_dpp %3, %7 row_ror:1 row_mask:0xf bank_mask:0xf"
                     : "=&v"(a), "=&v"(b), "=&v"(c), "=&v"(d) : "v"(v[0]), "v"(v[1]), "v"(v[2]), "v"(v[3]));
        return (f32x4){a, b, c, d}; }
    static DI f32x2 ror1_2(f32x2 v) { float a, b;
        asm volatile("s_nop 1\n\tv_mov_b32_dpp %0, %2 row_ror:1 row_mask:0xf bank_mask:0xf\n\tv_mov_b32_dpp %1, %3 row_ror:1 row_mask:0xf bank_mask:0xf" : "=&v"(a), "=&v"(b) : "v"(v[0]), "v"(v[1]));
        return (f32x2){a, b}; }
    static DI f32x2 ror15_2(f32x2 v) { float a, b;
        asm volatile("s_nop 1\n\tv_mov_b32_dpp %0, %2 row_ror:15 row_mask:0xf bank_mask:0xf\n\tv_mov_b32_dpp %1, %3 row_ror:15 row_mask:0xf bank_mask:0xf" : "=&v"(a), "=&v"(b) : "v"(v[0]), "v"(v[1]));
        return (f32x2){a, b}; }
    static DI f32x4 ror15_4(f32x4 v) { float a, b, c, d;
        asm volatile("s_nop 1\n\tv_mov_b32_dpp %0, %4 row_ror:15 row_mask:0xf bank_mask:0xf\n\tv_mov_b32_dpp %1, %5 row_ror:15 row_mask:0xf bank_mask:0xf\n\tv_mov_b32_dpp %2, %6 row_ror:15 row_mask:0xf bank_mask:0xf\n\tv_mov_b32_dpp %3, %7 row_ror:15 row_mask:0xf bank_mask:0xf"
                     : "=&v"(a), "=&v"(b), "=&v"(c), "=&v"(d) : "v"(v[0]), "v"(v[1]), "v"(v[2]), "v"(v[3]));
        return (f32x4){a, b, c, d}; }
    DI void ffn_up(const f32x4 (&acc)[2][2][4][2], const pg8::Unit& u, int wr, int wc, int fr, int fq, int par) const {
        bf16_t* O = (bf16_t*)q0; float* halo = (float*)q3;
        const int cl = wc * 32 + 8 * fq;
        float rstd[2][4];
        { const LAS float* pw = xch + PREW_F + (wr * 4 + wc) * 192;
#pragma unroll
          for (int g = 0; g < 8; ++g) rstd[g >> 2][g & 3] = rsqrtf(pw[g * 16 + fr] * (1.0f / 1024.0f) + 1e-6f); }
        const LAS float* wbuf = xch + WIMG_F + par * 1280;
#define XW(ST, TB, BJ, V0, V1) do { LAS float* xp_ = xch + ((((ST) + 1) * 2 + (TB)) * 2 + (BJ)) * 128 + cl; *(LAS f32x4*)xp_ = (V0); *(LAS f32x4*)(xp_ + 4) = (V1); } while (0)
#define TR(AI, BJ, M, N) (acc[AI][BJ][M][N] * rstd[AI][M])
        if (fr == 0) { XW(wr, 0, 0, TR(0, 0, 0, 0), TR(0, 0, 0, 1)); XW(wr, 0, 1, TR(0, 1, 0, 0), TR(0, 1, 0, 1)); XW(2 + wr, 0, 0, TR(1, 0, 0, 0), TR(1, 0, 0, 1)); XW(2 + wr, 0, 1, TR(1, 1, 0, 0), TR(1, 1, 0, 1)); }
        if (fr == 15) { XW(wr, 1, 0, TR(0, 0, 3, 0), TR(0, 0, 3, 1)); XW(wr, 1, 1, TR(0, 1, 3, 0), TR(0, 1, 3, 1)); XW(2 + wr, 1, 0, TR(1, 0, 3, 0), TR(1, 0, 3, 1)); XW(2 + wr, 1, 1, TR(1, 1, 3, 0), TR(1, 1, 3, 1)); }
        { const f32x4 zz = (f32x4){0.f, 0.f, 0.f, 0.f}; if (fr == 0 && wr == 0) { XW(-1, 1, 0, zz, zz); XW(-1, 1, 1, zz, zz); } if (fr == 15 && wr == 1) { XW(4, 0, 0, zz, zz); XW(4, 0, 1, zz, zz); } }
#undef XW
        asm volatile("s_waitcnt lgkmcnt(0)" ::: "memory"); __builtin_amdgcn_s_barrier(); asm volatile("" ::: "memory"); __builtin_amdgcn_s_barrier(); asm volatile("" ::: "memory");
        {
            float* hp = halo + (size_t)(u.pm * 22 + u.pn) * 4 * 256 + cl;
            const f32x4 sa0 = *(const LAS f32x4*)(wbuf + 512 + cl), sa1 = *(const LAS f32x4*)(wbuf + 512 + cl + 4), sg0 = *(const LAS f32x4*)(wbuf + 640 + 512 + cl), sg1 = *(const LAS f32x4*)(wbuf + 640 + 512 + cl + 4);
            if (wr == 0 && fr < 2) { float* h2 = hp + fr * 256; *(f32x4*)h2 = TR(0, 0, 0, 0) + sa0; *(f32x4*)(h2 + 4) = TR(0, 0, 0, 1) + sa1; *(f32x4*)(h2 + 128) = TR(0, 1, 0, 0) + sg0; *(f32x4*)(h2 + 132) = TR(0, 1, 0, 1) + sg1; }
            if (wr == 1 && fr >= 14) { float* h2 = hp + (fr - 12) * 256; *(f32x4*)h2 = TR(1, 0, 3, 0) + sa0; *(f32x4*)(h2 + 4) = TR(1, 0, 3, 1) + sa1; *(f32x4*)(h2 + 128) = TR(1, 1, 3, 0) + sg0; *(f32x4*)(h2 + 132) = TR(1, 1, 3, 1) + sg1; }
        }
#undef TR
        asm volatile("" ::: "memory");
        const int rowt = u.pm * 256 + wr * 64 + fr;
        const bool f0 = fr == 0, f15 = fr == 15;
        f32x2 sg[2][4][4];
#define SILU2(v) (f32x2){silu_f(v[0]), silu_f(v[1])}
#define H2(V, HH) __builtin_shufflevector(V, V, 2 * (HH), 2 * (HH) + 1)
#define CONV_GROUP(BJ, Q, AI, OP) do { \
            const int st = 2 * (AI) + wr; \
            const f32x2 pb = *(const LAS f32x2*)(xch + (((st) * 2 + 1) * 2 + (BJ)) * 128 + cl + 2 * (Q)) + sw; \
            const f32x2 nb = *(const LAS f32x2*)(xch + (((st + 2) * 2 + 0) * 2 + (BJ)) * 128 + cl + 2 * (Q)) + sw; \
            const f32x2 c0 = H2(acc[AI][BJ][0][(Q) >> 1], (Q) & 1) * rstd[AI][0] + sw, c1 = H2(acc[AI][BJ][1][(Q) >> 1], (Q) & 1) * rstd[AI][1] + sw, \
                        c2 = H2(acc[AI][BJ][2][(Q) >> 1], (Q) & 1) * rstd[AI][2] + sw, c3 = H2(acc[AI][BJ][3][(Q) >> 1], (Q) & 1) * rstd[AI][3] + sw; \
            const f32x2 R0 = ror1_2(c0), L0 = ror15_2(c0), L1 = ror15_2(c1); \
            { const f32x2 v = w0 * (f0 ? pb : R0) + w1 * c0 + w2 * (f15 ? L1 : L0) + bb; OP(sg[AI][0][Q], v); } \
            __builtin_amdgcn_sched_barrier(0); \
            const f32x2 R1 = ror1_2(c1), L2 = ror15_2(c2); \
            { const f32x2 v = w0 * (f0 ? R0 : R1) + w1 * c1 + w2 * (f15 ? L2 : L1) + bb; OP(sg[AI][1][Q], v); } \
            __builtin_amdgcn_sched_barrier(0); \
            const f32x2 R2 = ror1_2(c2), L3 = ror15_2(c3); \
            { const f32x2 v = w0 * (f0 ? R1 : R2) + w1 * c2 + w2 * (f15 ? L3 : L2) + bb; OP(sg[AI][2][Q], v); } \
            __builtin_amdgcn_sched_barrier(0); \
            const f32x2 R3 = ror1_2(c3); \
            { const f32x2 v = w0 * (f0 ? R2 : R3) + w1 * c3 + w2 * (f15 ? nb : L3) + bb; OP(sg[AI][3][Q], v); } \
            __builtin_amdgcn_sched_barrier(0); } while (0)
#define OP_G(dst, v) dst = SILU2(v)
#define OP_A(dst, v) dst *= v
#define CONV_W(BJ, Q) const LAS float* wp_ = wbuf + (BJ) * 640 + cl + 2 * (Q); \
            const f32x2 w0 = *(const LAS f32x2*)wp_, w1 = *(const LAS f32x2*)(wp_ + 128), w2 = *(const LAS f32x2*)(wp_ + 256), bb = *(const LAS f32x2*)(wp_ + 384), sw = *(const LAS f32x2*)(wp_ + 512);
        { CONV_W(1, 0) CONV_GROUP(1, 0, 0, OP_G); CONV_GROUP(1, 0, 1, OP_G); }
        { CONV_W(1, 1) CONV_GROUP(1, 1, 0, OP_G); CONV_GROUP(1, 1, 1, OP_G); }
        { CONV_W(1, 2) CONV_GROUP(1, 2, 0, OP_G); CONV_GROUP(1, 2, 1, OP_G); }
        { CONV_W(1, 3) CONV_GROUP(1, 3, 0, OP_G); CONV_GROUP(1, 3, 1, OP_G); }
        { CONV_W(0, 0) CONV_GROUP(0, 0, 0, OP_A); CONV_GROUP(0, 0, 1, OP_A); }
        { CONV_W(0, 1) CONV_GROUP(0, 1, 0, OP_A); CONV_GROUP(0, 1, 1, OP_A); }
        { CONV_W(0, 2) CONV_GROUP(0, 2, 0, OP_A); CONV_GROUP(0, 2, 1, OP_A); }
        { CONV_W(0, 3) CONV_GROUP(0, 3, 0, OP_A); CONV_GROUP(0, 3, 1, OP_A); }
#undef CONV_W
#undef CONV_GROUP
#undef OP_G
#undef OP_A
#undef SILU2
#undef H2
#define ST16(AI, MM) do { u32x4 w_; w_.x = cvt_pk_bf16(sg[AI][MM][0][0], sg[AI][MM][0][1]); w_.y = cvt_pk_bf16(sg[AI][MM][1][0], sg[AI][MM][1][1]); w_.z = cvt_pk_bf16(sg[AI][MM][2][0], sg[AI][MM][2][1]); w_.w = cvt_pk_bf16(sg[AI][MM][3][0], sg[AI][MM][3][1]); \
            *(u32x4*)(O + (size_t)(rowt + (AI) * 128 + (MM) * 16) * 2816 + u.pn * 128 + cl) = w_; } while (0)
        ST16(0, 0); ST16(0, 1); ST16(0, 2); ST16(0, 3); ST16(1, 0); ST16(1, 1); ST16(1, 2); ST16(1, 3);
#undef ST16
    }
    template <int K> static constexpr bool perm_of() { return true; }
    template <int kind> DI void prefetch(Pre& P, const pg8::Unit& u, int wr, int wc, int fr, int fq, int par) const {
        (void)P;
        if constexpr (kind == EPI_UKV) {
            if (fq == 0 && fr < 8) __builtin_amdgcn_global_load_lds((const unsigned*)((const float*)q2 + wc * 32 + fr * 4), (LAS unsigned*)(xch + PREW_F + (wr * 4 + wc) * 192 + 128), 16, 0, 0);
        }
        if constexpr (kind == EPI_GLA_IN || kind == EPI_BF16 || kind == EPI_FFN_UP) {
            const float* rsb = (const float*)(kind == EPI_FFN_UP ? q4 : q3);
            if (rsb) {
                LAS float* pw = xch + PREW_F + (wr * 4 + wc) * 192;
                const int bidx = u.pm < 256 ? (u.pm >> 4) : 16;
                if (fq == 0) {
                    const float* rsp = rsb + u.pm * 256 + wr * 64 + fr;
#pragma unroll
                    for (int g = 0; g < 8; ++g) __builtin_amdgcn_global_load_lds((const unsigned*)(rsp + (g >> 2) * 128 + (g & 3) * 16), (LAS unsigned*)(pw + g * 16), 4, 0, 0);
                    if constexpr (kind != EPI_FFN_UP) {
                        const float* sw = (const float*)q4 + (size_t)bidx * 5632 + u.pn * 256 + (fr >> 3) * 128 + wc * 32 + (fr & 7) * 4;
                        __builtin_amdgcn_global_load_lds((const unsigned*)sw, (LAS unsigned*)(pw + 128), 16, 0, 0);
                    }
                }
                if constexpr (kind == EPI_FFN_UP) {
                    const int wid = wr * 4 + wc;
                    if (wid < 5) {
                        const float* cw = (const float*)q1; const float* cb = (const float*)q2; const float* shw = (const float*)q5 + (size_t)bidx * 5632 + u.pn * 256;
                        const int i4 = (wid * 64 + fq * 16 + fr) * 4, bjw = i4 / 640, rem = i4 % 640, kw = rem >> 7, c_ = rem & 127;
                        const float* srcw = kw < 3 ? cw + kw * 5632 + bjw * 2816 + u.pn * 128 + c_ : kw == 3 ? cb + bjw * 2816 + u.pn * 128 + c_ : shw + bjw * 128 + c_;
                        __builtin_amdgcn_global_load_lds((const unsigned*)srcw, (LAS unsigned*)(xch + WIMG_F + par * 1280 + wid * 256), 16, 0, 0);
                    }
                }
            }
        }
    }
    template <int kind> DI void run(const f32x4 (&acc)[2][2][4][2], const Pre& P, const pg8::Unit& u, int wr, int wc, int fr, int fq, int par) const {
        asm volatile("" : "+v"(fr), "+v"(fq));
        if constexpr (kind == EPI_FFN_UP) { ffn_up(acc, u, wr, wc, fr, fq, par); return; }
        if constexpr (kind == EPI_RESID) {
            const float* base_l = (const float*)q0; const float* base_c = (const float*)q1; float* out_l = (float*)q2; unsigned char* wsb = (unsigned char*)q3; float* out_c = (float*)(wsb + WS_XC);
            const float* modl = (const float*)q4; const float* gnext = (const float*)q5;
            const int bidx = u.pm < 256 ? (u.pm >> 4) : 16;
            const float* gv = modl + (size_t)bidx * 6144 + (ldc ? 5 * 1024 : 2 * 1024);
            const float* bp = u.pm < 256 ? base_l + (size_t)u.pm * 256 * 1024 : base_c + (size_t)(u.pm - 256) * 256 * 1024;
            float* op = u.pm < 256 ? out_l + (size_t)u.pm * 256 * 1024 : out_c + (size_t)(u.pm - 256) * 256 * 1024;
            const int col0 = u.pn * 256 + wc * 32 + 8 * fq;
            f32x4 gt[2][2], gn[2][2];
#pragma unroll
            for (int bj = 0; bj < 2; ++bj)
#pragma unroll
                for (int n = 0; n < 2; ++n) gt[bj][n] = *(const f32x4*)(gv + col0 + bj * 128 + n * 4);
            if (gnext) {
                const float* scn = ldc ? modl + (size_t)(17 + bidx) * 6144 + 1024 : modl + (size_t)bidx * 6144 + 4 * 1024;
#pragma unroll
                for (int bj = 0; bj < 2; ++bj)
#pragma unroll
                    for (int n = 0; n < 2; ++n) gn[bj][n] = *(const f32x4*)(gnext + col0 + bj * 128 + n * 4) * (*(const f32x4*)(scn + col0 + bj * 128 + n * 4) + 1.0f);
            }
            bf16_t* xs = (bf16_t*)(wsb + (ldc ? WS_H : WS_XSA)) + (size_t)u.pm * 256 * 1024;
            float* rs = (float*)(wsb + WS_RS) + (ldc ? MR : 0) + u.pm * 256;
            f32x4 bsA[4], bsB[4];
#define RS_LOAD(K, DST) do { const size_t off_ = (size_t)(((K) >> 2) * 128 + wr * 64 + ((K) & 3) * 16 + fr) * 1024 + col0; \
                _Pragma("unroll") for (int q_ = 0; q_ < 4; ++q_) DST[q_] = *(const f32x4*)(bp + off_ + (q_ >> 1) * 128 + (q_ & 1) * 4); } while (0)
#define RS_DO(K, SRC) do { const int ai_ = (K) >> 2, m_ = (K) & 3; const int rl = ai_ * 128 + wr * 64 + m_ * 16 + fr; const size_t off = (size_t)rl * 1024 + col0; float ssq = 0.f; \
                _Pragma("unroll") for (int bj = 0; bj < 2; ++bj) { \
                    const f32x4 xa = SRC[2 * bj] + gt[bj][0] * acc[ai_][bj][m_][0], xb = SRC[2 * bj + 1] + gt[bj][1] * acc[ai_][bj][m_][1]; \
                    *(f32x4*)(op + off + bj * 128) = xa; *(f32x4*)(op + off + bj * 128 + 4) = xb; \
                    if (gnext) { ssq += xa[0] * xa[0] + xa[1] * xa[1] + xa[2] * xa[2] + xa[3] * xa[3] + xb[0] * xb[0] + xb[1] * xb[1] + xb[2] * xb[2] + xb[3] * xb[3]; \
                        const f32x4 ya = xa * gn[bj][0], yb = xb * gn[bj][1]; \
                        u32x4 w; w.x = cvt_pk_bf16(ya[0], ya[1]); w.y = cvt_pk_bf16(ya[2], ya[3]); w.z = cvt_pk_bf16(yb[0], yb[1]); w.w = cvt_pk_bf16(yb[2], yb[3]); \
                        *(u32x4*)(xs + off + bj * 128) = w; } } \
                if (gnext) { ssq += __shfl_xor(ssq, 16); ssq += __shfl_xor(ssq, 32); if (fq == 0) unsafeAtomicAdd(rs + rl, ssq); } } while (0)
            RS_LOAD(0, bsA);
            RS_LOAD(1, bsB); RS_DO(0, bsA);
            RS_LOAD(2, bsA); RS_DO(1, bsB);
            RS_LOAD(3, bsB); RS_DO(2, bsA);
            RS_LOAD(4, bsA); RS_DO(3, bsB);
            RS_LOAD(5, bsB); RS_DO(4, bsA);
            RS_LOAD(6, bsA); RS_DO(5, bsB);
            RS_LOAD(7, bsB); RS_DO(6, bsA);
            RS_DO(7, bsB);
#undef RS_LOAD
#undef RS_DO
            return;
        } else {
        bf16_t* O = (bf16_t*)q0; float* lr = (float*)q1; bf16_t* KB = (bf16_t*)q0; bf16_t* VB = (bf16_t*)q1;
        const int rowt = u.pm * 256 + wr * 64 + fr;
        f32x4 swv[2][2]; float rsv[2][4];
        float krs[2][4]; f32x4 kg0, kg1;
        if constexpr (kind == EPI_UKV) {
            LAS float* P = xch;
#pragma unroll
            for (int ai = 0; ai < 2; ++ai)
#pragma unroll
                for (int m = 0; m < 4; ++m) {
                    const f32x4 a = acc[ai][0][m][0], b = acc[ai][0][m][1];
                    float t = a[0] * a[0] + a[1] * a[1] + a[2] * a[2] + a[3] * a[3] + b[0] * b[0] + b[1] * b[1] + b[2] * b[2] + b[3] * b[3];
                    t += __shfl_xor(t, 16); t += __shfl_xor(t, 32);
                    if (fq == 0) P[(ai * 128 + wr * 64 + m * 16 + fr) * 4 + wc] = t;
                }
            asm volatile("s_waitcnt lgkmcnt(0)" ::: "memory"); __builtin_amdgcn_s_barrier(); asm volatile("" ::: "memory");
#pragma unroll
            for (int ai = 0; ai < 2; ++ai)
#pragma unroll
                for (int m = 0; m < 4; ++m) { const f32x4 t4 = *(const LAS f32x4*)(P + (ai * 128 + wr * 64 + m * 16 + fr) * 4); krs[ai][m] = rsqrtf((t4[0] + t4[1] + t4[2] + t4[3]) * (1.0f / 128.0f) + 1e-6f); }
            { const LAS float* pw = xch + PREW_F + (wr * 4 + wc) * 192 + 128 + 8 * fq; kg0 = *(const LAS f32x4*)pw; kg1 = *(const LAS f32x4*)(pw + 4); }
        }
        if constexpr (kind == EPI_GLA_IN || kind == EPI_BF16) {
            if (q3) { const LAS float* pw = xch + PREW_F + (wr * 4 + wc) * 192;
#pragma unroll
                for (int g = 0; g < 8; ++g) rsv[g >> 2][g & 3] = pw[g * 16 + fr];
#pragma unroll
                for (int bj = 0; bj < 2; ++bj) { swv[bj][0] = *(const LAS f32x4*)(pw + 128 + bj * 32 + 8 * fq); swv[bj][1] = *(const LAS f32x4*)(pw + 128 + bj * 32 + 8 * fq + 4); } }
        }
#pragma unroll
        for (int ai = 0; ai < 2; ++ai)
#pragma unroll
            for (int m = 0; m < 4; ++m) {
                const int row = rowt + ai * 128 + m * 16;
#pragma unroll
                for (int bj = 0; bj < 2; ++bj) {
                    f32x4 v0 = acc[ai][bj][m][0], v1 = acc[ai][bj][m][1];
                    const int cin = bj * 128 + wc * 32 + 8 * fq;
                    if constexpr (kind == EPI_GLA_IN || kind == EPI_BF16) {
                        if (q3) {
                            const float rstd = rsqrtf(rsv[ai][m] * (1.0f / 1024.0f) + 1e-6f);
                            v0 = v0 * rstd + swv[bj][0]; v1 = v1 * rstd + swv[bj][1];
                        }
                    }
                    if constexpr (kind == EPI_GLA_IN) {
                        if (u.pn == 12) {
                            if (bj == 0 && wc == 0) { float* lp = lr + (size_t)row * 32 + 8 * fq; *(f32x4*)lp = v0; *(f32x4*)(lp + 4) = v1; }
                            continue;
                        }
                        if (u.pn < 2) { v0 *= 0.08838834764831845f; v1 *= 0.08838834764831845f; }
                    }
                    u32x4 w; w.x = cvt_pk_bf16(v0[0], v0[1]); w.y = cvt_pk_bf16(v0[2], v0[3]); w.z = cvt_pk_bf16(v1[0], v1[1]); w.w = cvt_pk_bf16(v1[2], v1[3]);
                    if constexpr (kind == EPI_GLA_IN) {
                        if (u.pn < 4) *(u32x4*)(O + (size_t)row * 1024 + u.pn * 256 + cin) = w;
                        else *(u32x4*)((bf16_t*)q2 + (size_t)row * 2048 + (u.pn - 4) * 256 + cin) = w;
                    } else if constexpr (kind == EPI_UKV) {
                        if (bj == 0) { const f32x4 n0 = v0 * krs[ai][m] * kg0, n1 = v1 * krs[ai][m] * kg1;
                            w.x = cvt_pk_bf16(n0[0], n0[1]); w.y = cvt_pk_bf16(n0[2], n0[3]); w.z = cvt_pk_bf16(n1[0], n1[1]); w.w = cvt_pk_bf16(n1[2], n1[3]); }
                        int key;
                        if (u.pm < 256) { const int b = u.pm >> 4; key = b * KEYS + CTXL + (row - b * SEQ); }
                        else { const int b = u.pm - 256; key = b * KEYS + (row - TL - b * CTXL); }
                        const int cc = wc * 32 + 8 * fq;
                        if (bj == 0) *(u32x4*)(KB + (size_t)key * 1536 + u.pn * 192 + cc) = w;
                        else *(u32x4*)(VB + (size_t)key * 1024 + u.pn * 128 + cc) = w;
                    } else {
                        *(u32x4*)(O + (size_t)row * ldc + u.pn * 256 + cin) = w;
                    }
                }
            }
        }
    }
};

DI void prep_phase(const Params& p, LAS unsigned char* lds) {
    const int tid = tid_opq();
    unsigned char* ws = (unsigned char*)p.in[opq(27)];
    LAS float* tl = (LAS float*)lds;
    const float* in_c = p.in[opq(1)]; const float* in_cctx = p.in[opq(3)]; const float* in_wada = p.in[opq(4)]; const float* in_bada = p.in[opq(5)];
    const float* in_gin = p.in[opq(8)]; const float* in_w1 = p.in[opq(9)]; const float* in_gout = p.in[opq(13)]; const float* in_mdown = p.in[opq(14)];
    const float* in_uq = p.in[opq(17)]; const float* in_ukv = p.in[opq(18)]; const float* in_mout = p.in[opq(21)]; const float* in_fup = p.in[opq(22)]; const float* in_fdown = p.in[opq(25)];
    constexpr int T0 = 1536, T2 = 512, T3 = 352, T4 = 288, T5 = 256, T6 = 512, T7 = 5632, T8 = 2816;
    constexpr int NTILE = T0 + T2 + T3 + T4 + T5 + T6 + T7 + T8;
    for (int t = blockIdx.x; t < NTILE; t += gridDim.x) {
        const float* src; int N, k0, n0, ld; bf16_t* dst;
        int q = t;
        if (q < T0) { const int j = q / 768, r = q % 768, kt = r / 48, nt = r % 48; src = in_gin + (size_t)j * 1024 * 3072; N = 3072; k0 = kt * 64; n0 = nt * 64;
            dst = (bf16_t*)(ws + WS_GIN + j * SZ_GIN) + (size_t)n0 * 1024 + k0; ld = 1024; }
        else if ((q -= T0) < T2) { const int j = q / 256, r = q % 256, kt = r / 16, nt = r % 16; src = in_gout + (size_t)j * 1024 * 1024; N = 1024; k0 = kt * 64; n0 = nt * 64;
            dst = (bf16_t*)(ws + WS_GOUT + j * SZ_SQ) + (size_t)n0 * 1024 + k0; ld = 1024; }
        else if ((q -= T2) < T3) { const int j = q / 176, r = q % 176, kt = r / 11, nt = r % 11; src = in_mdown + (size_t)j * 1024 * 704; N = 704; k0 = kt * 64; n0 = nt * 64;
            dst = (bf16_t*)(ws + WS_MDOWN + j * SZ_MDOWN) + (size_t)n0 * 1024 + k0; ld = 1024; }
        else if ((q -= T3) < T4) { const int j = q / 144, r = q % 144, kt = r / 24, nt = r % 24; src = in_uq + (size_t)j * 384 * 1536; N = 1536; k0 = kt * 64; n0 = nt * 64;
            dst = (bf16_t*)(ws + WS_MUQ + j * SZ_MUQ) + (size_t)n0 * 384 + k0; ld = 384; }
        else if ((q -= T4) < T5) { const int j = q / 128, r = q % 128, kt = r / 32, nt = r % 32; src = in_ukv + (size_t)j * 256 * 2048; N = 2048; k0 = kt * 64; n0 = nt * 64;
            dst = (bf16_t*)(ws + WS_MUKV + j * SZ_MUKV) + (size_t)n0 * 256 + k0; ld = 256; }
        else if ((q -= T5) < T6) { const int j = q / 256, r = q % 256, kt = r / 16, nt = r % 16; src = in_mout + (size_t)j * 1024 * 1024; N = 1024; k0 = kt * 64; n0 = nt * 64;
            dst = (bf16_t*)(ws + WS_MOUT + j * SZ_SQ) + (size_t)n0 * 1024 + k0; ld = 1024; }
        else if ((q -= T6) < T7) { const int i = q / 1408, r = q % 1408, kt = r / 88, nt = r % 88; src = in_fup + (size_t)i * 1024 * 5632; N = 5632; k0 = kt * 64; n0 = nt * 64;
            const int isg = n0 >= DFF ? 1 : 0, cc = n0 - isg * DFF, drow = (cc >> 7) * 256 + isg * 128 + (cc & 127);
            dst = (bf16_t*)(ws + WS_FUP + (size_t)i * SZ_FUP) + (size_t)drow * 1024 + k0; ld = 1024; }
        else { q -= T7; const int i = q / 704, r = q % 704, kt = r / 16, nt = r % 16; src = in_fdown + (size_t)i * 2816 * 1024; N = 1024; k0 = kt * 64; n0 = nt * 64;
            dst = (bf16_t*)(ws + WS_FDOWN + (size_t)i * SZ_FDOWN) + (size_t)n0 * 2816 + k0; ld = 2816; }
#pragma unroll
        for (int i = 0; i < 8; ++i) { const int r = (tid >> 6) + 8 * i, c = tid & 63; tl[c * 65 + r] = src[(size_t)(k0 + r) * N + n0 + c]; }
        __syncthreads();
#pragma unroll
        for (int i = 0; i < 4; ++i) { const int rr = (tid >> 5) + 16 * i, c2 = (tid & 31) * 2; const float a = tl[rr * 65 + c2], b = tl[rr * 65 + c2 + 1];
            *(unsigned*)(dst + (size_t)rr * ld + c2) = cvt_pk_bf16(a, b); }
        __syncthreads();
    }
    const int gtid = blockIdx.x * NTHREADS + tid, gstride = gridDim.x * NTHREADS;
    for (int idx = gtid; idx < 65536; idx += gstride) {
        const int k = idx & 1023, r = (idx >> 10) & 15, dir = (idx >> 14) & 1, j = idx >> 15;
        const float v = in_w1[((size_t)(j * 2 + dir) * 1024 + k) * 16 + r];
        ((bf16_t*)(ws + WS_GIN + j * SZ_GIN))[(size_t)(3072 + dir * 16 + r) * 1024 + k] = f2bf(v);
    }
    for (int idx = gtid; idx < 2 * 114688; idx += gstride) { const int j = idx / 114688, o = idx % 114688; ((unsigned*)(ws + WS_GIN + j * SZ_GIN + 3104ull * 1024 * 2))[o] = 0u; }
    for (int idx = gtid; idx < 2 * 32768; idx += gstride) { const int j = idx / 32768, o = idx % 32768; ((unsigned*)(ws + WS_MDOWN + j * SZ_MDOWN + 704ull * 1024 * 2))[o] = 0u; }
    for (int idx = gtid; idx < MR; idx += gstride) ((float*)(ws + WS_RS))[idx] = 0.f;
    LAS float* sl = (LAS float*)lds;
    LAS float* red = (LAS float*)(lds + 81920);
    __syncthreads();
    for (int idx = tid; idx < 17 * 1024; idx += NTHREADS) { const int r = idx >> 10, k = idx & 1023; const float v = r < 16 ? in_c[r * 1024 + k] : in_cctx[k]; sl[k * 20 + r] = v / (1.0f + __expf(-v)); }
    __syncthreads();
    float* mod = (float*)(ws + WS_MOD);
    for (int it = blockIdx.x; it < 384; it += gridDim.x) {
        const int layer = it / 96, n0 = (it % 96) * 64, nn = tid & 63, ks = tid >> 6;
        const float* W = in_wada + (size_t)layer * 1024 * 6144 + n0 + nn;
        float acc[17];
#pragma unroll
        for (int r = 0; r < 17; ++r) acc[r] = 0.f;
        for (int kk = 0; kk < 128; ++kk) {
            const int k = ks * 128 + kk; const float w = W[(size_t)k * 6144];
            const f32x4 s0 = *(const LAS f32x4*)(sl + k * 20), s1 = *(const LAS f32x4*)(sl + k * 20 + 4), s2 = *(const LAS f32x4*)(sl + k * 20 + 8), s3 = *(const LAS f32x4*)(sl + k * 20 + 12);
            const float s16 = sl[k * 20 + 16];
#pragma unroll
            for (int j = 0; j < 4; ++j) { acc[j] += s0[j] * w; acc[4 + j] += s1[j] * w; acc[8 + j] += s2[j] * w; acc[12 + j] += s3[j] * w; }
            acc[16] += s16 * w;
        }
#pragma unroll
        for (int r = 0; r < 17; ++r) red[(ks * 17 + r) * 64 + nn] = acc[r];
        __syncthreads();
        for (int o = tid; o < 17 * 64; o += NTHREADS) { const int r = o >> 6, c = o & 63; float s = in_bada[layer * 6144 + n0 + c];
#pragma unroll
            for (int k8 = 0; k8 < 8; ++k8) s += red[(k8 * 17 + r) * 64 + c];
            mod[(size_t)(layer * 17 + r) * 6144 + n0 + c] = s; }
        __syncthreads();
    }
}

DI void shw_phase(unsigned char* ws, LAS unsigned char* lds) {
    const int tid = tid_opq(), wave = tid >> 6, lane = tid & 63;
    LAS float* sl = (LAS float*)lds;
    const float* mod = (const float*)(ws + WS_MOD);
    constexpr int NCH = 4 * 44 + 6 + 26 + 6;
    for (int ch = blockIdx.x; ch < NCH; ch += gridDim.x) {
        int layer, kind, n0; const bf16_t* Bt;
        if (ch < 176) { layer = ch / 44; kind = 1; n0 = (ch % 44) * 128; Bt = (const bf16_t*)(ws + WS_FUP + (size_t)layer * SZ_FUP); }
        else if (ch < 182) { layer = 1; kind = 0; n0 = (ch - 176) * 128; Bt = (const bf16_t*)(ws + WS_MDOWN); }
        else if (ch < 208) { layer = 2; kind = 0; n0 = (ch - 182) * 128; Bt = (const bf16_t*)(ws + WS_GIN + SZ_GIN); }
        else { layer = 3; kind = 0; n0 = (ch - 208) * 128; Bt = (const bf16_t*)(ws + WS_MDOWN + SZ_MDOWN); }
        __syncthreads();
        for (int idx = tid; idx < 17 * 256; idx += NTHREADS) { const int b = idx >> 8, k4 = (idx & 255) * 4;
            *(LAS f32x4*)(sl + b * 1024 + k4) = *(const f32x4*)(mod + (size_t)(layer * 17 + b) * 6144 + (kind ? 3 * 1024 : 0) + k4); }
        __syncthreads();
        float* out = (float*)(ws + WS_SHW) + (size_t)((layer * 2 + kind) * 17) * 5632;
#pragma unroll 1
        for (int i = 0; i < 16; ++i) {
            const int n = n0 + wave * 16 + i;
            float w[16];
#pragma unroll
            for (int j = 0; j < 4; ++j) { const u32x2 t = *(const u32x2*)(Bt + (size_t)n * 1024 + j * 256 + lane * 4); w[4 * j] = bf_lo(t.x); w[4 * j + 1] = bf_hi(t.x); w[4 * j + 2] = bf_lo(t.y); w[4 * j + 3] = bf_hi(t.y); }
            float mine = 0.f;
#pragma unroll 1
            for (int b = 0; b < 17; ++b) {
                float a = 0.f;
#pragma unroll
                for (int j = 0; j < 4; ++j) { const f32x4 sv = *(const LAS f32x4*)(sl + b * 1024 + j * 256 + lane * 4); a += sv[0] * w[4 * j] + sv[1] * w[4 * j + 1] + sv[2] * w[4 * j + 2] + sv[3] * w[4 * j + 3]; }
                a = wave_sum(a);
                if (lane == b) mine = a;
            }
            if (lane < 17) out[(size_t)lane * 5632 + n] = mine;
        }
    }
    __syncthreads();
}

DI void norm_phase(const float* xl, const float* xc, const float* gain, const float* modl, int sh_off, int sc_off, bf16_t* h) {
    const int tid = tid_opq(), wave = tid >> 6, lane = tid & 63;
    for (int row0 = (blockIdx.x * 8 + wave) * 4; row0 < MR; row0 += gridDim.x * 32) {
        const float* src = row0 < TL ? xl + (size_t)row0 * 1024 : xc + (size_t)(row0 - TL) * 1024;
        const float* mb = modl + (size_t)(row0 < TL ? (row0 >> 12) : 16) * 6144;
        f32x4 v[4][4]; float ss[4];
#pragma unroll
        for (int r = 0; r < 4; ++r)
#pragma unroll
            for (int i = 0; i < 4; ++i) v[r][i] = *(const f32x4*)(src + (size_t)r * 1024 + i * 256 + lane * 4);
#pragma unroll
        for (int r = 0; r < 4; ++r) { float t = 0.f;
#pragma unroll
            for (int i = 0; i < 4; ++i) t += v[r][i][0] * v[r][i][0] + v[r][i][1] * v[r][i][1] + v[r][i][2] * v[r][i][2] + v[r][i][3] * v[r][i][3];
            ss[r] = t; }
#pragma unroll
        for (int o = 32; o >= 1; o >>= 1) {
#pragma unroll
            for (int r = 0; r < 4; ++r) ss[r] += __shfl_xor(ss[r], o);
        }
#pragma unroll
        for (int i = 0; i < 4; ++i) {
            const int c = i * 256 + lane * 4;
            const f32x4 g = *(const f32x4*)(gain + c), sc = *(const f32x4*)(mb + sc_off + c), sh = *(const f32x4*)(mb + sh_off + c);
            const f32x4 gs = g * (sc + 1.0f);
#pragma unroll
            for (int r = 0; r < 4; ++r) {
                const float rstd = rsqrtf(ss[r] * (1.0f / 1024.0f) + 1e-6f);
                const f32x4 y = (v[r][i] * rstd) * gs + sh;
                u32x2 w; w.x = cvt_pk_bf16(y[0], y[1]); w.y = cvt_pk_bf16(y[2], y[3]);
                *(u32x2*)(h + (size_t)(row0 + r) * 1024 + c) = w;
            }
        }
    }
}

DI void scan_rowbase(int dir, int b, int c, int& rb, int& sg) {
    if (dir == 0) { sg = 1; rb = c < 4 ? TL + b * CTXL + c * 64 : b * SEQ + (c - 4) * 64; }
    else { sg = -1; rb = c < 4 ? TL + b * CTXL + 255 - c * 64 : b * SEQ + 4095 - (c - 4) * 64; }
}
struct GPStage { unsigned qv[8], kv[8]; f32x4 lrv; float w2r[16][2]; f32x2 gbias; };
DI void gp_load(GPStage& S, int item, const bf16_t* qk, const float* lr, const float* w2, const float* gb, int tid, int wave, int d0) {
    const int c = item % 68, rest = item / 68, h = rest & 3, dir = (rest >> 2) & 1, b = rest >> 3;
    int rowbase, sgn; scan_rowbase(dir, b, c, rowbase, sgn);
#pragma unroll
    for (int i = 0; i < 8; ++i) { const size_t ro = (size_t)(rowbase + sgn * (wave * 8 + i)) * 1024; S.qv[i] = *(const unsigned*)(qk + ro + h * 128 + d0); S.kv[i] = *(const unsigned*)(qk + ro + 512 + h * 128 + d0); }
    S.lrv = (f32x4){0.f, 0.f, 0.f, 0.f};
    if (tid < 256) S.lrv = *(const f32x4*)(lr + (size_t)(rowbase + sgn * (tid >> 2)) * 32 + dir * 16 + (tid & 3) * 4);
#pragma unroll
    for (int r = 0; r < 16; ++r) { const f32x2 t = *(const f32x2*)(w2 + (size_t)(dir * 16 + r) * 512 + h * 128 + d0); S.w2r[r][0] = t.x; S.w2r[r][1] = t.y; }
    S.gbias = *(const f32x2*)(gb + dir * 512 + h * 128 + d0);
}
DI void gp_item(const GPStage& S, int item, bf16_t* GQ, bf16_t* GK, bf16_t* GP, float* GE, LAS unsigned char* lds, int tid, int wave, int lane) {
    constexpr int QD = 0, KI = 17408, LRS = 34816, SEG = 38912;
    const int l15 = lane & 15, lq = lane >> 4, d0 = 2 * lane;
    if (tid < 256) *(LAS f32x4*)(lds + LRS + (tid >> 2) * 64 + (tid & 3) * 16) = S.lrv;
    __syncthreads();
    const LAS float* lrs = (const LAS float*)(lds + LRS);
    float bl0[8], bl1[8]; float cum0 = 0.f, cum1 = 0.f;
#pragma unroll
    for (int i = 0; i < 8; ++i) {
        const int s = wave * 8 + i;
        float z0 = S.gbias.x, z1 = S.gbias.y;
#pragma unroll
        for (int r4 = 0; r4 < 4; ++r4) { const f32x4 lv = *(const LAS f32x4*)(lrs + s * 16 + r4 * 4);
#pragma unroll
            for (int j = 0; j < 4; ++j) { z0 += lv[j] * S.w2r[r4 * 4 + j][0]; z1 += lv[j] * S.w2r[r4 * 4 + j][1]; } }
        const float g0 = (fminf(z0, 0.f) - __logf(1.0f + __expf(-fabsf(z0)))) * 0.0625f;
        const float g1 = (fminf(z1, 0.f) - __logf(1.0f + __expf(-fabsf(z1)))) * 0.0625f;
        cum0 += g0; cum1 += g1; bl0[i] = cum0; bl1[i] = cum1;
    }
    *(LAS f32x2*)(lds + SEG + (wave * 128 + d0) * 4) = (f32x2){cum0, cum1};
    __syncthreads();
    float off0 = 0.f, off1 = 0.f, tot0 = 0.f, tot1 = 0.f;
#pragma unroll
    for (int w = 0; w < 8; ++w) { const f32x2 t = *(const LAS f32x2*)(lds + SEG + (w * 128 + d0) * 4); tot0 += t.x; tot1 += t.y; if (w < wave) { off0 += t.x; off1 += t.y; } }
    const float et0 = __expf(tot0), et1 = __expf(tot1);
    if (wave == 0) *(f32x2*)(GE + (size_t)item * 128 + d0) = (f32x2){et0, et1};
    {
        unsigned ks0[4], ks1[4];
        bf16_t* gq = GQ + (size_t)item * 8192;
#pragma unroll
        for (int i = 0; i < 8; ++i) {
            const int s = wave * 8 + i;
            const float b0 = off0 + bl0[i], b1 = off1 + bl1[i];
            const float q0 = bf_lo(S.qv[i]), q1 = bf_hi(S.qv[i]), k0 = bf_lo(S.kv[i]), k1 = bf_hi(S.kv[i]);
            const float eb0 = __expf(b0), eb1 = __expf(b1), ib0 = __builtin_amdgcn_rcpf(eb0), ib1 = __builtin_amdgcn_rcpf(eb1);
            const unsigned qd = cvt_pk_bf16(q0 * eb0, q1 * eb1);
            *(LAS unsigned*)(lds + QD + s * 272 + d0 * 2) = qd;
            *(unsigned*)(gq + s * 128 + d0) = qd;
            *(LAS unsigned*)(lds + KI + s * 272 + d0 * 2) = cvt_pk_bf16(k0 * ib0, k1 * ib1);
            const float e0 = k0 * (et0 * ib0), e1 = k1 * (et1 * ib1);
            if (i & 1) { ks0[i >> 1] = (ks0[i >> 1] & 0xffffu) | (cvt_pk_bf16(0.f, e0) & 0xffff0000u); ks1[i >> 1] = (ks1[i >> 1] & 0xffffu) | (cvt_pk_bf16(0.f, e1) & 0xffff0000u); }
            else { ks0[i >> 1] = cvt_pk_bf16(e0, 0.f) & 0xffffu; ks1[i >> 1] = cvt_pk_bf16(e1, 0.f) & 0xffffu; }
        }
        bf16_t* gk = GK + (size_t)item * 8192;
        *(u32x4*)(gk + d0 * 64 + wave * 8) = (u32x4){ks0[0], ks0[1], ks0[2], ks0[3]};
        *(u32x4*)(gk + (d0 + 1) * 64 + wave * 8) = (u32x4){ks1[0], ks1[1], ks1[2], ks1[3]};
    }
    __syncthreads();
    {
        bf16_t* gp = GP + (size_t)item * 4096;
        const int t0 = 16 * (wave >> 1);
#pragma unroll
        for (int j = 0; j < 2; ++j) {
            const int s0 = 16 * ((wave & 1) * 2 + j);
            f32x4 a4 = (f32x4){0.f, 0.f, 0.f, 0.f};
#pragma unroll
            for (int kk = 0; kk < 4; ++kk) {
                const bf16x8 af = *(const LAS bf16x8*)(lds + QD + (t0 + l15) * 272 + (kk * 32 + 8 * lq) * 2);
                const bf16x8 bf = *(const LAS bf16x8*)(lds + KI + (s0 + l15) * 272 + (kk * 32 + 8 * lq) * 2);
                a4 = __builtin_amdgcn_mfma_f32_16x16x32_bf16(af, bf, a4, 0, 0, 0);
            }
            const int sc = s0 + l15;
#pragma unroll
            for (int r = 0; r < 4; ++r) { const int t = t0 + 4 * lq + r; gp[t * 64 + sc] = f2bf(sc <= t ? a4[r] : 0.f); }
        }
    }
}
DI void gateprep_phase(const bf16_t* qk, const float* lr, const float* w2, const float* gb, bf16_t* GQ, bf16_t* GK, bf16_t* GP, float* GE, LAS unsigned char* lds) {
    const int tid = tid_opq(), wave = __builtin_amdgcn_readfirstlane(tid >> 6), lane = tid & 63, d0 = 2 * lane;
    const int G = gridDim.x;
    GPStage A, B;
    int item = opq((int)blockIdx.x);
    if (item < NCHI) gp_load(A, item, qk, lr, w2, gb, tid, wave, d0);
    for (; item < NCHI; item += 2 * G) {
        if (item + G < NCHI) gp_load(B, item + G, qk, lr, w2, gb, tid, wave, d0);
        gp_item(A, item, GQ, GK, GP, GE, lds, tid, wave, lane);
        if (item + G < NCHI) {
            if (item + 2 * G < NCHI) gp_load(A, item + 2 * G, qk, lr, w2, gb, tid, wave, d0);
            gp_item(B, item + G, GQ, GK, GP, GE, lds, tid, wave, lane);
        }
    }
    __syncthreads();
}

DI void scan_phase(const bf16_t* vr, const bf16_t* GQ, const bf16_t* GK, const bf16_t* GP, const float* GE, bf16_t* of, bf16_t* ob, LAS unsigned char* lds) {
    constexpr int QD = 0, KST = 17408, VT = 35840, ST = 54272, PP = 89088, BL = 98304;
    const int tid = tid_opq(), wave = __builtin_amdgcn_readfirstlane(tid >> 6), lane = tid & 63;
    const int l31 = lane & 31, lh = lane >> 5;
    for (int item = blockIdx.x; item < 256; item += gridDim.x) {
        const int xcd_ = item & 7, slot_ = item >> 3, dvh = slot_ & 1, pair_ = (slot_ >> 1) * 8 + xcd_;
        const int b = pair_ >> 3, dir = (pair_ >> 2) & 1, h = pair_ & 3;
        bf16_t* obuf = dir ? ob : of;
        const int d0 = 2 * lane;
        const int gi0 = ((b * 2 + dir) * 4 + h) * 68;
        f32x16 Sacc[2];
#pragma unroll
        for (int i = 0; i < 16; ++i) { Sacc[0][i] = 0.f; Sacc[1][i] = 0.f; }
        __syncthreads();
        { unsigned z_ = 0u; asm volatile("" : "+v"(z_));
          for (int o = tid; o < 34816 / 16; o += NTHREADS) *(LAS u32x4*)(lds + ST + o * 16) = (u32x4){z_, z_, z_, z_}; }
        const int vcol = h * 256 + dvh * 128 + d0;
        struct ScStage { u32x4 gq0, gq1, gk0, gk1, gp0; unsigned vv[8]; float ebv; } A, B;
        A.ebv = 0.f; B.ebv = 0.f;
#define SCAN_LOAD(S, c) do { int rb_, sg_; scan_rowbase(dir, b, (c), rb_, sg_); const size_t gi_ = (size_t)(gi0 + (c)); \
        S.gq0 = *(const u32x4*)(GQ + gi_ * 8192 + tid * 8); S.gq1 = *(const u32x4*)(GQ + gi_ * 8192 + 4096 + tid * 8); \
        S.gk0 = *(const u32x4*)(GK + gi_ * 8192 + tid * 8); S.gk1 = *(const u32x4*)(GK + gi_ * 8192 + 4096 + tid * 8); \
        S.gp0 = *(const u32x4*)(GP + gi_ * 4096 + tid * 8); if (tid < 128) S.ebv = GE[gi_ * 128 + tid]; \
        _Pragma("unroll") for (int i = 0; i < 8; ++i) S.vv[i] = *(const unsigned*)(vr + (size_t)(rb_ + sg_ * (wave * 8 + i)) * 2048 + vcol); } while (0)
#define SCAN_CHUNK(S, c) do { \
            int rowbase, sgn; scan_rowbase(dir, b, (c), rowbase, sgn); \
            { const int e0 = tid * 8, e1 = 4096 + tid * 8; \
              *(LAS u32x4*)(lds + QD + (e0 >> 7) * 272 + (e0 & 127) * 2) = S.gq0; *(LAS u32x4*)(lds + QD + (e1 >> 7) * 272 + (e1 & 127) * 2) = S.gq1; \
              *(LAS u32x4*)(lds + KST + (e0 >> 6) * 144 + (e0 & 63) * 2) = S.gk0; *(LAS u32x4*)(lds + KST + (e1 >> 6) * 144 + (e1 & 63) * 2) = S.gk1; \
              *(LAS u32x4*)(lds + PP + (e0 >> 6) * 144 + (e0 & 63) * 2) = S.gp0; \
              if (tid < 128) *(LAS float*)(lds + BL + tid * 4) = S.ebv; \
              unsigned vt0[4], vt1[4]; \
              _Pragma("unroll") for (int i = 0; i < 8; ++i) { \
                  if (i & 1) { vt0[i >> 1] = (vt0[i >> 1] & 0xffffu) | (S.vv[i] << 16); vt1[i >> 1] = (vt1[i >> 1] & 0xffffu) | (S.vv[i] & 0xffff0000u); } \
                  else { vt0[i >> 1] = S.vv[i] & 0xffffu; vt1[i >> 1] = S.vv[i] >> 16; } } \
              *(LAS u32x4*)(lds + VT + d0 * 144 + wave * 16) = (u32x4){vt0[0], vt0[1], vt0[2], vt0[3]}; \
              *(LAS u32x4*)(lds + VT + (d0 + 1) * 144 + wave * 16) = (u32x4){vt1[0], vt1[1], vt1[2], vt1[3]}; \
            } \
            __syncthreads();     \
            if ((c) + 2 < 68) SCAN_LOAD(S, (c) + 2); \
            { \
                const int tq = wave >> 2, vq = wave & 3; \
                f32x16 oacc; \
                _Pragma("unroll") for (int i = 0; i < 16; ++i) oacc[i] = 0.f; \
                _Pragma("unroll") for (int kk = 0; kk < 8; ++kk) { \
                    const bf16x8 af = *(const LAS bf16x8*)(lds + QD + (32 * tq + l31) * 272 + (kk * 16 + 8 * lh) * 2); \
                    const bf16x8 bf = *(const LAS bf16x8*)(lds + ST + (32 * vq + l31) * 272 + (kk * 16 + 8 * lh) * 2); \
                    oacc = __builtin_amdgcn_mfma_f32_32x32x16_bf16(af, bf, oacc, 0, 0, 0); } \
                _Pragma("unroll") for (int kk = 0; kk < 4; ++kk) { \
                    const bf16x8 af = *(const LAS bf16x8*)(lds + PP + (32 * tq + l31) * 144 + (kk * 16 + 8 * lh) * 2); \
                    const bf16x8 bf = *(const LAS bf16x8*)(lds + VT + (32 * vq + l31) * 144 + (kk * 16 + 8 * lh) * 2); \
                    oacc = __builtin_amdgcn_mfma_f32_32x32x16_bf16(af, bf, oacc, 0, 0, 0); } \
                const int ocol = h * 256 + dvh * 128 + 32 * vq + l31; \
                _Pragma("unroll") for (int r = 0; r < 16; ++r) { const int t = 32 * tq + crow(r, lh); obuf[(size_t)(rowbase + sgn * t) * 1024 + ocol] = f2bf(oacc[r]); } \
            } \
            { \
                const int vq = wave & 3; \
                _Pragma("unroll") for (int j = 0; j < 2; ++j) { \
                    const int dq = 2 * (wave >> 2) + j; \
                    _Pragma("unroll") for (int r = 0; r < 16; ++r) Sacc[j][r] *= *(const LAS float*)(lds + BL + (32 * dq + crow(r, lh)) * 4); \
                    _Pragma("unroll") for (int kk = 0; kk < 4; ++kk) { \
                        const bf16x8 af = *(const LAS bf16x8*)(lds + KST + (32 * dq + l31) * 144 + (kk * 16 + 8 * lh) * 2); \
                        const bf16x8 bf = *(const LAS bf16x8*)(lds + VT + (32 * vq + l31) * 144 + (kk * 16 + 8 * lh) * 2); \
                        Sacc[j] = __builtin_amdgcn_mfma_f32_32x32x16_bf16(af, bf, Sacc[j], 0, 0, 0); } } \
            } \
            __syncthreads();     \
            { \
                const int vq = wave & 3; \
                _Pragma("unroll") for (int j = 0; j < 2; ++j) { \
                    const int dq = 2 * (wave >> 2) + j; \
                    _Pragma("unroll") for (int g = 0; g < 4; ++g) { \
                        u32x2 w; w.x = cvt_pk_bf16(Sacc[j][4 * g], Sacc[j][4 * g + 1]); w.y = cvt_pk_bf16(Sacc[j][4 * g + 2], Sacc[j][4 * g + 3]); \
                        *(LAS u32x2*)(lds + ST + (32 * vq + l31) * 272 + (32 * dq + 8 * g + 4 * lh) * 2) = w; } } \
            } } while (0)
        SCAN_LOAD(A, 0); SCAN_LOAD(B, 1);
        for (int c = 0; c < 68; c += 2) { SCAN_CHUNK(A, c); SCAN_CHUNK(B, c + 1); }
#undef SCAN_CHUNK
#undef SCAN_LOAD
    }
    __syncthreads();
}

DI void glapost_phase(const bf16_t* of, const bf16_t* ob, const bf16_t* vr, const float* onorm, bf16_t* a) {
    const int tid = tid_opq(), wave = tid >> 6, lane = tid & 63;
    const int c0 = lane * 16;
    float gn[16];
#pragma unroll
    for (int j = 0; j < 4; ++j) { const f32x4 t = *(const f32x4*)(onorm + (c0 & 255) + 4 * j); gn[4 * j] = t[0]; gn[4 * j + 1] = t[1]; gn[4 * j + 2] = t[2]; gn[4 * j + 3] = t[3]; }
    for (int row0 = (blockIdx.x * 8 + wave) * 4; row0 < MR; row0 += gridDim.x * 32) {
        u32x4 f0[4], f1[4], b0[4], b1[4], r0[4], r1[4];
#pragma unroll
        for (int q = 0; q < 4; ++q) { const size_t ro = (size_t)(row0 + q);
            f0[q] = *(const u32x4*)(of + ro * 1024 + c0); f1[q] = *(const u32x4*)(of + ro * 1024 + c0 + 8);
            b0[q] = *(const u32x4*)(ob + ro * 1024 + c0); b1[q] = *(const u32x4*)(ob + ro * 1024 + c0 + 8);
            r0[q] = *(const u32x4*)(vr + ro * 2048 + 1024 + c0); r1[q] = *(const u32x4*)(vr + ro * 2048 + 1024 + c0 + 8); }
        asm volatile("" ::: "memory");
#pragma unroll
        for (int q = 0; q < 4; ++q) {
            float o[16], rr[16];
#pragma unroll
            for (int j = 0; j < 4; ++j) {
                o[2 * j] = bf_lo(f0[q][j]) + bf_lo(b0[q][j]); o[2 * j + 1] = bf_hi(f0[q][j]) + bf_hi(b0[q][j]);
                o[8 + 2 * j] = bf_lo(f1[q][j]) + bf_lo(b1[q][j]); o[8 + 2 * j + 1] = bf_hi(f1[q][j]) + bf_hi(b1[q][j]);
                rr[2 * j] = bf_lo(r0[q][j]); rr[2 * j + 1] = bf_hi(r0[q][j]); rr[8 + 2 * j] = bf_lo(r1[q][j]); rr[8 + 2 * j + 1] = bf_hi(r1[q][j]);
            }
            float ss = 0.f;
#pragma unroll
            for (int j = 0; j < 16; ++j) ss += o[j] * o[j];
            ss += __shfl_xor(ss, 1); ss += __shfl_xor(ss, 2); ss += __shfl_xor(ss, 4); ss += __shfl_xor(ss, 8);
            const float rstd = rsqrtf(ss * (1.0f / 256.0f) + 1e-6f);
            unsigned w[8];
#pragma unroll
            for (int j = 0; j < 8; ++j) {
                const float y0 = o[2 * j] * rstd * gn[2 * j] * silu_f(rr[2 * j]), y1 = o[2 * j + 1] * rstd * gn[2 * j + 1] * silu_f(rr[2 * j + 1]);
                w[j] = cvt_pk_bf16(y0, y1);
            }
            *(u32x4*)(a + (size_t)(row0 + q) * 1024 + c0) = (u32x4){w[0], w[1], w[2], w[3]};
            *(u32x4*)(a + (size_t)(row0 + q) * 1024 + c0 + 8) = (u32x4){w[4], w[5], w[6], w[7]};
        }
    }
}

DI void rope_cs(int tpos, int lane, float& cs, float& sn) {
    const int f = lane & 15; const int pos = (lane >> 5) ? (tpos & 63) : (tpos >> 6);
    const float inv = exp2f(-(float)f * (13.287712379549449f / 16.0f));
    const float ang = (float)pos * inv;
    const float kf = rintf(ang * 0.15915494309189535f);
    float r = fmaf(-kf, 6.2831854820251465f, ang); r = fmaf(-kf, -1.7484556000744883e-7f, r);
    cs = __cosf(r); sn = __sinf(r);
}
DI float rope_apply(float y, int lane, float cs, float sn) {
    const float pr = __shfl_xor(y, 16);
    return (lane & 16) ? (pr * sn + y * cs) : (y * cs - pr * sn);
}
DI int key_of_row(int row) {
    if (row < TL) { const int b = row >> 12; return b * KEYS + CTXL + (row & 4095); }
    const int rc = row - TL; const int b = rc >> 8; return b * KEYS + (rc & 255);
}

DI void mlamid_phase(const bf16_t* dn, const float* qln, const float* kvln, const float* knorm, bf16_t* cqn, bf16_t* ckvn, bf16_t* KB) {
    const int tid = tid_opq(), wave = tid >> 6, lane = tid & 63;
    float gq[6];
#pragma unroll
    for (int i = 0; i < 3; ++i) { gq[2 * i] = qln[i * 128 + 2 * lane]; gq[2 * i + 1] = qln[i * 128 + 2 * lane + 1]; }
    const f32x4 gkv = *(const f32x4*)(kvln + 4 * lane);
    const float gpe = knorm[128 + lane];
    for (int row0 = (blockIdx.x * 8 + wave) * 4; row0 < MR; row0 += gridDim.x * 32) {
        unsigned q[4][3]; u32x2 kvv[4]; bf16_t pe[4];
#pragma unroll
        for (int r = 0; r < 4; ++r) { const bf16_t* src = dn + (size_t)(row0 + r) * 768;
#pragma unroll
            for (int i = 0; i < 3; ++i) q[r][i] = *(const unsigned*)(src + i * 128 + 2 * lane);
            kvv[r] = *(const u32x2*)(src + 384 + 4 * lane); pe[r] = src[640 + lane]; }
#pragma unroll
        for (int r = 0; r < 4; ++r) {
            const int row = row0 + r;
            float ss = 0.f;
#pragma unroll
            for (int i = 0; i < 3; ++i) { const float a = bf_lo(q[r][i]), b = bf_hi(q[r][i]); ss += a * a + b * b; }
            ss = wave_sum(ss);
            float rstd = rsqrtf(ss * (1.0f / 384.0f) + 1e-6f);
#pragma unroll
            for (int i = 0; i < 3; ++i) *(unsigned*)(cqn + (size_t)row * 384 + i * 128 + 2 * lane) = cvt_pk_bf16(bf_lo(q[r][i]) * rstd * gq[2 * i], bf_hi(q[r][i]) * rstd * gq[2 * i + 1]);
            const float k0 = bf_lo(kvv[r].x), k1 = bf_hi(kvv[r].x), k2 = bf_lo(kvv[r].y), k3 = bf_hi(kvv[r].y);
            ss = wave_sum(k0 * k0 + k1 * k1 + k2 * k2 + k3 * k3);
            rstd = rsqrtf(ss * (1.0f / 256.0f) + 1e-6f);
            { u32x2 w; w.x = cvt_pk_bf16(k0 * rstd * gkv[0], k1 * rstd * gkv[1]); w.y = cvt_pk_bf16(k2 * rstd * gkv[2], k3 * rstd * gkv[3]);
              *(u32x2*)(ckvn + (size_t)row * 256 + 4 * lane) = w; }
            const float x = __uint_as_float(((unsigned)pe[r]) << 16);
            ss = wave_sum(x * x);
            rstd = rsqrtf(ss * (1.0f / 64.0f) + 1e-6f);
            float y = x * rstd * gpe;
            if (row < TL) { float cs, sn; rope_cs(row & 4095, lane, cs, sn); y = rope_apply(y, lane, cs, sn); }
            const bf16_t yb = f2bf(y);
            bf16_t* kd = KB + (size_t)key_of_row(row) * 1536 + 128 + lane;
#pragma unroll
            for (int hh = 0; hh < 8; ++hh) kd[hh * 192] = yb;
        }
    }
}

DI void qkprep_phase(bf16_t* KB, const float* knorm) {
    const int tid = tid_opq(), wave = tid >> 6, lane = tid & 63;
    const float kn0 = knorm[2 * lane], kn1 = knorm[2 * lane + 1];
    for (int row0 = (blockIdx.x * 8 + wave) * 2; row0 < MR; row0 += gridDim.x * 16) {
        unsigned ka[2][8];
        bf16_t* kr0 = KB + (size_t)key_of_row(row0) * 1536; bf16_t* kr1 = KB + (size_t)key_of_row(row0 + 1) * 1536;
#pragma unroll
        for (int hh = 0; hh < 8; ++hh) { ka[0][hh] = *(const unsigned*)(kr0 + hh * 192 + 2 * lane); ka[1][hh] = *(const unsigned*)(kr1 + hh * 192 + 2 * lane); }
        asm volatile("" ::: "memory");
#pragma unroll
        for (int r = 0; r < 2; ++r) {
            bf16_t* kr = r ? kr1 : kr0;
#pragma unroll
            for (int hh = 0; hh < 8; ++hh) {
                const float c0 = bf_lo(ka[r][hh]), c1 = bf_hi(ka[r][hh]);
                const float s3 = wave_sum(c0 * c0 + c1 * c1);
                const float r3 = rsqrtf(s3 * (1.0f / 128.0f) + 1e-6f);
                *(unsigned*)(kr + hh * 192 + 2 * lane) = cvt_pk_bf16(c0 * r3 * kn0, c1 * r3 * kn1);
            }
        }
    }
}

namespace att {
constexpr int DQK = 192, DV = 128, NW = 8, QBLK = 32, KVBLK = 64;
constexpr int LDQ = 1536, LDK = 1536, LDV = 1024, LDO = 1024;
constexpr float SCALE = 0.07216878364870322f;
constexpr float THR = 8.f;
constexpr size_t SHM_V = KVBLK * DV * 2, SHM_K = KVBLK * DQK * 2;
#define KSWZ(row, colB) ((row) * 384 + ((colB) ^ ((((row) >> 1) & 7) << 4)))
#define SBAR() __builtin_amdgcn_sched_barrier(0)
DI unsigned cvtpk(float lo, float hi) { unsigned r; asm volatile("v_cvt_pk_bf16_f32 %0, %1, %2" : "=v"(r) : "v"(lo), "v"(hi)); return r; }
DI void partialSM(f32x16& p0, f32x16& p1, float& m_reg, float& mn, float& alpha) {
    constexpr float C = SCALE * 1.4426950408889634f;
    float pmax = p0[0];
#pragma unroll
    for (int r = 1; r < 16; ++r) pmax = fmaxf(pmax, p0[r]);
#pragma unroll
    for (int r = 0; r < 16; ++r) pmax = fmaxf(pmax, p1[r]);
    { auto rr = __builtin_amdgcn_permlane32_swap(__float_as_uint(pmax), __float_as_uint(pmax), false, false);
      pmax = fmaxf(__uint_as_float(rr[0]), __uint_as_float(rr[1])); }
    if (__builtin_expect(__all(pmax - m_reg <= THR / SCALE), 1)) { mn = m_reg; alpha = 1.f; }
    else { mn = fmaxf(m_reg, pmax); alpha = __builtin_amdgcn_exp2f((m_reg - mn) * C); m_reg = mn; }
    const float mnC = -mn * C;
#pragma unroll
    for (int r = 0; r < 16; ++r) p0[r] = fmaf(p0[r], C, mnC);
#pragma unroll
    for (int r = 0; r < 16; ++r) p1[r] = fmaf(p1[r], C, mnC);
#pragma unroll
    for (int r = 0; r < 16; ++r) p0[r] = __builtin_amdgcn_exp2f(p0[r]);
}
DI void finishSM(f32x16& p0, f32x16& p1, float alpha, float& l_reg, bf16x8& pa0, bf16x8& pa1, bf16x8& pa2, bf16x8& pa3) {
#pragma unroll
    for (int r = 0; r < 16; ++r) p1[r] = __builtin_amdgcn_exp2f(p1[r]);
    float ps = 0;
#pragma unroll
    for (int r = 0; r < 16; ++r) ps += p0[r];
#pragma unroll
    for (int r = 0; r < 16; ++r) ps += p1[r];
    { auto rr = __builtin_amdgcn_permlane32_swap(__float_as_uint(ps), __float_as_uint(ps), false, false);
      ps = __uint_as_float(rr[0]) + __uint_as_float(rr[1]); }
    l_reg = l_reg * alpha + ps;
#define PK4(P, BASE, OUT) do { unsigned a0 = cvtpk(P[BASE + 0], P[BASE + 1]), a1 = cvtpk(P[BASE + 2], P[BASE + 3]);   \
    unsigned b0 = cvtpk(P[BASE + 4], P[BASE + 5]), b1 = cvtpk(P[BASE + 6], P[BASE + 7]);                              \
    auto r0 = __builtin_amdgcn_permlane32_swap(a0, b0, false, false); auto r1 = __builtin_amdgcn_permlane32_swap(a1, b1, false, false); \
    u32x4 w = {r0[0], r1[0], r0[1], r1[1]}; OUT = *reinterpret_cast<bf16x8*>(&w); } while (0)
    PK4(p0, 0, pa0); PK4(p0, 8, pa1); PK4(p1, 0, pa2); PK4(p1, 8, pa3);
#undef PK4
}
DI void qkt(f32x16& p0, f32x16& p1, const char* Ks, const bf16x8* qr, int r32, int hi) {
#pragma unroll
    for (int r = 0; r < 16; ++r) { p0[r] = 0.f; p1[r] = 0.f; }
    bf16x8 ka[3], kb[3];
#define QK_RD(D0, SLOT) do { const int cb_ = ((D0) * 16 + hi * 8) * 2; ka[SLOT] = *reinterpret_cast<const bf16x8*>(Ks + KSWZ(r32, cb_)); kb[SLOT] = *reinterpret_cast<const bf16x8*>(Ks + KSWZ(32 + r32, cb_)); } while (0)
    QK_RD(0, 0); QK_RD(1, 1);
    __builtin_amdgcn_sched_barrier(0);
#pragma unroll
    for (int d0 = 0; d0 < 12; ++d0) {
        if (d0 + 2 < 12) QK_RD(d0 + 2, (d0 + 2) % 3);
        p0 = __builtin_amdgcn_mfma_f32_32x32x16_bf16(ka[d0 % 3], qr[d0], p0, 0, 0, 0);
        p1 = __builtin_amdgcn_mfma_f32_32x32x16_bf16(kb[d0 % 3], qr[d0], p1, 0, 0, 0);
        __builtin_amdgcn_sched_barrier(0);
    }
#undef QK_RD
}
DI int v_st(int k, int c) { const int kk = (k & ~0xC) | ((k & 4) << 1) | ((k & 8) >> 1); return ((kk >> 3) * 4 + (c >> 5)) * 512 + ((kk & 7) * 32 + (c & 31)) * 2; }
DI int v_rd_base(int lane) { return ((lane & 3) << 3) | (((lane >> 2) & 3) << 6) | (((lane >> 4) & 1) << 5) | (((lane >> 5) & 1) << 8); }
constexpr int v_rd_off(int d0, int ks, int half) { return d0 * 512 + ks * 4096 + half * 2048; }
template <int OFF> DI s16x4 tr_read(int vb) { s16x4 r; asm volatile("ds_read_b64_tr_b16 %0, %1 offset:%2" : "=&v"(r) : "v"(vb), "i"(OFF) : "memory"); return r; }
template <int D0> DI void pv_one(f32x16& od, int vb, bf16x8 pa0, bf16x8 pa1, bf16x8 pa2, bf16x8 pa3) {
    const s16x4 l0 = tr_read<v_rd_off(D0, 0, 0)>(vb), h0 = tr_read<v_rd_off(D0, 0, 1)>(vb), l1 = tr_read<v_rd_off(D0, 1, 0)>(vb), h1 = tr_read<v_rd_off(D0, 1, 1)>(vb);
    const s16x4 l2 = tr_read<v_rd_off(D0, 2, 0)>(vb), h2 = tr_read<v_rd_off(D0, 2, 1)>(vb), l3 = tr_read<v_rd_off(D0, 3, 0)>(vb), h3 = tr_read<v_rd_off(D0, 3, 1)>(vb);
    asm volatile("s_waitcnt lgkmcnt(0)" ::: "memory"); SBAR();
#define PK(L, H) (bf16x8){L[0], L[1], L[2], L[3], H[0], H[1], H[2], H[3]}
    od = __builtin_amdgcn_mfma_f32_32x32x16_bf16(pa0, PK(l0, h0), od, 0, 0, 0);
    od = __builtin_amdgcn_mfma_f32_32x32x16_bf16(pa1, PK(l1, h1), od, 0, 0, 0);
    od = __builtin_amdgcn_mfma_f32_32x32x16_bf16(pa2, PK(l2, h2), od, 0, 0, 0);
    od = __builtin_amdgcn_mfma_f32_32x32x16_bf16(pa3, PK(l3, h3), od, 0, 0, 0);
#undef PK
}
DI void pv_d0(f32x16* o, int vb, bf16x8 pa0, bf16x8 pa1, bf16x8 pa2, bf16x8 pa3) {
    pv_one<0>(o[0], vb, pa0, pa1, pa2, pa3); pv_one<1>(o[1], vb, pa0, pa1, pa2, pa3); pv_one<2>(o[2], vb, pa0, pa1, pa2, pa3); pv_one<3>(o[3], vb, pa0, pa1, pa2, pa3);
}
DI void attn_body(const bf16_t* __restrict__ Qb, const bf16_t* __restrict__ Kh, const bf16_t* __restrict__ Vh, bf16_t* __restrict__ Ob, int seq, char* lds, const float* __restrict__ qnorm, int tpos0) {
    const int tid = tid_opq(), wid = tid >> 6, lane = tid & 63, r32 = lane & 31, hi = lane >> 5;
    char* V_lds = lds; char* K_lds = lds + 2 * SHM_V;
    float* wsf = (float*)(lds + 2 * SHM_V + 2 * SHM_K) + wid * 64; float* li_l = wsf; float* al_l = wsf + 32;
    float m_reg = -1e30f, l_reg = 0; f32x16 o[4]; bf16x8 qr[12];
#pragma unroll
    for (int d = 0; d < 4; ++d)
#pragma unroll
        for (int r = 0; r < 16; ++r) o[d][r] = 0.f;
    const bf16_t* Qw = Qb + (long)(wid * QBLK + r32) * LDQ + hi * 8;
#pragma unroll
    for (int d0 = 0; d0 < 12; ++d0) qr[d0] = *reinterpret_cast<const bf16x8*>(Qw + d0 * 16);
    {
        float ssn = 0.f, ssr = 0.f;
#pragma unroll
        for (int d0 = 0; d0 < 12; ++d0) {
            const u32x4 w = *reinterpret_cast<const u32x4*>(&qr[d0]); float t = 0.f;
#pragma unroll
            for (int j = 0; j < 4; ++j) { const float a = bf_lo(w[j]), b = bf_hi(w[j]); t += a * a + b * b; }
            if (d0 < 8) ssn += t; else ssr += t;
        }
        ssn += __shfl_xor(ssn, 32); ssr += __shfl_xor(ssr, 32);
        const float rn = rsqrtf(ssn * (1.0f / 128.0f) + 1e-6f), rr = rsqrtf(ssr * (1.0f / 64.0f) + 1e-6f);
        float cs[2][8], sn[2][8];
        if (tpos0 >= 0) {
            const int t = tpos0 + wid * QBLK + r32;
#pragma unroll
            for (int a = 0; a < 2; ++a) { const float pos = (float)(a ? (t & 63) : (t >> 6));
#pragma unroll
                for (int j = 0; j < 8; ++j) { const float inv = exp2f(-(float)(hi * 8 + j) * (13.287712379549449f / 16.0f)); const float ang = pos * inv;
                    const float kf = rintf(ang * 0.15915494309189535f); float r = fmaf(-kf, 6.2831854820251465f, ang); r = fmaf(-kf, -1.7484556000744883e-7f, r);
                    cs[a][j] = __cosf(r); sn[a][j] = __sinf(r); } }
        } else {
#pragma unroll
            for (int a = 0; a < 2; ++a)
#pragma unroll
                for (int j = 0; j < 8; ++j) { cs[a][j] = 1.f; sn[a][j] = 0.f; }
        }
#pragma unroll
        for (int d0 = 0; d0 < 8; ++d0) {
            const u32x4 w = *reinterpret_cast<const u32x4*>(&qr[d0]); const float* gp = qnorm + d0 * 16 + hi * 8; const f32x4 g0 = *(const f32x4*)gp, g1 = *(const f32x4*)(gp + 4);
            u32x4 o4; o4.x = cvt_pk_bf16(bf_lo(w.x) * rn * g0[0], bf_hi(w.x) * rn * g0[1]); o4.y = cvt_pk_bf16(bf_lo(w.y) * rn * g0[2], bf_hi(w.y) * rn * g0[3]);
            o4.z = cvt_pk_bf16(bf_lo(w.z) * rn * g1[0], bf_hi(w.z) * rn * g1[1]); o4.w = cvt_pk_bf16(bf_lo(w.w) * rn * g1[2], bf_hi(w.w) * rn * g1[3]);
            qr[d0] = *reinterpret_cast<const bf16x8*>(&o4);
        }
#pragma unroll
        for (int a = 0; a < 2; ++a) {
            const u32x4 w1 = *reinterpret_cast<const u32x4*>(&qr[8 + 2 * a]), w2 = *reinterpret_cast<const u32x4*>(&qr[9 + 2 * a]);
            const float* g1p = qnorm + (8 + 2 * a) * 16 + hi * 8; const float* g2p = g1p + 16;
            float x1[8], x2[8], y1[8], y2[8];
#pragma unroll
            for (int j = 0; j < 4; ++j) { x1[2 * j] = bf_lo(w1[j]) * rr * g1p[2 * j]; x1[2 * j + 1] = bf_hi(w1[j]) * rr * g1p[2 * j + 1]; x2[2 * j] = bf_lo(w2[j]) * rr * g2p[2 * j]; x2[2 * j + 1] = bf_hi(w2[j]) * rr * g2p[2 * j + 1]; }
#pragma unroll
            for (int j = 0; j < 8; ++j) { y1[j] = x1[j] * cs[a][j] - x2[j] * sn[a][j]; y2[j] = x1[j] * sn[a][j] + x2[j] * cs[a][j]; }
            u32x4 o1, o2;
            o1.x = cvt_pk_bf16(y1[0], y1[1]); o1.y = cvt_pk_bf16(y1[2], y1[3]); o1.z = cvt_pk_bf16(y1[4], y1[5]); o1.w = cvt_pk_bf16(y1[6], y1[7]);
            o2.x = cvt_pk_bf16(y2[0], y2[1]); o2.y = cvt_pk_bf16(y2[2], y2[3]); o2.z = cvt_pk_bf16(y2[4], y2[5]); o2.w = cvt_pk_bf16(y2[6], y2[7]);
            qr[8 + 2 * a] = *reinterpret_cast<const bf16x8*>(&o1); qr[9 + 2 * a] = *reinterpret_cast<const bf16x8*>(&o2);
        }
    }
    const int sr = tid >> 4, sc = (tid & 15) * 8, vst0 = v_st(sr, sc), vst1 = v_st(32 + sr, sc);
    const int pr = tid >> 3, pc = 128 + (tid & 7) * 8;
    const int vb0 = (int)(uintptr_t)V_lds + v_rd_base(lane);
    bf16x8 vs0, vs1, ks0, ks1, kp;
#define SLOAD(k0) do { vs0 = *reinterpret_cast<const bf16x8*>(&Vh[(long)((k0) + sr) * LDV + sc]); vs1 = *reinterpret_cast<const bf16x8*>(&Vh[(long)((k0) + 32 + sr) * LDV + sc]); \
    ks0 = *reinterpret_cast<const bf16x8*>(&Kh[(long)((k0) + sr) * LDK + sc]); ks1 = *reinterpret_cast<const bf16x8*>(&Kh[(long)((k0) + 32 + sr) * LDK + sc]); \
    kp = *reinterpret_cast<const bf16x8*>(&Kh[(long)((k0) + pr) * LDK + pc]); } while (0)
#define SWRITE(b) do { *(bf16x8*)(V_lds + (b) * SHM_V + vst0) = vs0; *(bf16x8*)(V_lds + (b) * SHM_V + vst1) = vs1; \
    *(bf16x8*)(K_lds + (b) * SHM_K + KSWZ(sr, sc * 2)) = ks0; *(bf16x8*)(K_lds + (b) * SHM_K + KSWZ(32 + sr, sc * 2)) = ks1; \
    *(bf16x8*)(K_lds + (b) * SHM_K + KSWZ(pr, pc * 2)) = kp; } while (0)
#define RESC(a) do { if (__any((a) < 1.f)) { if (hi == 0) al_l[r32] = (a); asm volatile("s_waitcnt lgkmcnt(0)" ::: "memory"); \
    _Pragma("unroll") for (int d = 0; d < 4; ++d) _Pragma("unroll") for (int r = 0; r < 16; ++r) o[d][r] *= al_l[crow(r, hi)]; } } while (0)
    f32x16 p0, p1; float mn, al; bf16x8 pa0, pa1, pa2, pa3; const int NT = seq / KVBLK;
    SLOAD(0); asm volatile("s_waitcnt vmcnt(0)" ::: "memory"); SWRITE(0); __syncthreads();
    for (int j = 0; j < NT; ++j) {
        const int cb = j & 1;
        if (j + 1 < NT) SLOAD((j + 1) * KVBLK);
        SBAR(); qkt(p0, p1, K_lds + cb * SHM_K, qr, r32, hi);
        partialSM(p0, p1, m_reg, mn, al);
        finishSM(p0, p1, al, l_reg, pa0, pa1, pa2, pa3);
        RESC(al); SBAR();
        pv_d0(o, vb0 + cb * (int)SHM_V, pa0, pa1, pa2, pa3);
        if (j + 1 < NT) { asm volatile("s_waitcnt vmcnt(0)" ::: "memory"); SWRITE(cb ^ 1); }
        __syncthreads();
    }
    if (hi == 0) li_l[r32] = l_reg; asm volatile("s_waitcnt lgkmcnt(0)" ::: "memory");
    float rli[16];
#pragma unroll
    for (int r = 0; r < 16; ++r) rli[r] = __builtin_amdgcn_rcpf(li_l[crow(r, hi)]);
    bf16_t* Ow = Ob + (long)(wid * QBLK) * LDO;
#pragma unroll
    for (int r = 0; r < 16; ++r) { const int orow = crow(r, hi);
#pragma unroll
        for (int d0 = 0; d0 < 4; ++d0) Ow[(long)orow * LDO + d0 * 32 + r32] = f2bf(o[d0][r] * rli[r]); }
#undef SLOAD
#undef SWRITE
#undef RESC
}
#undef KSWZ
#undef SBAR
}

DI void attn_phase(const bf16_t* Q, const bf16_t* KB, const bf16_t* VB, bf16_t* O, char* lds, int nitems, const float* qnorm) {
    for (int it = blockIdx.x; it < nitems; it += gridDim.x) {
        int b, h, qrow0, seq, tpos0;
        if (it < 2048) {
            const int rnd = it >> 8, blk = it & 255, xcd_ = blk & 7, slot_ = blk >> 3, idx = rnd * 16 + xcd_ * 2 + (slot_ >> 4);
            b = idx >> 3; h = idx & 7; tpos0 = (slot_ & 15) * 256; qrow0 = b * SEQ + tpos0; seq = KEYS; }
        else { const int j = it - 2048; b = j >> 3; h = j & 7; qrow0 = TL + b * CTXL; seq = CTXL; tpos0 = -1; }
        att::attn_body(Q + (size_t)qrow0 * 1536 + h * 192, KB + (size_t)b * KEYS * 1536 + h * 192, VB + (size_t)b * KEYS * 1024 + h * 128,
                       O + (size_t)qrow0 * 1024 + h * 128, seq, lds, qnorm, tpos0);
        __syncthreads();
    }
}

DI void fixup_phase(const float* halo, const float* cw, const float* cb, bf16_t* act) {
    const int gtid = blockIdx.x * NTHREADS + tid_opq(), gstride = gridDim.x * NTHREADS;
    for (int idx = gtid; idx < 272 * 22 * 64; idx += gstride) {
        const int c4 = (idx & 31) * 4, which = (idx >> 5) & 1, t = idx >> 6, pn = t % 22, pm = t / 22;
        const float* hp = halo + (size_t)(pm * 22 + pn) * 4 * 256;
        const bool sfirst = pm >= 256 || (pm & 15) == 0, slast = pm >= 256 || (pm & 15) == 15;
        const f32x4 z4 = (f32x4){0.f, 0.f, 0.f, 0.f};
        f32x4 pa, pg, ca, cg_, na, ng; int row;
        if (which == 0) { row = pm * 256;
            if (sfirst) { pa = z4; pg = z4; } else { const float* q = halo + (size_t)((pm - 1) * 22 + pn) * 4 * 256 + 3 * 256; pa = *(const f32x4*)(q + c4); pg = *(const f32x4*)(q + 128 + c4); }
            ca = *(const f32x4*)(hp + c4); cg_ = *(const f32x4*)(hp + 128 + c4); na = *(const f32x4*)(hp + 256 + c4); ng = *(const f32x4*)(hp + 256 + 128 + c4);
        } else { row = pm * 256 + 255;
            pa = *(const f32x4*)(hp + 2 * 256 + c4); pg = *(const f32x4*)(hp + 2 * 256 + 128 + c4); ca = *(const f32x4*)(hp + 3 * 256 + c4); cg_ = *(const f32x4*)(hp + 3 * 256 + 128 + c4);
            if (slast) { na = z4; ng = z4; } else { const float* q = halo + (size_t)((pm + 1) * 22 + pn) * 4 * 256; na = *(const f32x4*)(q + c4); ng = *(const f32x4*)(q + 128 + c4); }
        }
        const int ch = pn * 128 + c4;
        const f32x4 w0a = *(const f32x4*)(cw + ch), w1a = *(const f32x4*)(cw + 5632 + ch), w2a = *(const f32x4*)(cw + 2 * 5632 + ch), ba = *(const f32x4*)(cb + ch);
        const f32x4 w0g = *(const f32x4*)(cw + 2816 + ch), w1g = *(const f32x4*)(cw + 5632 + 2816 + ch), w2g = *(const f32x4*)(cw + 2 * 5632 + 2816 + ch), bg = *(const f32x4*)(cb + 2816 + ch);
        const f32x4 av = w0a * pa + w1a * ca + w2a * na + ba, gv = w0g * pg + w1g * cg_ + w2g * ng + bg;
        u32x2 w; w.x = cvt_pk_bf16(silu_f(gv[0]) * av[0], silu_f(gv[1]) * av[1]); w.y = cvt_pk_bf16(silu_f(gv[2]) * av[2], silu_f(gv[3]) * av[3]);
        *(u32x2*)(act + (size_t)row * 2816 + ch) = w;
    }
}


#define XB_TMO      128
#define XB_XCNT(j)  (256  + 64 * (j))
#define XB_XSUB(j)  (1280 + 64 * (j))
#define XB_XGEN(j)  (2304 + 64 * (j))
#define XB_TOP      3328
#define XB_TOPGEN   3392
#define XCD_BAR_WORDS 3456
#define XB_SPIN_CAP (1u << 18)
DI unsigned xb_ld(unsigned* p)              { return __hip_atomic_load(p, __ATOMIC_RELAXED, __HIP_MEMORY_SCOPE_AGENT); }
DI unsigned xb_add(unsigned* p, unsigned v) { return __hip_atomic_fetch_add(p, v, __ATOMIC_RELAXED, __HIP_MEMORY_SCOPE_AGENT); }
DI unsigned xb_xcc_id() { return (unsigned)__builtin_amdgcn_s_getreg((3 << 11) | 20) & 0xFu; }
#define XB_SPIN(cond, bar) do { unsigned _sp = 0; while (cond) { \
    if ((++_sp & 255u) == 0u) { if (xb_ld(&(bar)[XB_TMO])) break; if (_sp > XB_SPIN_CAP) { atomicAdd(&(bar)[XB_TMO], 1u); break; } } } } while (0)
struct XcdBarrier { unsigned* bar; unsigned x; volatile LAS unsigned* st; };
DI XcdBarrier xcd_barrier_post(unsigned* bar, volatile LAS unsigned* st) {
    XcdBarrier b; b.bar = bar; b.x = xb_xcc_id(); b.st = st;
    if (threadIdx.x == 0) (void)xb_add(&bar[XB_XCNT(b.x)], 1u);
    return b;
}
DI void xcd_barrier_complete(unsigned* bar, unsigned x, unsigned& nloc, unsigned& nx) {
    const unsigned G = gridDim.x * gridDim.y * gridDim.z;
    unsigned sum, cnt, mine, sp = 0u;
    for (;;) {
        sum = 0u; cnt = 0u; mine = 0u;
#pragma unroll
        for (unsigned j = 0; j < 16; ++j) { const unsigned c = xb_ld(&bar[XB_XCNT(j)]); sum += c; cnt += (c > 0u) ? 1u : 0u; mine = (j == x) ? c : mine; }
        if (sum == G) break;
        __builtin_amdgcn_s_sleep(1);
        if ((++sp & 255u) == 0u) { if (xb_ld(&bar[XB_TMO])) break; if (sp > XB_SPIN_CAP) { atomicAdd(&bar[XB_TMO], 1u); break; } }
    }
    nloc = mine > 0u ? mine : 1u; nx = cnt > 0u ? cnt : 1u;
}
DI void xcd_barrier(const XcdBarrier& b) {
    asm volatile("s_waitcnt vmcnt(0)" ::: "memory");
    __syncthreads();
    if (threadIdx.x == 0) {
        unsigned* bar = b.bar;
        __builtin_amdgcn_s_waitcnt(0);
        unsigned nloc = b.st[0], nx = b.st[1];
        if (nloc == 0u) { xcd_barrier_complete(bar, b.x, nloc, nx); b.st[0] = nloc; b.st[1] = nx; }
        const unsigned old = xb_add(&bar[XB_XSUB(b.x)], 1u);
        const unsigned gen = old / nloc;
        if (old + 1u == (gen + 1u) * nloc) {
            __builtin_amdgcn_fence(__ATOMIC_RELEASE, "agent");
            asm volatile("s_waitcnt vmcnt(0)" ::: "memory");
            const unsigned og = xb_add(&bar[XB_TOP], 1u);
            const unsigned tg = og / nx;
            if (og + 1u == (tg + 1u) * nx) xb_add(&bar[XB_TOPGEN], 1u);
            else XB_SPIN(xb_ld(&bar[XB_TOPGEN]) == tg, bar);
            __builtin_amdgcn_fence(__ATOMIC_ACQUIRE, "agent");
            xb_add(&bar[XB_XGEN(b.x)], 1u);
            asm volatile("s_waitcnt vmcnt(0)" ::: "memory");
        } else {
            XB_SPIN(xb_ld(&bar[XB_XGEN(b.x)]) == gen, bar);
            __builtin_amdgcn_fence(__ATOMIC_ACQUIRE, "agent");
            asm volatile("s_waitcnt vmcnt(0)" ::: "memory");
        }
    }
    __syncthreads();
}

__global__ void __launch_bounds__(NTHREADS) mega(Params p) {
    extern __shared__ __attribute__((aligned(16))) unsigned char smem[];
    LAS unsigned char* lds = (LAS unsigned char*)smem;
    cg::grid_group grid = cg::this_grid();
    volatile LAS unsigned* xb_st = (volatile LAS unsigned*)(lds + XB_ST_OFF);
    if (threadIdx.x < 4) xb_st[threadIdx.x] = 0u;
    __syncthreads();
    XcdBarrier xbar = xcd_barrier_post((unsigned*)((unsigned char*)p.in[27] + WS_BAR), xb_st);

    for (int ph = p.ph_lo; ph < p.ph_hi; ++ph) {
        unsigned char* ws = (unsigned char*)p.in[opq(27)];
        float* const xout = (float*)p.in[opq(26)];
        float* mod = (float*)(ws + WS_MOD);
        float* xc = (float*)(ws + WS_XC);
        bf16_t* hbuf = (bf16_t*)(ws + WS_H);
        if (ph == 0) {
            prep_phase(p, lds);
#if defined(MK_DUP_OP) && MK_DUP_OP == 99
            grid.sync(); prep_phase(p, lds);
#endif
        } else {
            const int q = ph - 1, lp = q / 21; int r = q % 21; int layer, nmix;
            if (r < 10) { layer = 2 * lp; nmix = 6; } else { layer = 2 * lp + 1; r -= 10; nmix = 7; }
            const bool is_mla = layer & 1; const int j = layer >> 1;
            const float* modl = mod + (size_t)layer * 17 * 6144;
            const bool first = (layer == 0);
            int op = -1, gsel = 0, hf = 0;
            if (r < nmix) {
                if (!is_mla) { op = r == 0 ? 0 : r == 1 ? 2 : r == 2 ? 9 : r == 3 ? 3 : r == 4 ? 4 : 2; gsel = r == 1 ? 0 : 1; }
                else { op = r == 0 ? 0 : r == 1 ? 2 : r == 2 ? 5 : r == 3 ? 2 : r == 4 ? 6 : r == 5 ? 7 : 2; gsel = r == 1 ? 2 : r == 3 ? 3 : 5; }
            } else {
                const int f = r - nmix;
                op = f == 0 ? 1 : f == 2 ? 8 : 2; gsel = f == 1 ? 6 : 7;
            }
            if (op == 1 || op == 6 || (op == 0 && layer > 0)) continue;
#ifdef MK_DUP_OP
            for (int rep_ = 0; rep_ < ((op == MK_DUP_OP || (op == 2 && gsel == MK_DUP_OP - 100)) ? 2 : 1); ++rep_) {
            if (rep_) grid.sync();
#else
            {
#endif
            if (op == 0) {
                norm_phase(p.in[opq(0)], p.in[opq(2)], p.in[opq(6)], modl, 0, 1024, hbuf);
                shw_phase(ws, lds);
            } else if (op == 2) {
                const int ng = (gsel == 3) ? 2 : 1;
                for (int gi = 0; gi < ng; ++gi) {
                    pg8::Gemm g; Epi E; int kind = EPI_BF16;
                    E.ldc = 0; E.xch = (LAS float*)(lds + XCH_OFF); E.q0 = nullptr; E.q1 = nullptr; E.q2 = nullptr; E.q3 = nullptr; E.q4 = nullptr; E.q5 = nullptr;
                    float* const shw_mix = (float*)(ws + WS_SHW) + (size_t)(layer * 2) * 17 * 5632; float* const shw_ffn = shw_mix + 17 * 5632;
                    float* const rs0 = (float*)(ws + WS_RS); float* const rs1 = rs0 + MR;
                    g.M = MR;
                    const int gs = gsel + gi;
                    if (gs == 0) { g.A = hbuf; g.Bt = (const bf16_t*)(ws + WS_GIN + j * SZ_GIN); g.N = 3328; g.K = 1024; g.lda = 1024; g.ldb = 1024;
                        kind = EPI_GLA_IN; E.q0 = ws + WS_QK; E.ldc = 1024; E.q1 = ws + WS_LR; E.q2 = ws + WS_VR; if (!first) { E.q3 = rs1; E.q4 = shw_mix; } }
                    else if (gs == 1 || gs == 5) { g.A = hbuf; g.Bt = (const bf16_t*)(ws + (gs == 1 ? WS_GOUT : WS_MOUT) + j * SZ_SQ); g.N = 1024; g.K = 1024; g.lda = 1024; g.ldb = 1024;
                        kind = EPI_RESID; E.ldc = 0; E.q0 = (void*)(first ? p.in[opq(0)] : xout); E.q1 = (void*)(first ? p.in[opq(2)] : xc); E.q2 = xout; E.q3 = ws; E.q4 = (void*)modl; E.q5 = (void*)(p.in[opq(7)] + layer * 1024);
                        for (int i = blockIdx.x * NTHREADS + tid_opq(); i < MR; i += gridDim.x * NTHREADS) rs1[i] = 0.f; }
                    else if (gs == 2) { g.A = hbuf; g.Bt = (const bf16_t*)(ws + WS_MDOWN + j * SZ_MDOWN); g.N = 768; g.K = 1024; g.lda = 1024; g.ldb = 1024;
                        E.q0 = ws + WS_DN; E.ldc = 768; E.q3 = rs1; E.q4 = shw_mix; }
                    else if (gs == 3) { g.A = (const bf16_t*)(ws + WS_CQN); g.Bt = (const bf16_t*)(ws + WS_MUQ + j * SZ_MUQ); g.N = 1536; g.K = 384; g.lda = 384; g.ldb = 384;
                        E.q0 = ws + WS_QRAW; E.ldc = 1536; }
                    else if (gs == 4) { g.A = (const bf16_t*)(ws + WS_CKVN); g.Bt = (const bf16_t*)(ws + WS_MUKV + j * SZ_MUKV); g.N = 2048; g.K = 256; g.lda = 256; g.ldb = 256;
                        kind = EPI_UKV; E.q0 = ws + WS_KB; E.q1 = ws + WS_VB; E.q2 = (void*)(p.in[opq(20)] + j * 192); }
                    else if (gs == 6) { g.A = (const bf16_t*)(ws + WS_XSA); g.Bt = (const bf16_t*)(ws + WS_FUP + (size_t)layer * SZ_FUP); g.N = 5632; g.K = 1024; g.lda = 1024; g.ldb = 1024;
                        kind = EPI_FFN_UP; E.q0 = ws + WS_ACT; E.ldc = 2816; E.q1 = (void*)(p.in[opq(23)] + (size_t)layer * 3 * 2 * DFF); E.q2 = (void*)(p.in[opq(24)] + (size_t)layer * 2 * DFF);
                        E.q3 = ws + WS_HALO; E.q4 = rs0; E.q5 = shw_ffn; }
                    else { g.A = (const bf16_t*)(ws + WS_ACT); g.Bt = (const bf16_t*)(ws + WS_FDOWN + (size_t)layer * SZ_FDOWN); g.N = 1024; g.K = 2816; g.lda = 2816; g.ldb = 2816;
                        kind = EPI_RESID; E.ldc = 1; E.q0 = xout; E.q1 = xc; E.q2 = xout; E.q3 = ws; E.q4 = (void*)modl; E.q5 = layer < 3 ? (void*)(p.in[opq(6)] + (layer + 1) * 1024) : nullptr;
                        for (int i = blockIdx.x * NTHREADS + tid_opq(); i < MR; i += gridDim.x * NTHREADS) rs0[i] = 0.f; }
                    if (layer == 3 && (gs == 3 || gs == 5 || gs == 6 || gs == 7)) g.M = TL;
                    pg8::StaticOrder S; S.init(g.M, g.N, (int)gridDim.x, (int)blockIdx.x, (gs == 1 || gs == 5 || gs == 7) ? 1 : 0);
                    if (kind == EPI_BF16) pg8::gemm_phase<Epi, EPI_BF16>(lds, g, S, E);
                    else if (kind == EPI_GLA_IN) pg8::gemm_phase<Epi, EPI_GLA_IN>(lds, g, S, E);
                    else if (kind == EPI_RESID) pg8::gemm_phase<Epi, EPI_RESID>(lds, g, S, E);
                    else if (kind == EPI_UKV) pg8::gemm_phase<Epi, EPI_UKV>(lds, g, S, E);
                    else pg8::gemm_phase<Epi, EPI_FFN_UP>(lds, g, S, E);
                    __syncthreads();
                }
            } else if (op == 3) {
                scan_phase((const bf16_t*)(ws + WS_VR), (const bf16_t*)(ws + WS_GQ), (const bf16_t*)(ws + WS_GK), (const bf16_t*)(ws + WS_GP), (const float*)(ws + WS_GE),
                           hbuf, (bf16_t*)(ws + WS_QK), lds);
            } else if (op == 9) {
                gateprep_phase((const bf16_t*)(ws + WS_QK), (const float*)(ws + WS_LR), p.in[opq(10)] + (size_t)j * 2 * 16 * 512, p.in[opq(11)] + (size_t)j * 2 * 512,
                               (bf16_t*)(ws + WS_GQ), (bf16_t*)(ws + WS_GK), (bf16_t*)(ws + WS_GP), (float*)(ws + WS_GE), lds);
            } else if (op == 4) {
                glapost_phase(hbuf, (const bf16_t*)(ws + WS_QK), (const bf16_t*)(ws + WS_VR), p.in[opq(12)] + j * 256, hbuf);
            } else if (op == 5) {
                mlamid_phase((const bf16_t*)(ws + WS_DN), p.in[opq(15)] + j * 384, p.in[opq(16)] + j * 256, p.in[opq(20)] + j * 192, (bf16_t*)(ws + WS_CQN), (bf16_t*)(ws + WS_CKVN), (bf16_t*)(ws + WS_KB));
            } else if (op == 6) {
                qkprep_phase((bf16_t*)(ws + WS_KB), p.in[opq(20)] + j * 192);
            } else if (op == 7) {
                attn_phase((const bf16_t*)(ws + WS_QRAW), (const bf16_t*)(ws + WS_KB), (const bf16_t*)(ws + WS_VB), hbuf, (char*)smem, layer == 3 ? 2048 : 2048 + 128, p.in[opq(19)] + j * 192);
            } else if (op == 8) {
                fixup_phase((const float*)(ws + WS_HALO), p.in[opq(23)] + (size_t)layer * 3 * 2 * DFF, p.in[opq(24)] + (size_t)layer * 2 * DFF, (bf16_t*)(ws + WS_ACT));
            }
            }
        }
        if (ph + 1 < p.ph_hi) { if (p.ph_lo < 0) grid.sync(); else xcd_barrier(xbar); }
    }
}

extern "C" void kernel_launch(void* const* d_in, const int* in_sizes, int n_in, void* d_out, int out_size, void* d_ws, size_t ws_size, hipStream_t stream) {
    static int grid = 0;
    if (grid == 0) {
        if (n_in != 26 || ws_size < WS_END) { fprintf(stderr, "kernel_launch: n_in %d ws %zu (need %zu)\n", n_in, ws_size, (size_t)WS_END); grid = -1; return; }
        int dev = 0, cus = 0, per_cu = 0;
        hipGetDevice(&dev);
        hipDeviceGetAttribute(&cus, hipDeviceAttributeMultiprocessorCount, dev);
        if (hipFuncSetAttribute((const void*)mega, hipFuncAttributeMaxDynamicSharedMemorySize, LDS_BYTES) != hipSuccess) { fprintf(stderr, "kernel_launch: hipFuncSetAttribute failed\n"); grid = -1; return; }
        if (hipOccupancyMaxActiveBlocksPerMultiprocessor(&per_cu, (const void*)mega, NTHREADS, LDS_BYTES) != hipSuccess || per_cu < 1) { fprintf(stderr, "kernel_launch: occupancy query %d\n", per_cu); per_cu = 1; }
        (void)hipGetLastError();
        grid = cus * per_cu;
        fprintf(stderr, "kernel_launch: grid %d (cus %d x %d)\n", grid, cus, per_cu);
    }
    if (grid < 0) return;
    Params p{};
    for (int i = 0; i < 26; ++i) p.in[i] = (const float*)d_in[i];
    p.in[26] = (const float*)d_out; p.in[27] = (const float*)d_ws;
    (void)hipMemsetAsync((unsigned char*)d_ws + WS_BAR, 0, 16384, stream);
#if MK_MULTI
    for (int ph = 0; ph < NPH; ++ph) {
        p.ph_lo = ph; p.ph_hi = ph + 1;
        hipLaunchKernelGGL(mega, dim3(grid), dim3(NTHREADS), LDS_BYTES, stream, p);
    }
#else
    p.ph_lo = 0; p.ph_hi = NPH;
    void* args[] = {&p};
    hipError_t e = hipLaunchCooperativeKernel((const void*)mega, dim3(grid), dim3(NTHREADS), args, LDS_BYTES, stream);
    if (e != hipSuccess) fprintf(stderr, "cooperative launch failed: %s (grid %d)\n", hipGetErrorString(e), grid);
#endif
}
```
